# Optimizing an MI355X kernel written in HIP

```python
import jax, jax.numpy as jnp
from jax import lax
import numpy as np

D_MODEL = 1024
BATCH = 4
SEQ = 8192
DEPTH = 1

GRID_W = 64
CTX_LEN = 256
W_CONV = 1024
CONV_K = 31
W_LRU = 1024
LRU_HEADS = 8
LRU_HEAD_DIM = W_LRU // LRU_HEADS
LRU_CONV_K = 4
LRU_C = 8.0
N_GROUPS = 4
EXPERTS_PER_GROUP = 4
N_EXPERTS = N_GROUPS * EXPERTS_PER_GROUP
TOP_K_IN_GROUP = 2
D_EXPERT = 512
EPS = 1e-6
SPLITS = (W_CONV, 2 * W_CONV, 2 * W_CONV + W_LRU, 2 * W_CONV + 2 * W_LRU, 2 * W_CONV + 2 * W_LRU + D_MODEL)
REC0 = 2 * W_CONV + W_LRU
REC1 = 2 * W_CONV + 2 * W_LRU
IN_COLS = 2 * W_CONV + 2 * W_LRU + 2 * D_MODEL

kernel_name = "hybrid_conformer_rglru_hmoe_prefix_block"


def rms_norm(x, g):
    xf = x.astype(jnp.float32)
    y = xf * lax.rsqrt(jnp.mean(xf * xf, axis=-1, keepdims=True) + EPS)
    return (y * g.astype(jnp.float32)).astype(x.dtype)


def layer_norm(x, g, b):
    xf = x.astype(jnp.float32)
    mu = jnp.mean(xf, axis=-1, keepdims=True)
    xc = xf - mu
    y = xc * lax.rsqrt(jnp.mean(xc * xc, axis=-1, keepdims=True) + EPS)
    return (y * g.astype(jnp.float32) + b.astype(jnp.float32)).astype(x.dtype)


def ada_split(cond, w, b):
    m = jax.nn.silu(cond) @ w + b
    return jnp.split(m[..., None, :], 6, axis=-1)


def modulate(xn, shift, scale):
    return xn * (1 + scale) + shift


def depthwise_conv(x, w, b, pad_lo, pad_hi):
    y = lax.conv_general_dilated(
        x, w[:, None, :].astype(x.dtype), window_strides=(1,),
        padding=[(pad_lo, pad_hi)], dimension_numbers=("NWC", "WIO", "NWC"),
        feature_group_count=x.shape[-1])
    return y + b


def conformer_conv(u, v, w_dw, b_dw, ln_g, ln_b, w_pa):
    z = u * jax.nn.sigmoid(v)
    z = depthwise_conv(z, w_dw, b_dw, CONV_K // 2, CONV_K // 2)
    z = jax.nn.silu(layer_norm(z, ln_g, ln_b))
    return z @ w_pa


def rglru_coeffs(xc, w_r, b_r, w_i, b_i, lam):
    bsz, n = xc.shape[0], xc.shape[1]
    xh = xc.reshape(bsz, n, LRU_HEADS, LRU_HEAD_DIM)
    r = jax.nn.sigmoid(jnp.einsum("blhi,hij->blhj", xh, w_r) + b_r).reshape(bsz, n, W_LRU)
    i = jax.nn.sigmoid(jnp.einsum("blhi,hij->blhj", xh, w_i) + b_i).reshape(bsz, n, W_LRU)
    log_a = -LRU_C * r.astype(jnp.float32) * jax.nn.softplus(-lam.astype(jnp.float32))
    a = jnp.exp(log_a)
    b = jnp.sqrt(-jnp.expm1(2.0 * log_a)) * (i * xc).astype(jnp.float32)
    return a, b


def linear_scan(a, b, h0):
    b = b.at[:, 0].add(a[:, 0] * h0)

    def combine(left, right):
        a_l, b_l = left
        a_r, b_r = right
        return a_l * a_r, a_r * b_l + b_r

    _, h = lax.associative_scan(combine, (a, b), axis=1)
    return h


def rglru_bidir(xc, pf, pb, h0f, h0b):
    af, bf = rglru_coeffs(xc, *pf)
    ab, bb = rglru_coeffs(jnp.flip(xc, axis=1), *pb)
    return linear_scan(af, bf, h0f), linear_scan(ab, bb, h0b)


def split_proj(p):
    return jnp.split(p, SPLITS, axis=-1)


def merge_branches(br_a, br_b, g_a, g_b, w_o):
    return (jax.nn.sigmoid(g_a) * br_a + jax.nn.sigmoid(g_b) * br_b) @ w_o


def hier_moe(h, w_grp, b_grp, w_er, b_er, w_gate, w_up, w_down):
    n_tok = h.shape[0]
    g_logits = (h @ w_grp + b_grp).astype(jnp.float32)
    g_prob = jax.nn.softmax(g_logits, axis=-1)
    g_sel = jnp.argmax(g_logits, axis=-1)
    p_grp = jnp.max(g_prob, axis=-1, keepdims=True)
    e_logits = (h @ w_er + b_er).astype(jnp.float32).reshape(n_tok, N_GROUPS, EXPERTS_PER_GROUP)
    e_sel = jnp.einsum("nge,ng->ne", e_logits, jax.nn.one_hot(g_sel, N_GROUPS, dtype=jnp.float32))
    top_v, top_i = lax.top_k(e_sel, TOP_K_IN_GROUP)
    wts = p_grp * jax.nn.softmax(top_v, axis=-1)
    expert_id = g_sel[:, None] * EXPERTS_PER_GROUP + top_i
    combine = jnp.sum(jax.nn.one_hot(expert_id, N_EXPERTS, dtype=jnp.float32) * wts[..., None], axis=1)
    combine = combine.astype(h.dtype)
    out = jnp.zeros_like(h)
    for g in range(N_GROUPS):
        sl = slice(g * EXPERTS_PER_GROUP, (g + 1) * EXPERTS_PER_GROUP)
        hg = jnp.einsum("nd,edf->nef", h, w_gate[sl])
        hu = jnp.einsum("nd,edf->nef", h, w_up[sl])
        act = jax.nn.silu(hg) * hu * combine[:, sl, None]
        out = out + jnp.einsum("nef,efd->nd", act, w_down[sl])
    return out


def setup_inputs(seed: int = 0) -> dict:
    key = jax.random.key(seed)
    ks = jax.random.split(key, 40)
    f32 = jnp.float32
    D, L = D_MODEL, DEPTH
    H, hd = LRU_HEADS, LRU_HEAD_DIM

    def nrm(k, shape, scale):
        return jax.random.normal(k, shape, f32) * scale

    def lam_init(k):
        a_c = jax.random.uniform(k, (L, W_LRU), f32, minval=0.9, maxval=0.999)
        a = a_c ** (1.0 / LRU_C)
        return jnp.log(a) - jnp.log1p(-a)

    return {
        "x": nrm(ks[0], (BATCH, SEQ, D), 1.0),
        "c": nrm(ks[1], (BATCH, D), 1.0),
        "ctx": nrm(ks[2], (BATCH, CTX_LEN, D), 1.0),
        "c_ctx": nrm(ks[3], (D,), 1.0),
        "w_ada": nrm(ks[4], (L, D, 6 * D), 0.5 * D ** -0.5),
        "b_ada": nrm(ks[5], (L, 6 * D), 0.01),
        "g_mix": 1.0 + nrm(ks[6], (L, D), 0.01),
        "w_in": nrm(ks[7], (L, D, IN_COLS), D ** -0.5),
        "b_in": nrm(ks[8], (L, IN_COLS), 0.01),
        "conv_w": nrm(ks[9], (L, CONV_K, W_CONV), CONV_K ** -0.5),
        "conv_b": nrm(ks[10], (L, W_CONV), 0.01),
        "ln_g": 1.0 + nrm(ks[11], (L, W_CONV), 0.01),
        "ln_b": nrm(ks[12], (L, W_CONV), 0.01),
        "w_pa": nrm(ks[13], (L, W_CONV, D), W_CONV ** -0.5),
        "lru_conv_w": nrm(ks[14], (L, LRU_CONV_K, W_LRU), LRU_CONV_K ** -0.5),
        "lru_conv_b": nrm(ks[15], (L, W_LRU), 0.01),
        "w_r_f": nrm(ks[16], (L, H, hd, hd), hd ** -0.5),
        "b_r_f": nrm(ks[17], (L, H, hd), 0.01),
        "w_i_f": nrm(ks[18], (L, H, hd, hd), hd ** -0.5),
        "b_i_f": nrm(ks[19], (L, H, hd), 0.01),
        "lam_f": lam_init(ks[20]),
        "w_r_b": nrm(ks[21], (L, H, hd, hd), hd ** -0.5),
        "b_r_b": nrm(ks[22], (L, H, hd), 0.01),
        "w_i_b": nrm(ks[23], (L, H, hd, hd), hd ** -0.5),
        "b_i_b": nrm(ks[24], (L, H, hd), 0.01),
        "lam_b": lam_init(ks[25]),
        "w_pb": nrm(ks[26], (L, W_LRU, D), W_LRU ** -0.5),
        "w_o": nrm(ks[27], (L, D, D), D ** -0.5),
        "g_ffn": 1.0 + nrm(ks[28], (L, D), 0.01),
        "w_grp": nrm(ks[29], (L, D, N_GROUPS), D ** -0.5),
        "b_grp": nrm(ks[30], (L, N_GROUPS), 0.01),
        "w_er": nrm(ks[31], (L, D, N_EXPERTS), D ** -0.5),
        "b_er": nrm(ks[32], (L, N_EXPERTS), 0.01),
        "w_gate": nrm(ks[33], (L, N_EXPERTS, D, D_EXPERT), D ** -0.5),
        "w_up": nrm(ks[34], (L, N_EXPERTS, D, D_EXPERT), D ** -0.5),
        "w_down": nrm(ks[35], (L, N_EXPERTS, D_EXPERT, D), D_EXPERT ** -0.5),
        "g_final": 1.0 + nrm(ks[36], (D,), 0.01),
    }


def reference(x, c, ctx, c_ctx, w_ada, b_ada, g_mix, w_in, b_in, conv_w, conv_b, ln_g, ln_b, w_pa,
              lru_conv_w, lru_conv_b, w_r_f, b_r_f, w_i_f, b_i_f, lam_f, w_r_b, b_r_b, w_i_b, b_i_b, lam_b,
              w_pb, w_o, g_ffn, w_grp, b_grp, w_er, b_er, w_gate, w_up, w_down, g_final):
    bsz, n_lat, d = x.shape
    rows = n_lat // GRID_W
    n_ctx = ctx.shape[1]
    zero_state = jnp.zeros((bsz, W_LRU), jnp.float32)
    for l in range(DEPTH):
        last = l == DEPTH - 1
        sh1, sc1, gt1, sh2, sc2, gt2 = ada_split(c, w_ada[l], b_ada[l])
        csh1, csc1, cgt1, csh2, csc2, cgt2 = ada_split(c_ctx, w_ada[l], b_ada[l])
        pf = (w_r_f[l], b_r_f[l], w_i_f[l], b_i_f[l], lam_f[l])
        pb = (w_r_b[l], b_r_b[l], w_i_b[l], b_i_b[l], lam_b[l])

        hc = modulate(rms_norm(ctx, g_mix[l]), csh1, csc1)
        if last:
            xr_c = hc @ w_in[l][:, REC0:REC1] + b_in[l][REC0:REC1]
        else:
            u_c, v_c, yg_c, xr_c, ga_c, gb_c = split_proj(hc @ w_in[l] + b_in[l])
        xc_c = depthwise_conv(xr_c, lru_conv_w[l], lru_conv_b[l], LRU_CONV_K // 2, LRU_CONV_K - 1 - LRU_CONV_K // 2)
        hf_c, hb_c = rglru_bidir(xc_c, pf, pb, zero_state, zero_state)
        h0f, h0b = hf_c[:, -1], hb_c[:, -1]
        if not last:
            a_c = conformer_conv(u_c, v_c, conv_w[l], conv_b[l], ln_g[l], ln_b[l], w_pa[l])
            y_c = (hf_c + jnp.flip(hb_c, axis=1)).astype(ctx.dtype)
            b_c = (jax.nn.gelu(yg_c) * y_c) @ w_pb[l]
            ctx_new = ctx + cgt1 * merge_branches(a_c, b_c, ga_c, gb_c, w_o[l])
            hcf = modulate(rms_norm(ctx_new, g_ffn[l]), csh2, csc2)
            ctx_new = ctx_new + cgt2 * hier_moe(hcf.reshape(-1, d), w_grp[l], b_grp[l], w_er[l], b_er[l],
                                                w_gate[l], w_up[l], w_down[l]).reshape(bsz, n_ctx, d)

        hx = modulate(rms_norm(x, g_mix[l]), sh1, sc1)
        u, v, yg, xr, ga, gb = split_proj(hx @ w_in[l] + b_in[l])
        a_lat = conformer_conv(u.reshape(bsz * rows, GRID_W, W_CONV), v.reshape(bsz * rows, GRID_W, W_CONV),
                               conv_w[l], conv_b[l], ln_g[l], ln_b[l], w_pa[l]).reshape(bsz, n_lat, d)
        xc = depthwise_conv(xr, lru_conv_w[l], lru_conv_b[l], LRU_CONV_K // 2, LRU_CONV_K - 1 - LRU_CONV_K // 2)
        hf, hb = rglru_bidir(xc, pf, pb, h0f, h0b)
        y_rec = (hf + jnp.flip(hb, axis=1)).astype(x.dtype)
        b_lat = (jax.nn.gelu(yg) * y_rec) @ w_pb[l]
        x = x + gt1 * merge_branches(a_lat, b_lat, ga, gb, w_o[l])
        hm = modulate(rms_norm(x, g_ffn[l]), sh2, sc2)
        x = x + gt2 * hier_moe(hm.reshape(-1, d), w_grp[l], b_grp[l], w_er[l], b_er[l],
                               w_gate[l], w_up[l], w_down[l]).reshape(bsz, n_lat, d)
        if not last:
            ctx = ctx_new
    return rms_norm(x, g_final)
```

```cpp
#include <hip/hip_runtime.h>
#include <hip/hip_cooperative_groups.h>
#include <cstdio>
#include <cstdint>
namespace cg = cooperative_groups;

#ifndef ONE_LAUNCH
#define ONE_LAUNCH 0
#endif

typedef unsigned short bf16_t;
typedef short bf16x8 __attribute__((ext_vector_type(8)));
typedef float f32x4 __attribute__((ext_vector_type(4)));
typedef float f32x2 __attribute__((ext_vector_type(2)));
typedef unsigned u32x4 __attribute__((ext_vector_type(4)));
typedef unsigned u32x2 __attribute__((ext_vector_type(2)));

constexpr int NT = 32768, NCX = 1024, DM = 1024, SEQ = 8192, CTXL = 256;
constexpr int NTHR = 512;
constexpr int NCH64 = 132;
constexpr size_t MiB = (size_t)1 << 20;
constexpr size_t OFF_CTL = 0, OFF_MOD = 1 * MiB, OFF_BINP = OFF_MOD + 128 * 1024, OFF_WIN = 2 * MiB, OFF_WPA = 14 * MiB, OFF_WPB = 16 * MiB,
                 OFF_WO = 18 * MiB, OFF_WG = 20 * MiB, OFF_WGU = 22 * MiB, OFF_WDN = 54 * MiB, OFF_HC = 70 * MiB, OFF_XRC = 72 * MiB,
                 OFF_TOT = 74 * MiB, OFF_ROUTE = 84 * MiB, OFF_LIST = 85 * MiB, OFF_WL = 87 * MiB, OFF_SLOT = 90 * MiB, SLOT = 64 * MiB,
                 WS_END = OFF_SLOT + 6 * SLOT;
constexpr int LDS_BYTES = 144 * 1024;
constexpr int NPHASE = 11;

struct Params { const float* in[37]; float* out; unsigned char* ws; };

enum { I_X = 0, I_C, I_CTX, I_CCTX, I_WADA, I_BADA, I_GMIX, I_WIN, I_BIN, I_CONVW, I_CONVB, I_LNG, I_LNB, I_WPA, I_LCW, I_LCB,
       I_WRF, I_BRF, I_WIF, I_BIF, I_LAMF, I_WRB, I_BRB, I_WIB, I_BIB, I_LAMB, I_WPB, I_WO, I_GFFN, I_WGRP, I_BGRP, I_WER, I_BER,
       I_WGATE, I_WUP, I_WDOWN, I_GFINAL };

__device__ __forceinline__ float bflo(unsigned w) { return __uint_as_float(w << 16); }
__device__ __forceinline__ float bfhi(unsigned w) { return __uint_as_float(w & 0xffff0000u); }
__device__ __forceinline__ float bf2f(bf16_t h) { return __uint_as_float(((unsigned)h) << 16); }
__device__ __forceinline__ unsigned pk2(float lo, float hi) { unsigned r; asm("v_cvt_pk_bf16_f32 %0, %1, %2" : "=v"(r) : "v"(lo), "v"(hi)); return r; }
__device__ __forceinline__ bf16_t f2bf(float f) { return (bf16_t)(pk2(f, 0.f) & 0xffffu); }
__device__ __forceinline__ float sigm(float x) { return __builtin_amdgcn_rcpf(1.0f + __expf(-x)); }
__device__ __forceinline__ float silu(float x) { return x * sigm(x); }
__device__ __forceinline__ float gelu_tanh(float x) { return x * sigm(1.5957691216057308f * (x + 0.044715f * x * x * x)); }
__device__ __forceinline__ float wave_sum(float v) {
#pragma unroll
    for (int o = 1; o < 64; o <<= 1) v += __shfl_xor(v, o);
    return v;
}
__device__ __forceinline__ void wave_lds_sync() { asm volatile("s_waitcnt lgkmcnt(0)" ::: "memory"); __builtin_amdgcn_wave_barrier(); }
__device__ __forceinline__ u32x2 pk4(f32x4 v) { u32x2 r; r.x = pk2(v[0], v[1]); r.y = pk2(v[2], v[3]); return r; }

template <class DRow>
__device__ __forceinline__ void tr_item(const float* __restrict__ src, int ldsrc, int k0, int n0, bf16_t* dst, int ldd, DRow drow, float* scr, int lane) {
#pragma unroll 8
    for (int i = 0; i < 32; ++i) { const int kk = 2 * i + (lane >> 5); scr[kk * 33 + (lane & 31)] = src[(size_t)(k0 + kk) * ldsrc + n0 + (lane & 31)]; }
    wave_lds_sync();
    const int c = lane & 7;
#pragma unroll
    for (int j = 0; j < 4; ++j) {
        const int n = (lane >> 3) + 8 * j; const float* s = scr + (8 * c) * 33 + n;
        u32x4 o; o.x = pk2(s[0], s[33]); o.y = pk2(s[66], s[99]); o.z = pk2(s[132], s[165]); o.w = pk2(s[198], s[231]);
        *(u32x4*)(dst + (size_t)drow(n0 + n) * ldd + k0 + 8 * c) = o;
    }
    wave_lds_sync();
}

__device__ __forceinline__ int win_srccol(int np) { const int p = np >> 8, r = np & 255; return p < 8 ? (r >> 7) * 1024 + 128 * p + (r & 127) : np; }

__device__ __forceinline__ void ph0_prep(const Params& p, int bid, int nb, unsigned char* lds) {
    const int tid = threadIdx.x, lane = tid & 63, wave = tid >> 6;
    unsigned char* ws = p.ws;
    float* scr = (float*)lds + wave * (64 * 33);
    const int gw = bid * 8 + wave, NGW = nb * 8;
    constexpr int N_WIN = 16 * 192, N_SQ = 16 * 32, N_G = 256, N_GU = 4096, N_DN = 4096;
    constexpr int NITEMS = N_WIN + 3 * N_SQ + N_G + 2 * N_GU + N_DN;
    for (int it = gw; it < NITEMS; it += NGW) {
        int r = it;
        if (r < N_WIN) { const int kb = r / 192, nbk = r % 192, d0 = 32 * nbk, sc0 = win_srccol(d0);
            tr_item(p.in[I_WIN], 6144, 64 * kb, sc0, (bf16_t*)(ws + OFF_WIN), 1024, [=](int n) { return n - sc0 + d0; }, scr, lane); continue; }
        r -= N_WIN;
        if (r < 3 * N_SQ) { const int which = r / N_SQ, q = r % N_SQ, kb = q / 32, nbk = q % 32;
            const float* src = which == 0 ? p.in[I_WPA] : which == 1 ? p.in[I_WPB] : p.in[I_WO];
            bf16_t* dst = (bf16_t*)(ws + (which == 0 ? OFF_WPA : which == 1 ? OFF_WPB : OFF_WO));
            tr_item(src, 1024, 64 * kb, 32 * nbk, dst, 1024, [=](int n) { return n; }, scr, lane); continue; }
        r -= 3 * N_SQ;
        if (r < N_G) { const int ty = r / 64, q = r % 64, h = q / 8, kb = (q % 8) / 4, nbk = q % 4;
            const float* src = (ty == 0 ? p.in[I_WRF] : ty == 1 ? p.in[I_WIF] : ty == 2 ? p.in[I_WRB] : p.in[I_WIB]) + (size_t)h * 128 * 128;
            tr_item(src, 128, 64 * kb, 32 * nbk, (bf16_t*)(ws + OFF_WG), 128, [=](int n) { return h * 512 + (n >> 4) * 64 + ty * 16 + (n & 15); }, scr, lane); continue; }
        r -= N_G;
        if (r < 2 * N_GU) { const int bj = r / N_GU, q = r % N_GU, e = q / 256, kb = (q % 256) / 16, nbk = q % 16;
            const float* src = (bj == 0 ? p.in[I_WGATE] : p.in[I_WUP]) + (size_t)e * 1024 * 512;
            tr_item(src, 512, 64 * kb, 32 * nbk, (bf16_t*)(ws + OFF_WGU) + (size_t)e * 1024 * 1024, 1024, [=](int n) { return 256 * (n >> 7) + 128 * bj + (n & 127); }, scr, lane); continue; }
        r -= 2 * N_GU;
        { const int e = r / 256, kb = (r % 256) / 32, nbk = r % 32;
            tr_item(p.in[I_WDOWN] + (size_t)e * 512 * 1024, 1024, 64 * kb, 32 * nbk, (bf16_t*)(ws + OFF_WDN) + (size_t)e * 1024 * 512, 512, [=](int n) { return n; }, scr, lane); }
    }
    __syncthreads();
    float* red = (float*)lds;
    float* MOD = (float*)(ws + OFF_MOD);
    for (int it = bid; it < 96; it += nb) {
        const int col = it * 64 + lane;
        float a[5] = {0.f, 0.f, 0.f, 0.f, 0.f};
        const float* W = p.in[I_WADA];
        for (int k = wave * 128; k < wave * 128 + 128; ++k) {
            const float wv = W[(size_t)k * 6144 + col];
#pragma unroll
            for (int r = 0; r < 5; ++r) { const float cv = r < 4 ? p.in[I_C][r * 1024 + k] : p.in[I_CCTX][k]; a[r] += silu(cv) * wv; }
        }
#pragma unroll
        for (int r = 0; r < 5; ++r) red[(wave * 5 + r) * 64 + lane] = a[r];
        __syncthreads();
        if (tid < 320) { const int r = tid / 64, l = tid % 64; float s = 0.f;
#pragma unroll
            for (int w = 0; w < 8; ++w) s += red[(w * 5 + r) * 64 + l];
            MOD[r * 6144 + it * 64 + l] = s + p.in[I_BADA][it * 64 + l]; }
        __syncthreads();
    }
    float* BINP = (float*)(ws + OFF_BINP);
    for (int i = bid * NTHR + tid; i < 6144; i += nb * NTHR) BINP[i] = p.in[I_BIN][win_srccol(i)];
    if (bid == 0 && tid < 64) ((unsigned*)(ws + OFF_CTL))[tid] = 0u;
}

__device__ __forceinline__ void ph1_norm(const Params& p, int bid, int nb) {
    const int lane = threadIdx.x & 63, wave = threadIdx.x >> 6;
    const float* MOD = (const float*)(p.ws + OFF_MOD);
    for (int r = bid * 8 + wave; r < NT + NCX; r += nb * 8) {
        const bool lat = r < NT;
        const float* src = lat ? p.in[I_X] + (size_t)r * DM : p.in[I_CTX] + (size_t)(r - NT) * DM;
        bf16_t* dst = lat ? (bf16_t*)(p.ws + OFF_SLOT) + (size_t)r * DM : (bf16_t*)(p.ws + OFF_HC) + (size_t)(r - NT) * DM;
        const float* mrow = MOD + (lat ? r / SEQ : 4) * 6144;
        f32x4 v[4]; float ss = 0.f;
#pragma unroll
        for (int j = 0; j < 4; ++j) { v[j] = *(const f32x4*)(src + lane * 4 + 256 * j); ss += v[j][0] * v[j][0] + v[j][1] * v[j][1] + v[j][2] * v[j][2] + v[j][3] * v[j][3]; }
        const float rinv = rsqrtf(wave_sum(ss) * (1.0f / DM) + 1e-6f);
#pragma unroll
        for (int j = 0; j < 4; ++j) { const int c = lane * 4 + 256 * j;
            const f32x4 g = *(const f32x4*)(p.in[I_GMIX] + c), sh = *(const f32x4*)(mrow + c), sc = *(const f32x4*)(mrow + 1024 + c);
            f32x4 o;
#pragma unroll
            for (int e = 0; e < 4; ++e) o[e] = v[j][e] * rinv * g[e] * (1.0f + sc[e]) + sh[e];
            *(u32x2*)(dst + c) = pk4(o); }
    }
}

struct Unit { int pm, pn, aux, aux2; };

template <class S, class E>
__device__ __forceinline__ void sgemm_unit(const S& s, const Unit& u, const E& e) {
    const int lane = threadIdx.x & 63, w = threadIdx.x >> 6, fr = lane & 15, fq = lane >> 4;
    const int K = s.K;
    const bf16_t* b0 = s.brow(u, 16 * w + fr) + 8 * fq;
    const bf16_t* b1 = s.brow(u, 128 + 16 * w + fr) + 8 * fq;
    for (int sub = 0; sub < 4; ++sub) {
        f32x4 acc[4][2];
        const bf16_t* a[4];
#pragma unroll
        for (int m = 0; m < 4; ++m) { acc[m][0] = (f32x4){0.f, 0.f, 0.f, 0.f}; acc[m][1] = (f32x4){0.f, 0.f, 0.f, 0.f}; a[m] = s.arow(u, 64 * sub + 16 * m + fr) + 8 * fq; }
#pragma unroll 2
        for (int k0 = 0; k0 < K; k0 += 32) {
            const bf16x8 fb0 = *(const bf16x8*)(b0 + k0), fb1 = *(const bf16x8*)(b1 + k0);
#pragma unroll
            for (int m = 0; m < 4; ++m) { const bf16x8 fa = *(const bf16x8*)(a[m] + k0);
                acc[m][0] = __builtin_amdgcn_mfma_f32_16x16x32_bf16(fb0, fa, acc[m][0], 0, 0, 0);
                acc[m][1] = __builtin_amdgcn_mfma_f32_16x16x32_bf16(fb1, fa, acc[m][1], 0, 0, 0); }
        }
#pragma unroll
        for (int m = 0; m < 4; ++m) e(u, 64 * sub + 16 * m + fr, 16 * w + 4 * fq, acc[m][0], acc[m][1]);
    }
}
template <class S, class E>
__device__ __forceinline__ void gemm_phase_simple(const S& s, const E& e) { Unit u; for (int i = 0; s.next(i, u); ++i) sgemm_unit(s, u, e); }

struct SchG1 { const bf16_t *A, *Bt; int G, c, K;
    __device__ bool next(int i, Unit& u) const { const int L = i * G + c; if (L >= 128 * 24) return false; u.pm = L / 24; u.pn = L % 24; return true; }
    __device__ const bf16_t* arow(const Unit& u, int r) const { return A + (size_t)(u.pm * 256 + r) * 1024; }
    __device__ const bf16_t* brow(const Unit& u, int n) const { return Bt + (size_t)(u.pn * 256 + n) * 1024; } };
struct EpiG1 { bf16_t *Z, *GYG, *XR, *SGA, *SGB; const float* bias;
    __device__ void operator()(const Unit& u, int r, int j, f32x4 v0, f32x4 v1) const {
        const size_t row = (size_t)u.pm * 256 + r; const int cb = u.pn * 256 + j;
        v0 += *(const f32x4*)(bias + cb); v1 += *(const f32x4*)(bias + cb + 128);
        if (u.pn < 8) { f32x4 z;
#pragma unroll
            for (int e = 0; e < 4; ++e) z[e] = v0[e] * sigm(v1[e]);
            *(u32x2*)(Z + row * 1024 + u.pn * 128 + j) = pk4(z); }
        else { const int kind = u.pn >> 2;
            bf16_t* dst = GYG + (size_t)(kind - 2) * (SLOT / 2);
#pragma unroll
            for (int e = 0; e < 4; ++e) { if (kind == 2) { v0[e] = gelu_tanh(v0[e]); v1[e] = gelu_tanh(v1[e]); } else if (kind >= 4) { v0[e] = sigm(v0[e]); v1[e] = sigm(v1[e]); } }
            bf16_t* o = dst + row * 1024 + (u.pn & 3) * 256 + j;
            *(u32x2*)o = pk4(v0); *(u32x2*)(o + 128) = pk4(v1); }
    } };
struct SchCtx { const bf16_t *A, *Bt; int G, c, K;
    __device__ bool next(int i, Unit& u) const { const int L = i * G + c; if (L >= 16) return false; u.pm = L / 4; u.pn = L % 4; return true; }
    __device__ const bf16_t* arow(const Unit& u, int r) const { return A + (size_t)(u.pm * 256 + r) * 1024; }
    __device__ const bf16_t* brow(const Unit& u, int n) const { return Bt + (size_t)((12 + u.pn) * 256 + n) * 1024; } };
struct EpiCtx { bf16_t* XRC; const float* bias;
    __device__ void operator()(const Unit& u, int r, int j, f32x4 v0, f32x4 v1) const {
        const size_t row = (size_t)u.pm * 256 + r; const int cb = (12 + u.pn) * 256 + j;
        v0 += *(const f32x4*)(bias + cb); v1 += *(const f32x4*)(bias + cb + 128);
        bf16_t* o = XRC + row * 1024 + u.pn * 256 + j; *(u32x2*)o = pk4(v0); *(u32x2*)(o + 128) = pk4(v1); } };
struct SchG2 { const bf16_t *Aa, *Ab, *Wa, *Wb; int G, c, K;
    __device__ bool next(int i, Unit& u) const { const int t = (i >> 1) * G + c; if (t >= 512) return false; u.pm = t >> 2; u.pn = t & 3; u.aux = i & 1; return true; }
    __device__ const bf16_t* arow(const Unit& u, int r) const { return (u.aux ? Ab : Aa) + (size_t)(u.pm * 256 + r) * 1024; }
    __device__ const bf16_t* brow(const Unit& u, int n) const { return (u.aux ? Wb : Wa) + (size_t)(u.pn * 256 + n) * 1024; } };
struct EpiG2 { const bf16_t *SGA, *SGB; bf16_t* M;
    __device__ void operator()(const Unit& u, int r, int j, f32x4 v0, f32x4 v1) const {
        const size_t o = ((size_t)u.pm * 256 + r) * 1024 + u.pn * 256 + j;
        const bf16_t* G = u.aux ? SGB : SGA;
        const u32x2 g0 = *(const u32x2*)(G + o), g1 = *(const u32x2*)(G + o + 128);
        f32x4 r0, r1;
        r0[0] = bflo(g0.x) * v0[0]; r0[1] = bfhi(g0.x) * v0[1]; r0[2] = bflo(g0.y) * v0[2]; r0[3] = bfhi(g0.y) * v0[3];
        r1[0] = bflo(g1.x) * v1[0]; r1[1] = bfhi(g1.x) * v1[1]; r1[2] = bflo(g1.y) * v1[2]; r1[3] = bfhi(g1.y) * v1[3];
        if (u.aux) { const u32x2 t0 = *(const u32x2*)(M + o), t1 = *(const u32x2*)(M + o + 128);
            r0[0] += bflo(t0.x); r0[1] += bfhi(t0.x); r0[2] += bflo(t0.y); r0[3] += bfhi(t0.y);
            r1[0] += bflo(t1.x); r1[1] += bfhi(t1.x); r1[2] += bflo(t1.y); r1[3] += bfhi(t1.y); }
        *(u32x2*)(M + o) = pk4(r0); *(u32x2*)(M + o + 128) = pk4(r1); } };
struct SchG3 { const bf16_t *A, *Bt; int G, c, K;
    __device__ bool next(int i, Unit& u) const { const int L = i * G + c; if (L >= 512) return false; u.pm = L >> 2; u.pn = L & 3; return true; }
    __device__ const bf16_t* arow(const Unit& u, int r) const { return A + (size_t)(u.pm * 256 + r) * 1024; }
    __device__ const bf16_t* brow(const Unit& u, int n) const { return Bt + (size_t)(u.pn * 256 + n) * 1024; } };
struct EpiG3 { const float *X, *MOD; float* X1;
    __device__ void operator()(const Unit& u, int r, int j, f32x4 v0, f32x4 v1) const {
        const int row = u.pm * 256 + r, col = u.pn * 256 + j; const size_t o = (size_t)row * 1024 + col;
        const float* gt = MOD + (row / SEQ) * 6144 + 2 * 1024 + col;
        *(f32x4*)(X1 + o) = *(const f32x4*)(X + o) + *(const f32x4*)gt * v0;
        *(f32x4*)(X1 + o + 128) = *(const f32x4*)(X + o + 128) + *(const f32x4*)(gt + 128) * v1; } };
struct MoeMeta { const int* m;
    __device__ int cnt(int e) const { return m[e]; }
    __device__ int tb(int e) const { return m[16 + e]; }
    __device__ int find(int mt) const { int e = 0;
#pragma unroll
        for (int k = 1; k < 16; ++k) e += (m[16 + k] <= mt) ? 1 : 0;
        return e; } };
__device__ __forceinline__ void moe_meta_build(const Params& p, int* meta) {
    if (threadIdx.x == 0) { const unsigned* cnt = (const unsigned*)(p.ws + OFF_CTL); int t = 0;
        for (int e = 0; e < 16; ++e) { const int c = (int)__hip_atomic_load(cnt + e, __ATOMIC_RELAXED, __HIP_MEMORY_SCOPE_AGENT); meta[e] = c; meta[16 + e] = t; t += (c + 255) >> 8; }
        meta[32] = t; }
    __syncthreads();
}
struct SchUp { const bf16_t *HM, *W; const int* LIST; MoeMeta mm; int G, c, K;
    __device__ bool next(int i, Unit& u) const { const int L = i * G + c; if (L >= 4 * mm.m[32]) return false; const int mt = L >> 2; u.pn = L & 3; u.aux = mm.find(mt); u.aux2 = (mt - mm.tb(u.aux)) * 256; u.pm = mt; return true; }
    __device__ const bf16_t* arow(const Unit& u, int r) const { int pos = u.aux2 + r; const int c = mm.cnt(u.aux); pos = pos < c ? pos : c - 1; return HM + (size_t)LIST[u.aux * NT + pos] * 1024; }
    __device__ const bf16_t* brow(const Unit& u, int n) const { return W + ((size_t)u.aux * 1024 + u.pn * 256 + n) * 1024; } };
struct EpiUp { bf16_t* ACT; const float* WL; MoeMeta mm;
    __device__ void operator()(const Unit& u, int r, int j, f32x4 g, f32x4 up) const {
        const int pos = u.aux2 + r; if (pos >= mm.cnt(u.aux)) return;
        const float wt = WL[u.aux * NT + pos]; f32x4 a;
#pragma unroll
        for (int e = 0; e < 4; ++e) a[e] = silu(g[e]) * up[e] * wt;
        *(u32x2*)(ACT + ((size_t)u.pm * 256 + r) * 512 + u.pn * 128 + j) = pk4(a); } };
struct SchDn { const bf16_t *ACT, *W; MoeMeta mm; int G, c, K;
    __device__ bool next(int i, Unit& u) const { const int L = i * G + c; if (L >= 4 * mm.m[32]) return false; const int mt = L >> 2; u.pn = L & 3; u.aux = mm.find(mt); u.aux2 = (mt - mm.tb(u.aux)) * 256; u.pm = mt; return true; }
    __device__ const bf16_t* arow(const Unit& u, int r) const { return ACT + ((size_t)u.pm * 256 + r) * 512; }
    __device__ const bf16_t* brow(const Unit& u, int n) const { return W + ((size_t)u.aux * 1024 + u.pn * 256 + n) * 512; } };
struct EpiDn { bf16_t* Y; MoeMeta mm;
    __device__ void operator()(const Unit& u, int r, int j, f32x4 v0, f32x4 v1) const {
        if (u.aux2 + r >= mm.cnt(u.aux)) return;
        bf16_t* o = Y + ((size_t)u.pm * 256 + r) * 1024 + u.pn * 256 + j; *(u32x2*)o = pk4(v0); *(u32x2*)(o + 128) = pk4(v1); } };

__device__ __forceinline__ void aprep_item(const Params& p, int g, unsigned char* lds) {
    const int tid = threadIdx.x, lane = tid & 63, wave = tid >> 6;
    const bf16_t* Z = (const bf16_t*)(p.ws + OFF_SLOT + 1 * SLOT);
    bf16_t* AA = (bf16_t*)(p.ws + OFF_SLOT + 0 * SLOT);
    unsigned* zt = (unsigned*)lds;
    { const u32x4* src = (const u32x4*)(Z + (size_t)g * 64 * 1024); u32x4* d = (u32x4*)lds;
#pragma unroll 4
        for (int i = tid; i < 8192; i += NTHR) d[i] = src[i]; }
    __syncthreads();
    {
        float w0[31], w1[31];
        const float* cw = p.in[I_CONVW] + 2 * tid;
#pragma unroll
        for (int k = 0; k < 31; ++k) { const f32x2 t = *(const f32x2*)(cw + k * 1024); w0[k] = t.x; w1[k] = t.y; }
        const f32x2 cb = *(const f32x2*)(p.in[I_CONVB] + 2 * tid);
        float p0[16], p1[16];
#pragma unroll
        for (int o = 0; o < 16; ++o) { p0[o] = 0.f; p1[o] = 0.f; }
#pragma unroll
        for (int tb = 0; tb < 5; ++tb) {
            float c0[16], c1[16];
#pragma unroll
            for (int o = 0; o < 16; ++o) { c0[o] = cb.x; c1[o] = cb.y; }
            if (tb < 4) {
#pragma unroll
                for (int r0 = 0; r0 < 48; r0 += 8) {
                    unsigned vv[8];
#pragma unroll
                    for (int rr = 0; rr < 8; ++rr) { const int row = 16 * tb - 15 + r0 + rr; vv[rr] = (r0 + rr < 46 && row >= 0 && row < 64) ? zt[row * 512 + tid] : 0u; }
#pragma unroll
                    for (int rr = 0; rr < 8; ++rr) { const int r = r0 + rr, row = 16 * tb - 15 + r;
                        if (r < 46 && row >= 0 && row < 64) { const float x0 = bflo(vv[rr]), x1 = bfhi(vv[rr]);
#pragma unroll
                            for (int o = 0; o < 16; ++o) { const int k = r - o; if (k >= 0 && k < 31) { c0[o] += w0[k] * x0; c1[o] += w1[k] * x1; } } } }
                    asm volatile("" ::: "memory");
                }
            }
            if (tb > 0) {
#pragma unroll
                for (int o = 0; o < 16; ++o) zt[(16 * (tb - 1) + o) * 512 + tid] = pk2(p0[o], p1[o]);
            }
#pragma unroll
            for (int o = 0; o < 16; ++o) { p0[o] = c0[o]; p1[o] = c1[o]; }
        }
    }
    __syncthreads();
    for (int rr = 0; rr < 8; ++rr) {
        const int row = wave * 8 + rr;
        const u32x4 a = *(const u32x4*)(lds + row * 2048 + lane * 16), b = *(const u32x4*)(lds + row * 2048 + 1024 + lane * 16);
        float x[16];
        x[0] = bflo(a.x); x[1] = bfhi(a.x); x[2] = bflo(a.y); x[3] = bfhi(a.y); x[4] = bflo(a.z); x[5] = bfhi(a.z); x[6] = bflo(a.w); x[7] = bfhi(a.w);
        x[8] = bflo(b.x); x[9] = bfhi(b.x); x[10] = bflo(b.y); x[11] = bfhi(b.y); x[12] = bflo(b.z); x[13] = bfhi(b.z); x[14] = bflo(b.w); x[15] = bfhi(b.w);
        float s = 0.f;
#pragma unroll
        for (int e = 0; e < 16; ++e) s += x[e];
        const float mean = wave_sum(s) * (1.0f / 1024.0f);
        float q = 0.f;
#pragma unroll
        for (int e = 0; e < 16; ++e) { x[e] -= mean; q += x[e] * x[e]; }
        const float rstd = rsqrtf(wave_sum(q) * (1.0f / 1024.0f) + 1e-6f);
        float y[16];
#pragma unroll
        for (int hh = 0; hh < 2; ++hh) { const int c0 = hh * 512 + lane * 8;
            const f32x4 g0 = *(const f32x4*)(p.in[I_LNG] + c0), g1 = *(const f32x4*)(p.in[I_LNG] + c0 + 4), b0 = *(const f32x4*)(p.in[I_LNB] + c0), b1 = *(const f32x4*)(p.in[I_LNB] + c0 + 4);
#pragma unroll
            for (int e = 0; e < 4; ++e) { y[hh * 8 + e] = silu(x[hh * 8 + e] * rstd * g0[e] + b0[e]); y[hh * 8 + 4 + e] = silu(x[hh * 8 + 4 + e] * rstd * g1[e] + b1[e]); } }
        bf16_t* o = AA + ((size_t)g * 64 + row) * 1024 + lane * 8;
        u32x4 o0, o1; o0.x = pk2(y[0], y[1]); o0.y = pk2(y[2], y[3]); o0.z = pk2(y[4], y[5]); o0.w = pk2(y[6], y[7]);
        o1.x = pk2(y[8], y[9]); o1.y = pk2(y[10], y[11]); o1.z = pk2(y[12], y[13]); o1.w = pk2(y[14], y[15]);
        *(u32x4*)o = o0; *(u32x4*)(o + 512) = o1;
    }
    __syncthreads();
}

constexpr int XC_STRIDE = 272;
template <bool FINAL>
__device__ __forceinline__ void b_item(const Params& p, int b, int c256, int h, unsigned char* lds) {
    const int tid = threadIdx.x, lane = tid & 63, wave = tid >> 6, fr = lane & 15, q = lane >> 4;
    const bool isctx = c256 < 0;
    const int seqlen = isctx ? CTXL : SEQ, sbase = isctx ? 0 : c256 * 256;
    const bf16_t* src = isctx ? (const bf16_t*)(p.ws + OFF_XRC) + (size_t)b * CTXL * 1024 : (const bf16_t*)(p.ws + OFF_SLOT + 3 * SLOT) + (size_t)b * SEQ * 1024;
    const int kc0 = isctx ? 0 : 4 + c256 * 4;
    f32x2* TOT = (f32x2*)(p.ws + OFF_TOT);
    const bf16_t* WG = (const bf16_t*)(p.ws + OFF_WG);
    float* hin = (float*)(lds + 64 * XC_STRIDE);
    const int chl = 16 * wave + fr, ch = h * 128 + chl;
    const float brf = p.in[I_BRF][ch], bif = p.in[I_BIF][ch], brb = p.in[I_BRB][ch], bib = p.in[I_BIB][ch];
    const float nspf = -8.0f * log1pf(__expf(-p.in[I_LAMF][ch])), nspb = -8.0f * log1pf(__expf(-p.in[I_LAMB][ch]));
    if (FINAL) {
        if (tid < 256) { const int dir = tid >> 7, cl = tid & 127, cg_ = h * 128 + cl; float hc = 0.f;
            const f32x2* T = TOT + ((size_t)b * NCH64 * 2 + dir) * 1024 + cg_;
            if (dir == 0) {
                for (int k = 0; k < kc0; ++k) { const f32x2 t = T[(size_t)k * 2048]; hc = t.x * hc + t.y; }
                for (int s = 0; s < 4; ++s) { hin[(s * 2 + 0) * 128 + cl] = hc; const f32x2 t = T[(size_t)(kc0 + s) * 2048]; hc = t.x * hc + t.y; }
            } else {
                for (int k = 3; k >= 0; --k) { const f32x2 t = T[(size_t)k * 2048]; hc = t.x * hc + t.y; }
                for (int k = NCH64 - 1; k >= kc0 + 4; --k) { const f32x2 t = T[(size_t)k * 2048]; hc = t.x * hc + t.y; }
                for (int s = 3; s >= 0; --s) { hin[(s * 2 + 1) * 128 + cl] = hc; const f32x2 t = T[(size_t)(kc0 + s) * 2048]; hc = t.x * hc + t.y; }
            }
        }
        __syncthreads();
    }
    for (int sub = 0; sub < 4; ++sub) {
        const int t0 = sbase + 64 * sub;
        {
            const int tt = tid >> 3, cgp = tid & 7, c0 = h * 128 + 16 * cgp;
            float xc[16];
            { const f32x4* bp = (const f32x4*)(p.in[I_LCB] + c0);
#pragma unroll
                for (int e4 = 0; e4 < 4; ++e4) { const f32x4 t = bp[e4]; xc[4 * e4] = t[0]; xc[4 * e4 + 1] = t[1]; xc[4 * e4 + 2] = t[2]; xc[4 * e4 + 3] = t[3]; } }
#pragma unroll
            for (int k = 0; k < 4; ++k) {
                const int row = t0 + tt + k - 2;
                if (row >= 0 && row < seqlen) {
                    const u32x4 a = *(const u32x4*)(src + (size_t)row * 1024 + c0), bb = *(const u32x4*)(src + (size_t)row * 1024 + c0 + 8);
                    const f32x4* wp = (const f32x4*)(p.in[I_LCW] + k * 1024 + c0);
                    const f32x4 w0 = wp[0], w1 = wp[1], w2 = wp[2], w3 = wp[3];
                    xc[0] += w0[0] * bflo(a.x); xc[1] += w0[1] * bfhi(a.x); xc[2] += w0[2] * bflo(a.y); xc[3] += w0[3] * bfhi(a.y);
                    xc[4] += w1[0] * bflo(a.z); xc[5] += w1[1] * bfhi(a.z); xc[6] += w1[2] * bflo(a.w); xc[7] += w1[3] * bfhi(a.w);
                    xc[8] += w2[0] * bflo(bb.x); xc[9] += w2[1] * bfhi(bb.x); xc[10] += w2[2] * bflo(bb.y); xc[11] += w2[3] * bfhi(bb.y);
                    xc[12] += w3[0] * bflo(bb.z); xc[13] += w3[1] * bfhi(bb.z); xc[14] += w3[2] * bflo(bb.w); xc[15] += w3[3] * bfhi(bb.w);
                }
            }
            u32x4 o0, o1; o0.x = pk2(xc[0], xc[1]); o0.y = pk2(xc[2], xc[3]); o0.z = pk2(xc[4], xc[5]); o0.w = pk2(xc[6], xc[7]);
            o1.x = pk2(xc[8], xc[9]); o1.y = pk2(xc[10], xc[11]); o1.z = pk2(xc[12], xc[13]); o1.w = pk2(xc[14], xc[15]);
            *(u32x4*)(lds + tt * XC_STRIDE + cgp * 32) = o0; *(u32x4*)(lds + tt * XC_STRIDE + cgp * 32 + 16) = o1;
        }
        __syncthreads();
        f32x4 acc[4][4];
#pragma unroll
        for (int m = 0; m < 4; ++m)
#pragma unroll
            for (int ty = 0; ty < 4; ++ty) acc[m][ty] = (f32x4){0.f, 0.f, 0.f, 0.f};
#pragma unroll
        for (int kk = 0; kk < 4; ++kk) {
            bf16x8 fa[4];
#pragma unroll
            for (int m = 0; m < 4; ++m) fa[m] = *(const bf16x8*)(lds + (16 * m + fr) * XC_STRIDE + (32 * kk + 8 * q) * 2);
#pragma unroll
            for (int ty = 0; ty < 4; ++ty) {
                const bf16x8 fb = *(const bf16x8*)(WG + (size_t)(h * 512 + wave * 64 + ty * 16 + fr) * 128 + 32 * kk + 8 * q);
#pragma unroll
                for (int m = 0; m < 4; ++m) acc[m][ty] = __builtin_amdgcn_mfma_f32_16x16x32_bf16(fa[m], fb, acc[m][ty], 0, 0, 0);
            }
        }
#pragma unroll
        for (int m = 0; m < 4; ++m)
#pragma unroll
            for (int i = 0; i < 4; ++i) {
                const float xcv = bf2f(*(const bf16_t*)(lds + (16 * m + 4 * q + i) * XC_STRIDE + chl * 2));
                const float laf = nspf * sigm(acc[m][0][i] + brf), lab = nspb * sigm(acc[m][2][i] + brb);
                const float gif = sigm(acc[m][1][i] + bif), gib = sigm(acc[m][3][i] + bib);
                acc[m][0][i] = __expf(laf); acc[m][1][i] = sqrtf(-expm1f(2.0f * laf)) * (gif * xcv);
                acc[m][2][i] = __expf(lab); acc[m][3][i] = sqrtf(-expm1f(2.0f * lab)) * (gib * xcv);
            }
        float At[4], Bt[4], Ae[4], Be[4];
#pragma unroll
        for (int m = 0; m < 4; ++m) {
            float A = 1.f, B = 0.f;
#pragma unroll
            for (int i = 0; i < 4; ++i) { B = acc[m][0][i] * B + acc[m][1][i]; A = acc[m][0][i] * A; }
            float tA = __shfl_up(A, 16), tB = __shfl_up(B, 16); if (q >= 1) { B = A * tB + B; A = A * tA; }
            tA = __shfl_up(A, 32); tB = __shfl_up(B, 32); if (q >= 2) { B = A * tB + B; A = A * tA; }
            Ae[m] = __shfl_up(A, 16); Be[m] = __shfl_up(B, 16); if (q == 0) { Ae[m] = 1.f; Be[m] = 0.f; }
            At[m] = __shfl(A, 48 + fr); Bt[m] = __shfl(B, 48 + fr);
        }
        if (!FINAL) {
            float A = 1.f, B = 0.f;
#pragma unroll
            for (int m = 0; m < 4; ++m) { B = At[m] * B + Bt[m]; A = At[m] * A; }
            if (q == 0) TOT[((size_t)(b * NCH64 + kc0 + sub) * 2 + 0) * 1024 + ch] = (f32x2){A, B};
        } else {
            float hh = hin[(sub * 2 + 0) * 128 + chl];
#pragma unroll
            for (int m = 0; m < 4; ++m) {
                float hs = Ae[m] * hh + Be[m];
#pragma unroll
                for (int i = 0; i < 4; ++i) { hs = acc[m][0][i] * hs + acc[m][1][i]; acc[m][0][i] = hs; }
                hh = At[m] * hh + Bt[m];
            }
        }
#pragma unroll
        for (int m = 0; m < 4; ++m) {
            float A = 1.f, B = 0.f;
#pragma unroll
            for (int i = 3; i >= 0; --i) { B = acc[m][2][i] * B + acc[m][3][i]; A = acc[m][2][i] * A; }
            float tA = __shfl_down(A, 16), tB = __shfl_down(B, 16); if (q <= 2) { B = A * tB + B; A = A * tA; }
            tA = __shfl_down(A, 32); tB = __shfl_down(B, 32); if (q <= 1) { B = A * tB + B; A = A * tA; }
            Ae[m] = __shfl_down(A, 16); Be[m] = __shfl_down(B, 16); if (q == 3) { Ae[m] = 1.f; Be[m] = 0.f; }
            At[m] = __shfl(A, fr); Bt[m] = __shfl(B, fr);
        }
        if (!FINAL) {
            float A = 1.f, B = 0.f;
#pragma unroll
            for (int m = 3; m >= 0; --m) { B = At[m] * B + Bt[m]; A = At[m] * A; }
            if (q == 0) TOT[((size_t)(b * NCH64 + kc0 + sub) * 2 + 1) * 1024 + ch] = (f32x2){A, B};
        } else {
            float hh = hin[(sub * 2 + 1) * 128 + chl];
#pragma unroll
            for (int m = 3; m >= 0; --m) {
                float hs = Ae[m] * hh + Be[m];
#pragma unroll
                for (int i = 3; i >= 0; --i) { hs = acc[m][2][i] * hs + acc[m][3][i]; acc[m][2][i] = hs; }
                hh = At[m] * hh + Bt[m];
            }
            const bf16_t* GYG = (const bf16_t*)(p.ws + OFF_SLOT + 2 * SLOT);
            bf16_t* AB = (bf16_t*)(p.ws + OFF_SLOT + 1 * SLOT);
#pragma unroll
            for (int m = 0; m < 4; ++m)
#pragma unroll
                for (int i = 0; i < 4; ++i) {
                    const size_t o = ((size_t)b * SEQ + t0 + 16 * m + 4 * q + i) * 1024 + ch;
                    AB[o] = f2bf(bf2f(GYG[o]) * (acc[m][0][i] + acc[m][2][i]));
                }
        }
        __syncthreads();
    }
}

__device__ __forceinline__ void ph8_route(const Params& p, int bid, int nb, unsigned char* lds) {
    const int tid = threadIdx.x, lane = tid & 63, wave = tid >> 6;
    float* Wl = (float*)lds;
    int* lcnt = (int*)(lds + 81920);
    int* lbase = lcnt + 16;
    int* tinfo = lcnt + 32;
    float* twt = (float*)(tinfo + 512);
    for (int i = tid; i < 1024 * 20; i += NTHR) { const int k = i / 20, o = i % 20; Wl[i] = o < 4 ? p.in[I_WGRP][k * 4 + o] : p.in[I_WER][k * 16 + o - 4]; }
    const float* MOD = (const float*)(p.ws + OFF_MOD);
    const float* X1 = p.out;
    bf16_t* HM = (bf16_t*)(p.ws + OFF_SLOT + 2 * SLOT);
    unsigned* gcnt = (unsigned*)(p.ws + OFF_CTL);
    int* LIST = (int*)(p.ws + OFF_LIST); float* WLs = (float*)(p.ws + OFF_WL); int* ROUTE = (int*)(p.ws + OFF_ROUTE);
    for (int tile = bid; tile < NT / 128; tile += nb) {
        if (tid < 16) lcnt[tid] = 0;
        __syncthreads();
        for (int tt = 0; tt < 16; ++tt) {
            const int tl = wave * 16 + tt, tok = tile * 128 + tl;
            const float* mrow = MOD + (tok / SEQ) * 6144;
            f32x4 v[4]; float ss = 0.f;
#pragma unroll
            for (int j = 0; j < 4; ++j) { v[j] = *(const f32x4*)(X1 + (size_t)tok * DM + lane * 4 + 256 * j); ss += v[j][0] * v[j][0] + v[j][1] * v[j][1] + v[j][2] * v[j][2] + v[j][3] * v[j][3]; }
            const float rinv = rsqrtf(wave_sum(ss) * (1.0f / DM) + 1e-6f);
            float lg[20];
#pragma unroll
            for (int o = 0; o < 20; ++o) lg[o] = 0.f;
#pragma unroll
            for (int j = 0; j < 4; ++j) { const int c = lane * 4 + 256 * j;
                const f32x4 g = *(const f32x4*)(p.in[I_GFFN] + c), sh = *(const f32x4*)(mrow + 3 * 1024 + c), sc = *(const f32x4*)(mrow + 4 * 1024 + c);
                f32x4 hm;
#pragma unroll
                for (int e = 0; e < 4; ++e) { hm[e] = v[j][e] * rinv * g[e] * (1.0f + sc[e]) + sh[e];
#pragma unroll
                    for (int o = 0; o < 20; ++o) lg[o] += hm[e] * Wl[(c + e) * 20 + o]; }
                *(u32x2*)(HM + (size_t)tok * DM + c) = pk4(hm); }
#pragma unroll
            for (int o = 0; o < 20; ++o) lg[o] = wave_sum(lg[o]);
#pragma unroll
            for (int o = 0; o < 4; ++o) lg[o] += p.in[I_BGRP][o];
#pragma unroll
            for (int o = 0; o < 16; ++o) lg[4 + o] += p.in[I_BER][o];
            int gs = 0; float gm = lg[0];
#pragma unroll
            for (int o = 1; o < 4; ++o) if (lg[o] > gm) { gm = lg[o]; gs = o; }
            float den = 0.f;
#pragma unroll
            for (int o = 0; o < 4; ++o) den += __expf(lg[o] - gm);
            const float pg = 1.0f / den;
            float el[4];
#pragma unroll
            for (int o = 0; o < 4; ++o) el[o] = gs == 0 ? lg[4 + o] : gs == 1 ? lg[8 + o] : gs == 2 ? lg[12 + o] : lg[16 + o];
            int i1 = 0; float v1 = el[0];
#pragma unroll
            for (int o = 1; o < 4; ++o) if (el[o] > v1) { v1 = el[o]; i1 = o; }
            int i2 = -1; float v2 = -3.0e38f;
#pragma unroll
            for (int o = 0; o < 4; ++o) if (o != i1 && el[o] > v2) { v2 = el[o]; i2 = o; }
            const float w1 = 1.0f / (1.0f + __expf(v2 - v1)), w2 = 1.0f - w1;
            if (lane == 0) { const int e1 = gs * 4 + i1, e2 = gs * 4 + i2;
                const int r1 = atomicAdd(&lcnt[e1], 1), r2 = atomicAdd(&lcnt[e2], 1);
                tinfo[tl * 4 + 0] = e1; tinfo[tl * 4 + 1] = r1; tinfo[tl * 4 + 2] = e2; tinfo[tl * 4 + 3] = r2; twt[tl * 2] = pg * w1; twt[tl * 2 + 1] = pg * w2; }
        }
        __syncthreads();
        if (tid < 16) lbase[tid] = (int)__hip_atomic_fetch_add(gcnt + tid, (unsigned)lcnt[tid], __ATOMIC_RELAXED, __HIP_MEMORY_SCOPE_AGENT);
        __syncthreads();
        if (tid < 128) { const int tok = tile * 128 + tid;
            const int e1 = tinfo[tid * 4], e2 = tinfo[tid * 4 + 2], p1 = lbase[e1] + tinfo[tid * 4 + 1], p2 = lbase[e2] + tinfo[tid * 4 + 3];
            LIST[e1 * NT + p1] = tok; LIST[e2 * NT + p2] = tok; WLs[e1 * NT + p1] = twt[tid * 2]; WLs[e2 * NT + p2] = twt[tid * 2 + 1];
            ROUTE[tok * 4 + 0] = e1; ROUTE[tok * 4 + 1] = p1; ROUTE[tok * 4 + 2] = e2; ROUTE[tok * 4 + 3] = p2; }
        __syncthreads();
    }
}

__device__ __forceinline__ void ph10_final(const Params& p, int bid, int nb, const int* meta) {
    const int lane = threadIdx.x & 63, wave = threadIdx.x >> 6;
    const float* MOD = (const float*)(p.ws + OFF_MOD);
    const bf16_t* Y = (const bf16_t*)(p.ws + OFF_SLOT);
    const int* ROUTE = (const int*)(p.ws + OFF_ROUTE);
    float* X1 = p.out;
    for (int r = bid * 8 + wave; r < NT; r += nb * 8) {
        const int e1 = ROUTE[r * 4], p1 = ROUTE[r * 4 + 1], e2 = ROUTE[r * 4 + 2], p2 = ROUTE[r * 4 + 3];
        const bf16_t* y1 = Y + ((size_t)meta[16 + e1] * 256 + p1) * 1024; const bf16_t* y2 = Y + ((size_t)meta[16 + e2] * 256 + p2) * 1024;
        const float* gt = MOD + (r / SEQ) * 6144 + 5 * 1024;
        f32x4 v[4]; float ss = 0.f;
#pragma unroll
        for (int j = 0; j < 4; ++j) { const int c = lane * 4 + 256 * j;
            v[j] = *(const f32x4*)(X1 + (size_t)r * DM + c);
            const u32x2 a = *(const u32x2*)(y1 + c), bq = *(const u32x2*)(y2 + c); const f32x4 g = *(const f32x4*)(gt + c);
            v[j][0] += g[0] * (bflo(a.x) + bflo(bq.x)); v[j][1] += g[1] * (bfhi(a.x) + bfhi(bq.x)); v[j][2] += g[2] * (bflo(a.y) + bflo(bq.y)); v[j][3] += g[3] * (bfhi(a.y) + bfhi(bq.y));
            ss += v[j][0] * v[j][0] + v[j][1] * v[j][1] + v[j][2] * v[j][2] + v[j][3] * v[j][3]; }
        const float rinv = rsqrtf(wave_sum(ss) * (1.0f / DM) + 1e-6f);
#pragma unroll
        for (int j = 0; j < 4; ++j) { const int c = lane * 4 + 256 * j; const f32x4 g = *(const f32x4*)(p.in[I_GFINAL] + c);
            *(f32x4*)(X1 + (size_t)r * DM + c) = v[j] * rinv * g; }
    }
}

__global__ void __launch_bounds__(NTHR) mega(Params p, int lo, int hi) {
    extern __shared__ __attribute__((aligned(16))) unsigned char lds[];
    cg::grid_group grid = cg::this_grid();
    const int bid = blockIdx.x, nb = gridDim.x;
    unsigned char* ws = p.ws;
    bf16_t* S0 = (bf16_t*)(ws + OFF_SLOT), *S1 = (bf16_t*)(ws + OFF_SLOT + SLOT), *S2 = (bf16_t*)(ws + OFF_SLOT + 2 * SLOT), *S3 = (bf16_t*)(ws + OFF_SLOT + 3 * SLOT),
           *S4 = (bf16_t*)(ws + OFF_SLOT + 4 * SLOT), *S5 = (bf16_t*)(ws + OFF_SLOT + 5 * SLOT);
    const float* MOD = (const float*)(ws + OFF_MOD); const float* BINP = (const float*)(ws + OFF_BINP);
    int* meta = (int*)(lds + LDS_BYTES - 256);
#ifndef PHMASK
#define PHMASK 0x7ff
#endif
#define IN(k) (((PHMASK >> (k)) & 1) && lo <= (k) && (k) < hi)
#define SEAM(k) do { if (IN(k) && IN((k) + 1)) grid.sync(); } while (0)
    if (IN(0)) { ph0_prep(p, bid, nb, lds); } SEAM(0);
    if (IN(1)) { ph1_norm(p, bid, nb); } SEAM(1);
    if (IN(2)) {
        { SchCtx s{(const bf16_t*)(ws + OFF_HC), (const bf16_t*)(ws + OFF_WIN), nb, bid, 1024}; EpiCtx e{(bf16_t*)(ws + OFF_XRC), BINP}; gemm_phase_simple(s, e); }
        { SchG1 s{S0, (const bf16_t*)(ws + OFF_WIN), nb, bid, 1024}; EpiG1 e{S1, S2, S3, S4, S5, BINP}; gemm_phase_simple(s, e); }
    } SEAM(2);
    if (IN(3)) {
        for (int g = bid; g < 512; g += nb) aprep_item(p, g, lds);
        for (int it = bid; it < 1024 + 32; it += nb) { if (it < 1024) b_item<false>(p, it >> 8, (it >> 3) & 31, it & 7, lds); else b_item<false>(p, (it - 1024) >> 3, -1, it & 7, lds); }
    } SEAM(3);
    if (IN(4)) {
        for (int it = bid; it < 1024; it += nb) b_item<true>(p, it >> 8, (it >> 3) & 31, it & 7, lds);
    } SEAM(4);
    if (IN(5)) { SchG2 s{S0, S1, (const bf16_t*)(ws + OFF_WPA), (const bf16_t*)(ws + OFF_WPB), nb, bid, 1024}; EpiG2 e{S4, S5, S3}; gemm_phase_simple(s, e); } SEAM(5);
    if (IN(6)) { SchG3 s{S3, (const bf16_t*)(ws + OFF_WO), nb, bid, 1024}; EpiG3 e{p.in[I_X], MOD, p.out}; gemm_phase_simple(s, e); } SEAM(6);
    if (IN(7)) { ph8_route(p, bid, nb, lds); } SEAM(7);
    if (IN(8)) { __syncthreads(); moe_meta_build(p, meta); MoeMeta mm{meta};
        SchUp s{S2, (const bf16_t*)(ws + OFF_WGU), (const int*)(ws + OFF_LIST), mm, nb, bid, 1024}; EpiUp e{S4, (const float*)(ws + OFF_WL), mm}; gemm_phase_simple(s, e); } SEAM(8);
    if (IN(9)) { __syncthreads(); moe_meta_build(p, meta); MoeMeta mm{meta};
        SchDn s{S4, (const bf16_t*)(ws + OFF_WDN), mm, nb, bid, 512}; EpiDn e{S0, mm}; gemm_phase_simple(s, e); } SEAM(9);
    if (IN(10)) { __syncthreads(); moe_meta_build(p, meta); ph10_final(p, bid, nb, meta); }
#undef IN
#undef SEAM
}

extern "C" void kernel_launch(void* const* d_in, const int* in_sizes, int n_in, void* d_out, int out_size, void* d_ws, size_t ws_size, hipStream_t stream) {
    static int grid = 0;
    if (grid == 0) {
        if (n_in != 37 || out_size != NT * DM || ws_size < WS_END) { fprintf(stderr, "kernel_launch: unexpected shapes: n_in %d out %d ws %zu (need %zu)\n", n_in, out_size, ws_size, (size_t)WS_END); grid = -1; return; }
        int dev = 0, cus = 0, per_cu = 0;
        hipGetDevice(&dev); hipDeviceGetAttribute(&cus, hipDeviceAttributeMultiprocessorCount, dev);
        if (hipFuncSetAttribute((const void*)mega, hipFuncAttributeMaxDynamicSharedMemorySize, LDS_BYTES) != hipSuccess) { fprintf(stderr, "kernel_launch: hipFuncSetAttribute failed\n"); grid = -1; return; }
        if (hipOccupancyMaxActiveBlocksPerMultiprocessor(&per_cu, (const void*)mega, NTHR, LDS_BYTES) != hipSuccess || per_cu < 1) { fprintf(stderr, "kernel_launch: occupancy query says %d\n", per_cu); per_cu = 1; }
        (void)hipGetLastError();
        grid = cus * 1;
        fprintf(stderr, "kernel_launch: grid %d (cus %d, per_cu %d)\n", grid, cus, per_cu);
    }
    if (grid < 0) return;
    Params p{};
    for (int i = 0; i < 37; ++i) p.in[i] = (const float*)d_in[i];
    p.out = (float*)d_out; p.ws = (unsigned char*)d_ws;
#if ONE_LAUNCH
    int lo = 0, hi = NPHASE; void* args[] = {&p, &lo, &hi};
    hipError_t e = hipLaunchCooperativeKernel((const void*)mega, dim3(grid), dim3(NTHR), args, LDS_BYTES, stream);
    if (e != hipSuccess) fprintf(stderr, "cooperative launch failed: %s (grid %d)\n", hipGetErrorString(e), grid);
#else
    for (int k = 0; k < NPHASE; ++k) hipLaunchKernelGGL(mega, dim3(grid), dim3(NTHR), LDS_BYTES, stream, p, k, k + 1);
#endif
}
```

```cpp
#include <hip/hip_runtime.h>
#include <hip/hip_cooperative_groups.h>
#include <cstdio>
#include <cstdint>
namespace cg = cooperative_groups;

#ifndef ONE_LAUNCH
#define ONE_LAUNCH 1
#endif

typedef unsigned short bf16_t;
typedef short bf16x8 __attribute__((ext_vector_type(8)));
typedef float f32x4 __attribute__((ext_vector_type(4)));
typedef float f32x2 __attribute__((ext_vector_type(2)));
typedef unsigned u32x4 __attribute__((ext_vector_type(4)));
typedef unsigned u32x2 __attribute__((ext_vector_type(2)));

constexpr int NT = 32768, NCX = 1024, DM = 1024, SEQ = 8192, CTXL = 256;
constexpr int NTHR = 512;
constexpr int NCH64 = 132;
constexpr size_t MiB = (size_t)1 << 20;
constexpr size_t OFF_CTL = 0, OFF_MOD = 1 * MiB, OFF_BINP = OFF_MOD + 128 * 1024, OFF_WIN = 2 * MiB, OFF_WPA = 14 * MiB, OFF_WPB = 16 * MiB,
                 OFF_WO = 18 * MiB, OFF_WG = 20 * MiB, OFF_WGU = 22 * MiB, OFF_WDN = 54 * MiB, OFF_HC = 70 * MiB, OFF_XRC = 72 * MiB,
                 OFF_TOT = 74 * MiB, OFF_ROUTE = 84 * MiB, OFF_LIST = 85 * MiB, OFF_WL = 87 * MiB, OFF_SLOT = 90 * MiB, SLOT = 64 * MiB,
                 WS_END = OFF_SLOT + 6 * SLOT;
constexpr int LDS_BYTES = 144 * 1024;
constexpr int NPHASE = 11;

struct Params { const float* in[37]; float* out; unsigned char* ws; };

enum { I_X = 0, I_C, I_CTX, I_CCTX, I_WADA, I_BADA, I_GMIX, I_WIN, I_BIN, I_CONVW, I_CONVB, I_LNG, I_LNB, I_WPA, I_LCW, I_LCB,
       I_WRF, I_BRF, I_WIF, I_BIF, I_LAMF, I_WRB, I_BRB, I_WIB, I_BIB, I_LAMB, I_WPB, I_WO, I_GFFN, I_WGRP, I_BGRP, I_WER, I_BER,
       I_WGATE, I_WUP, I_WDOWN, I_GFINAL };

__device__ __forceinline__ float bflo(unsigned w) { return __uint_as_float(w << 16); }
__device__ __forceinline__ float bfhi(unsigned w) { return __uint_as_float(w & 0xffff0000u); }
__device__ __forceinline__ float bf2f(bf16_t h) { return __uint_as_float(((unsigned)h) << 16); }
__device__ __forceinline__ unsigned pk2(float lo, float hi) { unsigned r; asm("v_cvt_pk_bf16_f32 %0, %1, %2" : "=v"(r) : "v"(lo), "v"(hi)); return r; }
__device__ __forceinline__ bf16_t f2bf(float f) { return (bf16_t)(pk2(f, 0.f) & 0xffffu); }
__device__ __forceinline__ float sigm(float x) { return __builtin_amdgcn_rcpf(1.0f + __expf(-x)); }
__device__ __forceinline__ float silu(float x) { return x * sigm(x); }
__device__ __forceinline__ float gelu_tanh(float x) { return x * sigm(1.5957691216057308f * (x + 0.044715f * x * x * x)); }
__device__ __forceinline__ float wave_sum(float v) {
#pragma unroll
    for (int o = 1; o < 64; o <<= 1) v += __shfl_xor(v, o);
    return v;
}
__device__ __forceinline__ void wave_lds_sync() { asm volatile("s_waitcnt lgkmcnt(0)" ::: "memory"); __builtin_amdgcn_wave_barrier(); }
__device__ __forceinline__ u32x2 pk4(f32x4 v) { u32x2 r; r.x = pk2(v[0], v[1]); r.y = pk2(v[2], v[3]); return r; }

template <class DRow>
__device__ __forceinline__ void tr_item(const float* __restrict__ src, int ldsrc, int k0, int n0, bf16_t* dst, int ldd, DRow drow, float* scr, int lane) {
#pragma unroll 8
    for (int i = 0; i < 32; ++i) { const int kk = 2 * i + (lane >> 5); scr[kk * 33 + (lane & 31)] = src[(size_t)(k0 + kk) * ldsrc + n0 + (lane & 31)]; }
    wave_lds_sync();
    const int c = lane & 7;
#pragma unroll
    for (int j = 0; j < 4; ++j) {
        const int n = (lane >> 3) + 8 * j; const float* s = scr + (8 * c) * 33 + n;
        u32x4 o; o.x = pk2(s[0], s[33]); o.y = pk2(s[66], s[99]); o.z = pk2(s[132], s[165]); o.w = pk2(s[198], s[231]);
        *(u32x4*)(dst + (size_t)drow(n0 + n) * ldd + k0 + 8 * c) = o;
    }
    wave_lds_sync();
}

__device__ __forceinline__ int win_srccol(int np) { const int p = np >> 8, r = np & 255; return p < 8 ? (r >> 7) * 1024 + 128 * p + (r & 127) : np; }

__device__ __forceinline__ void ph0_prep(const Params& p, int bid, int nb, unsigned char* lds) {
    const int tid = threadIdx.x, lane = tid & 63, wave = tid >> 6;
    unsigned char* ws = p.ws;
    float* scr = (float*)lds + wave * (64 * 33);
    const int gw = bid * 8 + wave, NGW = nb * 8;
    constexpr int N_WIN = 16 * 192, N_SQ = 16 * 32, N_G = 256, N_GU = 4096, N_DN = 4096;
    constexpr int NITEMS = N_WIN + 3 * N_SQ + N_G + 2 * N_GU + N_DN;
    for (int it = gw; it < NITEMS; it += NGW) {
        int r = it;
        if (r < N_WIN) { const int kb = r / 192, nbk = r % 192, d0 = 32 * nbk, sc0 = win_srccol(d0);
            tr_item(p.in[I_WIN], 6144, 64 * kb, sc0, (bf16_t*)(ws + OFF_WIN), 1024, [=](int n) { return n - sc0 + d0; }, scr, lane); continue; }
        r -= N_WIN;
        if (r < 3 * N_SQ) { const int which = r / N_SQ, q = r % N_SQ, kb = q / 32, nbk = q % 32;
            const float* src = which == 0 ? p.in[I_WPA] : which == 1 ? p.in[I_WPB] : p.in[I_WO];
            bf16_t* dst = (bf16_t*)(ws + (which == 0 ? OFF_WPA : which == 1 ? OFF_WPB : OFF_WO));
            tr_item(src, 1024, 64 * kb, 32 * nbk, dst, 1024, [=](int n) { return n; }, scr, lane); continue; }
        r -= 3 * N_SQ;
        if (r < N_G) { const int ty = r / 64, q = r % 64, h = q / 8, kb = (q % 8) / 4, nbk = q % 4;
            const float* src = (ty == 0 ? p.in[I_WRF] : ty == 1 ? p.in[I_WIF] : ty == 2 ? p.in[I_WRB] : p.in[I_WIB]) + (size_t)h * 128 * 128;
            tr_item(src, 128, 64 * kb, 32 * nbk, (bf16_t*)(ws + OFF_WG), 128, [=](int n) { return h * 512 + (n >> 4) * 64 + ty * 16 + (n & 15); }, scr, lane); continue; }
        r -= N_G;
        if (r < 2 * N_GU) { const int bj = r / N_GU, q = r % N_GU, e = q / 256, kb = (q % 256) / 16, nbk = q % 16;
            const float* src = (bj == 0 ? p.in[I_WGATE] : p.in[I_WUP]) + (size_t)e * 1024 * 512;
            tr_item(src, 512, 64 * kb, 32 * nbk, (bf16_t*)(ws + OFF_WGU) + (size_t)e * 1024 * 1024, 1024, [=](int n) { return 256 * (n >> 7) + 128 * bj + (n & 127); }, scr, lane); continue; }
        r -= 2 * N_GU;
        { const int e = r / 256, kb = (r % 256) / 32, nbk = r % 32;
            tr_item(p.in[I_WDOWN] + (size_t)e * 512 * 1024, 1024, 64 * kb, 32 * nbk, (bf16_t*)(ws + OFF_WDN) + (size_t)e * 1024 * 512, 512, [=](int n) { return n; }, scr, lane); }
    }
    __syncthreads();
    float* red = (float*)lds;
    float* MOD = (float*)(ws + OFF_MOD);
    for (int it = bid; it < 96; it += nb) {
        const int col = it * 64 + lane;
        float a[5] = {0.f, 0.f, 0.f, 0.f, 0.f};
        const float* W = p.in[I_WADA];
        for (int k = wave * 128; k < wave * 128 + 128; ++k) {
            const float wv = W[(size_t)k * 6144 + col];
#pragma unroll
            for (int r = 0; r < 5; ++r) { const float cv = r < 4 ? p.in[I_C][r * 1024 + k] : p.in[I_CCTX][k]; a[r] += silu(cv) * wv; }
        }
#pragma unroll
        for (int r = 0; r < 5; ++r) red[(wave * 5 + r) * 64 + lane] = a[r];
        __syncthreads();
        if (tid < 320) { const int r = tid / 64, l = tid % 64; float s = 0.f;
#pragma unroll
            for (int w = 0; w < 8; ++w) s += red[(w * 5 + r) * 64 + l];
            MOD[r * 6144 + it * 64 + l] = s + p.in[I_BADA][it * 64 + l]; }
        __syncthreads();
    }
    float* BINP = (float*)(ws + OFF_BINP);
    for (int i = bid * NTHR + tid; i < 6144; i += nb * NTHR) BINP[i] = p.in[I_BIN][win_srccol(i)];
    if (bid == 0 && tid < 64) ((unsigned*)(ws + OFF_CTL))[tid] = 0u;
}

__device__ __forceinline__ void ph1_norm(const Params& p, int bid, int nb) {
    const int lane = threadIdx.x & 63, wave = threadIdx.x >> 6;
    const float* MOD = (const float*)(p.ws + OFF_MOD);
    for (int r = bid * 8 + wave; r < NT + NCX; r += nb * 8) {
        const bool lat = r < NT;
        const float* src = lat ? p.in[I_X] + (size_t)r * DM : p.in[I_CTX] + (size_t)(r - NT) * DM;
        bf16_t* dst = lat ? (bf16_t*)(p.ws + OFF_SLOT) + (size_t)r * DM : (bf16_t*)(p.ws + OFF_HC) + (size_t)(r - NT) * DM;
        const float* mrow = MOD + (lat ? r / SEQ : 4) * 6144;
        f32x4 v[4]; float ss = 0.f;
#pragma unroll
        for (int j = 0; j < 4; ++j) { v[j] = *(const f32x4*)(src + lane * 4 + 256 * j); ss += v[j][0] * v[j][0] + v[j][1] * v[j][1] + v[j][2] * v[j][2] + v[j][3] * v[j][3]; }
        const float rinv = rsqrtf(wave_sum(ss) * (1.0f / DM) + 1e-6f);
#pragma unroll
        for (int j = 0; j < 4; ++j) { const int c = lane * 4 + 256 * j;
            const f32x4 g = *(const f32x4*)(p.in[I_GMIX] + c), sh = *(const f32x4*)(mrow + c), sc = *(const f32x4*)(mrow + 1024 + c);
            f32x4 o;
#pragma unroll
            for (int e = 0; e < 4; ++e) o[e] = v[j][e] * rinv * g[e] * (1.0f + sc[e]) + sh[e];
            *(u32x2*)(dst + c) = pk4(o); }
    }
}

struct Unit { int pm, pn, aux, aux2; };

template <class S, class E>
__device__ __forceinline__ void sgemm_unit(const S& s, const Unit& u, const E& e) {
    const int lane = threadIdx.x & 63, w = threadIdx.x >> 6, fr = lane & 15, fq = lane >> 4;
    const int K = s.K;
    const bf16_t* b0 = s.brow(u, 16 * w + fr) + 8 * fq;
    const bf16_t* b1 = s.brow(u, 128 + 16 * w + fr) + 8 * fq;
    for (int sub = 0; sub < 4; ++sub) {
        f32x4 acc[4][2];
        const bf16_t* a[4];
#pragma unroll
        for (int m = 0; m < 4; ++m) { acc[m][0] = (f32x4){0.f, 0.f, 0.f, 0.f}; acc[m][1] = (f32x4){0.f, 0.f, 0.f, 0.f}; a[m] = s.arow(u, 64 * sub + 16 * m + fr) + 8 * fq; }
#pragma unroll 2
        for (int k0 = 0; k0 < K; k0 += 32) {
            const bf16x8 fb0 = *(const bf16x8*)(b0 + k0), fb1 = *(const bf16x8*)(b1 + k0);
#pragma unroll
            for (int m = 0; m < 4; ++m) { const bf16x8 fa = *(const bf16x8*)(a[m] + k0);
                acc[m][0] = __builtin_amdgcn_mfma_f32_16x16x32_bf16(fb0, fa, acc[m][0], 0, 0, 0);
                acc[m][1] = __builtin_amdgcn_mfma_f32_16x16x32_bf16(fb1, fa, acc[m][1], 0, 0, 0); }
        }
#pragma unroll
        for (int m = 0; m < 4; ++m) e(u, 64 * sub + 16 * m + fr, 16 * w + 4 * fq, acc[m][0], acc[m][1]);
    }
}
template <class S, class E>
__device__ __forceinline__ void gemm_phase_simple(const S& s, const E& e) { Unit u; for (int i = 0; s.next(i, u); ++i) sgemm_unit(s, u, e); }

struct SchG1 { const bf16_t *A, *Bt; int G, c, K;
    __device__ bool next(int i, Unit& u) const { const int L = i * G + c; if (L >= 128 * 24) return false; u.pm = L / 24; u.pn = L % 24; return true; }
    __device__ const bf16_t* arow(const Unit& u, int r) const { return A + (size_t)(u.pm * 256 + r) * 1024; }
    __device__ const bf16_t* brow(const Unit& u, int n) const { return Bt + (size_t)(u.pn * 256 + n) * 1024; } };
struct EpiG1 { bf16_t *Z, *GYG, *XR, *SGA, *SGB; const float* bias;
    __device__ void operator()(const Unit& u, int r, int j, f32x4 v0, f32x4 v1) const {
        const size_t row = (size_t)u.pm * 256 + r; const int cb = u.pn * 256 + j;
        v0 += *(const f32x4*)(bias + cb); v1 += *(const f32x4*)(bias + cb + 128);
        if (u.pn < 8) { f32x4 z;
#pragma unroll
            for (int e = 0; e < 4; ++e) z[e] = v0[e] * sigm(v1[e]);
            *(u32x2*)(Z + row * 1024 + u.pn * 128 + j) = pk4(z); }
        else { const int kind = u.pn >> 2;
            bf16_t* dst = GYG + (size_t)(kind - 2) * (SLOT / 2);
#pragma unroll
            for (int e = 0; e < 4; ++e) { if (kind == 2) { v0[e] = gelu_tanh(v0[e]); v1[e] = gelu_tanh(v1[e]); } else if (kind >= 4) { v0[e] = sigm(v0[e]); v1[e] = sigm(v1[e]); } }
            bf16_t* o = dst + row * 1024 + (u.pn & 3) * 256 + j;
            *(u32x2*)o = pk4(v0); *(u32x2*)(o + 128) = pk4(v1); }
    } };
struct SchCtx { const bf16_t *A, *Bt; int G, c, K;
    __device__ bool next(int i, Unit& u) const { const int L = i * G + c; if (L >= 16) return false; u.pm = L / 4; u.pn = L % 4; return true; }
    __device__ const bf16_t* arow(const Unit& u, int r) const { return A + (size_t)(u.pm * 256 + r) * 1024; }
    __device__ const bf16_t* brow(const Unit& u, int n) const { return Bt + (size_t)((12 + u.pn) * 256 + n) * 1024; } };
struct EpiCtx { bf16_t* XRC; const float* bias;
    __device__ void operator()(const Unit& u, int r, int j, f32x4 v0, f32x4 v1) const {
        const size_t row = (size_t)u.pm * 256 + r; const int cb = (12 + u.pn) * 256 + j;
        v0 += *(const f32x4*)(bias + cb); v1 += *(const f32x4*)(bias + cb + 128);
        bf16_t* o = XRC + row * 1024 + u.pn * 256 + j; *(u32x2*)o = pk4(v0); *(u32x2*)(o + 128) = pk4(v1); } };
struct SchG2 { const bf16_t *Aa, *Ab, *Wa, *Wb; int G, c, K;
    __device__ bool next(int i, Unit& u) const { const int t = (i >> 1) * G + c; if (t >= 512) return false; u.pm = t >> 2; u.pn = t & 3; u.aux = i & 1; return true; }
    __device__ const bf16_t* arow(const Unit& u, int r) const { return (u.aux ? Ab : Aa) + (size_t)(u.pm * 256 + r) * 1024; }
    __device__ const bf16_t* brow(const Unit& u, int n) const { return (u.aux ? Wb : Wa) + (size_t)(u.pn * 256 + n) * 1024; } };
struct EpiG2 { const bf16_t *SGA, *SGB; bf16_t* M;
    __device__ void operator()(const Unit& u, int r, int j, f32x4 v0, f32x4 v1) const {
        const size_t o = ((size_t)u.pm * 256 + r) * 1024 + u.pn * 256 + j;
        const bf16_t* G = u.aux ? SGB : SGA;
        const u32x2 g0 = *(const u32x2*)(G + o), g1 = *(const u32x2*)(G + o + 128);
        f32x4 r0, r1;
        r0[0] = bflo(g0.x) * v0[0]; r0[1] = bfhi(g0.x) * v0[1]; r0[2] = bflo(g0.y) * v0[2]; r0[3] = bfhi(g0.y) * v0[3];
        r1[0] = bflo(g1.x) * v1[0]; r1[1] = bfhi(g1.x) * v1[1]; r1[2] = bflo(g1.y) * v1[2]; r1[3] = bfhi(g1.y) * v1[3];
        if (u.aux) { const u32x2 t0 = *(const u32x2*)(M + o), t1 = *(const u32x2*)(M + o + 128);
            r0[0] += bflo(t0.x); r0[1] += bfhi(t0.x); r0[2] += bflo(t0.y); r0[3] += bfhi(t0.y);
            r1[0] += bflo(t1.x); r1[1] += bfhi(t1.x); r1[2] += bflo(t1.y); r1[3] += bfhi(t1.y); }
        *(u32x2*)(M + o) = pk4(r0); *(u32x2*)(M + o + 128) = pk4(r1); } };
struct SchG3 { const bf16_t *A, *Bt; int G, c, K;
    __device__ bool next(int i, Unit& u) const { const int L = i * G + c; if (L >= 512) return false; u.pm = L >> 2; u.pn = L & 3; return true; }
    __device__ const bf16_t* arow(const Unit& u, int r) const { return A + (size_t)(u.pm * 256 + r) * 1024; }
    __device__ const bf16_t* brow(const Unit& u, int n) const { return Bt + (size_t)(u.pn * 256 + n) * 1024; } };
struct EpiG3 { const float *X, *MOD; float* X1;
    __device__ void operator()(const Unit& u, int r, int j, f32x4 v0, f32x4 v1) const {
        const int row = u.pm * 256 + r, col = u.pn * 256 + j; const size_t o = (size_t)row * 1024 + col;
        const float* gt = MOD + (row / SEQ) * 6144 + 2 * 1024 + col;
        *(f32x4*)(X1 + o) = *(const f32x4*)(X + o) + *(const f32x4*)gt * v0;
        *(f32x4*)(X1 + o + 128) = *(const f32x4*)(X + o + 128) + *(const f32x4*)(gt + 128) * v1; } };
struct MoeMeta { const int* m;
    __device__ int cnt(int e) const { return m[e]; }
    __device__ int tb(int e) const { return m[16 + e]; }
    __device__ int find(int mt) const { int e = 0;
#pragma unroll
        for (int k = 1; k < 16; ++k) e += (m[16 + k] <= mt) ? 1 : 0;
        return e; } };
__device__ __forceinline__ void moe_meta_build(const Params& p, int* meta) {
    if (threadIdx.x == 0) { const unsigned* cnt = (const unsigned*)(p.ws + OFF_CTL); int t = 0;
        for (int e = 0; e < 16; ++e) { const int c = (int)__hip_atomic_load(cnt + e, __ATOMIC_RELAXED, __HIP_MEMORY_SCOPE_AGENT); meta[e] = c; meta[16 + e] = t; t += (c + 255) >> 8; }
        meta[32] = t; }
    __syncthreads();
}
struct SchUp { const bf16_t *HM, *W; const int* LIST; MoeMeta mm; int G, c, K;
    __device__ bool next(int i, Unit& u) const { const int L = i * G + c; if (L >= 4 * mm.m[32]) return false; const int mt = L >> 2; u.pn = L & 3; u.aux = mm.find(mt); u.aux2 = (mt - mm.tb(u.aux)) * 256; u.pm = mt; return true; }
    __device__ const bf16_t* arow(const Unit& u, int r) const { int pos = u.aux2 + r; const int c = mm.cnt(u.aux); pos = pos < c ? pos : c - 1; return HM + (size_t)LIST[u.aux * NT + pos] * 1024; }
    __device__ const bf16_t* brow(const Unit& u, int n) const { return W + ((size_t)u.aux * 1024 + u.pn * 256 + n) * 1024; } };
struct EpiUp { bf16_t* ACT; const float* WL; MoeMeta mm;
    __device__ void operator()(const Unit& u, int r, int j, f32x4 g, f32x4 up) const {
        const int pos = u.aux2 + r; if (pos >= mm.cnt(u.aux)) return;
        const float wt = WL[u.aux * NT + pos]; f32x4 a;
#pragma unroll
        for (int e = 0; e < 4; ++e) a[e] = silu(g[e]) * up[e] * wt;
        *(u32x2*)(ACT + ((size_t)u.pm * 256 + r) * 512 + u.pn * 128 + j) = pk4(a); } };
struct SchDn { const bf16_t *ACT, *W; MoeMeta mm; int G, c, K;
    __device__ bool next(int i, Unit& u) const { const int L = i * G + c; if (L >= 4 * mm.m[32]) return false; const int mt = L >> 2; u.pn = L & 3; u.aux = mm.find(mt); u.aux2 = (mt - mm.tb(u.aux)) * 256; u.pm = mt; return true; }
    __device__ const bf16_t* arow(const Unit& u, int r) const { return ACT + ((size_t)u.pm * 256 + r) * 512; }
    __device__ const bf16_t* brow(const Unit& u, int n) const { return W + ((size_t)u.aux * 1024 + u.pn * 256 + n) * 512; } };
struct EpiDn { bf16_t* Y; MoeMeta mm;
    __device__ void operator()(const Unit& u, int r, int j, f32x4 v0, f32x4 v1) const {
        if (u.aux2 + r >= mm.cnt(u.aux)) return;
        bf16_t* o = Y + ((size_t)u.pm * 256 + r) * 1024 + u.pn * 256 + j; *(u32x2*)o = pk4(v0); *(u32x2*)(o + 128) = pk4(v1); } };

__device__ __forceinline__ void aprep_item(const Params& p, int g, unsigned char* lds) {
    const int tid = threadIdx.x, lane = tid & 63, wave = tid >> 6;
    const bf16_t* Z = (const bf16_t*)(p.ws + OFF_SLOT + 1 * SLOT);
    bf16_t* AA = (bf16_t*)(p.ws + OFF_SLOT + 0 * SLOT);
    unsigned* zt = (unsigned*)lds;
    { const u32x4* src = (const u32x4*)(Z + (size_t)g * 64 * 1024); u32x4* d = (u32x4*)lds;
#pragma unroll 4
        for (int i = tid; i < 8192; i += NTHR) d[i] = src[i]; }
    __syncthreads();
    {
        float w0[31], w1[31];
        const float* cw = p.in[I_CONVW] + 2 * tid;
#pragma unroll
        for (int k = 0; k < 31; ++k) { const f32x2 t = *(const f32x2*)(cw + k * 1024); w0[k] = t.x; w1[k] = t.y; }
        const f32x2 cb = *(const f32x2*)(p.in[I_CONVB] + 2 * tid);
        float p0[16], p1[16];
#pragma unroll
        for (int o = 0; o < 16; ++o) { p0[o] = 0.f; p1[o] = 0.f; }
#pragma unroll
        for (int tb = 0; tb < 5; ++tb) {
            float c0[16], c1[16];
#pragma unroll
            for (int o = 0; o < 16; ++o) { c0[o] = cb.x; c1[o] = cb.y; }
            if (tb < 4) {
#pragma unroll
                for (int r0 = 0; r0 < 48; r0 += 8) {
                    unsigned vv[8];
#pragma unroll
                    for (int rr = 0; rr < 8; ++rr) { const int row = 16 * tb - 15 + r0 + rr; vv[rr] = (r0 + rr < 46 && row >= 0 && row < 64) ? zt[row * 512 + tid] : 0u; }
#pragma unroll
                    for (int rr = 0; rr < 8; ++rr) { const int r = r0 + rr, row = 16 * tb - 15 + r;
                        if (r < 46 && row >= 0 && row < 64) { const float x0 = bflo(vv[rr]), x1 = bfhi(vv[rr]);
#pragma unroll
                            for (int o = 0; o < 16; ++o) { const int k = r - o; if (k >= 0 && k < 31) { c0[o] += w0[k] * x0; c1[o] += w1[k] * x1; } } } }
                    asm volatile("" ::: "memory");
                }
            }
            if (tb > 0) {
#pragma unroll
                for (int o = 0; o < 16; ++o) zt[(16 * (tb - 1) + o) * 512 + tid] = pk2(p0[o], p1[o]);
            }
#pragma unroll
            for (int o = 0; o < 16; ++o) { p0[o] = c0[o]; p1[o] = c1[o]; }
        }
    }
    __syncthreads();
    for (int rr = 0; rr < 8; ++rr) {
        const int row = wave * 8 + rr;
        const u32x4 a = *(const u32x4*)(lds + row * 2048 + lane * 16), b = *(const u32x4*)(lds + row * 2048 + 1024 + lane * 16);
        float x[16];
        x[0] = bflo(a.x); x[1] = bfhi(a.x); x[2] = bflo(a.y); x[3] = bfhi(a.y); x[4] = bflo(a.z); x[5] = bfhi(a.z); x[6] = bflo(a.w); x[7] = bfhi(a.w);
        x[8] = bflo(b.x); x[9] = bfhi(b.x); x[10] = bflo(b.y); x[11] = bfhi(b.y); x[12] = bflo(b.z); x[13] = bfhi(b.z); x[14] = bflo(b.w); x[15] = bfhi(b.w);
        float s = 0.f;
#pragma unroll
        for (int e = 0; e < 16; ++e) s += x[e];
        const float mean = wave_sum(s) * (1.0f / 1024.0f);
        float q = 0.f;
#pragma unroll
        for (int e = 0; e < 16; ++e) { x[e] -= mean; q += x[e] * x[e]; }
        const float rstd = rsqrtf(wave_sum(q) * (1.0f / 1024.0f) + 1e-6f);
        float y[16];
#pragma unroll
        for (int hh = 0; hh < 2; ++hh) { const int c0 = hh * 512 + lane * 8;
            const f32x4 g0 = *(const f32x4*)(p.in[I_LNG] + c0), g1 = *(const f32x4*)(p.in[I_LNG] + c0 + 4), b0 = *(const f32x4*)(p.in[I_LNB] + c0), b1 = *(const f32x4*)(p.in[I_LNB] + c0 + 4);
#pragma unroll
            for (int e = 0; e < 4; ++e) { y[hh * 8 + e] = silu(x[hh * 8 + e] * rstd * g0[e] + b0[e]); y[hh * 8 + 4 + e] = silu(x[hh * 8 + 4 + e] * rstd * g1[e] + b1[e]); } }
        bf16_t* o = AA + ((size_t)g * 64 + row) * 1024 + lane * 8;
        u32x4 o0, o1; o0.x = pk2(y[0], y[1]); o0.y = pk2(y[2], y[3]); o0.z = pk2(y[4], y[5]); o0.w = pk2(y[6], y[7]);
        o1.x = pk2(y[8], y[9]); o1.y = pk2(y[10], y[11]); o1.z = pk2(y[12], y[13]); o1.w = pk2(y[14], y[15]);
        *(u32x4*)o = o0; *(u32x4*)(o + 512) = o1;
    }
    __syncthreads();
}

constexpr int XC_STRIDE = 272;
template <bool FINAL>
__device__ __forceinline__ void b_item(const Params& p, int b, int c256, int h, unsigned char* lds) {
    const int tid = threadIdx.x, lane = tid & 63, wave = tid >> 6, fr = lane & 15, q = lane >> 4;
    const bool isctx = c256 < 0;
    const int seqlen = isctx ? CTXL : SEQ, sbase = isctx ? 0 : c256 * 256;
    const bf16_t* src = isctx ? (const bf16_t*)(p.ws + OFF_XRC) + (size_t)b * CTXL * 1024 : (const bf16_t*)(p.ws + OFF_SLOT + 3 * SLOT) + (size_t)b * SEQ * 1024;
    const int kc0 = isctx ? 0 : 4 + c256 * 4;
    f32x2* TOT = (f32x2*)(p.ws + OFF_TOT);
    const bf16_t* WG = (const bf16_t*)(p.ws + OFF_WG);
    float* hin = (float*)(lds + 64 * XC_STRIDE);
    const int chl = 16 * wave + fr, ch = h * 128 + chl;
    const float brf = p.in[I_BRF][ch], bif = p.in[I_BIF][ch], brb = p.in[I_BRB][ch], bib = p.in[I_BIB][ch];
    const float nspf = -8.0f * log1pf(__expf(-p.in[I_LAMF][ch])), nspb = -8.0f * log1pf(__expf(-p.in[I_LAMB][ch]));
    if (FINAL) {
        if (tid < 256) { const int dir = tid >> 7, cl = tid & 127, cg_ = h * 128 + cl; float hc = 0.f;
            const f32x2* T = TOT + ((size_t)b * NCH64 * 2 + dir) * 1024 + cg_;
            if (dir == 0) {
                for (int k = 0; k < kc0; ++k) { const f32x2 t = T[(size_t)k * 2048]; hc = t.x * hc + t.y; }
                for (int s = 0; s < 4; ++s) { hin[(s * 2 + 0) * 128 + cl] = hc; const f32x2 t = T[(size_t)(kc0 + s) * 2048]; hc = t.x * hc + t.y; }
            } else {
                for (int k = 3; k >= 0; --k) { const f32x2 t = T[(size_t)k * 2048]; hc = t.x * hc + t.y; }
                for (int k = NCH64 - 1; k >= kc0 + 4; --k) { const f32x2 t = T[(size_t)k * 2048]; hc = t.x * hc + t.y; }
                for (int s = 3; s >= 0; --s) { hin[(s * 2 + 1) * 128 + cl] = hc; const f32x2 t = T[(size_t)(kc0 + s) * 2048]; hc = t.x * hc + t.y; }
            }
        }
        __syncthreads();
    }
    for (int sub = 0; sub < 4; ++sub) {
        const int t0 = sbase + 64 * sub;
        {
            const int tt = tid >> 3, cgp = tid & 7, c0 = h * 128 + 16 * cgp;
            float xc[16];
            { const f32x4* bp = (const f32x4*)(p.in[I_LCB] + c0);
#pragma unroll
                for (int e4 = 0; e4 < 4; ++e4) { const f32x4 t = bp[e4]; xc[4 * e4] = t[0]; xc[4 * e4 + 1] = t[1]; xc[4 * e4 + 2] = t[2]; xc[4 * e4 + 3] = t[3]; } }
#pragma unroll
            for (int k = 0; k < 4; ++k) {
                const int row = t0 + tt + k - 2;
                if (row >= 0 && row < seqlen) {
                    const u32x4 a = *(const u32x4*)(src + (size_t)row * 1024 + c0), bb = *(const u32x4*)(src + (size_t)row * 1024 + c0 + 8);
                    const f32x4* wp = (const f32x4*)(p.in[I_LCW] + k * 1024 + c0);
                    const f32x4 w0 = wp[0], w1 = wp[1], w2 = wp[2], w3 = wp[3];
                    xc[0] += w0[0] * bflo(a.x); xc[1] += w0[1] * bfhi(a.x); xc[2] += w0[2] * bflo(a.y); xc[3] += w0[3] * bfhi(a.y);
                    xc[4] += w1[0] * bflo(a.z); xc[5] += w1[1] * bfhi(a.z); xc[6] += w1[2] * bflo(a.w); xc[7] += w1[3] * bfhi(a.w);
                    xc[8] += w2[0] * bflo(bb.x); xc[9] += w2[1] * bfhi(bb.x); xc[10] += w2[2] * bflo(bb.y); xc[11] += w2[3] * bfhi(bb.y);
                    xc[12] += w3[0] * bflo(bb.z); xc[13] += w3[1] * bfhi(bb.z); xc[14] += w3[2] * bflo(bb.w); xc[15] += w3[3] * bfhi(bb.w);
                }
            }
            u32x4 o0, o1; o0.x = pk2(xc[0], xc[1]); o0.y = pk2(xc[2], xc[3]); o0.z = pk2(xc[4], xc[5]); o0.w = pk2(xc[6], xc[7]);
            o1.x = pk2(xc[8], xc[9]); o1.y = pk2(xc[10], xc[11]); o1.z = pk2(xc[12], xc[13]); o1.w = pk2(xc[14], xc[15]);
            *(u32x4*)(lds + tt * XC_STRIDE + cgp * 32) = o0; *(u32x4*)(lds + tt * XC_STRIDE + cgp * 32 + 16) = o1;
        }
        __syncthreads();
        f32x4 acc[4][4];
#pragma unroll
        for (int m = 0; m < 4; ++m)
#pragma unroll
            for (int ty = 0; ty < 4; ++ty) acc[m][ty] = (f32x4){0.f, 0.f, 0.f, 0.f};
#pragma unroll
        for (int kk = 0; kk < 4; ++kk) {
            bf16x8 fa[4];
#pragma unroll
            for (int m = 0; m < 4; ++m) fa[m] = *(const bf16x8*)(lds + (16 * m + fr) * XC_STRIDE + (32 * kk + 8 * q) * 2);
#pragma unroll
            for (int ty = 0; ty < 4; ++ty) {
                const bf16x8 fb = *(const bf16x8*)(WG + (size_t)(h * 512 + wave * 64 + ty * 16 + fr) * 128 + 32 * kk + 8 * q);
#pragma unroll
                for (int m = 0; m < 4; ++m) acc[m][ty] = __builtin_amdgcn_mfma_f32_16x16x32_bf16(fa[m], fb, acc[m][ty], 0, 0, 0);
            }
        }
#pragma unroll
        for (int m = 0; m < 4; ++m)
#pragma unroll
            for (int i = 0; i < 4; ++i) {
                const float xcv = bf2f(*(const bf16_t*)(lds + (16 * m + 4 * q + i) * XC_STRIDE + chl * 2));
                const float laf = nspf * sigm(acc[m][0][i] + brf), lab = nspb * sigm(acc[m][2][i] + brb);
                const float gif = sigm(acc[m][1][i] + bif), gib = sigm(acc[m][3][i] + bib);
                acc[m][0][i] = __expf(laf); acc[m][1][i] = sqrtf(-expm1f(2.0f * laf)) * (gif * xcv);
                acc[m][2][i] = __expf(lab); acc[m][3][i] = sqrtf(-expm1f(2.0f * lab)) * (gib * xcv);
            }
        float At[4], Bt[4], Ae[4], Be[4];
#pragma unroll
        for (int m = 0; m < 4; ++m) {
            float A = 1.f, B = 0.f;
#pragma unroll
            for (int i = 0; i < 4; ++i) { B = acc[m][0][i] * B + acc[m][1][i]; A = acc[m][0][i] * A; }
            float tA = __shfl_up(A, 16), tB = __shfl_up(B, 16); if (q >= 1) { B = A * tB + B; A = A * tA; }
            tA = __shfl_up(A, 32); tB = __shfl_up(B, 32); if (q >= 2) { B = A * tB + B; A = A * tA; }
            Ae[m] = __shfl_up(A, 16); Be[m] = __shfl_up(B, 16); if (q == 0) { Ae[m] = 1.f; Be[m] = 0.f; }
            At[m] = __shfl(A, 48 + fr); Bt[m] = __shfl(B, 48 + fr);
        }
        if (!FINAL) {
            float A = 1.f, B = 0.f;
#pragma unroll
            for (int m = 0; m < 4; ++m) { B = At[m] * B + Bt[m]; A = At[m] * A; }
            if (q == 0) TOT[((size_t)(b * NCH64 + kc0 + sub) * 2 + 0) * 1024 + ch] = (f32x2){A, B};
        } else {
            float hh = hin[(sub * 2 + 0) * 128 + chl];
#pragma unroll
            for (int m = 0; m < 4; ++m) {
                float hs = Ae[m] * hh + Be[m];
#pragma unroll
                for (int i = 0; i < 4; ++i) { hs = acc[m][0][i] * hs + acc[m][1][i]; acc[m][0][i] = hs; }
                hh = At[m] * hh + Bt[m];
            }
        }
#pragma unroll
        for (int m = 0; m < 4; ++m) {
            float A = 1.f, B = 0.f;
#pragma unroll
            for (int i = 3; i >= 0; --i) { B = acc[m][2][i] * B + acc[m][3][i]; A = acc[m][2][i] * A; }
            float tA = __shfl_down(A, 16), tB = __shfl_down(B, 16); if (q <= 2) { B = A * tB + B; A = A * tA; }
            tA = __shfl_down(A, 32); tB = __shfl_down(B, 32); if (q <= 1) { B = A * tB + B; A = A * tA; }
            Ae[m] = __shfl_down(A, 16); Be[m] = __shfl_down(B, 16); if (q == 3) { Ae[m] = 1.f; Be[m] = 0.f; }
            At[m] = __shfl(A, fr); Bt[m] = __shfl(B, fr);
        }
        if (!FINAL) {
            float A = 1.f, B = 0.f;
#pragma unroll
            for (int m = 3; m >= 0; --m) { B = At[m] * B + Bt[m]; A = At[m] * A; }
            if (q == 0) TOT[((size_t)(b * NCH64 + kc0 + sub) * 2 + 1) * 1024 + ch] = (f32x2){A, B};
        } else {
            float hh = hin[(sub * 2 + 1) * 128 + chl];
#pragma unroll
            for (int m = 3; m >= 0; --m) {
                float hs = Ae[m] * hh + Be[m];
#pragma unroll
                for (int i = 3; i >= 0; --i) { hs = acc[m][2][i] * hs + acc[m][3][i]; acc[m][2][i] = hs; }
                hh = At[m] * hh + Bt[m];
            }
            const bf16_t* GYG = (const bf16_t*)(p.ws + OFF_SLOT + 2 * SLOT);
            bf16_t* AB = (bf16_t*)(p.ws + OFF_SLOT + 1 * SLOT);
#pragma unroll
            for (int m = 0; m < 4; ++m)
#pragma unroll
                for (int i = 0; i < 4; ++i) {
                    const size_t o = ((size_t)b * SEQ + t0 + 16 * m + 4 * q + i) * 1024 + ch;
                    AB[o] = f2bf(bf2f(GYG[o]) * (acc[m][0][i] + acc[m][2][i]));
                }
        }
        __syncthreads();
    }
}

__device__ __forceinline__ void ph8_route(const Params& p, int bid, int nb, unsigned char* lds) {
    const int tid = threadIdx.x, lane = tid & 63, wave = tid >> 6;
    float* Wl = (float*)lds;
    int* lcnt = (int*)(lds + 81920);
    int* lbase = lcnt + 16;
    int* tinfo = lcnt + 32;
    float* twt = (float*)(tinfo + 512);
    for (int i = tid; i < 1024 * 20; i += NTHR) { const int k = i / 20, o = i % 20; Wl[i] = o < 4 ? p.in[I_WGRP][k * 4 + o] : p.in[I_WER][k * 16 + o - 4]; }
    const float* MOD = (const float*)(p.ws + OFF_MOD);
    const float* X1 = p.out;
    bf16_t* HM = (bf16_t*)(p.ws + OFF_SLOT + 2 * SLOT);
    unsigned* gcnt = (unsigned*)(p.ws + OFF_CTL);
    int* LIST = (int*)(p.ws + OFF_LIST); float* WLs = (float*)(p.ws + OFF_WL); int* ROUTE = (int*)(p.ws + OFF_ROUTE);
    for (int tile = bid; tile < NT / 128; tile += nb) {
        if (tid < 16) lcnt[tid] = 0;
        __syncthreads();
        for (int tt = 0; tt < 16; ++tt) {
            const int tl = wave * 16 + tt, tok = tile * 128 + tl;
            const float* mrow = MOD + (tok / SEQ) * 6144;
            f32x4 v[4]; float ss = 0.f;
#pragma unroll
            for (int j = 0; j < 4; ++j) { v[j] = *(const f32x4*)(X1 + (size_t)tok * DM + lane * 4 + 256 * j); ss += v[j][0] * v[j][0] + v[j][1] * v[j][1] + v[j][2] * v[j][2] + v[j][3] * v[j][3]; }
            const float rinv = rsqrtf(wave_sum(ss) * (1.0f / DM) + 1e-6f);
            float lg[20];
#pragma unroll
            for (int o = 0; o < 20; ++o) lg[o] = 0.f;
#pragma unroll
            for (int j = 0; j < 4; ++j) { const int c = lane * 4 + 256 * j;
                const f32x4 g = *(const f32x4*)(p.in[I_GFFN] + c), sh = *(const f32x4*)(mrow + 3 * 1024 + c), sc = *(const f32x4*)(mrow + 4 * 1024 + c);
                f32x4 hm;
#pragma unroll
                for (int e = 0; e < 4; ++e) { hm[e] = v[j][e] * rinv * g[e] * (1.0f + sc[e]) + sh[e];
#pragma unroll
                    for (int o = 0; o < 20; ++o) lg[o] += hm[e] * Wl[(c + e) * 20 + o]; }
                *(u32x2*)(HM + (size_t)tok * DM + c) = pk4(hm); }
#pragma unroll
            for (int o = 0; o < 20; ++o) lg[o] = wave_sum(lg[o]);
#pragma unroll
            for (int o = 0; o < 4; ++o) lg[o] += p.in[I_BGRP][o];
#pragma unroll
            for (int o = 0; o < 16; ++o) lg[4 + o] += p.in[I_BER][o];
            int gs = 0; float gm = lg[0];
#pragma unroll
            for (int o = 1; o < 4; ++o) if (lg[o] > gm) { gm = lg[o]; gs = o; }
            float den = 0.f;
#pragma unroll
            for (int o = 0; o < 4; ++o) den += __expf(lg[o] - gm);
            const float pg = 1.0f / den;
            float el[4];
#pragma unroll
            for (int o = 0; o < 4; ++o) el[o] = gs == 0 ? lg[4 + o] : gs == 1 ? lg[8 + o] : gs == 2 ? lg[12 + o] : lg[16 + o];
            int i1 = 0; float v1 = el[0];
#pragma unroll
            for (int o = 1; o < 4; ++o) if (el[o] > v1) { v1 = el[o]; i1 = o; }
            int i2 = -1; float v2 = -3.0e38f;
#pragma unroll
            for (int o = 0; o < 4; ++o) if (o != i1 && el[o] > v2) { v2 = el[o]; i2 = o; }
            const float w1 = 1.0f / (1.0f + __expf(v2 - v1)), w2 = 1.0f - w1;
            if (lane == 0) { const int e1 = gs * 4 + i1, e2 = gs * 4 + i2;
                const int r1 = atomicAdd(&lcnt[e1], 1), r2 = atomicAdd(&lcnt[e2], 1);
                tinfo[tl * 4 + 0] = e1; tinfo[tl * 4 + 1] = r1; tinfo[tl * 4 + 2] = e2; tinfo[tl * 4 + 3] = r2; twt[tl * 2] = pg * w1; twt[tl * 2 + 1] = pg * w2; }
        }
        __syncthreads();
        if (tid < 16) lbase[tid] = (int)__hip_atomic_fetch_add(gcnt + tid, (unsigned)lcnt[tid], __ATOMIC_RELAXED, __HIP_MEMORY_SCOPE_AGENT);
        __syncthreads();
        if (tid < 128) { const int tok = tile * 128 + tid;
            const int e1 = tinfo[tid * 4], e2 = tinfo[tid * 4 + 2], p1 = lbase[e1] + tinfo[tid * 4 + 1], p2 = lbase[e2] + tinfo[tid * 4 + 3];
            LIST[e1 * NT + p1] = tok; LIST[e2 * NT + p2] = tok; WLs[e1 * NT + p1] = twt[tid * 2]; WLs[e2 * NT + p2] = twt[tid * 2 + 1];
            ROUTE[tok * 4 + 0] = e1; ROUTE[tok * 4 + 1] = p1; ROUTE[tok * 4 + 2] = e2; ROUTE[tok * 4 + 3] = p2; }
        __syncthreads();
    }
}

__device__ __forceinline__ void ph10_final(const Params& p, int bid, int nb, const int* meta) {
    const int lane = threadIdx.x & 63, wave = threadIdx.x >> 6;
    const float* MOD = (const float*)(p.ws + OFF_MOD);
    const bf16_t* Y = (const bf16_t*)(p.ws + OFF_SLOT);
    const int* ROUTE = (const int*)(p.ws + OFF_ROUTE);
    float* X1 = p.out;
    for (int r = bid * 8 + wave; r < NT; r += nb * 8) {
        const int e1 = ROUTE[r * 4], p1 = ROUTE[r * 4 + 1], e2 = ROUTE[r * 4 + 2], p2 = ROUTE[r * 4 + 3];
        const bf16_t* y1 = Y + ((size_t)meta[16 + e1] * 256 + p1) * 1024; const bf16_t* y2 = Y + ((size_t)meta[16 + e2] * 256 + p2) * 1024;
        const float* gt = MOD + (r / SEQ) * 6144 + 5 * 1024;
        f32x4 v[4]; float ss = 0.f;
#pragma unroll
        for (int j = 0; j < 4; ++j) { const int c = lane * 4 + 256 * j;
            v[j] = *(const f32x4*)(X1 + (size_t)r * DM + c);
            const u32x2 a = *(const u32x2*)(y1 + c), bq = *(const u32x2*)(y2 + c); const f32x4 g = *(const f32x4*)(gt + c);
            v[j][0] += g[0] * (bflo(a.x) + bflo(bq.x)); v[j][1] += g[1] * (bfhi(a.x) + bfhi(bq.x)); v[j][2] += g[2] * (bflo(a.y) + bflo(bq.y)); v[j][3] += g[3] * (bfhi(a.y) + bfhi(bq.y));
            ss += v[j][0] * v[j][0] + v[j][1] * v[j][1] + v[j][2] * v[j][2] + v[j][3] * v[j][3]; }
        const float rinv = rsqrtf(wave_sum(ss) * (1.0f / DM) + 1e-6f);
#pragma unroll
        for (int j = 0; j < 4; ++j) { const int c = lane * 4 + 256 * j; const f32x4 g = *(const f32x4*)(p.in[I_GFINAL] + c);
            *(f32x4*)(X1 + (size_t)r * DM + c) = v[j] * rinv * g; }
    }
}

__global__ void __launch_bounds__(NTHR) mega(Params p, int lo, int hi) {
    extern __shared__ __attribute__((aligned(16))) unsigned char lds[];
    cg::grid_group grid = cg::this_grid();
    const int bid = blockIdx.x, nb = gridDim.x;
    unsigned char* ws = p.ws;
    bf16_t* S0 = (bf16_t*)(ws + OFF_SLOT), *S1 = (bf16_t*)(ws + OFF_SLOT + SLOT), *S2 = (bf16_t*)(ws + OFF_SLOT + 2 * SLOT), *S3 = (bf16_t*)(ws + OFF_SLOT + 3 * SLOT),
           *S4 = (bf16_t*)(ws + OFF_SLOT + 4 * SLOT), *S5 = (bf16_t*)(ws + OFF_SLOT + 5 * SLOT);
    const float* MOD = (const float*)(ws + OFF_MOD); const float* BINP = (const float*)(ws + OFF_BINP);
    int* meta = (int*)(lds + LDS_BYTES - 256);
#ifndef PHMASK
#define PHMASK 0x7ff
#endif
#define IN(k) (((PHMASK >> (k)) & 1) && lo <= (k) && (k) < hi)
#define SEAM(k) do { if (IN(k) && IN((k) + 1)) grid.sync(); } while (0)
    if (IN(0)) { ph0_prep(p, bid, nb, lds); } SEAM(0);
    if (IN(1)) { ph1_norm(p, bid, nb); } SEAM(1);
    if (IN(2)) {
        { SchCtx s{(const bf16_t*)(ws + OFF_HC), (const bf16_t*)(ws + OFF_WIN), nb, bid, 1024}; EpiCtx e{(bf16_t*)(ws + OFF_XRC), BINP}; gemm_phase_simple(s, e); }
        { SchG1 s{S0, (const bf16_t*)(ws + OFF_WIN), nb, bid, 1024}; EpiG1 e{S1, S2, S3, S4, S5, BINP}; gemm_phase_simple(s, e); }
    } SEAM(2);
    if (IN(3)) {
        for (int g = bid; g < 512; g += nb) aprep_item(p, g, lds);
        for (int it = bid; it < 1024 + 32; it += nb) { if (it < 1024) b_item<false>(p, it >> 8, (it >> 3) & 31, it & 7, lds); else b_item<false>(p, (it - 1024) >> 3, -1, it & 7, lds); }
    } SEAM(3);
    if (IN(4)) {
        for (int it = bid; it < 1024; it += nb) b_item<true>(p, it >> 8, (it >> 3) & 31, it & 7, lds);
    } SEAM(4);
    if (IN(5)) { SchG2 s{S0, S1, (const bf16_t*)(ws + OFF_WPA), (const bf16_t*)(ws + OFF_WPB), nb, bid, 1024}; EpiG2 e{S4, S5, S3}; gemm_phase_simple(s, e); } SEAM(5);
    if (IN(6)) { SchG3 s{S3, (const bf16_t*)(ws + OFF_WO), nb, bid, 1024}; EpiG3 e{p.in[I_X], MOD, p.out}; gemm_phase_simple(s, e); } SEAM(6);
    if (IN(7)) { ph8_route(p, bid, nb, lds); } SEAM(7);
    if (IN(8)) { __syncthreads(); moe_meta_build(p, meta); MoeMeta mm{meta};
        SchUp s{S2, (const bf16_t*)(ws + OFF_WGU), (const int*)(ws + OFF_LIST), mm, nb, bid, 1024}; EpiUp e{S4, (const float*)(ws + OFF_WL), mm}; gemm_phase_simple(s, e); } SEAM(8);
    if (IN(9)) { __syncthreads(); moe_meta_build(p, meta); MoeMeta mm{meta};
        SchDn s{S4, (const bf16_t*)(ws + OFF_WDN), mm, nb, bid, 512}; EpiDn e{S0, mm}; gemm_phase_simple(s, e); } SEAM(9);
    if (IN(10)) { __syncthreads(); moe_meta_build(p, meta); ph10_final(p, bid, nb, meta); }
#undef IN
#undef SEAM
}

extern "C" void kernel_launch(void* const* d_in, const int* in_sizes, int n_in, void* d_out, int out_size, void* d_ws, size_t ws_size, hipStream_t stream) {
    static int grid = 0;
    if (grid == 0) {
        if (n_in != 37 || out_size != NT * DM || ws_size < WS_END) { fprintf(stderr, "kernel_launch: unexpected shapes: n_in %d out %d ws %zu (need %zu)\n", n_in, out_size, ws_size, (size_t)WS_END); grid = -1; return; }
        int dev = 0, cus = 0, per_cu = 0;
        (void)hipGetDevice(&dev); (void)hipDeviceGetAttribute(&cus, hipDeviceAttributeMultiprocessorCount, dev);
        if (hipFuncSetAttribute((const void*)mega, hipFuncAttributeMaxDynamicSharedMemorySize, LDS_BYTES) != hipSuccess) { fprintf(stderr, "kernel_launch: hipFuncSetAttribute failed\n"); grid = -1; return; }
        if (hipOccupancyMaxActiveBlocksPerMultiprocessor(&per_cu, (const void*)mega, NTHR, LDS_BYTES) != hipSuccess || per_cu < 1) { fprintf(stderr, "kernel_launch: occupancy query says %d\n", per_cu); per_cu = 1; }
        (void)hipGetLastError();
        grid = cus * 1;
        fprintf(stderr, "kernel_launch: grid %d (cus %d, per_cu %d)\n", grid, cus, per_cu);
    }
    if (grid < 0) return;
    Params p{};
    for (int i = 0; i < 37; ++i) p.in[i] = (const float*)d_in[i];
    p.out = (float*)d_out; p.ws = (unsigned char*)d_ws;
#if ONE_LAUNCH
    int lo = 0, hi = NPHASE; void* args[] = {&p, &lo, &hi};
    hipError_t e = hipLaunchCooperativeKernel((const void*)mega, dim3(grid), dim3(NTHR), args, LDS_BYTES, stream);
    if (e != hipSuccess) fprintf(stderr, "cooperative launch failed: %s (grid %d)\n", hipGetErrorString(e), grid);
#else
    for (int k = 0; k < NPHASE; ++k) hipLaunchKernelGGL(mega, dim3(grid), dim3(NTHR), LDS_BYTES, stream, p, k, k + 1);
#endif
}
```

```cpp
#include <hip/hip_runtime.h>
#include <hip/hip_cooperative_groups.h>
#include <cstdio>
#include <cstdint>
namespace cg = cooperative_groups;

#ifndef ONE_LAUNCH
#define ONE_LAUNCH 1
#endif

typedef unsigned short bf16_t;
typedef short bf16x8 __attribute__((ext_vector_type(8)));
typedef float f32x4 __attribute__((ext_vector_type(4)));
typedef float f32x2 __attribute__((ext_vector_type(2)));
typedef unsigned u32x4 __attribute__((ext_vector_type(4)));
typedef unsigned u32x2 __attribute__((ext_vector_type(2)));

constexpr int NT = 32768, NCX = 1024, DM = 1024, SEQ = 8192, CTXL = 256;
constexpr int NTHR = 512;
constexpr int NCH64 = 132;
constexpr size_t MiB = (size_t)1 << 20;
constexpr size_t OFF_CTL = 0, OFF_MOD = 1 * MiB, OFF_BINP = OFF_MOD + 128 * 1024, OFF_WIN = 2 * MiB, OFF_WPA = 14 * MiB, OFF_WPB = 16 * MiB,
                 OFF_WO = 18 * MiB, OFF_WG = 20 * MiB, OFF_WGU = 22 * MiB, OFF_WDN = 54 * MiB, OFF_HC = 70 * MiB, OFF_XRC = 72 * MiB,
                 OFF_TOT = 74 * MiB, OFF_ROUTE = 84 * MiB, OFF_LIST = 85 * MiB, OFF_WL = 87 * MiB, OFF_SLOT = 90 * MiB, SLOT = 64 * MiB,
                 WS_END = OFF_SLOT + 6 * SLOT;
constexpr int LDS_BYTES = 144 * 1024;
constexpr int NPHASE = 11;

struct Params { const float* in[37]; float* out; unsigned char* ws; };

enum { I_X = 0, I_C, I_CTX, I_CCTX, I_WADA, I_BADA, I_GMIX, I_WIN, I_BIN, I_CONVW, I_CONVB, I_LNG, I_LNB, I_WPA, I_LCW, I_LCB,
       I_WRF, I_BRF, I_WIF, I_BIF, I_LAMF, I_WRB, I_BRB, I_WIB, I_BIB, I_LAMB, I_WPB, I_WO, I_GFFN, I_WGRP, I_BGRP, I_WER, I_BER,
       I_WGATE, I_WUP, I_WDOWN, I_GFINAL };

__device__ __forceinline__ float bflo(unsigned w) { return __uint_as_float(w << 16); }
__device__ __forceinline__ float bfhi(unsigned w) { return __uint_as_float(w & 0xffff0000u); }
__device__ __forceinline__ float bf2f(bf16_t h) { return __uint_as_float(((unsigned)h) << 16); }
__device__ __forceinline__ unsigned pk2(float lo, float hi) { unsigned r; asm("v_cvt_pk_bf16_f32 %0, %1, %2" : "=v"(r) : "v"(lo), "v"(hi)); return r; }
__device__ __forceinline__ bf16_t f2bf(float f) { return (bf16_t)(pk2(f, 0.f) & 0xffffu); }
__device__ __forceinline__ float sigm(float x) { return __builtin_amdgcn_rcpf(1.0f + __expf(-x)); }
__device__ __forceinline__ float silu(float x) { return x * sigm(x); }
__device__ __forceinline__ float gelu_tanh(float x) { return x * sigm(1.5957691216057308f * (x + 0.044715f * x * x * x)); }
__device__ __forceinline__ float wave_sum(float v) {
#pragma unroll
    for (int o = 1; o < 64; o <<= 1) v += __shfl_xor(v, o);
    return v;
}
__device__ __forceinline__ void wave_lds_sync() { asm volatile("s_waitcnt lgkmcnt(0)" ::: "memory"); __builtin_amdgcn_wave_barrier(); }
__device__ __forceinline__ u32x2 pk4(f32x4 v) { u32x2 r; r.x = pk2(v[0], v[1]); r.y = pk2(v[2], v[3]); return r; }

template <class DRow>
__device__ __forceinline__ void tr_item(const float* __restrict__ src, int ldsrc, int k0, int n0, bf16_t* dst, int ldd, DRow drow, float* scr, int lane) {
#pragma unroll 8
    for (int i = 0; i < 32; ++i) { const int kk = 2 * i + (lane >> 5); scr[kk * 33 + (lane & 31)] = src[(size_t)(k0 + kk) * ldsrc + n0 + (lane & 31)]; }
    wave_lds_sync();
    const int c = lane & 7;
#pragma unroll
    for (int j = 0; j < 4; ++j) {
        const int n = (lane >> 3) + 8 * j; const float* s = scr + (8 * c) * 33 + n;
        u32x4 o; o.x = pk2(s[0], s[33]); o.y = pk2(s[66], s[99]); o.z = pk2(s[132], s[165]); o.w = pk2(s[198], s[231]);
        *(u32x4*)(dst + (size_t)drow(n0 + n) * ldd + k0 + 8 * c) = o;
    }
    wave_lds_sync();
}

__device__ __forceinline__ int win_srccol(int np) { const int p = np >> 8, r = np & 255; return p < 8 ? (r >> 7) * 1024 + 128 * p + (r & 127) : np; }

__device__ __forceinline__ void ph0_prep(const Params& p, int bid, int nb, unsigned char* lds) {
    const int tid = threadIdx.x, lane = tid & 63, wave = tid >> 6;
    unsigned char* ws = p.ws;
    float* scr = (float*)lds + wave * (64 * 33);
    const int gw = bid * 8 + wave, NGW = nb * 8;
    constexpr int N_WIN = 16 * 192, N_SQ = 16 * 32, N_G = 256, N_GU = 4096, N_DN = 4096;
    constexpr int NITEMS = N_WIN + 3 * N_SQ + N_G + 2 * N_GU + N_DN;
    for (int it = gw; it < NITEMS; it += NGW) {
        int r = it;
        if (r < N_WIN) { const int kb = r / 192, nbk = r % 192, d0 = 32 * nbk, sc0 = win_srccol(d0);
            tr_item(p.in[I_WIN], 6144, 64 * kb, sc0, (bf16_t*)(ws + OFF_WIN), 1024, [=](int n) { return n - sc0 + d0; }, scr, lane); continue; }
        r -= N_WIN;
        if (r < 3 * N_SQ) { const int which = r / N_SQ, q = r % N_SQ, kb = q / 32, nbk = q % 32;
            const float* src = which == 0 ? p.in[I_WPA] : which == 1 ? p.in[I_WPB] : p.in[I_WO];
            bf16_t* dst = (bf16_t*)(ws + (which == 0 ? OFF_WPA : which == 1 ? OFF_WPB : OFF_WO));
            tr_item(src, 1024, 64 * kb, 32 * nbk, dst, 1024, [=](int n) { return n; }, scr, lane); continue; }
        r -= 3 * N_SQ;
        if (r < N_G) { const int ty = r / 64, q = r % 64, h = q / 8, kb = (q % 8) / 4, nbk = q % 4;
            const float* src = (ty == 0 ? p.in[I_WRF] : ty == 1 ? p.in[I_WIF] : ty == 2 ? p.in[I_WRB] : p.in[I_WIB]) + (size_t)h * 128 * 128;
            tr_item(src, 128, 64 * kb, 32 * nbk, (bf16_t*)(ws + OFF_WG), 128, [=](int n) { return h * 512 + (n >> 4) * 64 + ty * 16 + (n & 15); }, scr, lane); continue; }
        r -= N_G;
        if (r < 2 * N_GU) { const int bj = r / N_GU, q = r % N_GU, e = q / 256, kb = (q % 256) / 16, nbk = q % 16;
            const float* src = (bj == 0 ? p.in[I_WGATE] : p.in[I_WUP]) + (size_t)e * 1024 * 512;
            tr_item(src, 512, 64 * kb, 32 * nbk, (bf16_t*)(ws + OFF_WGU) + (size_t)e * 1024 * 1024, 1024, [=](int n) { return 256 * (n >> 7) + 128 * bj + (n & 127); }, scr, lane); continue; }
        r -= 2 * N_GU;
        { const int e = r / 256, kb = (r % 256) / 32, nbk = r % 32;
            tr_item(p.in[I_WDOWN] + (size_t)e * 512 * 1024, 1024, 64 * kb, 32 * nbk, (bf16_t*)(ws + OFF_WDN) + (size_t)e * 1024 * 512, 512, [=](int n) { return n; }, scr, lane); }
    }
    __syncthreads();
    float* red = (float*)lds;
    float* MOD = (float*)(ws + OFF_MOD);
    for (int it = bid; it < 96; it += nb) {
        const int col = it * 64 + lane;
        float a[5] = {0.f, 0.f, 0.f, 0.f, 0.f};
        const float* W = p.in[I_WADA];
        for (int k = wave * 128; k < wave * 128 + 128; ++k) {
            const float wv = W[(size_t)k * 6144 + col];
#pragma unroll
            for (int r = 0; r < 5; ++r) { const float cv = r < 4 ? p.in[I_C][r * 1024 + k] : p.in[I_CCTX][k]; a[r] += silu(cv) * wv; }
        }
#pragma unroll
        for (int r = 0; r < 5; ++r) red[(wave * 5 + r) * 64 + lane] = a[r];
        __syncthreads();
        if (tid < 320) { const int r = tid / 64, l = tid % 64; float s = 0.f;
#pragma unroll
            for (int w = 0; w < 8; ++w) s += red[(w * 5 + r) * 64 + l];
            MOD[r * 6144 + it * 64 + l] = s + p.in[I_BADA][it * 64 + l]; }
        __syncthreads();
    }
    float* BINP = (float*)(ws + OFF_BINP);
    for (int i = bid * NTHR + tid; i < 6144; i += nb * NTHR) BINP[i] = p.in[I_BIN][win_srccol(i)];
    if (bid == 0 && tid < 64) ((unsigned*)(ws + OFF_CTL))[tid] = 0u;
}

__device__ __forceinline__ void ph1_norm(const Params& p, int bid, int nb) {
    const int lane = threadIdx.x & 63, wave = threadIdx.x >> 6;
    const float* MOD = (const float*)(p.ws + OFF_MOD);
    for (int r = bid * 8 + wave; r < NT + NCX; r += nb * 8) {
        const bool lat = r < NT;
        const float* src = lat ? p.in[I_X] + (size_t)r * DM : p.in[I_CTX] + (size_t)(r - NT) * DM;
        bf16_t* dst = lat ? (bf16_t*)(p.ws + OFF_SLOT) + (size_t)r * DM : (bf16_t*)(p.ws + OFF_HC) + (size_t)(r - NT) * DM;
        const float* mrow = MOD + (lat ? r / SEQ : 4) * 6144;
        f32x4 v[4]; float ss = 0.f;
#pragma unroll
        for (int j = 0; j < 4; ++j) { v[j] = *(const f32x4*)(src + lane * 4 + 256 * j); ss += v[j][0] * v[j][0] + v[j][1] * v[j][1] + v[j][2] * v[j][2] + v[j][3] * v[j][3]; }
        const float rinv = rsqrtf(wave_sum(ss) * (1.0f / DM) + 1e-6f);
#pragma unroll
        for (int j = 0; j < 4; ++j) { const int c = lane * 4 + 256 * j;
            const f32x4 g = *(const f32x4*)(p.in[I_GMIX] + c), sh = *(const f32x4*)(mrow + c), sc = *(const f32x4*)(mrow + 1024 + c);
            f32x4 o;
#pragma unroll
            for (int e = 0; e < 4; ++e) o[e] = v[j][e] * rinv * g[e] * (1.0f + sc[e]) + sh[e];
            *(u32x2*)(dst + c) = pk4(o); }
    }
}

struct Unit { int pm, pn, aux, aux2; };

template <class S, class E>
__device__ __forceinline__ void sgemm_unit(const S& s, const Unit& u, const E& e) {
    const int lane = threadIdx.x & 63, w = threadIdx.x >> 6, fr = lane & 15, fq = lane >> 4;
    const int K = s.K;
    const bf16_t* b0 = s.brow(u, 16 * w + fr) + 8 * fq;
    const bf16_t* b1 = s.brow(u, 128 + 16 * w + fr) + 8 * fq;
    for (int sub = 0; sub < 4; ++sub) {
        f32x4 acc[4][2];
        const bf16_t* a[4];
#pragma unroll
        for (int m = 0; m < 4; ++m) { acc[m][0] = (f32x4){0.f, 0.f, 0.f, 0.f}; acc[m][1] = (f32x4){0.f, 0.f, 0.f, 0.f}; a[m] = s.arow(u, 64 * sub + 16 * m + fr) + 8 * fq; }
#pragma unroll 2
        for (int k0 = 0; k0 < K; k0 += 32) {
            const bf16x8 fb0 = *(const bf16x8*)(b0 + k0), fb1 = *(const bf16x8*)(b1 + k0);
#pragma unroll
            for (int m = 0; m < 4; ++m) { const bf16x8 fa = *(const bf16x8*)(a[m] + k0);
                acc[m][0] = __builtin_amdgcn_mfma_f32_16x16x32_bf16(fb0, fa, acc[m][0], 0, 0, 0);
                acc[m][1] = __builtin_amdgcn_mfma_f32_16x16x32_bf16(fb1, fa, acc[m][1], 0, 0, 0); }
        }
#pragma unroll
        for (int m = 0; m < 4; ++m) e(u, 64 * sub + 16 * m + fr, 16 * w + 4 * fq, acc[m][0], acc[m][1]);
    }
}
template <class S, class E>
__device__ __forceinline__ void gemm_phase_simple(const S& s, const E& e) { Unit u; for (int i = 0; s.next(i, u); ++i) sgemm_unit(s, u, e); }


#define LAS __attribute__((address_space(3)))
constexpr int BK = 64, HTB = 128 * BK * 2, STAGE_BYTES = 8 * HTB;
__device__ __forceinline__ int lds_byte(int r, int c) { const int st = (r >> 4) * 2 + (c >> 5), rr = r & 15, cc = c & 31, ob = rr * 64 + cc * 2; return st * 1024 + (ob ^ (((ob >> 9) & 1) << 5)); }
__device__ __forceinline__ void stage_rc(int b, int& R, int& C) { const int st = b / 1024, sb = b % 1024, swz = sb ^ (((sb >> 9) & 1) << 5); R = (st >> 1) * 16 + swz / 64; C = (st & 1) * 32 + (swz % 64) / 2; }

template <bool GATHER, class S, class E>
__device__ __forceinline__ void gemm_phase_pipe(unsigned char* ldsg, const S& sch, const E& epi) {
    LAS unsigned char* lds = (LAS unsigned char*)ldsg;
    const int tid = threadIdx.x, wid = __builtin_amdgcn_readfirstlane(tid >> 6), lane = tid & 63, wr = wid >> 2, wc = wid & 3, fr = lane & 15, fq = lane >> 4;
    const int K = sch.K, nt = K / BK;
    int Rr[2], Cc[2]; unsigned voffA[2], voffB[2];
#pragma unroll
    for (int i = 0; i < 2; ++i) { stage_rc(tid * 16 + i * 8192, Rr[i], Cc[i]); voffA[i] = (unsigned)(Rr[i] * K + Cc[i]) * 2u; voffB[i] = voffA[i]; }
    const size_t kstep = (size_t)(BK * 2);
    const size_t hstep = (size_t)128 * K * 2;
    const unsigned ldsw = (unsigned)wid * 1024u;
    const int aoff = lds_byte(wr * 64 + fr, fq * 8), boff = lds_byte(wc * 32 + fr, fq * 8);
#define PG8_SA(b, h) (((b) * 2 + (h)) * HTB)
#define PG8_SB(b, h) ((4 + (b) * 2 + (h)) * HTB)
#define PG8_STAGE_B(bufoff, gbase) do { _Pragma("unroll") for (int _i = 0; _i < 2; ++_i) \
        __builtin_amdgcn_global_load_lds((const unsigned*)((const char*)(gbase) + voffB[_i]), (LAS unsigned*)(lds + (bufoff) + ldsw + _i * 8192), 16, 0, 0); } while (0)
#define PG8_STAGE_A(bufoff, gbase, h, vo) do { _Pragma("unroll") for (int _i = 0; _i < 2; ++_i) \
        __builtin_amdgcn_global_load_lds((const unsigned*)((const char*)(gbase) + (GATHER ? (size_t)(vo)[h][_i] : (size_t)(h) * hstep + voffA[_i])), (LAS unsigned*)(lds + (bufoff) + ldsw + _i * 8192), 16, 0, 0); } while (0)
#define PG8_LDA(dst, b, h) do { _Pragma("unroll") for (int m = 0; m < 4; ++m) _Pragma("unroll") for (int k = 0; k < 2; ++k) dst[m][k] = *(const LAS bf16x8*)(lds + PG8_SA(b, h) + aoff + m * 2048 + k * 1024); } while (0)
#define PG8_LDB(dst, b, h) do { _Pragma("unroll") for (int n = 0; n < 2; ++n) _Pragma("unroll") for (int k = 0; k < 2; ++k) dst[n][k] = *(const LAS bf16x8*)(lds + PG8_SB(b, h) + boff + n * 2048 + k * 1024); } while (0)
#define PG8_MMA(ai, bj, At, Bt) do { __builtin_amdgcn_s_setprio(1); _Pragma("unroll") for (int m = 0; m < 4; ++m) _Pragma("unroll") for (int n = 0; n < 2; ++n) _Pragma("unroll") for (int k = 0; k < 2; ++k) \
        acc[ai][bj][m][n] = __builtin_amdgcn_mfma_f32_16x16x32_bf16(Bt[n][k], At[m][k], acc[ai][bj][m][n], 0, 0, 0); __builtin_amdgcn_s_setprio(0); } while (0)
#define PG8_WAIT_V(n) asm volatile("s_waitcnt vmcnt(" #n ")" ::: "memory")
#define PG8_WAIT_L(n) asm volatile("s_waitcnt lgkmcnt(" #n ")" ::: "memory")
#define PG8_BAR __builtin_amdgcn_s_barrier()
#define PG8_SCHED __builtin_amdgcn_sched_barrier(0)
    Unit cur, nxt; int ui = 0;
    if (!sch.next(0, cur)) return;
    f32x4 acc[2][2][4][2];
#pragma unroll
    for (int a = 0; a < 2; ++a)
#pragma unroll
        for (int b = 0; b < 2; ++b)
#pragma unroll
            for (int m = 0; m < 4; ++m)
#pragma unroll
                for (int n = 0; n < 2; ++n) acc[a][b][m][n] = (f32x4){0.f, 0.f, 0.f, 0.f};
    bf16x8 At[4][2], B0[2][2], B1[2][2];
    unsigned voAc[2][2], voAn[2][2];
#pragma unroll
    for (int h = 0; h < 2; ++h)
#pragma unroll
        for (int i = 0; i < 2; ++i) { voAc[h][i] = GATHER ? sch.aoff(cur, 128 * h + Rr[i]) + (unsigned)Cc[i] * 2u : 0u; voAn[h][i] = voAc[h][i]; }
    const char* cA = sch.abase(cur); const char* cB = sch.bbase(cur);
    PG8_STAGE_B(PG8_SB(0, 0), cB); PG8_STAGE_A(PG8_SA(0, 0), cA, 0, voAc); PG8_STAGE_B(PG8_SB(0, 1), cB + hstep); PG8_STAGE_A(PG8_SA(0, 1), cA, 1, voAc);
    if (wr == 1) PG8_BAR;
    PG8_WAIT_V(4); PG8_BAR;
    PG8_STAGE_B(PG8_SB(1, 0), cB + kstep); PG8_STAGE_A(PG8_SA(1, 0), cA + kstep, 0, voAc); PG8_STAGE_B(PG8_SB(1, 1), cB + hstep + kstep);
    PG8_WAIT_V(6); PG8_BAR;
    for (;;) {
        const bool has_next = sch.next(ui + 1, nxt);
        const char* nA = has_next ? sch.abase(nxt) : cA; const char* nB = has_next ? sch.bbase(nxt) : cB;
        if (GATHER) {
#pragma unroll
            for (int h = 0; h < 2; ++h)
#pragma unroll
                for (int i = 0; i < 2; ++i) voAn[h][i] = has_next ? sch.aoff(nxt, 128 * h + Rr[i]) + (unsigned)Cc[i] * 2u : voAc[h][i];
        }
        for (int t = 0; t < nt; t += 2) {
            const bool last = (t == nt - 2);
            const char* a1 = cA + (size_t)(t + 1) * kstep;
            const char* a2 = last ? nA : cA + (size_t)(t + 2) * kstep; const char* b2 = last ? nB : cB + (size_t)(t + 2) * kstep;
            const char* a3 = a2 + kstep; const char* b3 = b2 + kstep;
            unsigned vo2[2][2];
#pragma unroll
            for (int h = 0; h < 2; ++h)
#pragma unroll
                for (int i = 0; i < 2; ++i) vo2[h][i] = last ? voAn[h][i] : voAc[h][i];
            PG8_LDB(B0, 0, 0); PG8_SCHED; PG8_LDA(At, 0, 0); PG8_STAGE_A(PG8_SA(1, 1), a1, 1, voAc);
            PG8_WAIT_L(8); PG8_BAR; PG8_WAIT_L(0); PG8_MMA(0, 0, At, B0); PG8_BAR; PG8_SCHED;
            PG8_LDB(B1, 0, 1); PG8_STAGE_B(PG8_SB(0, 0), b2);
            PG8_BAR; PG8_WAIT_L(0); PG8_MMA(0, 1, At, B1); PG8_BAR;
            PG8_LDA(At, 0, 1); PG8_STAGE_A(PG8_SA(0, 0), a2, 0, vo2);
            PG8_BAR; PG8_WAIT_L(0); PG8_MMA(1, 0, At, B0); PG8_BAR; PG8_SCHED;
            PG8_STAGE_B(PG8_SB(0, 1), b2 + hstep);
            PG8_WAIT_V(6); PG8_BAR; PG8_MMA(1, 1, At, B1); PG8_BAR;
            PG8_LDB(B0, 1, 0); PG8_SCHED; PG8_LDA(At, 1, 0); PG8_STAGE_A(PG8_SA(0, 1), a2, 1, vo2);
            PG8_WAIT_L(8); PG8_BAR; PG8_WAIT_L(0); PG8_MMA(0, 0, At, B0); PG8_BAR; PG8_SCHED;
            PG8_LDB(B1, 1, 1); PG8_STAGE_B(PG8_SB(1, 0), b3);
            PG8_BAR; PG8_WAIT_L(0); PG8_MMA(0, 1, At, B1); PG8_BAR;
            PG8_LDA(At, 1, 1); PG8_STAGE_A(PG8_SA(1, 0), a3, 0, vo2);
            PG8_BAR; PG8_WAIT_L(0); PG8_MMA(1, 0, At, B0); PG8_BAR; PG8_SCHED;
            PG8_STAGE_B(PG8_SB(1, 1), b3 + hstep);
            PG8_WAIT_V(6); PG8_BAR; PG8_MMA(1, 1, At, B1); PG8_BAR;
        }
#pragma unroll
        for (int ai = 0; ai < 2; ++ai)
#pragma unroll
            for (int m = 0; m < 4; ++m)
#pragma unroll
                for (int n = 0; n < 2; ++n) epi(cur, ai * 128 + wr * 64 + m * 16 + fr, wc * 32 + n * 16 + 4 * fq, acc[ai][0][m][n], acc[ai][1][m][n]);
        if (!has_next) break;
#pragma unroll
        for (int a = 0; a < 2; ++a)
#pragma unroll
            for (int b = 0; b < 2; ++b)
#pragma unroll
                for (int m = 0; m < 4; ++m)
#pragma unroll
                    for (int n = 0; n < 2; ++n) acc[a][b][m][n] = (f32x4){0.f, 0.f, 0.f, 0.f};
        cur = nxt; cA = nA; cB = nB; ++ui;
#pragma unroll
        for (int h = 0; h < 2; ++h)
#pragma unroll
            for (int i = 0; i < 2; ++i) voAc[h][i] = voAn[h][i];
    }
    PG8_WAIT_V(0);
    if (wr == 0) PG8_BAR;
    PG8_BAR;
#undef PG8_SA
#undef PG8_SB
#undef PG8_STAGE_A
#undef PG8_STAGE_B
#undef PG8_LDA
#undef PG8_LDB
#undef PG8_MMA
#undef PG8_WAIT_V
#undef PG8_WAIT_L
#undef PG8_BAR
#undef PG8_SCHED
}

struct SchG1 { const bf16_t *A, *Bt; int G, c, K;
    __device__ bool next(int i, Unit& u) const { const int L = i * G + c; if (L >= 128 * 24) return false; u.pm = L / 24; u.pn = L % 24; return true; }
    __device__ const bf16_t* arow(const Unit& u, int r) const { return A + (size_t)(u.pm * 256 + r) * 1024; }
    __device__ const bf16_t* brow(const Unit& u, int n) const { return Bt + (size_t)(u.pn * 256 + n) * 1024; }
    __device__ const char* abase(const Unit& u) const { return (const char*)(A + (size_t)u.pm * 256 * 1024); }
    __device__ const char* bbase(const Unit& u) const { return (const char*)(Bt + (size_t)u.pn * 256 * 1024); }
    __device__ unsigned aoff(const Unit&, int) const { return 0u; } };
struct EpiG1 { bf16_t *Z, *GYG, *XR, *SGA, *SGB; const float* bias;
    __device__ void operator()(const Unit& u, int r, int j, f32x4 v0, f32x4 v1) const {
        const size_t row = (size_t)u.pm * 256 + r; const int cb = u.pn * 256 + j;
        v0 += *(const f32x4*)(bias + cb); v1 += *(const f32x4*)(bias + cb + 128);
        if (u.pn < 8) { f32x4 z;
#pragma unroll
            for (int e = 0; e < 4; ++e) z[e] = v0[e] * sigm(v1[e]);
            *(u32x2*)(Z + row * 1024 + u.pn * 128 + j) = pk4(z); }
        else { const int kind = u.pn >> 2;
            bf16_t* dst = GYG + (size_t)(kind - 2) * (SLOT / 2);
#pragma unroll
            for (int e = 0; e < 4; ++e) { if (kind == 2) { v0[e] = gelu_tanh(v0[e]); v1[e] = gelu_tanh(v1[e]); } else if (kind >= 4) { v0[e] = sigm(v0[e]); v1[e] = sigm(v1[e]); } }
            bf16_t* o = dst + row * 1024 + (u.pn & 3) * 256 + j;
            *(u32x2*)o = pk4(v0); *(u32x2*)(o + 128) = pk4(v1); }
    } };
struct SchCtx { const bf16_t *A, *Bt; int G, c, K;
    __device__ bool next(int i, Unit& u) const { const int L = i * G + c; if (L >= 16) return false; u.pm = L / 4; u.pn = L % 4; return true; }
    __device__ const bf16_t* arow(const Unit& u, int r) const { return A + (size_t)(u.pm * 256 + r) * 1024; }
    __device__ const bf16_t* brow(const Unit& u, int n) const { return Bt + (size_t)((12 + u.pn) * 256 + n) * 1024; }
    __device__ const char* abase(const Unit& u) const { return (const char*)(A + (size_t)u.pm * 256 * 1024); }
    __device__ const char* bbase(const Unit& u) const { return (const char*)(Bt + (size_t)(12 + u.pn) * 256 * 1024); }
    __device__ unsigned aoff(const Unit&, int) const { return 0u; } };
struct EpiCtx { bf16_t* XRC; const float* bias;
    __device__ void operator()(const Unit& u, int r, int j, f32x4 v0, f32x4 v1) const {
        const size_t row = (size_t)u.pm * 256 + r; const int cb = (12 + u.pn) * 256 + j;
        v0 += *(const f32x4*)(bias + cb); v1 += *(const f32x4*)(bias + cb + 128);
        bf16_t* o = XRC + row * 1024 + u.pn * 256 + j; *(u32x2*)o = pk4(v0); *(u32x2*)(o + 128) = pk4(v1); } };
struct SchG2 { const bf16_t *Aa, *Ab, *Wa, *Wb; int G, c, K;
    __device__ bool next(int i, Unit& u) const { const int t = (i >> 1) * G + c; if (t >= 512) return false; u.pm = t >> 2; u.pn = t & 3; u.aux = i & 1; return true; }
    __device__ const bf16_t* arow(const Unit& u, int r) const { return Aa + (size_t)u.aux * (SLOT / 2) + (size_t)(u.pm * 256 + r) * 1024; }
    __device__ const bf16_t* brow(const Unit& u, int n) const { return Wa + (size_t)u.aux * (1024 * 1024) + (size_t)(u.pn * 256 + n) * 1024; }
    __device__ const char* abase(const Unit& u) const { return (const char*)(Aa + (size_t)u.aux * (SLOT / 2) + (size_t)u.pm * 256 * 1024); }
    __device__ const char* bbase(const Unit& u) const { return (const char*)(Wa + (size_t)u.aux * (1024 * 1024) + (size_t)u.pn * 256 * 1024); }
    __device__ unsigned aoff(const Unit&, int) const { return 0u; } };
struct EpiG2 { const bf16_t *SGA, *SGB; bf16_t* M;
    __device__ void operator()(const Unit& u, int r, int j, f32x4 v0, f32x4 v1) const {
        const size_t o = ((size_t)u.pm * 256 + r) * 1024 + u.pn * 256 + j;
        const bf16_t* G = SGA + (size_t)u.aux * (SLOT / 2);
        const u32x2 g0 = *(const u32x2*)(G + o), g1 = *(const u32x2*)(G + o + 128);
        f32x4 r0, r1;
        r0[0] = bflo(g0.x) * v0[0]; r0[1] = bfhi(g0.x) * v0[1]; r0[2] = bflo(g0.y) * v0[2]; r0[3] = bfhi(g0.y) * v0[3];
        r1[0] = bflo(g1.x) * v1[0]; r1[1] = bfhi(g1.x) * v1[1]; r1[2] = bflo(g1.y) * v1[2]; r1[3] = bfhi(g1.y) * v1[3];
        if (u.aux) { const u32x2 t0 = *(const u32x2*)(M + o), t1 = *(const u32x2*)(M + o + 128);
            r0[0] += bflo(t0.x); r0[1] += bfhi(t0.x); r0[2] += bflo(t0.y); r0[3] += bfhi(t0.y);
            r1[0] += bflo(t1.x); r1[1] += bfhi(t1.x); r1[2] += bflo(t1.y); r1[3] += bfhi(t1.y); }
        *(u32x2*)(M + o) = pk4(r0); *(u32x2*)(M + o + 128) = pk4(r1); } };
struct SchG3 { const bf16_t *A, *Bt; int G, c, K;
    __device__ bool next(int i, Unit& u) const { const int L = i * G + c; if (L >= 512) return false; u.pm = L >> 2; u.pn = L & 3; return true; }
    __device__ const bf16_t* arow(const Unit& u, int r) const { return A + (size_t)(u.pm * 256 + r) * 1024; }
    __device__ const bf16_t* brow(const Unit& u, int n) const { return Bt + (size_t)(u.pn * 256 + n) * 1024; }
    __device__ const char* abase(const Unit& u) const { return (const char*)(A + (size_t)u.pm * 256 * 1024); }
    __device__ const char* bbase(const Unit& u) const { return (const char*)(Bt + (size_t)u.pn * 256 * 1024); }
    __device__ unsigned aoff(const Unit&, int) const { return 0u; } };
struct EpiG3 { const float *X, *MOD; float* X1;
    __device__ void operator()(const Unit& u, int r, int j, f32x4 v0, f32x4 v1) const {
        const int row = u.pm * 256 + r, col = u.pn * 256 + j; const size_t o = (size_t)row * 1024 + col;
        const float* gt = MOD + (row / SEQ) * 6144 + 2 * 1024 + col;
        *(f32x4*)(X1 + o) = *(const f32x4*)(X + o) + *(const f32x4*)gt * v0;
        *(f32x4*)(X1 + o + 128) = *(const f32x4*)(X + o + 128) + *(const f32x4*)(gt + 128) * v1; } };
struct MoeMeta { const int* m;
    __device__ int cnt(int e) const { return m[e]; }
    __device__ int tb(int e) const { return m[16 + e]; }
    __device__ int find(int mt) const { int e = 0;
#pragma unroll
        for (int k = 1; k < 16; ++k) e += (m[16 + k] <= mt) ? 1 : 0;
        return e; } };
__device__ __forceinline__ void moe_meta_build(const Params& p, int* meta) {
    if (threadIdx.x == 0) { const unsigned* cnt = (const unsigned*)(p.ws + OFF_CTL); int t = 0;
        for (int e = 0; e < 16; ++e) { const int c = (int)__hip_atomic_load(cnt + e, __ATOMIC_RELAXED, __HIP_MEMORY_SCOPE_AGENT); meta[e] = c; meta[16 + e] = t; t += (c + 255) >> 8; }
        meta[32] = t; }
    __syncthreads();
}
struct SchUp { const bf16_t *HM, *W; const int* LIST; MoeMeta mm; int G, c, K; const int* idx;
    __device__ bool next(int i, Unit& u) const { const int L = i * G + c; if (L >= 4 * mm.m[32]) return false; const int mt = L >> 2; u.pn = L & 3; u.aux = mm.find(mt); u.aux2 = (mt - mm.tb(u.aux)) * 256; u.pm = mt | (i << 16); return true; }
    __device__ const char* abase(const Unit&) const { return (const char*)HM; }
    __device__ const char* bbase(const Unit& u) const { return (const char*)(W + ((size_t)u.aux * 1024 + u.pn * 256) * 1024); }
    __device__ unsigned aoff(const Unit& u, int r) const { return (unsigned)idx[(u.pm >> 16) * 256 + r] * 2048u; }
    __device__ const bf16_t* arow(const Unit& u, int r) const { int pos = u.aux2 + r; const int c = mm.cnt(u.aux); pos = pos < c ? pos : c - 1; return HM + (size_t)LIST[u.aux * NT + pos] * 1024; }
    __device__ const bf16_t* brow(const Unit& u, int n) const { return W + ((size_t)u.aux * 1024 + u.pn * 256 + n) * 1024; } };
struct EpiUp { bf16_t* ACT; const float* WL; MoeMeta mm;
    __device__ void operator()(const Unit& u, int r, int j, f32x4 g, f32x4 up) const {
        const int pos = u.aux2 + r; if (pos >= mm.cnt(u.aux)) return;
        const float wt = WL[u.aux * NT + pos]; f32x4 a;
#pragma unroll
        for (int e = 0; e < 4; ++e) a[e] = silu(g[e]) * up[e] * wt;
        *(u32x2*)(ACT + ((size_t)(u.pm & 0xffff) * 256 + r) * 512 + u.pn * 128 + j) = pk4(a); } };
struct SchDn { const bf16_t *ACT, *W; MoeMeta mm; int G, c, K;
    __device__ bool next(int i, Unit& u) const { const int L = i * G + c; if (L >= 4 * mm.m[32]) return false; const int mt = L >> 2; u.pn = L & 3; u.aux = mm.find(mt); u.aux2 = (mt - mm.tb(u.aux)) * 256; u.pm = mt; return true; }
    __device__ const bf16_t* arow(const Unit& u, int r) const { return ACT + ((size_t)u.pm * 256 + r) * 512; }
    __device__ const bf16_t* brow(const Unit& u, int n) const { return W + ((size_t)u.aux * 1024 + u.pn * 256 + n) * 512; }
    __device__ const char* abase(const Unit& u) const { return (const char*)(ACT + (size_t)u.pm * 256 * 512); }
    __device__ const char* bbase(const Unit& u) const { return (const char*)(W + ((size_t)u.aux * 1024 + u.pn * 256) * 512); }
    __device__ unsigned aoff(const Unit&, int) const { return 0u; } };
struct EpiDn { bf16_t* Y; MoeMeta mm;
    __device__ void operator()(const Unit& u, int r, int j, f32x4 v0, f32x4 v1) const {
        if (u.aux2 + r >= mm.cnt(u.aux)) return;
        bf16_t* o = Y + ((size_t)u.pm * 256 + r) * 1024 + u.pn * 256 + j; *(u32x2*)o = pk4(v0); *(u32x2*)(o + 128) = pk4(v1); } };

__device__ __forceinline__ void aprep_item(const Params& p, int g, unsigned char* lds) {
    const int tid = threadIdx.x, lane = tid & 63, wave = tid >> 6;
    const bf16_t* Z = (const bf16_t*)(p.ws + OFF_SLOT + 1 * SLOT);
    bf16_t* AA = (bf16_t*)(p.ws + OFF_SLOT + 0 * SLOT);
    unsigned* zt = (unsigned*)lds;
    { const u32x4* src = (const u32x4*)(Z + (size_t)g * 64 * 1024); u32x4* d = (u32x4*)lds;
#pragma unroll 4
        for (int i = tid; i < 8192; i += NTHR) d[i] = src[i]; }
    __syncthreads();
    {
        float w0[31], w1[31];
        const float* cw = p.in[I_CONVW] + 2 * tid;
#pragma unroll
        for (int k = 0; k < 31; ++k) { const f32x2 t = *(const f32x2*)(cw + k * 1024); w0[k] = t.x; w1[k] = t.y; }
        const f32x2 cb = *(const f32x2*)(p.in[I_CONVB] + 2 * tid);
        float p0[16], p1[16];
#pragma unroll
        for (int o = 0; o < 16; ++o) { p0[o] = 0.f; p1[o] = 0.f; }
#pragma unroll
        for (int tb = 0; tb < 5; ++tb) {
            float c0[16], c1[16];
#pragma unroll
            for (int o = 0; o < 16; ++o) { c0[o] = cb.x; c1[o] = cb.y; }
            if (tb < 4) {
#pragma unroll
                for (int r0 = 0; r0 < 48; r0 += 8) {
                    unsigned vv[8];
#pragma unroll
                    for (int rr = 0; rr < 8; ++rr) { const int row = 16 * tb - 15 + r0 + rr; vv[rr] = (r0 + rr < 46 && row >= 0 && row < 64) ? zt[row * 512 + tid] : 0u; }
#pragma unroll
                    for (int rr = 0; rr < 8; ++rr) { const int r = r0 + rr, row = 16 * tb - 15 + r;
                        if (r < 46 && row >= 0 && row < 64) { const float x0 = bflo(vv[rr]), x1 = bfhi(vv[rr]);
#pragma unroll
                            for (int o = 0; o < 16; ++o) { const int k = r - o; if (k >= 0 && k < 31) { c0[o] += w0[k] * x0; c1[o] += w1[k] * x1; } } } }
                    asm volatile("" ::: "memory");
                }
            }
            if (tb > 0) {
#pragma unroll
                for (int o = 0; o < 16; ++o) zt[(16 * (tb - 1) + o) * 512 + tid] = pk2(p0[o], p1[o]);
            }
#pragma unroll
            for (int o = 0; o < 16; ++o) { p0[o] = c0[o]; p1[o] = c1[o]; }
        }
    }
    __syncthreads();
    for (int rr = 0; rr < 8; ++rr) {
        const int row = wave * 8 + rr;
        const u32x4 a = *(const u32x4*)(lds + row * 2048 + lane * 16), b = *(const u32x4*)(lds + row * 2048 + 1024 + lane * 16);
        float x[16];
        x[0] = bflo(a.x); x[1] = bfhi(a.x); x[2] = bflo(a.y); x[3] = bfhi(a.y); x[4] = bflo(a.z); x[5] = bfhi(a.z); x[6] = bflo(a.w); x[7] = bfhi(a.w);
        x[8] = bflo(b.x); x[9] = bfhi(b.x); x[10] = bflo(b.y); x[11] = bfhi(b.y); x[12] = bflo(b.z); x[13] = bfhi(b.z); x[14] = bflo(b.w); x[15] = bfhi(b.w);
        float s = 0.f;
#pragma unroll
        for (int e = 0; e < 16; ++e) s += x[e];
        const float mean = wave_sum(s) * (1.0f / 1024.0f);
        float q = 0.f;
#pragma unroll
        for (int e = 0; e < 16; ++e) { x[e] -= mean; q += x[e] * x[e]; }
        const float rstd = rsqrtf(wave_sum(q) * (1.0f / 1024.0f) + 1e-6f);
        float y[16];
#pragma unroll
        for (int hh = 0; hh < 2; ++hh) { const int c0 = hh * 512 + lane * 8;
            const f32x4 g0 = *(const f32x4*)(p.in[I_LNG] + c0), g1 = *(const f32x4*)(p.in[I_LNG] + c0 + 4), b0 = *(const f32x4*)(p.in[I_LNB] + c0), b1 = *(const f32x4*)(p.in[I_LNB] + c0 + 4);
#pragma unroll
            for (int e = 0; e < 4; ++e) { y[hh * 8 + e] = silu(x[hh * 8 + e] * rstd * g0[e] + b0[e]); y[hh * 8 + 4 + e] = silu(x[hh * 8 + 4 + e] * rstd * g1[e] + b1[e]); } }
        bf16_t* o = AA + ((size_t)g * 64 + row) * 1024 + lane * 8;
        u32x4 o0, o1; o0.x = pk2(y[0], y[1]); o0.y = pk2(y[2], y[3]); o0.z = pk2(y[4], y[5]); o0.w = pk2(y[6], y[7]);
        o1.x = pk2(y[8], y[9]); o1.y = pk2(y[10], y[11]); o1.z = pk2(y[12], y[13]); o1.w = pk2(y[14], y[15]);
        *(u32x4*)o = o0; *(u32x4*)(o + 512) = o1;
    }
    __syncthreads();
}

constexpr int XC_STRIDE = 272;
template <bool FINAL>
__device__ __forceinline__ void b_item(const Params& p, int b, int c256, int h, unsigned char* lds) {
    const int tid = threadIdx.x, lane = tid & 63, wave = tid >> 6, fr = lane & 15, q = lane >> 4;
    const bool isctx = c256 < 0;
    const int seqlen = isctx ? CTXL : SEQ, sbase = isctx ? 0 : c256 * 256;
    const bf16_t* src = isctx ? (const bf16_t*)(p.ws + OFF_XRC) + (size_t)b * CTXL * 1024 : (const bf16_t*)(p.ws + OFF_SLOT + 3 * SLOT) + (size_t)b * SEQ * 1024;
    const int kc0 = isctx ? 0 : 4 + c256 * 4;
    f32x2* TOT = (f32x2*)(p.ws + OFF_TOT);
    const bf16_t* WG = (const bf16_t*)(p.ws + OFF_WG);
    float* hin = (float*)(lds + 64 * XC_STRIDE);
    const int chl = 16 * wave + fr, ch = h * 128 + chl;
    const float brf = p.in[I_BRF][ch], bif = p.in[I_BIF][ch], brb = p.in[I_BRB][ch], bib = p.in[I_BIB][ch];
    const float nspf = -8.0f * log1pf(__expf(-p.in[I_LAMF][ch])), nspb = -8.0f * log1pf(__expf(-p.in[I_LAMB][ch]));
    if (FINAL) {
        if (tid < 256) { const int dir = tid >> 7, cl = tid & 127, cg_ = h * 128 + cl; float hc = 0.f;
            const f32x2* T = TOT + ((size_t)b * NCH64 * 2 + dir) * 1024 + cg_;
            if (dir == 0) {
                for (int k = 0; k < kc0; ++k) { const f32x2 t = T[(size_t)k * 2048]; hc = t.x * hc + t.y; }
                for (int s = 0; s < 4; ++s) { hin[(s * 2 + 0) * 128 + cl] = hc; const f32x2 t = T[(size_t)(kc0 + s) * 2048]; hc = t.x * hc + t.y; }
            } else {
                for (int k = 3; k >= 0; --k) { const f32x2 t = T[(size_t)k * 2048]; hc = t.x * hc + t.y; }
                for (int k = NCH64 - 1; k >= kc0 + 4; --k) { const f32x2 t = T[(size_t)k * 2048]; hc = t.x * hc + t.y; }
                for (int s = 3; s >= 0; --s) { hin[(s * 2 + 1) * 128 + cl] = hc; const f32x2 t = T[(size_t)(kc0 + s) * 2048]; hc = t.x * hc + t.y; }
            }
        }
        __syncthreads();
    }
    for (int sub = 0; sub < 4; ++sub) {
        const int t0 = sbase + 64 * sub;
        {
            const int tt = tid >> 3, cgp = tid & 7, c0 = h * 128 + 16 * cgp;
            float xc[16];
            { const f32x4* bp = (const f32x4*)(p.in[I_LCB] + c0);
#pragma unroll
                for (int e4 = 0; e4 < 4; ++e4) { const f32x4 t = bp[e4]; xc[4 * e4] = t[0]; xc[4 * e4 + 1] = t[1]; xc[4 * e4 + 2] = t[2]; xc[4 * e4 + 3] = t[3]; } }
#pragma unroll
            for (int k = 0; k < 4; ++k) {
                const int row = t0 + tt + k - 2;
                if (row >= 0 && row < seqlen) {
                    const u32x4 a = *(const u32x4*)(src + (size_t)row * 1024 + c0), bb = *(const u32x4*)(src + (size_t)row * 1024 + c0 + 8);
                    const f32x4* wp = (const f32x4*)(p.in[I_LCW] + k * 1024 + c0);
                    const f32x4 w0 = wp[0], w1 = wp[1], w2 = wp[2], w3 = wp[3];
                    xc[0] += w0[0] * bflo(a.x); xc[1] += w0[1] * bfhi(a.x); xc[2] += w0[2] * bflo(a.y); xc[3] += w0[3] * bfhi(a.y);
                    xc[4] += w1[0] * bflo(a.z); xc[5] += w1[1] * bfhi(a.z); xc[6] += w1[2] * bflo(a.w); xc[7] += w1[3] * bfhi(a.w);
                    xc[8] += w2[0] * bflo(bb.x); xc[9] += w2[1] * bfhi(bb.x); xc[10] += w2[2] * bflo(bb.y); xc[11] += w2[3] * bfhi(bb.y);
                    xc[12] += w3[0] * bflo(bb.z); xc[13] += w3[1] * bfhi(bb.z); xc[14] += w3[2] * bflo(bb.w); xc[15] += w3[3] * bfhi(bb.w);
                }
            }
            u32x4 o0, o1; o0.x = pk2(xc[0], xc[1]); o0.y = pk2(xc[2], xc[3]); o0.z = pk2(xc[4], xc[5]); o0.w = pk2(xc[6], xc[7]);
            o1.x = pk2(xc[8], xc[9]); o1.y = pk2(xc[10], xc[11]); o1.z = pk2(xc[12], xc[13]); o1.w = pk2(xc[14], xc[15]);
            *(u32x4*)(lds + tt * XC_STRIDE + cgp * 32) = o0; *(u32x4*)(lds + tt * XC_STRIDE + cgp * 32 + 16) = o1;
        }
        __syncthreads();
        f32x4 acc[4][4];
#pragma unroll
        for (int m = 0; m < 4; ++m)
#pragma unroll
            for (int ty = 0; ty < 4; ++ty) acc[m][ty] = (f32x4){0.f, 0.f, 0.f, 0.f};
#pragma unroll
        for (int kk = 0; kk < 4; ++kk) {
            bf16x8 fa[4];
#pragma unroll
            for (int m = 0; m < 4; ++m) fa[m] = *(const bf16x8*)(lds + (16 * m + fr) * XC_STRIDE + (32 * kk + 8 * q) * 2);
#pragma unroll
            for (int ty = 0; ty < 4; ++ty) {
                const bf16x8 fb = *(const bf16x8*)(WG + (size_t)(h * 512 + wave * 64 + ty * 16 + fr) * 128 + 32 * kk + 8 * q);
#pragma unroll
                for (int m = 0; m < 4; ++m) acc[m][ty] = __builtin_amdgcn_mfma_f32_16x16x32_bf16(fa[m], fb, acc[m][ty], 0, 0, 0);
            }
        }
#pragma unroll
        for (int m = 0; m < 4; ++m)
#pragma unroll
            for (int i = 0; i < 4; ++i) {
                const float xcv = bf2f(*(const bf16_t*)(lds + (16 * m + 4 * q + i) * XC_STRIDE + chl * 2));
                const float laf = nspf * sigm(acc[m][0][i] + brf), lab = nspb * sigm(acc[m][2][i] + brb);
                const float gif = sigm(acc[m][1][i] + bif), gib = sigm(acc[m][3][i] + bib);
                acc[m][0][i] = __expf(laf); acc[m][1][i] = sqrtf(-expm1f(2.0f * laf)) * (gif * xcv);
                acc[m][2][i] = __expf(lab); acc[m][3][i] = sqrtf(-expm1f(2.0f * lab)) * (gib * xcv);
            }
        float At[4], Bt[4], Ae[4], Be[4];
#pragma unroll
        for (int m = 0; m < 4; ++m) {
            float A = 1.f, B = 0.f;
#pragma unroll
            for (int i = 0; i < 4; ++i) { B = acc[m][0][i] * B + acc[m][1][i]; A = acc[m][0][i] * A; }
            float tA = __shfl_up(A, 16), tB = __shfl_up(B, 16); if (q >= 1) { B = A * tB + B; A = A * tA; }
            tA = __shfl_up(A, 32); tB = __shfl_up(B, 32); if (q >= 2) { B = A * tB + B; A = A * tA; }
            Ae[m] = __shfl_up(A, 16); Be[m] = __shfl_up(B, 16); if (q == 0) { Ae[m] = 1.f; Be[m] = 0.f; }
            At[m] = __shfl(A, 48 + fr); Bt[m] = __shfl(B, 48 + fr);
        }
        if (!FINAL) {
            float A = 1.f, B = 0.f;
#pragma unroll
            for (int m = 0; m < 4; ++m) { B = At[m] * B + Bt[m]; A = At[m] * A; }
            if (q == 0) TOT[((size_t)(b * NCH64 + kc0 + sub) * 2 + 0) * 1024 + ch] = (f32x2){A, B};
        } else {
            float hh = hin[(sub * 2 + 0) * 128 + chl];
#pragma unroll
            for (int m = 0; m < 4; ++m) {
                float hs = Ae[m] * hh + Be[m];
#pragma unroll
                for (int i = 0; i < 4; ++i) { hs = acc[m][0][i] * hs + acc[m][1][i]; acc[m][0][i] = hs; }
                hh = At[m] * hh + Bt[m];
            }
        }
#pragma unroll
        for (int m = 0; m < 4; ++m) {
            float A = 1.f, B = 0.f;
#pragma unroll
            for (int i = 3; i >= 0; --i) { B = acc[m][2][i] * B + acc[m][3][i]; A = acc[m][2][i] * A; }
            float tA = __shfl_down(A, 16), tB = __shfl_down(B, 16); if (q <= 2) { B = A * tB + B; A = A * tA; }
            tA = __shfl_down(A, 32); tB = __shfl_down(B, 32); if (q <= 1) { B = A * tB + B; A = A * tA; }
            Ae[m] = __shfl_down(A, 16); Be[m] = __shfl_down(B, 16); if (q == 3) { Ae[m] = 1.f; Be[m] = 0.f; }
            At[m] = __shfl(A, fr); Bt[m] = __shfl(B, fr);
        }
        if (!FINAL) {
            float A = 1.f, B = 0.f;
#pragma unroll
            for (int m = 3; m >= 0; --m) { B = At[m] * B + Bt[m]; A = At[m] * A; }
            if (q == 0) TOT[((size_t)(b * NCH64 + kc0 + sub) * 2 + 1) * 1024 + ch] = (f32x2){A, B};
        } else {
            float hh = hin[(sub * 2 + 1) * 128 + chl];
#pragma unroll
            for (int m = 3; m >= 0; --m) {
                float hs = Ae[m] * hh + Be[m];
#pragma unroll
                for (int i = 3; i >= 0; --i) { hs = acc[m][2][i] * hs + acc[m][3][i]; acc[m][2][i] = hs; }
                hh = At[m] * hh + Bt[m];
            }
            const bf16_t* GYG = (const bf16_t*)(p.ws + OFF_SLOT + 2 * SLOT);
            bf16_t* AB = (bf16_t*)(p.ws + OFF_SLOT + 1 * SLOT);
#pragma unroll
            for (int m = 0; m < 4; ++m)
#pragma unroll
                for (int i = 0; i < 4; ++i) {
                    const size_t o = ((size_t)b * SEQ + t0 + 16 * m + 4 * q + i) * 1024 + ch;
                    AB[o] = f2bf(bf2f(GYG[o]) * (acc[m][0][i] + acc[m][2][i]));
                }
        }
        __syncthreads();
    }
}

__device__ __forceinline__ void ph8_route(const Params& p, int bid, int nb, unsigned char* lds) {
    const int tid = threadIdx.x, lane = tid & 63, wave = tid >> 6;
    float* Wl = (float*)lds;
    int* lcnt = (int*)(lds + 81920);
    int* lbase = lcnt + 16;
    int* tinfo = lcnt + 32;
    float* twt = (float*)(tinfo + 512);
    for (int i = tid; i < 1024 * 20; i += NTHR) { const int k = i / 20, o = i % 20; Wl[i] = o < 4 ? p.in[I_WGRP][k * 4 + o] : p.in[I_WER][k * 16 + o - 4]; }
    const float* MOD = (const float*)(p.ws + OFF_MOD);
    const float* X1 = p.out;
    bf16_t* HM = (bf16_t*)(p.ws + OFF_SLOT + 2 * SLOT);
    unsigned* gcnt = (unsigned*)(p.ws + OFF_CTL);
    int* LIST = (int*)(p.ws + OFF_LIST); float* WLs = (float*)(p.ws + OFF_WL); int* ROUTE = (int*)(p.ws + OFF_ROUTE);
    for (int tile = bid; tile < NT / 128; tile += nb) {
        if (tid < 16) lcnt[tid] = 0;
        __syncthreads();
        for (int tt = 0; tt < 16; ++tt) {
            const int tl = wave * 16 + tt, tok = tile * 128 + tl;
            const float* mrow = MOD + (tok / SEQ) * 6144;
            f32x4 v[4]; float ss = 0.f;
#pragma unroll
            for (int j = 0; j < 4; ++j) { v[j] = *(const f32x4*)(X1 + (size_t)tok * DM + lane * 4 + 256 * j); ss += v[j][0] * v[j][0] + v[j][1] * v[j][1] + v[j][2] * v[j][2] + v[j][3] * v[j][3]; }
            const float rinv = rsqrtf(wave_sum(ss) * (1.0f / DM) + 1e-6f);
            float lg[20];
#pragma unroll
            for (int o = 0; o < 20; ++o) lg[o] = 0.f;
#pragma unroll
            for (int j = 0; j < 4; ++j) { const int c = lane * 4 + 256 * j;
                const f32x4 g = *(const f32x4*)(p.in[I_GFFN] + c), sh = *(const f32x4*)(mrow + 3 * 1024 + c), sc = *(const f32x4*)(mrow + 4 * 1024 + c);
                f32x4 hm;
#pragma unroll
                for (int e = 0; e < 4; ++e) { hm[e] = v[j][e] * rinv * g[e] * (1.0f + sc[e]) + sh[e];
#pragma unroll
                    for (int o = 0; o < 20; ++o) lg[o] += hm[e] * Wl[(c + e) * 20 + o]; }
                *(u32x2*)(HM + (size_t)tok * DM + c) = pk4(hm); }
#pragma unroll
            for (int o = 0; o < 20; ++o) lg[o] = wave_sum(lg[o]);
#pragma unroll
            for (int o = 0; o < 4; ++o) lg[o] += p.in[I_BGRP][o];
#pragma unroll
            for (int o = 0; o < 16; ++o) lg[4 + o] += p.in[I_BER][o];
            int gs = 0; float gm = lg[0];
#pragma unroll
            for (int o = 1; o < 4; ++o) if (lg[o] > gm) { gm = lg[o]; gs = o; }
            float den = 0.f;
#pragma unroll
            for (int o = 0; o < 4; ++o) den += __expf(lg[o] - gm);
            const float pg = 1.0f / den;
            float el[4];
#pragma unroll
            for (int o = 0; o < 4; ++o) el[o] = gs == 0 ? lg[4 + o] : gs == 1 ? lg[8 + o] : gs == 2 ? lg[12 + o] : lg[16 + o];
            int i1 = 0; float v1 = el[0];
#pragma unroll
            for (int o = 1; o < 4; ++o) if (el[o] > v1) { v1 = el[o]; i1 = o; }
            int i2 = -1; float v2 = -3.0e38f;
#pragma unroll
            for (int o = 0; o < 4; ++o) if (o != i1 && el[o] > v2) { v2 = el[o]; i2 = o; }
            const float w1 = 1.0f / (1.0f + __expf(v2 - v1)), w2 = 1.0f - w1;
            if (lane == 0) { const int e1 = gs * 4 + i1, e2 = gs * 4 + i2;
                const int r1 = atomicAdd(&lcnt[e1], 1), r2 = atomicAdd(&lcnt[e2], 1);
                tinfo[tl * 4 + 0] = e1; tinfo[tl * 4 + 1] = r1; tinfo[tl * 4 + 2] = e2; tinfo[tl * 4 + 3] = r2; twt[tl * 2] = pg * w1; twt[tl * 2 + 1] = pg * w2; }
        }
        __syncthreads();
        if (tid < 16) lbase[tid] = (int)__hip_atomic_fetch_add(gcnt + tid, (unsigned)lcnt[tid], __ATOMIC_RELAXED, __HIP_MEMORY_SCOPE_AGENT);
        __syncthreads();
        if (tid < 128) { const int tok = tile * 128 + tid;
            const int e1 = tinfo[tid * 4], e2 = tinfo[tid * 4 + 2], p1 = lbase[e1] + tinfo[tid * 4 + 1], p2 = lbase[e2] + tinfo[tid * 4 + 3];
            LIST[e1 * NT + p1] = tok; LIST[e2 * NT + p2] = tok; WLs[e1 * NT + p1] = twt[tid * 2]; WLs[e2 * NT + p2] = twt[tid * 2 + 1];
            ROUTE[tok * 4 + 0] = e1; ROUTE[tok * 4 + 1] = p1; ROUTE[tok * 4 + 2] = e2; ROUTE[tok * 4 + 3] = p2; }
        __syncthreads();
    }
}

__device__ __forceinline__ void ph10_final(const Params& p, int bid, int nb, const int* meta) {
    const int lane = threadIdx.x & 63, wave = threadIdx.x >> 6;
    const float* MOD = (const float*)(p.ws + OFF_MOD);
    const bf16_t* Y = (const bf16_t*)(p.ws + OFF_SLOT);
    const int* ROUTE = (const int*)(p.ws + OFF_ROUTE);
    float* X1 = p.out;
    for (int r = bid * 8 + wave; r < NT; r += nb * 8) {
        const int e1 = ROUTE[r * 4], p1 = ROUTE[r * 4 + 1], e2 = ROUTE[r * 4 + 2], p2 = ROUTE[r * 4 + 3];
        const bf16_t* y1 = Y + ((size_t)meta[16 + e1] * 256 + p1) * 1024; const bf16_t* y2 = Y + ((size_t)meta[16 + e2] * 256 + p2) * 1024;
        const float* gt = MOD + (r / SEQ) * 6144 + 5 * 1024;
        f32x4 v[4]; float ss = 0.f;
#pragma unroll
        for (int j = 0; j < 4; ++j) { const int c = lane * 4 + 256 * j;
            v[j] = *(const f32x4*)(X1 + (size_t)r * DM + c);
            const u32x2 a = *(const u32x2*)(y1 + c), bq = *(const u32x2*)(y2 + c); const f32x4 g = *(const f32x4*)(gt + c);
            v[j][0] += g[0] * (bflo(a.x) + bflo(bq.x)); v[j][1] += g[1] * (bfhi(a.x) + bfhi(bq.x)); v[j][2] += g[2] * (bflo(a.y) + bflo(bq.y)); v[j][3] += g[3] * (bfhi(a.y) + bfhi(bq.y));
            ss += v[j][0] * v[j][0] + v[j][1] * v[j][1] + v[j][2] * v[j][2] + v[j][3] * v[j][3]; }
        const float rinv = rsqrtf(wave_sum(ss) * (1.0f / DM) + 1e-6f);
#pragma unroll
        for (int j = 0; j < 4; ++j) { const int c = lane * 4 + 256 * j; const f32x4 g = *(const f32x4*)(p.in[I_GFINAL] + c);
            *(f32x4*)(X1 + (size_t)r * DM + c) = v[j] * rinv * g; }
    }
}

__global__ void __launch_bounds__(NTHR) mega(Params p, int lo, int hi) {
    extern __shared__ __attribute__((aligned(16))) unsigned char lds[];
    cg::grid_group grid = cg::this_grid();
    const int bid = blockIdx.x, nb = gridDim.x;
    unsigned char* ws = p.ws;
    bf16_t* S0 = (bf16_t*)(ws + OFF_SLOT), *S1 = (bf16_t*)(ws + OFF_SLOT + SLOT), *S2 = (bf16_t*)(ws + OFF_SLOT + 2 * SLOT), *S3 = (bf16_t*)(ws + OFF_SLOT + 3 * SLOT),
           *S4 = (bf16_t*)(ws + OFF_SLOT + 4 * SLOT), *S5 = (bf16_t*)(ws + OFF_SLOT + 5 * SLOT);
    const float* MOD = (const float*)(ws + OFF_MOD); const float* BINP = (const float*)(ws + OFF_BINP);
    int* meta = (int*)(lds + LDS_BYTES - 256);
#ifndef PHMASK
#define PHMASK 0x7ff
#endif
#define IN(k) (((PHMASK >> (k)) & 1) && lo <= (k) && (k) < hi)
#ifndef PIPE_MASK
#define PIPE_MASK 0x364
#endif
#define GEMM_RUN(k, gather, s, e) do { if ((PIPE_MASK >> (k)) & 1) gemm_phase_pipe<gather>(lds, s, e); else gemm_phase_simple(s, e); } while (0)
#define SEAM(k) do { if (IN(k) && IN((k) + 1)) grid.sync(); } while (0)
    if (IN(0)) { ph0_prep(p, bid, nb, lds); } SEAM(0);
    if (IN(1)) { ph1_norm(p, bid, nb); } SEAM(1);
    if (IN(2)) {
        { SchCtx s{(const bf16_t*)(ws + OFF_HC), (const bf16_t*)(ws + OFF_WIN), nb, bid, 1024}; EpiCtx e{(bf16_t*)(ws + OFF_XRC), BINP}; GEMM_RUN(2, false, s, e); }
        { SchG1 s{S0, (const bf16_t*)(ws + OFF_WIN), nb, bid, 1024}; EpiG1 e{S1, S2, S3, S4, S5, BINP}; GEMM_RUN(2, false, s, e); }
    } SEAM(2);
    if (IN(3)) {
        for (int g = bid; g < 512; g += nb) aprep_item(p, g, lds);
        for (int it = bid; it < 1024 + 32; it += nb) { if (it < 1024) b_item<false>(p, it >> 8, (it >> 3) & 31, it & 7, lds); else b_item<false>(p, (it - 1024) >> 3, -1, it & 7, lds); }
    } SEAM(3);
    if (IN(4)) {
        for (int it = bid; it < 1024; it += nb) b_item<true>(p, it >> 8, (it >> 3) & 31, it & 7, lds);
    } SEAM(4);
    if (IN(5)) { SchG2 s{S0, S1, (const bf16_t*)(ws + OFF_WPA), (const bf16_t*)(ws + OFF_WPB), nb, bid, 1024}; EpiG2 e{S4, S5, S3}; GEMM_RUN(5, false, s, e); } SEAM(5);
    if (IN(6)) { SchG3 s{S3, (const bf16_t*)(ws + OFF_WO), nb, bid, 1024}; EpiG3 e{p.in[I_X], MOD, p.out}; GEMM_RUN(6, false, s, e); } SEAM(6);
    if (IN(7)) { ph8_route(p, bid, nb, lds); } SEAM(7);
    if (IN(8)) { __syncthreads(); moe_meta_build(p, meta); MoeMeta mm{meta};
        int* idx = (int*)(lds + STAGE_BYTES);
        SchUp s{S2, (const bf16_t*)(ws + OFF_WGU), (const int*)(ws + OFF_LIST), mm, nb, bid, 1024, idx}; EpiUp e{S4, (const float*)(ws + OFF_WL), mm};
        { Unit u; for (int i = 0; i < 8 && s.next(i, u); ++i) { if (threadIdx.x < 256) { int pos = u.aux2 + (int)threadIdx.x; const int c = mm.cnt(u.aux); pos = pos < c ? pos : c - 1; idx[i * 256 + threadIdx.x] = s.LIST[u.aux * NT + pos]; } } }
        __syncthreads();
        GEMM_RUN(8, true, s, e); } SEAM(8);
    if (IN(9)) { __syncthreads(); moe_meta_build(p, meta); MoeMeta mm{meta};
        SchDn s{S4, (const bf16_t*)(ws + OFF_WDN), mm, nb, bid, 512}; EpiDn e{S0, mm}; GEMM_RUN(9, false, s, e); } SEAM(9);
    if (IN(10)) { __syncthreads(); moe_meta_build(p, meta); ph10_final(p, bid, nb, meta); }
#undef IN
#undef SEAM
}

extern "C" void kernel_launch(void* const* d_in, const int* in_sizes, int n_in, void* d_out, int out_size, void* d_ws, size_t ws_size, hipStream_t stream) {
    static int grid = 0;
    if (grid == 0) {
        if (n_in != 37 || out_size != NT * DM || ws_size < WS_END) { fprintf(stderr, "kernel_launch: unexpected shapes: n_in %d out %d ws %zu (need %zu)\n", n_in, out_size, ws_size, (size_t)WS_END); grid = -1; return; }
        int dev = 0, cus = 0, per_cu = 0;
        (void)hipGetDevice(&dev); (void)hipDeviceGetAttribute(&cus, hipDeviceAttributeMultiprocessorCount, dev);
        if (hipFuncSetAttribute((const void*)mega, hipFuncAttributeMaxDynamicSharedMemorySize, LDS_BYTES) != hipSuccess) { fprintf(stderr, "kernel_launch: hipFuncSetAttribute failed\n"); grid = -1; return; }
        if (hipOccupancyMaxActiveBlocksPerMultiprocessor(&per_cu, (const void*)mega, NTHR, LDS_BYTES) != hipSuccess || per_cu < 1) { fprintf(stderr, "kernel_launch: occupancy query says %d\n", per_cu); per_cu = 1; }
        (void)hipGetLastError();
        grid = cus * 1;
        fprintf(stderr, "kernel_launch: grid %d (cus %d, per_cu %d)\n", grid, cus, per_cu);
    }
    if (grid < 0) return;
    Params p{};
    for (int i = 0; i < 37; ++i) p.in[i] = (const float*)d_in[i];
    p.out = (float*)d_out; p.ws = (unsigned char*)d_ws;
#if ONE_LAUNCH
    int lo = 0, hi = NPHASE; void* args[] = {&p, &lo, &hi};
    hipError_t e = hipLaunchCooperativeKernel((const void*)mega, dim3(grid), dim3(NTHR), args, LDS_BYTES, stream);
    if (e != hipSuccess) fprintf(stderr, "cooperative launch failed: %s (grid %d)\n", hipGetErrorString(e), grid);
#else
    for (int k = 0; k < NPHASE; ++k) hipLaunchKernelGGL(mega, dim3(grid), dim3(NTHR), LDS_BYTES, stream, p, k, k + 1);
#endif
}
```

```cpp
#include <hip/hip_runtime.h>
#include <hip/hip_cooperative_groups.h>
#include <cstdio>
#include <cstdint>
namespace cg = cooperative_groups;

#ifndef ONE_LAUNCH
#define ONE_LAUNCH 1
#endif

typedef unsigned short bf16_t;
typedef short bf16x8 __attribute__((ext_vector_type(8)));
typedef float f32x4 __attribute__((ext_vector_type(4)));
typedef float f32x2 __attribute__((ext_vector_type(2)));
typedef unsigned u32x4 __attribute__((ext_vector_type(4)));
typedef unsigned u32x2 __attribute__((ext_vector_type(2)));

constexpr int NT = 32768, NCX = 1024, DM = 1024, SEQ = 8192, CTXL = 256;
constexpr int NTHR = 512;
constexpr int NCH64 = 132;
constexpr size_t MiB = (size_t)1 << 20;
constexpr size_t OFF_CTL = 0, OFF_MOD = 1 * MiB, OFF_BINP = OFF_MOD + 128 * 1024, OFF_WIN = 2 * MiB, OFF_WPA = 14 * MiB, OFF_WPB = 16 * MiB,
                 OFF_WO = 18 * MiB, OFF_WG = 20 * MiB, OFF_WGU = 22 * MiB, OFF_WDN = 54 * MiB, OFF_HC = 70 * MiB, OFF_XRC = 72 * MiB,
                 OFF_TOT = 74 * MiB, OFF_ROUTE = 84 * MiB, OFF_LIST = 85 * MiB, OFF_WL = 87 * MiB, OFF_SLOT = 90 * MiB, SLOT = 64 * MiB,
                 WS_END = OFF_SLOT + 6 * SLOT;
constexpr int LDS_BYTES = 144 * 1024;
constexpr int NPHASE = 11;

struct Params { const float* in[37]; float* out; unsigned char* ws; int pv; int pad; };

enum { I_X = 0, I_C, I_CTX, I_CCTX, I_WADA, I_BADA, I_GMIX, I_WIN, I_BIN, I_CONVW, I_CONVB, I_LNG, I_LNB, I_WPA, I_LCW, I_LCB,
       I_WRF, I_BRF, I_WIF, I_BIF, I_LAMF, I_WRB, I_BRB, I_WIB, I_BIB, I_LAMB, I_WPB, I_WO, I_GFFN, I_WGRP, I_BGRP, I_WER, I_BER,
       I_WGATE, I_WUP, I_WDOWN, I_GFINAL };

__device__ __forceinline__ float bflo(unsigned w) { return __uint_as_float(w << 16); }
__device__ __forceinline__ float bfhi(unsigned w) { return __uint_as_float(w & 0xffff0000u); }
__device__ __forceinline__ float bf2f(bf16_t h) { return __uint_as_float(((unsigned)h) << 16); }
__device__ __forceinline__ unsigned pk2(float lo, float hi) { unsigned r; asm("v_cvt_pk_bf16_f32 %0, %1, %2" : "=v"(r) : "v"(lo), "v"(hi)); return r; }
__device__ __forceinline__ bf16_t f2bf(float f) { return (bf16_t)(pk2(f, 0.f) & 0xffffu); }
__device__ __forceinline__ float sigm(float x) { return __builtin_amdgcn_rcpf(1.0f + __expf(-x)); }
__device__ __forceinline__ float silu(float x) { return x * sigm(x); }
__device__ __forceinline__ float gelu_tanh(float x) { return x * sigm(1.5957691216057308f * (x + 0.044715f * x * x * x)); }
__device__ __forceinline__ float wave_sum(float v) {
#pragma unroll
    for (int o = 1; o < 64; o <<= 1) v += __shfl_xor(v, o);
    return v;
}
__device__ __forceinline__ void wave_lds_sync() { asm volatile("s_waitcnt lgkmcnt(0)" ::: "memory"); __builtin_amdgcn_wave_barrier(); }
__device__ __forceinline__ u32x2 pk4(f32x4 v) { u32x2 r; r.x = pk2(v[0], v[1]); r.y = pk2(v[2], v[3]); return r; }

template <class DRow>
__device__ __forceinline__ void tr_item(const float* __restrict__ src, int ldsrc, int k0, int n0, bf16_t* dst, int ldd, DRow drow, float* scr, int lane) {
#pragma unroll 8
    for (int i = 0; i < 32; ++i) { const int kk = 2 * i + (lane >> 5); scr[kk * 33 + (lane & 31)] = src[(size_t)(k0 + kk) * ldsrc + n0 + (lane & 31)]; }
    wave_lds_sync();
    const int c = lane & 7;
#pragma unroll
    for (int j = 0; j < 4; ++j) {
        const int n = (lane >> 3) + 8 * j; const float* s = scr + (8 * c) * 33 + n;
        u32x4 o; o.x = pk2(s[0], s[33]); o.y = pk2(s[66], s[99]); o.z = pk2(s[132], s[165]); o.w = pk2(s[198], s[231]);
        *(u32x4*)(dst + (size_t)drow(n0 + n) * ldd + k0 + 8 * c) = o;
    }
    wave_lds_sync();
}

__device__ __forceinline__ int win_srccol(int np) { const int p = np >> 8, r = np & 255; return p < 8 ? (r >> 7) * 1024 + 128 * p + (r & 127) : np; }

__device__ __forceinline__ void ph0_prep(const Params& p, int bid, int nb, unsigned char* lds) {
    const int tid = threadIdx.x, lane = tid & 63, wave = tid >> 6;
    unsigned char* ws = p.ws;
    float* scr = (float*)lds + wave * (64 * 33);
    const int gw = bid * 8 + wave, NGW = nb * 8;
    constexpr int N_WIN = 16 * 192, N_SQ = 16 * 32, N_G = 256, N_GU = 4096, N_DN = 4096;
    constexpr int NITEMS = N_WIN + 3 * N_SQ + N_G + 2 * N_GU + N_DN;
    for (int it = gw; it < NITEMS; it += NGW) {
        int r = it;
        if (r < N_WIN) { const int kb = r / 192, nbk = r % 192, d0 = 32 * nbk, sc0 = win_srccol(d0);
            tr_item(p.in[I_WIN], 6144, 64 * kb, sc0, (bf16_t*)(ws + OFF_WIN), 1024, [=](int n) { return n - sc0 + d0; }, scr, lane); continue; }
        r -= N_WIN;
        if (r < 3 * N_SQ) { const int which = r / N_SQ, q = r % N_SQ, kb = q / 32, nbk = q % 32;
            const float* src = which == 0 ? p.in[I_WPA] : which == 1 ? p.in[I_WPB] : p.in[I_WO];
            bf16_t* dst = (bf16_t*)(ws + (which == 0 ? OFF_WPA : which == 1 ? OFF_WPB : OFF_WO));
            tr_item(src, 1024, 64 * kb, 32 * nbk, dst, 1024, [=](int n) { return n; }, scr, lane); continue; }
        r -= 3 * N_SQ;
        if (r < N_G) { const int ty = r / 64, q = r % 64, h = q / 8, kb = (q % 8) / 4, nbk = q % 4;
            const float* src = (ty == 0 ? p.in[I_WRF] : ty == 1 ? p.in[I_WIF] : ty == 2 ? p.in[I_WRB] : p.in[I_WIB]) + (size_t)h * 128 * 128;
            tr_item(src, 128, 64 * kb, 32 * nbk, (bf16_t*)(ws + OFF_WG), 128, [=](int n) { return h * 512 + (n >> 4) * 64 + ty * 16 + (n & 15); }, scr, lane); continue; }
        r -= N_G;
        if (r < 2 * N_GU) { const int bj = r / N_GU, q = r % N_GU, e = q / 256, kb = (q % 256) / 16, nbk = q % 16;
            const float* src = (bj == 0 ? p.in[I_WGATE] : p.in[I_WUP]) + (size_t)e * 1024 * 512;
            tr_item(src, 512, 64 * kb, 32 * nbk, (bf16_t*)(ws + OFF_WGU) + (size_t)e * 1024 * 1024, 1024, [=](int n) { return 256 * (n >> 7) + 128 * bj + (n & 127); }, scr, lane); continue; }
        r -= 2 * N_GU;
        { const int e = r / 256, kb = (r % 256) / 32, nbk = r % 32;
            tr_item(p.in[I_WDOWN] + (size_t)e * 512 * 1024, 1024, 64 * kb, 32 * nbk, (bf16_t*)(ws + OFF_WDN) + (size_t)e * 1024 * 512, 512, [=](int n) { return n; }, scr, lane); }
    }
    __syncthreads();
    float* red = (float*)lds;
    float* MOD = (float*)(ws + OFF_MOD);
    for (int it = bid; it < 96; it += nb) {
        const int col = it * 64 + lane;
        float a[5] = {0.f, 0.f, 0.f, 0.f, 0.f};
        const float* W = p.in[I_WADA];
        for (int k = wave * 128; k < wave * 128 + 128; ++k) {
            const float wv = W[(size_t)k * 6144 + col];
#pragma unroll
            for (int r = 0; r < 5; ++r) { const float cv = r < 4 ? p.in[I_C][r * 1024 + k] : p.in[I_CCTX][k]; a[r] += silu(cv) * wv; }
        }
#pragma unroll
        for (int r = 0; r < 5; ++r) red[(wave * 5 + r) * 64 + lane] = a[r];
        __syncthreads();
        if (tid < 320) { const int r = tid / 64, l = tid % 64; float s = 0.f;
#pragma unroll
            for (int w = 0; w < 8; ++w) s += red[(w * 5 + r) * 64 + l];
            MOD[r * 6144 + it * 64 + l] = s + p.in[I_BADA][it * 64 + l]; }
        __syncthreads();
    }
    float* BINP = (float*)(ws + OFF_BINP);
    for (int i = bid * NTHR + tid; i < 6144; i += nb * NTHR) BINP[i] = p.in[I_BIN][win_srccol(i)];
    if (bid == 0 && tid < 64) ((unsigned*)(ws + OFF_CTL))[tid] = 0u;
}

__device__ __forceinline__ void ph1_norm(const Params& p, int bid, int nb) {
    const int lane = threadIdx.x & 63, wave = threadIdx.x >> 6;
    const float* MOD = (const float*)(p.ws + OFF_MOD);
    for (int r = bid * 8 + wave; r < NT + NCX; r += nb * 8) {
        const bool lat = r < NT;
        const float* src = lat ? p.in[I_X] + (size_t)r * DM : p.in[I_CTX] + (size_t)(r - NT) * DM;
        bf16_t* dst = lat ? (bf16_t*)(p.ws + OFF_SLOT) + (size_t)r * DM : (bf16_t*)(p.ws + OFF_HC) + (size_t)(r - NT) * DM;
        const float* mrow = MOD + (lat ? r / SEQ : 4) * 6144;
        f32x4 v[4]; float ss = 0.f;
#pragma unroll
        for (int j = 0; j < 4; ++j) { v[j] = *(const f32x4*)(src + lane * 4 + 256 * j); ss += v[j][0] * v[j][0] + v[j][1] * v[j][1] + v[j][2] * v[j][2] + v[j][3] * v[j][3]; }
        const float rinv = rsqrtf(wave_sum(ss) * (1.0f / DM) + 1e-6f);
#pragma unroll
        for (int j = 0; j < 4; ++j) { const int c = lane * 4 + 256 * j;
            const f32x4 g = *(const f32x4*)(p.in[I_GMIX] + c), sh = *(const f32x4*)(mrow + c), sc = *(const f32x4*)(mrow + 1024 + c);
            f32x4 o;
#pragma unroll
            for (int e = 0; e < 4; ++e) o[e] = v[j][e] * rinv * g[e] * (1.0f + sc[e]) + sh[e];
            *(u32x2*)(dst + c) = pk4(o); }
    }
}

struct Unit { int pm, pn, aux, aux2; };

template <class S, class E>
__device__ __forceinline__ void sgemm_unit(const S& s, const Unit& u, const E& e) {
    const int lane = threadIdx.x & 63, w = threadIdx.x >> 6, fr = lane & 15, fq = lane >> 4;
    const int K = s.K;
    const bf16_t* b0 = s.brow(u, 16 * w + fr) + 8 * fq;
    const bf16_t* b1 = s.brow(u, 128 + 16 * w + fr) + 8 * fq;
    for (int sub = 0; sub < 4; ++sub) {
        f32x4 acc[4][2];
        const bf16_t* a[4];
#pragma unroll
        for (int m = 0; m < 4; ++m) { acc[m][0] = (f32x4){0.f, 0.f, 0.f, 0.f}; acc[m][1] = (f32x4){0.f, 0.f, 0.f, 0.f}; a[m] = s.arow(u, 64 * sub + 16 * m + fr) + 8 * fq; }
#pragma unroll 2
        for (int k0 = 0; k0 < K; k0 += 32) {
            const bf16x8 fb0 = *(const bf16x8*)(b0 + k0), fb1 = *(const bf16x8*)(b1 + k0);
#pragma unroll
            for (int m = 0; m < 4; ++m) { const bf16x8 fa = *(const bf16x8*)(a[m] + k0);
                acc[m][0] = __builtin_amdgcn_mfma_f32_16x16x32_bf16(fb0, fa, acc[m][0], 0, 0, 0);
                acc[m][1] = __builtin_amdgcn_mfma_f32_16x16x32_bf16(fb1, fa, acc[m][1], 0, 0, 0); }
        }
#pragma unroll
        for (int m = 0; m < 4; ++m) e(u, 64 * sub + 16 * m + fr, 16 * w + 4 * fq, acc[m][0], acc[m][1]);
    }
}
template <class S, class E>
__device__ __forceinline__ void gemm_phase_simple(const S& s, const E& e) { Unit u; for (int i = 0; s.next(i, u); ++i) sgemm_unit(s, u, e); }


#define LAS __attribute__((address_space(3)))
constexpr int BK = 64, HTB = 128 * BK * 2, STAGE_BYTES = 8 * HTB;
__device__ __forceinline__ int lds_byte(int r, int c) { const int st = (r >> 4) * 2 + (c >> 5), rr = r & 15, cc = c & 31, ob = rr * 64 + cc * 2; return st * 1024 + (ob ^ (((ob >> 9) & 1) << 5)); }
__device__ __forceinline__ void stage_rc(int b, int& R, int& C) { const int st = b / 1024, sb = b % 1024, swz = sb ^ (((sb >> 9) & 1) << 5); R = (st >> 1) * 16 + swz / 64; C = (st & 1) * 32 + (swz % 64) / 2; }

template <bool GATHER, class S, class E>
__device__ __forceinline__ void gemm_phase_pipe(unsigned char* ldsg, const S& sch, const E& epi) {
    LAS unsigned char* lds = (LAS unsigned char*)ldsg;
    const int tid = threadIdx.x, wid = __builtin_amdgcn_readfirstlane(tid >> 6), lane = tid & 63, wr = wid >> 2, wc = wid & 3, fr = lane & 15, fq = lane >> 4;
    const int K = sch.K, nt = K / BK;
    int Rr[2], Cc[2]; unsigned voffA[2], voffB[2];
#pragma unroll
    for (int i = 0; i < 2; ++i) { stage_rc(tid * 16 + i * 8192, Rr[i], Cc[i]); voffA[i] = (unsigned)(Rr[i] * K + Cc[i]) * 2u; voffB[i] = voffA[i]; }
    const size_t kstep = (size_t)(BK * 2);
    const size_t hstep = (size_t)128 * K * 2;
    const unsigned ldsw = (unsigned)wid * 1024u;
    const int aoff = lds_byte(wr * 64 + fr, fq * 8), boff = lds_byte(wc * 32 + fr, fq * 8);
#define PG8_SA(b, h) (((b) * 2 + (h)) * HTB)
#define PG8_SB(b, h) ((4 + (b) * 2 + (h)) * HTB)
#define PG8_STAGE_B(bufoff, gbase) do { _Pragma("unroll") for (int _i = 0; _i < 2; ++_i) \
        __builtin_amdgcn_global_load_lds((const unsigned*)((const char*)(gbase) + voffB[_i]), (LAS unsigned*)(lds + (bufoff) + ldsw + _i * 8192), 16, 0, 0); } while (0)
#define PG8_STAGE_A(bufoff, gbase, h, vo) do { _Pragma("unroll") for (int _i = 0; _i < 2; ++_i) \
        __builtin_amdgcn_global_load_lds((const unsigned*)((const char*)(gbase) + (GATHER ? (size_t)(vo)[h][_i] : (size_t)(h) * hstep + voffA[_i])), (LAS unsigned*)(lds + (bufoff) + ldsw + _i * 8192), 16, 0, 0); } while (0)
#define PG8_LDA(dst, b, h) do { _Pragma("unroll") for (int m = 0; m < 4; ++m) _Pragma("unroll") for (int k = 0; k < 2; ++k) dst[m][k] = *(const LAS bf16x8*)(lds + PG8_SA(b, h) + aoff + m * 2048 + k * 1024); } while (0)
#define PG8_LDB(dst, b, h) do { _Pragma("unroll") for (int n = 0; n < 2; ++n) _Pragma("unroll") for (int k = 0; k < 2; ++k) dst[n][k] = *(const LAS bf16x8*)(lds + PG8_SB(b, h) + boff + n * 2048 + k * 1024); } while (0)
#define PG8_MMA(ai, bj, At, Bt) do { __builtin_amdgcn_s_setprio(1); _Pragma("unroll") for (int m = 0; m < 4; ++m) _Pragma("unroll") for (int n = 0; n < 2; ++n) _Pragma("unroll") for (int k = 0; k < 2; ++k) \
        acc[ai][bj][m][n] = __builtin_amdgcn_mfma_f32_16x16x32_bf16(Bt[n][k], At[m][k], acc[ai][bj][m][n], 0, 0, 0); __builtin_amdgcn_s_setprio(0); } while (0)
#define PG8_WAIT_V(n) asm volatile("s_waitcnt vmcnt(" #n ")" ::: "memory")
#define PG8_WAIT_L(n) asm volatile("s_waitcnt lgkmcnt(" #n ")" ::: "memory")
#define PG8_BAR __builtin_amdgcn_s_barrier()
#define PG8_SCHED __builtin_amdgcn_sched_barrier(0)
    Unit cur, nxt; int ui = 0;
    if (!sch.next(0, cur)) return;
    f32x4 acc[2][2][4][2];
#pragma unroll
    for (int a = 0; a < 2; ++a)
#pragma unroll
        for (int b = 0; b < 2; ++b)
#pragma unroll
            for (int m = 0; m < 4; ++m)
#pragma unroll
                for (int n = 0; n < 2; ++n) acc[a][b][m][n] = (f32x4){0.f, 0.f, 0.f, 0.f};
    bf16x8 At[4][2], B0[2][2], B1[2][2];
    unsigned voAc[2][2], voAn[2][2];
#pragma unroll
    for (int h = 0; h < 2; ++h)
#pragma unroll
        for (int i = 0; i < 2; ++i) { voAc[h][i] = GATHER ? sch.aoff(cur, 128 * h + Rr[i]) + (unsigned)Cc[i] * 2u : 0u; voAn[h][i] = voAc[h][i]; }
    const char* cA = sch.abase(cur); const char* cB = sch.bbase(cur);
    PG8_STAGE_B(PG8_SB(0, 0), cB); PG8_STAGE_A(PG8_SA(0, 0), cA, 0, voAc); PG8_STAGE_B(PG8_SB(0, 1), cB + hstep); PG8_STAGE_A(PG8_SA(0, 1), cA, 1, voAc);
    if (wr == 1) PG8_BAR;
    PG8_WAIT_V(4); PG8_BAR;
    PG8_STAGE_B(PG8_SB(1, 0), cB + kstep); PG8_STAGE_A(PG8_SA(1, 0), cA + kstep, 0, voAc); PG8_STAGE_B(PG8_SB(1, 1), cB + hstep + kstep);
    PG8_WAIT_V(6); PG8_BAR;
    for (;;) {
        const bool has_next = sch.next(ui + 1, nxt);
        const char* nA = has_next ? sch.abase(nxt) : cA; const char* nB = has_next ? sch.bbase(nxt) : cB;
        if (GATHER) {
#pragma unroll
            for (int h = 0; h < 2; ++h)
#pragma unroll
                for (int i = 0; i < 2; ++i) voAn[h][i] = has_next ? sch.aoff(nxt, 128 * h + Rr[i]) + (unsigned)Cc[i] * 2u : voAc[h][i];
        }
        for (int t = 0; t < nt; t += 2) {
            const bool last = (t == nt - 2);
            const char* a1 = cA + (size_t)(t + 1) * kstep;
            const char* a2 = last ? nA : cA + (size_t)(t + 2) * kstep; const char* b2 = last ? nB : cB + (size_t)(t + 2) * kstep;
            const char* a3 = a2 + kstep; const char* b3 = b2 + kstep;
            unsigned vo2[2][2];
#pragma unroll
            for (int h = 0; h < 2; ++h)
#pragma unroll
                for (int i = 0; i < 2; ++i) vo2[h][i] = last ? voAn[h][i] : voAc[h][i];
            PG8_LDB(B0, 0, 0); PG8_SCHED; PG8_LDA(At, 0, 0); PG8_STAGE_A(PG8_SA(1, 1), a1, 1, voAc);
            PG8_WAIT_L(8); PG8_BAR; PG8_WAIT_L(0); PG8_MMA(0, 0, At, B0); PG8_BAR; PG8_SCHED;
            PG8_LDB(B1, 0, 1); PG8_STAGE_B(PG8_SB(0, 0), b2);
            PG8_BAR; PG8_WAIT_L(0); PG8_MMA(0, 1, At, B1); PG8_BAR;
            PG8_LDA(At, 0, 1); PG8_STAGE_A(PG8_SA(0, 0), a2, 0, vo2);
            PG8_BAR; PG8_WAIT_L(0); PG8_MMA(1, 0, At, B0); PG8_BAR; PG8_SCHED;
            PG8_STAGE_B(PG8_SB(0, 1), b2 + hstep);
            PG8_WAIT_V(6); PG8_BAR; PG8_MMA(1, 1, At, B1); PG8_BAR;
            PG8_LDB(B0, 1, 0); PG8_SCHED; PG8_LDA(At, 1, 0); PG8_STAGE_A(PG8_SA(0, 1), a2, 1, vo2);
            PG8_WAIT_L(8); PG8_BAR; PG8_WAIT_L(0); PG8_MMA(0, 0, At, B0); PG8_BAR; PG8_SCHED;
            PG8_LDB(B1, 1, 1); PG8_STAGE_B(PG8_SB(1, 0), b3);
            PG8_BAR; PG8_WAIT_L(0); PG8_MMA(0, 1, At, B1); PG8_BAR;
            PG8_LDA(At, 1, 1); PG8_STAGE_A(PG8_SA(1, 0), a3, 0, vo2);
            PG8_BAR; PG8_WAIT_L(0); PG8_MMA(1, 0, At, B0); PG8_BAR; PG8_SCHED;
            PG8_STAGE_B(PG8_SB(1, 1), b3 + hstep);
            PG8_WAIT_V(6); PG8_BAR; PG8_MMA(1, 1, At, B1); PG8_BAR;
        }
#pragma unroll
        for (int ai = 0; ai < 2; ++ai)
#pragma unroll
            for (int m = 0; m < 4; ++m)
#pragma unroll
                for (int n = 0; n < 2; ++n) epi(cur, ai * 128 + wr * 64 + m * 16 + fr, wc * 32 + n * 16 + 4 * fq, acc[ai][0][m][n], acc[ai][1][m][n]);
        if (!has_next) break;
#pragma unroll
        for (int a = 0; a < 2; ++a)
#pragma unroll
            for (int b = 0; b < 2; ++b)
#pragma unroll
                for (int m = 0; m < 4; ++m)
#pragma unroll
                    for (int n = 0; n < 2; ++n) acc[a][b][m][n] = (f32x4){0.f, 0.f, 0.f, 0.f};
        cur = nxt; cA = nA; cB = nB; ++ui;
#pragma unroll
        for (int h = 0; h < 2; ++h)
#pragma unroll
            for (int i = 0; i < 2; ++i) voAc[h][i] = voAn[h][i];
    }
    PG8_WAIT_V(0);
    if (wr == 0) PG8_BAR;
    PG8_BAR;
#undef PG8_SA
#undef PG8_SB
#undef PG8_STAGE_A
#undef PG8_STAGE_B
#undef PG8_LDA
#undef PG8_LDB
#undef PG8_MMA
#undef PG8_WAIT_V
#undef PG8_WAIT_L
#undef PG8_BAR
#undef PG8_SCHED
}

struct SchG1 { const bf16_t *A, *Bt; int G, c, K;
    __device__ __forceinline__ bool next(int i, Unit& u) const { const int L = i * G + c; if (L >= 128 * 24) return false; u.pm = L / 24; u.pn = L % 24; return true; }
    __device__ __forceinline__ const bf16_t* arow(const Unit& u, int r) const { return A + (size_t)(u.pm * 256 + r) * 1024; }
    __device__ __forceinline__ const bf16_t* brow(const Unit& u, int n) const { return Bt + (size_t)(u.pn * 256 + n) * 1024; }
    __device__ __forceinline__ const char* abase(const Unit& u) const { return (const char*)(A + (size_t)u.pm * 256 * 1024); }
    __device__ __forceinline__ const char* bbase(const Unit& u) const { return (const char*)(Bt + (size_t)u.pn * 256 * 1024); }
    __device__ __forceinline__ unsigned aoff(const Unit&, int) const { return 0u; } };
struct EpiG1 { bf16_t *Z, *GYG, *XR, *SGA, *SGB; const float* bias;
    __device__ __forceinline__ void operator()(const Unit& u, int r, int j, f32x4 v0, f32x4 v1) const {
        const size_t row = (size_t)u.pm * 256 + r; const int cb = u.pn * 256 + j;
        v0 += *(const f32x4*)(bias + cb); v1 += *(const f32x4*)(bias + cb + 128);
        if (u.pn < 8) { f32x4 z;
#pragma unroll
            for (int e = 0; e < 4; ++e) z[e] = v0[e] * sigm(v1[e]);
            *(u32x2*)(Z + row * 1024 + u.pn * 128 + j) = pk4(z); }
        else { const int kind = u.pn >> 2;
            bf16_t* dst = GYG + (size_t)(kind - 2) * (SLOT / 2);
#pragma unroll
            for (int e = 0; e < 4; ++e) { if (kind == 2) { v0[e] = gelu_tanh(v0[e]); v1[e] = gelu_tanh(v1[e]); } else if (kind >= 4) { v0[e] = sigm(v0[e]); v1[e] = sigm(v1[e]); } }
            bf16_t* o = dst + row * 1024 + (u.pn & 3) * 256 + j;
            *(u32x2*)o = pk4(v0); *(u32x2*)(o + 128) = pk4(v1); }
    } };
struct SchCtx { const bf16_t *A, *Bt; int G, c, K;
    __device__ __forceinline__ bool next(int i, Unit& u) const { const int L = i * G + c; if (L >= 16) return false; u.pm = L / 4; u.pn = L % 4; return true; }
    __device__ __forceinline__ const bf16_t* arow(const Unit& u, int r) const { return A + (size_t)(u.pm * 256 + r) * 1024; }
    __device__ __forceinline__ const bf16_t* brow(const Unit& u, int n) const { return Bt + (size_t)((12 + u.pn) * 256 + n) * 1024; }
    __device__ __forceinline__ const char* abase(const Unit& u) const { return (const char*)(A + (size_t)u.pm * 256 * 1024); }
    __device__ __forceinline__ const char* bbase(const Unit& u) const { return (const char*)(Bt + (size_t)(12 + u.pn) * 256 * 1024); }
    __device__ __forceinline__ unsigned aoff(const Unit&, int) const { return 0u; } };
struct EpiCtx { bf16_t* XRC; const float* bias;
    __device__ __forceinline__ void operator()(const Unit& u, int r, int j, f32x4 v0, f32x4 v1) const {
        const size_t row = (size_t)u.pm * 256 + r; const int cb = (12 + u.pn) * 256 + j;
        v0 += *(const f32x4*)(bias + cb); v1 += *(const f32x4*)(bias + cb + 128);
        bf16_t* o = XRC + row * 1024 + u.pn * 256 + j; *(u32x2*)o = pk4(v0); *(u32x2*)(o + 128) = pk4(v1); } };
struct SchG2 { const bf16_t *Aa, *Ab, *Wa, *Wb; int G, c, K;
    __device__ __forceinline__ bool next(int i, Unit& u) const { const int t = (i >> 1) * G + c; if (t >= 512) return false; u.pm = t >> 2; u.pn = t & 3; u.aux = i & 1; return true; }
    __device__ __forceinline__ const bf16_t* arow(const Unit& u, int r) const { return Aa + (size_t)u.aux * (SLOT / 2) + (size_t)(u.pm * 256 + r) * 1024; }
    __device__ __forceinline__ const bf16_t* brow(const Unit& u, int n) const { return Wa + (size_t)u.aux * (1024 * 1024) + (size_t)(u.pn * 256 + n) * 1024; }
    __device__ __forceinline__ const char* abase(const Unit& u) const { return (const char*)(Aa + (size_t)u.aux * (SLOT / 2) + (size_t)u.pm * 256 * 1024); }
    __device__ __forceinline__ const char* bbase(const Unit& u) const { return (const char*)(Wa + (size_t)u.aux * (1024 * 1024) + (size_t)u.pn * 256 * 1024); }
    __device__ __forceinline__ unsigned aoff(const Unit&, int) const { return 0u; } };
struct EpiG2 { const bf16_t *SGA, *SGB; bf16_t* M;
    __device__ __forceinline__ void operator()(const Unit& u, int r, int j, f32x4 v0, f32x4 v1) const {
        const size_t o = ((size_t)u.pm * 256 + r) * 1024 + u.pn * 256 + j;
        const bf16_t* G = SGA + (size_t)u.aux * (SLOT / 2);
        const u32x2 g0 = *(const u32x2*)(G + o), g1 = *(const u32x2*)(G + o + 128);
        f32x4 r0, r1;
        r0[0] = bflo(g0.x) * v0[0]; r0[1] = bfhi(g0.x) * v0[1]; r0[2] = bflo(g0.y) * v0[2]; r0[3] = bfhi(g0.y) * v0[3];
        r1[0] = bflo(g1.x) * v1[0]; r1[1] = bfhi(g1.x) * v1[1]; r1[2] = bflo(g1.y) * v1[2]; r1[3] = bfhi(g1.y) * v1[3];
        if (u.aux) { const u32x2 t0 = *(const u32x2*)(M + o), t1 = *(const u32x2*)(M + o + 128);
            r0[0] += bflo(t0.x); r0[1] += bfhi(t0.x); r0[2] += bflo(t0.y); r0[3] += bfhi(t0.y);
            r1[0] += bflo(t1.x); r1[1] += bfhi(t1.x); r1[2] += bflo(t1.y); r1[3] += bfhi(t1.y); }
        *(u32x2*)(M + o) = pk4(r0); *(u32x2*)(M + o + 128) = pk4(r1); } };
struct SchG3 { const bf16_t *A, *Bt; int G, c, K;
    __device__ __forceinline__ bool next(int i, Unit& u) const { const int L = i * G + c; if (L >= 512) return false; u.pm = L >> 2; u.pn = L & 3; return true; }
    __device__ __forceinline__ const bf16_t* arow(const Unit& u, int r) const { return A + (size_t)(u.pm * 256 + r) * 1024; }
    __device__ __forceinline__ const bf16_t* brow(const Unit& u, int n) const { return Bt + (size_t)(u.pn * 256 + n) * 1024; }
    __device__ __forceinline__ const char* abase(const Unit& u) const { return (const char*)(A + (size_t)u.pm * 256 * 1024); }
    __device__ __forceinline__ const char* bbase(const Unit& u) const { return (const char*)(Bt + (size_t)u.pn * 256 * 1024); }
    __device__ __forceinline__ unsigned aoff(const Unit&, int) const { return 0u; } };
struct EpiG3 { const float *X, *MOD; float* X1;
    __device__ __forceinline__ void operator()(const Unit& u, int r, int j, f32x4 v0, f32x4 v1) const {
        const int row = u.pm * 256 + r, col = u.pn * 256 + j; const size_t o = (size_t)row * 1024 + col;
        const float* gt = MOD + (row / SEQ) * 6144 + 2 * 1024 + col;
        *(f32x4*)(X1 + o) = *(const f32x4*)(X + o) + *(const f32x4*)gt * v0;
        *(f32x4*)(X1 + o + 128) = *(const f32x4*)(X + o + 128) + *(const f32x4*)(gt + 128) * v1; } };
struct MoeMeta { const int* m;
    __device__ __forceinline__ int cnt(int e) const { return m[e]; }
    __device__ __forceinline__ int tb(int e) const { return m[16 + e]; }
    __device__ __forceinline__ int find(int mt) const { int e = 0;
#pragma unroll
        for (int k = 1; k < 16; ++k) e += (m[16 + k] <= mt) ? 1 : 0;
        return e; } };
__device__ __forceinline__ void moe_meta_build(const Params& p, int* meta) {
    if (threadIdx.x == 0) { const unsigned* cnt = (const unsigned*)(p.ws + OFF_CTL); int t = 0;
        for (int e = 0; e < 16; ++e) { const int c = (int)__hip_atomic_load(cnt + e, __ATOMIC_RELAXED, __HIP_MEMORY_SCOPE_AGENT); meta[e] = c; meta[16 + e] = t; t += (c + 255) >> 8; }
        meta[32] = t; }
    __syncthreads();
}
struct SchUp { const bf16_t *HM, *W; const int* LIST; MoeMeta mm; int G, c, K; const int* idx;
    __device__ __forceinline__ bool next(int i, Unit& u) const { const int L = i * G + c; if (L >= 4 * mm.m[32]) return false; const int mt = L >> 2; u.pn = L & 3; u.aux = mm.find(mt); u.aux2 = (mt - mm.tb(u.aux)) * 256; u.pm = mt | (i << 16); return true; }
    __device__ __forceinline__ const char* abase(const Unit&) const { return (const char*)HM; }
    __device__ __forceinline__ const char* bbase(const Unit& u) const { return (const char*)(W + ((size_t)u.aux * 1024 + u.pn * 256) * 1024); }
    __device__ __forceinline__ unsigned aoff(const Unit& u, int r) const { return (unsigned)idx[(u.pm >> 16) * 256 + r] * 2048u; }
    __device__ __forceinline__ const bf16_t* arow(const Unit& u, int r) const { int pos = u.aux2 + r; const int c = mm.cnt(u.aux); pos = pos < c ? pos : c - 1; return HM + (size_t)LIST[u.aux * NT + pos] * 1024; }
    __device__ __forceinline__ const bf16_t* brow(const Unit& u, int n) const { return W + ((size_t)u.aux * 1024 + u.pn * 256 + n) * 1024; } };
struct EpiUp { bf16_t* ACT; const float* WL; MoeMeta mm;
    __device__ __forceinline__ void operator()(const Unit& u, int r, int j, f32x4 g, f32x4 up) const {
        const int pos = u.aux2 + r; if (pos >= mm.cnt(u.aux)) return;
        const float wt = WL[u.aux * NT + pos]; f32x4 a;
#pragma unroll
        for (int e = 0; e < 4; ++e) a[e] = silu(g[e]) * up[e] * wt;
        *(u32x2*)(ACT + ((size_t)(u.pm & 0xffff) * 256 + r) * 512 + u.pn * 128 + j) = pk4(a); } };
struct SchDn { const bf16_t *ACT, *W; MoeMeta mm; int G, c, K;
    __device__ __forceinline__ bool next(int i, Unit& u) const { const int L = i * G + c; if (L >= 4 * mm.m[32]) return false; const int mt = L >> 2; u.pn = L & 3; u.aux = mm.find(mt); u.aux2 = (mt - mm.tb(u.aux)) * 256; u.pm = mt; return true; }
    __device__ __forceinline__ const bf16_t* arow(const Unit& u, int r) const { return ACT + ((size_t)u.pm * 256 + r) * 512; }
    __device__ __forceinline__ const bf16_t* brow(const Unit& u, int n) const { return W + ((size_t)u.aux * 1024 + u.pn * 256 + n) * 512; }
    __device__ __forceinline__ const char* abase(const Unit& u) const { return (const char*)(ACT + (size_t)u.pm * 256 * 512); }
    __device__ __forceinline__ const char* bbase(const Unit& u) const { return (const char*)(W + ((size_t)u.aux * 1024 + u.pn * 256) * 512); }
    __device__ __forceinline__ unsigned aoff(const Unit&, int) const { return 0u; } };
struct EpiDn { bf16_t* Y; MoeMeta mm;
    __device__ __forceinline__ void operator()(const Unit& u, int r, int j, f32x4 v0, f32x4 v1) const {
        if (u.aux2 + r >= mm.cnt(u.aux)) return;
        bf16_t* o = Y + ((size_t)u.pm * 256 + r) * 1024 + u.pn * 256 + j; *(u32x2*)o = pk4(v0); *(u32x2*)(o + 128) = pk4(v1); } };

__device__ __forceinline__ void aprep_item(const Params& p, int g, unsigned char* lds) {
    const int tid = threadIdx.x, lane = tid & 63, wave = tid >> 6;
    const bf16_t* Z = (const bf16_t*)(p.ws + OFF_SLOT + 1 * SLOT);
    bf16_t* AA = (bf16_t*)(p.ws + OFF_SLOT + 0 * SLOT);
    unsigned* zt = (unsigned*)lds;
    { const u32x4* src = (const u32x4*)(Z + (size_t)g * 64 * 1024); u32x4* d = (u32x4*)lds;
#pragma unroll 4
        for (int i = tid; i < 8192; i += NTHR) d[i] = src[i]; }
    __syncthreads();
    {
        float w0[31], w1[31];
        const float* cw = p.in[I_CONVW] + 2 * tid;
#pragma unroll
        for (int k = 0; k < 31; ++k) { const f32x2 t = *(const f32x2*)(cw + k * 1024); w0[k] = t.x; w1[k] = t.y; }
        const f32x2 cb = *(const f32x2*)(p.in[I_CONVB] + 2 * tid);
        float p0[16], p1[16];
#pragma unroll
        for (int o = 0; o < 16; ++o) { p0[o] = 0.f; p1[o] = 0.f; }
#pragma unroll
        for (int tb = 0; tb < 5; ++tb) {
            float c0[16], c1[16];
#pragma unroll
            for (int o = 0; o < 16; ++o) { c0[o] = cb.x; c1[o] = cb.y; }
            if (tb < 4) {
#pragma unroll
                for (int r0 = 0; r0 < 48; r0 += 8) {
                    unsigned vv[8];
#pragma unroll
                    for (int rr = 0; rr < 8; ++rr) { const int row = 16 * tb - 15 + r0 + rr; vv[rr] = (r0 + rr < 46 && row >= 0 && row < 64) ? zt[row * 512 + tid] : 0u; }
#pragma unroll
                    for (int rr = 0; rr < 8; ++rr) { const int r = r0 + rr, row = 16 * tb - 15 + r;
                        if (r < 46 && row >= 0 && row < 64) { const float x0 = bflo(vv[rr]), x1 = bfhi(vv[rr]);
#pragma unroll
                            for (int o = 0; o < 16; ++o) { const int k = r - o; if (k >= 0 && k < 31) { c0[o] += w0[k] * x0; c1[o] += w1[k] * x1; } } } }
                    asm volatile("" ::: "memory");
                }
            }
            if (tb > 0) {
#pragma unroll
                for (int o = 0; o < 16; ++o) zt[(16 * (tb - 1) + o) * 512 + tid] = pk2(p0[o], p1[o]);
            }
#pragma unroll
            for (int o = 0; o < 16; ++o) { p0[o] = c0[o]; p1[o] = c1[o]; }
        }
    }
    __syncthreads();
    for (int rr = 0; rr < 8; ++rr) {
        const int row = wave * 8 + rr;
        const u32x4 a = *(const u32x4*)(lds + row * 2048 + lane * 16), b = *(const u32x4*)(lds + row * 2048 + 1024 + lane * 16);
        float x[16];
        x[0] = bflo(a.x); x[1] = bfhi(a.x); x[2] = bflo(a.y); x[3] = bfhi(a.y); x[4] = bflo(a.z); x[5] = bfhi(a.z); x[6] = bflo(a.w); x[7] = bfhi(a.w);
        x[8] = bflo(b.x); x[9] = bfhi(b.x); x[10] = bflo(b.y); x[11] = bfhi(b.y); x[12] = bflo(b.z); x[13] = bfhi(b.z); x[14] = bflo(b.w); x[15] = bfhi(b.w);
        float s = 0.f;
#pragma unroll
        for (int e = 0; e < 16; ++e) s += x[e];
        const float mean = wave_sum(s) * (1.0f / 1024.0f);
        float q = 0.f;
#pragma unroll
        for (int e = 0; e < 16; ++e) { x[e] -= mean; q += x[e] * x[e]; }
        const float rstd = rsqrtf(wave_sum(q) * (1.0f / 1024.0f) + 1e-6f);
        float y[16];
#pragma unroll
        for (int hh = 0; hh < 2; ++hh) { const int c0 = hh * 512 + lane * 8;
            const f32x4 g0 = *(const f32x4*)(p.in[I_LNG] + c0), g1 = *(const f32x4*)(p.in[I_LNG] + c0 + 4), b0 = *(const f32x4*)(p.in[I_LNB] + c0), b1 = *(const f32x4*)(p.in[I_LNB] + c0 + 4);
#pragma unroll
            for (int e = 0; e < 4; ++e) { y[hh * 8 + e] = silu(x[hh * 8 + e] * rstd * g0[e] + b0[e]); y[hh * 8 + 4 + e] = silu(x[hh * 8 + 4 + e] * rstd * g1[e] + b1[e]); } }
        bf16_t* o = AA + ((size_t)g * 64 + row) * 1024 + lane * 8;
        u32x4 o0, o1; o0.x = pk2(y[0], y[1]); o0.y = pk2(y[2], y[3]); o0.z = pk2(y[4], y[5]); o0.w = pk2(y[6], y[7]);
        o1.x = pk2(y[8], y[9]); o1.y = pk2(y[10], y[11]); o1.z = pk2(y[12], y[13]); o1.w = pk2(y[14], y[15]);
        *(u32x4*)o = o0; *(u32x4*)(o + 512) = o1;
    }
    __syncthreads();
}

constexpr int XC_STRIDE = 272;
constexpr int YB_STRIDE = 132;
constexpr int B_XC_OFF = 0, B_HIN_OFF = 256 * XC_STRIDE  , B_Y_OFF = B_HIN_OFF + 4096  , B_Y_BYTES = 64 * YB_STRIDE * 4  ;
constexpr size_t OFF_TOT256 = OFF_TOT + 9 * MiB;

__device__ __forceinline__ void lru_coef(float lr, float li, float nsp, float xcv, float& a, float& b) {
    const float la = nsp * sigm(lr);
    a = __expf(la);
    const float am1 = la > -0.25f ? la * (1.0f + la * (0.5f + la * (0.16666667f + la * (0.041666668f + la * 0.008333334f)))) : a - 1.0f;
    b = __builtin_amdgcn_sqrtf(-am1 * (a + 1.0f)) * (sigm(li) * xcv);
}

template <bool FINAL>
__device__ __forceinline__ void b_item(const Params& p, int b, int c256, int h, unsigned char* lds) {
    const int tid = threadIdx.x, lane = tid & 63, wave = tid >> 6, fr = lane & 15, q = lane >> 4;
    const bool isctx = c256 < 0;
    const int seqlen = isctx ? CTXL : SEQ, sbase = isctx ? 0 : c256 * 256;
    const bf16_t* src = isctx ? (const bf16_t*)(p.ws + OFF_XRC) + (size_t)b * CTXL * 1024 : (const bf16_t*)(p.ws + OFF_SLOT + 3 * SLOT) + (size_t)b * SEQ * 1024;
    const int kc0 = isctx ? 0 : 4 + c256 * 4, k256 = isctx ? 0 : 1 + c256;
    f32x2* TOT = (f32x2*)(p.ws + OFF_TOT);
    f32x2* TOT256 = (f32x2*)(p.ws + OFF_TOT256);
    const bf16_t* WG = (const bf16_t*)(p.ws + OFF_WG);
    float* hin = (float*)(lds + B_HIN_OFF);
    const int chl = 16 * wave + fr, ch = h * 128 + chl;
    const float brf = p.in[I_BRF][ch], bif = p.in[I_BIF][ch], brb = p.in[I_BRB][ch], bib = p.in[I_BIB][ch];
    const float nspf = -8.0f * log1pf(__expf(-p.in[I_LAMF][ch])), nspb = -8.0f * log1pf(__expf(-p.in[I_LAMB][ch]));
    float runAf = 1.f, runBf = 0.f, runAb = 1.f, runBb = 0.f;
    if (FINAL) {
        if (tid < 256) { const int dir = tid >> 7, cl = tid & 127, cg_ = h * 128 + cl; float hc = 0.f;
            const f32x2* T2 = TOT256 + ((size_t)b * 33 * 2 + dir) * 1024 + cg_;
            const f32x2* T = TOT + ((size_t)b * NCH64 * 2 + dir) * 1024 + cg_;
            if (dir == 0) {
                for (int k0 = 0; k0 < k256; k0 += 8) { f32x2 t[8];
#pragma unroll
                    for (int j = 0; j < 8; ++j) t[j] = (k0 + j < k256) ? T2[(size_t)(k0 + j) * 2048] : (f32x2){1.f, 0.f};
#pragma unroll
                    for (int j = 0; j < 8; ++j) hc = t[j].x * hc + t[j].y; }
                f32x2 ts[4];
#pragma unroll
                for (int s = 0; s < 4; ++s) ts[s] = T[(size_t)(kc0 + s) * 2048];
#pragma unroll
                for (int s = 0; s < 4; ++s) { hin[(s * 2 + 0) * 128 + cl] = hc; hc = ts[s].x * hc + ts[s].y; }
            } else {
                { const f32x2 t = T2[0]; hc = t.y; }
                for (int k0 = 32; k0 > k256; k0 -= 8) { f32x2 t[8];
#pragma unroll
                    for (int j = 0; j < 8; ++j) t[j] = (k0 - j > k256) ? T2[(size_t)(k0 - j) * 2048] : (f32x2){1.f, 0.f};
#pragma unroll
                    for (int j = 0; j < 8; ++j) hc = t[j].x * hc + t[j].y; }
                f32x2 ts[4];
#pragma unroll
                for (int s = 0; s < 4; ++s) ts[s] = T[(size_t)(kc0 + s) * 2048];
#pragma unroll
                for (int s = 3; s >= 0; --s) { hin[(s * 2 + 1) * 128 + cl] = hc; hc = ts[s].x * hc + ts[s].y; }
            }
        }
        __syncthreads();
    }
    {
        const int cgp = tid & 7, c0 = h * 128 + 16 * cgp;
        float wk[4][16], bs[16];
        { const f32x4* bp = (const f32x4*)(p.in[I_LCB] + c0);
#pragma unroll
            for (int e4 = 0; e4 < 4; ++e4) { const f32x4 t = bp[e4]; bs[4 * e4] = t[0]; bs[4 * e4 + 1] = t[1]; bs[4 * e4 + 2] = t[2]; bs[4 * e4 + 3] = t[3]; }
#pragma unroll
            for (int k = 0; k < 4; ++k) { const f32x4* wp = (const f32x4*)(p.in[I_LCW] + k * 1024 + c0);
#pragma unroll
                for (int e4 = 0; e4 < 4; ++e4) { const f32x4 t = wp[e4]; wk[k][4 * e4] = t[0]; wk[k][4 * e4 + 1] = t[1]; wk[k][4 * e4 + 2] = t[2]; wk[k][4 * e4 + 3] = t[3]; } } }
#pragma unroll
        for (int r = 0; r < 4; ++r) {
            const int tt = (tid >> 3) + 64 * r;
            float xc[16];
#pragma unroll
            for (int e = 0; e < 16; ++e) xc[e] = bs[e];
#pragma unroll
            for (int k = 0; k < 4; ++k) {
                const int row = sbase + tt + k - 2;
                if (row >= 0 && row < seqlen) {
                    const u32x4 a = *(const u32x4*)(src + (size_t)row * 1024 + c0), bb = *(const u32x4*)(src + (size_t)row * 1024 + c0 + 8);
                    xc[0] += wk[k][0] * bflo(a.x); xc[1] += wk[k][1] * bfhi(a.x); xc[2] += wk[k][2] * bflo(a.y); xc[3] += wk[k][3] * bfhi(a.y);
                    xc[4] += wk[k][4] * bflo(a.z); xc[5] += wk[k][5] * bfhi(a.z); xc[6] += wk[k][6] * bflo(a.w); xc[7] += wk[k][7] * bfhi(a.w);
                    xc[8] += wk[k][8] * bflo(bb.x); xc[9] += wk[k][9] * bfhi(bb.x); xc[10] += wk[k][10] * bflo(bb.y); xc[11] += wk[k][11] * bfhi(bb.y);
                    xc[12] += wk[k][12] * bflo(bb.z); xc[13] += wk[k][13] * bfhi(bb.z); xc[14] += wk[k][14] * bflo(bb.w); xc[15] += wk[k][15] * bfhi(bb.w);
                }
            }
            u32x4 o0, o1; o0.x = pk2(xc[0], xc[1]); o0.y = pk2(xc[2], xc[3]); o0.z = pk2(xc[4], xc[5]); o0.w = pk2(xc[6], xc[7]);
            o1.x = pk2(xc[8], xc[9]); o1.y = pk2(xc[10], xc[11]); o1.z = pk2(xc[12], xc[13]); o1.w = pk2(xc[14], xc[15]);
            *(u32x4*)(lds + B_XC_OFF + tt * XC_STRIDE + cgp * 32) = o0; *(u32x4*)(lds + B_XC_OFF + tt * XC_STRIDE + cgp * 32 + 16) = o1;
        }
    }
    __syncthreads();
    for (int sub = 0; sub < 4; ++sub) {
        const int t0 = sbase + 64 * sub;
        const unsigned char* xcs = lds + B_XC_OFF + 64 * sub * XC_STRIDE;
        float* ybuf = (float*)(lds + B_Y_OFF + (sub & 1) * B_Y_BYTES);
        bf16x8 fb[4][4];
#pragma unroll
        for (int ty = 0; ty < 4; ++ty)
#pragma unroll
            for (int kk = 0; kk < 4; ++kk) fb[ty][kk] = *(const bf16x8*)(WG + (size_t)(h * 512 + wave * 64 + ty * 16 + fr) * 128 + 32 * kk + 8 * q);
        const int ot = tid >> 3, oc = (tid & 7) * 16;
        u32x4 gy0, gy1;
        if (FINAL) { const bf16_t* GYG = (const bf16_t*)(p.ws + OFF_SLOT + 2 * SLOT) + ((size_t)b * SEQ + t0 + ot) * 1024 + h * 128 + oc;
            gy0 = *(const u32x4*)GYG; gy1 = *(const u32x4*)(GYG + 8); }
        f32x4 acc[4][4];
#pragma unroll
        for (int m = 0; m < 4; ++m)
#pragma unroll
            for (int ty = 0; ty < 4; ++ty) acc[m][ty] = (f32x4){0.f, 0.f, 0.f, 0.f};
#pragma unroll
        for (int kk = 0; kk < 4; ++kk) {
            bf16x8 fa[4];
#pragma unroll
            for (int m = 0; m < 4; ++m) fa[m] = *(const bf16x8*)(xcs + (16 * m + fr) * XC_STRIDE + (32 * kk + 8 * q) * 2);
#pragma unroll
            for (int ty = 0; ty < 4; ++ty)
#pragma unroll
                for (int m = 0; m < 4; ++m) acc[m][ty] = __builtin_amdgcn_mfma_f32_16x16x32_bf16(fa[m], fb[ty][kk], acc[m][ty], 0, 0, 0);
        }
#pragma unroll
        for (int m = 0; m < 4; ++m)
#pragma unroll
            for (int i = 0; i < 4; ++i) {
                const float xcv = bf2f(*(const bf16_t*)(xcs + (16 * m + 4 * q + i) * XC_STRIDE + chl * 2));
                float a0, b0, a1, b1;
                lru_coef(acc[m][0][i] + brf, acc[m][1][i] + bif, nspf, xcv, a0, b0);
                lru_coef(acc[m][2][i] + brb, acc[m][3][i] + bib, nspb, xcv, a1, b1);
                acc[m][0][i] = a0; acc[m][1][i] = b0; acc[m][2][i] = a1; acc[m][3][i] = b1;
            }
        float At[4], Bt[4], Ae[4], Be[4];
#pragma unroll
        for (int m = 0; m < 4; ++m) {
            float A = 1.f, B = 0.f;
#pragma unroll
            for (int i = 0; i < 4; ++i) { B = acc[m][0][i] * B + acc[m][1][i]; A = acc[m][0][i] * A; }
            float tA = __shfl_up(A, 16), tB = __shfl_up(B, 16); if (q >= 1) { B = A * tB + B; A = A * tA; }
            tA = __shfl_up(A, 32); tB = __shfl_up(B, 32); if (q >= 2) { B = A * tB + B; A = A * tA; }
            Ae[m] = __shfl_up(A, 16); Be[m] = __shfl_up(B, 16); if (q == 0) { Ae[m] = 1.f; Be[m] = 0.f; }
            At[m] = __shfl(A, 48 + fr); Bt[m] = __shfl(B, 48 + fr);
        }
        if (!FINAL) {
            float A = 1.f, B = 0.f;
#pragma unroll
            for (int m = 0; m < 4; ++m) { B = At[m] * B + Bt[m]; A = At[m] * A; }
            if (q == 0) TOT[((size_t)(b * NCH64 + kc0 + sub) * 2 + 0) * 1024 + ch] = (f32x2){A, B};
            runBf = A * runBf + B; runAf = A * runAf;
        } else {
            float hh = hin[(sub * 2 + 0) * 128 + chl];
#pragma unroll
            for (int m = 0; m < 4; ++m) {
                float hs = Ae[m] * hh + Be[m];
#pragma unroll
                for (int i = 0; i < 4; ++i) { hs = acc[m][0][i] * hs + acc[m][1][i]; acc[m][0][i] = hs; }
                hh = At[m] * hh + Bt[m];
            }
        }
#pragma unroll
        for (int m = 0; m < 4; ++m) {
            float A = 1.f, B = 0.f;
#pragma unroll
            for (int i = 3; i >= 0; --i) { B = acc[m][2][i] * B + acc[m][3][i]; A = acc[m][2][i] * A; }
            float tA = __shfl_down(A, 16), tB = __shfl_down(B, 16); if (q <= 2) { B = A * tB + B; A = A * tA; }
            tA = __shfl_down(A, 32); tB = __shfl_down(B, 32); if (q <= 1) { B = A * tB + B; A = A * tA; }
            Ae[m] = __shfl_down(A, 16); Be[m] = __shfl_down(B, 16); if (q == 3) { Ae[m] = 1.f; Be[m] = 0.f; }
            At[m] = __shfl(A, fr); Bt[m] = __shfl(B, fr);
        }
        if (!FINAL) {
            float A = 1.f, B = 0.f;
#pragma unroll
            for (int m = 3; m >= 0; --m) { B = At[m] * B + Bt[m]; A = At[m] * A; }
            if (q == 0) TOT[((size_t)(b * NCH64 + kc0 + sub) * 2 + 1) * 1024 + ch] = (f32x2){A, B};
            runBb = runAb * B + runBb; runAb = runAb * A;
        } else {
            float hh = hin[(sub * 2 + 1) * 128 + chl];
#pragma unroll
            for (int m = 3; m >= 0; --m) {
                float hs = Ae[m] * hh + Be[m];
#pragma unroll
                for (int i = 3; i >= 0; --i) { hs = acc[m][2][i] * hs + acc[m][3][i]; acc[m][2][i] = hs; }
                hh = At[m] * hh + Bt[m];
            }
#pragma unroll
            for (int m = 0; m < 4; ++m)
#pragma unroll
                for (int i = 0; i < 4; ++i) ybuf[(16 * m + 4 * q + i) * YB_STRIDE + chl] = acc[m][0][i] + acc[m][2][i];
            __syncthreads();
            const f32x4* yp = (const f32x4*)(ybuf + ot * YB_STRIDE + oc);
            const f32x4 y0 = yp[0], y1 = yp[1], y2 = yp[2], y3 = yp[3];
            u32x4 o0, o1;
            o0.x = pk2(bflo(gy0.x) * y0[0], bfhi(gy0.x) * y0[1]); o0.y = pk2(bflo(gy0.y) * y0[2], bfhi(gy0.y) * y0[3]);
            o0.z = pk2(bflo(gy0.z) * y1[0], bfhi(gy0.z) * y1[1]); o0.w = pk2(bflo(gy0.w) * y1[2], bfhi(gy0.w) * y1[3]);
            o1.x = pk2(bflo(gy1.x) * y2[0], bfhi(gy1.x) * y2[1]); o1.y = pk2(bflo(gy1.y) * y2[2], bfhi(gy1.y) * y2[3]);
            o1.z = pk2(bflo(gy1.z) * y3[0], bfhi(gy1.z) * y3[1]); o1.w = pk2(bflo(gy1.w) * y3[2], bfhi(gy1.w) * y3[3]);
            bf16_t* AB = (bf16_t*)(p.ws + OFF_SLOT + 1 * SLOT) + ((size_t)b * SEQ + t0 + ot) * 1024 + h * 128 + oc;
            *(u32x4*)AB = o0; *(u32x4*)(AB + 8) = o1;
        }
    }
    __syncthreads();
    if (!FINAL && q == 0) {
        TOT256[((size_t)(b * 33 + k256) * 2 + 0) * 1024 + ch] = (f32x2){runAf, runBf};
        TOT256[((size_t)(b * 33 + k256) * 2 + 1) * 1024 + ch] = (f32x2){runAb, runBb};
    }
}

__device__ __forceinline__ void ph8_route(const Params& p, int bid, int nb, unsigned char* lds) {
    const int tid = threadIdx.x, lane = tid & 63, wave = tid >> 6;
    float* Wl = (float*)lds;
    int* lcnt = (int*)(lds + 81920);
    int* lbase = lcnt + 16;
    int* tinfo = lcnt + 32;
    float* twt = (float*)(tinfo + 512);
    for (int i = tid; i < 1024 * 20; i += NTHR) { const int k = i / 20, o = i % 20; Wl[o * 1024 + k] = o < 4 ? p.in[I_WGRP][k * 4 + o] : p.in[I_WER][k * 16 + o - 4]; }
    __syncthreads();
    const float* MOD = (const float*)(p.ws + OFF_MOD);
    const float* X1 = p.out;
    bf16_t* HM = (bf16_t*)(p.ws + OFF_SLOT + 2 * SLOT);
    unsigned* gcnt = (unsigned*)(p.ws + OFF_CTL);
    int* LIST = (int*)(p.ws + OFF_LIST); float* WLs = (float*)(p.ws + OFF_WL); int* ROUTE = (int*)(p.ws + OFF_ROUTE);
    for (int tile = bid; tile < NT / 128; tile += nb) {
        if (tid < 16) lcnt[tid] = 0;
        __syncthreads();
        for (int tt = 0; tt < 16; ++tt) {
            const int tl = wave * 16 + tt, tok = tile * 128 + tl;
            const float* mrow = MOD + (tok / SEQ) * 6144;
            f32x4 v[4]; float ss = 0.f;
#pragma unroll
            for (int j = 0; j < 4; ++j) { v[j] = *(const f32x4*)(X1 + (size_t)tok * DM + lane * 4 + 256 * j); ss += v[j][0] * v[j][0] + v[j][1] * v[j][1] + v[j][2] * v[j][2] + v[j][3] * v[j][3]; }
            const float rinv = rsqrtf(wave_sum(ss) * (1.0f / DM) + 1e-6f);
            float lg[20];
#pragma unroll
            for (int o = 0; o < 20; ++o) lg[o] = 0.f;
#pragma unroll
            for (int j = 0; j < 4; ++j) { const int c = lane * 4 + 256 * j;
                const f32x4 g = *(const f32x4*)(p.in[I_GFFN] + c), sh = *(const f32x4*)(mrow + 3 * 1024 + c), sc = *(const f32x4*)(mrow + 4 * 1024 + c);
                f32x4 hm;
#pragma unroll
                for (int e = 0; e < 4; ++e) hm[e] = v[j][e] * rinv * g[e] * (1.0f + sc[e]) + sh[e];
#pragma unroll
                for (int o = 0; o < 20; ++o) { const f32x4 wv = *(const f32x4*)(Wl + o * 1024 + c); lg[o] += hm[0] * wv[0] + hm[1] * wv[1] + hm[2] * wv[2] + hm[3] * wv[3]; }
                *(u32x2*)(HM + (size_t)tok * DM + c) = pk4(hm); }
#pragma unroll
            for (int o = 0; o < 20; ++o) lg[o] = wave_sum(lg[o]);
#pragma unroll
            for (int o = 0; o < 4; ++o) lg[o] += p.in[I_BGRP][o];
#pragma unroll
            for (int o = 0; o < 16; ++o) lg[4 + o] += p.in[I_BER][o];
            int gs = 0; float gm = lg[0];
#pragma unroll
            for (int o = 1; o < 4; ++o) if (lg[o] > gm) { gm = lg[o]; gs = o; }
            float den = 0.f;
#pragma unroll
            for (int o = 0; o < 4; ++o) den += __expf(lg[o] - gm);
            const float pg = 1.0f / den;
            float el[4];
#pragma unroll
            for (int o = 0; o < 4; ++o) el[o] = gs == 0 ? lg[4 + o] : gs == 1 ? lg[8 + o] : gs == 2 ? lg[12 + o] : lg[16 + o];
            int i1 = 0; float v1 = el[0];
#pragma unroll
            for (int o = 1; o < 4; ++o) if (el[o] > v1) { v1 = el[o]; i1 = o; }
            int i2 = -1; float v2 = -3.0e38f;
#pragma unroll
            for (int o = 0; o < 4; ++o) if (o != i1 && el[o] > v2) { v2 = el[o]; i2 = o; }
            const float w1 = 1.0f / (1.0f + __expf(v2 - v1)), w2 = 1.0f - w1;
            if (lane == 0) { const int e1 = gs * 4 + i1, e2 = gs * 4 + i2;
                const int r1 = atomicAdd(&lcnt[e1], 1), r2 = atomicAdd(&lcnt[e2], 1);
                tinfo[tl * 4 + 0] = e1; tinfo[tl * 4 + 1] = r1; tinfo[tl * 4 + 2] = e2; tinfo[tl * 4 + 3] = r2; twt[tl * 2] = pg * w1; twt[tl * 2 + 1] = pg * w2; }
        }
        __syncthreads();
        if (tid < 16) lbase[tid] = (int)__hip_atomic_fetch_add(gcnt + tid, (unsigned)lcnt[tid], __ATOMIC_RELAXED, __HIP_MEMORY_SCOPE_AGENT);
        __syncthreads();
        if (tid < 128) { const int tok = tile * 128 + tid;
            const int e1 = tinfo[tid * 4], e2 = tinfo[tid * 4 + 2], p1 = lbase[e1] + tinfo[tid * 4 + 1], p2 = lbase[e2] + tinfo[tid * 4 + 3];
            LIST[e1 * NT + p1] = tok; LIST[e2 * NT + p2] = tok; WLs[e1 * NT + p1] = twt[tid * 2]; WLs[e2 * NT + p2] = twt[tid * 2 + 1];
            ROUTE[tok * 4 + 0] = e1; ROUTE[tok * 4 + 1] = p1; ROUTE[tok * 4 + 2] = e2; ROUTE[tok * 4 + 3] = p2; }
        __syncthreads();
    }
}

__device__ __forceinline__ void ph10_final(const Params& p, int bid, int nb, const int* meta) {
    const int lane = threadIdx.x & 63, wave = threadIdx.x >> 6;
    const float* MOD = (const float*)(p.ws + OFF_MOD);
    const bf16_t* Y = (const bf16_t*)(p.ws + OFF_SLOT);
    const int* ROUTE = (const int*)(p.ws + OFF_ROUTE);
    float* X1 = p.out;
    for (int r = bid * 8 + wave; r < NT; r += nb * 8) {
        const int e1 = ROUTE[r * 4], p1 = ROUTE[r * 4 + 1], e2 = ROUTE[r * 4 + 2], p2 = ROUTE[r * 4 + 3];
        const bf16_t* y1 = Y + ((size_t)meta[16 + e1] * 256 + p1) * 1024; const bf16_t* y2 = Y + ((size_t)meta[16 + e2] * 256 + p2) * 1024;
        const float* gt = MOD + (r / SEQ) * 6144 + 5 * 1024;
        f32x4 v[4]; float ss = 0.f;
#pragma unroll
        for (int j = 0; j < 4; ++j) { const int c = lane * 4 + 256 * j;
            v[j] = *(const f32x4*)(X1 + (size_t)r * DM + c);
            const u32x2 a = *(const u32x2*)(y1 + c), bq = *(const u32x2*)(y2 + c); const f32x4 g = *(const f32x4*)(gt + c);
            v[j][0] += g[0] * (bflo(a.x) + bflo(bq.x)); v[j][1] += g[1] * (bfhi(a.x) + bfhi(bq.x)); v[j][2] += g[2] * (bflo(a.y) + bflo(bq.y)); v[j][3] += g[3] * (bfhi(a.y) + bfhi(bq.y));
            ss += v[j][0] * v[j][0] + v[j][1] * v[j][1] + v[j][2] * v[j][2] + v[j][3] * v[j][3]; }
        const float rinv = rsqrtf(wave_sum(ss) * (1.0f / DM) + 1e-6f);
#pragma unroll
        for (int j = 0; j < 4; ++j) { const int c = lane * 4 + 256 * j; const f32x4 g = *(const f32x4*)(p.in[I_GFINAL] + c);
            *(f32x4*)(X1 + (size_t)r * DM + c) = v[j] * rinv * g; }
    }
}


#define XB_TMO      128
#define XB_XCNT(j)  (256  + 64 * (j))
#define XB_XSUB(j)  (1280 + 64 * (j))
#define XB_XGEN(j)  (2304 + 64 * (j))
#define XB_TOP      3328
#define XB_TOPGEN   3392
#define XCD_BAR_WORDS 3456
#define XB_SPIN_CAP (1u << 18)
__device__ __forceinline__ unsigned xb_ld(unsigned* p)              { return __hip_atomic_load(p, __ATOMIC_RELAXED, __HIP_MEMORY_SCOPE_AGENT); }
__device__ __forceinline__ unsigned xb_add(unsigned* p, unsigned v) { return __hip_atomic_fetch_add(p, v, __ATOMIC_RELAXED, __HIP_MEMORY_SCOPE_AGENT); }
__device__ __forceinline__ unsigned xb_xcc_id() { return (unsigned)__builtin_amdgcn_s_getreg((3 << 11) | 20) & 0xFu; }
#define XB_SPIN(cond, bar) do { unsigned _sp = 0; while (cond) { __builtin_amdgcn_s_sleep(1); \
    if ((++_sp & 255u) == 0u) { if (xb_ld(&(bar)[XB_TMO])) break; if (_sp > XB_SPIN_CAP) { atomicAdd(&(bar)[XB_TMO], 1u); break; } } } } while (0)
struct XcdBarrier { unsigned* bar; unsigned x; volatile unsigned* st; };
__device__ __forceinline__ XcdBarrier xcd_barrier_post(unsigned* bar, volatile unsigned* st) {
    XcdBarrier b; b.bar = bar; b.x = xb_xcc_id(); b.st = st;
    if (threadIdx.x == 0) (void)xb_add(&bar[XB_XCNT(b.x)], 1u);
    return b;
}
__device__ __forceinline__ void xcd_barrier_complete(unsigned* bar, unsigned x, unsigned& nloc, unsigned& nx) {
    const unsigned G = gridDim.x * gridDim.y * gridDim.z;
    unsigned sum, cnt, mine, sp = 0u;
    for (;;) {
        sum = 0u; cnt = 0u; mine = 0u;
#pragma unroll
        for (unsigned j = 0; j < 16; ++j) { const unsigned c = xb_ld(&bar[XB_XCNT(j)]); sum += c; cnt += (c > 0u) ? 1u : 0u; mine = (j == x) ? c : mine; }
        if (sum == G) break;
        __builtin_amdgcn_s_sleep(1);
        if ((++sp & 255u) == 0u) { if (xb_ld(&bar[XB_TMO])) break; if (sp > XB_SPIN_CAP) { atomicAdd(&bar[XB_TMO], 1u); break; } }
    }
    nloc = mine > 0u ? mine : 1u; nx = cnt > 0u ? cnt : 1u;
}
__device__ __forceinline__ void xcd_barrier(const XcdBarrier& b) {
    asm volatile("s_waitcnt vmcnt(0)" ::: "memory");
    __syncthreads();
    if (threadIdx.x == 0) {
        unsigned* bar = b.bar;
        __builtin_amdgcn_s_waitcnt(0);
        unsigned nloc = b.st[0], nx = b.st[1];
        if (nloc == 0u) { xcd_barrier_complete(bar, b.x, nloc, nx); b.st[0] = nloc; b.st[1] = nx; }
        const unsigned old = xb_add(&bar[XB_XSUB(b.x)], 1u);
        const unsigned gen = old / nloc;
        if (old + 1u == (gen + 1u) * nloc) {
            __builtin_amdgcn_fence(__ATOMIC_RELEASE, "agent");
            asm volatile("s_waitcnt vmcnt(0)" ::: "memory");
            const unsigned og = xb_add(&bar[XB_TOP], 1u);
            const unsigned tg = og / nx;
            if (og + 1u == (tg + 1u) * nx) xb_add(&bar[XB_TOPGEN], 1u);
            else XB_SPIN(xb_ld(&bar[XB_TOPGEN]) == tg, bar);
            __builtin_amdgcn_fence(__ATOMIC_ACQUIRE, "agent");
            xb_add(&bar[XB_XGEN(b.x)], 1u);
            asm volatile("s_waitcnt vmcnt(0)" ::: "memory");
        } else {
            XB_SPIN(xb_ld(&bar[XB_XGEN(b.x)]) == gen, bar);
            __builtin_amdgcn_fence(__ATOMIC_ACQUIRE, "agent");
            asm volatile("s_waitcnt vmcnt(0)" ::: "memory");
        }
    }
    __syncthreads();
}
constexpr size_t OFF_BAR = OFF_CTL + 4096;

__global__ void __launch_bounds__(NTHR) mega(Params p, int lo, int hi) {
    extern __shared__ __attribute__((aligned(16))) unsigned char lds[];
    cg::grid_group grid = cg::this_grid();
    const int bid = blockIdx.x, nb = gridDim.x;
    unsigned char* ws = p.ws;
    bf16_t* S0 = (bf16_t*)(ws + OFF_SLOT), *S1 = (bf16_t*)(ws + OFF_SLOT + SLOT), *S2 = (bf16_t*)(ws + OFF_SLOT + 2 * SLOT), *S3 = (bf16_t*)(ws + OFF_SLOT + 3 * SLOT),
           *S4 = (bf16_t*)(ws + OFF_SLOT + 4 * SLOT), *S5 = (bf16_t*)(ws + OFF_SLOT + 5 * SLOT);
    const float* MOD = (const float*)(ws + OFF_MOD); const float* BINP = (const float*)(ws + OFF_BINP);
    int* meta = (int*)(lds + LDS_BYTES - 256);
#ifndef PHMASK
#define PHMASK 0x7ff
#endif
#define IN(k) (((PHMASK >> (k)) & 1) && lo <= (k) && (k) < hi)
#ifndef PIPE_MASK
#define PIPE_MASK 0x364
#endif
#define GEMM_RUN(k, gather, s, e) do { if ((PIPE_MASK >> (k)) & 1) gemm_phase_pipe<gather>(lds, s, e); else gemm_phase_simple(s, e); } while (0)
    volatile unsigned* xst = (volatile unsigned*)(lds + LDS_BYTES - 16);
    if (threadIdx.x < 2) xst[threadIdx.x] = 0u;
    __syncthreads();
    XcdBarrier xbar; xbar.bar = (unsigned*)(ws + OFF_BAR); xbar.x = 0; xbar.st = xst;
    if (hi - lo > 1) xbar = xcd_barrier_post((unsigned*)(ws + OFF_BAR), xst);
    if (p.pv == 0x7eadbeef) grid.sync();
#define SEAM(k) do { if (IN(k) && IN((k) + 1)) xcd_barrier(xbar); } while (0)
    if (IN(0)) { ph0_prep(p, bid, nb, lds); } SEAM(0);
    if (IN(1)) { ph1_norm(p, bid, nb); } SEAM(1);
    if (IN(2)) {
        { SchCtx s{(const bf16_t*)(ws + OFF_HC), (const bf16_t*)(ws + OFF_WIN), nb, bid, 1024}; EpiCtx e{(bf16_t*)(ws + OFF_XRC), BINP}; GEMM_RUN(2, false, s, e); }
        { SchG1 s{S0, (const bf16_t*)(ws + OFF_WIN), nb, bid, 1024}; EpiG1 e{S1, S2, S3, S4, S5, BINP}; GEMM_RUN(2, false, s, e); }
    } SEAM(2);
    if (IN(3)) {
        for (int g = bid; g < 512; g += nb) aprep_item(p, g, lds);
        for (int it = bid; it < 1024 + 32; it += nb) { if (it < 1024) b_item<false>(p, it >> 8, (it >> 3) & 31, it & 7, lds); else b_item<false>(p, (it - 1024) >> 3, -1, it & 7, lds); }
    } SEAM(3);
    if (IN(4)) {
        for (int it = bid; it < 1024; it += nb) b_item<true>(p, it >> 8, (it >> 3) & 31, it & 7, lds);
    } SEAM(4);
    if (IN(5)) { SchG2 s{S0, S1, (const bf16_t*)(ws + OFF_WPA), (const bf16_t*)(ws + OFF_WPB), nb, bid, 1024}; EpiG2 e{S4, S5, S3}; GEMM_RUN(5, false, s, e); } SEAM(5);
    if (IN(6)) { SchG3 s{S3, (const bf16_t*)(ws + OFF_WO), nb, bid, 1024}; EpiG3 e{p.in[I_X], MOD, p.out}; GEMM_RUN(6, false, s, e); } SEAM(6);
    if (IN(7)) { ph8_route(p, bid, nb, lds); } SEAM(7);
    if (IN(8)) { __syncthreads(); moe_meta_build(p, meta); MoeMeta mm{meta};
        int* idx = (int*)(lds + STAGE_BYTES);
        SchUp s{S2, (const bf16_t*)(ws + OFF_WGU), (const int*)(ws + OFF_LIST), mm, nb, bid, 1024, idx}; EpiUp e{S4, (const float*)(ws + OFF_WL), mm};
        { Unit u; for (int i = 0; i < 8 && s.next(i, u); ++i) { if (threadIdx.x < 256) { int pos = u.aux2 + (int)threadIdx.x; const int c = mm.cnt(u.aux); pos = pos < c ? pos : c - 1; idx[i * 256 + threadIdx.x] = s.LIST[u.aux * NT + pos]; } } }
        __syncthreads();
        GEMM_RUN(8, true, s, e); } SEAM(8);
    if (IN(9)) { __syncthreads(); moe_meta_build(p, meta); MoeMeta mm{meta};
        SchDn s{S4, (const bf16_t*)(ws + OFF_WDN), mm, nb, bid, 512}; EpiDn e{S0, mm}; GEMM_RUN(9, false, s, e); } SEAM(9);
    if (IN(10)) { __syncthreads(); moe_meta_build(p, meta); ph10_final(p, bid, nb, meta); }
#undef IN
#undef SEAM
}

extern "C" void kernel_launch(void* const* d_in, const int* in_sizes, int n_in, void* d_out, int out_size, void* d_ws, size_t ws_size, hipStream_t stream) {
    static int grid = 0;
    if (grid == 0) {
        if (n_in != 37 || out_size != NT * DM || ws_size < WS_END) { fprintf(stderr, "kernel_launch: unexpected shapes: n_in %d out %d ws %zu (need %zu)\n", n_in, out_size, ws_size, (size_t)WS_END); grid = -1; return; }
        int dev = 0, cus = 0, per_cu = 0;
        (void)hipGetDevice(&dev); (void)hipDeviceGetAttribute(&cus, hipDeviceAttributeMultiprocessorCount, dev);
        if (hipFuncSetAttribute((const void*)mega, hipFuncAttributeMaxDynamicSharedMemorySize, LDS_BYTES) != hipSuccess) { fprintf(stderr, "kernel_launch: hipFuncSetAttribute failed\n"); grid = -1; return; }
        if (hipOccupancyMaxActiveBlocksPerMultiprocessor(&per_cu, (const void*)mega, NTHR, LDS_BYTES) != hipSuccess || per_cu < 1) { fprintf(stderr, "kernel_launch: occupancy query says %d\n", per_cu); per_cu = 1; }
        (void)hipGetLastError();
        grid = cus * 1;
        fprintf(stderr, "kernel_launch: grid %d (cus %d, per_cu %d)\n", grid, cus, per_cu);
    }
    if (grid < 0) return;
    Params p{};
    for (int i = 0; i < 37; ++i) p.in[i] = (const float*)d_in[i];
    p.out = (float*)d_out; p.ws = (unsigned char*)d_ws;
#if ONE_LAUNCH
    (void)hipMemsetAsync((unsigned char*)d_ws + OFF_BAR, 0, XCD_BAR_WORDS * 4, stream);
    int lo = 0, hi = NPHASE; void* args[] = {&p, &lo, &hi};
    hipError_t e = hipLaunchCooperativeKernel((const void*)mega, dim3(grid), dim3(NTHR), args, LDS_BYTES, stream);
    if (e != hipSuccess) fprintf(stderr, "cooperative launch failed: %s (grid %d)\n", hipGetErrorString(e), grid);
#ifdef PROBE_PHASE
    hipLaunchKernelGGL(mega, dim3(grid), dim3(NTHR), LDS_BYTES, stream, p, PROBE_PHASE, PROBE_PHASE + 1);
#endif
#else
    for (int k = 0; k < NPHASE; ++k) hipLaunchKernelGGL(mega, dim3(grid), dim3(NTHR), LDS_BYTES, stream, p, k, k + 1);
#endif
}
```

```cpp
#include <hip/hip_runtime.h>
#include <hip/hip_cooperative_groups.h>
#include <cstdio>
#include <cstdint>
namespace cg = cooperative_groups;

#ifndef ONE_LAUNCH
#define ONE_LAUNCH 1
#endif

typedef unsigned short bf16_t;
typedef short bf16x8 __attribute__((ext_vector_type(8)));
typedef float f32x4 __attribute__((ext_vector_type(4)));
typedef float f32x2 __attribute__((ext_vector_type(2)));
typedef unsigned u32x4 __attribute__((ext_vector_type(4)));
typedef unsigned u32x2 __attribute__((ext_vector_type(2)));

constexpr int NT = 32768, NCX = 1024, DM = 1024, SEQ = 8192, CTXL = 256;
constexpr int NTHR = 512;
constexpr int NCH64 = 132;
constexpr size_t MiB = (size_t)1 << 20;
constexpr size_t OFF_CTL = 0, OFF_MOD = 1 * MiB, OFF_BINP = OFF_MOD + 128 * 1024, OFF_WIN = 2 * MiB, OFF_WPA = 14 * MiB, OFF_WPB = 16 * MiB,
                 OFF_WO = 18 * MiB, OFF_WG = 20 * MiB, OFF_WGU = 22 * MiB, OFF_WDN = 54 * MiB, OFF_HC = 70 * MiB, OFF_XRC = 72 * MiB,
                 OFF_TOT = 74 * MiB, OFF_ROUTE = 84 * MiB, OFF_LIST = 85 * MiB, OFF_WL = 87 * MiB, OFF_SLOT = 90 * MiB, SLOT = 64 * MiB,
                 WS_END = OFF_SLOT + 6 * SLOT;
constexpr int LDS_BYTES = 144 * 1024;
constexpr int NPHASE = 11;

struct Params { const float* in[37]; float* out; unsigned char* ws; int pv; int pad; };

enum { I_X = 0, I_C, I_CTX, I_CCTX, I_WADA, I_BADA, I_GMIX, I_WIN, I_BIN, I_CONVW, I_CONVB, I_LNG, I_LNB, I_WPA, I_LCW, I_LCB,
       I_WRF, I_BRF, I_WIF, I_BIF, I_LAMF, I_WRB, I_BRB, I_WIB, I_BIB, I_LAMB, I_WPB, I_WO, I_GFFN, I_WGRP, I_BGRP, I_WER, I_BER,
       I_WGATE, I_WUP, I_WDOWN, I_GFINAL };

__device__ __forceinline__ float bflo(unsigned w) { return __uint_as_float(w << 16); }
__device__ __forceinline__ float bfhi(unsigned w) { return __uint_as_float(w & 0xffff0000u); }
__device__ __forceinline__ float bf2f(bf16_t h) { return __uint_as_float(((unsigned)h) << 16); }
__device__ __forceinline__ unsigned pk2(float lo, float hi) { unsigned r; asm("v_cvt_pk_bf16_f32 %0, %1, %2" : "=v"(r) : "v"(lo), "v"(hi)); return r; }
__device__ __forceinline__ bf16_t f2bf(float f) { return (bf16_t)(pk2(f, 0.f) & 0xffffu); }
__device__ __forceinline__ float sigm(float x) { return __builtin_amdgcn_rcpf(1.0f + __expf(-x)); }
__device__ __forceinline__ float silu(float x) { return x * sigm(x); }
__device__ __forceinline__ float gelu_tanh(float x) { return x * sigm(1.5957691216057308f * (x + 0.044715f * x * x * x)); }
__device__ __forceinline__ float wave_sum(float v) {
#pragma unroll
    for (int o = 1; o < 64; o <<= 1) v += __shfl_xor(v, o);
    return v;
}
__device__ __forceinline__ void wave_lds_sync() { asm volatile("s_waitcnt lgkmcnt(0)" ::: "memory"); __builtin_amdgcn_wave_barrier(); }
__device__ __forceinline__ u32x2 pk4(f32x4 v) { u32x2 r; r.x = pk2(v[0], v[1]); r.y = pk2(v[2], v[3]); return r; }

template <class DRow>
__device__ __forceinline__ void tr_item(const float* __restrict__ src, int ldsrc, int k0, int n0, bf16_t* dst, int ldd, DRow drow, float* scr, int lane) {
#pragma unroll 8
    for (int i = 0; i < 32; ++i) { const int kk = 2 * i + (lane >> 5); scr[kk * 33 + (lane & 31)] = src[(size_t)(k0 + kk) * ldsrc + n0 + (lane & 31)]; }
    wave_lds_sync();
    const int c = lane & 7;
#pragma unroll
    for (int j = 0; j < 4; ++j) {
        const int n = (lane >> 3) + 8 * j; const float* s = scr + (8 * c) * 33 + n;
        u32x4 o; o.x = pk2(s[0], s[33]); o.y = pk2(s[66], s[99]); o.z = pk2(s[132], s[165]); o.w = pk2(s[198], s[231]);
        *(u32x4*)(dst + (size_t)drow(n0 + n) * ldd + k0 + 8 * c) = o;
    }
    wave_lds_sync();
}

__device__ __forceinline__ int win_srccol(int np) { const int p = np >> 8, r = np & 255; return p < 8 ? (r >> 7) * 1024 + 128 * p + (r & 127) : np; }

__device__ __forceinline__ void ph0_prep(const Params& p, int bid, int nb, unsigned char* lds) {
    const int tid = threadIdx.x, lane = tid & 63, wave = tid >> 6;
    unsigned char* ws = p.ws;
    float* scr = (float*)lds + wave * (64 * 33);
    const int gw = bid * 8 + wave, NGW = nb * 8;
    constexpr int N_WIN = 16 * 192, N_SQ = 16 * 32, N_G = 256, N_GU = 4096, N_DN = 4096;
    constexpr int NITEMS = N_WIN + 3 * N_SQ + N_G + 2 * N_GU + N_DN;
    for (int it = gw; it < NITEMS; it += NGW) {
        int r = it;
        if (r < N_WIN) { const int kb = r / 192, nbk = r % 192, d0 = 32 * nbk, sc0 = win_srccol(d0);
            tr_item(p.in[I_WIN], 6144, 64 * kb, sc0, (bf16_t*)(ws + OFF_WIN), 1024, [=](int n) { return n - sc0 + d0; }, scr, lane); continue; }
        r -= N_WIN;
        if (r < 3 * N_SQ) { const int which = r / N_SQ, q = r % N_SQ, kb = q / 32, nbk = q % 32;
            const float* src = which == 0 ? p.in[I_WPA] : which == 1 ? p.in[I_WPB] : p.in[I_WO];
            bf16_t* dst = (bf16_t*)(ws + (which == 0 ? OFF_WPA : which == 1 ? OFF_WPB : OFF_WO));
            tr_item(src, 1024, 64 * kb, 32 * nbk, dst, 1024, [=](int n) { return n; }, scr, lane); continue; }
        r -= 3 * N_SQ;
        if (r < N_G) { const int ty = r / 64, q = r % 64, h = q / 8, kb = (q % 8) / 4, nbk = q % 4;
            const float* src = (ty == 0 ? p.in[I_WRF] : ty == 1 ? p.in[I_WIF] : ty == 2 ? p.in[I_WRB] : p.in[I_WIB]) + (size_t)h * 128 * 128;
            tr_item(src, 128, 64 * kb, 32 * nbk, (bf16_t*)(ws + OFF_WG), 128, [=](int n) { return h * 512 + (n >> 4) * 64 + ty * 16 + (n & 15); }, scr, lane); continue; }
        r -= N_G;
        if (r < 2 * N_GU) { const int bj = r / N_GU, q = r % N_GU, e = q / 256, kb = (q % 256) / 16, nbk = q % 16;
            const float* src = (bj == 0 ? p.in[I_WGATE] : p.in[I_WUP]) + (size_t)e * 1024 * 512;
            tr_item(src, 512, 64 * kb, 32 * nbk, (bf16_t*)(ws + OFF_WGU) + (size_t)e * 1024 * 1024, 1024, [=](int n) { return 256 * (n >> 7) + 128 * bj + (n & 127); }, scr, lane); continue; }
        r -= 2 * N_GU;
        { const int e = r / 256, kb = (r % 256) / 32, nbk = r % 32;
            tr_item(p.in[I_WDOWN] + (size_t)e * 512 * 1024, 1024, 64 * kb, 32 * nbk, (bf16_t*)(ws + OFF_WDN) + (size_t)e * 1024 * 512, 512, [=](int n) { return n; }, scr, lane); }
    }
    __syncthreads();
    float* red = (float*)lds;
    float* MOD = (float*)(ws + OFF_MOD);
    for (int it = bid; it < 96; it += nb) {
        const int col = it * 64 + lane;
        float a[5] = {0.f, 0.f, 0.f, 0.f, 0.f};
        const float* W = p.in[I_WADA];
        for (int k = wave * 128; k < wave * 128 + 128; ++k) {
            const float wv = W[(size_t)k * 6144 + col];
#pragma unroll
            for (int r = 0; r < 5; ++r) { const float cv = r < 4 ? p.in[I_C][r * 1024 + k] : p.in[I_CCTX][k]; a[r] += silu(cv) * wv; }
        }
#pragma unroll
        for (int r = 0; r < 5; ++r) red[(wave * 5 + r) * 64 + lane] = a[r];
        __syncthreads();
        if (tid < 320) { const int r = tid / 64, l = tid % 64; float s = 0.f;
#pragma unroll
            for (int w = 0; w < 8; ++w) s += red[(w * 5 + r) * 64 + l];
            MOD[r * 6144 + it * 64 + l] = s + p.in[I_BADA][it * 64 + l]; }
        __syncthreads();
    }
    float* BINP = (float*)(ws + OFF_BINP);
    for (int i = bid * NTHR + tid; i < 6144; i += nb * NTHR) BINP[i] = p.in[I_BIN][win_srccol(i)];
    if (bid == 0 && tid < 64) ((unsigned*)(ws + OFF_CTL))[tid] = 0u;
}

__device__ __forceinline__ void ph1_norm(const Params& p, int bid, int nb) {
    const int lane = threadIdx.x & 63, wave = threadIdx.x >> 6;
    const float* MOD = (const float*)(p.ws + OFF_MOD);
    for (int r = bid * 8 + wave; r < NT + NCX; r += nb * 8) {
        const bool lat = r < NT;
        const float* src = lat ? p.in[I_X] + (size_t)r * DM : p.in[I_CTX] + (size_t)(r - NT) * DM;
        bf16_t* dst = lat ? (bf16_t*)(p.ws + OFF_SLOT) + (size_t)r * DM : (bf16_t*)(p.ws + OFF_HC) + (size_t)(r - NT) * DM;
        const float* mrow = MOD + (lat ? r / SEQ : 4) * 6144;
        f32x4 v[4]; float ss = 0.f;
#pragma unroll
        for (int j = 0; j < 4; ++j) { v[j] = *(const f32x4*)(src + lane * 4 + 256 * j); ss += v[j][0] * v[j][0] + v[j][1] * v[j][1] + v[j][2] * v[j][2] + v[j][3] * v[j][3]; }
        const float rinv = rsqrtf(wave_sum(ss) * (1.0f / DM) + 1e-6f);
#pragma unroll
        for (int j = 0; j < 4; ++j) { const int c = lane * 4 + 256 * j;
            const f32x4 g = *(const f32x4*)(p.in[I_GMIX] + c), sh = *(const f32x4*)(mrow + c), sc = *(const f32x4*)(mrow + 1024 + c);
            f32x4 o;
#pragma unroll
            for (int e = 0; e < 4; ++e) o[e] = v[j][e] * rinv * g[e] * (1.0f + sc[e]) + sh[e];
            *(u32x2*)(dst + c) = pk4(o); }
    }
}

struct Unit { int pm, pn, aux, aux2; };

#define LAS __attribute__((address_space(3)))
constexpr int BK = 64, HTB = 128 * BK * 2, STAGE_BYTES = 8 * HTB;
__device__ __forceinline__ int lds_byte(int r, int c) { const int st = (r >> 4) * 2 + (c >> 5), rr = r & 15, cc = c & 31, ob = rr * 64 + cc * 2; return st * 1024 + (ob ^ (((ob >> 9) & 1) << 5)); }
__device__ __forceinline__ void stage_rc(int b, int& R, int& C) { const int st = b / 1024, sb = b % 1024, swz = sb ^ (((sb >> 9) & 1) << 5); R = (st >> 1) * 16 + swz / 64; C = (st & 1) * 32 + (swz % 64) / 2; }

template <bool GATHER, class S, class E>
__device__ __forceinline__ void gemm_phase_pipe(unsigned char* ldsg, const S& sch, const E& epi) {
    LAS unsigned char* lds = (LAS unsigned char*)ldsg;
    const int tid = threadIdx.x, wid = __builtin_amdgcn_readfirstlane(tid >> 6), lane = tid & 63, wr = wid >> 2, wc = wid & 3, fr = lane & 15, fq = lane >> 4;
    const int K = sch.K, nt = K / BK;
    int Rr[2], Cc[2]; unsigned voffA[2], voffB[2];
#pragma unroll
    for (int i = 0; i < 2; ++i) { stage_rc(tid * 16 + i * 8192, Rr[i], Cc[i]); voffA[i] = (unsigned)(Rr[i] * K + Cc[i]) * 2u;
        const int rho = Rr[i] & 31, Rb = (Rr[i] & ~31) + 8 * ((rho & 15) >> 2) + 4 * (rho >> 4) + (rho & 3);
        voffB[i] = (unsigned)(Rb * K + Cc[i]) * 2u; }
    const size_t kstep = (size_t)(BK * 2);
    const size_t hstep = (size_t)128 * K * 2;
    const unsigned ldsw = (unsigned)wid * 1024u;
    const int aoff = lds_byte(wr * 64 + fr, fq * 8), boff = lds_byte(wc * 32 + fr, fq * 8);
#define PG8_SA(b, h) (((b) * 2 + (h)) * HTB)
#define PG8_SB(b, h) ((4 + (b) * 2 + (h)) * HTB)
#define PG8_STAGE_B(bufoff, gbase) do { _Pragma("unroll") for (int _i = 0; _i < 2; ++_i) \
        __builtin_amdgcn_global_load_lds((const unsigned*)((const char*)(gbase) + voffB[_i]), (LAS unsigned*)(lds + (bufoff) + ldsw + _i * 8192), 16, 0, 0); } while (0)
#define PG8_STAGE_A(bufoff, gbase, h, vo) do { _Pragma("unroll") for (int _i = 0; _i < 2; ++_i) \
        __builtin_amdgcn_global_load_lds((const unsigned*)((const char*)(gbase) + (GATHER ? (size_t)(vo)[h][_i] : (size_t)(h) * hstep + voffA[_i])), (LAS unsigned*)(lds + (bufoff) + ldsw + _i * 8192), 16, 0, 0); } while (0)
#define PG8_LDA(dst, b, h) do { _Pragma("unroll") for (int m = 0; m < 4; ++m) _Pragma("unroll") for (int k = 0; k < 2; ++k) dst[m][k] = *(const LAS bf16x8*)(lds + PG8_SA(b, h) + aoff + m * 2048 + k * 1024); } while (0)
#define PG8_LDB(dst, b, h) do { _Pragma("unroll") for (int n = 0; n < 2; ++n) _Pragma("unroll") for (int k = 0; k < 2; ++k) dst[n][k] = *(const LAS bf16x8*)(lds + PG8_SB(b, h) + boff + n * 2048 + k * 1024); } while (0)
#define PG8_MMA(ai, bj, At, Bt) do { __builtin_amdgcn_s_setprio(1); _Pragma("unroll") for (int m = 0; m < 4; ++m) _Pragma("unroll") for (int n = 0; n < 2; ++n) _Pragma("unroll") for (int k = 0; k < 2; ++k) \
        acc[ai][bj][m][n] = __builtin_amdgcn_mfma_f32_16x16x32_bf16(Bt[n][k], At[m][k], acc[ai][bj][m][n], 0, 0, 0); __builtin_amdgcn_s_setprio(0); } while (0)
#define PG8_WAIT_V(n) asm volatile("s_waitcnt vmcnt(" #n ")" ::: "memory")
#define PG8_WAIT_L(n) asm volatile("s_waitcnt lgkmcnt(" #n ")" ::: "memory")
#define PG8_BAR __builtin_amdgcn_s_barrier()
#define PG8_SCHED __builtin_amdgcn_sched_barrier(0)
    Unit cur, nxt; int ui = 0;
    if (!sch.next(0, cur)) return;
    f32x4 acc[2][2][4][2];
#pragma unroll
    for (int a = 0; a < 2; ++a)
#pragma unroll
        for (int b = 0; b < 2; ++b)
#pragma unroll
            for (int m = 0; m < 4; ++m)
#pragma unroll
                for (int n = 0; n < 2; ++n) acc[a][b][m][n] = (f32x4){0.f, 0.f, 0.f, 0.f};
    bf16x8 At[4][2], B0[2][2], B1[2][2];
    unsigned voAc[2][2], voAn[2][2];
#pragma unroll
    for (int h = 0; h < 2; ++h)
#pragma unroll
        for (int i = 0; i < 2; ++i) { voAc[h][i] = GATHER ? sch.aoff(cur, 128 * h + Rr[i]) + (unsigned)Cc[i] * 2u : 0u; voAn[h][i] = voAc[h][i]; }
    const char* cA = sch.abase(cur); const char* cB = sch.bbase(cur);
    PG8_STAGE_B(PG8_SB(0, 0), cB); PG8_STAGE_A(PG8_SA(0, 0), cA, 0, voAc); PG8_STAGE_B(PG8_SB(0, 1), cB + hstep); PG8_STAGE_A(PG8_SA(0, 1), cA, 1, voAc);
    if (wr == 1) PG8_BAR;
    PG8_WAIT_V(4); PG8_BAR;
    PG8_STAGE_B(PG8_SB(1, 0), cB + kstep); PG8_STAGE_A(PG8_SA(1, 0), cA + kstep, 0, voAc); PG8_STAGE_B(PG8_SB(1, 1), cB + hstep + kstep);
    PG8_WAIT_V(6); PG8_BAR;
    for (;;) {
        const bool has_next = sch.next(ui + 1, nxt);
        const char* nA = has_next ? sch.abase(nxt) : cA; const char* nB = has_next ? sch.bbase(nxt) : cB;
        if (GATHER) {
#pragma unroll
            for (int h = 0; h < 2; ++h)
#pragma unroll
                for (int i = 0; i < 2; ++i) voAn[h][i] = has_next ? sch.aoff(nxt, 128 * h + Rr[i]) + (unsigned)Cc[i] * 2u : voAc[h][i];
        }
#pragma unroll 1
        for (int t = 0; t < nt; t += 2) {
            const bool last = (t == nt - 2);
            const char* a1 = cA + (size_t)(t + 1) * kstep;
            const char* a2 = last ? nA : cA + (size_t)(t + 2) * kstep; const char* b2 = last ? nB : cB + (size_t)(t + 2) * kstep;
            const char* a3 = a2 + kstep; const char* b3 = b2 + kstep;
            unsigned vo2[2][2];
#pragma unroll
            for (int h = 0; h < 2; ++h)
#pragma unroll
                for (int i = 0; i < 2; ++i) vo2[h][i] = last ? voAn[h][i] : voAc[h][i];
            PG8_LDB(B0, 0, 0); PG8_SCHED; PG8_LDA(At, 0, 0); PG8_STAGE_A(PG8_SA(1, 1), a1, 1, voAc);
            PG8_WAIT_L(8); PG8_BAR; PG8_WAIT_L(0); PG8_MMA(0, 0, At, B0); PG8_BAR; PG8_SCHED;
            PG8_LDB(B1, 0, 1); PG8_STAGE_B(PG8_SB(0, 0), b2);
            PG8_BAR; PG8_WAIT_L(0); PG8_MMA(0, 1, At, B1); PG8_BAR;
            PG8_LDA(At, 0, 1); PG8_STAGE_A(PG8_SA(0, 0), a2, 0, vo2);
            PG8_BAR; PG8_WAIT_L(0); PG8_MMA(1, 0, At, B0); PG8_BAR; PG8_SCHED;
            PG8_STAGE_B(PG8_SB(0, 1), b2 + hstep);
            PG8_WAIT_V(6); PG8_BAR; PG8_MMA(1, 1, At, B1); PG8_BAR;
            PG8_LDB(B0, 1, 0); PG8_SCHED; PG8_LDA(At, 1, 0); PG8_STAGE_A(PG8_SA(0, 1), a2, 1, vo2);
            PG8_WAIT_L(8); PG8_BAR; PG8_WAIT_L(0); PG8_MMA(0, 0, At, B0); PG8_BAR; PG8_SCHED;
            PG8_LDB(B1, 1, 1); PG8_STAGE_B(PG8_SB(1, 0), b3);
            PG8_BAR; PG8_WAIT_L(0); PG8_MMA(0, 1, At, B1); PG8_BAR;
            PG8_LDA(At, 1, 1); PG8_STAGE_A(PG8_SA(1, 0), a3, 0, vo2);
            PG8_BAR; PG8_WAIT_L(0); PG8_MMA(1, 0, At, B0); PG8_BAR; PG8_SCHED;
            PG8_STAGE_B(PG8_SB(1, 1), b3 + hstep);
            PG8_WAIT_V(6); PG8_BAR; PG8_MMA(1, 1, At, B1); PG8_BAR;
        }
        { int frx = fr, fqx = fq; asm volatile("" : "+v"(frx), "+v"(fqx));
#pragma unroll
        for (int ai = 0; ai < 2; ++ai)
#pragma unroll
            for (int m = 0; m < 4; ++m) epi(cur, ai * 128 + wr * 64 + m * 16 + frx, wc * 32 + 8 * fqx, acc[ai][0][m][0], acc[ai][0][m][1], acc[ai][1][m][0], acc[ai][1][m][1]); }
        if (!has_next) break;
#pragma unroll
        for (int a = 0; a < 2; ++a)
#pragma unroll
            for (int b = 0; b < 2; ++b)
#pragma unroll
                for (int m = 0; m < 4; ++m)
#pragma unroll
                    for (int n = 0; n < 2; ++n) acc[a][b][m][n] = (f32x4){0.f, 0.f, 0.f, 0.f};
        cur = nxt; cA = nA; cB = nB; ++ui;
#pragma unroll
        for (int h = 0; h < 2; ++h)
#pragma unroll
            for (int i = 0; i < 2; ++i) voAc[h][i] = voAn[h][i];
    }
    PG8_WAIT_V(0);
    if (wr == 0) PG8_BAR;
    PG8_BAR;
#undef PG8_SA
#undef PG8_SB
#undef PG8_STAGE_A
#undef PG8_STAGE_B
#undef PG8_LDA
#undef PG8_LDB
#undef PG8_MMA
#undef PG8_WAIT_V
#undef PG8_WAIT_L
#undef PG8_BAR
#undef PG8_SCHED
}

struct SchG1 { const bf16_t *A, *Bt; int G, c, K;
    __device__ __forceinline__ bool next(int i, Unit& u) const { const int L = i * G + c; if (L >= 128 * 24) return false; u.pm = L / 24; u.pn = L % 24; return true; }
    __device__ __forceinline__ const bf16_t* arow(const Unit& u, int r) const { return A + (size_t)(u.pm * 256 + r) * 1024; }
    __device__ __forceinline__ const bf16_t* brow(const Unit& u, int n) const { return Bt + (size_t)(u.pn * 256 + n) * 1024; }
    __device__ __forceinline__ const char* abase(const Unit& u) const { return (const char*)(A + (size_t)u.pm * 256 * 1024); }
    __device__ __forceinline__ const char* bbase(const Unit& u) const { return (const char*)(Bt + (size_t)u.pn * 256 * 1024); }
    __device__ __forceinline__ unsigned aoff(const Unit&, int) const { return 0u; } };
__device__ __forceinline__ u32x4 pk8(f32x4 a, f32x4 b) { u32x4 r; r.x = pk2(a[0], a[1]); r.y = pk2(a[2], a[3]); r.z = pk2(b[0], b[1]); r.w = pk2(b[2], b[3]); return r; }
__device__ __forceinline__ void unpk8(u32x4 w, f32x4& a, f32x4& b) { a[0] = bflo(w.x); a[1] = bfhi(w.x); a[2] = bflo(w.y); a[3] = bfhi(w.y); b[0] = bflo(w.z); b[1] = bfhi(w.z); b[2] = bflo(w.w); b[3] = bfhi(w.w); }
struct EpiG1 { bf16_t *Z, *GYG, *XR, *SGA, *SGB; const float* bias;
    __device__ __forceinline__ void operator()(const Unit& u, int r, int j, f32x4 a0, f32x4 a1, f32x4 b0, f32x4 b1) const {
        const size_t row = (size_t)u.pm * 256 + r; const int cb = u.pn * 256 + j;
        a0 += *(const f32x4*)(bias + cb); a1 += *(const f32x4*)(bias + cb + 4); b0 += *(const f32x4*)(bias + cb + 128); b1 += *(const f32x4*)(bias + cb + 132);
        if (u.pn < 8) {
#pragma unroll
            for (int e = 0; e < 4; ++e) { a0[e] *= sigm(b0[e]); a1[e] *= sigm(b1[e]); }
            *(u32x4*)(Z + row * 1024 + u.pn * 128 + j) = pk8(a0, a1); }
        else { const int kind = u.pn >> 2;
            bf16_t* dst = GYG + (size_t)(kind - 2) * (SLOT / 2);
#pragma unroll
            for (int e = 0; e < 4; ++e) { if (kind == 2) { a0[e] = gelu_tanh(a0[e]); a1[e] = gelu_tanh(a1[e]); b0[e] = gelu_tanh(b0[e]); b1[e] = gelu_tanh(b1[e]); }
                else if (kind >= 4) { a0[e] = sigm(a0[e]); a1[e] = sigm(a1[e]); b0[e] = sigm(b0[e]); b1[e] = sigm(b1[e]); } }
            bf16_t* o = dst + row * 1024 + (u.pn & 3) * 256 + j;
            *(u32x4*)o = pk8(a0, a1); *(u32x4*)(o + 128) = pk8(b0, b1); }
    } };
struct SchCtx { const bf16_t *A, *Bt; int G, c, K;
    __device__ __forceinline__ bool next(int i, Unit& u) const { const int L = i * G + c; if (L >= 16) return false; u.pm = L / 4; u.pn = L % 4; return true; }
    __device__ __forceinline__ const bf16_t* arow(const Unit& u, int r) const { return A + (size_t)(u.pm * 256 + r) * 1024; }
    __device__ __forceinline__ const bf16_t* brow(const Unit& u, int n) const { return Bt + (size_t)((12 + u.pn) * 256 + n) * 1024; }
    __device__ __forceinline__ const char* abase(const Unit& u) const { return (const char*)(A + (size_t)u.pm * 256 * 1024); }
    __device__ __forceinline__ const char* bbase(const Unit& u) const { return (const char*)(Bt + (size_t)(12 + u.pn) * 256 * 1024); }
    __device__ __forceinline__ unsigned aoff(const Unit&, int) const { return 0u; } };
struct EpiCtx { bf16_t* XRC; const float* bias;
    __device__ __forceinline__ void operator()(const Unit& u, int r, int j, f32x4 a0, f32x4 a1, f32x4 b0, f32x4 b1) const {
        const size_t row = (size_t)u.pm * 256 + r; const int cb = (12 + u.pn) * 256 + j;
        a0 += *(const f32x4*)(bias + cb); a1 += *(const f32x4*)(bias + cb + 4); b0 += *(const f32x4*)(bias + cb + 128); b1 += *(const f32x4*)(bias + cb + 132);
        bf16_t* o = XRC + row * 1024 + u.pn * 256 + j; *(u32x4*)o = pk8(a0, a1); *(u32x4*)(o + 128) = pk8(b0, b1); } };
struct SchG2 { const bf16_t *Aa, *Ab, *Wa, *Wb; int G, c, K;
    __device__ __forceinline__ bool next(int i, Unit& u) const { const int t = (i >> 1) * G + c; if (t >= 512) return false; u.pm = t >> 2; u.pn = t & 3; u.aux = i & 1; return true; }
    __device__ __forceinline__ const bf16_t* arow(const Unit& u, int r) const { return Aa + (size_t)u.aux * (SLOT / 2) + (size_t)(u.pm * 256 + r) * 1024; }
    __device__ __forceinline__ const bf16_t* brow(const Unit& u, int n) const { return Wa + (size_t)u.aux * (1024 * 1024) + (size_t)(u.pn * 256 + n) * 1024; }
    __device__ __forceinline__ const char* abase(const Unit& u) const { return (const char*)(Aa + (size_t)u.aux * (SLOT / 2) + (size_t)u.pm * 256 * 1024); }
    __device__ __forceinline__ const char* bbase(const Unit& u) const { return (const char*)(Wa + (size_t)u.aux * (1024 * 1024) + (size_t)u.pn * 256 * 1024); }
    __device__ __forceinline__ unsigned aoff(const Unit&, int) const { return 0u; } };
struct EpiG2 { const bf16_t *SGA, *SGB; bf16_t* M;
    __device__ __forceinline__ void operator()(const Unit& u, int r, int j, f32x4 a0, f32x4 a1, f32x4 b0, f32x4 b1) const {
        const size_t o = ((size_t)u.pm * 256 + r) * 1024 + u.pn * 256 + j;
        const bf16_t* G = SGA + (size_t)u.aux * (SLOT / 2);
        f32x4 g0, g1, g2, g3; unpk8(*(const u32x4*)(G + o), g0, g1); unpk8(*(const u32x4*)(G + o + 128), g2, g3);
        a0 *= g0; a1 *= g1; b0 *= g2; b1 *= g3;
        if (u.aux) { f32x4 t0, t1, t2, t3; unpk8(*(const u32x4*)(M + o), t0, t1); unpk8(*(const u32x4*)(M + o + 128), t2, t3); a0 += t0; a1 += t1; b0 += t2; b1 += t3; }
        *(u32x4*)(M + o) = pk8(a0, a1); *(u32x4*)(M + o + 128) = pk8(b0, b1); } };
struct SchG3 { const bf16_t *A, *Bt; int G, c, K;
    __device__ __forceinline__ bool next(int i, Unit& u) const { const int L = i * G + c; if (L >= 512) return false; u.pm = L >> 2; u.pn = L & 3; return true; }
    __device__ __forceinline__ const bf16_t* arow(const Unit& u, int r) const { return A + (size_t)(u.pm * 256 + r) * 1024; }
    __device__ __forceinline__ const bf16_t* brow(const Unit& u, int n) const { return Bt + (size_t)(u.pn * 256 + n) * 1024; }
    __device__ __forceinline__ const char* abase(const Unit& u) const { return (const char*)(A + (size_t)u.pm * 256 * 1024); }
    __device__ __forceinline__ const char* bbase(const Unit& u) const { return (const char*)(Bt + (size_t)u.pn * 256 * 1024); }
    __device__ __forceinline__ unsigned aoff(const Unit&, int) const { return 0u; } };
struct EpiG3 { const float *X, *MOD; float* X1;
    __device__ __forceinline__ void operator()(const Unit& u, int r, int j, f32x4 a0, f32x4 a1, f32x4 b0, f32x4 b1) const {
        const int row = u.pm * 256 + r, col = u.pn * 256 + j; const size_t o = (size_t)row * 1024 + col;
        const float* gt = MOD + (row / SEQ) * 6144 + 2 * 1024 + col;
        *(f32x4*)(X1 + o) = *(const f32x4*)(X + o) + *(const f32x4*)gt * a0; *(f32x4*)(X1 + o + 4) = *(const f32x4*)(X + o + 4) + *(const f32x4*)(gt + 4) * a1;
        *(f32x4*)(X1 + o + 128) = *(const f32x4*)(X + o + 128) + *(const f32x4*)(gt + 128) * b0; *(f32x4*)(X1 + o + 132) = *(const f32x4*)(X + o + 132) + *(const f32x4*)(gt + 132) * b1; } };
struct MoeMeta { const int* m;
    __device__ __forceinline__ int cnt(int e) const { return __builtin_amdgcn_readfirstlane(m[e]); }
    __device__ __forceinline__ int tb(int e) const { return __builtin_amdgcn_readfirstlane(m[16 + e]); }
    __device__ __forceinline__ int ntiles() const { return __builtin_amdgcn_readfirstlane(m[32]); }
    __device__ __forceinline__ int find(int mt) const { int e = 0;
#pragma unroll
        for (int k = 1; k < 16; ++k) e += (__builtin_amdgcn_readfirstlane(m[16 + k]) <= mt) ? 1 : 0;
        return e; } };
__device__ __forceinline__ void moe_meta_build(const Params& p, int* meta) {
    if (threadIdx.x == 0) { const unsigned* cnt = (const unsigned*)(p.ws + OFF_CTL); int t = 0;
        for (int e = 0; e < 16; ++e) { const int c = (int)__hip_atomic_load(cnt + e, __ATOMIC_RELAXED, __HIP_MEMORY_SCOPE_AGENT); meta[e] = c; meta[16 + e] = t; t += (c + 255) >> 8; }
        meta[32] = t; }
    __syncthreads();
}
struct SchUp { const bf16_t *HM, *W; const int* LIST; MoeMeta mm; int G, c, K; const int* idx;
    __device__ __forceinline__ bool next(int i, Unit& u) const { const int L = i * G + c; if (L >= 4 * mm.ntiles()) return false; const int mt = L >> 2; u.pn = L & 3; u.aux = mm.find(mt); u.aux2 = (mt - mm.tb(u.aux)) * 256; u.pm = mt | (i << 16); return true; }
    __device__ __forceinline__ const char* abase(const Unit&) const { return (const char*)HM; }
    __device__ __forceinline__ const char* bbase(const Unit& u) const { return (const char*)(W + ((size_t)u.aux * 1024 + u.pn * 256) * 1024); }
    __device__ __forceinline__ unsigned aoff(const Unit& u, int r) const { return (unsigned)idx[(u.pm >> 16) * 256 + r] * 2048u; }
    __device__ __forceinline__ const bf16_t* arow(const Unit& u, int r) const { int pos = u.aux2 + r; const int c = mm.cnt(u.aux); pos = pos < c ? pos : c - 1; return HM + (size_t)LIST[u.aux * NT + pos] * 1024; }
    __device__ __forceinline__ const bf16_t* brow(const Unit& u, int n) const { return W + ((size_t)u.aux * 1024 + u.pn * 256 + n) * 1024; } };
struct EpiUp { bf16_t* ACT; const float* WL; MoeMeta mm;
    __device__ __forceinline__ void operator()(const Unit& u, int r, int j, f32x4 g0, f32x4 g1, f32x4 u0, f32x4 u1) const {
        const int pos = u.aux2 + r; if (pos >= mm.cnt(u.aux)) return;
        const float wt = WL[u.aux * NT + pos];
#pragma unroll
        for (int e = 0; e < 4; ++e) { g0[e] = silu(g0[e]) * u0[e] * wt; g1[e] = silu(g1[e]) * u1[e] * wt; }
        *(u32x4*)(ACT + ((size_t)(u.pm & 0xffff) * 256 + r) * 512 + u.pn * 128 + j) = pk8(g0, g1); } };
struct SchDn { const bf16_t *ACT, *W; MoeMeta mm; int G, c, K;
    __device__ __forceinline__ bool next(int i, Unit& u) const { const int L = i * G + c; if (L >= 4 * mm.ntiles()) return false; const int mt = L >> 2; u.pn = L & 3; u.aux = mm.find(mt); u.aux2 = (mt - mm.tb(u.aux)) * 256; u.pm = mt; return true; }
    __device__ __forceinline__ const bf16_t* arow(const Unit& u, int r) const { return ACT + ((size_t)u.pm * 256 + r) * 512; }
    __device__ __forceinline__ const bf16_t* brow(const Unit& u, int n) const { return W + ((size_t)u.aux * 1024 + u.pn * 256 + n) * 512; }
    __device__ __forceinline__ const char* abase(const Unit& u) const { return (const char*)(ACT + (size_t)u.pm * 256 * 512); }
    __device__ __forceinline__ const char* bbase(const Unit& u) const { return (const char*)(W + ((size_t)u.aux * 1024 + u.pn * 256) * 512); }
    __device__ __forceinline__ unsigned aoff(const Unit&, int) const { return 0u; } };
struct EpiDn { bf16_t* Y; MoeMeta mm;
    __device__ __forceinline__ void operator()(const Unit& u, int r, int j, f32x4 a0, f32x4 a1, f32x4 b0, f32x4 b1) const {
        if (u.aux2 + r >= mm.cnt(u.aux)) return;
        bf16_t* o = Y + ((size_t)u.pm * 256 + r) * 1024 + u.pn * 256 + j; *(u32x4*)o = pk8(a0, a1); *(u32x4*)(o + 128) = pk8(b0, b1); } };

__device__ __forceinline__ void aprep_item(const Params& p, int g, unsigned char* lds) {
    const int tid = threadIdx.x, lane = tid & 63, wave = tid >> 6;
    const bf16_t* Z = (const bf16_t*)(p.ws + OFF_SLOT + 1 * SLOT);
    bf16_t* AA = (bf16_t*)(p.ws + OFF_SLOT + 0 * SLOT);
    unsigned* zt = (unsigned*)lds;
    { const u32x4* src = (const u32x4*)(Z + (size_t)g * 64 * 1024); u32x4* d = (u32x4*)lds;
#pragma unroll 4
        for (int i = tid; i < 8192; i += NTHR) d[i] = src[i]; }
    __syncthreads();
    {
        float w0[31], w1[31];
        const float* cw = p.in[I_CONVW] + 2 * tid;
#pragma unroll
        for (int k = 0; k < 31; ++k) { const f32x2 t = *(const f32x2*)(cw + k * 1024); w0[k] = t.x; w1[k] = t.y; }
        const f32x2 cb = *(const f32x2*)(p.in[I_CONVB] + 2 * tid);
        float p0[16], p1[16];
#pragma unroll
        for (int o = 0; o < 16; ++o) { p0[o] = 0.f; p1[o] = 0.f; }
#pragma unroll
        for (int tb = 0; tb < 5; ++tb) {
            float c0[16], c1[16];
#pragma unroll
            for (int o = 0; o < 16; ++o) { c0[o] = cb.x; c1[o] = cb.y; }
            if (tb < 4) {
#pragma unroll
                for (int r0 = 0; r0 < 48; r0 += 8) {
                    unsigned vv[8];
#pragma unroll
                    for (int rr = 0; rr < 8; ++rr) { const int row = 16 * tb - 15 + r0 + rr; vv[rr] = (r0 + rr < 46 && row >= 0 && row < 64) ? zt[row * 512 + tid] : 0u; }
#pragma unroll
                    for (int rr = 0; rr < 8; ++rr) { const int r = r0 + rr, row = 16 * tb - 15 + r;
                        if (r < 46 && row >= 0 && row < 64) { const float x0 = bflo(vv[rr]), x1 = bfhi(vv[rr]);
#pragma unroll
                            for (int o = 0; o < 16; ++o) { const int k = r - o; if (k >= 0 && k < 31) { c0[o] += w0[k] * x0; c1[o] += w1[k] * x1; } } } }
                    asm volatile("" ::: "memory");
                }
            }
            if (tb > 0) {
#pragma unroll
                for (int o = 0; o < 16; ++o) zt[(16 * (tb - 1) + o) * 512 + tid] = pk2(p0[o], p1[o]);
            }
#pragma unroll
            for (int o = 0; o < 16; ++o) { p0[o] = c0[o]; p1[o] = c1[o]; }
        }
    }
    __syncthreads();
    for (int rr = 0; rr < 8; ++rr) {
        const int row = wave * 8 + rr;
        const u32x4 a = *(const u32x4*)(lds + row * 2048 + lane * 16), b = *(const u32x4*)(lds + row * 2048 + 1024 + lane * 16);
        float x[16];
        x[0] = bflo(a.x); x[1] = bfhi(a.x); x[2] = bflo(a.y); x[3] = bfhi(a.y); x[4] = bflo(a.z); x[5] = bfhi(a.z); x[6] = bflo(a.w); x[7] = bfhi(a.w);
        x[8] = bflo(b.x); x[9] = bfhi(b.x); x[10] = bflo(b.y); x[11] = bfhi(b.y); x[12] = bflo(b.z); x[13] = bfhi(b.z); x[14] = bflo(b.w); x[15] = bfhi(b.w);
        float s = 0.f;
#pragma unroll
        for (int e = 0; e < 16; ++e) s += x[e];
        const float mean = wave_sum(s) * (1.0f / 1024.0f);
        float q = 0.f;
#pragma unroll
        for (int e = 0; e < 16; ++e) { x[e] -= mean; q += x[e] * x[e]; }
        const float rstd = rsqrtf(wave_sum(q) * (1.0f / 1024.0f) + 1e-6f);
        float y[16];
#pragma unroll
        for (int hh = 0; hh < 2; ++hh) { const int c0 = hh * 512 + lane * 8;
            const f32x4 g0 = *(const f32x4*)(p.in[I_LNG] + c0), g1 = *(const f32x4*)(p.in[I_LNG] + c0 + 4), b0 = *(const f32x4*)(p.in[I_LNB] + c0), b1 = *(const f32x4*)(p.in[I_LNB] + c0 + 4);
#pragma unroll
            for (int e = 0; e < 4; ++e) { y[hh * 8 + e] = silu(x[hh * 8 + e] * rstd * g0[e] + b0[e]); y[hh * 8 + 4 + e] = silu(x[hh * 8 + 4 + e] * rstd * g1[e] + b1[e]); } }
        bf16_t* o = AA + ((size_t)g * 64 + row) * 1024 + lane * 8;
        u32x4 o0, o1; o0.x = pk2(y[0], y[1]); o0.y = pk2(y[2], y[3]); o0.z = pk2(y[4], y[5]); o0.w = pk2(y[6], y[7]);
        o1.x = pk2(y[8], y[9]); o1.y = pk2(y[10], y[11]); o1.z = pk2(y[12], y[13]); o1.w = pk2(y[14], y[15]);
        *(u32x4*)o = o0; *(u32x4*)(o + 512) = o1;
    }
    __syncthreads();
}

constexpr int XC_STRIDE = 272;
constexpr int YB_STRIDE = 132;
constexpr int B_XC_OFF = 0, B_HIN_OFF = 256 * XC_STRIDE  , B_Y_OFF = B_HIN_OFF + 4096  , B_Y_BYTES = 64 * YB_STRIDE * 4  ;
constexpr size_t OFF_TOT256 = OFF_TOT + 9 * MiB;

__device__ __forceinline__ void lru_coef(float lr, float li, float nsp, float xcv, float& a, float& b) {
    const float la = nsp * sigm(lr);
    a = __expf(la);
    const float am1 = la > -0.25f ? la * (1.0f + la * (0.5f + la * (0.16666667f + la * (0.041666668f + la * 0.008333334f)))) : a - 1.0f;
    b = __builtin_amdgcn_sqrtf(-am1 * (a + 1.0f)) * (sigm(li) * xcv);
}

template <bool FINAL, int DIR>
__device__ __forceinline__ void lru_dir(const unsigned char* xcs, const bf16x8 (&fbr)[4], const bf16x8 (&fbi)[4], float br, float bi, float nsp, int fr, int q, int chl,
                                        float hin_v, f32x4 (&hout)[4], float& totA, float& totB) {
    f32x4 ar[4], ai[4];
#pragma unroll
    for (int m = 0; m < 4; ++m) { ar[m] = (f32x4){0.f, 0.f, 0.f, 0.f}; ai[m] = (f32x4){0.f, 0.f, 0.f, 0.f}; }
#pragma unroll
    for (int kk = 0; kk < 4; ++kk) {
#pragma unroll
        for (int m = 0; m < 4; ++m) { const bf16x8 fa = *(const bf16x8*)(xcs + (16 * m + fr) * XC_STRIDE + (32 * kk + 8 * q) * 2);
            ar[m] = __builtin_amdgcn_mfma_f32_16x16x32_bf16(fa, fbr[kk], ar[m], 0, 0, 0);
            ai[m] = __builtin_amdgcn_mfma_f32_16x16x32_bf16(fa, fbi[kk], ai[m], 0, 0, 0); }
    }
#pragma unroll
    for (int m = 0; m < 4; ++m)
#pragma unroll
        for (int i = 0; i < 4; ++i) {
            const float xcv = bf2f(*(const bf16_t*)(xcs + (16 * m + 4 * q + i) * XC_STRIDE + chl * 2));
            float a, b; lru_coef(ar[m][i] + br, ai[m][i] + bi, nsp, xcv, a, b); ar[m][i] = a; ai[m][i] = b;
        }
    float At[4], Bt[4], Ae[4], Be[4];
#pragma unroll
    for (int m = 0; m < 4; ++m) {
        float A = 1.f, B = 0.f;
#pragma unroll
        for (int ii = 0; ii < 4; ++ii) { const int i = DIR ? 3 - ii : ii; B = ar[m][i] * B + ai[m][i]; A = ar[m][i] * A; }
        if (DIR == 0) {
            float tA = __shfl_up(A, 16), tB = __shfl_up(B, 16); if (q >= 1) { B = A * tB + B; A = A * tA; }
            tA = __shfl_up(A, 32); tB = __shfl_up(B, 32); if (q >= 2) { B = A * tB + B; A = A * tA; }
            Ae[m] = __shfl_up(A, 16); Be[m] = __shfl_up(B, 16); if (q == 0) { Ae[m] = 1.f; Be[m] = 0.f; }
            At[m] = __shfl(A, 48 + fr); Bt[m] = __shfl(B, 48 + fr);
        } else {
            float tA = __shfl_down(A, 16), tB = __shfl_down(B, 16); if (q <= 2) { B = A * tB + B; A = A * tA; }
            tA = __shfl_down(A, 32); tB = __shfl_down(B, 32); if (q <= 1) { B = A * tB + B; A = A * tA; }
            Ae[m] = __shfl_down(A, 16); Be[m] = __shfl_down(B, 16); if (q == 3) { Ae[m] = 1.f; Be[m] = 0.f; }
            At[m] = __shfl(A, fr); Bt[m] = __shfl(B, fr);
        }
    }
    if (!FINAL) {
        float A = 1.f, B = 0.f;
#pragma unroll
        for (int mm = 0; mm < 4; ++mm) { const int m = DIR ? 3 - mm : mm; B = At[m] * B + Bt[m]; A = At[m] * A; }
        totA = A; totB = B;
    } else {
        float hh = hin_v;
#pragma unroll
        for (int mm = 0; mm < 4; ++mm) { const int m = DIR ? 3 - mm : mm;
            float hs = Ae[m] * hh + Be[m];
#pragma unroll
            for (int ii = 0; ii < 4; ++ii) { const int i = DIR ? 3 - ii : ii; hs = ar[m][i] * hs + ai[m][i]; hout[m][i] = hs; }
            hh = At[m] * hh + Bt[m];
        }
    }
}

template <bool FINAL>
__device__ __forceinline__ void b_phase(const Params& p, int bid, int nb, unsigned char* lds) {
    const int tid = threadIdx.x, lane = tid & 63, wave = tid >> 6, fr = lane & 15, q = lane >> 4;
    f32x2* TOT = (f32x2*)(p.ws + OFF_TOT);
    f32x2* TOT256 = (f32x2*)(p.ws + OFF_TOT256);
    const bf16_t* WG = (const bf16_t*)(p.ws + OFF_WG);
    float* hin = (float*)(lds + B_HIN_OFF);
    const int chl = 16 * wave + fr;
    const int nitems = FINAL ? 1024 : 1024 + 32;
    int hprev = -1;
    bf16x8 fb[4][4];
    float brf = 0.f, bif = 0.f, brb = 0.f, bib = 0.f, nspf = 0.f, nspb = 0.f;
    for (int it = bid; it < nitems; it += nb) {
        const bool isctx = it >= 1024;
        const int b = isctx ? (it - 1024) >> 3 : it >> 8, c256 = isctx ? -1 : (it >> 3) & 31, h = it & 7;
        const int seqlen = isctx ? CTXL : SEQ, sbase = isctx ? 0 : c256 * 256;
        const bf16_t* src = isctx ? (const bf16_t*)(p.ws + OFF_XRC) + (size_t)b * CTXL * 1024 : (const bf16_t*)(p.ws + OFF_SLOT + 3 * SLOT) + (size_t)b * SEQ * 1024;
        const int kc0 = isctx ? 0 : 4 + c256 * 4, k256 = isctx ? 0 : 1 + c256;
        const int ch = h * 128 + chl;
        if (h != hprev) {
            hprev = h;
#pragma unroll
            for (int ty = 0; ty < 4; ++ty)
#pragma unroll
                for (int kk = 0; kk < 4; ++kk) fb[ty][kk] = *(const bf16x8*)(WG + (size_t)(h * 512 + wave * 64 + ty * 16 + fr) * 128 + 32 * kk + 8 * q);
            brf = p.in[I_BRF][ch]; bif = p.in[I_BIF][ch]; brb = p.in[I_BRB][ch]; bib = p.in[I_BIB][ch];
            nspf = -8.0f * log1pf(__expf(-p.in[I_LAMF][ch])); nspb = -8.0f * log1pf(__expf(-p.in[I_LAMB][ch]));
        }
        float runAf = 1.f, runBf = 0.f, runAb = 1.f, runBb = 0.f;
        {
            const int cgp = tid & 15, c0 = h * 128 + 8 * cgp;
            float wk[4][8], bs[8];
            { const f32x4* bp = (const f32x4*)(p.in[I_LCB] + c0); const f32x4 t0_ = bp[0], t1_ = bp[1];
                bs[0] = t0_[0]; bs[1] = t0_[1]; bs[2] = t0_[2]; bs[3] = t0_[3]; bs[4] = t1_[0]; bs[5] = t1_[1]; bs[6] = t1_[2]; bs[7] = t1_[3];
#pragma unroll
                for (int k = 0; k < 4; ++k) { const f32x4* wp = (const f32x4*)(p.in[I_LCW] + k * 1024 + c0); const f32x4 w0 = wp[0], w1 = wp[1];
                    wk[k][0] = w0[0]; wk[k][1] = w0[1]; wk[k][2] = w0[2]; wk[k][3] = w0[3]; wk[k][4] = w1[0]; wk[k][5] = w1[1]; wk[k][6] = w1[2]; wk[k][7] = w1[3]; } }
#pragma unroll 1
            for (int ps = 0; ps < 2; ++ps) {
                const int tq = ps * 128 + (tid >> 4) * 4;
                float xc[4][8];
#pragma unroll
                for (int r = 0; r < 4; ++r)
#pragma unroll
                    for (int e = 0; e < 8; ++e) xc[r][e] = bs[e];
#pragma unroll
                for (int rr = 0; rr < 7; ++rr) {
                    const int row = sbase + tq + rr - 2;
                    u32x4 a = (u32x4){0u, 0u, 0u, 0u};
                    if (row >= 0 && row < seqlen) a = *(const u32x4*)(src + (size_t)row * 1024 + c0);
                    const float x[8] = {bflo(a.x), bfhi(a.x), bflo(a.y), bfhi(a.y), bflo(a.z), bfhi(a.z), bflo(a.w), bfhi(a.w)};
#pragma unroll
                    for (int r = 0; r < 4; ++r) { const int k = rr - r;
                        if (k >= 0 && k < 4) {
#pragma unroll
                            for (int e = 0; e < 8; ++e) xc[r][e] += wk[k][e] * x[e]; } }
                }
#pragma unroll
                for (int r = 0; r < 4; ++r) {
                    u32x4 o0; o0.x = pk2(xc[r][0], xc[r][1]); o0.y = pk2(xc[r][2], xc[r][3]); o0.z = pk2(xc[r][4], xc[r][5]); o0.w = pk2(xc[r][6], xc[r][7]);
                    *(u32x4*)(lds + B_XC_OFF + (tq + r) * XC_STRIDE + cgp * 16) = o0;
                }
            }
        }
        f32x2 ct[33], cs[4];
        const int cdir = (tid >> 7) & 1, ccl = tid & 127;
        if (FINAL && tid < 256) {
            const f32x2* T2 = TOT256 + ((size_t)b * 33 * 2 + cdir) * 1024 + h * 128 + ccl;
            const f32x2* T = TOT + ((size_t)b * NCH64 * 2 + cdir) * 1024 + h * 128 + ccl;
#pragma unroll
            for (int k = 0; k < 33; ++k) { const bool use = cdir == 0 ? (k < k256) : (k == 0 || k > k256); ct[k] = use ? T2[(size_t)k * 2048] : (f32x2){1.f, 0.f}; }
#pragma unroll
            for (int s_ = 0; s_ < 4; ++s_) cs[s_] = T[(size_t)(kc0 + s_) * 2048];
        }
        if (FINAL && tid < 256) {
            float hc = 0.f;
            if (cdir == 0) {
#pragma unroll
                for (int k = 0; k < 33; ++k) hc = ct[k].x * hc + ct[k].y;
#pragma unroll
                for (int s_ = 0; s_ < 4; ++s_) { hin[(s_ * 2 + 0) * 128 + ccl] = hc; hc = cs[s_].x * hc + cs[s_].y; }
            } else {
                hc = ct[0].y;
#pragma unroll
                for (int k = 32; k >= 1; --k) hc = ct[k].x * hc + ct[k].y;
#pragma unroll
                for (int s_ = 3; s_ >= 0; --s_) { hin[(s_ * 2 + 1) * 128 + ccl] = hc; hc = cs[s_].x * hc + cs[s_].y; }
            }
        }
        __syncthreads();
        for (int sub = 0; sub < 4; ++sub) {
            const int t0 = sbase + 64 * sub;
            const unsigned char* xcs = lds + B_XC_OFF + 64 * sub * XC_STRIDE;
            float* ybuf = (float*)(lds + B_Y_OFF + (sub & 1) * B_Y_BYTES);
            const int ot = tid >> 3, oc = (tid & 7) * 16;
            f32x4 hf[4], hb[4]; float tA, tB;
            lru_dir<FINAL, 0>(xcs, fb[0], fb[1], brf, bif, nspf, fr, q, chl, FINAL ? hin[(sub * 2 + 0) * 128 + chl] : 0.f, hf, tA, tB);
            if (!FINAL) { if (q == 0) TOT[((size_t)(b * NCH64 + kc0 + sub) * 2 + 0) * 1024 + ch] = (f32x2){tA, tB};
                runBf = tA * runBf + tB; runAf = tA * runAf; }
            u32x4 gy0, gy1;
            if (FINAL) { const bf16_t* GYG = (const bf16_t*)(p.ws + OFF_SLOT + 2 * SLOT) + ((size_t)b * SEQ + t0 + ot) * 1024 + h * 128 + oc;
                gy0 = *(const u32x4*)GYG; gy1 = *(const u32x4*)(GYG + 8); }
            lru_dir<FINAL, 1>(xcs, fb[2], fb[3], brb, bib, nspb, fr, q, chl, FINAL ? hin[(sub * 2 + 1) * 128 + chl] : 0.f, hb, tA, tB);
            if (!FINAL) { if (q == 0) TOT[((size_t)(b * NCH64 + kc0 + sub) * 2 + 1) * 1024 + ch] = (f32x2){tA, tB};
                runBb = runAb * tB + runBb; runAb = runAb * tA; }
            if (FINAL) {
#pragma unroll
                for (int m = 0; m < 4; ++m)
#pragma unroll
                    for (int i = 0; i < 4; ++i) ybuf[(16 * m + 4 * q + i) * YB_STRIDE + chl] = hf[m][i] + hb[m][i];
                __syncthreads();
                const f32x4* yp = (const f32x4*)(ybuf + ot * YB_STRIDE + oc);
                const f32x4 y0 = yp[0], y1 = yp[1], y2 = yp[2], y3 = yp[3];
                u32x4 o0, o1;
                o0.x = pk2(bflo(gy0.x) * y0[0], bfhi(gy0.x) * y0[1]); o0.y = pk2(bflo(gy0.y) * y0[2], bfhi(gy0.y) * y0[3]);
                o0.z = pk2(bflo(gy0.z) * y1[0], bfhi(gy0.z) * y1[1]); o0.w = pk2(bflo(gy0.w) * y1[2], bfhi(gy0.w) * y1[3]);
                o1.x = pk2(bflo(gy1.x) * y2[0], bfhi(gy1.x) * y2[1]); o1.y = pk2(bflo(gy1.y) * y2[2], bfhi(gy1.y) * y2[3]);
                o1.z = pk2(bflo(gy1.z) * y3[0], bfhi(gy1.z) * y3[1]); o1.w = pk2(bflo(gy1.w) * y3[2], bfhi(gy1.w) * y3[3]);
                bf16_t* AB = (bf16_t*)(p.ws + OFF_SLOT + 1 * SLOT) + ((size_t)b * SEQ + t0 + ot) * 1024 + h * 128 + oc;
                *(u32x4*)AB = o0; *(u32x4*)(AB + 8) = o1;
            }
        }
        __syncthreads();
        if (!FINAL && q == 0) {
            TOT256[((size_t)(b * 33 + k256) * 2 + 0) * 1024 + ch] = (f32x2){runAf, runBf};
            TOT256[((size_t)(b * 33 + k256) * 2 + 1) * 1024 + ch] = (f32x2){runAb, runBb};
        }
    }
}

__device__ __forceinline__ void ph8_route(const Params& p, int bid, int nb, unsigned char* lds) {
    const int tid = threadIdx.x, lane = tid & 63, wave = tid >> 6;
    float* Wl = (float*)lds;
    int* lcnt = (int*)(lds + 81920);
    int* lbase = lcnt + 16;
    int* tinfo = lcnt + 32;
    float* twt = (float*)(tinfo + 512);
    for (int i = tid; i < 1024 * 20; i += NTHR) { const int k = i / 20, o = i % 20; Wl[o * 1024 + k] = o < 4 ? p.in[I_WGRP][k * 4 + o] : p.in[I_WER][k * 16 + o - 4]; }
    __syncthreads();
    const float* MOD = (const float*)(p.ws + OFF_MOD);
    const float* X1 = p.out;
    bf16_t* HM = (bf16_t*)(p.ws + OFF_SLOT + 2 * SLOT);
    unsigned* gcnt = (unsigned*)(p.ws + OFF_CTL);
    int* LIST = (int*)(p.ws + OFF_LIST); float* WLs = (float*)(p.ws + OFF_WL); int* ROUTE = (int*)(p.ws + OFF_ROUTE);
    for (int tile = bid; tile < NT / 128; tile += nb) {
        if (tid < 16) lcnt[tid] = 0;
        __syncthreads();
        for (int tt = 0; tt < 16; ++tt) {
            const int tl = wave * 16 + tt, tok = tile * 128 + tl;
            const float* mrow = MOD + (tok / SEQ) * 6144;
            f32x4 v[4]; float ss = 0.f;
#pragma unroll
            for (int j = 0; j < 4; ++j) { v[j] = *(const f32x4*)(X1 + (size_t)tok * DM + lane * 4 + 256 * j); ss += v[j][0] * v[j][0] + v[j][1] * v[j][1] + v[j][2] * v[j][2] + v[j][3] * v[j][3]; }
            const float rinv = rsqrtf(wave_sum(ss) * (1.0f / DM) + 1e-6f);
            float lg[20];
#pragma unroll
            for (int o = 0; o < 20; ++o) lg[o] = 0.f;
#pragma unroll
            for (int j = 0; j < 4; ++j) { const int c = lane * 4 + 256 * j;
                const f32x4 g = *(const f32x4*)(p.in[I_GFFN] + c), sh = *(const f32x4*)(mrow + 3 * 1024 + c), sc = *(const f32x4*)(mrow + 4 * 1024 + c);
                f32x4 hm;
#pragma unroll
                for (int e = 0; e < 4; ++e) hm[e] = v[j][e] * rinv * g[e] * (1.0f + sc[e]) + sh[e];
#pragma unroll
                for (int o = 0; o < 20; ++o) { const f32x4 wv = *(const f32x4*)(Wl + o * 1024 + c); lg[o] += hm[0] * wv[0] + hm[1] * wv[1] + hm[2] * wv[2] + hm[3] * wv[3]; }
                *(u32x2*)(HM + (size_t)tok * DM + c) = pk4(hm); }
#pragma unroll
            for (int o = 0; o < 20; ++o) lg[o] = wave_sum(lg[o]);
#pragma unroll
            for (int o = 0; o < 4; ++o) lg[o] += p.in[I_BGRP][o];
#pragma unroll
            for (int o = 0; o < 16; ++o) lg[4 + o] += p.in[I_BER][o];
            int gs = 0; float gm = lg[0];
#pragma unroll
            for (int o = 1; o < 4; ++o) if (lg[o] > gm) { gm = lg[o]; gs = o; }
            float den = 0.f;
#pragma unroll
            for (int o = 0; o < 4; ++o) den += __expf(lg[o] - gm);
            const float pg = 1.0f / den;
            float el[4];
#pragma unroll
            for (int o = 0; o < 4; ++o) el[o] = gs == 0 ? lg[4 + o] : gs == 1 ? lg[8 + o] : gs == 2 ? lg[12 + o] : lg[16 + o];
            int i1 = 0; float v1 = el[0];
#pragma unroll
            for (int o = 1; o < 4; ++o) if (el[o] > v1) { v1 = el[o]; i1 = o; }
            int i2 = -1; float v2 = -3.0e38f;
#pragma unroll
            for (int o = 0; o < 4; ++o) if (o != i1 && el[o] > v2) { v2 = el[o]; i2 = o; }
            const float w1 = 1.0f / (1.0f + __expf(v2 - v1)), w2 = 1.0f - w1;
            if (lane == 0) { const int e1 = gs * 4 + i1, e2 = gs * 4 + i2;
                const int r1 = atomicAdd(&lcnt[e1], 1), r2 = atomicAdd(&lcnt[e2], 1);
                tinfo[tl * 4 + 0] = e1; tinfo[tl * 4 + 1] = r1; tinfo[tl * 4 + 2] = e2; tinfo[tl * 4 + 3] = r2; twt[tl * 2] = pg * w1; twt[tl * 2 + 1] = pg * w2; }
        }
        __syncthreads();
        if (tid < 16) lbase[tid] = (int)__hip_atomic_fetch_add(gcnt + tid, (unsigned)lcnt[tid], __ATOMIC_RELAXED, __HIP_MEMORY_SCOPE_AGENT);
        __syncthreads();
        if (tid < 128) { const int tok = tile * 128 + tid;
            const int e1 = tinfo[tid * 4], e2 = tinfo[tid * 4 + 2], p1 = lbase[e1] + tinfo[tid * 4 + 1], p2 = lbase[e2] + tinfo[tid * 4 + 3];
            LIST[e1 * NT + p1] = tok; LIST[e2 * NT + p2] = tok; WLs[e1 * NT + p1] = twt[tid * 2]; WLs[e2 * NT + p2] = twt[tid * 2 + 1];
            ROUTE[tok * 4 + 0] = e1; ROUTE[tok * 4 + 1] = p1; ROUTE[tok * 4 + 2] = e2; ROUTE[tok * 4 + 3] = p2; }
        __syncthreads();
    }
}

__device__ __forceinline__ void ph10_final(const Params& p, int bid, int nb, const int* meta) {
    const int lane = threadIdx.x & 63, wave = threadIdx.x >> 6;
    const float* MOD = (const float*)(p.ws + OFF_MOD);
    const bf16_t* Y = (const bf16_t*)(p.ws + OFF_SLOT);
    const int* ROUTE = (const int*)(p.ws + OFF_ROUTE);
    float* X1 = p.out;
    for (int r = bid * 8 + wave; r < NT; r += nb * 8) {
        const int e1 = ROUTE[r * 4], p1 = ROUTE[r * 4 + 1], e2 = ROUTE[r * 4 + 2], p2 = ROUTE[r * 4 + 3];
        const bf16_t* y1 = Y + ((size_t)meta[16 + e1] * 256 + p1) * 1024; const bf16_t* y2 = Y + ((size_t)meta[16 + e2] * 256 + p2) * 1024;
        const float* gt = MOD + (r / SEQ) * 6144 + 5 * 1024;
        f32x4 v[4]; float ss = 0.f;
#pragma unroll
        for (int j = 0; j < 4; ++j) { const int c = lane * 4 + 256 * j;
            v[j] = *(const f32x4*)(X1 + (size_t)r * DM + c);
            const u32x2 a = *(const u32x2*)(y1 + c), bq = *(const u32x2*)(y2 + c); const f32x4 g = *(const f32x4*)(gt + c);
            v[j][0] += g[0] * (bflo(a.x) + bflo(bq.x)); v[j][1] += g[1] * (bfhi(a.x) + bfhi(bq.x)); v[j][2] += g[2] * (bflo(a.y) + bflo(bq.y)); v[j][3] += g[3] * (bfhi(a.y) + bfhi(bq.y));
            ss += v[j][0] * v[j][0] + v[j][1] * v[j][1] + v[j][2] * v[j][2] + v[j][3] * v[j][3]; }
        const float rinv = rsqrtf(wave_sum(ss) * (1.0f / DM) + 1e-6f);
#pragma unroll
        for (int j = 0; j < 4; ++j) { const int c = lane * 4 + 256 * j; const f32x4 g = *(const f32x4*)(p.in[I_GFINAL] + c);
            *(f32x4*)(X1 + (size_t)r * DM + c) = v[j] * rinv * g; }
    }
}


#define XB_TMO      128
#define XB_XCNT(j)  (256  + 64 * (j))
#define XB_XSUB(j)  (1280 + 64 * (j))
#define XB_XGEN(j)  (2304 + 64 * (j))
#define XB_TOP      3328
#define XB_TOPGEN   3392
#define XCD_BAR_WORDS 3456
#define XB_SPIN_CAP (1u << 18)
__device__ __forceinline__ unsigned xb_ld(unsigned* p)              { return __hip_atomic_load(p, __ATOMIC_RELAXED, __HIP_MEMORY_SCOPE_AGENT); }
__device__ __forceinline__ unsigned xb_add(unsigned* p, unsigned v) { return __hip_atomic_fetch_add(p, v, __ATOMIC_RELAXED, __HIP_MEMORY_SCOPE_AGENT); }
__device__ __forceinline__ unsigned xb_xcc_id() { return (unsigned)__builtin_amdgcn_s_getreg((3 << 11) | 20) & 0xFu; }
#define XB_SPIN(cond, bar) do { unsigned _sp = 0; while (cond) { __builtin_amdgcn_s_sleep(1); \
    if ((++_sp & 255u) == 0u) { if (xb_ld(&(bar)[XB_TMO])) break; if (_sp > XB_SPIN_CAP) { atomicAdd(&(bar)[XB_TMO], 1u); break; } } } } while (0)
struct XcdBarrier { unsigned* bar; unsigned x; volatile unsigned* st; };
__device__ __forceinline__ XcdBarrier xcd_barrier_post(unsigned* bar, volatile unsigned* st) {
    XcdBarrier b; b.bar = bar; b.x = xb_xcc_id(); b.st = st;
    if (threadIdx.x == 0) (void)xb_add(&bar[XB_XCNT(b.x)], 1u);
    return b;
}
__device__ __forceinline__ void xcd_barrier_complete(unsigned* bar, unsigned x, unsigned& nloc, unsigned& nx) {
    const unsigned G = gridDim.x * gridDim.y * gridDim.z;
    unsigned sum, cnt, mine, sp = 0u;
    for (;;) {
        sum = 0u; cnt = 0u; mine = 0u;
#pragma unroll
        for (unsigned j = 0; j < 16; ++j) { const unsigned c = xb_ld(&bar[XB_XCNT(j)]); sum += c; cnt += (c > 0u) ? 1u : 0u; mine = (j == x) ? c : mine; }
        if (sum == G) break;
        __builtin_amdgcn_s_sleep(1);
        if ((++sp & 255u) == 0u) { if (xb_ld(&bar[XB_TMO])) break; if (sp > XB_SPIN_CAP) { atomicAdd(&bar[XB_TMO], 1u); break; } }
    }
    nloc = mine > 0u ? mine : 1u; nx = cnt > 0u ? cnt : 1u;
}
__device__ __forceinline__ void xcd_barrier(const XcdBarrier& b) {
    asm volatile("s_waitcnt vmcnt(0)" ::: "memory");
    __syncthreads();
    if (threadIdx.x == 0) {
        unsigned* bar = b.bar;
        __builtin_amdgcn_s_waitcnt(0);
        unsigned nloc = b.st[0], nx = b.st[1];
        if (nloc == 0u) { xcd_barrier_complete(bar, b.x, nloc, nx); b.st[0] = nloc; b.st[1] = nx; }
        const unsigned old = xb_add(&bar[XB_XSUB(b.x)], 1u);
        const unsigned gen = old / nloc;
        if (old + 1u == (gen + 1u) * nloc) {
            __builtin_amdgcn_fence(__ATOMIC_RELEASE, "agent");
            asm volatile("s_waitcnt vmcnt(0)" ::: "memory");
            const unsigned og = xb_add(&bar[XB_TOP], 1u);
            const unsigned tg = og / nx;
            if (og + 1u == (tg + 1u) * nx) xb_add(&bar[XB_TOPGEN], 1u);
            else XB_SPIN(xb_ld(&bar[XB_TOPGEN]) == tg, bar);
            __builtin_amdgcn_fence(__ATOMIC_ACQUIRE, "agent");
            xb_add(&bar[XB_XGEN(b.x)], 1u);
            asm volatile("s_waitcnt vmcnt(0)" ::: "memory");
        } else {
            XB_SPIN(xb_ld(&bar[XB_XGEN(b.x)]) == gen, bar);
            __builtin_amdgcn_fence(__ATOMIC_ACQUIRE, "agent");
            asm volatile("s_waitcnt vmcnt(0)" ::: "memory");
        }
    }
    __syncthreads();
}
constexpr size_t OFF_BAR = OFF_CTL + 4096;

__global__ void __launch_bounds__(NTHR) mega(Params p, int lo, int hi) {
    extern __shared__ __attribute__((aligned(16))) unsigned char lds[];
    cg::grid_group grid = cg::this_grid();
    const int bid = blockIdx.x, nb = gridDim.x;
    unsigned char* ws = p.ws;
    bf16_t* S0 = (bf16_t*)(ws + OFF_SLOT), *S1 = (bf16_t*)(ws + OFF_SLOT + SLOT), *S2 = (bf16_t*)(ws + OFF_SLOT + 2 * SLOT), *S3 = (bf16_t*)(ws + OFF_SLOT + 3 * SLOT),
           *S4 = (bf16_t*)(ws + OFF_SLOT + 4 * SLOT), *S5 = (bf16_t*)(ws + OFF_SLOT + 5 * SLOT);
    const float* MOD = (const float*)(ws + OFF_MOD); const float* BINP = (const float*)(ws + OFF_BINP);
    int* meta = (int*)(lds + LDS_BYTES - 256);
#ifndef PHMASK
#define PHMASK 0x7ff
#endif
#define IN(k) (((PHMASK >> (k)) & 1) && lo <= (k) && (k) < hi)
#ifndef PIPE_MASK
#define PIPE_MASK 0x364
#endif
#define GEMM_RUN(k, gather, s, e) gemm_phase_pipe<gather>(lds, s, e)
    volatile unsigned* xst = (volatile unsigned*)(lds + LDS_BYTES - 16);
    if (threadIdx.x < 2) xst[threadIdx.x] = 0u;
    __syncthreads();
    XcdBarrier xbar; xbar.bar = (unsigned*)(ws + OFF_BAR); xbar.x = 0; xbar.st = xst;
    if (hi - lo > 1) xbar = xcd_barrier_post((unsigned*)(ws + OFF_BAR), xst);
    if (p.pv == 0x7eadbeef) grid.sync();
#define SEAM(k) do { if (IN(k) && IN((k) + 1)) xcd_barrier(xbar); } while (0)
    if (IN(0)) { ph0_prep(p, bid, nb, lds); } SEAM(0);
    if (IN(1)) { ph1_norm(p, bid, nb); } SEAM(1);
    if (IN(2)) {
        { SchCtx s{(const bf16_t*)(ws + OFF_HC), (const bf16_t*)(ws + OFF_WIN), nb, bid, 1024}; EpiCtx e{(bf16_t*)(ws + OFF_XRC), BINP}; GEMM_RUN(2, false, s, e); }
        { SchG1 s{S0, (const bf16_t*)(ws + OFF_WIN), nb, bid, 1024}; EpiG1 e{S1, S2, S3, S4, S5, BINP}; GEMM_RUN(2, false, s, e); }
    } SEAM(2);
    if (IN(3)) {
        for (int g = bid; g < 512; g += nb) aprep_item(p, g, lds);
        b_phase<false>(p, bid, nb, lds);
    } SEAM(3);
    if (IN(4)) {
        b_phase<true>(p, bid, nb, lds);
    } SEAM(4);
    if (IN(5)) { SchG2 s{S0, S1, (const bf16_t*)(ws + OFF_WPA), (const bf16_t*)(ws + OFF_WPB), nb, bid, 1024}; EpiG2 e{S4, S5, S3}; GEMM_RUN(5, false, s, e); } SEAM(5);
    if (IN(6)) { SchG3 s{S3, (const bf16_t*)(ws + OFF_WO), nb, bid, 1024}; EpiG3 e{p.in[I_X], MOD, p.out}; GEMM_RUN(6, false, s, e); } SEAM(6);
    if (IN(7)) { ph8_route(p, bid, nb, lds); } SEAM(7);
    if (IN(8)) { __syncthreads(); moe_meta_build(p, meta); MoeMeta mm{meta};
        int* idx = (int*)(lds + STAGE_BYTES);
        SchUp s{S2, (const bf16_t*)(ws + OFF_WGU), (const int*)(ws + OFF_LIST), mm, nb, bid, 1024, idx}; EpiUp e{S4, (const float*)(ws + OFF_WL), mm};
        { Unit u; for (int i = 0; i < 8 && s.next(i, u); ++i) { if (threadIdx.x < 256) { int pos = u.aux2 + (int)threadIdx.x; const int c = mm.cnt(u.aux); pos = pos < c ? pos : c - 1; idx[i * 256 + threadIdx.x] = s.LIST[u.aux * NT + pos]; } } }
        __syncthreads();
        GEMM_RUN(8, true, s, e); } SEAM(8);
    if (IN(9)) { __syncthreads(); moe_meta_build(p, meta); MoeMeta mm{meta};
        SchDn s{S4, (const bf16_t*)(ws + OFF_WDN), mm, nb, bid, 512}; EpiDn e{S0, mm}; GEMM_RUN(9, false, s, e); } SEAM(9);
    if (IN(10)) { __syncthreads(); moe_meta_build(p, meta); ph10_final(p, bid, nb, meta); }
#undef IN
#undef SEAM
}

extern "C" void kernel_launch(void* const* d_in, const int* in_sizes, int n_in, void* d_out, int out_size, void* d_ws, size_t ws_size, hipStream_t stream) {
    static int grid = 0;
    if (grid == 0) {
        if (n_in != 37 || out_size != NT * DM || ws_size < WS_END) { fprintf(stderr, "kernel_launch: unexpected shapes: n_in %d out %d ws %zu (need %zu)\n", n_in, out_size, ws_size, (size_t)WS_END); grid = -1; return; }
        int dev = 0, cus = 0, per_cu = 0;
        (void)hipGetDevice(&dev); (void)hipDeviceGetAttribute(&cus, hipDeviceAttributeMultiprocessorCount, dev);
        if (hipFuncSetAttribute((const void*)mega, hipFuncAttributeMaxDynamicSharedMemorySize, LDS_BYTES) != hipSuccess) { fprintf(stderr, "kernel_launch: hipFuncSetAttribute failed\n"); grid = -1; return; }
        if (hipOccupancyMaxActiveBlocksPerMultiprocessor(&per_cu, (const void*)mega, NTHR, LDS_BYTES) != hipSuccess || per_cu < 1) { fprintf(stderr, "kernel_launch: occupancy query says %d\n", per_cu); per_cu = 1; }
        (void)hipGetLastError();
        grid = cus * 1;
        fprintf(stderr, "kernel_launch: grid %d (cus %d, per_cu %d)\n", grid, cus, per_cu);
    }
    if (grid < 0) return;
    Params p{};
    for (int i = 0; i < 37; ++i) p.in[i] = (const float*)d_in[i];
    p.out = (float*)d_out; p.ws = (unsigned char*)d_ws;
#if ONE_LAUNCH
    (void)hipMemsetAsync((unsigned char*)d_ws + OFF_BAR, 0, XCD_BAR_WORDS * 4, stream);
    int lo = 0, hi = NPHASE; void* args[] = {&p, &lo, &hi};
    hipError_t e = hipLaunchCooperativeKernel((const void*)mega, dim3(grid), dim3(NTHR), args, LDS_BYTES, stream);
    if (e != hipSuccess) fprintf(stderr, "cooperative launch failed: %s (grid %d)\n", hipGetErrorString(e), grid);
#ifdef PROBE_PHASE
    hipLaunchKernelGGL(mega, dim3(grid), dim3(NTHR), LDS_BYTES, stream, p, PROBE_PHASE, PROBE_PHASE + 1);
#endif
#else
    for (int k = 0; k < NPHASE; ++k) hipLaunchKernelGGL(mega, dim3(grid), dim3(NTHR), LDS_BYTES, stream, p, k, k + 1);
#endif
}
```

```cpp
#include <hip/hip_runtime.h>
#include <hip/hip_cooperative_groups.h>
#include <cstdio>
#include <cstdint>
namespace cg = cooperative_groups;

#ifndef ONE_LAUNCH
#define ONE_LAUNCH 1
#endif

typedef unsigned short bf16_t;
typedef short bf16x8 __attribute__((ext_vector_type(8)));
typedef float f32x4 __attribute__((ext_vector_type(4)));
typedef float f32x2 __attribute__((ext_vector_type(2)));
typedef unsigned u32x4 __attribute__((ext_vector_type(4)));
typedef unsigned u32x2 __attribute__((ext_vector_type(2)));

constexpr int NT = 32768, NCX = 1024, DM = 1024, SEQ = 8192, CTXL = 256;
constexpr int NTHR = 512;
constexpr int NCH64 = 132;
constexpr size_t MiB = (size_t)1 << 20;
constexpr size_t OFF_CTL = 0, OFF_MOD = 1 * MiB, OFF_BINP = OFF_MOD + 128 * 1024, OFF_WIN = 2 * MiB, OFF_WPA = 14 * MiB, OFF_WPB = 16 * MiB,
                 OFF_WO = 18 * MiB, OFF_WG = 20 * MiB, OFF_WGU = 22 * MiB, OFF_WDN = 54 * MiB, OFF_HC = 70 * MiB, OFF_XRC = 72 * MiB,
                 OFF_TOT = 74 * MiB, OFF_ROUTE = 84 * MiB, OFF_LIST = 85 * MiB, OFF_WL = 87 * MiB, OFF_SLOT = 90 * MiB, SLOT = 64 * MiB,
                 WS_END = OFF_SLOT + 6 * SLOT;
constexpr int LDS_BYTES = 144 * 1024;
constexpr int NPHASE = 11;

struct Params { const float* in[37]; float* out; unsigned char* ws; int pv; int pad; };

enum { I_X = 0, I_C, I_CTX, I_CCTX, I_WADA, I_BADA, I_GMIX, I_WIN, I_BIN, I_CONVW, I_CONVB, I_LNG, I_LNB, I_WPA, I_LCW, I_LCB,
       I_WRF, I_BRF, I_WIF, I_BIF, I_LAMF, I_WRB, I_BRB, I_WIB, I_BIB, I_LAMB, I_WPB, I_WO, I_GFFN, I_WGRP, I_BGRP, I_WER, I_BER,
       I_WGATE, I_WUP, I_WDOWN, I_GFINAL };

__device__ __forceinline__ float bflo(unsigned w) { return __uint_as_float(w << 16); }
__device__ __forceinline__ float bfhi(unsigned w) { return __uint_as_float(w & 0xffff0000u); }
__device__ __forceinline__ float bf2f(bf16_t h) { return __uint_as_float(((unsigned)h) << 16); }
__device__ __forceinline__ unsigned pk2(float lo, float hi) { unsigned r; asm("v_cvt_pk_bf16_f32 %0, %1, %2" : "=v"(r) : "v"(lo), "v"(hi)); return r; }
__device__ __forceinline__ bf16_t f2bf(float f) { return (bf16_t)(pk2(f, 0.f) & 0xffffu); }
__device__ __forceinline__ float sigm(float x) { return __builtin_amdgcn_rcpf(1.0f + __expf(-x)); }
__device__ __forceinline__ float silu(float x) { return x * sigm(x); }
__device__ __forceinline__ float gelu_tanh(float x) { return x * sigm(1.5957691216057308f * (x + 0.044715f * x * x * x)); }
__device__ __forceinline__ float wave_sum(float v) {
#pragma unroll
    for (int o = 1; o < 64; o <<= 1) v += __shfl_xor(v, o);
    return v;
}
__device__ __forceinline__ void wave_lds_sync() { asm volatile("s_waitcnt lgkmcnt(0)" ::: "memory"); __builtin_amdgcn_wave_barrier(); }
__device__ __forceinline__ u32x2 pk4(f32x4 v) { u32x2 r; r.x = pk2(v[0], v[1]); r.y = pk2(v[2], v[3]); return r; }

template <class DRow>
__device__ __forceinline__ void tr_item(const float* __restrict__ src, int ldsrc, int k0, int n0, bf16_t* dst, int ldd, DRow drow, float* scr, int lane) {
#pragma unroll 8
    for (int i = 0; i < 32; ++i) { const int kk = 2 * i + (lane >> 5); scr[kk * 33 + (lane & 31)] = src[(size_t)(k0 + kk) * ldsrc + n0 + (lane & 31)]; }
    wave_lds_sync();
    const int c = lane & 7;
#pragma unroll
    for (int j = 0; j < 4; ++j) {
        const int n = (lane >> 3) + 8 * j; const float* s = scr + (8 * c) * 33 + n;
        u32x4 o; o.x = pk2(s[0], s[33]); o.y = pk2(s[66], s[99]); o.z = pk2(s[132], s[165]); o.w = pk2(s[198], s[231]);
        *(u32x4*)(dst + (size_t)drow(n0 + n) * ldd + k0 + 8 * c) = o;
    }
    wave_lds_sync();
}

__device__ __forceinline__ int win_srccol(int np) { const int p = np >> 8, r = np & 255; return p < 8 ? (r >> 7) * 1024 + 128 * p + (r & 127) : np; }

__device__ __forceinline__ void ph0_prep(const Params& p, int bid, int nb, unsigned char* lds) {
    const int tid = threadIdx.x, lane = tid & 63, wave = tid >> 6;
    unsigned char* ws = p.ws;
    float* scr = (float*)lds + wave * (64 * 33);
    const int gw = bid * 8 + wave, NGW = nb * 8;
    constexpr int N_WIN = 16 * 192, N_SQ = 16 * 32, N_G = 256, N_GU = 4096, N_DN = 4096;
    constexpr int NITEMS = N_WIN + 3 * N_SQ + N_G + 2 * N_GU + N_DN;
    for (int it = gw; it < NITEMS; it += NGW) {
        int r = it;
        if (r < N_WIN) { const int kb = r / 192, nbk = r % 192, d0 = 32 * nbk, sc0 = win_srccol(d0);
            tr_item(p.in[I_WIN], 6144, 64 * kb, sc0, (bf16_t*)(ws + OFF_WIN), 1024, [=](int n) { return n - sc0 + d0; }, scr, lane); continue; }
        r -= N_WIN;
        if (r < 3 * N_SQ) { const int which = r / N_SQ, q = r % N_SQ, kb = q / 32, nbk = q % 32;
            const float* src = which == 0 ? p.in[I_WPA] : which == 1 ? p.in[I_WPB] : p.in[I_WO];
            bf16_t* dst = (bf16_t*)(ws + (which == 0 ? OFF_WPA : which == 1 ? OFF_WPB : OFF_WO));
            tr_item(src, 1024, 64 * kb, 32 * nbk, dst, 1024, [=](int n) { return n; }, scr, lane); continue; }
        r -= 3 * N_SQ;
        if (r < N_G) { const int ty = r / 64, q = r % 64, h = q / 8, kb = (q % 8) / 4, nbk = q % 4;
            const float* src = (ty == 0 ? p.in[I_WRF] : ty == 1 ? p.in[I_WIF] : ty == 2 ? p.in[I_WRB] : p.in[I_WIB]) + (size_t)h * 128 * 128;
            tr_item(src, 128, 64 * kb, 32 * nbk, (bf16_t*)(ws + OFF_WG), 128, [=](int n) { return h * 512 + (n >> 4) * 64 + ty * 16 + (n & 15); }, scr, lane); continue; }
        r -= N_G;
        if (r < 2 * N_GU) { const int bj = r / N_GU, q = r % N_GU, e = q / 256, kb = (q % 256) / 16, nbk = q % 16;
            const float* src = (bj == 0 ? p.in[I_WGATE] : p.in[I_WUP]) + (size_t)e * 1024 * 512;
            tr_item(src, 512, 64 * kb, 32 * nbk, (bf16_t*)(ws + OFF_WGU) + (size_t)e * 1024 * 1024, 1024, [=](int n) { return 256 * (n >> 7) + 128 * bj + (n & 127); }, scr, lane); continue; }
        r -= 2 * N_GU;
        { const int e = r / 256, kb = (r % 256) / 32, nbk = r % 32;
            tr_item(p.in[I_WDOWN] + (size_t)e * 512 * 1024, 1024, 64 * kb, 32 * nbk, (bf16_t*)(ws + OFF_WDN) + (size_t)e * 1024 * 512, 512, [=](int n) { return n; }, scr, lane); }
    }
    __syncthreads();
    float* red = (float*)lds;
    float* MOD = (float*)(ws + OFF_MOD);
    for (int it = bid; it < 96; it += nb) {
        const int col = it * 64 + lane;
        float a[5] = {0.f, 0.f, 0.f, 0.f, 0.f};
        const float* W = p.in[I_WADA];
        for (int k = wave * 128; k < wave * 128 + 128; ++k) {
            const float wv = W[(size_t)k * 6144 + col];
#pragma unroll
            for (int r = 0; r < 5; ++r) { const float cv = r < 4 ? p.in[I_C][r * 1024 + k] : p.in[I_CCTX][k]; a[r] += silu(cv) * wv; }
        }
#pragma unroll
        for (int r = 0; r < 5; ++r) red[(wave * 5 + r) * 64 + lane] = a[r];
        __syncthreads();
        if (tid < 320) { const int r = tid / 64, l = tid % 64; float s = 0.f;
#pragma unroll
            for (int w = 0; w < 8; ++w) s += red[(w * 5 + r) * 64 + l];
            MOD[r * 6144 + it * 64 + l] = s + p.in[I_BADA][it * 64 + l]; }
        __syncthreads();
    }
    float* BINP = (float*)(ws + OFF_BINP);
    for (int i = bid * NTHR + tid; i < 6144; i += nb * NTHR) BINP[i] = p.in[I_BIN][win_srccol(i)];
    if (bid == 0 && tid < 64) ((unsigned*)(ws + OFF_CTL))[tid] = 0u;
}

__device__ __forceinline__ void ph1_norm(const Params& p, int bid, int nb) {
    const int lane = threadIdx.x & 63, wave = threadIdx.x >> 6;
    const float* MOD = (const float*)(p.ws + OFF_MOD);
    for (int r = bid * 8 + wave; r < NT + NCX; r += nb * 8) {
        const bool lat = r < NT;
        const float* src = lat ? p.in[I_X] + (size_t)r * DM : p.in[I_CTX] + (size_t)(r - NT) * DM;
        bf16_t* dst = lat ? (bf16_t*)(p.ws + OFF_SLOT) + (size_t)r * DM : (bf16_t*)(p.ws + OFF_HC) + (size_t)(r - NT) * DM;
        const float* mrow = MOD + (lat ? r / SEQ : 4) * 6144;
        f32x4 v[4]; float ss = 0.f;
#pragma unroll
        for (int j = 0; j < 4; ++j) { v[j] = *(const f32x4*)(src + lane * 4 + 256 * j); ss += v[j][0] * v[j][0] + v[j][1] * v[j][1] + v[j][2] * v[j][2] + v[j][3] * v[j][3]; }
        const float rinv = rsqrtf(wave_sum(ss) * (1.0f / DM) + 1e-6f);
#pragma unroll
        for (int j = 0; j < 4; ++j) { const int c = lane * 4 + 256 * j;
            const f32x4 g = *(const f32x4*)(p.in[I_GMIX] + c), sh = *(const f32x4*)(mrow + c), sc = *(const f32x4*)(mrow + 1024 + c);
            f32x4 o;
#pragma unroll
            for (int e = 0; e < 4; ++e) o[e] = v[j][e] * rinv * g[e] * (1.0f + sc[e]) + sh[e];
            *(u32x2*)(dst + c) = pk4(o); }
    }
}

struct Unit { int pm, pn, aux, aux2; };

#define LAS __attribute__((address_space(3)))
constexpr int BK = 64, HTB = 128 * BK * 2, STAGE_BYTES = 8 * HTB;
__device__ __forceinline__ int lds_byte(int r, int c) { const int st = (r >> 4) * 2 + (c >> 5), rr = r & 15, cc = c & 31, ob = rr * 64 + cc * 2; return st * 1024 + (ob ^ (((ob >> 9) & 1) << 5)); }
__device__ __forceinline__ void stage_rc(int b, int& R, int& C) { const int st = b / 1024, sb = b % 1024, swz = sb ^ (((sb >> 9) & 1) << 5); R = (st >> 1) * 16 + swz / 64; C = (st & 1) * 32 + (swz % 64) / 2; }

template <bool GATHER, class S, class E>
__device__ __forceinline__ void gemm_phase_pipe(unsigned char* ldsg, const S& sch, const E& epi) {
    LAS unsigned char* lds = (LAS unsigned char*)ldsg;
    const int tid = threadIdx.x, wid = __builtin_amdgcn_readfirstlane(tid >> 6), lane = tid & 63, wr = wid >> 2, wc = wid & 3, fr = lane & 15, fq = lane >> 4;
    const int K = sch.K, nt = K / BK;
    int Rr[2], Cc[2]; unsigned voffA[2], voffB[2];
#pragma unroll
    for (int i = 0; i < 2; ++i) { stage_rc(tid * 16 + i * 8192, Rr[i], Cc[i]); voffA[i] = (unsigned)(Rr[i] * K + Cc[i]) * 2u;
        const int rho = Rr[i] & 31, Rb = (Rr[i] & ~31) + 8 * ((rho & 15) >> 2) + 4 * (rho >> 4) + (rho & 3);
        voffB[i] = (unsigned)(Rb * K + Cc[i]) * 2u; }
    const size_t kstep = (size_t)(BK * 2);
    const size_t hstep = (size_t)128 * K * 2;
    const unsigned ldsw = (unsigned)wid * 1024u;
    const int aoff = lds_byte(wr * 64 + fr, fq * 8), boff = lds_byte(wc * 32 + fr, fq * 8);
#define PG8_SA(b, h) (((b) * 2 + (h)) * HTB)
#define PG8_SB(b, h) ((4 + (b) * 2 + (h)) * HTB)
#define PG8_STAGE_B(bufoff, gbase) do { _Pragma("unroll") for (int _i = 0; _i < 2; ++_i) \
        __builtin_amdgcn_global_load_lds((const unsigned*)((const char*)(gbase) + voffB[_i]), (LAS unsigned*)(lds + (bufoff) + ldsw + _i * 8192), 16, 0, 0); } while (0)
#define PG8_STAGE_A(bufoff, gbase, h, vo) do { _Pragma("unroll") for (int _i = 0; _i < 2; ++_i) \
        __builtin_amdgcn_global_load_lds((const unsigned*)((const char*)(gbase) + (GATHER ? (size_t)(vo)[h][_i] : (size_t)(h) * hstep + voffA[_i])), (LAS unsigned*)(lds + (bufoff) + ldsw + _i * 8192), 16, 0, 0); } while (0)
#define PG8_LDA(dst, b, h) do { _Pragma("unroll") for (int m = 0; m < 4; ++m) _Pragma("unroll") for (int k = 0; k < 2; ++k) dst[m][k] = *(const LAS bf16x8*)(lds + PG8_SA(b, h) + aoff + m * 2048 + k * 1024); } while (0)
#define PG8_LDB(dst, b, h) do { _Pragma("unroll") for (int n = 0; n < 2; ++n) _Pragma("unroll") for (int k = 0; k < 2; ++k) dst[n][k] = *(const LAS bf16x8*)(lds + PG8_SB(b, h) + boff + n * 2048 + k * 1024); } while (0)
#define PG8_MMA(ai, bj, At, Bt) do { __builtin_amdgcn_s_setprio(1); _Pragma("unroll") for (int m = 0; m < 4; ++m) _Pragma("unroll") for (int n = 0; n < 2; ++n) _Pragma("unroll") for (int k = 0; k < 2; ++k) \
        acc[ai][bj][m][n] = __builtin_amdgcn_mfma_f32_16x16x32_bf16(Bt[n][k], At[m][k], acc[ai][bj][m][n], 0, 0, 0); __builtin_amdgcn_s_setprio(0); } while (0)
#define PG8_WAIT_V(n) asm volatile("s_waitcnt vmcnt(" #n ")" ::: "memory")
#define PG8_WAIT_L(n) asm volatile("s_waitcnt lgkmcnt(" #n ")" ::: "memory")
#define PG8_BAR __builtin_amdgcn_s_barrier()
#define PG8_SCHED __builtin_amdgcn_sched_barrier(0)
    Unit cur, nxt; int ui = 0;
    if (!sch.next(0, cur)) return;
    f32x4 acc[2][2][4][2];
#pragma unroll
    for (int a = 0; a < 2; ++a)
#pragma unroll
        for (int b = 0; b < 2; ++b)
#pragma unroll
            for (int m = 0; m < 4; ++m)
#pragma unroll
                for (int n = 0; n < 2; ++n) acc[a][b][m][n] = (f32x4){0.f, 0.f, 0.f, 0.f};
    bf16x8 At[4][2], B0[2][2], B1[2][2];
    unsigned voAc[2][2], voAn[2][2];
#pragma unroll
    for (int h = 0; h < 2; ++h)
#pragma unroll
        for (int i = 0; i < 2; ++i) { voAc[h][i] = GATHER ? sch.aoff(cur, 128 * h + Rr[i]) + (unsigned)Cc[i] * 2u : 0u; voAn[h][i] = voAc[h][i]; }
    const char* cA = sch.abase(cur); const char* cB = sch.bbase(cur);
    PG8_STAGE_B(PG8_SB(0, 0), cB); PG8_STAGE_A(PG8_SA(0, 0), cA, 0, voAc); PG8_STAGE_B(PG8_SB(0, 1), cB + hstep); PG8_STAGE_A(PG8_SA(0, 1), cA, 1, voAc);
    if (wr == 1) PG8_BAR;
    PG8_WAIT_V(4); PG8_BAR;
    PG8_STAGE_B(PG8_SB(1, 0), cB + kstep); PG8_STAGE_A(PG8_SA(1, 0), cA + kstep, 0, voAc); PG8_STAGE_B(PG8_SB(1, 1), cB + hstep + kstep);
    PG8_WAIT_V(6); PG8_BAR;
    for (;;) {
        const bool has_next = sch.next(ui + 1, nxt);
        const char* nA = has_next ? sch.abase(nxt) : cA; const char* nB = has_next ? sch.bbase(nxt) : cB;
        if (GATHER) {
#pragma unroll
            for (int h = 0; h < 2; ++h)
#pragma unroll
                for (int i = 0; i < 2; ++i) voAn[h][i] = has_next ? sch.aoff(nxt, 128 * h + Rr[i]) + (unsigned)Cc[i] * 2u : voAc[h][i];
        }
#pragma unroll 1
        for (int t = 0; t < nt; t += 2) {
            const bool last = (t == nt - 2);
            const char* a1 = cA + (size_t)(t + 1) * kstep;
            const char* a2 = last ? nA : cA + (size_t)(t + 2) * kstep; const char* b2 = last ? nB : cB + (size_t)(t + 2) * kstep;
            const char* a3 = a2 + kstep; const char* b3 = b2 + kstep;
            unsigned vo2[2][2];
#pragma unroll
            for (int h = 0; h < 2; ++h)
#pragma unroll
                for (int i = 0; i < 2; ++i) vo2[h][i] = last ? voAn[h][i] : voAc[h][i];
            PG8_LDB(B0, 0, 0); PG8_SCHED; PG8_LDA(At, 0, 0); PG8_STAGE_A(PG8_SA(1, 1), a1, 1, voAc);
            PG8_WAIT_L(8); PG8_BAR; PG8_WAIT_L(0); PG8_MMA(0, 0, At, B0); PG8_BAR; PG8_SCHED;
            PG8_LDB(B1, 0, 1); PG8_STAGE_B(PG8_SB(0, 0), b2);
            PG8_BAR; PG8_WAIT_L(0); PG8_MMA(0, 1, At, B1); PG8_BAR;
            PG8_LDA(At, 0, 1); PG8_STAGE_A(PG8_SA(0, 0), a2, 0, vo2);
            PG8_BAR; PG8_WAIT_L(0); PG8_MMA(1, 0, At, B0); PG8_BAR; PG8_SCHED;
            PG8_STAGE_B(PG8_SB(0, 1), b2 + hstep);
            PG8_WAIT_V(6); PG8_BAR; PG8_MMA(1, 1, At, B1); PG8_BAR;
            PG8_LDB(B0, 1, 0); PG8_SCHED; PG8_LDA(At, 1, 0); PG8_STAGE_A(PG8_SA(0, 1), a2, 1, vo2);
            PG8_WAIT_L(8); PG8_BAR; PG8_WAIT_L(0); PG8_MMA(0, 0, At, B0); PG8_BAR; PG8_SCHED;
            PG8_LDB(B1, 1, 1); PG8_STAGE_B(PG8_SB(1, 0), b3);
            PG8_BAR; PG8_WAIT_L(0); PG8_MMA(0, 1, At, B1); PG8_BAR;
            PG8_LDA(At, 1, 1); PG8_STAGE_A(PG8_SA(1, 0), a3, 0, vo2);
            PG8_BAR; PG8_WAIT_L(0); PG8_MMA(1, 0, At, B0); PG8_BAR; PG8_SCHED;
            PG8_STAGE_B(PG8_SB(1, 1), b3 + hstep);
            PG8_WAIT_V(6); PG8_BAR; PG8_MMA(1, 1, At, B1); PG8_BAR;
        }
        { int frx = fr, fqx = fq; asm volatile("" : "+v"(frx), "+v"(fqx));
            const int jx = wc * 32 + 8 * fqx, rx = wr * 64 + frx;
            const typename E::Col ecol = epi.col(cur, jx);
            typename E::Pre epre = epi.load(cur, rx, jx);
#pragma unroll
            for (int g = 0; g < 8; ++g) { const int ai = g >> 2, m = g & 3;
                typename E::Pre enx = epre; if (g < 7) enx = epi.load(cur, ((g + 1) >> 2) * 128 + ((g + 1) & 3) * 16 + rx, jx);
                epi.apply(cur, ai * 128 + m * 16 + rx, jx, ecol, epre, acc[ai][0][m][0], acc[ai][0][m][1], acc[ai][1][m][0], acc[ai][1][m][1]);
                epre = enx; } }
        if (!has_next) break;
#pragma unroll
        for (int a = 0; a < 2; ++a)
#pragma unroll
            for (int b = 0; b < 2; ++b)
#pragma unroll
                for (int m = 0; m < 4; ++m)
#pragma unroll
                    for (int n = 0; n < 2; ++n) acc[a][b][m][n] = (f32x4){0.f, 0.f, 0.f, 0.f};
        cur = nxt; cA = nA; cB = nB; ++ui;
#pragma unroll
        for (int h = 0; h < 2; ++h)
#pragma unroll
            for (int i = 0; i < 2; ++i) voAc[h][i] = voAn[h][i];
    }
    PG8_WAIT_V(0);
    if (wr == 0) PG8_BAR;
    PG8_BAR;
#undef PG8_SA
#undef PG8_SB
#undef PG8_STAGE_A
#undef PG8_STAGE_B
#undef PG8_LDA
#undef PG8_LDB
#undef PG8_MMA
#undef PG8_WAIT_V
#undef PG8_WAIT_L
#undef PG8_BAR
#undef PG8_SCHED
}

struct SchG1 { const bf16_t *A, *Bt; int G, c, K;
    __device__ __forceinline__ bool next(int i, Unit& u) const { const int L = i * G + c; if (L >= 128 * 24) return false; u.pm = L / 24; u.pn = L % 24; return true; }
    __device__ __forceinline__ const bf16_t* arow(const Unit& u, int r) const { return A + (size_t)(u.pm * 256 + r) * 1024; }
    __device__ __forceinline__ const bf16_t* brow(const Unit& u, int n) const { return Bt + (size_t)(u.pn * 256 + n) * 1024; }
    __device__ __forceinline__ const char* abase(const Unit& u) const { return (const char*)(A + (size_t)u.pm * 256 * 1024); }
    __device__ __forceinline__ const char* bbase(const Unit& u) const { return (const char*)(Bt + (size_t)u.pn * 256 * 1024); }
    __device__ __forceinline__ unsigned aoff(const Unit&, int) const { return 0u; } };
__device__ __forceinline__ u32x4 pk8(f32x4 a, f32x4 b) { u32x4 r; r.x = pk2(a[0], a[1]); r.y = pk2(a[2], a[3]); r.z = pk2(b[0], b[1]); r.w = pk2(b[2], b[3]); return r; }
__device__ __forceinline__ void unpk8(u32x4 w, f32x4& a, f32x4& b) { a[0] = bflo(w.x); a[1] = bfhi(w.x); a[2] = bflo(w.y); a[3] = bfhi(w.y); b[0] = bflo(w.z); b[1] = bfhi(w.z); b[2] = bflo(w.w); b[3] = bfhi(w.w); }
struct EpiG1 { bf16_t *Z, *GYG, *XR, *SGA, *SGB; const float* bias;
    struct Col { f32x4 c0, c1, c2, c3; }; struct Pre { };
    __device__ __forceinline__ Col col(const Unit& u, int j) const { const float* bp = bias + u.pn * 256 + j; return Col{*(const f32x4*)bp, *(const f32x4*)(bp + 4), *(const f32x4*)(bp + 128), *(const f32x4*)(bp + 132)}; }
    __device__ __forceinline__ Pre load(const Unit&, int, int) const { return Pre{}; }
    __device__ __forceinline__ void apply(const Unit& u, int r, int j, const Col& c, const Pre&, f32x4 a0, f32x4 a1, f32x4 b0, f32x4 b1) const {
        const size_t row = (size_t)u.pm * 256 + r;
        a0 += c.c0; a1 += c.c1; b0 += c.c2; b1 += c.c3;
        if (u.pn < 8) {
#pragma unroll
            for (int e = 0; e < 4; ++e) { a0[e] *= sigm(b0[e]); a1[e] *= sigm(b1[e]); }
            *(u32x4*)(Z + row * 1024 + u.pn * 128 + j) = pk8(a0, a1); }
        else { const int kind = u.pn >> 2;
            bf16_t* dst = GYG + (size_t)(kind - 2) * (SLOT / 2);
#pragma unroll
            for (int e = 0; e < 4; ++e) { if (kind == 2) { a0[e] = gelu_tanh(a0[e]); a1[e] = gelu_tanh(a1[e]); b0[e] = gelu_tanh(b0[e]); b1[e] = gelu_tanh(b1[e]); }
                else if (kind >= 4) { a0[e] = sigm(a0[e]); a1[e] = sigm(a1[e]); b0[e] = sigm(b0[e]); b1[e] = sigm(b1[e]); } }
            bf16_t* o = dst + row * 1024 + (u.pn & 3) * 256 + j;
            *(u32x4*)o = pk8(a0, a1); *(u32x4*)(o + 128) = pk8(b0, b1); }
    } };
struct SchCtx { const bf16_t *A, *Bt; int G, c, K;
    __device__ __forceinline__ bool next(int i, Unit& u) const { const int L = i * G + c; if (L >= 16) return false; u.pm = L / 4; u.pn = L % 4; return true; }
    __device__ __forceinline__ const bf16_t* arow(const Unit& u, int r) const { return A + (size_t)(u.pm * 256 + r) * 1024; }
    __device__ __forceinline__ const bf16_t* brow(const Unit& u, int n) const { return Bt + (size_t)((12 + u.pn) * 256 + n) * 1024; }
    __device__ __forceinline__ const char* abase(const Unit& u) const { return (const char*)(A + (size_t)u.pm * 256 * 1024); }
    __device__ __forceinline__ const char* bbase(const Unit& u) const { return (const char*)(Bt + (size_t)(12 + u.pn) * 256 * 1024); }
    __device__ __forceinline__ unsigned aoff(const Unit&, int) const { return 0u; } };
struct EpiCtx { bf16_t* XRC; const float* bias;
    struct Col { f32x4 c0, c1, c2, c3; }; struct Pre { };
    __device__ __forceinline__ Col col(const Unit& u, int j) const { const float* bp = bias + (12 + u.pn) * 256 + j; return Col{*(const f32x4*)bp, *(const f32x4*)(bp + 4), *(const f32x4*)(bp + 128), *(const f32x4*)(bp + 132)}; }
    __device__ __forceinline__ Pre load(const Unit&, int, int) const { return Pre{}; }
    __device__ __forceinline__ void apply(const Unit& u, int r, int j, const Col& c, const Pre&, f32x4 a0, f32x4 a1, f32x4 b0, f32x4 b1) const {
        const size_t row = (size_t)u.pm * 256 + r;
        a0 += c.c0; a1 += c.c1; b0 += c.c2; b1 += c.c3;
        bf16_t* o = XRC + row * 1024 + u.pn * 256 + j; *(u32x4*)o = pk8(a0, a1); *(u32x4*)(o + 128) = pk8(b0, b1); } };
struct SchG2 { const bf16_t *Aa, *Ab, *Wa, *Wb; int G, c, K;
    __device__ __forceinline__ bool next(int i, Unit& u) const { const int t = (i >> 1) * G + c; if (t >= 512) return false; u.pm = t >> 2; u.pn = t & 3; u.aux = i & 1; return true; }
    __device__ __forceinline__ const bf16_t* arow(const Unit& u, int r) const { return Aa + (size_t)u.aux * (SLOT / 2) + (size_t)(u.pm * 256 + r) * 1024; }
    __device__ __forceinline__ const bf16_t* brow(const Unit& u, int n) const { return Wa + (size_t)u.aux * (1024 * 1024) + (size_t)(u.pn * 256 + n) * 1024; }
    __device__ __forceinline__ const char* abase(const Unit& u) const { return (const char*)(Aa + (size_t)u.aux * (SLOT / 2) + (size_t)u.pm * 256 * 1024); }
    __device__ __forceinline__ const char* bbase(const Unit& u) const { return (const char*)(Wa + (size_t)u.aux * (1024 * 1024) + (size_t)u.pn * 256 * 1024); }
    __device__ __forceinline__ unsigned aoff(const Unit&, int) const { return 0u; } };
struct EpiG2 { const bf16_t *SGA, *SGB; bf16_t* M;
    struct Col { }; struct Pre { u32x4 g0, g1, t0, t1; };
    __device__ __forceinline__ Col col(const Unit&, int) const { return Col{}; }
    __device__ __forceinline__ Pre load(const Unit& u, int r, int j) const {
        const size_t o = ((size_t)u.pm * 256 + r) * 1024 + u.pn * 256 + j; const bf16_t* G = SGA + (size_t)u.aux * (SLOT / 2);
        Pre q; q.g0 = *(const u32x4*)(G + o); q.g1 = *(const u32x4*)(G + o + 128);
        if (u.aux) { q.t0 = *(const u32x4*)(M + o); q.t1 = *(const u32x4*)(M + o + 128); } else { q.t0 = (u32x4){0u, 0u, 0u, 0u}; q.t1 = q.t0; }
        return q; }
    __device__ __forceinline__ void apply(const Unit& u, int r, int j, const Col&, const Pre& q, f32x4 a0, f32x4 a1, f32x4 b0, f32x4 b1) const {
        const size_t o = ((size_t)u.pm * 256 + r) * 1024 + u.pn * 256 + j;
        f32x4 g0, g1, g2, g3, t0, t1, t2, t3; unpk8(q.g0, g0, g1); unpk8(q.g1, g2, g3); unpk8(q.t0, t0, t1); unpk8(q.t1, t2, t3);
        a0 = a0 * g0 + t0; a1 = a1 * g1 + t1; b0 = b0 * g2 + t2; b1 = b1 * g3 + t3;
        *(u32x4*)(M + o) = pk8(a0, a1); *(u32x4*)(M + o + 128) = pk8(b0, b1); } };
struct SchG3 { const bf16_t *A, *Bt; int G, c, K;
    __device__ __forceinline__ bool next(int i, Unit& u) const { const int L = i * G + c; if (L >= 512) return false; u.pm = L >> 2; u.pn = L & 3; return true; }
    __device__ __forceinline__ const bf16_t* arow(const Unit& u, int r) const { return A + (size_t)(u.pm * 256 + r) * 1024; }
    __device__ __forceinline__ const bf16_t* brow(const Unit& u, int n) const { return Bt + (size_t)(u.pn * 256 + n) * 1024; }
    __device__ __forceinline__ const char* abase(const Unit& u) const { return (const char*)(A + (size_t)u.pm * 256 * 1024); }
    __device__ __forceinline__ const char* bbase(const Unit& u) const { return (const char*)(Bt + (size_t)u.pn * 256 * 1024); }
    __device__ __forceinline__ unsigned aoff(const Unit&, int) const { return 0u; } };
struct EpiG3 { const float *X, *MOD; float* X1;
    struct Col { f32x4 c0, c1, c2, c3; }; struct Pre { f32x4 x0, x1, x2, x3; };
    __device__ __forceinline__ Col col(const Unit& u, int j) const { const float* gt = MOD + ((u.pm * 256) / SEQ) * 6144 + 2 * 1024 + u.pn * 256 + j; return Col{*(const f32x4*)gt, *(const f32x4*)(gt + 4), *(const f32x4*)(gt + 128), *(const f32x4*)(gt + 132)}; }
    __device__ __forceinline__ Pre load(const Unit& u, int r, int j) const { const float* xp = X + ((size_t)u.pm * 256 + r) * 1024 + u.pn * 256 + j; return Pre{*(const f32x4*)xp, *(const f32x4*)(xp + 4), *(const f32x4*)(xp + 128), *(const f32x4*)(xp + 132)}; }
    __device__ __forceinline__ void apply(const Unit& u, int r, int j, const Col& c, const Pre& q, f32x4 a0, f32x4 a1, f32x4 b0, f32x4 b1) const {
        float* op = X1 + ((size_t)u.pm * 256 + r) * 1024 + u.pn * 256 + j;
        *(f32x4*)op = q.x0 + c.c0 * a0; *(f32x4*)(op + 4) = q.x1 + c.c1 * a1; *(f32x4*)(op + 128) = q.x2 + c.c2 * b0; *(f32x4*)(op + 132) = q.x3 + c.c3 * b1; } };
struct MoeMeta { const int* m;
    __device__ __forceinline__ int cnt(int e) const { return __builtin_amdgcn_readfirstlane(m[e]); }
    __device__ __forceinline__ int tb(int e) const { return __builtin_amdgcn_readfirstlane(m[16 + e]); }
    __device__ __forceinline__ int ntiles() const { return __builtin_amdgcn_readfirstlane(m[32]); }
    __device__ __forceinline__ int find(int mt) const { int e = 0;
#pragma unroll
        for (int k = 1; k < 16; ++k) e += (__builtin_amdgcn_readfirstlane(m[16 + k]) <= mt) ? 1 : 0;
        return e; } };
__device__ __forceinline__ void moe_meta_build(const Params& p, int* meta) {
    if (threadIdx.x == 0) { const unsigned* cnt = (const unsigned*)(p.ws + OFF_CTL); int t = 0;
        for (int e = 0; e < 16; ++e) { const int c = (int)__hip_atomic_load(cnt + e, __ATOMIC_RELAXED, __HIP_MEMORY_SCOPE_AGENT); meta[e] = c; meta[16 + e] = t; t += (c + 255) >> 8; }
        meta[32] = t; }
    __syncthreads();
}
struct SchUp { const bf16_t *HM, *W; const int* LIST; MoeMeta mm; int G, c, K; const int* idx;
    __device__ __forceinline__ bool next(int i, Unit& u) const { const int L = i * G + c; if (L >= 4 * mm.ntiles()) return false; const int mt = L >> 2; u.pn = L & 3; u.aux = mm.find(mt); u.aux2 = (mt - mm.tb(u.aux)) * 256; u.pm = mt | (i << 16); return true; }
    __device__ __forceinline__ const char* abase(const Unit&) const { return (const char*)HM; }
    __device__ __forceinline__ const char* bbase(const Unit& u) const { return (const char*)(W + ((size_t)u.aux * 1024 + u.pn * 256) * 1024); }
    __device__ __forceinline__ unsigned aoff(const Unit& u, int r) const { return (unsigned)idx[(u.pm >> 16) * 256 + r] * 2048u; }
    __device__ __forceinline__ const bf16_t* arow(const Unit& u, int r) const { int pos = u.aux2 + r; const int c = mm.cnt(u.aux); pos = pos < c ? pos : c - 1; return HM + (size_t)LIST[u.aux * NT + pos] * 1024; }
    __device__ __forceinline__ const bf16_t* brow(const Unit& u, int n) const { return W + ((size_t)u.aux * 1024 + u.pn * 256 + n) * 1024; } };
struct EpiUp { bf16_t* ACT; const float* WL; MoeMeta mm;
    struct Col { }; struct Pre { float wt; };
    __device__ __forceinline__ Col col(const Unit&, int) const { return Col{}; }
    __device__ __forceinline__ Pre load(const Unit& u, int r, int) const { const int pos = u.aux2 + r; return Pre{pos < mm.cnt(u.aux) ? WL[u.aux * NT + pos] : 0.f}; }
    __device__ __forceinline__ void apply(const Unit& u, int r, int j, const Col&, const Pre& q, f32x4 g0, f32x4 g1, f32x4 u0, f32x4 u1) const {
        if (u.aux2 + r >= mm.cnt(u.aux)) return;
#pragma unroll
        for (int e = 0; e < 4; ++e) { g0[e] = silu(g0[e]) * u0[e] * q.wt; g1[e] = silu(g1[e]) * u1[e] * q.wt; }
        *(u32x4*)(ACT + ((size_t)(u.pm & 0xffff) * 256 + r) * 512 + u.pn * 128 + j) = pk8(g0, g1); } };
struct SchDn { const bf16_t *ACT, *W; MoeMeta mm; int G, c, K;
    __device__ __forceinline__ bool next(int i, Unit& u) const { const int L = i * G + c; if (L >= 4 * mm.ntiles()) return false; const int mt = L >> 2; u.pn = L & 3; u.aux = mm.find(mt); u.aux2 = (mt - mm.tb(u.aux)) * 256; u.pm = mt; return true; }
    __device__ __forceinline__ const bf16_t* arow(const Unit& u, int r) const { return ACT + ((size_t)u.pm * 256 + r) * 512; }
    __device__ __forceinline__ const bf16_t* brow(const Unit& u, int n) const { return W + ((size_t)u.aux * 1024 + u.pn * 256 + n) * 512; }
    __device__ __forceinline__ const char* abase(const Unit& u) const { return (const char*)(ACT + (size_t)u.pm * 256 * 512); }
    __device__ __forceinline__ const char* bbase(const Unit& u) const { return (const char*)(W + ((size_t)u.aux * 1024 + u.pn * 256) * 512); }
    __device__ __forceinline__ unsigned aoff(const Unit&, int) const { return 0u; } };
struct EpiDn { bf16_t* Y; MoeMeta mm;
    struct Col { }; struct Pre { };
    __device__ __forceinline__ Col col(const Unit&, int) const { return Col{}; }
    __device__ __forceinline__ Pre load(const Unit&, int, int) const { return Pre{}; }
    __device__ __forceinline__ void apply(const Unit& u, int r, int j, const Col&, const Pre&, f32x4 a0, f32x4 a1, f32x4 b0, f32x4 b1) const {
        if (u.aux2 + r >= mm.cnt(u.aux)) return;
        bf16_t* o = Y + ((size_t)u.pm * 256 + r) * 1024 + u.pn * 256 + j; *(u32x4*)o = pk8(a0, a1); *(u32x4*)(o + 128) = pk8(b0, b1); } };

__device__ __forceinline__ void aprep_item(const Params& p, int g, unsigned char* lds) {
    const int tid = threadIdx.x, lane = tid & 63, wave = tid >> 6;
    const bf16_t* Z = (const bf16_t*)(p.ws + OFF_SLOT + 1 * SLOT);
    bf16_t* AA = (bf16_t*)(p.ws + OFF_SLOT + 0 * SLOT);
    unsigned* zt = (unsigned*)lds;
    { const u32x4* src = (const u32x4*)(Z + (size_t)g * 64 * 1024); u32x4* d = (u32x4*)lds;
#pragma unroll 4
        for (int i = tid; i < 8192; i += NTHR) d[i] = src[i]; }
    __syncthreads();
    {
        float w0[31], w1[31];
        const float* cw = p.in[I_CONVW] + 2 * tid;
#pragma unroll
        for (int k = 0; k < 31; ++k) { const f32x2 t = *(const f32x2*)(cw + k * 1024); w0[k] = t.x; w1[k] = t.y; }
        const f32x2 cb = *(const f32x2*)(p.in[I_CONVB] + 2 * tid);
        float p0[16], p1[16];
#pragma unroll
        for (int o = 0; o < 16; ++o) { p0[o] = 0.f; p1[o] = 0.f; }
#pragma unroll
        for (int tb = 0; tb < 5; ++tb) {
            float c0[16], c1[16];
#pragma unroll
            for (int o = 0; o < 16; ++o) { c0[o] = cb.x; c1[o] = cb.y; }
            if (tb < 4) {
#pragma unroll
                for (int r0 = 0; r0 < 48; r0 += 8) {
                    unsigned vv[8];
#pragma unroll
                    for (int rr = 0; rr < 8; ++rr) { const int row = 16 * tb - 15 + r0 + rr; vv[rr] = (r0 + rr < 46 && row >= 0 && row < 64) ? zt[row * 512 + tid] : 0u; }
#pragma unroll
                    for (int rr = 0; rr < 8; ++rr) { const int r = r0 + rr, row = 16 * tb - 15 + r;
                        if (r < 46 && row >= 0 && row < 64) { const float x0 = bflo(vv[rr]), x1 = bfhi(vv[rr]);
#pragma unroll
                            for (int o = 0; o < 16; ++o) { const int k = r - o; if (k >= 0 && k < 31) { c0[o] += w0[k] * x0; c1[o] += w1[k] * x1; } } } }
                    asm volatile("" ::: "memory");
                }
            }
            if (tb > 0) {
#pragma unroll
                for (int o = 0; o < 16; ++o) zt[(16 * (tb - 1) + o) * 512 + tid] = pk2(p0[o], p1[o]);
            }
#pragma unroll
            for (int o = 0; o < 16; ++o) { p0[o] = c0[o]; p1[o] = c1[o]; }
        }
    }
    __syncthreads();
    for (int rr = 0; rr < 8; ++rr) {
        const int row = wave * 8 + rr;
        const u32x4 a = *(const u32x4*)(lds + row * 2048 + lane * 16), b = *(const u32x4*)(lds + row * 2048 + 1024 + lane * 16);
        float x[16];
        x[0] = bflo(a.x); x[1] = bfhi(a.x); x[2] = bflo(a.y); x[3] = bfhi(a.y); x[4] = bflo(a.z); x[5] = bfhi(a.z); x[6] = bflo(a.w); x[7] = bfhi(a.w);
        x[8] = bflo(b.x); x[9] = bfhi(b.x); x[10] = bflo(b.y); x[11] = bfhi(b.y); x[12] = bflo(b.z); x[13] = bfhi(b.z); x[14] = bflo(b.w); x[15] = bfhi(b.w);
        float s = 0.f;
#pragma unroll
        for (int e = 0; e < 16; ++e) s += x[e];
        const float mean = wave_sum(s) * (1.0f / 1024.0f);
        float q = 0.f;
#pragma unroll
        for (int e = 0; e < 16; ++e) { x[e] -= mean; q += x[e] * x[e]; }
        const float rstd = rsqrtf(wave_sum(q) * (1.0f / 1024.0f) + 1e-6f);
        float y[16];
#pragma unroll
        for (int hh = 0; hh < 2; ++hh) { const int c0 = hh * 512 + lane * 8;
            const f32x4 g0 = *(const f32x4*)(p.in[I_LNG] + c0), g1 = *(const f32x4*)(p.in[I_LNG] + c0 + 4), b0 = *(const f32x4*)(p.in[I_LNB] + c0), b1 = *(const f32x4*)(p.in[I_LNB] + c0 + 4);
#pragma unroll
            for (int e = 0; e < 4; ++e) { y[hh * 8 + e] = silu(x[hh * 8 + e] * rstd * g0[e] + b0[e]); y[hh * 8 + 4 + e] = silu(x[hh * 8 + 4 + e] * rstd * g1[e] + b1[e]); } }
        bf16_t* o = AA + ((size_t)g * 64 + row) * 1024 + lane * 8;
        u32x4 o0, o1; o0.x = pk2(y[0], y[1]); o0.y = pk2(y[2], y[3]); o0.z = pk2(y[4], y[5]); o0.w = pk2(y[6], y[7]);
        o1.x = pk2(y[8], y[9]); o1.y = pk2(y[10], y[11]); o1.z = pk2(y[12], y[13]); o1.w = pk2(y[14], y[15]);
        *(u32x4*)o = o0; *(u32x4*)(o + 512) = o1;
    }
    __syncthreads();
}

constexpr int XC_STRIDE = 272;
constexpr int YB_STRIDE = 132;
constexpr int B_XC_OFF = 0, B_HIN_OFF = 256 * XC_STRIDE  , B_Y_OFF = B_HIN_OFF + 4096  , B_Y_BYTES = 64 * YB_STRIDE * 4  ;
constexpr size_t OFF_TOT256 = OFF_TOT + 9 * MiB;

__device__ __forceinline__ void lru_coef(float lr, float li, float nsp, float xcv, float& a, float& b) {
    const float la = nsp * sigm(lr);
    a = __expf(la);
    const float am1 = la > -0.25f ? la * (1.0f + la * (0.5f + la * (0.16666667f + la * (0.041666668f + la * 0.008333334f)))) : a - 1.0f;
    b = __builtin_amdgcn_sqrtf(-am1 * (a + 1.0f)) * (sigm(li) * xcv);
}

template <bool FINAL, int DIR>
__device__ __forceinline__ void lru_dir(const unsigned char* xcs, const bf16x8 (&fbr)[4], const bf16x8 (&fbi)[4], float br, float bi, float nsp, int fr, int q, int chl,
                                        float hin_v, f32x4 (&hout)[4], float& totA, float& totB) {
    f32x4 ar[4], ai[4];
#pragma unroll
    for (int m = 0; m < 4; ++m) { ar[m] = (f32x4){0.f, 0.f, 0.f, 0.f}; ai[m] = (f32x4){0.f, 0.f, 0.f, 0.f}; }
#pragma unroll
    for (int kk = 0; kk < 4; ++kk) {
#pragma unroll
        for (int m = 0; m < 4; ++m) { const bf16x8 fa = *(const bf16x8*)(xcs + (16 * m + fr) * XC_STRIDE + (32 * kk + 8 * q) * 2);
            ar[m] = __builtin_amdgcn_mfma_f32_16x16x32_bf16(fa, fbr[kk], ar[m], 0, 0, 0);
            ai[m] = __builtin_amdgcn_mfma_f32_16x16x32_bf16(fa, fbi[kk], ai[m], 0, 0, 0); }
    }
#pragma unroll
    for (int m = 0; m < 4; ++m)
#pragma unroll
        for (int i = 0; i < 4; ++i) {
            const float xcv = bf2f(*(const bf16_t*)(xcs + (16 * m + 4 * q + i) * XC_STRIDE + chl * 2));
            float a, b; lru_coef(ar[m][i] + br, ai[m][i] + bi, nsp, xcv, a, b); ar[m][i] = a; ai[m][i] = b;
        }
    float At[4], Bt[4], Ae[4], Be[4];
#pragma unroll
    for (int m = 0; m < 4; ++m) {
        float A = 1.f, B = 0.f;
#pragma unroll
        for (int ii = 0; ii < 4; ++ii) { const int i = DIR ? 3 - ii : ii; B = ar[m][i] * B + ai[m][i]; A = ar[m][i] * A; }
        if (DIR == 0) {
            float tA = __shfl_up(A, 16), tB = __shfl_up(B, 16); if (q >= 1) { B = A * tB + B; A = A * tA; }
            tA = __shfl_up(A, 32); tB = __shfl_up(B, 32); if (q >= 2) { B = A * tB + B; A = A * tA; }
            Ae[m] = __shfl_up(A, 16); Be[m] = __shfl_up(B, 16); if (q == 0) { Ae[m] = 1.f; Be[m] = 0.f; }
            At[m] = __shfl(A, 48 + fr); Bt[m] = __shfl(B, 48 + fr);
        } else {
            float tA = __shfl_down(A, 16), tB = __shfl_down(B, 16); if (q <= 2) { B = A * tB + B; A = A * tA; }
            tA = __shfl_down(A, 32); tB = __shfl_down(B, 32); if (q <= 1) { B = A * tB + B; A = A * tA; }
            Ae[m] = __shfl_down(A, 16); Be[m] = __shfl_down(B, 16); if (q == 3) { Ae[m] = 1.f; Be[m] = 0.f; }
            At[m] = __shfl(A, fr); Bt[m] = __shfl(B, fr);
        }
    }
    if (!FINAL) {
        float A = 1.f, B = 0.f;
#pragma unroll
        for (int mm = 0; mm < 4; ++mm) { const int m = DIR ? 3 - mm : mm; B = At[m] * B + Bt[m]; A = At[m] * A; }
        totA = A; totB = B;
    } else {
        float hh = hin_v;
#pragma unroll
        for (int mm = 0; mm < 4; ++mm) { const int m = DIR ? 3 - mm : mm;
            float hs = Ae[m] * hh + Be[m];
#pragma unroll
            for (int ii = 0; ii < 4; ++ii) { const int i = DIR ? 3 - ii : ii; hs = ar[m][i] * hs + ai[m][i]; hout[m][i] = hs; }
            hh = At[m] * hh + Bt[m];
        }
    }
}

template <bool FINAL>
__device__ __forceinline__ void b_phase(const Params& p, int bid, int nb, unsigned char* lds) {
    const int tid = threadIdx.x, lane = tid & 63, wave = tid >> 6, fr = lane & 15, q = lane >> 4;
    f32x2* TOT = (f32x2*)(p.ws + OFF_TOT);
    f32x2* TOT256 = (f32x2*)(p.ws + OFF_TOT256);
    const bf16_t* WG = (const bf16_t*)(p.ws + OFF_WG);
    float* hin = (float*)(lds + B_HIN_OFF);
    const int chl = 16 * wave + fr;
    const int nitems = FINAL ? 1024 : 1024 + 32;
    int hprev = -1;
    bf16x8 fb[4][4];
    float brf = 0.f, bif = 0.f, brb = 0.f, bib = 0.f, nspf = 0.f, nspb = 0.f;
    for (int it = bid; it < nitems; it += nb) {
        const bool isctx = it >= 1024;
        const int b = isctx ? (it - 1024) >> 3 : it >> 8, c256 = isctx ? -1 : (it >> 3) & 31, h = it & 7;
        const int seqlen = isctx ? CTXL : SEQ, sbase = isctx ? 0 : c256 * 256;
        const bf16_t* src = isctx ? (const bf16_t*)(p.ws + OFF_XRC) + (size_t)b * CTXL * 1024 : (const bf16_t*)(p.ws + OFF_SLOT + 3 * SLOT) + (size_t)b * SEQ * 1024;
        const int kc0 = isctx ? 0 : 4 + c256 * 4, k256 = isctx ? 0 : 1 + c256;
        const int ch = h * 128 + chl;
        if (h != hprev) {
            hprev = h;
#pragma unroll
            for (int ty = 0; ty < 4; ++ty)
#pragma unroll
                for (int kk = 0; kk < 4; ++kk) fb[ty][kk] = *(const bf16x8*)(WG + (size_t)(h * 512 + wave * 64 + ty * 16 + fr) * 128 + 32 * kk + 8 * q);
            brf = p.in[I_BRF][ch]; bif = p.in[I_BIF][ch]; brb = p.in[I_BRB][ch]; bib = p.in[I_BIB][ch];
            nspf = -8.0f * log1pf(__expf(-p.in[I_LAMF][ch])); nspb = -8.0f * log1pf(__expf(-p.in[I_LAMB][ch]));
        }
        float runAf = 1.f, runBf = 0.f, runAb = 1.f, runBb = 0.f;
        {
            const int cgp = tid & 15, c0 = h * 128 + 8 * cgp;
            float wk[4][8], bs[8];
            { const f32x4* bp = (const f32x4*)(p.in[I_LCB] + c0); const f32x4 t0_ = bp[0], t1_ = bp[1];
                bs[0] = t0_[0]; bs[1] = t0_[1]; bs[2] = t0_[2]; bs[3] = t0_[3]; bs[4] = t1_[0]; bs[5] = t1_[1]; bs[6] = t1_[2]; bs[7] = t1_[3];
#pragma unroll
                for (int k = 0; k < 4; ++k) { const f32x4* wp = (const f32x4*)(p.in[I_LCW] + k * 1024 + c0); const f32x4 w0 = wp[0], w1 = wp[1];
                    wk[k][0] = w0[0]; wk[k][1] = w0[1]; wk[k][2] = w0[2]; wk[k][3] = w0[3]; wk[k][4] = w1[0]; wk[k][5] = w1[1]; wk[k][6] = w1[2]; wk[k][7] = w1[3]; } }
#pragma unroll 1
            for (int ps = 0; ps < 2; ++ps) {
                const int tq = ps * 128 + (tid >> 4) * 4;
                float xc[4][8];
#pragma unroll
                for (int r = 0; r < 4; ++r)
#pragma unroll
                    for (int e = 0; e < 8; ++e) xc[r][e] = bs[e];
#pragma unroll
                for (int rr = 0; rr < 7; ++rr) {
                    const int row = sbase + tq + rr - 2;
                    u32x4 a = (u32x4){0u, 0u, 0u, 0u};
                    if (row >= 0 && row < seqlen) a = *(const u32x4*)(src + (size_t)row * 1024 + c0);
                    const float x[8] = {bflo(a.x), bfhi(a.x), bflo(a.y), bfhi(a.y), bflo(a.z), bfhi(a.z), bflo(a.w), bfhi(a.w)};
#pragma unroll
                    for (int r = 0; r < 4; ++r) { const int k = rr - r;
                        if (k >= 0 && k < 4) {
#pragma unroll
                            for (int e = 0; e < 8; ++e) xc[r][e] += wk[k][e] * x[e]; } }
                }
#pragma unroll
                for (int r = 0; r < 4; ++r) {
                    u32x4 o0; o0.x = pk2(xc[r][0], xc[r][1]); o0.y = pk2(xc[r][2], xc[r][3]); o0.z = pk2(xc[r][4], xc[r][5]); o0.w = pk2(xc[r][6], xc[r][7]);
                    *(u32x4*)(lds + B_XC_OFF + (tq + r) * XC_STRIDE + cgp * 16) = o0;
                }
            }
        }
        f32x2 ct[33], cs[4];
        const int cdir = (tid >> 7) & 1, ccl = tid & 127;
        if (FINAL && tid < 256) {
            const f32x2* T2 = TOT256 + ((size_t)b * 33 * 2 + cdir) * 1024 + h * 128 + ccl;
            const f32x2* T = TOT + ((size_t)b * NCH64 * 2 + cdir) * 1024 + h * 128 + ccl;
#pragma unroll
            for (int k = 0; k < 33; ++k) { const bool use = cdir == 0 ? (k < k256) : (k == 0 || k > k256); ct[k] = use ? T2[(size_t)k * 2048] : (f32x2){1.f, 0.f}; }
#pragma unroll
            for (int s_ = 0; s_ < 4; ++s_) cs[s_] = T[(size_t)(kc0 + s_) * 2048];
        }
        if (FINAL && tid < 256) {
            float hc = 0.f;
            if (cdir == 0) {
#pragma unroll
                for (int k = 0; k < 33; ++k) hc = ct[k].x * hc + ct[k].y;
#pragma unroll
                for (int s_ = 0; s_ < 4; ++s_) { hin[(s_ * 2 + 0) * 128 + ccl] = hc; hc = cs[s_].x * hc + cs[s_].y; }
            } else {
                hc = ct[0].y;
#pragma unroll
                for (int k = 32; k >= 1; --k) hc = ct[k].x * hc + ct[k].y;
#pragma unroll
                for (int s_ = 3; s_ >= 0; --s_) { hin[(s_ * 2 + 1) * 128 + ccl] = hc; hc = cs[s_].x * hc + cs[s_].y; }
            }
        }
        __syncthreads();
        for (int sub = 0; sub < 4; ++sub) {
            const int t0 = sbase + 64 * sub;
            const unsigned char* xcs = lds + B_XC_OFF + 64 * sub * XC_STRIDE;
            float* ybuf = (float*)(lds + B_Y_OFF + (sub & 1) * B_Y_BYTES);
            const int ot = tid >> 3, oc = (tid & 7) * 16;
            f32x4 hf[4], hb[4]; float tA, tB;
            lru_dir<FINAL, 0>(xcs, fb[0], fb[1], brf, bif, nspf, fr, q, chl, FINAL ? hin[(sub * 2 + 0) * 128 + chl] : 0.f, hf, tA, tB);
            if (!FINAL) { if (q == 0) TOT[((size_t)(b * NCH64 + kc0 + sub) * 2 + 0) * 1024 + ch] = (f32x2){tA, tB};
                runBf = tA * runBf + tB; runAf = tA * runAf; }
            u32x4 gy0, gy1;
            if (FINAL) { const bf16_t* GYG = (const bf16_t*)(p.ws + OFF_SLOT + 2 * SLOT) + ((size_t)b * SEQ + t0 + ot) * 1024 + h * 128 + oc;
                gy0 = *(const u32x4*)GYG; gy1 = *(const u32x4*)(GYG + 8); }
            lru_dir<FINAL, 1>(xcs, fb[2], fb[3], brb, bib, nspb, fr, q, chl, FINAL ? hin[(sub * 2 + 1) * 128 + chl] : 0.f, hb, tA, tB);
            if (!FINAL) { if (q == 0) TOT[((size_t)(b * NCH64 + kc0 + sub) * 2 + 1) * 1024 + ch] = (f32x2){tA, tB};
                runBb = runAb * tB + runBb; runAb = runAb * tA; }
            if (FINAL) {
#pragma unroll
                for (int m = 0; m < 4; ++m)
#pragma unroll
                    for (int i = 0; i < 4; ++i) ybuf[(16 * m + 4 * q + i) * YB_STRIDE + chl] = hf[m][i] + hb[m][i];
                __syncthreads();
                const f32x4* yp = (const f32x4*)(ybuf + ot * YB_STRIDE + oc);
                const f32x4 y0 = yp[0], y1 = yp[1], y2 = yp[2], y3 = yp[3];
                u32x4 o0, o1;
                o0.x = pk2(bflo(gy0.x) * y0[0], bfhi(gy0.x) * y0[1]); o0.y = pk2(bflo(gy0.y) * y0[2], bfhi(gy0.y) * y0[3]);
                o0.z = pk2(bflo(gy0.z) * y1[0], bfhi(gy0.z) * y1[1]); o0.w = pk2(bflo(gy0.w) * y1[2], bfhi(gy0.w) * y1[3]);
                o1.x = pk2(bflo(gy1.x) * y2[0], bfhi(gy1.x) * y2[1]); o1.y = pk2(bflo(gy1.y) * y2[2], bfhi(gy1.y) * y2[3]);
                o1.z = pk2(bflo(gy1.z) * y3[0], bfhi(gy1.z) * y3[1]); o1.w = pk2(bflo(gy1.w) * y3[2], bfhi(gy1.w) * y3[3]);
                bf16_t* AB = (bf16_t*)(p.ws + OFF_SLOT + 1 * SLOT) + ((size_t)b * SEQ + t0 + ot) * 1024 + h * 128 + oc;
                *(u32x4*)AB = o0; *(u32x4*)(AB + 8) = o1;
            }
        }
        __syncthreads();
        if (!FINAL && q == 0) {
            TOT256[((size_t)(b * 33 + k256) * 2 + 0) * 1024 + ch] = (f32x2){runAf, runBf};
            TOT256[((size_t)(b * 33 + k256) * 2 + 1) * 1024 + ch] = (f32x2){runAb, runBb};
        }
    }
}

__device__ __forceinline__ void ph8_route(const Params& p, int bid, int nb, unsigned char* lds) {
    const int tid = threadIdx.x, lane = tid & 63, wave = tid >> 6;
    float* Wl = (float*)lds;
    int* lcnt = (int*)(lds + 81920);
    int* lbase = lcnt + 16;
    int* tinfo = lcnt + 32;
    float* twt = (float*)(tinfo + 512);
    for (int i = tid; i < 1024 * 20; i += NTHR) { const int k = i / 20, o = i % 20; Wl[o * 1024 + k] = o < 4 ? p.in[I_WGRP][k * 4 + o] : p.in[I_WER][k * 16 + o - 4]; }
    __syncthreads();
    const float* MOD = (const float*)(p.ws + OFF_MOD);
    const float* X1 = p.out;
    bf16_t* HM = (bf16_t*)(p.ws + OFF_SLOT + 2 * SLOT);
    unsigned* gcnt = (unsigned*)(p.ws + OFF_CTL);
    int* LIST = (int*)(p.ws + OFF_LIST); float* WLs = (float*)(p.ws + OFF_WL); int* ROUTE = (int*)(p.ws + OFF_ROUTE);
    for (int tile = bid; tile < NT / 128; tile += nb) {
        if (tid < 16) lcnt[tid] = 0;
        __syncthreads();
        for (int tt = 0; tt < 16; ++tt) {
            const int tl = wave * 16 + tt, tok = tile * 128 + tl;
            const float* mrow = MOD + (tok / SEQ) * 6144;
            f32x4 v[4]; float ss = 0.f;
#pragma unroll
            for (int j = 0; j < 4; ++j) { v[j] = *(const f32x4*)(X1 + (size_t)tok * DM + lane * 4 + 256 * j); ss += v[j][0] * v[j][0] + v[j][1] * v[j][1] + v[j][2] * v[j][2] + v[j][3] * v[j][3]; }
            const float rinv = rsqrtf(wave_sum(ss) * (1.0f / DM) + 1e-6f);
            float lg[20];
#pragma unroll
            for (int o = 0; o < 20; ++o) lg[o] = 0.f;
#pragma unroll
            for (int j = 0; j < 4; ++j) { const int c = lane * 4 + 256 * j;
                const f32x4 g = *(const f32x4*)(p.in[I_GFFN] + c), sh = *(const f32x4*)(mrow + 3 * 1024 + c), sc = *(const f32x4*)(mrow + 4 * 1024 + c);
                f32x4 hm;
#pragma unroll
                for (int e = 0; e < 4; ++e) hm[e] = v[j][e] * rinv * g[e] * (1.0f + sc[e]) + sh[e];
#pragma unroll
                for (int o = 0; o < 20; ++o) { const f32x4 wv = *(const f32x4*)(Wl + o * 1024 + c); lg[o] += hm[0] * wv[0] + hm[1] * wv[1] + hm[2] * wv[2] + hm[3] * wv[3]; }
                *(u32x2*)(HM + (size_t)tok * DM + c) = pk4(hm); }
#pragma unroll
            for (int o = 0; o < 20; ++o) lg[o] = wave_sum(lg[o]);
#pragma unroll
            for (int o = 0; o < 4; ++o) lg[o] += p.in[I_BGRP][o];
#pragma unroll
            for (int o = 0; o < 16; ++o) lg[4 + o] += p.in[I_BER][o];
            int gs = 0; float gm = lg[0];
#pragma unroll
            for (int o = 1; o < 4; ++o) if (lg[o] > gm) { gm = lg[o]; gs = o; }
            float den = 0.f;
#pragma unroll
            for (int o = 0; o < 4; ++o) den += __expf(lg[o] - gm);
            const float pg = 1.0f / den;
            float el[4];
#pragma unroll
            for (int o = 0; o < 4; ++o) el[o] = gs == 0 ? lg[4 + o] : gs == 1 ? lg[8 + o] : gs == 2 ? lg[12 + o] : lg[16 + o];
            int i1 = 0; float v1 = el[0];
#pragma unroll
            for (int o = 1; o < 4; ++o) if (el[o] > v1) { v1 = el[o]; i1 = o; }
            int i2 = -1; float v2 = -3.0e38f;
#pragma unroll
            for (int o = 0; o < 4; ++o) if (o != i1 && el[o] > v2) { v2 = el[o]; i2 = o; }
            const float w1 = 1.0f / (1.0f + __expf(v2 - v1)), w2 = 1.0f - w1;
            if (lane == 0) { const int e1 = gs * 4 + i1, e2 = gs * 4 + i2;
                const int r1 = atomicAdd(&lcnt[e1], 1), r2 = atomicAdd(&lcnt[e2], 1);
                tinfo[tl * 4 + 0] = e1; tinfo[tl * 4 + 1] = r1; tinfo[tl * 4 + 2] = e2; tinfo[tl * 4 + 3] = r2; twt[tl * 2] = pg * w1; twt[tl * 2 + 1] = pg * w2; }
        }
        __syncthreads();
        if (tid < 16) lbase[tid] = (int)__hip_atomic_fetch_add(gcnt + tid, (unsigned)lcnt[tid], __ATOMIC_RELAXED, __HIP_MEMORY_SCOPE_AGENT);
        __syncthreads();
        if (tid < 128) { const int tok = tile * 128 + tid;
            const int e1 = tinfo[tid * 4], e2 = tinfo[tid * 4 + 2], p1 = lbase[e1] + tinfo[tid * 4 + 1], p2 = lbase[e2] + tinfo[tid * 4 + 3];
            LIST[e1 * NT + p1] = tok; LIST[e2 * NT + p2] = tok; WLs[e1 * NT + p1] = twt[tid * 2]; WLs[e2 * NT + p2] = twt[tid * 2 + 1];
            ROUTE[tok * 4 + 0] = e1; ROUTE[tok * 4 + 1] = p1; ROUTE[tok * 4 + 2] = e2; ROUTE[tok * 4 + 3] = p2; }
        __syncthreads();
    }
}

__device__ __forceinline__ void ph10_final(const Params& p, int bid, int nb, const int* meta) {
    const int lane = threadIdx.x & 63, wave = threadIdx.x >> 6;
    const float* MOD = (const float*)(p.ws + OFF_MOD);
    const bf16_t* Y = (const bf16_t*)(p.ws + OFF_SLOT);
    const int* ROUTE = (const int*)(p.ws + OFF_ROUTE);
    float* X1 = p.out;
    for (int r = bid * 8 + wave; r < NT; r += nb * 8) {
        const int e1 = ROUTE[r * 4], p1 = ROUTE[r * 4 + 1], e2 = ROUTE[r * 4 + 2], p2 = ROUTE[r * 4 + 3];
        const bf16_t* y1 = Y + ((size_t)meta[16 + e1] * 256 + p1) * 1024; const bf16_t* y2 = Y + ((size_t)meta[16 + e2] * 256 + p2) * 1024;
        const float* gt = MOD + (r / SEQ) * 6144 + 5 * 1024;
        f32x4 v[4]; float ss = 0.f;
#pragma unroll
        for (int j = 0; j < 4; ++j) { const int c = lane * 4 + 256 * j;
            v[j] = *(const f32x4*)(X1 + (size_t)r * DM + c);
            const u32x2 a = *(const u32x2*)(y1 + c), bq = *(const u32x2*)(y2 + c); const f32x4 g = *(const f32x4*)(gt + c);
            v[j][0] += g[0] * (bflo(a.x) + bflo(bq.x)); v[j][1] += g[1] * (bfhi(a.x) + bfhi(bq.x)); v[j][2] += g[2] * (bflo(a.y) + bflo(bq.y)); v[j][3] += g[3] * (bfhi(a.y) + bfhi(bq.y));
            ss += v[j][0] * v[j][0] + v[j][1] * v[j][1] + v[j][2] * v[j][2] + v[j][3] * v[j][3]; }
        const float rinv = rsqrtf(wave_sum(ss) * (1.0f / DM) + 1e-6f);
#pragma unroll
        for (int j = 0; j < 4; ++j) { const int c = lane * 4 + 256 * j; const f32x4 g = *(const f32x4*)(p.in[I_GFINAL] + c);
            *(f32x4*)(X1 + (size_t)r * DM + c) = v[j] * rinv * g; }
    }
}


#define XB_TMO      128
#define XB_XCNT(j)  (256  + 64 * (j))
#define XB_XSUB(j)  (1280 + 64 * (j))
#define XB_XGEN(j)  (2304 + 64 * (j))
#define XB_TOP      3328
#define XB_TOPGEN   3392
#define XCD_BAR_WORDS 3456
#define XB_SPIN_CAP (1u << 18)
__device__ __forceinline__ unsigned xb_ld(unsigned* p)              { return __hip_atomic_load(p, __ATOMIC_RELAXED, __HIP_MEMORY_SCOPE_AGENT); }
__device__ __forceinline__ unsigned xb_add(unsigned* p, unsigned v) { return __hip_atomic_fetch_add(p, v, __ATOMIC_RELAXED, __HIP_MEMORY_SCOPE_AGENT); }
__device__ __forceinline__ unsigned xb_xcc_id() { return (unsigned)__builtin_amdgcn_s_getreg((3 << 11) | 20) & 0xFu; }
#define XB_SPIN(cond, bar) do { unsigned _sp = 0; while (cond) { __builtin_amdgcn_s_sleep(1); \
    if ((++_sp & 255u) == 0u) { if (xb_ld(&(bar)[XB_TMO])) break; if (_sp > XB_SPIN_CAP) { atomicAdd(&(bar)[XB_TMO], 1u); break; } } } } while (0)
struct XcdBarrier { unsigned* bar; unsigned x; volatile unsigned* st; };
__device__ __forceinline__ XcdBarrier xcd_barrier_post(unsigned* bar, volatile unsigned* st) {
    XcdBarrier b; b.bar = bar; b.x = xb_xcc_id(); b.st = st;
    if (threadIdx.x == 0) (void)xb_add(&bar[XB_XCNT(b.x)], 1u);
    return b;
}
__device__ __forceinline__ void xcd_barrier_complete(unsigned* bar, unsigned x, unsigned& nloc, unsigned& nx) {
    const unsigned G = gridDim.x * gridDim.y * gridDim.z;
    unsigned sum, cnt, mine, sp = 0u;
    for (;;) {
        sum = 0u; cnt = 0u; mine = 0u;
#pragma unroll
        for (unsigned j = 0; j < 16; ++j) { const unsigned c = xb_ld(&bar[XB_XCNT(j)]); sum += c; cnt += (c > 0u) ? 1u : 0u; mine = (j == x) ? c : mine; }
        if (sum == G) break;
        __builtin_amdgcn_s_sleep(1);
        if ((++sp & 255u) == 0u) { if (xb_ld(&bar[XB_TMO])) break; if (sp > XB_SPIN_CAP) { atomicAdd(&bar[XB_TMO], 1u); break; } }
    }
    nloc = mine > 0u ? mine : 1u; nx = cnt > 0u ? cnt : 1u;
}
__device__ __forceinline__ void xcd_barrier(const XcdBarrier& b) {
    asm volatile("s_waitcnt vmcnt(0)" ::: "memory");
    __syncthreads();
    if (threadIdx.x == 0) {
        unsigned* bar = b.bar;
        __builtin_amdgcn_s_waitcnt(0);
        unsigned nloc = b.st[0], nx = b.st[1];
        if (nloc == 0u) { xcd_barrier_complete(bar, b.x, nloc, nx); b.st[0] = nloc; b.st[1] = nx; }
        const unsigned old = xb_add(&bar[XB_XSUB(b.x)], 1u);
        const unsigned gen = old / nloc;
        if (old + 1u == (gen + 1u) * nloc) {
            __builtin_amdgcn_fence(__ATOMIC_RELEASE, "agent");
            asm volatile("s_waitcnt vmcnt(0)" ::: "memory");
            const unsigned og = xb_add(&bar[XB_TOP], 1u);
            const unsigned tg = og / nx;
            if (og + 1u == (tg + 1u) * nx) xb_add(&bar[XB_TOPGEN], 1u);
            else XB_SPIN(xb_ld(&bar[XB_TOPGEN]) == tg, bar);
            __builtin_amdgcn_fence(__ATOMIC_ACQUIRE, "agent");
            xb_add(&bar[XB_XGEN(b.x)], 1u);
            asm volatile("s_waitcnt vmcnt(0)" ::: "memory");
        } else {
            XB_SPIN(xb_ld(&bar[XB_XGEN(b.x)]) == gen, bar);
            __builtin_amdgcn_fence(__ATOMIC_ACQUIRE, "agent");
            asm volatile("s_waitcnt vmcnt(0)" ::: "memory");
        }
    }
    __syncthreads();
}
constexpr size_t OFF_BAR = OFF_CTL + 4096;

__global__ void __launch_bounds__(NTHR) mega(Params p, int lo, int hi) {
    extern __shared__ __attribute__((aligned(16))) unsigned char lds[];
    cg::grid_group grid = cg::this_grid();
    const int bid = blockIdx.x, nb = gridDim.x;
    unsigned char* ws = p.ws;
    bf16_t* S0 = (bf16_t*)(ws + OFF_SLOT), *S1 = (bf16_t*)(ws + OFF_SLOT + SLOT), *S2 = (bf16_t*)(ws + OFF_SLOT + 2 * SLOT), *S3 = (bf16_t*)(ws + OFF_SLOT + 3 * SLOT),
           *S4 = (bf16_t*)(ws + OFF_SLOT + 4 * SLOT), *S5 = (bf16_t*)(ws + OFF_SLOT + 5 * SLOT);
    const float* MOD = (const float*)(ws + OFF_MOD); const float* BINP = (const float*)(ws + OFF_BINP);
    int* meta = (int*)(lds + LDS_BYTES - 256);
#ifndef PHMASK
#define PHMASK 0x7ff
#endif
#define IN(k) (((PHMASK >> (k)) & 1) && lo <= (k) && (k) < hi)
#ifndef PIPE_MASK
#define PIPE_MASK 0x364
#endif
#define GEMM_RUN(k, gather, s, e) gemm_phase_pipe<gather>(lds, s, e)
    volatile unsigned* xst = (volatile unsigned*)(lds + LDS_BYTES - 16);
    if (threadIdx.x < 2) xst[threadIdx.x] = 0u;
    __syncthreads();
    XcdBarrier xbar; xbar.bar = (unsigned*)(ws + OFF_BAR); xbar.x = 0; xbar.st = xst;
    if (hi - lo > 1) xbar = xcd_barrier_post((unsigned*)(ws + OFF_BAR), xst);
    if (p.pv == 0x7eadbeef) grid.sync();
#define SEAM(k) do { if (IN(k) && IN((k) + 1)) xcd_barrier(xbar); } while (0)
    if (IN(0)) { ph0_prep(p, bid, nb, lds); } SEAM(0);
    if (IN(1)) { ph1_norm(p, bid, nb); } SEAM(1);
    if (IN(2)) {
        { SchCtx s{(const bf16_t*)(ws + OFF_HC), (const bf16_t*)(ws + OFF_WIN), nb, bid, 1024}; EpiCtx e{(bf16_t*)(ws + OFF_XRC), BINP}; GEMM_RUN(2, false, s, e); }
        { SchG1 s{S0, (const bf16_t*)(ws + OFF_WIN), nb, bid, 1024}; EpiG1 e{S1, S2, S3, S4, S5, BINP}; GEMM_RUN(2, false, s, e); }
    } SEAM(2);
    if (IN(3)) {
        for (int g = bid; g < 512; g += nb) aprep_item(p, g, lds);
        b_phase<false>(p, bid, nb, lds);
    } SEAM(3);
    if (IN(4)) {
        b_phase<true>(p, bid, nb, lds);
    } SEAM(4);
    if (IN(5)) { SchG2 s{S0, S1, (const bf16_t*)(ws + OFF_WPA), (const bf16_t*)(ws + OFF_WPB), nb, bid, 1024}; EpiG2 e{S4, S5, S3}; GEMM_RUN(5, false, s, e); } SEAM(5);
    if (IN(6)) { SchG3 s{S3, (const bf16_t*)(ws + OFF_WO), nb, bid, 1024}; EpiG3 e{p.in[I_X], MOD, p.out}; GEMM_RUN(6, false, s, e); } SEAM(6);
    if (IN(7)) { ph8_route(p, bid, nb, lds); } SEAM(7);
    if (IN(8)) { __syncthreads(); moe_meta_build(p, meta); MoeMeta mm{meta};
        int* idx = (int*)(lds + STAGE_BYTES);
        SchUp s{S2, (const bf16_t*)(ws + OFF_WGU), (const int*)(ws + OFF_LIST), mm, nb, bid, 1024, idx}; EpiUp e{S4, (const float*)(ws + OFF_WL), mm};
        { Unit u; for (int i = 0; i < 8 && s.next(i, u); ++i) { if (threadIdx.x < 256) { int pos = u.aux2 + (int)threadIdx.x; const int c = mm.cnt(u.aux); pos = pos < c ? pos : c - 1; idx[i * 256 + threadIdx.x] = s.LIST[u.aux * NT + pos]; } } }
        __syncthreads();
        GEMM_RUN(8, true, s, e); } SEAM(8);
    if (IN(9)) { __syncthreads(); moe_meta_build(p, meta); MoeMeta mm{meta};
        SchDn s{S4, (const bf16_t*)(ws + OFF_WDN), mm, nb, bid, 512}; EpiDn e{S0, mm}; GEMM_RUN(9, false, s, e); } SEAM(9);
    if (IN(10)) { __syncthreads(); moe_meta_build(p, meta); ph10_final(p, bid, nb, meta); }
#undef IN
#undef SEAM
}

extern "C" void kernel_launch(void* const* d_in, const int* in_sizes, int n_in, void* d_out, int out_size, void* d_ws, size_t ws_size, hipStream_t stream) {
    static int grid = 0;
    if (grid == 0) {
        if (n_in != 37 || out_size != NT * DM || ws_size < WS_END) { fprintf(stderr, "kernel_launch: unexpected shapes: n_in %d out %d ws %zu (need %zu)\n", n_in, out_size, ws_size, (size_t)WS_END); grid = -1; return; }
        int dev = 0, cus = 0, per_cu = 0;
        (void)hipGetDevice(&dev); (void)hipDeviceGetAttribute(&cus, hipDeviceAttributeMultiprocessorCount, dev);
        if (hipFuncSetAttribute((const void*)mega, hipFuncAttributeMaxDynamicSharedMemorySize, LDS_BYTES) != hipSuccess) { fprintf(stderr, "kernel_launch: hipFuncSetAttribute failed\n"); grid = -1; return; }
        if (hipOccupancyMaxActiveBlocksPerMultiprocessor(&per_cu, (const void*)mega, NTHR, LDS_BYTES) != hipSuccess || per_cu < 1) { fprintf(stderr, "kernel_launch: occupancy query says %d\n", per_cu); per_cu = 1; }
        (void)hipGetLastError();
        grid = cus * 1;
        fprintf(stderr, "kernel_launch: grid %d (cus %d, per_cu %d)\n", grid, cus, per_cu);
    }
    if (grid < 0) return;
    Params p{};
    for (int i = 0; i < 37; ++i) p.in[i] = (const float*)d_in[i];
    p.out = (float*)d_out; p.ws = (unsigned char*)d_ws;
#if ONE_LAUNCH
    (void)hipMemsetAsync((unsigned char*)d_ws + OFF_BAR, 0, XCD_BAR_WORDS * 4, stream);
    int lo = 0, hi = NPHASE; void* args[] = {&p, &lo, &hi};
    hipError_t e = hipLaunchCooperativeKernel((const void*)mega, dim3(grid), dim3(NTHR), args, LDS_BYTES, stream);
    if (e != hipSuccess) fprintf(stderr, "cooperative launch failed: %s (grid %d)\n", hipGetErrorString(e), grid);
#ifdef PROBE_PHASE
    hipLaunchKernelGGL(mega, dim3(grid), dim3(NTHR), LDS_BYTES, stream, p, PROBE_PHASE, PROBE_PHASE + 1);
#endif
#else
    for (int k = 0; k < NPHASE; ++k) hipLaunchKernelGGL(mega, dim3(grid), dim3(NTHR), LDS_BYTES, stream, p, k, k + 1);
#endif
}
```

```cpp
#include <hip/hip_runtime.h>
#include <hip/hip_cooperative_groups.h>
#include <cstdio>
#include <cstdint>
namespace cg = cooperative_groups;

#ifndef ONE_LAUNCH
#define ONE_LAUNCH 1
#endif

typedef unsigned short bf16_t;
typedef short bf16x8 __attribute__((ext_vector_type(8)));
typedef float f32x4 __attribute__((ext_vector_type(4)));
typedef float f32x2 __attribute__((ext_vector_type(2)));
typedef unsigned u32x4 __attribute__((ext_vector_type(4)));
typedef unsigned u32x2 __attribute__((ext_vector_type(2)));

constexpr int NT = 32768, NCX = 1024, DM = 1024, SEQ = 8192, CTXL = 256;
constexpr int NTHR = 512;
constexpr int NCH64 = 132;
constexpr size_t MiB = (size_t)1 << 20;
constexpr size_t OFF_CTL = 0, OFF_MOD = 1 * MiB, OFF_BINP = OFF_MOD + 128 * 1024, OFF_WIN = 2 * MiB, OFF_WPA = 14 * MiB, OFF_WPB = 16 * MiB,
                 OFF_WO = 18 * MiB, OFF_WG = 20 * MiB, OFF_WGU = 22 * MiB, OFF_WDN = 54 * MiB, OFF_HC = 70 * MiB, OFF_XRC = 72 * MiB,
                 OFF_TOT = 74 * MiB, OFF_ROUTE = 84 * MiB, OFF_LIST = 85 * MiB, OFF_WL = 87 * MiB, OFF_SLOT = 90 * MiB, SLOT = 64 * MiB,
                 WS_END = OFF_SLOT + 6 * SLOT;
constexpr int LDS_BYTES = 144 * 1024;
constexpr int NPHASE = 11;

struct Params { const float* in[37]; float* out; unsigned char* ws; int pv; int pad; };

enum { I_X = 0, I_C, I_CTX, I_CCTX, I_WADA, I_BADA, I_GMIX, I_WIN, I_BIN, I_CONVW, I_CONVB, I_LNG, I_LNB, I_WPA, I_LCW, I_LCB,
       I_WRF, I_BRF, I_WIF, I_BIF, I_LAMF, I_WRB, I_BRB, I_WIB, I_BIB, I_LAMB, I_WPB, I_WO, I_GFFN, I_WGRP, I_BGRP, I_WER, I_BER,
       I_WGATE, I_WUP, I_WDOWN, I_GFINAL };

__device__ __forceinline__ float bflo(unsigned w) { return __uint_as_float(w << 16); }
__device__ __forceinline__ float bfhi(unsigned w) { return __uint_as_float(w & 0xffff0000u); }
__device__ __forceinline__ float bf2f(bf16_t h) { return __uint_as_float(((unsigned)h) << 16); }
__device__ __forceinline__ unsigned pk2(float lo, float hi) { unsigned r; asm("v_cvt_pk_bf16_f32 %0, %1, %2" : "=v"(r) : "v"(lo), "v"(hi)); return r; }
__device__ __forceinline__ bf16_t f2bf(float f) { return (bf16_t)(pk2(f, 0.f) & 0xffffu); }
__device__ __forceinline__ float sigm(float x) { return __builtin_amdgcn_rcpf(1.0f + __expf(-x)); }
__device__ __forceinline__ float silu(float x) { return x * sigm(x); }
__device__ __forceinline__ float gelu_tanh(float x) { return x * sigm(1.5957691216057308f * (x + 0.044715f * x * x * x)); }
__device__ __forceinline__ float wave_sum(float v) {
#pragma unroll
    for (int o = 1; o < 64; o <<= 1) v += __shfl_xor(v, o);
    return v;
}
__device__ __forceinline__ void wave_lds_sync() { asm volatile("s_waitcnt lgkmcnt(0)" ::: "memory"); __builtin_amdgcn_wave_barrier(); }
__device__ __forceinline__ u32x2 pk4(f32x4 v) { u32x2 r; r.x = pk2(v[0], v[1]); r.y = pk2(v[2], v[3]); return r; }

__device__ __forceinline__ u32x4 pk8(f32x4 a, f32x4 b) { u32x4 r; r.x = pk2(a[0], a[1]); r.y = pk2(a[2], a[3]); r.z = pk2(b[0], b[1]); r.w = pk2(b[2], b[3]); return r; }
__device__ __forceinline__ void unpk8(u32x4 w, f32x4& a, f32x4& b) { a[0] = bflo(w.x); a[1] = bfhi(w.x); a[2] = bflo(w.y); a[3] = bfhi(w.y); b[0] = bflo(w.z); b[1] = bfhi(w.z); b[2] = bflo(w.w); b[3] = bfhi(w.w); }

template <class DRow>
__device__ __forceinline__ void tr_item(const float* __restrict__ src, int ldsrc, int k0, int n0, bf16_t* dst, int ldd, DRow drow, float* scr, int lane) {
#pragma unroll 8
    for (int i = 0; i < 32; ++i) { const int kk = 2 * i + (lane >> 5); scr[kk * 33 + (lane & 31)] = src[(size_t)(k0 + kk) * ldsrc + n0 + (lane & 31)]; }
    wave_lds_sync();
    const int c = lane & 7;
#pragma unroll
    for (int j = 0; j < 4; ++j) {
        const int n = (lane >> 3) + 8 * j; const float* s = scr + (8 * c) * 33 + n;
        u32x4 o; o.x = pk2(s[0], s[33]); o.y = pk2(s[66], s[99]); o.z = pk2(s[132], s[165]); o.w = pk2(s[198], s[231]);
        *(u32x4*)(dst + (size_t)drow(n0 + n) * ldd + k0 + 8 * c) = o;
    }
    wave_lds_sync();
}

__device__ __forceinline__ int win_srccol(int np) { const int p = np >> 8, r = np & 255; return p < 8 ? (r >> 7) * 1024 + 128 * p + (r & 127) : np; }

__device__ __forceinline__ void ph0_prep(const Params& p, int bid, int nb, unsigned char* lds) {
    const int tid = threadIdx.x, lane = tid & 63, wave = tid >> 6;
    unsigned char* ws = p.ws;
    float* scr = (float*)lds + wave * (64 * 33);
    const int gw = bid * 8 + wave, NGW = nb * 8;
    constexpr int N_WIN = 16 * 192, N_SQ = 16 * 32, N_G = 256, N_GU = 4096, N_DN = 4096;
    constexpr int NITEMS = N_WIN + 3 * N_SQ + N_G + 2 * N_GU + N_DN;
    for (int it = gw; it < NITEMS; it += NGW) {
        int r = it;
        if (r < N_WIN) { const int kb = r / 192, nbk = r % 192, d0 = 32 * nbk, sc0 = win_srccol(d0);
            tr_item(p.in[I_WIN], 6144, 64 * kb, sc0, (bf16_t*)(ws + OFF_WIN), 1024, [=](int n) { return n - sc0 + d0; }, scr, lane); continue; }
        r -= N_WIN;
        if (r < 3 * N_SQ) { const int which = r / N_SQ, q = r % N_SQ, kb = q / 32, nbk = q % 32;
            const float* src = which == 0 ? p.in[I_WPA] : which == 1 ? p.in[I_WPB] : p.in[I_WO];
            bf16_t* dst = (bf16_t*)(ws + (which == 0 ? OFF_WPA : which == 1 ? OFF_WPB : OFF_WO));
            tr_item(src, 1024, 64 * kb, 32 * nbk, dst, 1024, [=](int n) { return n; }, scr, lane); continue; }
        r -= 3 * N_SQ;
        if (r < N_G) { const int ty = r / 64, q = r % 64, h = q / 8, kb = (q % 8) / 4, nbk = q % 4;
            const float* src = (ty == 0 ? p.in[I_WRF] : ty == 1 ? p.in[I_WIF] : ty == 2 ? p.in[I_WRB] : p.in[I_WIB]) + (size_t)h * 128 * 128;
            tr_item(src, 128, 64 * kb, 32 * nbk, (bf16_t*)(ws + OFF_WG), 128, [=](int n) { return h * 512 + (n >> 4) * 64 + ty * 16 + (n & 15); }, scr, lane); continue; }
        r -= N_G;
        if (r < 2 * N_GU) { const int bj = r / N_GU, q = r % N_GU, e = q / 256, kb = (q % 256) / 16, nbk = q % 16;
            const float* src = (bj == 0 ? p.in[I_WGATE] : p.in[I_WUP]) + (size_t)e * 1024 * 512;
            tr_item(src, 512, 64 * kb, 32 * nbk, (bf16_t*)(ws + OFF_WGU) + (size_t)e * 1024 * 1024, 1024, [=](int n) { return 256 * (n >> 7) + 128 * bj + (n & 127); }, scr, lane); continue; }
        r -= 2 * N_GU;
        { const int e = r / 256, kb = (r % 256) / 32, nbk = r % 32;
            tr_item(p.in[I_WDOWN] + (size_t)e * 512 * 1024, 1024, 64 * kb, 32 * nbk, (bf16_t*)(ws + OFF_WDN) + (size_t)e * 1024 * 512, 512, [=](int n) { return n; }, scr, lane); }
    }
    __syncthreads();
    float* red = (float*)lds;
    float* MOD = (float*)(ws + OFF_MOD);
    for (int it = bid; it < 96; it += nb) {
        const int col = it * 64 + lane;
        float a[5] = {0.f, 0.f, 0.f, 0.f, 0.f};
        const float* W = p.in[I_WADA];
        for (int k = wave * 128; k < wave * 128 + 128; ++k) {
            const float wv = W[(size_t)k * 6144 + col];
#pragma unroll
            for (int r = 0; r < 5; ++r) { const float cv = r < 4 ? p.in[I_C][r * 1024 + k] : p.in[I_CCTX][k]; a[r] += silu(cv) * wv; }
        }
#pragma unroll
        for (int r = 0; r < 5; ++r) red[(wave * 5 + r) * 64 + lane] = a[r];
        __syncthreads();
        if (tid < 320) { const int r = tid / 64, l = tid % 64; float s = 0.f;
#pragma unroll
            for (int w = 0; w < 8; ++w) s += red[(w * 5 + r) * 64 + l];
            MOD[r * 6144 + it * 64 + l] = s + p.in[I_BADA][it * 64 + l]; }
        __syncthreads();
    }
    float* BINP = (float*)(ws + OFF_BINP);
    for (int i = bid * NTHR + tid; i < 6144; i += nb * NTHR) BINP[i] = p.in[I_BIN][win_srccol(i)];
    if (bid == 0 && tid < 64) ((unsigned*)(ws + OFF_CTL))[tid] = 0u;
}

__device__ __forceinline__ void ph1_norm(const Params& p, int bid, int nb) {
    const int lane = threadIdx.x & 63, wave = threadIdx.x >> 6;
    const float* MOD = (const float*)(p.ws + OFF_MOD);
    for (int r = bid * 8 + wave; r < NT + NCX; r += nb * 8) {
        const bool lat = r < NT;
        const float* src = lat ? p.in[I_X] + (size_t)r * DM : p.in[I_CTX] + (size_t)(r - NT) * DM;
        bf16_t* dst = lat ? (bf16_t*)(p.ws + OFF_SLOT) + (size_t)r * DM : (bf16_t*)(p.ws + OFF_HC) + (size_t)(r - NT) * DM;
        const float* mrow = MOD + (lat ? r / SEQ : 4) * 6144;
        f32x4 v[4]; float ss = 0.f;
#pragma unroll
        for (int j = 0; j < 4; ++j) { v[j] = *(const f32x4*)(src + lane * 4 + 256 * j); ss += v[j][0] * v[j][0] + v[j][1] * v[j][1] + v[j][2] * v[j][2] + v[j][3] * v[j][3]; }
        const float rinv = rsqrtf(wave_sum(ss) * (1.0f / DM) + 1e-6f);
#pragma unroll
        for (int j = 0; j < 4; ++j) { const int c = lane * 4 + 256 * j;
            const f32x4 g = *(const f32x4*)(p.in[I_GMIX] + c), sh = *(const f32x4*)(mrow + c), sc = *(const f32x4*)(mrow + 1024 + c);
            f32x4 o;
#pragma unroll
            for (int e = 0; e < 4; ++e) o[e] = v[j][e] * rinv * g[e] * (1.0f + sc[e]) + sh[e];
            *(u32x2*)(dst + c) = pk4(o); }
    }
}

struct Unit { int pm, pn, aux, aux2; };

#define LAS __attribute__((address_space(3)))
constexpr int BK = 64, HTB = 128 * BK * 2, STAGE_BYTES = 8 * HTB;
__device__ __forceinline__ int lds_byte(int r, int c) { const int st = (r >> 4) * 2 + (c >> 5), rr = r & 15, cc = c & 31, ob = rr * 64 + cc * 2; return st * 1024 + (ob ^ (((ob >> 9) & 1) << 5)); }
__device__ __forceinline__ void stage_rc(int b, int& R, int& C) { const int st = b / 1024, sb = b % 1024, swz = sb ^ (((sb >> 9) & 1) << 5); R = (st >> 1) * 16 + swz / 64; C = (st & 1) * 32 + (swz % 64) / 2; }

template <bool GATHER, class S, class E>
__device__ __forceinline__ void gemm_phase_pipe(unsigned char* ldsg, const S& sch, const E& epi) {
    LAS unsigned char* lds = (LAS unsigned char*)ldsg;
    const int tid = threadIdx.x, wid = __builtin_amdgcn_readfirstlane(tid >> 6), lane = tid & 63, wr = wid >> 2, wc = wid & 3, fr = lane & 15, fq = lane >> 4;
    const int K = sch.K, nt = K / BK;
    int Rr[2], Cc[2]; unsigned voffA[2], voffB[2];
#pragma unroll
    for (int i = 0; i < 2; ++i) { stage_rc(tid * 16 + i * 8192, Rr[i], Cc[i]); voffA[i] = (unsigned)(Rr[i] * K + Cc[i]) * 2u;
        const int rho = Rr[i] & 31, Rb = (Rr[i] & ~31) + 8 * ((rho & 15) >> 2) + 4 * (rho >> 4) + (rho & 3);
        voffB[i] = (unsigned)(Rb * K + Cc[i]) * 2u; }
    const size_t kstep = (size_t)(BK * 2);
    const size_t hstep = (size_t)128 * K * 2;
    const unsigned ldsw = (unsigned)wid * 1024u;
    const int aoff = lds_byte(wr * 64 + fr, fq * 8), boff = lds_byte(wc * 32 + fr, fq * 8);
#define PG8_SA(b, h) (((b) * 2 + (h)) * HTB)
#define PG8_SB(b, h) ((4 + (b) * 2 + (h)) * HTB)
#define PG8_STAGE_B(bufoff, gbase) do { _Pragma("unroll") for (int _i = 0; _i < 2; ++_i) \
        __builtin_amdgcn_global_load_lds((const unsigned*)((const char*)(gbase) + voffB[_i]), (LAS unsigned*)(lds + (bufoff) + ldsw + _i * 8192), 16, 0, 0); } while (0)
#define PG8_STAGE_A(bufoff, gbase, h, vo) do { _Pragma("unroll") for (int _i = 0; _i < 2; ++_i) \
        __builtin_amdgcn_global_load_lds((const unsigned*)((const char*)(gbase) + (GATHER ? (size_t)(vo)[h][_i] : (size_t)(h) * hstep + voffA[_i])), (LAS unsigned*)(lds + (bufoff) + ldsw + _i * 8192), 16, 0, 0); } while (0)
#define PG8_LDA(dst, b, h) do { _Pragma("unroll") for (int m = 0; m < 4; ++m) _Pragma("unroll") for (int k = 0; k < 2; ++k) dst[m][k] = *(const LAS bf16x8*)(lds + PG8_SA(b, h) + aoff + m * 2048 + k * 1024); } while (0)
#define PG8_LDB(dst, b, h) do { _Pragma("unroll") for (int n = 0; n < 2; ++n) _Pragma("unroll") for (int k = 0; k < 2; ++k) dst[n][k] = *(const LAS bf16x8*)(lds + PG8_SB(b, h) + boff + n * 2048 + k * 1024); } while (0)
#define PG8_MMA(ai, bj, At, Bt) do { __builtin_amdgcn_s_setprio(1); _Pragma("unroll") for (int m = 0; m < 4; ++m) _Pragma("unroll") for (int n = 0; n < 2; ++n) _Pragma("unroll") for (int k = 0; k < 2; ++k) \
        acc[ai][bj][m][n] = __builtin_amdgcn_mfma_f32_16x16x32_bf16(Bt[n][k], At[m][k], acc[ai][bj][m][n], 0, 0, 0); __builtin_amdgcn_s_setprio(0); } while (0)
#define PG8_WAIT_V(n) asm volatile("s_waitcnt vmcnt(" #n ")" ::: "memory")
#define PG8_WAIT_L(n) asm volatile("s_waitcnt lgkmcnt(" #n ")" ::: "memory")
#define PG8_BAR __builtin_amdgcn_s_barrier()
#define PG8_SCHED __builtin_amdgcn_sched_barrier(0)
    Unit cur, nxt; int ui = 0;
    if (!sch.next(0, cur)) return;
    f32x4 acc[2][2][4][2];
#pragma unroll
    for (int a = 0; a < 2; ++a)
#pragma unroll
        for (int b = 0; b < 2; ++b)
#pragma unroll
            for (int m = 0; m < 4; ++m)
#pragma unroll
                for (int n = 0; n < 2; ++n) acc[a][b][m][n] = (f32x4){0.f, 0.f, 0.f, 0.f};
    bf16x8 At[4][2], B0[2][2], B1[2][2];
    unsigned voAc[2][2], voAn[2][2];
#pragma unroll
    for (int h = 0; h < 2; ++h)
#pragma unroll
        for (int i = 0; i < 2; ++i) { voAc[h][i] = GATHER ? sch.aoff(cur, 128 * h + Rr[i]) + (unsigned)Cc[i] * 2u : 0u; voAn[h][i] = voAc[h][i]; }
    const char* cA = sch.abase(cur); const char* cB = sch.bbase(cur);
    PG8_STAGE_B(PG8_SB(0, 0), cB); PG8_STAGE_A(PG8_SA(0, 0), cA, 0, voAc); PG8_STAGE_B(PG8_SB(0, 1), cB + hstep); PG8_STAGE_A(PG8_SA(0, 1), cA, 1, voAc);
    if (wr == 1) PG8_BAR;
    PG8_WAIT_V(4); PG8_BAR;
    PG8_STAGE_B(PG8_SB(1, 0), cB + kstep); PG8_STAGE_A(PG8_SA(1, 0), cA + kstep, 0, voAc); PG8_STAGE_B(PG8_SB(1, 1), cB + hstep + kstep);
    PG8_WAIT_V(6); PG8_BAR;
    for (;;) {
        const bool has_next = sch.next(ui + 1, nxt);
        const char* nA = has_next ? sch.abase(nxt) : cA; const char* nB = has_next ? sch.bbase(nxt) : cB;
        if (GATHER) {
#pragma unroll
            for (int h = 0; h < 2; ++h)
#pragma unroll
                for (int i = 0; i < 2; ++i) voAn[h][i] = has_next ? sch.aoff(nxt, 128 * h + Rr[i]) + (unsigned)Cc[i] * 2u : voAc[h][i];
        }
#pragma unroll 1
        for (int t = 0; t < nt; t += 2) {
            const bool last = (t == nt - 2);
            const char* a1 = cA + (size_t)(t + 1) * kstep;
            const char* a2 = last ? nA : cA + (size_t)(t + 2) * kstep; const char* b2 = last ? nB : cB + (size_t)(t + 2) * kstep;
            const char* a3 = a2 + kstep; const char* b3 = b2 + kstep;
            unsigned vo2[2][2];
#pragma unroll
            for (int h = 0; h < 2; ++h)
#pragma unroll
                for (int i = 0; i < 2; ++i) vo2[h][i] = last ? voAn[h][i] : voAc[h][i];
            PG8_LDB(B0, 0, 0); PG8_SCHED; PG8_LDA(At, 0, 0); PG8_STAGE_A(PG8_SA(1, 1), a1, 1, voAc);
            PG8_WAIT_L(8); PG8_BAR; PG8_WAIT_L(0); PG8_MMA(0, 0, At, B0); PG8_BAR; PG8_SCHED;
            PG8_LDB(B1, 0, 1); PG8_STAGE_B(PG8_SB(0, 0), b2);
            PG8_BAR; PG8_WAIT_L(0); PG8_MMA(0, 1, At, B1); PG8_BAR;
            PG8_LDA(At, 0, 1); PG8_STAGE_A(PG8_SA(0, 0), a2, 0, vo2);
            PG8_BAR; PG8_WAIT_L(0); PG8_MMA(1, 0, At, B0); PG8_BAR; PG8_SCHED;
            PG8_STAGE_B(PG8_SB(0, 1), b2 + hstep);
            PG8_WAIT_V(6); PG8_BAR; PG8_MMA(1, 1, At, B1); PG8_BAR;
            PG8_LDB(B0, 1, 0); PG8_SCHED; PG8_LDA(At, 1, 0); PG8_STAGE_A(PG8_SA(0, 1), a2, 1, vo2);
            PG8_WAIT_L(8); PG8_BAR; PG8_WAIT_L(0); PG8_MMA(0, 0, At, B0); PG8_BAR; PG8_SCHED;
            PG8_LDB(B1, 1, 1); PG8_STAGE_B(PG8_SB(1, 0), b3);
            PG8_BAR; PG8_WAIT_L(0); PG8_MMA(0, 1, At, B1); PG8_BAR;
            PG8_LDA(At, 1, 1); PG8_STAGE_A(PG8_SA(1, 0), a3, 0, vo2);
            PG8_BAR; PG8_WAIT_L(0); PG8_MMA(1, 0, At, B0); PG8_BAR; PG8_SCHED;
            PG8_STAGE_B(PG8_SB(1, 1), b3 + hstep);
            PG8_WAIT_V(6); PG8_BAR; PG8_MMA(1, 1, At, B1); PG8_BAR;
        }
        { int frx = fr, fqx = fq; asm volatile("" : "+v"(frx), "+v"(fqx));
            const int jx = wc * 32 + 8 * fqx, rx = wr * 64 + frx;
            const typename E::Col ecol = epi.col(cur, jx);
            typename E::Pre epre = epi.load(cur, rx, jx);
#pragma unroll
            for (int g = 0; g < 8; ++g) { const int ai = g >> 2, m = g & 3;
                typename E::Pre enx = epre; if (g < 7) enx = epi.load(cur, ((g + 1) >> 2) * 128 + ((g + 1) & 3) * 16 + rx, jx);
                epi.apply(cur, ai * 128 + m * 16 + rx, jx, ecol, epre, acc[ai][0][m][0], acc[ai][0][m][1], acc[ai][1][m][0], acc[ai][1][m][1]);
                epre = enx; } }
        if (!has_next) break;
#pragma unroll
        for (int a = 0; a < 2; ++a)
#pragma unroll
            for (int b = 0; b < 2; ++b)
#pragma unroll
                for (int m = 0; m < 4; ++m)
#pragma unroll
                    for (int n = 0; n < 2; ++n) acc[a][b][m][n] = (f32x4){0.f, 0.f, 0.f, 0.f};
        cur = nxt; cA = nA; cB = nB; ++ui;
#pragma unroll
        for (int h = 0; h < 2; ++h)
#pragma unroll
            for (int i = 0; i < 2; ++i) voAc[h][i] = voAn[h][i];
    }
    PG8_WAIT_V(0);
    if (wr == 0) PG8_BAR;
    PG8_BAR;
#undef PG8_SA
#undef PG8_SB
#undef PG8_STAGE_A
#undef PG8_STAGE_B
#undef PG8_LDA
#undef PG8_LDB
#undef PG8_MMA
#undef PG8_WAIT_V
#undef PG8_WAIT_L
#undef PG8_BAR
#undef PG8_SCHED
}

struct SchG1 { const bf16_t *A, *Bt; int G, c, K;
    __device__ __forceinline__ bool next(int i, Unit& u) const { const int L = i * G + c; if (L >= 128 * 24) return false; u.pm = L / 24; u.pn = L % 24; return true; }
    __device__ __forceinline__ const bf16_t* arow(const Unit& u, int r) const { return A + (size_t)(u.pm * 256 + r) * 1024; }
    __device__ __forceinline__ const bf16_t* brow(const Unit& u, int n) const { return Bt + (size_t)(u.pn * 256 + n) * 1024; }
    __device__ __forceinline__ const char* abase(const Unit& u) const { return (const char*)(A + (size_t)u.pm * 256 * 1024); }
    __device__ __forceinline__ const char* bbase(const Unit& u) const { return (const char*)(Bt + (size_t)u.pn * 256 * 1024); }
    __device__ __forceinline__ unsigned aoff(const Unit&, int) const { return 0u; } };
struct EpiG1 { bf16_t *Z, *GYG, *XR, *SGA, *SGB; const float* bias;
    struct Col { f32x4 c0, c1, c2, c3; }; struct Pre { };
    __device__ __forceinline__ Col col(const Unit& u, int j) const { const float* bp = bias + u.pn * 256 + j; return Col{*(const f32x4*)bp, *(const f32x4*)(bp + 4), *(const f32x4*)(bp + 128), *(const f32x4*)(bp + 132)}; }
    __device__ __forceinline__ Pre load(const Unit&, int, int) const { return Pre{}; }
    __device__ __forceinline__ void apply(const Unit& u, int r, int j, const Col& c, const Pre&, f32x4 a0, f32x4 a1, f32x4 b0, f32x4 b1) const {
        const size_t row = (size_t)u.pm * 256 + r;
        a0 += c.c0; a1 += c.c1; b0 += c.c2; b1 += c.c3;
        if (u.pn < 8) {
#pragma unroll
            for (int e = 0; e < 4; ++e) { a0[e] *= sigm(b0[e]); a1[e] *= sigm(b1[e]); }
            *(u32x4*)(Z + row * 1024 + u.pn * 128 + j) = pk8(a0, a1); }
        else { const int kind = u.pn >> 2;
            bf16_t* dst = GYG + (size_t)(kind - 2) * (SLOT / 2);
#pragma unroll
            for (int e = 0; e < 4; ++e) { if (kind == 2) { a0[e] = gelu_tanh(a0[e]); a1[e] = gelu_tanh(a1[e]); b0[e] = gelu_tanh(b0[e]); b1[e] = gelu_tanh(b1[e]); }
                else if (kind >= 4) { a0[e] = sigm(a0[e]); a1[e] = sigm(a1[e]); b0[e] = sigm(b0[e]); b1[e] = sigm(b1[e]); } }
            bf16_t* o = dst + row * 1024 + (u.pn & 3) * 256 + j;
            *(u32x4*)o = pk8(a0, a1); *(u32x4*)(o + 128) = pk8(b0, b1); }
    } };
struct SchCtx { const bf16_t *A, *Bt; int G, c, K;
    __device__ __forceinline__ bool next(int i, Unit& u) const { const int L = i * G + c; if (L >= 16) return false; u.pm = L / 4; u.pn = L % 4; return true; }
    __device__ __forceinline__ const bf16_t* arow(const Unit& u, int r) const { return A + (size_t)(u.pm * 256 + r) * 1024; }
    __device__ __forceinline__ const bf16_t* brow(const Unit& u, int n) const { return Bt + (size_t)((12 + u.pn) * 256 + n) * 1024; }
    __device__ __forceinline__ const char* abase(const Unit& u) const { return (const char*)(A + (size_t)u.pm * 256 * 1024); }
    __device__ __forceinline__ const char* bbase(const Unit& u) const { return (const char*)(Bt + (size_t)(12 + u.pn) * 256 * 1024); }
    __device__ __forceinline__ unsigned aoff(const Unit&, int) const { return 0u; } };
struct EpiCtx { bf16_t* XRC; const float* bias;
    struct Col { f32x4 c0, c1, c2, c3; }; struct Pre { };
    __device__ __forceinline__ Col col(const Unit& u, int j) const { const float* bp = bias + (12 + u.pn) * 256 + j; return Col{*(const f32x4*)bp, *(const f32x4*)(bp + 4), *(const f32x4*)(bp + 128), *(const f32x4*)(bp + 132)}; }
    __device__ __forceinline__ Pre load(const Unit&, int, int) const { return Pre{}; }
    __device__ __forceinline__ void apply(const Unit& u, int r, int j, const Col& c, const Pre&, f32x4 a0, f32x4 a1, f32x4 b0, f32x4 b1) const {
        const size_t row = (size_t)u.pm * 256 + r;
        a0 += c.c0; a1 += c.c1; b0 += c.c2; b1 += c.c3;
        bf16_t* o = XRC + row * 1024 + u.pn * 256 + j; *(u32x4*)o = pk8(a0, a1); *(u32x4*)(o + 128) = pk8(b0, b1); } };
struct SchG2 { const bf16_t *Aa, *Ab, *Wa, *Wb; int G, c, K;
    __device__ __forceinline__ bool next(int i, Unit& u) const { const int t = (i >> 1) * G + c; if (t >= 512) return false; u.pm = t >> 2; u.pn = t & 3; u.aux = i & 1; return true; }
    __device__ __forceinline__ const bf16_t* arow(const Unit& u, int r) const { return Aa + (size_t)u.aux * (SLOT / 2) + (size_t)(u.pm * 256 + r) * 1024; }
    __device__ __forceinline__ const bf16_t* brow(const Unit& u, int n) const { return Wa + (size_t)u.aux * (1024 * 1024) + (size_t)(u.pn * 256 + n) * 1024; }
    __device__ __forceinline__ const char* abase(const Unit& u) const { return (const char*)(Aa + (size_t)u.aux * (SLOT / 2) + (size_t)u.pm * 256 * 1024); }
    __device__ __forceinline__ const char* bbase(const Unit& u) const { return (const char*)(Wa + (size_t)u.aux * (1024 * 1024) + (size_t)u.pn * 256 * 1024); }
    __device__ __forceinline__ unsigned aoff(const Unit&, int) const { return 0u; } };
struct EpiG2 { const bf16_t *SGA, *SGB; bf16_t* M;
    struct Col { }; struct Pre { u32x4 g0, g1, t0, t1; };
    __device__ __forceinline__ Col col(const Unit&, int) const { return Col{}; }
    __device__ __forceinline__ Pre load(const Unit& u, int r, int j) const {
        const size_t o = ((size_t)u.pm * 256 + r) * 1024 + u.pn * 256 + j; const bf16_t* G = SGA + (size_t)u.aux * (SLOT / 2);
        Pre q; q.g0 = *(const u32x4*)(G + o); q.g1 = *(const u32x4*)(G + o + 128);
        if (u.aux) { q.t0 = *(const u32x4*)(M + o); q.t1 = *(const u32x4*)(M + o + 128); } else { q.t0 = (u32x4){0u, 0u, 0u, 0u}; q.t1 = q.t0; }
        return q; }
    __device__ __forceinline__ void apply(const Unit& u, int r, int j, const Col&, const Pre& q, f32x4 a0, f32x4 a1, f32x4 b0, f32x4 b1) const {
        const size_t o = ((size_t)u.pm * 256 + r) * 1024 + u.pn * 256 + j;
        f32x4 g0, g1, g2, g3, t0, t1, t2, t3; unpk8(q.g0, g0, g1); unpk8(q.g1, g2, g3); unpk8(q.t0, t0, t1); unpk8(q.t1, t2, t3);
        a0 = a0 * g0 + t0; a1 = a1 * g1 + t1; b0 = b0 * g2 + t2; b1 = b1 * g3 + t3;
        *(u32x4*)(M + o) = pk8(a0, a1); *(u32x4*)(M + o + 128) = pk8(b0, b1); } };
struct SchG3 { const bf16_t *A, *Bt; int G, c, K;
    __device__ __forceinline__ bool next(int i, Unit& u) const { const int L = i * G + c; if (L >= 512) return false; u.pm = L >> 2; u.pn = L & 3; return true; }
    __device__ __forceinline__ const bf16_t* arow(const Unit& u, int r) const { return A + (size_t)(u.pm * 256 + r) * 1024; }
    __device__ __forceinline__ const bf16_t* brow(const Unit& u, int n) const { return Bt + (size_t)(u.pn * 256 + n) * 1024; }
    __device__ __forceinline__ const char* abase(const Unit& u) const { return (const char*)(A + (size_t)u.pm * 256 * 1024); }
    __device__ __forceinline__ const char* bbase(const Unit& u) const { return (const char*)(Bt + (size_t)u.pn * 256 * 1024); }
    __device__ __forceinline__ unsigned aoff(const Unit&, int) const { return 0u; } };
struct EpiG3 { const float *X, *MOD; float* X1;
    struct Col { f32x4 c0, c1, c2, c3; }; struct Pre { f32x4 x0, x1, x2, x3; };
    __device__ __forceinline__ Col col(const Unit& u, int j) const { const float* gt = MOD + ((u.pm * 256) / SEQ) * 6144 + 2 * 1024 + u.pn * 256 + j; return Col{*(const f32x4*)gt, *(const f32x4*)(gt + 4), *(const f32x4*)(gt + 128), *(const f32x4*)(gt + 132)}; }
    __device__ __forceinline__ Pre load(const Unit& u, int r, int j) const { const float* xp = X + ((size_t)u.pm * 256 + r) * 1024 + u.pn * 256 + j; return Pre{*(const f32x4*)xp, *(const f32x4*)(xp + 4), *(const f32x4*)(xp + 128), *(const f32x4*)(xp + 132)}; }
    __device__ __forceinline__ void apply(const Unit& u, int r, int j, const Col& c, const Pre& q, f32x4 a0, f32x4 a1, f32x4 b0, f32x4 b1) const {
        float* op = X1 + ((size_t)u.pm * 256 + r) * 1024 + u.pn * 256 + j;
        *(f32x4*)op = q.x0 + c.c0 * a0; *(f32x4*)(op + 4) = q.x1 + c.c1 * a1; *(f32x4*)(op + 128) = q.x2 + c.c2 * b0; *(f32x4*)(op + 132) = q.x3 + c.c3 * b1; } };
struct MoeMeta { const int* m;
    __device__ __forceinline__ int cnt(int e) const { return __builtin_amdgcn_readfirstlane(m[e]); }
    __device__ __forceinline__ int tb(int e) const { return __builtin_amdgcn_readfirstlane(m[16 + e]); }
    __device__ __forceinline__ int ntiles() const { return __builtin_amdgcn_readfirstlane(m[32]); }
    __device__ __forceinline__ int find(int mt) const { int e = 0;
#pragma unroll
        for (int k = 1; k < 16; ++k) e += (__builtin_amdgcn_readfirstlane(m[16 + k]) <= mt) ? 1 : 0;
        return e; } };
__device__ __forceinline__ void moe_meta_build(const Params& p, int* meta) {
    if (threadIdx.x == 0) { const unsigned* cnt = (const unsigned*)(p.ws + OFF_CTL); int t = 0;
        for (int e = 0; e < 16; ++e) { const int c = (int)__hip_atomic_load(cnt + e, __ATOMIC_RELAXED, __HIP_MEMORY_SCOPE_AGENT); meta[e] = c; meta[16 + e] = t; t += (c + 255) >> 8; }
        meta[32] = t; }
    __syncthreads();
}
struct SchUp { const bf16_t *HM, *W; const int* LIST; MoeMeta mm; int G, c, K; const int* idx;
    __device__ __forceinline__ bool next(int i, Unit& u) const { const int L = i * G + c; if (L >= 4 * mm.ntiles()) return false; const int mt = L >> 2; u.pn = L & 3; u.aux = mm.find(mt); u.aux2 = (mt - mm.tb(u.aux)) * 256; u.pm = mt | (i << 16); return true; }
    __device__ __forceinline__ const char* abase(const Unit&) const { return (const char*)HM; }
    __device__ __forceinline__ const char* bbase(const Unit& u) const { return (const char*)(W + ((size_t)u.aux * 1024 + u.pn * 256) * 1024); }
    __device__ __forceinline__ unsigned aoff(const Unit& u, int r) const { return (unsigned)idx[(u.pm >> 16) * 256 + r] * 2048u; }
    __device__ __forceinline__ const bf16_t* arow(const Unit& u, int r) const { int pos = u.aux2 + r; const int c = mm.cnt(u.aux); pos = pos < c ? pos : c - 1; return HM + (size_t)LIST[u.aux * NT + pos] * 1024; }
    __device__ __forceinline__ const bf16_t* brow(const Unit& u, int n) const { return W + ((size_t)u.aux * 1024 + u.pn * 256 + n) * 1024; } };
struct EpiUp { bf16_t* ACT; const float* WL; MoeMeta mm;
    struct Col { }; struct Pre { float wt; };
    __device__ __forceinline__ Col col(const Unit&, int) const { return Col{}; }
    __device__ __forceinline__ Pre load(const Unit& u, int r, int) const { const int pos = u.aux2 + r; return Pre{pos < mm.cnt(u.aux) ? WL[u.aux * NT + pos] : 0.f}; }
    __device__ __forceinline__ void apply(const Unit& u, int r, int j, const Col&, const Pre& q, f32x4 g0, f32x4 g1, f32x4 u0, f32x4 u1) const {
        if (u.aux2 + r >= mm.cnt(u.aux)) return;
#pragma unroll
        for (int e = 0; e < 4; ++e) { g0[e] = silu(g0[e]) * u0[e] * q.wt; g1[e] = silu(g1[e]) * u1[e] * q.wt; }
        *(u32x4*)(ACT + ((size_t)(u.pm & 0xffff) * 256 + r) * 512 + u.pn * 128 + j) = pk8(g0, g1); } };
struct SchDn { const bf16_t *ACT, *W; MoeMeta mm; int G, c, K;
    __device__ __forceinline__ bool next(int i, Unit& u) const { const int L = i * G + c; if (L >= 4 * mm.ntiles()) return false; const int mt = L >> 2; u.pn = L & 3; u.aux = mm.find(mt); u.aux2 = (mt - mm.tb(u.aux)) * 256; u.pm = mt; return true; }
    __device__ __forceinline__ const bf16_t* arow(const Unit& u, int r) const { return ACT + ((size_t)u.pm * 256 + r) * 512; }
    __device__ __forceinline__ const bf16_t* brow(const Unit& u, int n) const { return W + ((size_t)u.aux * 1024 + u.pn * 256 + n) * 512; }
    __device__ __forceinline__ const char* abase(const Unit& u) const { return (const char*)(ACT + (size_t)u.pm * 256 * 512); }
    __device__ __forceinline__ const char* bbase(const Unit& u) const { return (const char*)(W + ((size_t)u.aux * 1024 + u.pn * 256) * 512); }
    __device__ __forceinline__ unsigned aoff(const Unit&, int) const { return 0u; } };
struct EpiDn { bf16_t* Y; MoeMeta mm;
    struct Col { }; struct Pre { };
    __device__ __forceinline__ Col col(const Unit&, int) const { return Col{}; }
    __device__ __forceinline__ Pre load(const Unit&, int, int) const { return Pre{}; }
    __device__ __forceinline__ void apply(const Unit& u, int r, int j, const Col&, const Pre&, f32x4 a0, f32x4 a1, f32x4 b0, f32x4 b1) const {
        if (u.aux2 + r >= mm.cnt(u.aux)) return;
        bf16_t* o = Y + ((size_t)u.pm * 256 + r) * 1024 + u.pn * 256 + j; *(u32x4*)o = pk8(a0, a1); *(u32x4*)(o + 128) = pk8(b0, b1); } };

__device__ __forceinline__ void aprep_item(const Params& p, int g, unsigned char* lds) {
    const int tid = threadIdx.x, lane = tid & 63, wave = tid >> 6;
    const bf16_t* Z = (const bf16_t*)(p.ws + OFF_SLOT + 1 * SLOT);
    bf16_t* AA = (bf16_t*)(p.ws + OFF_SLOT + 0 * SLOT) + (size_t)g * 64 * 1024;
    const unsigned* zt = (const unsigned*)lds;
    { const u32x4* src = (const u32x4*)(Z + (size_t)g * 64 * 1024); u32x4* d = (u32x4*)lds;
        u32x4 tmp[16];
#pragma unroll
        for (int i = 0; i < 16; ++i) tmp[i] = src[tid + i * NTHR];
#pragma unroll
        for (int i = 0; i < 16; ++i) d[tid + i * NTHR] = tmp[i]; }
    __syncthreads();
    {
        f32x2 w[31];
        const float* cw = p.in[I_CONVW] + 2 * tid;
#pragma unroll
        for (int k = 0; k < 31; ++k) w[k] = *(const f32x2*)(cw + k * 1024);
        const f32x2 cb = *(const f32x2*)(p.in[I_CONVB] + 2 * tid);
#pragma unroll 1
        for (int tb = 0; tb < 4; ++tb) {
            f32x2 cz[16];
#pragma unroll
            for (int o = 0; o < 16; ++o) cz[o] = cb;
#pragma unroll
            for (int r0 = 0; r0 < 48; r0 += 8) {
                unsigned vv[8];
#pragma unroll
                for (int rr = 0; rr < 8; ++rr) if (r0 + rr < 46) { const int row = 16 * tb - 15 + r0 + rr; const bool ok = (unsigned)row < 64u; const unsigned t = zt[(ok ? row : 0) * 512 + tid]; vv[rr] = ok ? t : 0u; }
#pragma unroll
                for (int rr = 0; rr < 8; ++rr) { const int r = r0 + rr;
                    if (r < 46) { const f32x2 x = (f32x2){bflo(vv[rr]), bfhi(vv[rr])};
#pragma unroll
                        for (int o = 0; o < 16; ++o) { const int k = r - o; if (k >= 0 && k < 31) cz[o] += w[k] * x; } } }
            }
#pragma unroll
            for (int o = 0; o < 16; ++o) *(unsigned*)(AA + (size_t)(16 * tb + o) * 1024 + 2 * tid) = pk2(cz[o].x, cz[o].y);
        }
    }
    asm volatile("s_waitcnt vmcnt(0)" ::: "memory");
    __syncthreads();
    u32x4 ra[8], rb[8];
#pragma unroll
    for (int rr = 0; rr < 8; ++rr) { const bf16_t* rp = AA + (size_t)(wave * 8 + rr) * 1024 + lane * 8; ra[rr] = *(const u32x4*)rp; rb[rr] = *(const u32x4*)(rp + 512); }
    f32x4 lg0[2], lg1[2], lb0[2], lb1[2];
#pragma unroll
    for (int hh = 0; hh < 2; ++hh) { const int c0 = hh * 512 + lane * 8;
        lg0[hh] = *(const f32x4*)(p.in[I_LNG] + c0); lg1[hh] = *(const f32x4*)(p.in[I_LNG] + c0 + 4); lb0[hh] = *(const f32x4*)(p.in[I_LNB] + c0); lb1[hh] = *(const f32x4*)(p.in[I_LNB] + c0 + 4); }
#pragma unroll
    for (int rr = 0; rr < 8; ++rr) {
        const int row = wave * 8 + rr;
        f32x4 x0, x1, x2, x3; unpk8(ra[rr], x0, x1); unpk8(rb[rr], x2, x3);
        const f32x4 sv = (x0 + x1) + (x2 + x3);
        const float mean = wave_sum((sv[0] + sv[1]) + (sv[2] + sv[3])) * (1.0f / 1024.0f);
        x0 -= mean; x1 -= mean; x2 -= mean; x3 -= mean;
        const f32x4 qv = (x0 * x0 + x1 * x1) + (x2 * x2 + x3 * x3);
        const float rstd = rsqrtf(wave_sum((qv[0] + qv[1]) + (qv[2] + qv[3])) * (1.0f / 1024.0f) + 1e-6f);
        x0 = x0 * rstd * lg0[0] + lb0[0]; x1 = x1 * rstd * lg1[0] + lb1[0]; x2 = x2 * rstd * lg0[1] + lb0[1]; x3 = x3 * rstd * lg1[1] + lb1[1];
#pragma unroll
        for (int e = 0; e < 4; ++e) { x0[e] = silu(x0[e]); x1[e] = silu(x1[e]); x2[e] = silu(x2[e]); x3[e] = silu(x3[e]); }
        bf16_t* o = AA + (size_t)row * 1024 + lane * 8;
        *(u32x4*)o = pk8(x0, x1); *(u32x4*)(o + 512) = pk8(x2, x3);
    }
    __syncthreads();
}

constexpr int XC_STRIDE = 272;
constexpr int YB_STRIDE = 132;
constexpr int B_XC_OFF = 0, B_HIN_OFF = 256 * XC_STRIDE  , B_Y_OFF = B_HIN_OFF + 4096  , B_Y_BYTES = 64 * YB_STRIDE * 4  ;
constexpr size_t OFF_TOT256 = OFF_TOT + 9 * MiB;

__device__ __forceinline__ void lru_coef(float lr, float li, float nsp, float xcv, float& a, float& b) {
    const float la = nsp * sigm(lr);
    a = __expf(la);
    const float am1 = la > -0.25f ? la * (1.0f + la * (0.5f + la * (0.16666667f + la * (0.041666668f + la * 0.008333334f)))) : a - 1.0f;
    b = __builtin_amdgcn_sqrtf(-am1 * (a + 1.0f)) * (sigm(li) * xcv);
}

template <bool FINAL, int DIR>
__device__ __forceinline__ void lru_dir(const unsigned char* xcs, const bf16x8 (&fbr)[4], const bf16x8 (&fbi)[4], float br, float bi, float nsp, int fr, int q, int chl,
                                        float hin_v, f32x4 (&hout)[4], float& totA, float& totB) {
    f32x4 ar[4], ai[4];
#pragma unroll
    for (int m = 0; m < 4; ++m) { ar[m] = (f32x4){0.f, 0.f, 0.f, 0.f}; ai[m] = (f32x4){0.f, 0.f, 0.f, 0.f}; }
#pragma unroll
    for (int kk = 0; kk < 4; ++kk) {
#pragma unroll
        for (int m = 0; m < 4; ++m) { const bf16x8 fa = *(const bf16x8*)(xcs + (16 * m + fr) * XC_STRIDE + (32 * kk + 8 * q) * 2);
            ar[m] = __builtin_amdgcn_mfma_f32_16x16x32_bf16(fa, fbr[kk], ar[m], 0, 0, 0);
            ai[m] = __builtin_amdgcn_mfma_f32_16x16x32_bf16(fa, fbi[kk], ai[m], 0, 0, 0); }
    }
#pragma unroll
    for (int m = 0; m < 4; ++m)
#pragma unroll
        for (int i = 0; i < 4; ++i) {
            const float xcv = bf2f(*(const bf16_t*)(xcs + (16 * m + 4 * q + i) * XC_STRIDE + chl * 2));
            float a, b; lru_coef(ar[m][i] + br, ai[m][i] + bi, nsp, xcv, a, b); ar[m][i] = a; ai[m][i] = b;
        }
    float At[4], Bt[4], Ae[4], Be[4];
#pragma unroll
    for (int m = 0; m < 4; ++m) {
        float A = 1.f, B = 0.f;
#pragma unroll
        for (int ii = 0; ii < 4; ++ii) { const int i = DIR ? 3 - ii : ii; B = ar[m][i] * B + ai[m][i]; A = ar[m][i] * A; }
        if (DIR == 0) {
            float tA = __shfl_up(A, 16), tB = __shfl_up(B, 16); if (q >= 1) { B = A * tB + B; A = A * tA; }
            tA = __shfl_up(A, 32); tB = __shfl_up(B, 32); if (q >= 2) { B = A * tB + B; A = A * tA; }
            Ae[m] = __shfl_up(A, 16); Be[m] = __shfl_up(B, 16); if (q == 0) { Ae[m] = 1.f; Be[m] = 0.f; }
            At[m] = __shfl(A, 48 + fr); Bt[m] = __shfl(B, 48 + fr);
        } else {
            float tA = __shfl_down(A, 16), tB = __shfl_down(B, 16); if (q <= 2) { B = A * tB + B; A = A * tA; }
            tA = __shfl_down(A, 32); tB = __shfl_down(B, 32); if (q <= 1) { B = A * tB + B; A = A * tA; }
            Ae[m] = __shfl_down(A, 16); Be[m] = __shfl_down(B, 16); if (q == 3) { Ae[m] = 1.f; Be[m] = 0.f; }
            At[m] = __shfl(A, fr); Bt[m] = __shfl(B, fr);
        }
    }
    if (!FINAL) {
        float A = 1.f, B = 0.f;
#pragma unroll
        for (int mm = 0; mm < 4; ++mm) { const int m = DIR ? 3 - mm : mm; B = At[m] * B + Bt[m]; A = At[m] * A; }
        totA = A; totB = B;
    } else {
        float hh = hin_v;
#pragma unroll
        for (int mm = 0; mm < 4; ++mm) { const int m = DIR ? 3 - mm : mm;
            float hs = Ae[m] * hh + Be[m];
#pragma unroll
            for (int ii = 0; ii < 4; ++ii) { const int i = DIR ? 3 - ii : ii; hs = ar[m][i] * hs + ai[m][i]; hout[m][i] = hs; }
            hh = At[m] * hh + Bt[m];
        }
    }
}

template <bool FINAL>
__device__ __forceinline__ void b_phase(const Params& p, int bid, int nb, unsigned char* lds) {
    const int tid = threadIdx.x, lane = tid & 63, wave = tid >> 6, fr = lane & 15, q = lane >> 4;
    f32x2* TOT = (f32x2*)(p.ws + OFF_TOT);
    f32x2* TOT256 = (f32x2*)(p.ws + OFF_TOT256);
    const bf16_t* WG = (const bf16_t*)(p.ws + OFF_WG);
    float* hin = (float*)(lds + B_HIN_OFF);
    const int chl = 16 * wave + fr;
    const int nitems = FINAL ? 1024 : 1024 + 32;
    int hprev = -1;
    bf16x8 fb[4][4];
    float* cst = (float*)(lds + B_Y_OFF + 2 * B_Y_BYTES);
    for (int it = bid; it < nitems; it += nb) {
        const bool isctx = it >= 1024;
        const int b = isctx ? (it - 1024) >> 3 : it >> 8, c256 = isctx ? -1 : (it >> 3) & 31, h = it & 7;
        const int seqlen = isctx ? CTXL : SEQ, sbase = isctx ? 0 : c256 * 256;
        const bf16_t* src = isctx ? (const bf16_t*)(p.ws + OFF_XRC) + (size_t)b * CTXL * 1024 : (const bf16_t*)(p.ws + OFF_SLOT + 3 * SLOT) + (size_t)b * SEQ * 1024;
        const int kc0 = isctx ? 0 : 4 + c256 * 4, k256 = isctx ? 0 : 1 + c256;
        const int ch = h * 128 + chl;
        if (h != hprev) {
            hprev = h;
#pragma unroll
            for (int ty = 0; ty < 4; ++ty)
#pragma unroll
                for (int kk = 0; kk < 4; ++kk) fb[ty][kk] = *(const bf16x8*)(WG + (size_t)(h * 512 + wave * 64 + ty * 16 + fr) * 128 + 32 * kk + 8 * q);
            if (q == 0) { cst[0 * 128 + chl] = p.in[I_BRF][ch]; cst[1 * 128 + chl] = p.in[I_BIF][ch]; cst[2 * 128 + chl] = -8.0f * log1pf(__expf(-p.in[I_LAMF][ch]));
                          cst[3 * 128 + chl] = p.in[I_BRB][ch]; cst[4 * 128 + chl] = p.in[I_BIB][ch]; cst[5 * 128 + chl] = -8.0f * log1pf(__expf(-p.in[I_LAMB][ch])); }
            wave_lds_sync();
        }
        float runAf = 1.f, runBf = 0.f, runAb = 1.f, runBb = 0.f;
        {
            const int cgp = tid & 15, c0 = h * 128 + 8 * cgp;
            float wk[4][8], bs[8];
            { const f32x4* bp = (const f32x4*)(p.in[I_LCB] + c0); const f32x4 t0_ = bp[0], t1_ = bp[1];
                bs[0] = t0_[0]; bs[1] = t0_[1]; bs[2] = t0_[2]; bs[3] = t0_[3]; bs[4] = t1_[0]; bs[5] = t1_[1]; bs[6] = t1_[2]; bs[7] = t1_[3];
#pragma unroll
                for (int k = 0; k < 4; ++k) { const f32x4* wp = (const f32x4*)(p.in[I_LCW] + k * 1024 + c0); const f32x4 w0 = wp[0], w1 = wp[1];
                    wk[k][0] = w0[0]; wk[k][1] = w0[1]; wk[k][2] = w0[2]; wk[k][3] = w0[3]; wk[k][4] = w1[0]; wk[k][5] = w1[1]; wk[k][6] = w1[2]; wk[k][7] = w1[3]; } }
#pragma unroll 1
            for (int ps = 0; ps < 2; ++ps) {
                const int tq = ps * 128 + (tid >> 4) * 4;
                float xc[4][8];
#pragma unroll
                for (int r = 0; r < 4; ++r)
#pragma unroll
                    for (int e = 0; e < 8; ++e) xc[r][e] = bs[e];
#pragma unroll
                for (int rr = 0; rr < 7; ++rr) {
                    const int row = sbase + tq + rr - 2;
                    u32x4 a = (u32x4){0u, 0u, 0u, 0u};
                    if (row >= 0 && row < seqlen) a = *(const u32x4*)(src + (size_t)row * 1024 + c0);
                    const float x[8] = {bflo(a.x), bfhi(a.x), bflo(a.y), bfhi(a.y), bflo(a.z), bfhi(a.z), bflo(a.w), bfhi(a.w)};
#pragma unroll
                    for (int r = 0; r < 4; ++r) { const int k = rr - r;
                        if (k >= 0 && k < 4) {
#pragma unroll
                            for (int e = 0; e < 8; ++e) xc[r][e] += wk[k][e] * x[e]; } }
                }
#pragma unroll
                for (int r = 0; r < 4; ++r) {
                    u32x4 o0; o0.x = pk2(xc[r][0], xc[r][1]); o0.y = pk2(xc[r][2], xc[r][3]); o0.z = pk2(xc[r][4], xc[r][5]); o0.w = pk2(xc[r][6], xc[r][7]);
                    *(u32x4*)(lds + B_XC_OFF + (tq + r) * XC_STRIDE + cgp * 16) = o0;
                }
            }
        }
        f32x2 ct[33], cs[4];
        const int cdir = (tid >> 7) & 1, ccl = tid & 127;
        if (FINAL && tid < 256) {
            const f32x2* T2 = TOT256 + ((size_t)b * 33 * 2 + cdir) * 1024 + h * 128 + ccl;
            const f32x2* T = TOT + ((size_t)b * NCH64 * 2 + cdir) * 1024 + h * 128 + ccl;
#pragma unroll
            for (int k = 0; k < 33; ++k) { const bool use = cdir == 0 ? (k < k256) : (k == 0 || k > k256); ct[k] = use ? T2[(size_t)k * 2048] : (f32x2){1.f, 0.f}; }
#pragma unroll
            for (int s_ = 0; s_ < 4; ++s_) cs[s_] = T[(size_t)(kc0 + s_) * 2048];
        }
        if (FINAL && tid < 256) {
            float hc = 0.f;
            if (cdir == 0) {
#pragma unroll
                for (int k = 0; k < 33; ++k) hc = ct[k].x * hc + ct[k].y;
#pragma unroll
                for (int s_ = 0; s_ < 4; ++s_) { hin[(s_ * 2 + 0) * 128 + ccl] = hc; hc = cs[s_].x * hc + cs[s_].y; }
            } else {
                hc = ct[0].y;
#pragma unroll
                for (int k = 32; k >= 1; --k) hc = ct[k].x * hc + ct[k].y;
#pragma unroll
                for (int s_ = 3; s_ >= 0; --s_) { hin[(s_ * 2 + 1) * 128 + ccl] = hc; hc = cs[s_].x * hc + cs[s_].y; }
            }
        }
        __syncthreads();
        for (int sub = 0; sub < 4; ++sub) {
            const int t0 = sbase + 64 * sub;
            const unsigned char* xcs = lds + B_XC_OFF + 64 * sub * XC_STRIDE;
            float* ybuf = (float*)(lds + B_Y_OFF + (sub & 1) * B_Y_BYTES);
            const int ot = tid >> 3, oc = (tid & 7) * 16;
            f32x4 hf[4], hb[4]; float tA, tB;
            lru_dir<FINAL, 0>(xcs, fb[0], fb[1], cst[0 * 128 + chl], cst[1 * 128 + chl], cst[2 * 128 + chl], fr, q, chl, FINAL ? hin[(sub * 2 + 0) * 128 + chl] : 0.f, hf, tA, tB);
            if (!FINAL) { if (q == 0) TOT[((size_t)(b * NCH64 + kc0 + sub) * 2 + 0) * 1024 + ch] = (f32x2){tA, tB};
                runBf = tA * runBf + tB; runAf = tA * runAf; }
            u32x4 gy0, gy1;
            if (FINAL) { const bf16_t* GYG = (const bf16_t*)(p.ws + OFF_SLOT + 2 * SLOT) + ((size_t)b * SEQ + t0 + ot) * 1024 + h * 128 + oc;
                gy0 = *(const u32x4*)GYG; gy1 = *(const u32x4*)(GYG + 8); }
            lru_dir<FINAL, 1>(xcs, fb[2], fb[3], cst[3 * 128 + chl], cst[4 * 128 + chl], cst[5 * 128 + chl], fr, q, chl, FINAL ? hin[(sub * 2 + 1) * 128 + chl] : 0.f, hb, tA, tB);
            if (!FINAL) { if (q == 0) TOT[((size_t)(b * NCH64 + kc0 + sub) * 2 + 1) * 1024 + ch] = (f32x2){tA, tB};
                runBb = runAb * tB + runBb; runAb = runAb * tA; }
            if (FINAL) {
#pragma unroll
                for (int m = 0; m < 4; ++m)
#pragma unroll
                    for (int i = 0; i < 4; ++i) ybuf[(16 * m + 4 * q + i) * YB_STRIDE + chl] = hf[m][i] + hb[m][i];
                __syncthreads();
                const f32x4* yp = (const f32x4*)(ybuf + ot * YB_STRIDE + oc);
                const f32x4 y0 = yp[0], y1 = yp[1], y2 = yp[2], y3 = yp[3];
                u32x4 o0, o1;
                o0.x = pk2(bflo(gy0.x) * y0[0], bfhi(gy0.x) * y0[1]); o0.y = pk2(bflo(gy0.y) * y0[2], bfhi(gy0.y) * y0[3]);
                o0.z = pk2(bflo(gy0.z) * y1[0], bfhi(gy0.z) * y1[1]); o0.w = pk2(bflo(gy0.w) * y1[2], bfhi(gy0.w) * y1[3]);
                o1.x = pk2(bflo(gy1.x) * y2[0], bfhi(gy1.x) * y2[1]); o1.y = pk2(bflo(gy1.y) * y2[2], bfhi(gy1.y) * y2[3]);
                o1.z = pk2(bflo(gy1.z) * y3[0], bfhi(gy1.z) * y3[1]); o1.w = pk2(bflo(gy1.w) * y3[2], bfhi(gy1.w) * y3[3]);
                bf16_t* AB = (bf16_t*)(p.ws + OFF_SLOT + 1 * SLOT) + ((size_t)b * SEQ + t0 + ot) * 1024 + h * 128 + oc;
                *(u32x4*)AB = o0; *(u32x4*)(AB + 8) = o1;
            }
        }
        __syncthreads();
        if (!FINAL && q == 0) {
            TOT256[((size_t)(b * 33 + k256) * 2 + 0) * 1024 + ch] = (f32x2){runAf, runBf};
            TOT256[((size_t)(b * 33 + k256) * 2 + 1) * 1024 + ch] = (f32x2){runAb, runBb};
        }
    }
}

template <int CTRL, int RMASK> __device__ __forceinline__ float dpp_add(float v) { return v + __int_as_float(__builtin_amdgcn_update_dpp(0, __float_as_int(v), CTRL, RMASK, 0xF, false)); }
__device__ __forceinline__ float wave_sum_dpp(float v) {
    v = dpp_add<0xB1, 0xF>(v); v = dpp_add<0x4E, 0xF>(v); v = dpp_add<0x141, 0xF>(v); v = dpp_add<0x140, 0xF>(v); v = dpp_add<0x142, 0xA>(v); v = dpp_add<0x143, 0xC>(v);
    return __int_as_float(__builtin_amdgcn_readlane(__float_as_int(v), 63));
}
__device__ __forceinline__ void ph8_route(const Params& p, int bid, int nb, unsigned char* lds) {
    constexpr int NU = 1;
    const int tid = threadIdx.x, lane = tid & 63, wave = tid >> 6;
    float* Wl = (float*)lds;
    int* lcnt = (int*)(lds + 81920);
    int* lbase = lcnt + 16;
    int* tinfo = lcnt + 32;
    float* twt = (float*)(tinfo + 512);
#pragma unroll 1
    for (int kk = 0; kk < 2; ++kk) { const int k = tid + kk * NTHR;
        const f32x4 wg = *(const f32x4*)(p.in[I_WGRP] + k * 4);
        Wl[0 * 1024 + k] = wg[0]; Wl[1 * 1024 + k] = wg[1]; Wl[2 * 1024 + k] = wg[2]; Wl[3 * 1024 + k] = wg[3];
#pragma unroll
        for (int o4 = 0; o4 < 4; ++o4) { const f32x4 we = *(const f32x4*)(p.in[I_WER] + k * 16 + o4 * 4);
            Wl[(4 + o4 * 4 + 0) * 1024 + k] = we[0]; Wl[(4 + o4 * 4 + 1) * 1024 + k] = we[1]; Wl[(4 + o4 * 4 + 2) * 1024 + k] = we[2]; Wl[(4 + o4 * 4 + 3) * 1024 + k] = we[3]; } }
    __syncthreads();
    const float* MOD = (const float*)(p.ws + OFF_MOD);
    const float* X1 = p.out;
    bf16_t* HM = (bf16_t*)(p.ws + OFF_SLOT + 2 * SLOT);
    unsigned* gcnt = (unsigned*)(p.ws + OFF_CTL);
    int* LIST = (int*)(p.ws + OFF_LIST); float* WLs = (float*)(p.ws + OFF_WL); int* ROUTE = (int*)(p.ws + OFF_ROUTE);
    float* bl = (float*)(lds + 81920 + 8192);
    if (tid < 20) bl[tid] = tid < 4 ? p.in[I_BGRP][tid] : p.in[I_BER][tid - 4];
    __syncthreads();
    for (int tile = bid; tile < NT / 128; tile += nb) {
        if (tid < 16) lcnt[tid] = 0;
        __syncthreads();
        const float* mrow = MOD + ((tile * 128) / SEQ) * 6144;
        f32x4 gq[4], shq[4], scq[4];
#pragma unroll
        for (int j = 0; j < 4; ++j) { const int c = lane * 4 + 256 * j; gq[j] = *(const f32x4*)(p.in[I_GFFN] + c); shq[j] = *(const f32x4*)(mrow + 3 * 1024 + c); scq[j] = *(const f32x4*)(mrow + 4 * 1024 + c); gq[j] = gq[j] * (1.0f + scq[j]); }
#pragma unroll 1
        for (int tt = 0; tt < 16; tt += NU) {
            const int tl = wave * 16 + tt, tok = tile * 128 + tl;
            f32x4 v[NU][4]; float ss[NU];
#pragma unroll
            for (int u = 0; u < NU; ++u) ss[u] = 0.f;
#pragma unroll
            for (int u = 0; u < NU; ++u)
#pragma unroll
                for (int j = 0; j < 4; ++j) { v[u][j] = *(const f32x4*)(X1 + (size_t)(tok + u) * DM + lane * 4 + 256 * j); const f32x4 sq = v[u][j] * v[u][j]; ss[u] += (sq[0] + sq[1]) + (sq[2] + sq[3]); }
            float lg[NU][20];
#pragma unroll
            for (int u = 0; u < NU; ++u) { const float rinv = rsqrtf(wave_sum_dpp(ss[u]) * (1.0f / DM) + 1e-6f);
#pragma unroll
                for (int j = 0; j < 4; ++j) { v[u][j] = v[u][j] * rinv * gq[j] + shq[j]; *(u32x2*)(HM + (size_t)(tok + u) * DM + lane * 4 + 256 * j) = pk4(v[u][j]); }
}
#pragma unroll
            for (int o = 0; o < 20; ++o)
            { f32x4 wv[4];
#pragma unroll
                for (int j = 0; j < 4; ++j) wv[j] = *(const f32x4*)(Wl + o * 1024 + lane * 4 + 256 * j);
#pragma unroll
                for (int u = 0; u < NU; ++u) { f32x4 pr = v[u][0] * wv[0]; pr += v[u][1] * wv[1]; pr += v[u][2] * wv[2]; pr += v[u][3] * wv[3]; lg[u][o] = (pr[0] + pr[1]) + (pr[2] + pr[3]); }
                if ((o & 3) == 3) asm volatile("" ::: "memory"); }
#pragma unroll
            for (int u = 0; u < NU; ++u) {
#pragma unroll
                for (int o = 0; o < 20; ++o) lg[u][o] = wave_sum_dpp(lg[u][o]) + bl[o];
                int gs = 0; float gm = lg[u][0];
#pragma unroll
                for (int o = 1; o < 4; ++o) if (lg[u][o] > gm) { gm = lg[u][o]; gs = o; }
                float den = 0.f;
#pragma unroll
                for (int o = 0; o < 4; ++o) den += __expf(lg[u][o] - gm);
                const float pg = 1.0f / den;
                float el[4];
#pragma unroll
                for (int o = 0; o < 4; ++o) el[o] = gs == 0 ? lg[u][4 + o] : gs == 1 ? lg[u][8 + o] : gs == 2 ? lg[u][12 + o] : lg[u][16 + o];
                int i1 = 0; float v1 = el[0];
#pragma unroll
                for (int o = 1; o < 4; ++o) if (el[o] > v1) { v1 = el[o]; i1 = o; }
                int i2 = -1; float v2 = -3.0e38f;
#pragma unroll
                for (int o = 0; o < 4; ++o) if (o != i1 && el[o] > v2) { v2 = el[o]; i2 = o; }
                const float w1 = 1.0f / (1.0f + __expf(v2 - v1)), w2 = 1.0f - w1;
                if (lane == 0) { const int e1 = gs * 4 + i1, e2 = gs * 4 + i2;
                    const int r1 = atomicAdd(&lcnt[e1], 1), r2 = atomicAdd(&lcnt[e2], 1);
                    tinfo[(tl + u) * 4 + 0] = e1; tinfo[(tl + u) * 4 + 1] = r1; tinfo[(tl + u) * 4 + 2] = e2; tinfo[(tl + u) * 4 + 3] = r2; twt[(tl + u) * 2] = pg * w1; twt[(tl + u) * 2 + 1] = pg * w2; }
            }
        }
        __syncthreads();
        if (tid < 16) lbase[tid] = (int)__hip_atomic_fetch_add(gcnt + tid, (unsigned)lcnt[tid], __ATOMIC_RELAXED, __HIP_MEMORY_SCOPE_AGENT);
        __syncthreads();
        if (tid < 128) { const int tok = tile * 128 + tid;
            const int e1 = tinfo[tid * 4], e2 = tinfo[tid * 4 + 2], p1 = lbase[e1] + tinfo[tid * 4 + 1], p2 = lbase[e2] + tinfo[tid * 4 + 3];
            LIST[e1 * NT + p1] = tok; LIST[e2 * NT + p2] = tok; WLs[e1 * NT + p1] = twt[tid * 2]; WLs[e2 * NT + p2] = twt[tid * 2 + 1];
            ROUTE[tok * 4 + 0] = e1; ROUTE[tok * 4 + 1] = p1; ROUTE[tok * 4 + 2] = e2; ROUTE[tok * 4 + 3] = p2; }
        __syncthreads();
    }
}

__device__ __forceinline__ void ph10_final(const Params& p, int bid, int nb, const int* meta) {
    const int lane = threadIdx.x & 63, wave = threadIdx.x >> 6;
    const float* MOD = (const float*)(p.ws + OFF_MOD);
    const bf16_t* Y = (const bf16_t*)(p.ws + OFF_SLOT);
    const int* ROUTE = (const int*)(p.ws + OFF_ROUTE);
    float* X1 = p.out;
    for (int r = bid * 8 + wave; r < NT; r += nb * 8) {
        const int e1 = ROUTE[r * 4], p1 = ROUTE[r * 4 + 1], e2 = ROUTE[r * 4 + 2], p2 = ROUTE[r * 4 + 3];
        const bf16_t* y1 = Y + ((size_t)meta[16 + e1] * 256 + p1) * 1024; const bf16_t* y2 = Y + ((size_t)meta[16 + e2] * 256 + p2) * 1024;
        const float* gt = MOD + (r / SEQ) * 6144 + 5 * 1024;
        f32x4 v[4]; float ss = 0.f;
#pragma unroll
        for (int j = 0; j < 4; ++j) { const int c = lane * 4 + 256 * j;
            v[j] = *(const f32x4*)(X1 + (size_t)r * DM + c);
            const u32x2 a = *(const u32x2*)(y1 + c), bq = *(const u32x2*)(y2 + c); const f32x4 g = *(const f32x4*)(gt + c);
            v[j][0] += g[0] * (bflo(a.x) + bflo(bq.x)); v[j][1] += g[1] * (bfhi(a.x) + bfhi(bq.x)); v[j][2] += g[2] * (bflo(a.y) + bflo(bq.y)); v[j][3] += g[3] * (bfhi(a.y) + bfhi(bq.y));
            ss += v[j][0] * v[j][0] + v[j][1] * v[j][1] + v[j][2] * v[j][2] + v[j][3] * v[j][3]; }
        const float rinv = rsqrtf(wave_sum(ss) * (1.0f / DM) + 1e-6f);
#pragma unroll
        for (int j = 0; j < 4; ++j) { const int c = lane * 4 + 256 * j; const f32x4 g = *(const f32x4*)(p.in[I_GFINAL] + c);
            *(f32x4*)(X1 + (size_t)r * DM + c) = v[j] * rinv * g; }
    }
}


#define XB_TMO      128
#define XB_XCNT(j)  (256  + 64 * (j))
#define XB_XSUB(j)  (1280 + 64 * (j))
#define XB_XGEN(j)  (2304 + 64 * (j))
#define XB_TOP      3328
#define XB_TOPGEN   3392
#define XCD_BAR_WORDS 3456
#define XB_SPIN_CAP (1u << 18)
__device__ __forceinline__ unsigned xb_ld(unsigned* p)              { return __hip_atomic_load(p, __ATOMIC_RELAXED, __HIP_MEMORY_SCOPE_AGENT); }
__device__ __forceinline__ unsigned xb_add(unsigned* p, unsigned v) { return __hip_atomic_fetch_add(p, v, __ATOMIC_RELAXED, __HIP_MEMORY_SCOPE_AGENT); }
__device__ __forceinline__ unsigned xb_xcc_id() { return (unsigned)__builtin_amdgcn_s_getreg((3 << 11) | 20) & 0xFu; }
#define XB_SPIN(cond, bar) do { unsigned _sp = 0; while (cond) { __builtin_amdgcn_s_sleep(1); \
    if ((++_sp & 255u) == 0u) { if (xb_ld(&(bar)[XB_TMO])) break; if (_sp > XB_SPIN_CAP) { atomicAdd(&(bar)[XB_TMO], 1u); break; } } } } while (0)
struct XcdBarrier { unsigned* bar; unsigned x; volatile unsigned* st; };
__device__ __forceinline__ XcdBarrier xcd_barrier_post(unsigned* bar, volatile unsigned* st) {
    XcdBarrier b; b.bar = bar; b.x = xb_xcc_id(); b.st = st;
    if (threadIdx.x == 0) (void)xb_add(&bar[XB_XCNT(b.x)], 1u);
    return b;
}
__device__ __forceinline__ void xcd_barrier_complete(unsigned* bar, unsigned x, unsigned& nloc, unsigned& nx) {
    const unsigned G = gridDim.x * gridDim.y * gridDim.z;
    unsigned sum, cnt, mine, sp = 0u;
    for (;;) {
        sum = 0u; cnt = 0u; mine = 0u;
#pragma unroll
        for (unsigned j = 0; j < 16; ++j) { const unsigned c = xb_ld(&bar[XB_XCNT(j)]); sum += c; cnt += (c > 0u) ? 1u : 0u; mine = (j == x) ? c : mine; }
        if (sum == G) break;
        __builtin_amdgcn_s_sleep(1);
        if ((++sp & 255u) == 0u) { if (xb_ld(&bar[XB_TMO])) break; if (sp > XB_SPIN_CAP) { atomicAdd(&bar[XB_TMO], 1u); break; } }
    }
    nloc = mine > 0u ? mine : 1u; nx = cnt > 0u ? cnt : 1u;
}
__device__ __forceinline__ void xcd_barrier(const XcdBarrier& b) {
    asm volatile("s_waitcnt vmcnt(0)" ::: "memory");
    __syncthreads();
    if (threadIdx.x == 0) {
        unsigned* bar = b.bar;
        __builtin_amdgcn_s_waitcnt(0);
        unsigned nloc = b.st[0], nx = b.st[1];
        if (nloc == 0u) { xcd_barrier_complete(bar, b.x, nloc, nx); b.st[0] = nloc; b.st[1] = nx; }
        const unsigned old = xb_add(&bar[XB_XSUB(b.x)], 1u);
        const unsigned gen = old / nloc;
        if (old + 1u == (gen + 1u) * nloc) {
            __builtin_amdgcn_fence(__ATOMIC_RELEASE, "agent");
            asm volatile("s_waitcnt vmcnt(0)" ::: "memory");
            const unsigned og = xb_add(&bar[XB_TOP], 1u);
            const unsigned tg = og / nx;
            if (og + 1u == (tg + 1u) * nx) xb_add(&bar[XB_TOPGEN], 1u);
            else XB_SPIN(xb_ld(&bar[XB_TOPGEN]) == tg, bar);
            __builtin_amdgcn_fence(__ATOMIC_ACQUIRE, "agent");
            xb_add(&bar[XB_XGEN(b.x)], 1u);
            asm volatile("s_waitcnt vmcnt(0)" ::: "memory");
        } else {
            XB_SPIN(xb_ld(&bar[XB_XGEN(b.x)]) == gen, bar);
            __builtin_amdgcn_fence(__ATOMIC_ACQUIRE, "agent");
            asm volatile("s_waitcnt vmcnt(0)" ::: "memory");
        }
    }
    __syncthreads();
}
constexpr size_t OFF_BAR = OFF_CTL + 4096;

__global__ void __launch_bounds__(NTHR) mega(Params p, int lo, int hi) {
    extern __shared__ __attribute__((aligned(16))) unsigned char lds[];
    cg::grid_group grid = cg::this_grid();
    const int bid = blockIdx.x, nb = gridDim.x;
    unsigned char* ws = p.ws;
    bf16_t* S0 = (bf16_t*)(ws + OFF_SLOT), *S1 = (bf16_t*)(ws + OFF_SLOT + SLOT), *S2 = (bf16_t*)(ws + OFF_SLOT + 2 * SLOT), *S3 = (bf16_t*)(ws + OFF_SLOT + 3 * SLOT),
           *S4 = (bf16_t*)(ws + OFF_SLOT + 4 * SLOT), *S5 = (bf16_t*)(ws + OFF_SLOT + 5 * SLOT);
    const float* MOD = (const float*)(ws + OFF_MOD); const float* BINP = (const float*)(ws + OFF_BINP);
    int* meta = (int*)(lds + LDS_BYTES - 256);
#ifndef PHMASK
#define PHMASK 0x7ff
#endif
#define IN(k) (((PHMASK >> (k)) & 1) && lo <= (k) && (k) < hi)
#ifndef PIPE_MASK
#define PIPE_MASK 0x364
#endif
#define GEMM_RUN(k, gather, s, e) gemm_phase_pipe<gather>(lds, s, e)
    volatile unsigned* xst = (volatile unsigned*)(lds + LDS_BYTES - 16);
    if (threadIdx.x < 2) xst[threadIdx.x] = 0u;
    __syncthreads();
    XcdBarrier xbar; xbar.bar = (unsigned*)(ws + OFF_BAR); xbar.x = 0; xbar.st = xst;
    if (hi - lo > 1) xbar = xcd_barrier_post((unsigned*)(ws + OFF_BAR), xst);
    if (p.pv == 0x7eadbeef) grid.sync();
#define SEAM(k) do { if (IN(k) && IN((k) + 1)) xcd_barrier(xbar); } while (0)
    if (IN(0)) { ph0_prep(p, bid, nb, lds); } SEAM(0);
    if (IN(1)) { ph1_norm(p, bid, nb); } SEAM(1);
    if (IN(2)) {
        { SchCtx s{(const bf16_t*)(ws + OFF_HC), (const bf16_t*)(ws + OFF_WIN), nb, bid, 1024}; EpiCtx e{(bf16_t*)(ws + OFF_XRC), BINP}; GEMM_RUN(2, false, s, e); }
        { SchG1 s{S0, (const bf16_t*)(ws + OFF_WIN), nb, bid, 1024}; EpiG1 e{S1, S2, S3, S4, S5, BINP}; GEMM_RUN(2, false, s, e); }
    } SEAM(2);
    if (IN(3)) {
#ifndef NO_APREP
        for (int g = bid; g < 512; g += nb) aprep_item(p, g, lds);
#endif
#ifndef NO_BLOCAL
        b_phase<false>(p, bid, nb, lds);
#endif
    } SEAM(3);
    if (IN(4)) {
        b_phase<true>(p, bid, nb, lds);
    } SEAM(4);
    if (IN(5)) { SchG2 s{S0, S1, (const bf16_t*)(ws + OFF_WPA), (const bf16_t*)(ws + OFF_WPB), nb, bid, 1024}; EpiG2 e{S4, S5, S3}; GEMM_RUN(5, false, s, e); } SEAM(5);
    if (IN(6)) { SchG3 s{S3, (const bf16_t*)(ws + OFF_WO), nb, bid, 1024}; EpiG3 e{p.in[I_X], MOD, p.out}; GEMM_RUN(6, false, s, e); } SEAM(6);
    if (IN(7)) { ph8_route(p, bid, nb, lds); } SEAM(7);
    if (IN(8)) { __syncthreads(); moe_meta_build(p, meta); MoeMeta mm{meta};
        int* idx = (int*)(lds + STAGE_BYTES);
        SchUp s{S2, (const bf16_t*)(ws + OFF_WGU), (const int*)(ws + OFF_LIST), mm, nb, bid, 1024, idx}; EpiUp e{S4, (const float*)(ws + OFF_WL), mm};
        { Unit u; for (int i = 0; i < 8 && s.next(i, u); ++i) { if (threadIdx.x < 256) { int pos = u.aux2 + (int)threadIdx.x; const int c = mm.cnt(u.aux); pos = pos < c ? pos : c - 1; idx[i * 256 + threadIdx.x] = s.LIST[u.aux * NT + pos]; } } }
        __syncthreads();
        GEMM_RUN(8, true, s, e); } SEAM(8);
    if (IN(9)) { __syncthreads(); moe_meta_build(p, meta); MoeMeta mm{meta};
        SchDn s{S4, (const bf16_t*)(ws + OFF_WDN), mm, nb, bid, 512}; EpiDn e{S0, mm}; GEMM_RUN(9, false, s, e); } SEAM(9);
    if (IN(10)) { __syncthreads(); moe_meta_build(p, meta); ph10_final(p, bid, nb, meta); }
#undef IN
#undef SEAM
}

extern "C" void kernel_launch(void* const* d_in, const int* in_sizes, int n_in, void* d_out, int out_size, void* d_ws, size_t ws_size, hipStream_t stream) {
    static int grid = 0;
    if (grid == 0) {
        if (n_in != 37 || out_size != NT * DM || ws_size < WS_END) { fprintf(stderr, "kernel_launch: unexpected shapes: n_in %d out %d ws %zu (need %zu)\n", n_in, out_size, ws_size, (size_t)WS_END); grid = -1; return; }
        int dev = 0, cus = 0, per_cu = 0;
        (void)hipGetDevice(&dev); (void)hipDeviceGetAttribute(&cus, hipDeviceAttributeMultiprocessorCount, dev);
        if (hipFuncSetAttribute((const void*)mega, hipFuncAttributeMaxDynamicSharedMemorySize, LDS_BYTES) != hipSuccess) { fprintf(stderr, "kernel_launch: hipFuncSetAttribute failed\n"); grid = -1; return; }
        if (hipOccupancyMaxActiveBlocksPerMultiprocessor(&per_cu, (const void*)mega, NTHR, LDS_BYTES) != hipSuccess || per_cu < 1) { fprintf(stderr, "kernel_launch: occupancy query says %d\n", per_cu); per_cu = 1; }
        (void)hipGetLastError();
        grid = cus * 1;
        fprintf(stderr, "kernel_launch: grid %d (cus %d, per_cu %d)\n", grid, cus, per_cu);
    }
    if (grid < 0) return;
    Params p{};
    for (int i = 0; i < 37; ++i) p.in[i] = (const float*)d_in[i];
    p.out = (float*)d_out; p.ws = (unsigned char*)d_ws;
#if ONE_LAUNCH
    (void)hipMemsetAsync((unsigned char*)d_ws + OFF_BAR, 0, XCD_BAR_WORDS * 4, stream);
    int lo = 0, hi = NPHASE; void* args[] = {&p, &lo, &hi};
    hipError_t e = hipLaunchCooperativeKernel((const void*)mega, dim3(grid), dim3(NTHR), args, LDS_BYTES, stream);
    if (e != hipSuccess) fprintf(stderr, "cooperative launch failed: %s (grid %d)\n", hipGetErrorString(e), grid);
#ifdef PROBE_PHASE
    hipLaunchKernelGGL(mega, dim3(grid), dim3(NTHR), LDS_BYTES, stream, p, PROBE_PHASE, PROBE_PHASE + 1);
#endif
#else
    for (int k = 0; k < NPHASE; ++k) hipLaunchKernelGGL(mega, dim3(grid), dim3(NTHR), LDS_BYTES, stream, p, k, k + 1);
#endif
}
```

```cpp
#include <hip/hip_runtime.h>
#include <hip/hip_cooperative_groups.h>
#include <cstdio>
#include <cstdint>
namespace cg = cooperative_groups;

#ifndef ONE_LAUNCH
#define ONE_LAUNCH 1
#endif

typedef unsigned short bf16_t;
typedef short bf16x8 __attribute__((ext_vector_type(8)));
typedef float f32x4 __attribute__((ext_vector_type(4)));
typedef float f32x2 __attribute__((ext_vector_type(2)));
typedef unsigned u32x4 __attribute__((ext_vector_type(4)));
typedef unsigned u32x2 __attribute__((ext_vector_type(2)));

constexpr int NT = 32768, NCX = 1024, DM = 1024, SEQ = 8192, CTXL = 256;
constexpr int NTHR = 512;
constexpr int NCH64 = 132;
constexpr size_t MiB = (size_t)1 << 20;
constexpr size_t OFF_CTL = 0, OFF_MOD = 1 * MiB, OFF_BINP = OFF_MOD + 128 * 1024, OFF_WIN = 2 * MiB, OFF_WPA = 14 * MiB, OFF_WPB = 16 * MiB,
                 OFF_WO = 18 * MiB, OFF_WG = 20 * MiB, OFF_WGU = 22 * MiB, OFF_WDN = 54 * MiB, OFF_HC = 70 * MiB, OFF_XRC = 72 * MiB,
                 OFF_TOT = 74 * MiB, OFF_ROUTE = 84 * MiB, OFF_LIST = 85 * MiB, OFF_WL = 87 * MiB, OFF_SLOT = 90 * MiB, SLOT = 64 * MiB,
                 WS_END = OFF_SLOT + 6 * SLOT;
constexpr int LDS_BYTES = 144 * 1024;
constexpr int NPHASE = 11;

struct Params { const float* in[37]; float* out; unsigned char* ws; int pv; int pad; };

enum { I_X = 0, I_C, I_CTX, I_CCTX, I_WADA, I_BADA, I_GMIX, I_WIN, I_BIN, I_CONVW, I_CONVB, I_LNG, I_LNB, I_WPA, I_LCW, I_LCB,
       I_WRF, I_BRF, I_WIF, I_BIF, I_LAMF, I_WRB, I_BRB, I_WIB, I_BIB, I_LAMB, I_WPB, I_WO, I_GFFN, I_WGRP, I_BGRP, I_WER, I_BER,
       I_WGATE, I_WUP, I_WDOWN, I_GFINAL };

__device__ __forceinline__ float bflo(unsigned w) { return __uint_as_float(w << 16); }
__device__ __forceinline__ float bfhi(unsigned w) { return __uint_as_float(w & 0xffff0000u); }
__device__ __forceinline__ float bf2f(bf16_t h) { return __uint_as_float(((unsigned)h) << 16); }
__device__ __forceinline__ unsigned pk2(float lo, float hi) { unsigned r; asm("v_cvt_pk_bf16_f32 %0, %1, %2" : "=v"(r) : "v"(lo), "v"(hi)); return r; }
__device__ __forceinline__ bf16_t f2bf(float f) { return (bf16_t)(pk2(f, 0.f) & 0xffffu); }
__device__ __forceinline__ float sigm(float x) { return __builtin_amdgcn_rcpf(1.0f + __expf(-x)); }
__device__ __forceinline__ float silu(float x) { return x * sigm(x); }
__device__ __forceinline__ float gelu_tanh(float x) { return x * sigm(1.5957691216057308f * (x + 0.044715f * x * x * x)); }
__device__ __forceinline__ float wave_sum(float v) {
#pragma unroll
    for (int o = 1; o < 64; o <<= 1) v += __shfl_xor(v, o);
    return v;
}
__device__ __forceinline__ void wave_lds_sync() { asm volatile("s_waitcnt lgkmcnt(0)" ::: "memory"); __builtin_amdgcn_wave_barrier(); }
__device__ __forceinline__ u32x2 pk4(f32x4 v) { u32x2 r; r.x = pk2(v[0], v[1]); r.y = pk2(v[2], v[3]); return r; }

__device__ __forceinline__ u32x4 pk8(f32x4 a, f32x4 b) { u32x4 r; r.x = pk2(a[0], a[1]); r.y = pk2(a[2], a[3]); r.z = pk2(b[0], b[1]); r.w = pk2(b[2], b[3]); return r; }
__device__ __forceinline__ void unpk8(u32x4 w, f32x4& a, f32x4& b) { a[0] = bflo(w.x); a[1] = bfhi(w.x); a[2] = bflo(w.y); a[3] = bfhi(w.y); b[0] = bflo(w.z); b[1] = bfhi(w.z); b[2] = bflo(w.w); b[3] = bfhi(w.w); }

template <class DRow>
__device__ __forceinline__ void tr_item(const float* __restrict__ src, int ldsrc, int k0, int n0, bf16_t* dst, int ldd, DRow drow, float* scr, int lane, float scale = 1.0f) {
    const float* sp = src + (size_t)k0 * ldsrc + n0 + lane;
#pragma unroll 16
    for (int kk = 0; kk < 64; ++kk) scr[kk * 65 + lane] = sp[(size_t)kk * ldsrc] * scale;
    wave_lds_sync();
    const int c = lane & 7;
#pragma unroll
    for (int j = 0; j < 8; ++j) {
        const int n = (lane >> 3) + 8 * j; const float* s = scr + (8 * c) * 65 + n;
        u32x4 o; o.x = pk2(s[0], s[65]); o.y = pk2(s[130], s[195]); o.z = pk2(s[260], s[325]); o.w = pk2(s[390], s[455]);
        *(u32x4*)(dst + (size_t)drow(n0 + n) * ldd + k0 + 8 * c) = o;
    }
    wave_lds_sync();
}

__device__ __forceinline__ int win_srccol(int np) { const int p = np >> 8, r = np & 255; return p < 8 ? (r >> 7) * 1024 + 128 * p + (r & 127) : np; }

__device__ __forceinline__ void ph0_prep(const Params& p, int bid, int nb, unsigned char* lds) {
    const int tid = threadIdx.x, lane = tid & 63, wave = tid >> 6;
    unsigned char* ws = p.ws;
    float* scr = (float*)lds + wave * (64 * 65);
    const int gw = bid * 8 + wave, NGW = nb * 8;
    constexpr int N_WIN = 16 * 96, N_SQ = 16 * 16, N_G = 128, N_GU = 2048, N_DN = 2048;
    constexpr int NITEMS = N_WIN + 3 * N_SQ + N_G + 2 * N_GU + N_DN;
    for (int it = gw; it < NITEMS; it += NGW) {
        int r = it;
        if (r < N_WIN) { const int kb = r / 96, nbk = r % 96, d0 = 64 * nbk, sc0 = win_srccol(d0);
            tr_item(p.in[I_WIN], 6144, 64 * kb, sc0, (bf16_t*)(ws + OFF_WIN), 1024, [=](int n) { return n - sc0 + d0; }, scr, lane); continue; }
        r -= N_WIN;
        if (r < 3 * N_SQ) { const int which = r / N_SQ, q = r % N_SQ, kb = q / 16, nbk = q % 16;
            const float* src = which == 0 ? p.in[I_WPA] : which == 1 ? p.in[I_WPB] : p.in[I_WO];
            bf16_t* dst = (bf16_t*)(ws + (which == 0 ? OFF_WPA : which == 1 ? OFF_WPB : OFF_WO));
            tr_item(src, 1024, 64 * kb, 64 * nbk, dst, 1024, [=](int n) { return n; }, scr, lane); continue; }
        r -= 3 * N_SQ;
        if (r < N_G) { const int ty = r / 32, q = r % 32, h = q / 4, kb = (q % 4) / 2, nbk = q % 2;
            const float* src = (ty == 0 ? p.in[I_WRF] : ty == 1 ? p.in[I_WIF] : ty == 2 ? p.in[I_WRB] : p.in[I_WIB]) + (size_t)h * 128 * 128;
            tr_item(src, 128, 64 * kb, 64 * nbk, (bf16_t*)(ws + OFF_WG), 128, [=](int n) { return h * 512 + (n >> 4) * 64 + ty * 16 + (n & 15); }, scr, lane, -1.4426950408889634f); continue; }
        r -= N_G;
        if (r < 2 * N_GU) { const int bj = r / N_GU, q = r % N_GU, e = q / 128, kb = (q % 128) / 8, nbk = q % 8;
            const float* src = (bj == 0 ? p.in[I_WGATE] : p.in[I_WUP]) + (size_t)e * 1024 * 512;
            tr_item(src, 512, 64 * kb, 64 * nbk, (bf16_t*)(ws + OFF_WGU) + (size_t)e * 1024 * 1024, 1024, [=](int n) { return 256 * (n >> 7) + 128 * bj + (n & 127); }, scr, lane); continue; }
        r -= 2 * N_GU;
        { const int e = r / 128, kb = (r % 128) / 16, nbk = r % 16;
            tr_item(p.in[I_WDOWN] + (size_t)e * 512 * 1024, 1024, 64 * kb, 64 * nbk, (bf16_t*)(ws + OFF_WDN) + (size_t)e * 1024 * 512, 512, [=](int n) { return n; }, scr, lane); }
    }
    __syncthreads();
    float* red = (float*)lds;
    float* MOD = (float*)(ws + OFF_MOD);
    for (int it = bid; it < 96; it += nb) {
        const int col = it * 64 + lane;
        float a[5] = {0.f, 0.f, 0.f, 0.f, 0.f};
        const float* W = p.in[I_WADA];
#pragma unroll 1
        for (int k0 = wave * 128; k0 < wave * 128 + 128; k0 += 16) {
            float wv[16];
#pragma unroll
            for (int kk = 0; kk < 16; ++kk) wv[kk] = W[(size_t)(k0 + kk) * 6144 + col];
#pragma unroll
            for (int kk = 0; kk < 16; ++kk)
#pragma unroll
                for (int r = 0; r < 5; ++r) { const float cv = r < 4 ? p.in[I_C][r * 1024 + k0 + kk] : p.in[I_CCTX][k0 + kk]; a[r] += silu(cv) * wv[kk]; }
        }
#pragma unroll
        for (int r = 0; r < 5; ++r) red[(wave * 5 + r) * 64 + lane] = a[r];
        __syncthreads();
        if (tid < 320) { const int r = tid / 64, l = tid % 64; float s = 0.f;
#pragma unroll
            for (int w = 0; w < 8; ++w) s += red[(w * 5 + r) * 64 + l];
            MOD[r * 6144 + it * 64 + l] = s + p.in[I_BADA][it * 64 + l]; }
        __syncthreads();
    }
    float* BINP = (float*)(ws + OFF_BINP);
    for (int i = bid * NTHR + tid; i < 6144; i += nb * NTHR) BINP[i] = p.in[I_BIN][win_srccol(i)];
    if (bid == 0 && tid < 64) ((unsigned*)(ws + OFF_CTL))[tid] = 0u;
}

__device__ __forceinline__ void ph1_norm(const Params& p, int bid, int nb) {
    const int lane = threadIdx.x & 63, wave = threadIdx.x >> 6;
    const float* MOD = (const float*)(p.ws + OFF_MOD);
    for (int r = bid * 8 + wave; r < NT + NCX; r += nb * 8) {
        const bool lat = r < NT;
        const float* src = lat ? p.in[I_X] + (size_t)r * DM : p.in[I_CTX] + (size_t)(r - NT) * DM;
        bf16_t* dst = lat ? (bf16_t*)(p.ws + OFF_SLOT) + (size_t)r * DM : (bf16_t*)(p.ws + OFF_HC) + (size_t)(r - NT) * DM;
        const float* mrow = MOD + (lat ? r / SEQ : 4) * 6144;
        f32x4 v[4]; float ss = 0.f;
#pragma unroll
        for (int j = 0; j < 4; ++j) { v[j] = *(const f32x4*)(src + lane * 4 + 256 * j); ss += v[j][0] * v[j][0] + v[j][1] * v[j][1] + v[j][2] * v[j][2] + v[j][3] * v[j][3]; }
        const float rinv = rsqrtf(wave_sum(ss) * (1.0f / DM) + 1e-6f);
#pragma unroll
        for (int j = 0; j < 4; ++j) { const int c = lane * 4 + 256 * j;
            const f32x4 g = *(const f32x4*)(p.in[I_GMIX] + c), sh = *(const f32x4*)(mrow + c), sc = *(const f32x4*)(mrow + 1024 + c);
            f32x4 o;
#pragma unroll
            for (int e = 0; e < 4; ++e) o[e] = v[j][e] * rinv * g[e] * (1.0f + sc[e]) + sh[e];
            *(u32x2*)(dst + c) = pk4(o); }
    }
}

struct Unit { int pm, pn, aux, aux2; };

#define LAS __attribute__((address_space(3)))
constexpr int BK = 64, HTB = 128 * BK * 2, STAGE_BYTES = 8 * HTB;
__device__ __forceinline__ int lds_byte(int r, int c) { const int st = (r >> 4) * 2 + (c >> 5), rr = r & 15, cc = c & 31, ob = rr * 64 + cc * 2; return st * 1024 + (ob ^ (((ob >> 9) & 1) << 5)); }
__device__ __forceinline__ void stage_rc(int b, int& R, int& C) { const int st = b / 1024, sb = b % 1024, swz = sb ^ (((sb >> 9) & 1) << 5); R = (st >> 1) * 16 + swz / 64; C = (st & 1) * 32 + (swz % 64) / 2; }

template <bool GATHER, class S, class E>
__device__ __forceinline__ void gemm_phase_pipe(unsigned char* ldsg, const S& sch, const E& epi) {
    LAS unsigned char* lds = (LAS unsigned char*)ldsg;
    const int tid = threadIdx.x, wid = __builtin_amdgcn_readfirstlane(tid >> 6), lane = tid & 63, wr = wid >> 2, wc = wid & 3, fr = lane & 15, fq = lane >> 4;
    const int K = sch.K, nt = K / BK;
    int Rr[2], Cc[2]; unsigned voffA[2], voffB[2];
#pragma unroll
    for (int i = 0; i < 2; ++i) { stage_rc(tid * 16 + i * 8192, Rr[i], Cc[i]); voffA[i] = (unsigned)(Rr[i] * K + Cc[i]) * 2u;
        const int rho = Rr[i] & 31, Rb = (Rr[i] & ~31) + 8 * ((rho & 15) >> 2) + 4 * (rho >> 4) + (rho & 3);
        voffB[i] = (unsigned)(Rb * K + Cc[i]) * 2u; }
    const size_t kstep = (size_t)(BK * 2);
    const size_t hstep = (size_t)128 * K * 2;
    const unsigned ldsw = (unsigned)wid * 1024u;
    const int aoff = lds_byte(wr * 64 + fr, fq * 8), boff = lds_byte(wc * 32 + fr, fq * 8);
#define PG8_SA(b, h) (((b) * 2 + (h)) * HTB)
#define PG8_SB(b, h) ((4 + (b) * 2 + (h)) * HTB)
#define PG8_STAGE_B(bufoff, gbase) do { _Pragma("unroll") for (int _i = 0; _i < 2; ++_i) \
        __builtin_amdgcn_global_load_lds((const unsigned*)((const char*)(gbase) + voffB[_i]), (LAS unsigned*)(lds + (bufoff) + ldsw + _i * 8192), 16, 0, 0); } while (0)
#define PG8_STAGE_A(bufoff, gbase, h, vo) do { _Pragma("unroll") for (int _i = 0; _i < 2; ++_i) \
        __builtin_amdgcn_global_load_lds((const unsigned*)((const char*)(gbase) + (GATHER ? (size_t)(vo)[h][_i] : (size_t)(h) * hstep + voffA[_i])), (LAS unsigned*)(lds + (bufoff) + ldsw + _i * 8192), 16, 0, 0); } while (0)
#define PG8_LDA(dst, b, h) do { _Pragma("unroll") for (int m = 0; m < 4; ++m) _Pragma("unroll") for (int k = 0; k < 2; ++k) dst[m][k] = *(const LAS bf16x8*)(lds + PG8_SA(b, h) + aoff + m * 2048 + k * 1024); } while (0)
#define PG8_LDB(dst, b, h) do { _Pragma("unroll") for (int n = 0; n < 2; ++n) _Pragma("unroll") for (int k = 0; k < 2; ++k) dst[n][k] = *(const LAS bf16x8*)(lds + PG8_SB(b, h) + boff + n * 2048 + k * 1024); } while (0)
#define PG8_MMA(ai, bj, At, Bt) do { __builtin_amdgcn_s_setprio(1); _Pragma("unroll") for (int m = 0; m < 4; ++m) _Pragma("unroll") for (int n = 0; n < 2; ++n) _Pragma("unroll") for (int k = 0; k < 2; ++k) \
        acc[ai][bj][m][n] = __builtin_amdgcn_mfma_f32_16x16x32_bf16(Bt[n][k], At[m][k], acc[ai][bj][m][n], 0, 0, 0); __builtin_amdgcn_s_setprio(0); } while (0)
#define PG8_WAIT_V(n) asm volatile("s_waitcnt vmcnt(" #n ")" ::: "memory")
#define PG8_WAIT_L(n) asm volatile("s_waitcnt lgkmcnt(" #n ")" ::: "memory")
#define PG8_BAR __builtin_amdgcn_s_barrier()
#define PG8_SCHED __builtin_amdgcn_sched_barrier(0)
    Unit cur, nxt; int ui = 0;
    if (!sch.next(0, cur)) return;
    f32x4 acc[2][2][4][2];
#pragma unroll
    for (int a = 0; a < 2; ++a)
#pragma unroll
        for (int b = 0; b < 2; ++b)
#pragma unroll
            for (int m = 0; m < 4; ++m)
#pragma unroll
                for (int n = 0; n < 2; ++n) acc[a][b][m][n] = (f32x4){0.f, 0.f, 0.f, 0.f};
    bf16x8 At[4][2], B0[2][2], B1[2][2];
    unsigned voAc[2][2], voAn[2][2];
#pragma unroll
    for (int h = 0; h < 2; ++h)
#pragma unroll
        for (int i = 0; i < 2; ++i) { voAc[h][i] = GATHER ? sch.aoff(cur, 128 * h + Rr[i]) + (unsigned)Cc[i] * 2u : 0u; voAn[h][i] = voAc[h][i]; }
    const char* cA = sch.abase(cur); const char* cB = sch.bbase(cur);
    PG8_STAGE_B(PG8_SB(0, 0), cB); PG8_STAGE_A(PG8_SA(0, 0), cA, 0, voAc); PG8_STAGE_B(PG8_SB(0, 1), cB + hstep); PG8_STAGE_A(PG8_SA(0, 1), cA, 1, voAc);
    if (wr == 1) PG8_BAR;
    PG8_WAIT_V(4); PG8_BAR;
    PG8_STAGE_B(PG8_SB(1, 0), cB + kstep); PG8_STAGE_A(PG8_SA(1, 0), cA + kstep, 0, voAc); PG8_STAGE_B(PG8_SB(1, 1), cB + hstep + kstep);
    PG8_WAIT_V(6); PG8_BAR;
    for (;;) {
        const bool has_next = sch.next(ui + 1, nxt);
        const char* nA = has_next ? sch.abase(nxt) : cA; const char* nB = has_next ? sch.bbase(nxt) : cB;
        if (GATHER) {
#pragma unroll
            for (int h = 0; h < 2; ++h)
#pragma unroll
                for (int i = 0; i < 2; ++i) voAn[h][i] = has_next ? sch.aoff(nxt, 128 * h + Rr[i]) + (unsigned)Cc[i] * 2u : voAc[h][i];
        }
#pragma unroll 1
        for (int t = 0; t < nt; t += 2) {
            const bool last = (t == nt - 2);
            const char* a1 = cA + (size_t)(t + 1) * kstep;
            const char* a2 = last ? nA : cA + (size_t)(t + 2) * kstep; const char* b2 = last ? nB : cB + (size_t)(t + 2) * kstep;
            const char* a3 = a2 + kstep; const char* b3 = b2 + kstep;
            unsigned vo2[2][2];
#pragma unroll
            for (int h = 0; h < 2; ++h)
#pragma unroll
                for (int i = 0; i < 2; ++i) vo2[h][i] = last ? voAn[h][i] : voAc[h][i];
            PG8_LDB(B0, 0, 0); PG8_SCHED; PG8_LDA(At, 0, 0); PG8_STAGE_A(PG8_SA(1, 1), a1, 1, voAc);
            PG8_WAIT_L(8); PG8_BAR; PG8_WAIT_L(0); PG8_MMA(0, 0, At, B0); PG8_BAR; PG8_SCHED;
            PG8_LDB(B1, 0, 1); PG8_STAGE_B(PG8_SB(0, 0), b2);
            PG8_BAR; PG8_WAIT_L(0); PG8_MMA(0, 1, At, B1); PG8_BAR;
            PG8_LDA(At, 0, 1); PG8_STAGE_A(PG8_SA(0, 0), a2, 0, vo2);
            PG8_BAR; PG8_WAIT_L(0); PG8_MMA(1, 0, At, B0); PG8_BAR; PG8_SCHED;
            PG8_STAGE_B(PG8_SB(0, 1), b2 + hstep);
            PG8_WAIT_V(6); PG8_BAR; PG8_MMA(1, 1, At, B1); PG8_BAR;
            PG8_LDB(B0, 1, 0); PG8_SCHED; PG8_LDA(At, 1, 0); PG8_STAGE_A(PG8_SA(0, 1), a2, 1, vo2);
            PG8_WAIT_L(8); PG8_BAR; PG8_WAIT_L(0); PG8_MMA(0, 0, At, B0); PG8_BAR; PG8_SCHED;
            PG8_LDB(B1, 1, 1); PG8_STAGE_B(PG8_SB(1, 0), b3);
            PG8_BAR; PG8_WAIT_L(0); PG8_MMA(0, 1, At, B1); PG8_BAR;
            PG8_LDA(At, 1, 1); PG8_STAGE_A(PG8_SA(1, 0), a3, 0, vo2);
            PG8_BAR; PG8_WAIT_L(0); PG8_MMA(1, 0, At, B0); PG8_BAR; PG8_SCHED;
            PG8_STAGE_B(PG8_SB(1, 1), b3 + hstep);
            PG8_WAIT_V(6); PG8_BAR; PG8_MMA(1, 1, At, B1); PG8_BAR;
        }
        { int frx = fr, fqx = fq; asm volatile("" : "+v"(frx), "+v"(fqx));
            const int jx = wc * 32 + 8 * fqx, rx = wr * 64 + frx;
            const typename E::Col ecol = epi.col(cur, jx);
            typename E::Pre epre = epi.load(cur, rx, jx);
#pragma unroll
            for (int g = 0; g < 8; ++g) { const int ai = g >> 2, m = g & 3;
                typename E::Pre enx = epre; if (g < 7) enx = epi.load(cur, ((g + 1) >> 2) * 128 + ((g + 1) & 3) * 16 + rx, jx);
                epi.apply(cur, ai * 128 + m * 16 + rx, jx, ecol, epre, acc[ai][0][m][0], acc[ai][0][m][1], acc[ai][1][m][0], acc[ai][1][m][1]);
                epre = enx; } }
        if (!has_next) break;
#pragma unroll
        for (int a = 0; a < 2; ++a)
#pragma unroll
            for (int b = 0; b < 2; ++b)
#pragma unroll
                for (int m = 0; m < 4; ++m)
#pragma unroll
                    for (int n = 0; n < 2; ++n) acc[a][b][m][n] = (f32x4){0.f, 0.f, 0.f, 0.f};
        cur = nxt; cA = nA; cB = nB; ++ui;
#pragma unroll
        for (int h = 0; h < 2; ++h)
#pragma unroll
            for (int i = 0; i < 2; ++i) voAc[h][i] = voAn[h][i];
    }
    PG8_WAIT_V(0);
    if (wr == 0) PG8_BAR;
    PG8_BAR;
#undef PG8_SA
#undef PG8_SB
#undef PG8_STAGE_A
#undef PG8_STAGE_B
#undef PG8_LDA
#undef PG8_LDB
#undef PG8_MMA
#undef PG8_WAIT_V
#undef PG8_WAIT_L
#undef PG8_BAR
#undef PG8_SCHED
}

struct SchG1 { const bf16_t *A, *Bt; int G, c, K;
    __device__ __forceinline__ bool next(int i, Unit& u) const { const int L = i * G + c; if (L >= 128 * 24) return false; u.pm = L / 24; u.pn = L % 24; return true; }
    __device__ __forceinline__ const bf16_t* arow(const Unit& u, int r) const { return A + (size_t)(u.pm * 256 + r) * 1024; }
    __device__ __forceinline__ const bf16_t* brow(const Unit& u, int n) const { return Bt + (size_t)(u.pn * 256 + n) * 1024; }
    __device__ __forceinline__ const char* abase(const Unit& u) const { return (const char*)(A + (size_t)u.pm * 256 * 1024); }
    __device__ __forceinline__ const char* bbase(const Unit& u) const { return (const char*)(Bt + (size_t)u.pn * 256 * 1024); }
    __device__ __forceinline__ unsigned aoff(const Unit&, int) const { return 0u; } };
struct EpiG1 { bf16_t *Z, *GYG, *XR, *SGA, *SGB; const float* bias;
    struct Col { f32x4 c0, c1, c2, c3; }; struct Pre { };
    __device__ __forceinline__ Col col(const Unit& u, int j) const { const float* bp = bias + u.pn * 256 + j; return Col{*(const f32x4*)bp, *(const f32x4*)(bp + 4), *(const f32x4*)(bp + 128), *(const f32x4*)(bp + 132)}; }
    __device__ __forceinline__ Pre load(const Unit&, int, int) const { return Pre{}; }
    __device__ __forceinline__ void apply(const Unit& u, int r, int j, const Col& c, const Pre&, f32x4 a0, f32x4 a1, f32x4 b0, f32x4 b1) const {
        const size_t row = (size_t)u.pm * 256 + r;
        a0 += c.c0; a1 += c.c1; b0 += c.c2; b1 += c.c3;
        if (u.pn < 8) {
#pragma unroll
            for (int e = 0; e < 4; ++e) { a0[e] *= sigm(b0[e]); a1[e] *= sigm(b1[e]); }
            *(u32x4*)(Z + row * 1024 + u.pn * 128 + j) = pk8(a0, a1); }
        else { const int kind = u.pn >> 2;
            bf16_t* dst = GYG + (size_t)(kind - 2) * (SLOT / 2);
#pragma unroll
            for (int e = 0; e < 4; ++e) { if (kind == 2) { a0[e] = gelu_tanh(a0[e]); a1[e] = gelu_tanh(a1[e]); b0[e] = gelu_tanh(b0[e]); b1[e] = gelu_tanh(b1[e]); }
                else if (kind >= 4) { a0[e] = sigm(a0[e]); a1[e] = sigm(a1[e]); b0[e] = sigm(b0[e]); b1[e] = sigm(b1[e]); } }
            bf16_t* o = dst + row * 1024 + (u.pn & 3) * 256 + j;
            *(u32x4*)o = pk8(a0, a1); *(u32x4*)(o + 128) = pk8(b0, b1); }
    } };
struct SchCtx { const bf16_t *A, *Bt; int G, c, K;
    __device__ __forceinline__ bool next(int i, Unit& u) const { const int L = i * G + c; if (L >= 16) return false; u.pm = L / 4; u.pn = L % 4; return true; }
    __device__ __forceinline__ const bf16_t* arow(const Unit& u, int r) const { return A + (size_t)(u.pm * 256 + r) * 1024; }
    __device__ __forceinline__ const bf16_t* brow(const Unit& u, int n) const { return Bt + (size_t)((12 + u.pn) * 256 + n) * 1024; }
    __device__ __forceinline__ const char* abase(const Unit& u) const { return (const char*)(A + (size_t)u.pm * 256 * 1024); }
    __device__ __forceinline__ const char* bbase(const Unit& u) const { return (const char*)(Bt + (size_t)(12 + u.pn) * 256 * 1024); }
    __device__ __forceinline__ unsigned aoff(const Unit&, int) const { return 0u; } };
struct EpiCtx { bf16_t* XRC; const float* bias;
    struct Col { f32x4 c0, c1, c2, c3; }; struct Pre { };
    __device__ __forceinline__ Col col(const Unit& u, int j) const { const float* bp = bias + (12 + u.pn) * 256 + j; return Col{*(const f32x4*)bp, *(const f32x4*)(bp + 4), *(const f32x4*)(bp + 128), *(const f32x4*)(bp + 132)}; }
    __device__ __forceinline__ Pre load(const Unit&, int, int) const { return Pre{}; }
    __device__ __forceinline__ void apply(const Unit& u, int r, int j, const Col& c, const Pre&, f32x4 a0, f32x4 a1, f32x4 b0, f32x4 b1) const {
        const size_t row = (size_t)u.pm * 256 + r;
        a0 += c.c0; a1 += c.c1; b0 += c.c2; b1 += c.c3;
        bf16_t* o = XRC + row * 1024 + u.pn * 256 + j; *(u32x4*)o = pk8(a0, a1); *(u32x4*)(o + 128) = pk8(b0, b1); } };
struct SchG2 { const bf16_t *Aa, *Ab, *Wa, *Wb; int G, c, K;
    __device__ __forceinline__ bool next(int i, Unit& u) const { const int t = (i >> 1) * G + c; if (t >= 512) return false; u.pm = t >> 2; u.pn = t & 3; u.aux = i & 1; return true; }
    __device__ __forceinline__ const bf16_t* arow(const Unit& u, int r) const { return Aa + (size_t)u.aux * (SLOT / 2) + (size_t)(u.pm * 256 + r) * 1024; }
    __device__ __forceinline__ const bf16_t* brow(const Unit& u, int n) const { return Wa + (size_t)u.aux * (1024 * 1024) + (size_t)(u.pn * 256 + n) * 1024; }
    __device__ __forceinline__ const char* abase(const Unit& u) const { return (const char*)(Aa + (size_t)u.aux * (SLOT / 2) + (size_t)u.pm * 256 * 1024); }
    __device__ __forceinline__ const char* bbase(const Unit& u) const { return (const char*)(Wa + (size_t)u.aux * (1024 * 1024) + (size_t)u.pn * 256 * 1024); }
    __device__ __forceinline__ unsigned aoff(const Unit&, int) const { return 0u; } };
struct EpiG2 { const bf16_t *SGA, *SGB; bf16_t* M;
    struct Col { }; struct Pre { u32x4 g0, g1, t0, t1; };
    __device__ __forceinline__ Col col(const Unit&, int) const { return Col{}; }
    __device__ __forceinline__ Pre load(const Unit& u, int r, int j) const {
        const size_t o = ((size_t)u.pm * 256 + r) * 1024 + u.pn * 256 + j; const bf16_t* G = SGA + (size_t)u.aux * (SLOT / 2);
        Pre q; q.g0 = *(const u32x4*)(G + o); q.g1 = *(const u32x4*)(G + o + 128);
        if (u.aux) { q.t0 = *(const u32x4*)(M + o); q.t1 = *(const u32x4*)(M + o + 128); } else { q.t0 = (u32x4){0u, 0u, 0u, 0u}; q.t1 = q.t0; }
        return q; }
    __device__ __forceinline__ void apply(const Unit& u, int r, int j, const Col&, const Pre& q, f32x4 a0, f32x4 a1, f32x4 b0, f32x4 b1) const {
        const size_t o = ((size_t)u.pm * 256 + r) * 1024 + u.pn * 256 + j;
        f32x4 g0, g1, g2, g3, t0, t1, t2, t3; unpk8(q.g0, g0, g1); unpk8(q.g1, g2, g3); unpk8(q.t0, t0, t1); unpk8(q.t1, t2, t3);
        a0 = a0 * g0 + t0; a1 = a1 * g1 + t1; b0 = b0 * g2 + t2; b1 = b1 * g3 + t3;
        *(u32x4*)(M + o) = pk8(a0, a1); *(u32x4*)(M + o + 128) = pk8(b0, b1); } };
struct SchG3 { const bf16_t *A, *Bt; int G, c, K;
    __device__ __forceinline__ bool next(int i, Unit& u) const { const int L = i * G + c; if (L >= 512) return false; u.pm = L >> 2; u.pn = L & 3; return true; }
    __device__ __forceinline__ const bf16_t* arow(const Unit& u, int r) const { return A + (size_t)(u.pm * 256 + r) * 1024; }
    __device__ __forceinline__ const bf16_t* brow(const Unit& u, int n) const { return Bt + (size_t)(u.pn * 256 + n) * 1024; }
    __device__ __forceinline__ const char* abase(const Unit& u) const { return (const char*)(A + (size_t)u.pm * 256 * 1024); }
    __device__ __forceinline__ const char* bbase(const Unit& u) const { return (const char*)(Bt + (size_t)u.pn * 256 * 1024); }
    __device__ __forceinline__ unsigned aoff(const Unit&, int) const { return 0u; } };
struct EpiG3 { const float *X, *MOD; float* X1;
    struct Col { f32x4 c0, c1, c2, c3; }; struct Pre { f32x4 x0, x1, x2, x3; };
    __device__ __forceinline__ Col col(const Unit& u, int j) const { const float* gt = MOD + ((u.pm * 256) / SEQ) * 6144 + 2 * 1024 + u.pn * 256 + j; return Col{*(const f32x4*)gt, *(const f32x4*)(gt + 4), *(const f32x4*)(gt + 128), *(const f32x4*)(gt + 132)}; }
    __device__ __forceinline__ Pre load(const Unit& u, int r, int j) const { const float* xp = X + ((size_t)u.pm * 256 + r) * 1024 + u.pn * 256 + j; return Pre{*(const f32x4*)xp, *(const f32x4*)(xp + 4), *(const f32x4*)(xp + 128), *(const f32x4*)(xp + 132)}; }
    __device__ __forceinline__ void apply(const Unit& u, int r, int j, const Col& c, const Pre& q, f32x4 a0, f32x4 a1, f32x4 b0, f32x4 b1) const {
        float* op = X1 + ((size_t)u.pm * 256 + r) * 1024 + u.pn * 256 + j;
        *(f32x4*)op = q.x0 + c.c0 * a0; *(f32x4*)(op + 4) = q.x1 + c.c1 * a1; *(f32x4*)(op + 128) = q.x2 + c.c2 * b0; *(f32x4*)(op + 132) = q.x3 + c.c3 * b1; } };
struct MoeMeta { const int* m;
    __device__ __forceinline__ int cnt(int e) const { return __builtin_amdgcn_readfirstlane(m[e]); }
    __device__ __forceinline__ int tb(int e) const { return __builtin_amdgcn_readfirstlane(m[16 + e]); }
    __device__ __forceinline__ int ntiles() const { return __builtin_amdgcn_readfirstlane(m[32]); }
    __device__ __forceinline__ int find(int mt) const { int e = 0;
#pragma unroll
        for (int k = 1; k < 16; ++k) e += (__builtin_amdgcn_readfirstlane(m[16 + k]) <= mt) ? 1 : 0;
        return e; } };
__device__ __forceinline__ void moe_meta_build(const Params& p, int* meta) {
    if (threadIdx.x == 0) { const unsigned* cnt = (const unsigned*)(p.ws + OFF_CTL); int t = 0;
        for (int e = 0; e < 16; ++e) { const int c = (int)__hip_atomic_load(cnt + e, __ATOMIC_RELAXED, __HIP_MEMORY_SCOPE_AGENT); meta[e] = c; meta[16 + e] = t; t += (c + 255) >> 8; }
        meta[32] = t; }
    __syncthreads();
}
struct SchUp { const bf16_t *HM, *W; const int* LIST; MoeMeta mm; int G, c, K; const int* idx;
    __device__ __forceinline__ bool next(int i, Unit& u) const { const int L = i * G + c; if (L >= 4 * mm.ntiles()) return false; const int mt = L >> 2; u.pn = L & 3; u.aux = mm.find(mt); u.aux2 = (mt - mm.tb(u.aux)) * 256; u.pm = mt | (i << 16); return true; }
    __device__ __forceinline__ const char* abase(const Unit&) const { return (const char*)HM; }
    __device__ __forceinline__ const char* bbase(const Unit& u) const { return (const char*)(W + ((size_t)u.aux * 1024 + u.pn * 256) * 1024); }
    __device__ __forceinline__ unsigned aoff(const Unit& u, int r) const { return (unsigned)idx[(u.pm >> 16) * 256 + r] * 2048u; }
    __device__ __forceinline__ const bf16_t* arow(const Unit& u, int r) const { int pos = u.aux2 + r; const int c = mm.cnt(u.aux); pos = pos < c ? pos : c - 1; return HM + (size_t)LIST[u.aux * NT + pos] * 1024; }
    __device__ __forceinline__ const bf16_t* brow(const Unit& u, int n) const { return W + ((size_t)u.aux * 1024 + u.pn * 256 + n) * 1024; } };
struct EpiUp { bf16_t* ACT; const float* WL; MoeMeta mm;
    struct Col { }; struct Pre { float wt; };
    __device__ __forceinline__ Col col(const Unit&, int) const { return Col{}; }
    __device__ __forceinline__ Pre load(const Unit& u, int r, int) const { const int pos = u.aux2 + r; return Pre{pos < mm.cnt(u.aux) ? WL[u.aux * NT + pos] : 0.f}; }
    __device__ __forceinline__ void apply(const Unit& u, int r, int j, const Col&, const Pre& q, f32x4 g0, f32x4 g1, f32x4 u0, f32x4 u1) const {
        if (u.aux2 + r >= mm.cnt(u.aux)) return;
#pragma unroll
        for (int e = 0; e < 4; ++e) { g0[e] = silu(g0[e]) * u0[e] * q.wt; g1[e] = silu(g1[e]) * u1[e] * q.wt; }
        *(u32x4*)(ACT + ((size_t)(u.pm & 0xffff) * 256 + r) * 512 + u.pn * 128 + j) = pk8(g0, g1); } };
struct SchDn { const bf16_t *ACT, *W; MoeMeta mm; int G, c, K;
    __device__ __forceinline__ bool next(int i, Unit& u) const { const int L = i * G + c; if (L >= 4 * mm.ntiles()) return false; const int mt = L >> 2; u.pn = L & 3; u.aux = mm.find(mt); u.aux2 = (mt - mm.tb(u.aux)) * 256; u.pm = mt; return true; }
    __device__ __forceinline__ const bf16_t* arow(const Unit& u, int r) const { return ACT + ((size_t)u.pm * 256 + r) * 512; }
    __device__ __forceinline__ const bf16_t* brow(const Unit& u, int n) const { return W + ((size_t)u.aux * 1024 + u.pn * 256 + n) * 512; }
    __device__ __forceinline__ const char* abase(const Unit& u) const { return (const char*)(ACT + (size_t)u.pm * 256 * 512); }
    __device__ __forceinline__ const char* bbase(const Unit& u) const { return (const char*)(W + ((size_t)u.aux * 1024 + u.pn * 256) * 512); }
    __device__ __forceinline__ unsigned aoff(const Unit&, int) const { return 0u; } };
struct EpiDn { bf16_t* Y; MoeMeta mm;
    struct Col { }; struct Pre { };
    __device__ __forceinline__ Col col(const Unit&, int) const { return Col{}; }
    __device__ __forceinline__ Pre load(const Unit&, int, int) const { return Pre{}; }
    __device__ __forceinline__ void apply(const Unit& u, int r, int j, const Col&, const Pre&, f32x4 a0, f32x4 a1, f32x4 b0, f32x4 b1) const {
        if (u.aux2 + r >= mm.cnt(u.aux)) return;
        bf16_t* o = Y + ((size_t)u.pm * 256 + r) * 1024 + u.pn * 256 + j; *(u32x4*)o = pk8(a0, a1); *(u32x4*)(o + 128) = pk8(b0, b1); } };

__device__ __forceinline__ void aprep_item(const Params& p, int g, unsigned char* lds) {
    const int tid = threadIdx.x, lane = tid & 63, wave = tid >> 6;
    const bf16_t* Z = (const bf16_t*)(p.ws + OFF_SLOT + 1 * SLOT);
    bf16_t* AA = (bf16_t*)(p.ws + OFF_SLOT + 0 * SLOT) + (size_t)g * 64 * 1024;
    const unsigned* zt = (const unsigned*)lds;
    { const u32x4* src = (const u32x4*)(Z + (size_t)g * 64 * 1024); u32x4* d = (u32x4*)lds;
        u32x4 tmp[16];
#pragma unroll
        for (int i = 0; i < 16; ++i) tmp[i] = src[tid + i * NTHR];
#pragma unroll
        for (int i = 0; i < 16; ++i) d[tid + i * NTHR] = tmp[i]; }
    __syncthreads();
    {
        f32x2 w[31];
        const float* cw = p.in[I_CONVW] + 2 * tid;
#pragma unroll
        for (int k = 0; k < 31; ++k) w[k] = *(const f32x2*)(cw + k * 1024);
        const f32x2 cb = *(const f32x2*)(p.in[I_CONVB] + 2 * tid);
#pragma unroll 1
        for (int tb = 0; tb < 4; ++tb) {
            f32x2 cz[16];
#pragma unroll
            for (int o = 0; o < 16; ++o) cz[o] = cb;
#pragma unroll
            for (int r0 = 0; r0 < 48; r0 += 8) {
                unsigned vv[8];
#pragma unroll
                for (int rr = 0; rr < 8; ++rr) if (r0 + rr < 46) { const int row = 16 * tb - 15 + r0 + rr; const bool ok = (unsigned)row < 64u; const unsigned t = zt[(ok ? row : 0) * 512 + tid]; vv[rr] = ok ? t : 0u; }
#pragma unroll
                for (int rr = 0; rr < 8; ++rr) { const int r = r0 + rr;
                    if (r < 46) { const f32x2 x = (f32x2){bflo(vv[rr]), bfhi(vv[rr])};
#pragma unroll
                        for (int o = 0; o < 16; ++o) { const int k = r - o; if (k >= 0 && k < 31) cz[o] += w[k] * x; } } }
            }
#pragma unroll
            for (int o = 0; o < 16; ++o) *(unsigned*)(AA + (size_t)(16 * tb + o) * 1024 + 2 * tid) = pk2(cz[o].x, cz[o].y);
        }
    }
    asm volatile("s_waitcnt vmcnt(0)" ::: "memory");
    __syncthreads();
    u32x4 ra[8], rb[8];
#pragma unroll
    for (int rr = 0; rr < 8; ++rr) { const bf16_t* rp = AA + (size_t)(wave * 8 + rr) * 1024 + lane * 8; ra[rr] = *(const u32x4*)rp; rb[rr] = *(const u32x4*)(rp + 512); }
    f32x4 lg0[2], lg1[2], lb0[2], lb1[2];
#pragma unroll
    for (int hh = 0; hh < 2; ++hh) { const int c0 = hh * 512 + lane * 8;
        lg0[hh] = *(const f32x4*)(p.in[I_LNG] + c0); lg1[hh] = *(const f32x4*)(p.in[I_LNG] + c0 + 4); lb0[hh] = *(const f32x4*)(p.in[I_LNB] + c0); lb1[hh] = *(const f32x4*)(p.in[I_LNB] + c0 + 4); }
#pragma unroll
    for (int rr = 0; rr < 8; ++rr) {
        const int row = wave * 8 + rr;
        f32x4 x0, x1, x2, x3; unpk8(ra[rr], x0, x1); unpk8(rb[rr], x2, x3);
        const f32x4 sv = (x0 + x1) + (x2 + x3);
        const float mean = wave_sum((sv[0] + sv[1]) + (sv[2] + sv[3])) * (1.0f / 1024.0f);
        x0 -= mean; x1 -= mean; x2 -= mean; x3 -= mean;
        const f32x4 qv = (x0 * x0 + x1 * x1) + (x2 * x2 + x3 * x3);
        const float rstd = rsqrtf(wave_sum((qv[0] + qv[1]) + (qv[2] + qv[3])) * (1.0f / 1024.0f) + 1e-6f);
        x0 = x0 * rstd * lg0[0] + lb0[0]; x1 = x1 * rstd * lg1[0] + lb1[0]; x2 = x2 * rstd * lg0[1] + lb0[1]; x3 = x3 * rstd * lg1[1] + lb1[1];
#pragma unroll
        for (int e = 0; e < 4; ++e) { x0[e] = silu(x0[e]); x1[e] = silu(x1[e]); x2[e] = silu(x2[e]); x3[e] = silu(x3[e]); }
        bf16_t* o = AA + (size_t)row * 1024 + lane * 8;
        *(u32x4*)o = pk8(x0, x1); *(u32x4*)(o + 512) = pk8(x2, x3);
    }
    __syncthreads();
}

constexpr int XC_STRIDE = 272;
constexpr int YB_STRIDE = 132;
constexpr int B_XC_OFF = 0, B_HIN_OFF = 256 * XC_STRIDE  , B_Y_OFF = B_HIN_OFF + 4096  , B_Y_BYTES = 64 * YB_STRIDE * 4  ;
constexpr size_t OFF_TOT256 = OFF_TOT + 9 * MiB;

__device__ __forceinline__ void lru_coef(float lr2, float li2, float nsp2, float xcv, float& a, float& b) {
    const float r = __builtin_amdgcn_rcpf(1.0f + __builtin_amdgcn_exp2f(lr2));
    a = __builtin_amdgcn_exp2f(nsp2 * r);
    const float v = fmaxf(__builtin_fmaf(-a, a, 1.0f), 1e-30f);
    const float d = 1.0f + __builtin_amdgcn_exp2f(li2);
    b = (v * __builtin_amdgcn_rsqf(v * d * d)) * xcv;
}

template <bool FINAL, int DIR>
__device__ __forceinline__ void lru_dir(const unsigned char* xcs, const bf16x8 (&fbr)[4], const bf16x8 (&fbi)[4], float br, float bi, float nsp, int fr, int q, int chl,
                                        float hin_v, f32x4 (&hout)[4], float& totA, float& totB) {
    f32x4 ar[4], ai[4];
#pragma unroll
    for (int m = 0; m < 4; ++m) { ar[m] = (f32x4){0.f, 0.f, 0.f, 0.f}; ai[m] = (f32x4){0.f, 0.f, 0.f, 0.f}; }
#pragma unroll
    for (int kk = 0; kk < 4; ++kk) {
#pragma unroll
        for (int m = 0; m < 4; ++m) { const bf16x8 fa = *(const bf16x8*)(xcs + (16 * m + fr) * XC_STRIDE + (32 * kk + 8 * q) * 2);
            ar[m] = __builtin_amdgcn_mfma_f32_16x16x32_bf16(fa, fbr[kk], ar[m], 0, 0, 0);
            ai[m] = __builtin_amdgcn_mfma_f32_16x16x32_bf16(fa, fbi[kk], ai[m], 0, 0, 0); }
    }
#pragma unroll
    for (int m = 0; m < 4; ++m)
#pragma unroll
        for (int i = 0; i < 4; ++i) {
            const float xcv = bf2f(*(const bf16_t*)(xcs + (16 * m + 4 * q + i) * XC_STRIDE + chl * 2));
            float a, b; lru_coef(ar[m][i] + br, ai[m][i] + bi, nsp, xcv, a, b); ar[m][i] = a; ai[m][i] = b;
        }
    float At[4], Bt[4], Ae[4], Be[4];
#pragma unroll
    for (int m = 0; m < 4; ++m) {
        float A = 1.f, B = 0.f;
#pragma unroll
        for (int ii = 0; ii < 4; ++ii) { const int i = DIR ? 3 - ii : ii; B = ar[m][i] * B + ai[m][i]; A = ar[m][i] * A; }
        if (DIR == 0) {
            float tA = __shfl_up(A, 16), tB = __shfl_up(B, 16); if (q >= 1) { B = A * tB + B; A = A * tA; }
            tA = __shfl_up(A, 32); tB = __shfl_up(B, 32); if (q >= 2) { B = A * tB + B; A = A * tA; }
            Ae[m] = __shfl_up(A, 16); Be[m] = __shfl_up(B, 16); if (q == 0) { Ae[m] = 1.f; Be[m] = 0.f; }
            At[m] = __shfl(A, 48 + fr); Bt[m] = __shfl(B, 48 + fr);
        } else {
            float tA = __shfl_down(A, 16), tB = __shfl_down(B, 16); if (q <= 2) { B = A * tB + B; A = A * tA; }
            tA = __shfl_down(A, 32); tB = __shfl_down(B, 32); if (q <= 1) { B = A * tB + B; A = A * tA; }
            Ae[m] = __shfl_down(A, 16); Be[m] = __shfl_down(B, 16); if (q == 3) { Ae[m] = 1.f; Be[m] = 0.f; }
            At[m] = __shfl(A, fr); Bt[m] = __shfl(B, fr);
        }
    }
    if (!FINAL) {
        float A = 1.f, B = 0.f;
#pragma unroll
        for (int mm = 0; mm < 4; ++mm) { const int m = DIR ? 3 - mm : mm; B = At[m] * B + Bt[m]; A = At[m] * A; }
        totA = A; totB = B;
    } else {
        float hh = hin_v;
#pragma unroll
        for (int mm = 0; mm < 4; ++mm) { const int m = DIR ? 3 - mm : mm;
            float hs = Ae[m] * hh + Be[m];
#pragma unroll
            for (int ii = 0; ii < 4; ++ii) { const int i = DIR ? 3 - ii : ii; hs = ar[m][i] * hs + ai[m][i]; hout[m][i] = hs; }
            hh = At[m] * hh + Bt[m];
        }
    }
}

template <bool FINAL>
__device__ __forceinline__ void b_phase(const Params& p, int bid, int nb, unsigned char* lds) {
    const int tid = threadIdx.x, lane = tid & 63, wave = tid >> 6, fr = lane & 15, q = lane >> 4;
    f32x2* TOT = (f32x2*)(p.ws + OFF_TOT);
    f32x2* TOT256 = (f32x2*)(p.ws + OFF_TOT256);
    const bf16_t* WG = (const bf16_t*)(p.ws + OFF_WG);
    float* hin = (float*)(lds + B_HIN_OFF);
    const int chl = 16 * wave + fr;
    const int nitems = FINAL ? 1024 : 1024 + 32;
    int hprev = -1;
    bf16x8 fb[4][4];
    float* cst = (float*)(lds + B_Y_OFF + 2 * B_Y_BYTES);
    for (int it = bid; it < nitems; it += nb) {
        const bool isctx = it >= 1024;
        const int b = isctx ? (it - 1024) >> 3 : it >> 8, c256 = isctx ? -1 : (it >> 3) & 31, h = it & 7;
        const int seqlen = isctx ? CTXL : SEQ, sbase = isctx ? 0 : c256 * 256;
        const bf16_t* src = isctx ? (const bf16_t*)(p.ws + OFF_XRC) + (size_t)b * CTXL * 1024 : (const bf16_t*)(p.ws + OFF_SLOT + 3 * SLOT) + (size_t)b * SEQ * 1024;
        const int kc0 = isctx ? 0 : 4 + c256 * 4, k256 = isctx ? 0 : 1 + c256;
        const int ch = h * 128 + chl;
        if (h != hprev) {
            hprev = h;
#pragma unroll
            for (int ty = 0; ty < 4; ++ty)
#pragma unroll
                for (int kk = 0; kk < 4; ++kk) fb[ty][kk] = *(const bf16x8*)(WG + (size_t)(h * 512 + wave * 64 + ty * 16 + fr) * 128 + 32 * kk + 8 * q);
            if (q == 0) { const float L2E = 1.4426950408889634f;
                          cst[0 * 128 + chl] = -L2E * p.in[I_BRF][ch]; cst[1 * 128 + chl] = -L2E * p.in[I_BIF][ch]; cst[2 * 128 + chl] = -8.0f * L2E * log1pf(__expf(-p.in[I_LAMF][ch]));
                          cst[3 * 128 + chl] = -L2E * p.in[I_BRB][ch]; cst[4 * 128 + chl] = -L2E * p.in[I_BIB][ch]; cst[5 * 128 + chl] = -8.0f * L2E * log1pf(__expf(-p.in[I_LAMB][ch])); }
            wave_lds_sync();
        }
        float runAf = 1.f, runBf = 0.f, runAb = 1.f, runBb = 0.f;
        {
            const int cgp = tid & 15, c0 = h * 128 + 8 * cgp;
            float wk[4][8], bs[8];
            { const f32x4* bp = (const f32x4*)(p.in[I_LCB] + c0); const f32x4 t0_ = bp[0], t1_ = bp[1];
                bs[0] = t0_[0]; bs[1] = t0_[1]; bs[2] = t0_[2]; bs[3] = t0_[3]; bs[4] = t1_[0]; bs[5] = t1_[1]; bs[6] = t1_[2]; bs[7] = t1_[3];
#pragma unroll
                for (int k = 0; k < 4; ++k) { const f32x4* wp = (const f32x4*)(p.in[I_LCW] + k * 1024 + c0); const f32x4 w0 = wp[0], w1 = wp[1];
                    wk[k][0] = w0[0]; wk[k][1] = w0[1]; wk[k][2] = w0[2]; wk[k][3] = w0[3]; wk[k][4] = w1[0]; wk[k][5] = w1[1]; wk[k][6] = w1[2]; wk[k][7] = w1[3]; } }
#pragma unroll 1
            for (int ps = 0; ps < 2; ++ps) {
                const int tq = ps * 128 + (tid >> 4) * 4;
                float xc[4][8];
#pragma unroll
                for (int r = 0; r < 4; ++r)
#pragma unroll
                    for (int e = 0; e < 8; ++e) xc[r][e] = bs[e];
#pragma unroll
                for (int rr = 0; rr < 7; ++rr) {
                    const int row = sbase + tq + rr - 2;
                    u32x4 a = (u32x4){0u, 0u, 0u, 0u};
                    if (row >= 0 && row < seqlen) a = *(const u32x4*)(src + (size_t)row * 1024 + c0);
                    const float x[8] = {bflo(a.x), bfhi(a.x), bflo(a.y), bfhi(a.y), bflo(a.z), bfhi(a.z), bflo(a.w), bfhi(a.w)};
#pragma unroll
                    for (int r = 0; r < 4; ++r) { const int k = rr - r;
                        if (k >= 0 && k < 4) {
#pragma unroll
                            for (int e = 0; e < 8; ++e) xc[r][e] += wk[k][e] * x[e]; } }
                }
#pragma unroll
                for (int r = 0; r < 4; ++r) {
                    u32x4 o0; o0.x = pk2(xc[r][0], xc[r][1]); o0.y = pk2(xc[r][2], xc[r][3]); o0.z = pk2(xc[r][4], xc[r][5]); o0.w = pk2(xc[r][6], xc[r][7]);
                    *(u32x4*)(lds + B_XC_OFF + (tq + r) * XC_STRIDE + cgp * 16) = o0;
                }
            }
        }
        f32x2 ct[33], cs[4];
        const int cdir = (tid >> 7) & 1, ccl = tid & 127;
        if (FINAL && tid < 256) {
            const f32x2* T2 = TOT256 + ((size_t)b * 33 * 2 + cdir) * 1024 + h * 128 + ccl;
            const f32x2* T = TOT + ((size_t)b * NCH64 * 2 + cdir) * 1024 + h * 128 + ccl;
#pragma unroll
            for (int k = 0; k < 33; ++k) { const bool use = cdir == 0 ? (k < k256) : (k == 0 || k > k256); ct[k] = use ? T2[(size_t)k * 2048] : (f32x2){1.f, 0.f}; }
#pragma unroll
            for (int s_ = 0; s_ < 4; ++s_) cs[s_] = T[(size_t)(kc0 + s_) * 2048];
        }
        if (FINAL && tid < 256) {
            float hc = 0.f;
            if (cdir == 0) {
#pragma unroll
                for (int k = 0; k < 33; ++k) hc = ct[k].x * hc + ct[k].y;
#pragma unroll
                for (int s_ = 0; s_ < 4; ++s_) { hin[(s_ * 2 + 0) * 128 + ccl] = hc; hc = cs[s_].x * hc + cs[s_].y; }
            } else {
                hc = ct[0].y;
#pragma unroll
                for (int k = 32; k >= 1; --k) hc = ct[k].x * hc + ct[k].y;
#pragma unroll
                for (int s_ = 3; s_ >= 0; --s_) { hin[(s_ * 2 + 1) * 128 + ccl] = hc; hc = cs[s_].x * hc + cs[s_].y; }
            }
        }
        __syncthreads();
        for (int sub = 0; sub < 4; ++sub) {
            const int t0 = sbase + 64 * sub;
            const unsigned char* xcs = lds + B_XC_OFF + 64 * sub * XC_STRIDE;
            float* ybuf = (float*)(lds + B_Y_OFF + (sub & 1) * B_Y_BYTES);
            const int ot = tid >> 3, oc = (tid & 7) * 16;
            f32x4 hf[4], hb[4]; float tA, tB;
            lru_dir<FINAL, 0>(xcs, fb[0], fb[1], cst[0 * 128 + chl], cst[1 * 128 + chl], cst[2 * 128 + chl], fr, q, chl, FINAL ? hin[(sub * 2 + 0) * 128 + chl] : 0.f, hf, tA, tB);
            if (!FINAL) { if (q == 0) TOT[((size_t)(b * NCH64 + kc0 + sub) * 2 + 0) * 1024 + ch] = (f32x2){tA, tB};
                runBf = tA * runBf + tB; runAf = tA * runAf; }
            u32x4 gy0, gy1;
            if (FINAL) { const bf16_t* GYG = (const bf16_t*)(p.ws + OFF_SLOT + 2 * SLOT) + ((size_t)b * SEQ + t0 + ot) * 1024 + h * 128 + oc;
                gy0 = *(const u32x4*)GYG; gy1 = *(const u32x4*)(GYG + 8); }
            lru_dir<FINAL, 1>(xcs, fb[2], fb[3], cst[3 * 128 + chl], cst[4 * 128 + chl], cst[5 * 128 + chl], fr, q, chl, FINAL ? hin[(sub * 2 + 1) * 128 + chl] : 0.f, hb, tA, tB);
            if (!FINAL) { if (q == 0) TOT[((size_t)(b * NCH64 + kc0 + sub) * 2 + 1) * 1024 + ch] = (f32x2){tA, tB};
                runBb = runAb * tB + runBb; runAb = runAb * tA; }
            if (FINAL) {
#pragma unroll
                for (int m = 0; m < 4; ++m)
#pragma unroll
                    for (int i = 0; i < 4; ++i) ybuf[(16 * m + 4 * q + i) * YB_STRIDE + chl] = hf[m][i] + hb[m][i];
                __syncthreads();
                const f32x4* yp = (const f32x4*)(ybuf + ot * YB_STRIDE + oc);
                const f32x4 y0 = yp[0], y1 = yp[1], y2 = yp[2], y3 = yp[3];
                u32x4 o0, o1;
                o0.x = pk2(bflo(gy0.x) * y0[0], bfhi(gy0.x) * y0[1]); o0.y = pk2(bflo(gy0.y) * y0[2], bfhi(gy0.y) * y0[3]);
                o0.z = pk2(bflo(gy0.z) * y1[0], bfhi(gy0.z) * y1[1]); o0.w = pk2(bflo(gy0.w) * y1[2], bfhi(gy0.w) * y1[3]);
                o1.x = pk2(bflo(gy1.x) * y2[0], bfhi(gy1.x) * y2[1]); o1.y = pk2(bflo(gy1.y) * y2[2], bfhi(gy1.y) * y2[3]);
                o1.z = pk2(bflo(gy1.z) * y3[0], bfhi(gy1.z) * y3[1]); o1.w = pk2(bflo(gy1.w) * y3[2], bfhi(gy1.w) * y3[3]);
                bf16_t* AB = (bf16_t*)(p.ws + OFF_SLOT + 1 * SLOT) + ((size_t)b * SEQ + t0 + ot) * 1024 + h * 128 + oc;
                *(u32x4*)AB = o0; *(u32x4*)(AB + 8) = o1;
            }
        }
        __syncthreads();
        if (!FINAL && q == 0) {
            TOT256[((size_t)(b * 33 + k256) * 2 + 0) * 1024 + ch] = (f32x2){runAf, runBf};
            TOT256[((size_t)(b * 33 + k256) * 2 + 1) * 1024 + ch] = (f32x2){runAb, runBb};
        }
    }
}

template <int CTRL, int RMASK> __device__ __forceinline__ float dpp_add(float v) { return v + __int_as_float(__builtin_amdgcn_update_dpp(0, __float_as_int(v), CTRL, RMASK, 0xF, false)); }
__device__ __forceinline__ float wave_sum_dpp(float v) {
    v = dpp_add<0xB1, 0xF>(v); v = dpp_add<0x4E, 0xF>(v); v = dpp_add<0x141, 0xF>(v); v = dpp_add<0x140, 0xF>(v); v = dpp_add<0x142, 0xA>(v); v = dpp_add<0x143, 0xC>(v);
    return __int_as_float(__builtin_amdgcn_readlane(__float_as_int(v), 63));
}
__device__ __forceinline__ void ph8_route(const Params& p, int bid, int nb, unsigned char* lds) {
    constexpr int NU = 1;
    const int tid = threadIdx.x, lane = tid & 63, wave = tid >> 6;
    float* Wl = (float*)lds;
    int* lcnt = (int*)(lds + 81920);
    int* lbase = lcnt + 16;
    int* tinfo = lcnt + 32;
    float* twt = (float*)(tinfo + 512);
#pragma unroll 1
    for (int kk = 0; kk < 2; ++kk) { const int k = tid + kk * NTHR;
        const f32x4 wg = *(const f32x4*)(p.in[I_WGRP] + k * 4);
        Wl[0 * 1024 + k] = wg[0]; Wl[1 * 1024 + k] = wg[1]; Wl[2 * 1024 + k] = wg[2]; Wl[3 * 1024 + k] = wg[3];
#pragma unroll
        for (int o4 = 0; o4 < 4; ++o4) { const f32x4 we = *(const f32x4*)(p.in[I_WER] + k * 16 + o4 * 4);
            Wl[(4 + o4 * 4 + 0) * 1024 + k] = we[0]; Wl[(4 + o4 * 4 + 1) * 1024 + k] = we[1]; Wl[(4 + o4 * 4 + 2) * 1024 + k] = we[2]; Wl[(4 + o4 * 4 + 3) * 1024 + k] = we[3]; } }
    __syncthreads();
    const float* MOD = (const float*)(p.ws + OFF_MOD);
    const float* X1 = p.out;
    bf16_t* HM = (bf16_t*)(p.ws + OFF_SLOT + 2 * SLOT);
    unsigned* gcnt = (unsigned*)(p.ws + OFF_CTL);
    int* LIST = (int*)(p.ws + OFF_LIST); float* WLs = (float*)(p.ws + OFF_WL); int* ROUTE = (int*)(p.ws + OFF_ROUTE);
    float* bl = (float*)(lds + 81920 + 8192);
    if (tid < 20) bl[tid] = tid < 4 ? p.in[I_BGRP][tid] : p.in[I_BER][tid - 4];
    __syncthreads();
    for (int tile = bid; tile < NT / 128; tile += nb) {
        if (tid < 16) lcnt[tid] = 0;
        __syncthreads();
        const float* mrow = MOD + ((tile * 128) / SEQ) * 6144;
        f32x4 gq[4], shq[4], scq[4];
#pragma unroll
        for (int j = 0; j < 4; ++j) { const int c = lane * 4 + 256 * j; gq[j] = *(const f32x4*)(p.in[I_GFFN] + c); shq[j] = *(const f32x4*)(mrow + 3 * 1024 + c); scq[j] = *(const f32x4*)(mrow + 4 * 1024 + c); gq[j] = gq[j] * (1.0f + scq[j]); }
        f32x4 nx[4];
#pragma unroll
        for (int j = 0; j < 4; ++j) nx[j] = *(const f32x4*)(X1 + (size_t)(tile * 128 + wave * 16) * DM + lane * 4 + 256 * j);
#pragma unroll 1
        for (int tt = 0; tt < 16; tt += NU) {
            const int tl = wave * 16 + tt, tok = tile * 128 + tl;
            f32x4 v[NU][4]; float ss[NU];
#pragma unroll
            for (int u = 0; u < NU; ++u) ss[u] = 0.f;
#pragma unroll
            for (int j = 0; j < 4; ++j) { v[0][j] = nx[j]; const f32x4 sq = v[0][j] * v[0][j]; ss[0] += (sq[0] + sq[1]) + (sq[2] + sq[3]); }
            { const int tn = tt + 1 < 16 ? tok + 1 : tok;
#pragma unroll
                for (int j = 0; j < 4; ++j) nx[j] = *(const f32x4*)(X1 + (size_t)tn * DM + lane * 4 + 256 * j); }
            float lg[NU][20];
#pragma unroll
            for (int u = 0; u < NU; ++u) { const float rinv = rsqrtf(wave_sum_dpp(ss[u]) * (1.0f / DM) + 1e-6f);
#pragma unroll
                for (int j = 0; j < 4; ++j) { v[u][j] = v[u][j] * rinv * gq[j] + shq[j]; *(u32x2*)(HM + (size_t)(tok + u) * DM + lane * 4 + 256 * j) = pk4(v[u][j]); }
}
#pragma unroll
            for (int o = 0; o < 20; ++o)
            { f32x4 wv[4];
#pragma unroll
                for (int j = 0; j < 4; ++j) wv[j] = *(const f32x4*)(Wl + o * 1024 + lane * 4 + 256 * j);
#pragma unroll
                for (int u = 0; u < NU; ++u) { f32x4 pr = v[u][0] * wv[0]; pr += v[u][1] * wv[1]; pr += v[u][2] * wv[2]; pr += v[u][3] * wv[3]; lg[u][o] = (pr[0] + pr[1]) + (pr[2] + pr[3]); }
                if ((o & 3) == 3) asm volatile("" ::: "memory"); }
#pragma unroll
            for (int u = 0; u < NU; ++u) {
#pragma unroll
                for (int o = 0; o < 20; ++o) lg[u][o] = wave_sum_dpp(lg[u][o]) + bl[o];
                int gs = 0; float gm = lg[u][0];
#pragma unroll
                for (int o = 1; o < 4; ++o) if (lg[u][o] > gm) { gm = lg[u][o]; gs = o; }
                float den = 0.f;
#pragma unroll
                for (int o = 0; o < 4; ++o) den += __expf(lg[u][o] - gm);
                const float pg = 1.0f / den;
                float el[4];
#pragma unroll
                for (int o = 0; o < 4; ++o) el[o] = gs == 0 ? lg[u][4 + o] : gs == 1 ? lg[u][8 + o] : gs == 2 ? lg[u][12 + o] : lg[u][16 + o];
                int i1 = 0; float v1 = el[0];
#pragma unroll
                for (int o = 1; o < 4; ++o) if (el[o] > v1) { v1 = el[o]; i1 = o; }
                int i2 = -1; float v2 = -3.0e38f;
#pragma unroll
                for (int o = 0; o < 4; ++o) if (o != i1 && el[o] > v2) { v2 = el[o]; i2 = o; }
                const float w1 = 1.0f / (1.0f + __expf(v2 - v1)), w2 = 1.0f - w1;
                if (lane == 0) { const int e1 = gs * 4 + i1, e2 = gs * 4 + i2;
                    const int r1 = atomicAdd(&lcnt[e1], 1), r2 = atomicAdd(&lcnt[e2], 1);
                    tinfo[(tl + u) * 4 + 0] = e1; tinfo[(tl + u) * 4 + 1] = r1; tinfo[(tl + u) * 4 + 2] = e2; tinfo[(tl + u) * 4 + 3] = r2; twt[(tl + u) * 2] = pg * w1; twt[(tl + u) * 2 + 1] = pg * w2; }
            }
        }
        __syncthreads();
        if (tid < 16) lbase[tid] = (int)__hip_atomic_fetch_add(gcnt + tid, (unsigned)lcnt[tid], __ATOMIC_RELAXED, __HIP_MEMORY_SCOPE_AGENT);
        __syncthreads();
        if (tid < 128) { const int tok = tile * 128 + tid;
            const int e1 = tinfo[tid * 4], e2 = tinfo[tid * 4 + 2], p1 = lbase[e1] + tinfo[tid * 4 + 1], p2 = lbase[e2] + tinfo[tid * 4 + 3];
            LIST[e1 * NT + p1] = tok; LIST[e2 * NT + p2] = tok; WLs[e1 * NT + p1] = twt[tid * 2]; WLs[e2 * NT + p2] = twt[tid * 2 + 1];
            ROUTE[tok * 4 + 0] = e1; ROUTE[tok * 4 + 1] = p1; ROUTE[tok * 4 + 2] = e2; ROUTE[tok * 4 + 3] = p2; }
        __syncthreads();
    }
}

__device__ __forceinline__ void ph10_final(const Params& p, int bid, int nb, const int* meta) {
    const int lane = threadIdx.x & 63, wave = threadIdx.x >> 6;
    const float* MOD = (const float*)(p.ws + OFF_MOD);
    const bf16_t* Y = (const bf16_t*)(p.ws + OFF_SLOT);
    const int* ROUTE = (const int*)(p.ws + OFF_ROUTE);
    float* X1 = p.out;
    for (int r = bid * 8 + wave; r < NT; r += nb * 8) {
        const int e1 = ROUTE[r * 4], p1 = ROUTE[r * 4 + 1], e2 = ROUTE[r * 4 + 2], p2 = ROUTE[r * 4 + 3];
        const bf16_t* y1 = Y + ((size_t)meta[16 + e1] * 256 + p1) * 1024; const bf16_t* y2 = Y + ((size_t)meta[16 + e2] * 256 + p2) * 1024;
        const float* gt = MOD + (r / SEQ) * 6144 + 5 * 1024;
        f32x4 v[4]; float ss = 0.f;
#pragma unroll
        for (int j = 0; j < 4; ++j) { const int c = lane * 4 + 256 * j;
            v[j] = *(const f32x4*)(X1 + (size_t)r * DM + c);
            const u32x2 a = *(const u32x2*)(y1 + c), bq = *(const u32x2*)(y2 + c); const f32x4 g = *(const f32x4*)(gt + c);
            v[j][0] += g[0] * (bflo(a.x) + bflo(bq.x)); v[j][1] += g[1] * (bfhi(a.x) + bfhi(bq.x)); v[j][2] += g[2] * (bflo(a.y) + bflo(bq.y)); v[j][3] += g[3] * (bfhi(a.y) + bfhi(bq.y));
            ss += v[j][0] * v[j][0] + v[j][1] * v[j][1] + v[j][2] * v[j][2] + v[j][3] * v[j][3]; }
        const float rinv = rsqrtf(wave_sum(ss) * (1.0f / DM) + 1e-6f);
#pragma unroll
        for (int j = 0; j < 4; ++j) { const int c = lane * 4 + 256 * j; const f32x4 g = *(const f32x4*)(p.in[I_GFINAL] + c);
            *(f32x4*)(X1 + (size_t)r * DM + c) = v[j] * rinv * g; }
    }
}


#define XB_TMO      128
#define XB_XCNT(j)  (256  + 64 * (j))
#define XB_XSUB(j)  (1280 + 64 * (j))
#define XB_XGEN(j)  (2304 + 64 * (j))
#define XB_TOP      3328
#define XB_TOPGEN   3392
#define XCD_BAR_WORDS 3456
#define XB_SPIN_CAP (1u << 18)
__device__ __forceinline__ unsigned xb_ld(unsigned* p)              { return __hip_atomic_load(p, __ATOMIC_RELAXED, __HIP_MEMORY_SCOPE_AGENT); }
__device__ __forceinline__ unsigned xb_add(unsigned* p, unsigned v) { return __hip_atomic_fetch_add(p, v, __ATOMIC_RELAXED, __HIP_MEMORY_SCOPE_AGENT); }
__device__ __forceinline__ unsigned xb_xcc_id() { return (unsigned)__builtin_amdgcn_s_getreg((3 << 11) | 20) & 0xFu; }
#define XB_SPIN(cond, bar) do { unsigned _sp = 0; while (cond) { __builtin_amdgcn_s_sleep(1); \
    if ((++_sp & 255u) == 0u) { if (xb_ld(&(bar)[XB_TMO])) break; if (_sp > XB_SPIN_CAP) { atomicAdd(&(bar)[XB_TMO], 1u); break; } } } } while (0)
struct XcdBarrier { unsigned* bar; unsigned x; volatile unsigned* st; };
__device__ __forceinline__ XcdBarrier xcd_barrier_post(unsigned* bar, volatile unsigned* st) {
    XcdBarrier b; b.bar = bar; b.x = xb_xcc_id(); b.st = st;
    if (threadIdx.x == 0) (void)xb_add(&bar[XB_XCNT(b.x)], 1u);
    return b;
}
__device__ __forceinline__ void xcd_barrier_complete(unsigned* bar, unsigned x, unsigned& nloc, unsigned& nx) {
    const unsigned G = gridDim.x * gridDim.y * gridDim.z;
    unsigned sum, cnt, mine, sp = 0u;
    for (;;) {
        sum = 0u; cnt = 0u; mine = 0u;
#pragma unroll
        for (unsigned j = 0; j < 16; ++j) { const unsigned c = xb_ld(&bar[XB_XCNT(j)]); sum += c; cnt += (c > 0u) ? 1u : 0u; mine = (j == x) ? c : mine; }
        if (sum == G) break;
        __builtin_amdgcn_s_sleep(1);
        if ((++sp & 255u) == 0u) { if (xb_ld(&bar[XB_TMO])) break; if (sp > XB_SPIN_CAP) { atomicAdd(&bar[XB_TMO], 1u); break; } }
    }
    nloc = mine > 0u ? mine : 1u; nx = cnt > 0u ? cnt : 1u;
}
__device__ __forceinline__ void xcd_barrier(const XcdBarrier& b) {
    asm volatile("s_waitcnt vmcnt(0)" ::: "memory");
    __syncthreads();
    if (threadIdx.x == 0) {
        unsigned* bar = b.bar;
        __builtin_amdgcn_s_waitcnt(0);
        unsigned nloc = b.st[0], nx = b.st[1];
        if (nloc == 0u) { xcd_barrier_complete(bar, b.x, nloc, nx); b.st[0] = nloc; b.st[1] = nx; }
        const unsigned old = xb_add(&bar[XB_XSUB(b.x)], 1u);
        const unsigned gen = old / nloc;
        if (old + 1u == (gen + 1u) * nloc) {
            __builtin_amdgcn_fence(__ATOMIC_RELEASE, "agent");
            asm volatile("s_waitcnt vmcnt(0)" ::: "memory");
            const unsigned og = xb_add(&bar[XB_TOP], 1u);
            const unsigned tg = og / nx;
            if (og + 1u == (tg + 1u) * nx) xb_add(&bar[XB_TOPGEN], 1u);
            else XB_SPIN(xb_ld(&bar[XB_TOPGEN]) == tg, bar);
            __builtin_amdgcn_fence(__ATOMIC_ACQUIRE, "agent");
            xb_add(&bar[XB_XGEN(b.x)], 1u);
            asm volatile("s_waitcnt vmcnt(0)" ::: "memory");
        } else {
            XB_SPIN(xb_ld(&bar[XB_XGEN(b.x)]) == gen, bar);
            __builtin_amdgcn_fence(__ATOMIC_ACQUIRE, "agent");
            asm volatile("s_waitcnt vmcnt(0)" ::: "memory");
        }
    }
    __syncthreads();
}
constexpr size_t OFF_BAR = OFF_CTL + 4096;

__global__ void __launch_bounds__(NTHR) mega(Params p, int lo, int hi) {
    extern __shared__ __attribute__((aligned(16))) unsigned char lds[];
    cg::grid_group grid = cg::this_grid();
    const int bid = blockIdx.x, nb = gridDim.x;
    unsigned char* ws = p.ws;
    bf16_t* S0 = (bf16_t*)(ws + OFF_SLOT), *S1 = (bf16_t*)(ws + OFF_SLOT + SLOT), *S2 = (bf16_t*)(ws + OFF_SLOT + 2 * SLOT), *S3 = (bf16_t*)(ws + OFF_SLOT + 3 * SLOT),
           *S4 = (bf16_t*)(ws + OFF_SLOT + 4 * SLOT), *S5 = (bf16_t*)(ws + OFF_SLOT + 5 * SLOT);
    const float* MOD = (const float*)(ws + OFF_MOD); const float* BINP = (const float*)(ws + OFF_BINP);
    int* meta = (int*)(lds + LDS_BYTES - 256);
#ifndef PHMASK
#define PHMASK 0x7ff
#endif
#define IN(k) (((PHMASK >> (k)) & 1) && lo <= (k) && (k) < hi)
#ifndef PIPE_MASK
#define PIPE_MASK 0x364
#endif
#define GEMM_RUN(k, gather, s, e) gemm_phase_pipe<gather>(lds, s, e)
    volatile unsigned* xst = (volatile unsigned*)(lds + LDS_BYTES - 16);
    if (threadIdx.x < 2) xst[threadIdx.x] = 0u;
    __syncthreads();
    XcdBarrier xbar; xbar.bar = (unsigned*)(ws + OFF_BAR); xbar.x = 0; xbar.st = xst;
    if (hi - lo > 1) xbar = xcd_barrier_post((unsigned*)(ws + OFF_BAR), xst);
    if (p.pv == 0x7eadbeef) grid.sync();
#define SEAM(k) do { if (IN(k) && IN((k) + 1)) xcd_barrier(xbar); } while (0)
    if (IN(0)) { ph0_prep(p, bid, nb, lds); } SEAM(0);
    if (IN(1)) { ph1_norm(p, bid, nb); } SEAM(1);
    if (IN(2)) {
        { SchCtx s{(const bf16_t*)(ws + OFF_HC), (const bf16_t*)(ws + OFF_WIN), nb, bid, 1024}; EpiCtx e{(bf16_t*)(ws + OFF_XRC), BINP}; GEMM_RUN(2, false, s, e); }
        { SchG1 s{S0, (const bf16_t*)(ws + OFF_WIN), nb, bid, 1024}; EpiG1 e{S1, S2, S3, S4, S5, BINP}; GEMM_RUN(2, false, s, e); }
    } SEAM(2);
    if (IN(3)) {
#ifndef NO_APREP
        for (int g = bid; g < 512; g += nb) aprep_item(p, g, lds);
#endif
#ifndef NO_BLOCAL
        b_phase<false>(p, bid, nb, lds);
#endif
    } SEAM(3);
    if (IN(4)) {
        b_phase<true>(p, bid, nb, lds);
    } SEAM(4);
    if (IN(5)) { SchG2 s{S0, S1, (const bf16_t*)(ws + OFF_WPA), (const bf16_t*)(ws + OFF_WPB), nb, bid, 1024}; EpiG2 e{S4, S5, S3}; GEMM_RUN(5, false, s, e); } SEAM(5);
    if (IN(6)) { SchG3 s{S3, (const bf16_t*)(ws + OFF_WO), nb, bid, 1024}; EpiG3 e{p.in[I_X], MOD, p.out}; GEMM_RUN(6, false, s, e); } SEAM(6);
    if (IN(7)) { ph8_route(p, bid, nb, lds); } SEAM(7);
    if (IN(8)) { __syncthreads(); moe_meta_build(p, meta); MoeMeta mm{meta};
        int* idx = (int*)(lds + STAGE_BYTES);
        SchUp s{S2, (const bf16_t*)(ws + OFF_WGU), (const int*)(ws + OFF_LIST), mm, nb, bid, 1024, idx}; EpiUp e{S4, (const float*)(ws + OFF_WL), mm};
        { Unit u; for (int i = 0; i < 8 && s.next(i, u); ++i) { if (threadIdx.x < 256) { int pos = u.aux2 + (int)threadIdx.x; const int c = mm.cnt(u.aux); pos = pos < c ? pos : c - 1; idx[i * 256 + threadIdx.x] = s.LIST[u.aux * NT + pos]; } } }
        __syncthreads();
        GEMM_RUN(8, true, s, e); } SEAM(8);
    if (IN(9)) { __syncthreads(); moe_meta_build(p, meta); MoeMeta mm{meta};
        SchDn s{S4, (const bf16_t*)(ws + OFF_WDN), mm, nb, bid, 512}; EpiDn e{S0, mm}; GEMM_RUN(9, false, s, e); } SEAM(9);
    if (IN(10)) { __syncthreads(); moe_meta_build(p, meta); ph10_final(p, bid, nb, meta); }
#undef IN
#undef SEAM
}

extern "C" void kernel_launch(void* const* d_in, const int* in_sizes, int n_in, void* d_out, int out_size, void* d_ws, size_t ws_size, hipStream_t stream) {
    static int grid = 0;
    if (grid == 0) {
        if (n_in != 37 || out_size != NT * DM || ws_size < WS_END) { fprintf(stderr, "kernel_launch: unexpected shapes: n_in %d out %d ws %zu (need %zu)\n", n_in, out_size, ws_size, (size_t)WS_END); grid = -1; return; }
        int dev = 0, cus = 0, per_cu = 0;
        (void)hipGetDevice(&dev); (void)hipDeviceGetAttribute(&cus, hipDeviceAttributeMultiprocessorCount, dev);
        if (hipFuncSetAttribute((const void*)mega, hipFuncAttributeMaxDynamicSharedMemorySize, LDS_BYTES) != hipSuccess) { fprintf(stderr, "kernel_launch: hipFuncSetAttribute failed\n"); grid = -1; return; }
        if (hipOccupancyMaxActiveBlocksPerMultiprocessor(&per_cu, (const void*)mega, NTHR, LDS_BYTES) != hipSuccess || per_cu < 1) { fprintf(stderr, "kernel_launch: occupancy query says %d\n", per_cu); per_cu = 1; }
        (void)hipGetLastError();
        grid = cus * 1;
        fprintf(stderr, "kernel_launch: grid %d (cus %d, per_cu %d)\n", grid, cus, per_cu);
    }
    if (grid < 0) return;
    Params p{};
    for (int i = 0; i < 37; ++i) p.in[i] = (const float*)d_in[i];
    p.out = (float*)d_out; p.ws = (unsigned char*)d_ws;
#if ONE_LAUNCH
    (void)hipMemsetAsync((unsigned char*)d_ws + OFF_BAR, 0, XCD_BAR_WORDS * 4, stream);
    int lo = 0, hi = NPHASE; void* args[] = {&p, &lo, &hi};
    hipError_t e = hipLaunchCooperativeKernel((const void*)mega, dim3(grid), dim3(NTHR), args, LDS_BYTES, stream);
    if (e != hipSuccess) fprintf(stderr, "cooperative launch failed: %s (grid %d)\n", hipGetErrorString(e), grid);
#ifdef PROBE_PHASE
    hipLaunchKernelGGL(mega, dim3(grid), dim3(NTHR), LDS_BYTES, stream, p, PROBE_PHASE, PROBE_PHASE + 1);
#endif
#else
    for (int k = 0; k < NPHASE; ++k) hipLaunchKernelGGL(mega, dim3(grid), dim3(NTHR), LDS_BYTES, stream, p, k, k + 1);
#endif
}
```

```cpp
#include <hip/hip_runtime.h>
#include <hip/hip_cooperative_groups.h>
#include <cstdio>
#include <cstdint>
namespace cg = cooperative_groups;

#ifndef ONE_LAUNCH
#define ONE_LAUNCH 1
#endif

typedef unsigned short bf16_t;
typedef short bf16x8 __attribute__((ext_vector_type(8)));
typedef float f32x4 __attribute__((ext_vector_type(4)));
typedef float f32x2 __attribute__((ext_vector_type(2)));
typedef unsigned u32x4 __attribute__((ext_vector_type(4)));
typedef unsigned u32x2 __attribute__((ext_vector_type(2)));

constexpr int NT = 32768, NCX = 1024, DM = 1024, SEQ = 8192, CTXL = 256;
constexpr int NTHR = 512;
constexpr int NCH64 = 132;
constexpr size_t MiB = (size_t)1 << 20;
constexpr size_t OFF_CTL = 0, OFF_MOD = 1 * MiB, OFF_BINP = OFF_MOD + 128 * 1024, OFF_WIN = 2 * MiB, OFF_WPA = 14 * MiB, OFF_WPB = 16 * MiB,
                 OFF_WO = 18 * MiB, OFF_WG = 20 * MiB, OFF_WGU = 22 * MiB, OFF_WDN = 54 * MiB, OFF_HC = 70 * MiB, OFF_XRC = 72 * MiB,
                 OFF_TOT = 74 * MiB, OFF_ROUTE = 84 * MiB, OFF_LIST = 85 * MiB, OFF_WL = 87 * MiB, OFF_SLOT = 90 * MiB, SLOT = 64 * MiB,
                 WS_END = OFF_SLOT + 6 * SLOT;
constexpr int LDS_BYTES = 144 * 1024;
constexpr int NPHASE = 11;

struct Params { const float* in[37]; float* out; unsigned char* ws; int pv; int pad; };

enum { I_X = 0, I_C, I_CTX, I_CCTX, I_WADA, I_BADA, I_GMIX, I_WIN, I_BIN, I_CONVW, I_CONVB, I_LNG, I_LNB, I_WPA, I_LCW, I_LCB,
       I_WRF, I_BRF, I_WIF, I_BIF, I_LAMF, I_WRB, I_BRB, I_WIB, I_BIB, I_LAMB, I_WPB, I_WO, I_GFFN, I_WGRP, I_BGRP, I_WER, I_BER,
       I_WGATE, I_WUP, I_WDOWN, I_GFINAL };

__device__ __forceinline__ float bflo(unsigned w) { return __uint_as_float(w << 16); }
__device__ __forceinline__ float bfhi(unsigned w) { return __uint_as_float(w & 0xffff0000u); }
__device__ __forceinline__ float bf2f(bf16_t h) { return __uint_as_float(((unsigned)h) << 16); }
__device__ __forceinline__ unsigned pk2(float lo, float hi) { unsigned r; asm("v_cvt_pk_bf16_f32 %0, %1, %2" : "=v"(r) : "v"(lo), "v"(hi)); return r; }
__device__ __forceinline__ bf16_t f2bf(float f) { return (bf16_t)(pk2(f, 0.f) & 0xffffu); }
__device__ __forceinline__ float sigm(float x) { return __builtin_amdgcn_rcpf(1.0f + __expf(-x)); }
__device__ __forceinline__ float silu(float x) { return x * sigm(x); }
__device__ __forceinline__ float gelu_tanh(float x) { return x * sigm(1.5957691216057308f * (x + 0.044715f * x * x * x)); }
__device__ __forceinline__ float wave_sum(float v) {
#pragma unroll
    for (int o = 1; o < 64; o <<= 1) v += __shfl_xor(v, o);
    return v;
}
template <int CTRL, int RMASK> __device__ __forceinline__ float dpp_add(float v) { return v + __int_as_float(__builtin_amdgcn_update_dpp(0, __float_as_int(v), CTRL, RMASK, 0xF, false)); }
__device__ __forceinline__ float wave_sum_dpp(float v) {
    v = dpp_add<0xB1, 0xF>(v); v = dpp_add<0x4E, 0xF>(v); v = dpp_add<0x141, 0xF>(v); v = dpp_add<0x140, 0xF>(v); v = dpp_add<0x142, 0xA>(v); v = dpp_add<0x143, 0xC>(v);
    return __int_as_float(__builtin_amdgcn_readlane(__float_as_int(v), 63));
}
__device__ __forceinline__ void wave_lds_sync() { asm volatile("s_waitcnt lgkmcnt(0)" ::: "memory"); __builtin_amdgcn_wave_barrier(); }
__device__ __forceinline__ u32x2 pk4(f32x4 v) { u32x2 r; r.x = pk2(v[0], v[1]); r.y = pk2(v[2], v[3]); return r; }

__device__ __forceinline__ u32x4 pk8(f32x4 a, f32x4 b) { u32x4 r; r.x = pk2(a[0], a[1]); r.y = pk2(a[2], a[3]); r.z = pk2(b[0], b[1]); r.w = pk2(b[2], b[3]); return r; }
__device__ __forceinline__ void unpk8(u32x4 w, f32x4& a, f32x4& b) { a[0] = bflo(w.x); a[1] = bfhi(w.x); a[2] = bflo(w.y); a[3] = bfhi(w.y); b[0] = bflo(w.z); b[1] = bfhi(w.z); b[2] = bflo(w.w); b[3] = bfhi(w.w); }

template <class DRow>
__device__ __forceinline__ void tr_item(const float* __restrict__ src, int ldsrc, int k0, int n0, bf16_t* dst, int ldd, DRow drow, float* scr, int lane, float scale = 1.0f) {
    const float* sp = src + (size_t)k0 * ldsrc + n0 + lane;
    float tv[64];
#pragma unroll
    for (int kk = 0; kk < 64; ++kk) tv[kk] = sp[(size_t)kk * ldsrc];
#pragma unroll
    for (int kk = 0; kk < 64; ++kk) scr[kk * 65 + lane] = tv[kk] * scale;
    wave_lds_sync();
    const int c = lane & 7;
#pragma unroll
    for (int j = 0; j < 8; ++j) {
        const int n = (lane >> 3) + 8 * j; const float* s = scr + (8 * c) * 65 + n;
        u32x4 o; o.x = pk2(s[0], s[65]); o.y = pk2(s[130], s[195]); o.z = pk2(s[260], s[325]); o.w = pk2(s[390], s[455]);
        *(u32x4*)(dst + (size_t)drow(n0 + n) * ldd + k0 + 8 * c) = o;
    }
    wave_lds_sync();
}

__device__ __forceinline__ int win_srccol(int np) { const int p = np >> 8, r = np & 255; return p < 8 ? (r >> 7) * 1024 + 128 * p + (r & 127) : np; }

__device__ __forceinline__ void ph0_prep(const Params& p, int bid, int nb, unsigned char* lds) {
    const int tid = threadIdx.x, lane = tid & 63, wave = tid >> 6;
    unsigned char* ws = p.ws;
    float* scr = (float*)lds + wave * (64 * 65);
    const int gw = bid * 8 + wave, NGW = nb * 8;
    constexpr int N_WIN = 16 * 96, N_SQ = 16 * 16, N_G = 128, N_GU = 2048, N_DN = 2048;
    constexpr int NITEMS = N_WIN + 3 * N_SQ + N_G + 2 * N_GU + N_DN;
    for (int it = gw; it < NITEMS; it += NGW) {
        int r = it;
        if (r < N_WIN) { const int kb = r / 96, nbk = r % 96, d0 = 64 * nbk, sc0 = win_srccol(d0);
            tr_item(p.in[I_WIN], 6144, 64 * kb, sc0, (bf16_t*)(ws + OFF_WIN), 1024, [=](int n) { return n - sc0 + d0; }, scr, lane); continue; }
        r -= N_WIN;
        if (r < 3 * N_SQ) { const int which = r / N_SQ, q = r % N_SQ, kb = q / 16, nbk = q % 16;
            const float* src = which == 0 ? p.in[I_WPA] : which == 1 ? p.in[I_WPB] : p.in[I_WO];
            bf16_t* dst = (bf16_t*)(ws + (which == 0 ? OFF_WPA : which == 1 ? OFF_WPB : OFF_WO));
            tr_item(src, 1024, 64 * kb, 64 * nbk, dst, 1024, [=](int n) { return n; }, scr, lane); continue; }
        r -= 3 * N_SQ;
        if (r < N_G) { const int ty = r / 32, q = r % 32, h = q / 4, kb = (q % 4) / 2, nbk = q % 2;
            const float* src = (ty == 0 ? p.in[I_WRF] : ty == 1 ? p.in[I_WIF] : ty == 2 ? p.in[I_WRB] : p.in[I_WIB]) + (size_t)h * 128 * 128;
            tr_item(src, 128, 64 * kb, 64 * nbk, (bf16_t*)(ws + OFF_WG), 128, [=](int n) { return h * 512 + (n >> 4) * 64 + ty * 16 + (n & 15); }, scr, lane, -1.4426950408889634f); continue; }
        r -= N_G;
        if (r < 2 * N_GU) { const int bj = r / N_GU, q = r % N_GU, e = q / 128, kb = (q % 128) / 8, nbk = q % 8;
            const float* src = (bj == 0 ? p.in[I_WGATE] : p.in[I_WUP]) + (size_t)e * 1024 * 512;
            tr_item(src, 512, 64 * kb, 64 * nbk, (bf16_t*)(ws + OFF_WGU) + (size_t)e * 1024 * 1024, 1024, [=](int n) { return 256 * (n >> 7) + 128 * bj + (n & 127); }, scr, lane); continue; }
        r -= 2 * N_GU;
        { const int e = r / 128, kb = (r % 128) / 16, nbk = r % 16;
            tr_item(p.in[I_WDOWN] + (size_t)e * 512 * 1024, 1024, 64 * kb, 64 * nbk, (bf16_t*)(ws + OFF_WDN) + (size_t)e * 1024 * 512, 512, [=](int n) { return n; }, scr, lane); }
    }
    __syncthreads();
    float* red = (float*)lds;
    float* MOD = (float*)(ws + OFF_MOD);
    for (int it = bid; it < 96; it += nb) {
        const int col = it * 64 + lane;
        float a[5] = {0.f, 0.f, 0.f, 0.f, 0.f};
        const float* W = p.in[I_WADA];
#pragma unroll 1
        for (int k0 = wave * 128; k0 < wave * 128 + 128; k0 += 16) {
            float wv[16];
#pragma unroll
            for (int kk = 0; kk < 16; ++kk) wv[kk] = W[(size_t)(k0 + kk) * 6144 + col];
#pragma unroll
            for (int kk = 0; kk < 16; ++kk)
#pragma unroll
                for (int r = 0; r < 5; ++r) { const float cv = r < 4 ? p.in[I_C][r * 1024 + k0 + kk] : p.in[I_CCTX][k0 + kk]; a[r] += silu(cv) * wv[kk]; }
        }
#pragma unroll
        for (int r = 0; r < 5; ++r) red[(wave * 5 + r) * 64 + lane] = a[r];
        __syncthreads();
        if (tid < 320) { const int r = tid / 64, l = tid % 64; float s = 0.f;
#pragma unroll
            for (int w = 0; w < 8; ++w) s += red[(w * 5 + r) * 64 + l];
            MOD[r * 6144 + it * 64 + l] = s + p.in[I_BADA][it * 64 + l]; }
        __syncthreads();
    }
    float* BINP = (float*)(ws + OFF_BINP);
    for (int i = bid * NTHR + tid; i < 6144; i += nb * NTHR) BINP[i] = p.in[I_BIN][win_srccol(i)];
    if (bid == 0 && tid < 64) ((unsigned*)(ws + OFF_CTL))[tid] = 0u;
}

__device__ __forceinline__ void ph1_norm(const Params& p, int bid, int nb) {
    const int lane = threadIdx.x & 63, wave = threadIdx.x >> 6;
    const float* MOD = (const float*)(p.ws + OFF_MOD);
    f32x4 gm[4];
#pragma unroll
    for (int j = 0; j < 4; ++j) gm[j] = *(const f32x4*)(p.in[I_GMIX] + lane * 4 + 256 * j);
    const int r0 = bid * 8 + wave, rs = nb * 8;
    f32x4 nx[4];
    { const float* src = r0 < NT ? p.in[I_X] + (size_t)r0 * DM : p.in[I_CTX] + (size_t)(r0 - NT) * DM;
#pragma unroll
        for (int j = 0; j < 4; ++j) nx[j] = *(const f32x4*)(src + lane * 4 + 256 * j); }
#pragma unroll 1
    for (int r = r0; r < NT + NCX; r += rs) {
        const bool lat = r < NT;
        bf16_t* dst = lat ? (bf16_t*)(p.ws + OFF_SLOT) + (size_t)r * DM : (bf16_t*)(p.ws + OFF_HC) + (size_t)(r - NT) * DM;
        const float* mrow = MOD + (lat ? r / SEQ : 4) * 6144;
        f32x4 v[4]; float ss = 0.f;
#pragma unroll
        for (int j = 0; j < 4; ++j) { v[j] = nx[j]; const f32x4 sq = v[j] * v[j]; ss += (sq[0] + sq[1]) + (sq[2] + sq[3]); }
        { const int rn = r + rs < NT + NCX ? r + rs : r;
            const float* src = rn < NT ? p.in[I_X] + (size_t)rn * DM : p.in[I_CTX] + (size_t)(rn - NT) * DM;
#pragma unroll
            for (int j = 0; j < 4; ++j) nx[j] = *(const f32x4*)(src + lane * 4 + 256 * j); }
        const float rinv = rsqrtf(wave_sum_dpp(ss) * (1.0f / DM) + 1e-6f);
#pragma unroll
        for (int j = 0; j < 4; ++j) { const int c = lane * 4 + 256 * j;
            const f32x4 sh = *(const f32x4*)(mrow + c), sc = *(const f32x4*)(mrow + 1024 + c);
            const f32x4 o = v[j] * rinv * gm[j] * (1.0f + sc) + sh;
            *(u32x2*)(dst + c) = pk4(o); }
    }
}

struct Unit { int pm, pn, aux, aux2; };

#define LAS __attribute__((address_space(3)))
constexpr int BK = 64, HTB = 128 * BK * 2, STAGE_BYTES = 8 * HTB;
__device__ __forceinline__ int lds_byte(int r, int c) { const int st = (r >> 4) * 2 + (c >> 5), rr = r & 15, cc = c & 31, ob = rr * 64 + cc * 2; return st * 1024 + (ob ^ (((ob >> 9) & 1) << 5)); }
__device__ __forceinline__ void stage_rc(int b, int& R, int& C) { const int st = b / 1024, sb = b % 1024, swz = sb ^ (((sb >> 9) & 1) << 5); R = (st >> 1) * 16 + swz / 64; C = (st & 1) * 32 + (swz % 64) / 2; }

template <bool GATHER, class S, class E>
__device__ __forceinline__ void gemm_phase_pipe(unsigned char* ldsg, const S& sch, const E& epi) {
    LAS unsigned char* lds = (LAS unsigned char*)ldsg;
    const int tid = threadIdx.x, wid = __builtin_amdgcn_readfirstlane(tid >> 6), lane = tid & 63, wr = wid >> 2, wc = wid & 3, fr = lane & 15, fq = lane >> 4;
    const int K = sch.K, nt = K / BK;
    int Rr[2], Cc[2]; unsigned voffA[2], voffB[2];
#pragma unroll
    for (int i = 0; i < 2; ++i) { stage_rc(tid * 16 + i * 8192, Rr[i], Cc[i]); voffA[i] = (unsigned)(Rr[i] * K + Cc[i]) * 2u;
        const int rho = Rr[i] & 31, Rb = (Rr[i] & ~31) + 8 * ((rho & 15) >> 2) + 4 * (rho >> 4) + (rho & 3);
        voffB[i] = (unsigned)(Rb * K + Cc[i]) * 2u; }
    const size_t kstep = (size_t)(BK * 2);
    const size_t hstep = (size_t)128 * K * 2;
    const unsigned ldsw = (unsigned)wid * 1024u;
    const int aoff = lds_byte(wr * 64 + fr, fq * 8), boff = lds_byte(wc * 32 + fr, fq * 8);
#define PG8_SA(b, h) (((b) * 2 + (h)) * HTB)
#define PG8_SB(b, h) ((4 + (b) * 2 + (h)) * HTB)
#define PG8_STAGE_B(bufoff, gbase) do { _Pragma("unroll") for (int _i = 0; _i < 2; ++_i) \
        __builtin_amdgcn_global_load_lds((const unsigned*)((const char*)(gbase) + voffB[_i]), (LAS unsigned*)(lds + (bufoff) + ldsw + _i * 8192), 16, 0, 0); } while (0)
#define PG8_STAGE_A(bufoff, gbase, h, vo) do { _Pragma("unroll") for (int _i = 0; _i < 2; ++_i) \
        __builtin_amdgcn_global_load_lds((const unsigned*)((const char*)(gbase) + (GATHER ? (size_t)(vo)[h][_i] : (size_t)(h) * hstep + voffA[_i])), (LAS unsigned*)(lds + (bufoff) + ldsw + _i * 8192), 16, 0, 0); } while (0)
#define PG8_LDA(dst, b, h) do { _Pragma("unroll") for (int m = 0; m < 4; ++m) _Pragma("unroll") for (int k = 0; k < 2; ++k) dst[m][k] = *(const LAS bf16x8*)(lds + PG8_SA(b, h) + aoff + m * 2048 + k * 1024); } while (0)
#define PG8_LDB(dst, b, h) do { _Pragma("unroll") for (int n = 0; n < 2; ++n) _Pragma("unroll") for (int k = 0; k < 2; ++k) dst[n][k] = *(const LAS bf16x8*)(lds + PG8_SB(b, h) + boff + n * 2048 + k * 1024); } while (0)
#define PG8_MMA(ai, bj, At, Bt) do { __builtin_amdgcn_s_setprio(1); _Pragma("unroll") for (int m = 0; m < 4; ++m) _Pragma("unroll") for (int n = 0; n < 2; ++n) _Pragma("unroll") for (int k = 0; k < 2; ++k) \
        acc[ai][bj][m][n] = __builtin_amdgcn_mfma_f32_16x16x32_bf16(Bt[n][k], At[m][k], acc[ai][bj][m][n], 0, 0, 0); __builtin_amdgcn_s_setprio(0); } while (0)
#define PG8_WAIT_V(n) asm volatile("s_waitcnt vmcnt(" #n ")" ::: "memory")
#define PG8_WAIT_L(n) asm volatile("s_waitcnt lgkmcnt(" #n ")" ::: "memory")
#define PG8_BAR __builtin_amdgcn_s_barrier()
#define PG8_SCHED __builtin_amdgcn_sched_barrier(0)
    Unit cur, nxt; int ui = 0;
    if (!sch.next(0, cur)) return;
    f32x4 acc[2][2][4][2];
#pragma unroll
    for (int a = 0; a < 2; ++a)
#pragma unroll
        for (int b = 0; b < 2; ++b)
#pragma unroll
            for (int m = 0; m < 4; ++m)
#pragma unroll
                for (int n = 0; n < 2; ++n) acc[a][b][m][n] = (f32x4){0.f, 0.f, 0.f, 0.f};
    bf16x8 At[4][2], B0[2][2], B1[2][2];
    unsigned voAc[2][2], voAn[2][2];
#pragma unroll
    for (int h = 0; h < 2; ++h)
#pragma unroll
        for (int i = 0; i < 2; ++i) { voAc[h][i] = GATHER ? sch.aoff(cur, 128 * h + Rr[i]) + (unsigned)Cc[i] * 2u : 0u; voAn[h][i] = voAc[h][i]; }
    const char* cA = sch.abase(cur); const char* cB = sch.bbase(cur);
    PG8_STAGE_B(PG8_SB(0, 0), cB); PG8_STAGE_A(PG8_SA(0, 0), cA, 0, voAc); PG8_STAGE_B(PG8_SB(0, 1), cB + hstep); PG8_STAGE_A(PG8_SA(0, 1), cA, 1, voAc);
    if (wr == 1) PG8_BAR;
    PG8_WAIT_V(4); PG8_BAR;
    PG8_STAGE_B(PG8_SB(1, 0), cB + kstep); PG8_STAGE_A(PG8_SA(1, 0), cA + kstep, 0, voAc); PG8_STAGE_B(PG8_SB(1, 1), cB + hstep + kstep);
    PG8_WAIT_V(6); PG8_BAR;
    for (;;) {
        const bool has_next = sch.next(ui + 1, nxt);
        const char* nA = has_next ? sch.abase(nxt) : cA; const char* nB = has_next ? sch.bbase(nxt) : cB;
        if (GATHER) {
#pragma unroll
            for (int h = 0; h < 2; ++h)
#pragma unroll
                for (int i = 0; i < 2; ++i) voAn[h][i] = has_next ? sch.aoff(nxt, 128 * h + Rr[i]) + (unsigned)Cc[i] * 2u : voAc[h][i];
        }
#pragma unroll 1
        for (int t = 0; t < nt; t += 2) {
            const bool last = (t == nt - 2);
            const char* a1 = cA + (size_t)(t + 1) * kstep;
            const char* a2 = last ? nA : cA + (size_t)(t + 2) * kstep; const char* b2 = last ? nB : cB + (size_t)(t + 2) * kstep;
            const char* a3 = a2 + kstep; const char* b3 = b2 + kstep;
            unsigned vo2[2][2];
#pragma unroll
            for (int h = 0; h < 2; ++h)
#pragma unroll
                for (int i = 0; i < 2; ++i) vo2[h][i] = last ? voAn[h][i] : voAc[h][i];
            PG8_LDB(B0, 0, 0); PG8_SCHED; PG8_LDA(At, 0, 0); PG8_STAGE_A(PG8_SA(1, 1), a1, 1, voAc);
            PG8_WAIT_L(8); PG8_BAR; PG8_WAIT_L(0); PG8_MMA(0, 0, At, B0); PG8_BAR; PG8_SCHED;
            PG8_LDB(B1, 0, 1); PG8_STAGE_B(PG8_SB(0, 0), b2);
            PG8_BAR; PG8_WAIT_L(0); PG8_MMA(0, 1, At, B1); PG8_BAR;
            PG8_LDA(At, 0, 1); PG8_STAGE_A(PG8_SA(0, 0), a2, 0, vo2);
            PG8_BAR; PG8_WAIT_L(0); PG8_MMA(1, 0, At, B0); PG8_BAR; PG8_SCHED;
            PG8_STAGE_B(PG8_SB(0, 1), b2 + hstep);
            PG8_WAIT_V(6); PG8_BAR; PG8_MMA(1, 1, At, B1); PG8_BAR;
            PG8_LDB(B0, 1, 0); PG8_SCHED; PG8_LDA(At, 1, 0); PG8_STAGE_A(PG8_SA(0, 1), a2, 1, vo2);
            PG8_WAIT_L(8); PG8_BAR; PG8_WAIT_L(0); PG8_MMA(0, 0, At, B0); PG8_BAR; PG8_SCHED;
            PG8_LDB(B1, 1, 1); PG8_STAGE_B(PG8_SB(1, 0), b3);
            PG8_BAR; PG8_WAIT_L(0); PG8_MMA(0, 1, At, B1); PG8_BAR;
            PG8_LDA(At, 1, 1); PG8_STAGE_A(PG8_SA(1, 0), a3, 0, vo2);
            PG8_BAR; PG8_WAIT_L(0); PG8_MMA(1, 0, At, B0); PG8_BAR; PG8_SCHED;
            PG8_STAGE_B(PG8_SB(1, 1), b3 + hstep);
            PG8_WAIT_V(6); PG8_BAR; PG8_MMA(1, 1, At, B1); PG8_BAR;
        }
        { int frx = fr, fqx = fq; asm volatile("" : "+v"(frx), "+v"(fqx));
            const int jx = wc * 32 + 8 * fqx, rx = wr * 64 + frx;
            const typename E::Col ecol = epi.col(cur, jx);
            constexpr int PF = E::PF;
            typename E::Pre epre[8];
#pragma unroll
            for (int g = 0; g < PF; ++g) epre[g] = epi.load(cur, (g >> 2) * 128 + (g & 3) * 16 + rx, jx);
#pragma unroll
            for (int g = 0; g < 8; ++g) { const int ai = g >> 2, m = g & 3;
                if (g + PF < 8) epre[g + PF] = epi.load(cur, ((g + PF) >> 2) * 128 + ((g + PF) & 3) * 16 + rx, jx);
                epi.apply(cur, ai * 128 + m * 16 + rx, jx, ecol, epre[g], acc[ai][0][m][0], acc[ai][0][m][1], acc[ai][1][m][0], acc[ai][1][m][1]); } }
        if (!has_next) break;
#pragma unroll
        for (int a = 0; a < 2; ++a)
#pragma unroll
            for (int b = 0; b < 2; ++b)
#pragma unroll
                for (int m = 0; m < 4; ++m)
#pragma unroll
                    for (int n = 0; n < 2; ++n) acc[a][b][m][n] = (f32x4){0.f, 0.f, 0.f, 0.f};
        cur = nxt; cA = nA; cB = nB; ++ui;
#pragma unroll
        for (int h = 0; h < 2; ++h)
#pragma unroll
            for (int i = 0; i < 2; ++i) voAc[h][i] = voAn[h][i];
    }
    PG8_WAIT_V(0);
    if (wr == 0) PG8_BAR;
    PG8_BAR;
#undef PG8_SA
#undef PG8_SB
#undef PG8_STAGE_A
#undef PG8_STAGE_B
#undef PG8_LDA
#undef PG8_LDB
#undef PG8_MMA
#undef PG8_WAIT_V
#undef PG8_WAIT_L
#undef PG8_BAR
#undef PG8_SCHED
}

struct SchG1 { const bf16_t *A, *Bt; int G, c, K;
    __device__ __forceinline__ bool next(int i, Unit& u) const { const int L = i * G + c; if (L >= 128 * 24) return false; u.pm = L / 24; u.pn = L % 24; return true; }
    __device__ __forceinline__ const bf16_t* arow(const Unit& u, int r) const { return A + (size_t)(u.pm * 256 + r) * 1024; }
    __device__ __forceinline__ const bf16_t* brow(const Unit& u, int n) const { return Bt + (size_t)(u.pn * 256 + n) * 1024; }
    __device__ __forceinline__ const char* abase(const Unit& u) const { return (const char*)(A + (size_t)u.pm * 256 * 1024); }
    __device__ __forceinline__ const char* bbase(const Unit& u) const { return (const char*)(Bt + (size_t)u.pn * 256 * 1024); }
    __device__ __forceinline__ unsigned aoff(const Unit&, int) const { return 0u; } };
struct EpiG1 { bf16_t *Z, *GYG, *XR, *SGA, *SGB; const float* bias;
    static constexpr int PF = 1; struct Col { f32x4 c0, c1, c2, c3; }; struct Pre { };
    __device__ __forceinline__ Col col(const Unit& u, int j) const { const float* bp = bias + u.pn * 256 + j; return Col{*(const f32x4*)bp, *(const f32x4*)(bp + 4), *(const f32x4*)(bp + 128), *(const f32x4*)(bp + 132)}; }
    __device__ __forceinline__ Pre load(const Unit&, int, int) const { return Pre{}; }
    __device__ __forceinline__ void apply(const Unit& u, int r, int j, const Col& c, const Pre&, f32x4 a0, f32x4 a1, f32x4 b0, f32x4 b1) const {
        const size_t row = (size_t)u.pm * 256 + r;
        a0 += c.c0; a1 += c.c1; b0 += c.c2; b1 += c.c3;
        if (u.pn < 8) {
#pragma unroll
            for (int e = 0; e < 4; ++e) { a0[e] *= sigm(b0[e]); a1[e] *= sigm(b1[e]); }
            *(u32x4*)(Z + row * 1024 + u.pn * 128 + j) = pk8(a0, a1); }
        else { const int kind = u.pn >> 2;
            bf16_t* dst = GYG + (size_t)(kind - 2) * (SLOT / 2);
#pragma unroll
            for (int e = 0; e < 4; ++e) { if (kind == 2) { a0[e] = gelu_tanh(a0[e]); a1[e] = gelu_tanh(a1[e]); b0[e] = gelu_tanh(b0[e]); b1[e] = gelu_tanh(b1[e]); }
                else if (kind >= 4) { a0[e] = sigm(a0[e]); a1[e] = sigm(a1[e]); b0[e] = sigm(b0[e]); b1[e] = sigm(b1[e]); } }
            bf16_t* o = dst + row * 1024 + (u.pn & 3) * 256 + j;
            *(u32x4*)o = pk8(a0, a1); *(u32x4*)(o + 128) = pk8(b0, b1); }
    } };
struct SchCtx { const bf16_t *A, *Bt; int G, c, K;
    __device__ __forceinline__ bool next(int i, Unit& u) const { const int L = i * G + c; if (L >= 16) return false; u.pm = L / 4; u.pn = L % 4; return true; }
    __device__ __forceinline__ const bf16_t* arow(const Unit& u, int r) const { return A + (size_t)(u.pm * 256 + r) * 1024; }
    __device__ __forceinline__ const bf16_t* brow(const Unit& u, int n) const { return Bt + (size_t)((12 + u.pn) * 256 + n) * 1024; }
    __device__ __forceinline__ const char* abase(const Unit& u) const { return (const char*)(A + (size_t)u.pm * 256 * 1024); }
    __device__ __forceinline__ const char* bbase(const Unit& u) const { return (const char*)(Bt + (size_t)(12 + u.pn) * 256 * 1024); }
    __device__ __forceinline__ unsigned aoff(const Unit&, int) const { return 0u; } };
struct EpiCtx { bf16_t* XRC; const float* bias;
    static constexpr int PF = 1; struct Col { f32x4 c0, c1, c2, c3; }; struct Pre { };
    __device__ __forceinline__ Col col(const Unit& u, int j) const { const float* bp = bias + (12 + u.pn) * 256 + j; return Col{*(const f32x4*)bp, *(const f32x4*)(bp + 4), *(const f32x4*)(bp + 128), *(const f32x4*)(bp + 132)}; }
    __device__ __forceinline__ Pre load(const Unit&, int, int) const { return Pre{}; }
    __device__ __forceinline__ void apply(const Unit& u, int r, int j, const Col& c, const Pre&, f32x4 a0, f32x4 a1, f32x4 b0, f32x4 b1) const {
        const size_t row = (size_t)u.pm * 256 + r;
        a0 += c.c0; a1 += c.c1; b0 += c.c2; b1 += c.c3;
        bf16_t* o = XRC + row * 1024 + u.pn * 256 + j; *(u32x4*)o = pk8(a0, a1); *(u32x4*)(o + 128) = pk8(b0, b1); } };
struct SchG2 { const bf16_t *Aa, *Ab, *Wa, *Wb; int G, c, K;
    __device__ __forceinline__ bool next(int i, Unit& u) const { const int t = (i >> 1) * G + c; if (t >= 512) return false; u.pm = t >> 2; u.pn = t & 3; u.aux = i & 1; return true; }
    __device__ __forceinline__ const bf16_t* arow(const Unit& u, int r) const { return Aa + (size_t)u.aux * (SLOT / 2) + (size_t)(u.pm * 256 + r) * 1024; }
    __device__ __forceinline__ const bf16_t* brow(const Unit& u, int n) const { return Wa + (size_t)u.aux * (1024 * 1024) + (size_t)(u.pn * 256 + n) * 1024; }
    __device__ __forceinline__ const char* abase(const Unit& u) const { return (const char*)(Aa + (size_t)u.aux * (SLOT / 2) + (size_t)u.pm * 256 * 1024); }
    __device__ __forceinline__ const char* bbase(const Unit& u) const { return (const char*)(Wa + (size_t)u.aux * (1024 * 1024) + (size_t)u.pn * 256 * 1024); }
    __device__ __forceinline__ unsigned aoff(const Unit&, int) const { return 0u; } };
struct EpiG2 { const bf16_t *SGA, *SGB; bf16_t* M;
    static constexpr int PF = 2; struct Col { }; struct Pre { u32x4 g0, g1, t0, t1; };
    __device__ __forceinline__ Col col(const Unit&, int) const { return Col{}; }
    __device__ __forceinline__ Pre load(const Unit& u, int r, int j) const {
        const size_t o = ((size_t)u.pm * 256 + r) * 1024 + u.pn * 256 + j; const bf16_t* G = SGA + (size_t)u.aux * (SLOT / 2);
        Pre q; q.g0 = *(const u32x4*)(G + o); q.g1 = *(const u32x4*)(G + o + 128);
        if (u.aux) { q.t0 = *(const u32x4*)(M + o); q.t1 = *(const u32x4*)(M + o + 128); } else { q.t0 = (u32x4){0u, 0u, 0u, 0u}; q.t1 = q.t0; }
        return q; }
    __device__ __forceinline__ void apply(const Unit& u, int r, int j, const Col&, const Pre& q, f32x4 a0, f32x4 a1, f32x4 b0, f32x4 b1) const {
        const size_t o = ((size_t)u.pm * 256 + r) * 1024 + u.pn * 256 + j;
        f32x4 g0, g1, g2, g3, t0, t1, t2, t3; unpk8(q.g0, g0, g1); unpk8(q.g1, g2, g3); unpk8(q.t0, t0, t1); unpk8(q.t1, t2, t3);
        a0 = a0 * g0 + t0; a1 = a1 * g1 + t1; b0 = b0 * g2 + t2; b1 = b1 * g3 + t3;
        *(u32x4*)(M + o) = pk8(a0, a1); *(u32x4*)(M + o + 128) = pk8(b0, b1); } };
struct SchG3 { const bf16_t *A, *Bt; int G, c, K;
    __device__ __forceinline__ bool next(int i, Unit& u) const { const int L = i * G + c; if (L >= 512) return false; u.pm = L >> 2; u.pn = L & 3; return true; }
    __device__ __forceinline__ const bf16_t* arow(const Unit& u, int r) const { return A + (size_t)(u.pm * 256 + r) * 1024; }
    __device__ __forceinline__ const bf16_t* brow(const Unit& u, int n) const { return Bt + (size_t)(u.pn * 256 + n) * 1024; }
    __device__ __forceinline__ const char* abase(const Unit& u) const { return (const char*)(A + (size_t)u.pm * 256 * 1024); }
    __device__ __forceinline__ const char* bbase(const Unit& u) const { return (const char*)(Bt + (size_t)u.pn * 256 * 1024); }
    __device__ __forceinline__ unsigned aoff(const Unit&, int) const { return 0u; } };
struct EpiG3 { const float *X, *MOD; bf16_t* X1B;
    static constexpr int PF = 3; struct Col { f32x4 c0, c1, c2, c3; }; struct Pre { f32x4 x0, x1, x2, x3; };
    __device__ __forceinline__ Col col(const Unit& u, int j) const { const float* gt = MOD + ((u.pm * 256) / SEQ) * 6144 + 2 * 1024 + u.pn * 256 + j; return Col{*(const f32x4*)gt, *(const f32x4*)(gt + 4), *(const f32x4*)(gt + 128), *(const f32x4*)(gt + 132)}; }
    __device__ __forceinline__ Pre load(const Unit& u, int r, int j) const { const float* xp = X + ((size_t)u.pm * 256 + r) * 1024 + u.pn * 256 + j; return Pre{*(const f32x4*)xp, *(const f32x4*)(xp + 4), *(const f32x4*)(xp + 128), *(const f32x4*)(xp + 132)}; }
    __device__ __forceinline__ void apply(const Unit& u, int r, int j, const Col& c, const Pre& q, f32x4 a0, f32x4 a1, f32x4 b0, f32x4 b1) const {
        bf16_t* op = X1B + ((size_t)u.pm * 256 + r) * 1024 + u.pn * 256 + j;
        *(u32x4*)op = pk8(q.x0 + c.c0 * a0, q.x1 + c.c1 * a1); *(u32x4*)(op + 128) = pk8(q.x2 + c.c2 * b0, q.x3 + c.c3 * b1); } };
struct MoeMeta { const int* m;
    __device__ __forceinline__ int cnt(int e) const { return __builtin_amdgcn_readfirstlane(m[e]); }
    __device__ __forceinline__ int tb(int e) const { return __builtin_amdgcn_readfirstlane(m[16 + e]); }
    __device__ __forceinline__ int ntiles() const { return __builtin_amdgcn_readfirstlane(m[32]); }
    __device__ __forceinline__ int find(int mt) const { int e = 0;
#pragma unroll
        for (int k = 1; k < 16; ++k) e += (__builtin_amdgcn_readfirstlane(m[16 + k]) <= mt) ? 1 : 0;
        return e; } };
__device__ __forceinline__ void moe_meta_build(const Params& p, int* meta) {
    if (threadIdx.x == 0) { const unsigned* cnt = (const unsigned*)(p.ws + OFF_CTL); int t = 0;
        for (int e = 0; e < 16; ++e) { const int c = (int)__hip_atomic_load(cnt + e, __ATOMIC_RELAXED, __HIP_MEMORY_SCOPE_AGENT); meta[e] = c; meta[16 + e] = t; t += (c + 255) >> 8; }
        meta[32] = t; }
    __syncthreads();
}
struct SchUp { const bf16_t *HM, *W; const int* LIST; MoeMeta mm; int G, c, K; const int* idx;
    __device__ __forceinline__ bool next(int i, Unit& u) const { const int L = i * G + c; if (L >= 4 * mm.ntiles()) return false; const int mt = L >> 2; u.pn = L & 3; u.aux = mm.find(mt); u.aux2 = (mt - mm.tb(u.aux)) * 256; u.pm = mt | (i << 16); return true; }
    __device__ __forceinline__ const char* abase(const Unit&) const { return (const char*)HM; }
    __device__ __forceinline__ const char* bbase(const Unit& u) const { return (const char*)(W + ((size_t)u.aux * 1024 + u.pn * 256) * 1024); }
    __device__ __forceinline__ unsigned aoff(const Unit& u, int r) const { return (unsigned)idx[(u.pm >> 16) * 256 + r] * 2048u; }
    __device__ __forceinline__ const bf16_t* arow(const Unit& u, int r) const { int pos = u.aux2 + r; const int c = mm.cnt(u.aux); pos = pos < c ? pos : c - 1; return HM + (size_t)LIST[u.aux * NT + pos] * 1024; }
    __device__ __forceinline__ const bf16_t* brow(const Unit& u, int n) const { return W + ((size_t)u.aux * 1024 + u.pn * 256 + n) * 1024; } };
struct EpiUp { bf16_t* ACT; const float* WL; MoeMeta mm;
    static constexpr int PF = 2; struct Col { }; struct Pre { float wt; };
    __device__ __forceinline__ Col col(const Unit&, int) const { return Col{}; }
    __device__ __forceinline__ Pre load(const Unit& u, int r, int) const { const int pos = u.aux2 + r; return Pre{pos < mm.cnt(u.aux) ? WL[u.aux * NT + pos] : 0.f}; }
    __device__ __forceinline__ void apply(const Unit& u, int r, int j, const Col&, const Pre& q, f32x4 g0, f32x4 g1, f32x4 u0, f32x4 u1) const {
        if (u.aux2 + r >= mm.cnt(u.aux)) return;
#pragma unroll
        for (int e = 0; e < 4; ++e) { g0[e] = silu(g0[e]) * u0[e] * q.wt; g1[e] = silu(g1[e]) * u1[e] * q.wt; }
        *(u32x4*)(ACT + ((size_t)(u.pm & 0xffff) * 256 + r) * 512 + u.pn * 128 + j) = pk8(g0, g1); } };
struct SchDn { const bf16_t *ACT, *W; MoeMeta mm; int G, c, K;
    __device__ __forceinline__ bool next(int i, Unit& u) const { const int L = i * G + c; if (L >= 4 * mm.ntiles()) return false; const int mt = L >> 2; u.pn = L & 3; u.aux = mm.find(mt); u.aux2 = (mt - mm.tb(u.aux)) * 256; u.pm = mt; return true; }
    __device__ __forceinline__ const bf16_t* arow(const Unit& u, int r) const { return ACT + ((size_t)u.pm * 256 + r) * 512; }
    __device__ __forceinline__ const bf16_t* brow(const Unit& u, int n) const { return W + ((size_t)u.aux * 1024 + u.pn * 256 + n) * 512; }
    __device__ __forceinline__ const char* abase(const Unit& u) const { return (const char*)(ACT + (size_t)u.pm * 256 * 512); }
    __device__ __forceinline__ const char* bbase(const Unit& u) const { return (const char*)(W + ((size_t)u.aux * 1024 + u.pn * 256) * 512); }
    __device__ __forceinline__ unsigned aoff(const Unit&, int) const { return 0u; } };
struct EpiDn { bf16_t* Y; MoeMeta mm;
    static constexpr int PF = 1; struct Col { }; struct Pre { };
    __device__ __forceinline__ Col col(const Unit&, int) const { return Col{}; }
    __device__ __forceinline__ Pre load(const Unit&, int, int) const { return Pre{}; }
    __device__ __forceinline__ void apply(const Unit& u, int r, int j, const Col&, const Pre&, f32x4 a0, f32x4 a1, f32x4 b0, f32x4 b1) const {
        if (u.aux2 + r >= mm.cnt(u.aux)) return;
        bf16_t* o = Y + ((size_t)u.pm * 256 + r) * 1024 + u.pn * 256 + j; *(u32x4*)o = pk8(a0, a1); *(u32x4*)(o + 128) = pk8(b0, b1); } };

__device__ __forceinline__ void aprep_item(const Params& p, int g, unsigned char* lds) {
    const int tid = threadIdx.x, lane = tid & 63, wave = tid >> 6;
    const bf16_t* Z = (const bf16_t*)(p.ws + OFF_SLOT + 1 * SLOT);
    bf16_t* AA = (bf16_t*)(p.ws + OFF_SLOT + 0 * SLOT) + (size_t)g * 64 * 1024;
    const unsigned* zt = (const unsigned*)lds;
    { const u32x4* src = (const u32x4*)(Z + (size_t)g * 64 * 1024); u32x4* d = (u32x4*)lds;
        u32x4 tmp[16];
#pragma unroll
        for (int i = 0; i < 16; ++i) tmp[i] = src[tid + i * NTHR];
#pragma unroll
        for (int i = 0; i < 16; ++i) d[tid + i * NTHR] = tmp[i]; }
    __syncthreads();
    {
        f32x2 w[31];
        const float* cw = p.in[I_CONVW] + 2 * tid;
#pragma unroll
        for (int k = 0; k < 31; ++k) w[k] = *(const f32x2*)(cw + k * 1024);
        const f32x2 cb = *(const f32x2*)(p.in[I_CONVB] + 2 * tid);
#pragma unroll 1
        for (int tb = 0; tb < 4; ++tb) {
            f32x2 cz[16];
#pragma unroll
            for (int o = 0; o < 16; ++o) cz[o] = cb;
#pragma unroll
            for (int r0 = 0; r0 < 48; r0 += 8) {
                unsigned vv[8];
#pragma unroll
                for (int rr = 0; rr < 8; ++rr) if (r0 + rr < 46) { const int row = 16 * tb - 15 + r0 + rr; const bool ok = (unsigned)row < 64u; const unsigned t = zt[(ok ? row : 0) * 512 + tid]; vv[rr] = ok ? t : 0u; }
#pragma unroll
                for (int rr = 0; rr < 8; ++rr) { const int r = r0 + rr;
                    if (r < 46) { const f32x2 x = (f32x2){bflo(vv[rr]), bfhi(vv[rr])};
#pragma unroll
                        for (int o = 0; o < 16; ++o) { const int k = r - o; if (k >= 0 && k < 31) cz[o] += w[k] * x; } } }
            }
#pragma unroll
            for (int o = 0; o < 16; ++o) *(unsigned*)(AA + (size_t)(16 * tb + o) * 1024 + 2 * tid) = pk2(cz[o].x, cz[o].y);
        }
    }
    asm volatile("s_waitcnt vmcnt(0)" ::: "memory");
    __syncthreads();
    u32x4 ra[8], rb[8];
#pragma unroll
    for (int rr = 0; rr < 8; ++rr) { const bf16_t* rp = AA + (size_t)(wave * 8 + rr) * 1024 + lane * 8; ra[rr] = *(const u32x4*)rp; rb[rr] = *(const u32x4*)(rp + 512); }
    f32x4 lg0[2], lg1[2], lb0[2], lb1[2];
#pragma unroll
    for (int hh = 0; hh < 2; ++hh) { const int c0 = hh * 512 + lane * 8;
        lg0[hh] = *(const f32x4*)(p.in[I_LNG] + c0); lg1[hh] = *(const f32x4*)(p.in[I_LNG] + c0 + 4); lb0[hh] = *(const f32x4*)(p.in[I_LNB] + c0); lb1[hh] = *(const f32x4*)(p.in[I_LNB] + c0 + 4); }
#pragma unroll
    for (int rr = 0; rr < 8; ++rr) {
        const int row = wave * 8 + rr;
        f32x4 x0, x1, x2, x3; unpk8(ra[rr], x0, x1); unpk8(rb[rr], x2, x3);
        const f32x4 sv = (x0 + x1) + (x2 + x3);
        const float mean = wave_sum((sv[0] + sv[1]) + (sv[2] + sv[3])) * (1.0f / 1024.0f);
        x0 -= mean; x1 -= mean; x2 -= mean; x3 -= mean;
        const f32x4 qv = (x0 * x0 + x1 * x1) + (x2 * x2 + x3 * x3);
        const float rstd = rsqrtf(wave_sum((qv[0] + qv[1]) + (qv[2] + qv[3])) * (1.0f / 1024.0f) + 1e-6f);
        x0 = x0 * rstd * lg0[0] + lb0[0]; x1 = x1 * rstd * lg1[0] + lb1[0]; x2 = x2 * rstd * lg0[1] + lb0[1]; x3 = x3 * rstd * lg1[1] + lb1[1];
#pragma unroll
        for (int e = 0; e < 4; ++e) { x0[e] = silu(x0[e]); x1[e] = silu(x1[e]); x2[e] = silu(x2[e]); x3[e] = silu(x3[e]); }
        bf16_t* o = AA + (size_t)row * 1024 + lane * 8;
        *(u32x4*)o = pk8(x0, x1); *(u32x4*)(o + 512) = pk8(x2, x3);
    }
    __syncthreads();
}

constexpr int XC_STRIDE = 272;
constexpr int YB_STRIDE = 132;
constexpr int B_XC_OFF = 0, B_HIN_OFF = 256 * XC_STRIDE  , B_Y_OFF = B_HIN_OFF + 4096  , B_Y_BYTES = 64 * YB_STRIDE * 4  ;
constexpr size_t OFF_TOT256 = OFF_TOT + 9 * MiB;

__device__ __forceinline__ void lru_coef(float lr2, float li2, float nsp2, float xcv, float& a, float& b) {
    const float r = __builtin_amdgcn_rcpf(1.0f + __builtin_amdgcn_exp2f(lr2));
    a = __builtin_amdgcn_exp2f(nsp2 * r);
    const float v = fmaxf(__builtin_fmaf(-a, a, 1.0f), 1e-30f);
    const float d = 1.0f + __builtin_amdgcn_exp2f(li2);
    b = (v * __builtin_amdgcn_rsqf(v * d * d)) * xcv;
}

template <bool FINAL, int DIR>
__device__ __forceinline__ void lru_dir(const unsigned char* xcs, const bf16x8 (&fbr)[4], const bf16x8 (&fbi)[4], float br, float bi, float nsp, int fr, int q, int chl,
                                        float hin_v, f32x4 (&hout)[4], float& totA, float& totB) {
    f32x4 ar[4], ai[4];
#pragma unroll
    for (int m = 0; m < 4; ++m) { ar[m] = (f32x4){0.f, 0.f, 0.f, 0.f}; ai[m] = (f32x4){0.f, 0.f, 0.f, 0.f}; }
#pragma unroll
    for (int kk = 0; kk < 4; ++kk) {
#pragma unroll
        for (int m = 0; m < 4; ++m) { const bf16x8 fa = *(const bf16x8*)(xcs + (16 * m + fr) * XC_STRIDE + (32 * kk + 8 * q) * 2);
            ar[m] = __builtin_amdgcn_mfma_f32_16x16x32_bf16(fa, fbr[kk], ar[m], 0, 0, 0);
            ai[m] = __builtin_amdgcn_mfma_f32_16x16x32_bf16(fa, fbi[kk], ai[m], 0, 0, 0); }
    }
#pragma unroll
    for (int m = 0; m < 4; ++m)
#pragma unroll
        for (int i = 0; i < 4; ++i) {
            const float xcv = bf2f(*(const bf16_t*)(xcs + (16 * m + 4 * q + i) * XC_STRIDE + chl * 2));
            float a, b; lru_coef(ar[m][i] + br, ai[m][i] + bi, nsp, xcv, a, b); ar[m][i] = a; ai[m][i] = b;
        }
    float At[4], Bt[4], Ae[4], Be[4];
#pragma unroll
    for (int m = 0; m < 4; ++m) {
        float A = 1.f, B = 0.f;
#pragma unroll
        for (int ii = 0; ii < 4; ++ii) { const int i = DIR ? 3 - ii : ii; B = ar[m][i] * B + ai[m][i]; A = ar[m][i] * A; }
        if (DIR == 0) {
            float tA = __shfl_up(A, 16), tB = __shfl_up(B, 16); if (q >= 1) { B = A * tB + B; A = A * tA; }
            tA = __shfl_up(A, 32); tB = __shfl_up(B, 32); if (q >= 2) { B = A * tB + B; A = A * tA; }
            Ae[m] = __shfl_up(A, 16); Be[m] = __shfl_up(B, 16); if (q == 0) { Ae[m] = 1.f; Be[m] = 0.f; }
            At[m] = __shfl(A, 48 + fr); Bt[m] = __shfl(B, 48 + fr);
        } else {
            float tA = __shfl_down(A, 16), tB = __shfl_down(B, 16); if (q <= 2) { B = A * tB + B; A = A * tA; }
            tA = __shfl_down(A, 32); tB = __shfl_down(B, 32); if (q <= 1) { B = A * tB + B; A = A * tA; }
            Ae[m] = __shfl_down(A, 16); Be[m] = __shfl_down(B, 16); if (q == 3) { Ae[m] = 1.f; Be[m] = 0.f; }
            At[m] = __shfl(A, fr); Bt[m] = __shfl(B, fr);
        }
    }
    if (!FINAL) {
        float A = 1.f, B = 0.f;
#pragma unroll
        for (int mm = 0; mm < 4; ++mm) { const int m = DIR ? 3 - mm : mm; B = At[m] * B + Bt[m]; A = At[m] * A; }
        totA = A; totB = B;
    } else {
        float hh = hin_v;
#pragma unroll
        for (int mm = 0; mm < 4; ++mm) { const int m = DIR ? 3 - mm : mm;
            float hs = Ae[m] * hh + Be[m];
#pragma unroll
            for (int ii = 0; ii < 4; ++ii) { const int i = DIR ? 3 - ii : ii; hs = ar[m][i] * hs + ai[m][i]; hout[m][i] = hs; }
            hh = At[m] * hh + Bt[m];
        }
    }
}

template <bool FINAL>
__device__ __forceinline__ void b_phase(const Params& p, int bid, int nb, unsigned char* lds) {
    const int tid = threadIdx.x, lane = tid & 63, wave = tid >> 6, fr = lane & 15, q = lane >> 4;
    f32x2* TOT = (f32x2*)(p.ws + OFF_TOT);
    f32x2* TOT256 = (f32x2*)(p.ws + OFF_TOT256);
    const bf16_t* WG = (const bf16_t*)(p.ws + OFF_WG);
    float* hin = (float*)(lds + B_HIN_OFF);
    const int chl = 16 * wave + fr;
    const int nitems = FINAL ? 1024 : 1024 + 128;
    int hprev = -1;
    bf16x8 fb[4][4];
    float* cst = (float*)(lds + B_Y_OFF + 2 * B_Y_BYTES);
    for (int it = bid; it < nitems; it += nb) {
        const bool isctx = it >= 1024;
        const int b = isctx ? (it - 1024) >> 5 : it >> 8, c256 = isctx ? -1 : (it >> 3) & 31, h = it & 7, csub = (it >> 3) & 3;
        const int seqlen = isctx ? CTXL : SEQ, sbase = isctx ? 0 : c256 * 256;
        const bf16_t* src = isctx ? (const bf16_t*)(p.ws + OFF_XRC) + (size_t)b * CTXL * 1024 : (const bf16_t*)(p.ws + OFF_SLOT + 3 * SLOT) + (size_t)b * SEQ * 1024;
        const int kc0 = isctx ? 0 : 4 + c256 * 4, k256 = isctx ? 0 : 1 + c256;
        const int ch = h * 128 + chl;
        if (h != hprev) {
            hprev = h;
#pragma unroll
            for (int ty = 0; ty < 4; ++ty)
#pragma unroll
                for (int kk = 0; kk < 4; ++kk) fb[ty][kk] = *(const bf16x8*)(WG + (size_t)(h * 512 + wave * 64 + ty * 16 + fr) * 128 + 32 * kk + 8 * q);
            if (q == 0) { const float L2E = 1.4426950408889634f;
                          cst[0 * 128 + chl] = -L2E * p.in[I_BRF][ch]; cst[1 * 128 + chl] = -L2E * p.in[I_BIF][ch]; cst[2 * 128 + chl] = -8.0f * L2E * log1pf(__expf(-p.in[I_LAMF][ch]));
                          cst[3 * 128 + chl] = -L2E * p.in[I_BRB][ch]; cst[4 * 128 + chl] = -L2E * p.in[I_BIB][ch]; cst[5 * 128 + chl] = -8.0f * L2E * log1pf(__expf(-p.in[I_LAMB][ch])); }
            wave_lds_sync();
        }
        float runAf = 1.f, runBf = 0.f, runAb = 1.f, runBb = 0.f;
        {
            const int cgp = tid & 15, c0 = h * 128 + 8 * cgp;
            float wk[4][8], bs[8];
            { const f32x4* bp = (const f32x4*)(p.in[I_LCB] + c0); const f32x4 t0_ = bp[0], t1_ = bp[1];
                bs[0] = t0_[0]; bs[1] = t0_[1]; bs[2] = t0_[2]; bs[3] = t0_[3]; bs[4] = t1_[0]; bs[5] = t1_[1]; bs[6] = t1_[2]; bs[7] = t1_[3];
#pragma unroll
                for (int k = 0; k < 4; ++k) { const f32x4* wp = (const f32x4*)(p.in[I_LCW] + k * 1024 + c0); const f32x4 w0 = wp[0], w1 = wp[1];
                    wk[k][0] = w0[0]; wk[k][1] = w0[1]; wk[k][2] = w0[2]; wk[k][3] = w0[3]; wk[k][4] = w1[0]; wk[k][5] = w1[1]; wk[k][6] = w1[2]; wk[k][7] = w1[3]; } }
#pragma unroll 1
            for (int ps = 0; ps < (isctx ? 1 : 2); ++ps) {
                if (isctx && tid >= 256) break;
                const int tq = isctx ? csub * 64 + (tid >> 4) * 4 : ps * 128 + (tid >> 4) * 4;
                float xc[4][8];
#pragma unroll
                for (int r = 0; r < 4; ++r)
#pragma unroll
                    for (int e = 0; e < 8; ++e) xc[r][e] = bs[e];
#pragma unroll
                for (int rr = 0; rr < 7; ++rr) {
                    const int row = sbase + tq + rr - 2;
                    u32x4 a = (u32x4){0u, 0u, 0u, 0u};
                    if (row >= 0 && row < seqlen) a = *(const u32x4*)(src + (size_t)row * 1024 + c0);
                    const float x[8] = {bflo(a.x), bfhi(a.x), bflo(a.y), bfhi(a.y), bflo(a.z), bfhi(a.z), bflo(a.w), bfhi(a.w)};
#pragma unroll
                    for (int r = 0; r < 4; ++r) { const int k = rr - r;
                        if (k >= 0 && k < 4) {
#pragma unroll
                            for (int e = 0; e < 8; ++e) xc[r][e] += wk[k][e] * x[e]; } }
                }
#pragma unroll
                for (int r = 0; r < 4; ++r) {
                    u32x4 o0; o0.x = pk2(xc[r][0], xc[r][1]); o0.y = pk2(xc[r][2], xc[r][3]); o0.z = pk2(xc[r][4], xc[r][5]); o0.w = pk2(xc[r][6], xc[r][7]);
                    *(u32x4*)(lds + B_XC_OFF + (tq + r) * XC_STRIDE + cgp * 16) = o0;
                }
            }
        }
        f32x2 ct[33], cs[4];
        const int cdir = (tid >> 7) & 1, ccl = tid & 127;
        if (FINAL && tid < 256) {
            const f32x2* T2 = TOT256 + ((size_t)b * 33 * 2 + cdir) * 1024 + h * 128 + ccl;
            const f32x2* T = TOT + ((size_t)b * NCH64 * 2 + cdir) * 1024 + h * 128 + ccl;
#pragma unroll
            for (int k = 1; k < 33; ++k) { const bool use = cdir == 0 ? (k < k256) : (k > k256); ct[k] = use ? T2[(size_t)k * 2048] : (f32x2){1.f, 0.f}; }
            { f32x2 c4[4];
#pragma unroll
                for (int s_ = 0; s_ < 4; ++s_) c4[s_] = T[(size_t)s_ * 2048];
                float A = 1.f, B = 0.f;
#pragma unroll
                for (int s_ = 0; s_ < 4; ++s_) { const f32x2 t = cdir == 0 ? c4[s_] : c4[3 - s_]; B = t.x * B + t.y; A = t.x * A; }
                ct[0] = (f32x2){A, B}; }
#pragma unroll
            for (int s_ = 0; s_ < 4; ++s_) cs[s_] = T[(size_t)(kc0 + s_) * 2048];
        }
        if (FINAL && tid < 256) {
            float hc = 0.f;
            if (cdir == 0) {
#pragma unroll
                for (int k = 0; k < 33; ++k) hc = ct[k].x * hc + ct[k].y;
#pragma unroll
                for (int s_ = 0; s_ < 4; ++s_) { hin[(s_ * 2 + 0) * 128 + ccl] = hc; hc = cs[s_].x * hc + cs[s_].y; }
            } else {
                hc = ct[0].y;
#pragma unroll
                for (int k = 32; k >= 1; --k) hc = ct[k].x * hc + ct[k].y;
#pragma unroll
                for (int s_ = 3; s_ >= 0; --s_) { hin[(s_ * 2 + 1) * 128 + ccl] = hc; hc = cs[s_].x * hc + cs[s_].y; }
            }
        }
        __syncthreads();
        for (int sub = isctx ? csub : 0; sub < (isctx ? csub + 1 : 4); ++sub) {
            const int t0 = sbase + 64 * sub;
            const unsigned char* xcs = lds + B_XC_OFF + 64 * sub * XC_STRIDE;
            float* ybuf = (float*)(lds + B_Y_OFF + (sub & 1) * B_Y_BYTES);
            const int ot = tid >> 3, oc = (tid & 7) * 16;
            f32x4 hf[4], hb[4]; float tA, tB;
            lru_dir<FINAL, 0>(xcs, fb[0], fb[1], cst[0 * 128 + chl], cst[1 * 128 + chl], cst[2 * 128 + chl], fr, q, chl, FINAL ? hin[(sub * 2 + 0) * 128 + chl] : 0.f, hf, tA, tB);
            if (!FINAL) { if (q == 0) TOT[((size_t)(b * NCH64 + kc0 + sub) * 2 + 0) * 1024 + ch] = (f32x2){tA, tB};
                runBf = tA * runBf + tB; runAf = tA * runAf; }
            u32x4 gy0, gy1;
            if (FINAL) { const bf16_t* GYG = (const bf16_t*)(p.ws + OFF_SLOT + 2 * SLOT) + ((size_t)b * SEQ + t0 + ot) * 1024 + h * 128 + oc;
                gy0 = *(const u32x4*)GYG; gy1 = *(const u32x4*)(GYG + 8); }
            lru_dir<FINAL, 1>(xcs, fb[2], fb[3], cst[3 * 128 + chl], cst[4 * 128 + chl], cst[5 * 128 + chl], fr, q, chl, FINAL ? hin[(sub * 2 + 1) * 128 + chl] : 0.f, hb, tA, tB);
            if (!FINAL) { if (q == 0) TOT[((size_t)(b * NCH64 + kc0 + sub) * 2 + 1) * 1024 + ch] = (f32x2){tA, tB};
                runBb = runAb * tB + runBb; runAb = runAb * tA; }
            if (FINAL) {
#pragma unroll
                for (int m = 0; m < 4; ++m)
#pragma unroll
                    for (int i = 0; i < 4; ++i) ybuf[(16 * m + 4 * q + i) * YB_STRIDE + chl] = hf[m][i] + hb[m][i];
                __syncthreads();
                const f32x4* yp = (const f32x4*)(ybuf + ot * YB_STRIDE + oc);
                const f32x4 y0 = yp[0], y1 = yp[1], y2 = yp[2], y3 = yp[3];
                u32x4 o0, o1;
                o0.x = pk2(bflo(gy0.x) * y0[0], bfhi(gy0.x) * y0[1]); o0.y = pk2(bflo(gy0.y) * y0[2], bfhi(gy0.y) * y0[3]);
                o0.z = pk2(bflo(gy0.z) * y1[0], bfhi(gy0.z) * y1[1]); o0.w = pk2(bflo(gy0.w) * y1[2], bfhi(gy0.w) * y1[3]);
                o1.x = pk2(bflo(gy1.x) * y2[0], bfhi(gy1.x) * y2[1]); o1.y = pk2(bflo(gy1.y) * y2[2], bfhi(gy1.y) * y2[3]);
                o1.z = pk2(bflo(gy1.z) * y3[0], bfhi(gy1.z) * y3[1]); o1.w = pk2(bflo(gy1.w) * y3[2], bfhi(gy1.w) * y3[3]);
                bf16_t* AB = (bf16_t*)(p.ws + OFF_SLOT + 1 * SLOT) + ((size_t)b * SEQ + t0 + ot) * 1024 + h * 128 + oc;
                *(u32x4*)AB = o0; *(u32x4*)(AB + 8) = o1;
            }
        }
        __syncthreads();
        if (!FINAL && q == 0 && !isctx) {
            TOT256[((size_t)(b * 33 + k256) * 2 + 0) * 1024 + ch] = (f32x2){runAf, runBf};
            TOT256[((size_t)(b * 33 + k256) * 2 + 1) * 1024 + ch] = (f32x2){runAb, runBb};
        }
    }
}

__device__ __forceinline__ void ph8_route(const Params& p, int bid, int nb, unsigned char* lds) {
    constexpr int NU = 1;
    const int tid = threadIdx.x, lane = tid & 63, wave = tid >> 6;
    float* Wl = (float*)lds;
    int* lcnt = (int*)(lds + 81920);
    int* lbase = lcnt + 16;
    int* tinfo = lcnt + 32;
    float* twt = (float*)(tinfo + 512);
#pragma unroll 1
    for (int kk = 0; kk < 2; ++kk) { const int k = tid + kk * NTHR;
        const f32x4 wg = *(const f32x4*)(p.in[I_WGRP] + k * 4);
        Wl[0 * 1024 + k] = wg[0]; Wl[1 * 1024 + k] = wg[1]; Wl[2 * 1024 + k] = wg[2]; Wl[3 * 1024 + k] = wg[3];
#pragma unroll
        for (int o4 = 0; o4 < 4; ++o4) { const f32x4 we = *(const f32x4*)(p.in[I_WER] + k * 16 + o4 * 4);
            Wl[(4 + o4 * 4 + 0) * 1024 + k] = we[0]; Wl[(4 + o4 * 4 + 1) * 1024 + k] = we[1]; Wl[(4 + o4 * 4 + 2) * 1024 + k] = we[2]; Wl[(4 + o4 * 4 + 3) * 1024 + k] = we[3]; } }
    __syncthreads();
    const float* MOD = (const float*)(p.ws + OFF_MOD);
    const bf16_t* X1B = (const bf16_t*)(p.ws + OFF_SLOT + 5 * SLOT);
    bf16_t* HM = (bf16_t*)(p.ws + OFF_SLOT + 2 * SLOT);
    unsigned* gcnt = (unsigned*)(p.ws + OFF_CTL);
    int* LIST = (int*)(p.ws + OFF_LIST); float* WLs = (float*)(p.ws + OFF_WL); int* ROUTE = (int*)(p.ws + OFF_ROUTE);
    float* bl = (float*)(lds + 81920 + 8192);
    if (tid < 20) bl[tid] = tid < 4 ? p.in[I_BGRP][tid] : p.in[I_BER][tid - 4];
    __syncthreads();
    for (int tile = bid; tile < NT / 128; tile += nb) {
        if (tid < 16) lcnt[tid] = 0;
        __syncthreads();
        const float* mrow = MOD + ((tile * 128) / SEQ) * 6144;
        f32x4 gq[4], shq[4], scq[4];
#pragma unroll
        for (int j = 0; j < 4; ++j) { const int c = lane * 4 + 256 * j; gq[j] = *(const f32x4*)(p.in[I_GFFN] + c); shq[j] = *(const f32x4*)(mrow + 3 * 1024 + c); scq[j] = *(const f32x4*)(mrow + 4 * 1024 + c); gq[j] = gq[j] * (1.0f + scq[j]); }
        u32x2 nx[4];
#pragma unroll
        for (int j = 0; j < 4; ++j) nx[j] = *(const u32x2*)(X1B + (size_t)(tile * 128 + wave * 16) * DM + lane * 4 + 256 * j);
#pragma unroll 1
        for (int tt = 0; tt < 16; tt += NU) {
            const int tl = wave * 16 + tt, tok = tile * 128 + tl;
            f32x4 v[NU][4]; float ss[NU];
#pragma unroll
            for (int u = 0; u < NU; ++u) ss[u] = 0.f;
#pragma unroll
            for (int j = 0; j < 4; ++j) { v[0][j] = (f32x4){bflo(nx[j].x), bfhi(nx[j].x), bflo(nx[j].y), bfhi(nx[j].y)}; const f32x4 sq = v[0][j] * v[0][j]; ss[0] += (sq[0] + sq[1]) + (sq[2] + sq[3]); }
            { const int tn = tt + 1 < 16 ? tok + 1 : tok;
#pragma unroll
                for (int j = 0; j < 4; ++j) nx[j] = *(const u32x2*)(X1B + (size_t)tn * DM + lane * 4 + 256 * j); }
            float lg[NU][20];
#pragma unroll
            for (int u = 0; u < NU; ++u) { const float rinv = rsqrtf(wave_sum_dpp(ss[u]) * (1.0f / DM) + 1e-6f);
#pragma unroll
                for (int j = 0; j < 4; ++j) { v[u][j] = v[u][j] * rinv * gq[j] + shq[j]; *(u32x2*)(HM + (size_t)(tok + u) * DM + lane * 4 + 256 * j) = pk4(v[u][j]); }
}
#pragma unroll
            for (int o = 0; o < 20; ++o)
            { f32x4 wv[4];
#pragma unroll
                for (int j = 0; j < 4; ++j) wv[j] = *(const f32x4*)(Wl + o * 1024 + lane * 4 + 256 * j);
#pragma unroll
                for (int u = 0; u < NU; ++u) { f32x4 pr = v[u][0] * wv[0]; pr += v[u][1] * wv[1]; pr += v[u][2] * wv[2]; pr += v[u][3] * wv[3]; lg[u][o] = (pr[0] + pr[1]) + (pr[2] + pr[3]); }
                if ((o & 3) == 3) asm volatile("" ::: "memory"); }
#pragma unroll
            for (int u = 0; u < NU; ++u) {
#pragma unroll
                for (int o = 0; o < 20; ++o) lg[u][o] = wave_sum_dpp(lg[u][o]) + bl[o];
                int gs = 0; float gm = lg[u][0];
#pragma unroll
                for (int o = 1; o < 4; ++o) if (lg[u][o] > gm) { gm = lg[u][o]; gs = o; }
                float den = 0.f;
#pragma unroll
                for (int o = 0; o < 4; ++o) den += __expf(lg[u][o] - gm);
                const float pg = 1.0f / den;
                float el[4];
#pragma unroll
                for (int o = 0; o < 4; ++o) el[o] = gs == 0 ? lg[u][4 + o] : gs == 1 ? lg[u][8 + o] : gs == 2 ? lg[u][12 + o] : lg[u][16 + o];
                int i1 = 0; float v1 = el[0];
#pragma unroll
                for (int o = 1; o < 4; ++o) if (el[o] > v1) { v1 = el[o]; i1 = o; }
                int i2 = -1; float v2 = -3.0e38f;
#pragma unroll
                for (int o = 0; o < 4; ++o) if (o != i1 && el[o] > v2) { v2 = el[o]; i2 = o; }
                const float w1 = 1.0f / (1.0f + __expf(v2 - v1)), w2 = 1.0f - w1;
                if (lane == 0) { const int e1 = gs * 4 + i1, e2 = gs * 4 + i2;
                    const int r1 = atomicAdd(&lcnt[e1], 1), r2 = atomicAdd(&lcnt[e2], 1);
                    tinfo[(tl + u) * 4 + 0] = e1; tinfo[(tl + u) * 4 + 1] = r1; tinfo[(tl + u) * 4 + 2] = e2; tinfo[(tl + u) * 4 + 3] = r2; twt[(tl + u) * 2] = pg * w1; twt[(tl + u) * 2 + 1] = pg * w2; }
            }
        }
        __syncthreads();
        if (tid < 16) lbase[tid] = (int)__hip_atomic_fetch_add(gcnt + tid, (unsigned)lcnt[tid], __ATOMIC_RELAXED, __HIP_MEMORY_SCOPE_AGENT);
        __syncthreads();
        if (tid < 128) { const int tok = tile * 128 + tid;
            const int e1 = tinfo[tid * 4], e2 = tinfo[tid * 4 + 2], p1 = lbase[e1] + tinfo[tid * 4 + 1], p2 = lbase[e2] + tinfo[tid * 4 + 3];
            LIST[e1 * NT + p1] = tok; LIST[e2 * NT + p2] = tok; WLs[e1 * NT + p1] = twt[tid * 2]; WLs[e2 * NT + p2] = twt[tid * 2 + 1];
            ROUTE[tok * 4 + 0] = e1; ROUTE[tok * 4 + 1] = p1; ROUTE[tok * 4 + 2] = e2; ROUTE[tok * 4 + 3] = p2; }
        __syncthreads();
    }
}

__device__ __forceinline__ void ph10_final(const Params& p, int bid, int nb, const int* meta) {
    const int lane = threadIdx.x & 63, wave = threadIdx.x >> 6;
    const float* MOD = (const float*)(p.ws + OFF_MOD);
    const bf16_t* Y = (const bf16_t*)(p.ws + OFF_SLOT);
    const int* ROUTE = (const int*)(p.ws + OFF_ROUTE);
    const bf16_t* X1B = (const bf16_t*)(p.ws + OFF_SLOT + 5 * SLOT); float* OUT = p.out;
    for (int r = bid * 8 + wave; r < NT; r += nb * 8) {
        const int e1 = ROUTE[r * 4], p1 = ROUTE[r * 4 + 1], e2 = ROUTE[r * 4 + 2], p2 = ROUTE[r * 4 + 3];
        const bf16_t* y1 = Y + ((size_t)meta[16 + e1] * 256 + p1) * 1024; const bf16_t* y2 = Y + ((size_t)meta[16 + e2] * 256 + p2) * 1024;
        const float* gt = MOD + (r / SEQ) * 6144 + 5 * 1024;
        f32x4 v[4]; float ss = 0.f;
#pragma unroll
        for (int j = 0; j < 4; ++j) { const int c = lane * 4 + 256 * j;
            { const u32x2 xb = *(const u32x2*)(X1B + (size_t)r * DM + c); v[j] = (f32x4){bflo(xb.x), bfhi(xb.x), bflo(xb.y), bfhi(xb.y)}; }
            const u32x2 a = *(const u32x2*)(y1 + c), bq = *(const u32x2*)(y2 + c); const f32x4 g = *(const f32x4*)(gt + c);
            v[j][0] += g[0] * (bflo(a.x) + bflo(bq.x)); v[j][1] += g[1] * (bfhi(a.x) + bfhi(bq.x)); v[j][2] += g[2] * (bflo(a.y) + bflo(bq.y)); v[j][3] += g[3] * (bfhi(a.y) + bfhi(bq.y));
            ss += v[j][0] * v[j][0] + v[j][1] * v[j][1] + v[j][2] * v[j][2] + v[j][3] * v[j][3]; }
        const float rinv = rsqrtf(wave_sum(ss) * (1.0f / DM) + 1e-6f);
#pragma unroll
        for (int j = 0; j < 4; ++j) { const int c = lane * 4 + 256 * j; const f32x4 g = *(const f32x4*)(p.in[I_GFINAL] + c);
            *(f32x4*)(OUT + (size_t)r * DM + c) = v[j] * rinv * g; }
    }
}


#define XB_TMO      128
#define XB_XCNT(j)  (256  + 64 * (j))
#define XB_XSUB(j)  (1280 + 64 * (j))
#define XB_XGEN(j)  (2304 + 64 * (j))
#define XB_TOP      3328
#define XB_TOPGEN   3392
#define XCD_BAR_WORDS 3456
#define XB_SPIN_CAP (1u << 18)
__device__ __forceinline__ unsigned xb_ld(unsigned* p)              { return __hip_atomic_load(p, __ATOMIC_RELAXED, __HIP_MEMORY_SCOPE_AGENT); }
__device__ __forceinline__ unsigned xb_add(unsigned* p, unsigned v) { return __hip_atomic_fetch_add(p, v, __ATOMIC_RELAXED, __HIP_MEMORY_SCOPE_AGENT); }
__device__ __forceinline__ unsigned xb_xcc_id() { return (unsigned)__builtin_amdgcn_s_getreg((3 << 11) | 20) & 0xFu; }
#define XB_SPIN(cond, bar) do { unsigned _sp = 0; while (cond) { __builtin_amdgcn_s_sleep(1); \
    if ((++_sp & 255u) == 0u) { if (xb_ld(&(bar)[XB_TMO])) break; if (_sp > XB_SPIN_CAP) { atomicAdd(&(bar)[XB_TMO], 1u); break; } } } } while (0)
struct XcdBarrier { unsigned* bar; unsigned x; volatile unsigned* st; };
__device__ __forceinline__ XcdBarrier xcd_barrier_post(unsigned* bar, volatile unsigned* st) {
    XcdBarrier b; b.bar = bar; b.x = xb_xcc_id(); b.st = st;
    if (threadIdx.x == 0) (void)xb_add(&bar[XB_XCNT(b.x)], 1u);
    return b;
}
__device__ __forceinline__ void xcd_barrier_complete(unsigned* bar, unsigned x, unsigned& nloc, unsigned& nx) {
    const unsigned G = gridDim.x * gridDim.y * gridDim.z;
    unsigned sum, cnt, mine, sp = 0u;
    for (;;) {
        sum = 0u; cnt = 0u; mine = 0u;
#pragma unroll
        for (unsigned j = 0; j < 16; ++j) { const unsigned c = xb_ld(&bar[XB_XCNT(j)]); sum += c; cnt += (c > 0u) ? 1u : 0u; mine = (j == x) ? c : mine; }
        if (sum == G) break;
        __builtin_amdgcn_s_sleep(1);
        if ((++sp & 255u) == 0u) { if (xb_ld(&bar[XB_TMO])) break; if (sp > XB_SPIN_CAP) { atomicAdd(&bar[XB_TMO], 1u); break; } }
    }
    nloc = mine > 0u ? mine : 1u; nx = cnt > 0u ? cnt : 1u;
}
__device__ __forceinline__ void xcd_barrier(const XcdBarrier& b) {
    asm volatile("s_waitcnt vmcnt(0)" ::: "memory");
    __syncthreads();
    if (threadIdx.x == 0) {
        unsigned* bar = b.bar;
        __builtin_amdgcn_s_waitcnt(0);
        unsigned nloc = b.st[0], nx = b.st[1];
        if (nloc == 0u) { xcd_barrier_complete(bar, b.x, nloc, nx); b.st[0] = nloc; b.st[1] = nx; }
        const unsigned old = xb_add(&bar[XB_XSUB(b.x)], 1u);
        const unsigned gen = old / nloc;
        if (old + 1u == (gen + 1u) * nloc) {
            __builtin_amdgcn_fence(__ATOMIC_RELEASE, "agent");
            asm volatile("s_waitcnt vmcnt(0)" ::: "memory");
            const unsigned og = xb_add(&bar[XB_TOP], 1u);
            const unsigned tg = og / nx;
            if (og + 1u == (tg + 1u) * nx) xb_add(&bar[XB_TOPGEN], 1u);
            else XB_SPIN(xb_ld(&bar[XB_TOPGEN]) == tg, bar);
            __builtin_amdgcn_fence(__ATOMIC_ACQUIRE, "agent");
            xb_add(&bar[XB_XGEN(b.x)], 1u);
            asm volatile("s_waitcnt vmcnt(0)" ::: "memory");
        } else {
            XB_SPIN(xb_ld(&bar[XB_XGEN(b.x)]) == gen, bar);
            __builtin_amdgcn_fence(__ATOMIC_ACQUIRE, "agent");
            asm volatile("s_waitcnt vmcnt(0)" ::: "memory");
        }
    }
    __syncthreads();
}
constexpr size_t OFF_BAR = OFF_CTL + 4096;

__global__ void __launch_bounds__(NTHR) mega(Params p, int lo, int hi) {
    extern __shared__ __attribute__((aligned(16))) unsigned char lds[];
    cg::grid_group grid = cg::this_grid();
    const int bid = blockIdx.x, nb = gridDim.x;
    unsigned char* ws = p.ws;
    bf16_t* S0 = (bf16_t*)(ws + OFF_SLOT), *S1 = (bf16_t*)(ws + OFF_SLOT + SLOT), *S2 = (bf16_t*)(ws + OFF_SLOT + 2 * SLOT), *S3 = (bf16_t*)(ws + OFF_SLOT + 3 * SLOT),
           *S4 = (bf16_t*)(ws + OFF_SLOT + 4 * SLOT), *S5 = (bf16_t*)(ws + OFF_SLOT + 5 * SLOT);
    const float* MOD = (const float*)(ws + OFF_MOD); const float* BINP = (const float*)(ws + OFF_BINP);
    int* meta = (int*)(lds + LDS_BYTES - 256);
#ifndef PHMASK
#define PHMASK 0x7ff
#endif
#define IN(k) (((PHMASK >> (k)) & 1) && lo <= (k) && (k) < hi)
#ifndef PIPE_MASK
#define PIPE_MASK 0x364
#endif
#define GEMM_RUN(k, gather, s, e) gemm_phase_pipe<gather>(lds, s, e)
    volatile unsigned* xst = (volatile unsigned*)(lds + LDS_BYTES - 16);
    if (threadIdx.x < 2) xst[threadIdx.x] = 0u;
    __syncthreads();
    XcdBarrier xbar; xbar.bar = (unsigned*)(ws + OFF_BAR); xbar.x = 0; xbar.st = xst;
    if (hi - lo > 1) xbar = xcd_barrier_post((unsigned*)(ws + OFF_BAR), xst);
    if (p.pv == 0x7eadbeef) grid.sync();
#define SEAM(k) do { if (IN(k) && IN((k) + 1)) xcd_barrier(xbar); } while (0)
    if (IN(0)) { ph0_prep(p, bid, nb, lds); } SEAM(0);
    if (IN(1)) { ph1_norm(p, bid, nb); } SEAM(1);
    if (IN(2)) {
        { SchCtx s{(const bf16_t*)(ws + OFF_HC), (const bf16_t*)(ws + OFF_WIN), nb, bid, 1024}; EpiCtx e{(bf16_t*)(ws + OFF_XRC), BINP}; GEMM_RUN(2, false, s, e); }
        { SchG1 s{S0, (const bf16_t*)(ws + OFF_WIN), nb, bid, 1024}; EpiG1 e{S1, S2, S3, S4, S5, BINP}; GEMM_RUN(2, false, s, e); }
    } SEAM(2);
    if (IN(3)) {
#ifndef NO_APREP
        for (int g = bid; g < 512; g += nb) aprep_item(p, g, lds);
#endif
#ifndef NO_BLOCAL
        b_phase<false>(p, bid, nb, lds);
#endif
    } SEAM(3);
    if (IN(4)) {
        b_phase<true>(p, bid, nb, lds);
    } SEAM(4);
    if (IN(5)) { SchG2 s{S0, S1, (const bf16_t*)(ws + OFF_WPA), (const bf16_t*)(ws + OFF_WPB), nb, bid, 1024}; EpiG2 e{S4, S5, S3}; GEMM_RUN(5, false, s, e); } SEAM(5);
    if (IN(6)) { SchG3 s{S3, (const bf16_t*)(ws + OFF_WO), nb, bid, 1024}; EpiG3 e{p.in[I_X], MOD, S5}; GEMM_RUN(6, false, s, e); } SEAM(6);
    if (IN(7)) { ph8_route(p, bid, nb, lds); } SEAM(7);
    if (IN(8)) { __syncthreads(); moe_meta_build(p, meta); MoeMeta mm{meta};
        int* idx = (int*)(lds + STAGE_BYTES);
        SchUp s{S2, (const bf16_t*)(ws + OFF_WGU), (const int*)(ws + OFF_LIST), mm, nb, bid, 1024, idx}; EpiUp e{S3, (const float*)(ws + OFF_WL), mm};
        { Unit u; for (int i = 0; i < 8 && s.next(i, u); ++i) { if (threadIdx.x < 256) { int pos = u.aux2 + (int)threadIdx.x; const int c = mm.cnt(u.aux); pos = pos < c ? pos : c - 1; idx[i * 256 + threadIdx.x] = s.LIST[u.aux * NT + pos]; } } }
        __syncthreads();
        GEMM_RUN(8, true, s, e); } SEAM(8);
    if (IN(9)) { __syncthreads(); moe_meta_build(p, meta); MoeMeta mm{meta};
        SchDn s{S3, (const bf16_t*)(ws + OFF_WDN), mm, nb, bid, 512}; EpiDn e{S0, mm}; GEMM_RUN(9, false, s, e); } SEAM(9);
    if (IN(10)) { __syncthreads(); moe_meta_build(p, meta); ph10_final(p, bid, nb, meta); }
#undef IN
#undef SEAM
}

extern "C" void kernel_launch(void* const* d_in, const int* in_sizes, int n_in, void* d_out, int out_size, void* d_ws, size_t ws_size, hipStream_t stream) {
    static int grid = 0;
    if (grid == 0) {
        if (n_in != 37 || out_size != NT * DM || ws_size < WS_END) { fprintf(stderr, "kernel_launch: unexpected shapes: n_in %d out %d ws %zu (need %zu)\n", n_in, out_size, ws_size, (size_t)WS_END); grid = -1; return; }
        int dev = 0, cus = 0, per_cu = 0;
        (void)hipGetDevice(&dev); (void)hipDeviceGetAttribute(&cus, hipDeviceAttributeMultiprocessorCount, dev);
        if (hipFuncSetAttribute((const void*)mega, hipFuncAttributeMaxDynamicSharedMemorySize, LDS_BYTES) != hipSuccess) { fprintf(stderr, "kernel_launch: hipFuncSetAttribute failed\n"); grid = -1; return; }
        if (hipOccupancyMaxActiveBlocksPerMultiprocessor(&per_cu, (const void*)mega, NTHR, LDS_BYTES) != hipSuccess || per_cu < 1) { fprintf(stderr, "kernel_launch: occupancy query says %d\n", per_cu); per_cu = 1; }
        (void)hipGetLastError();
        grid = cus * 1;
        fprintf(stderr, "kernel_launch: grid %d (cus %d, per_cu %d)\n", grid, cus, per_cu);
    }
    if (grid < 0) return;
    Params p{};
    for (int i = 0; i < 37; ++i) p.in[i] = (const float*)d_in[i];
    p.out = (float*)d_out; p.ws = (unsigned char*)d_ws;
#if ONE_LAUNCH
    (void)hipMemsetAsync((unsigned char*)d_ws + OFF_BAR, 0, XCD_BAR_WORDS * 4, stream);
    int lo = 0, hi = NPHASE; void* args[] = {&p, &lo, &hi};
    hipError_t e = hipLaunchCooperativeKernel((const void*)mega, dim3(grid), dim3(NTHR), args, LDS_BYTES, stream);
    if (e != hipSuccess) fprintf(stderr, "cooperative launch failed: %s (grid %d)\n", hipGetErrorString(e), grid);
#ifdef PROBE_PHASE
    hipLaunchKernelGGL(mega, dim3(grid), dim3(NTHR), LDS_BYTES, stream, p, PROBE_PHASE, PROBE_PHASE + 1);
#endif
#else
    for (int k = 0; k < NPHASE; ++k) hipLaunchKernelGGL(mega, dim3(grid), dim3(NTHR), LDS_BYTES, stream, p, k, k + 1);
#endif
}
```

```cpp
#include <hip/hip_runtime.h>
#include <hip/hip_cooperative_groups.h>
#include <cstdio>
#include <cstdint>
namespace cg = cooperative_groups;

#ifndef ONE_LAUNCH
#define ONE_LAUNCH 1
#endif

typedef unsigned short bf16_t;
typedef short bf16x8 __attribute__((ext_vector_type(8)));
typedef float f32x4 __attribute__((ext_vector_type(4)));
typedef float f32x2 __attribute__((ext_vector_type(2)));
typedef unsigned u32x4 __attribute__((ext_vector_type(4)));
typedef unsigned u32x2 __attribute__((ext_vector_type(2)));

constexpr int NT = 32768, NCX = 1024, DM = 1024, SEQ = 8192, CTXL = 256;
constexpr int NTHR = 512;
constexpr int NCH64 = 132;
constexpr size_t MiB = (size_t)1 << 20;
constexpr size_t OFF_CTL = 0, OFF_MOD = 1 * MiB, OFF_BINP = OFF_MOD + 128 * 1024, OFF_WIN = 2 * MiB, OFF_WPA = 14 * MiB, OFF_WPB = 16 * MiB,
                 OFF_WO = 18 * MiB, OFF_WG = 20 * MiB, OFF_WGU = 22 * MiB, OFF_WDN = 54 * MiB, OFF_HC = 70 * MiB, OFF_XRC = 72 * MiB,
                 OFF_TOT = 74 * MiB, OFF_ROUTE = 84 * MiB, OFF_LIST = 85 * MiB, OFF_WL = 87 * MiB, OFF_SLOT = 90 * MiB, SLOT = 64 * MiB,
                 WS_END = OFF_SLOT + 6 * SLOT;
constexpr int LDS_BYTES = 144 * 1024;
constexpr int NPHASE = 11;

struct Params { const float* in[37]; float* out; unsigned char* ws; int pv; int pad; };

enum { I_X = 0, I_C, I_CTX, I_CCTX, I_WADA, I_BADA, I_GMIX, I_WIN, I_BIN, I_CONVW, I_CONVB, I_LNG, I_LNB, I_WPA, I_LCW, I_LCB,
       I_WRF, I_BRF, I_WIF, I_BIF, I_LAMF, I_WRB, I_BRB, I_WIB, I_BIB, I_LAMB, I_WPB, I_WO, I_GFFN, I_WGRP, I_BGRP, I_WER, I_BER,
       I_WGATE, I_WUP, I_WDOWN, I_GFINAL };

__device__ __forceinline__ float bflo(unsigned w) { return __uint_as_float(w << 16); }
__device__ __forceinline__ float bfhi(unsigned w) { return __uint_as_float(w & 0xffff0000u); }
__device__ __forceinline__ float bf2f(bf16_t h) { return __uint_as_float(((unsigned)h) << 16); }
__device__ __forceinline__ unsigned pk2(float lo, float hi) { unsigned r; asm("v_cvt_pk_bf16_f32 %0, %1, %2" : "=v"(r) : "v"(lo), "v"(hi)); return r; }
__device__ __forceinline__ bf16_t f2bf(float f) { return (bf16_t)(pk2(f, 0.f) & 0xffffu); }
__device__ __forceinline__ float sigm(float x) { return __builtin_amdgcn_rcpf(1.0f + __expf(-x)); }
__device__ __forceinline__ float sigm2(float x2) { return __builtin_amdgcn_rcpf(1.0f + __builtin_amdgcn_exp2f(x2)); }
__device__ __forceinline__ float silu(float x) { return x * sigm(x); }
__device__ __forceinline__ float gelu_tanh(float x) { return x * sigm(1.5957691216057308f * (x + 0.044715f * x * x * x)); }
__device__ __forceinline__ float wave_sum(float v) {
#pragma unroll
    for (int o = 1; o < 64; o <<= 1) v += __shfl_xor(v, o);
    return v;
}
template <int CTRL, int RMASK> __device__ __forceinline__ float dpp_add(float v) { return v + __int_as_float(__builtin_amdgcn_update_dpp(0, __float_as_int(v), CTRL, RMASK, 0xF, false)); }
__device__ __forceinline__ float wave_sum_dpp(float v) {
    v = dpp_add<0xB1, 0xF>(v); v = dpp_add<0x4E, 0xF>(v); v = dpp_add<0x141, 0xF>(v); v = dpp_add<0x140, 0xF>(v); v = dpp_add<0x142, 0xA>(v); v = dpp_add<0x143, 0xC>(v);
    return __int_as_float(__builtin_amdgcn_readlane(__float_as_int(v), 63));
}
__device__ __forceinline__ void wave_lds_sync() { asm volatile("s_waitcnt lgkmcnt(0)" ::: "memory"); __builtin_amdgcn_wave_barrier(); }
__device__ __forceinline__ u32x2 pk4(f32x4 v) { u32x2 r; r.x = pk2(v[0], v[1]); r.y = pk2(v[2], v[3]); return r; }

__device__ __forceinline__ u32x4 pk8(f32x4 a, f32x4 b) { u32x4 r; r.x = pk2(a[0], a[1]); r.y = pk2(a[2], a[3]); r.z = pk2(b[0], b[1]); r.w = pk2(b[2], b[3]); return r; }
__device__ __forceinline__ void unpk8(u32x4 w, f32x4& a, f32x4& b) { a[0] = bflo(w.x); a[1] = bfhi(w.x); a[2] = bflo(w.y); a[3] = bfhi(w.y); b[0] = bflo(w.z); b[1] = bfhi(w.z); b[2] = bflo(w.w); b[3] = bfhi(w.w); }

template <class DRow>
__device__ __forceinline__ void tr_item(const float* __restrict__ src, int ldsrc, int k0, int n0, bf16_t* dst, int ldd, DRow drow, float* scr, int lane, float scale = 1.0f) {
    const float* sp = src + (size_t)k0 * ldsrc + n0 + lane;
    float tv[64];
#pragma unroll
    for (int kk = 0; kk < 64; ++kk) tv[kk] = sp[(size_t)kk * ldsrc];
#pragma unroll
    for (int kk = 0; kk < 64; ++kk) scr[kk * 65 + lane] = tv[kk] * scale;
    wave_lds_sync();
    const int c = lane & 7;
#pragma unroll
    for (int j = 0; j < 8; ++j) {
        const int n = (lane >> 3) + 8 * j; const float* s = scr + (8 * c) * 65 + n;
        u32x4 o; o.x = pk2(s[0], s[65]); o.y = pk2(s[130], s[195]); o.z = pk2(s[260], s[325]); o.w = pk2(s[390], s[455]);
        *(u32x4*)(dst + (size_t)drow(n0 + n) * ldd + k0 + 8 * c) = o;
    }
    wave_lds_sync();
}

__device__ __forceinline__ int win_srccol(int np) { const int p = np >> 8, r = np & 255; return p < 8 ? (r >> 7) * 1024 + 128 * p + (r & 127) : np; }

__device__ __forceinline__ void ph0_prep(const Params& p, int bid, int nb, unsigned char* lds) {
    const int tid = threadIdx.x, lane = tid & 63, wave = tid >> 6;
    unsigned char* ws = p.ws;
    float* scr = (float*)lds + wave * (64 * 65);
    const int gw = bid * 8 + wave, NGW = nb * 8;
    constexpr int N_WIN = 16 * 96, N_SQ = 16 * 16, N_G = 128, N_GU = 2048, N_DN = 2048;
    constexpr int NITEMS = N_WIN + 3 * N_SQ + N_G + 2 * N_GU + N_DN;
    for (int it = gw; it < NITEMS; it += NGW) {
        int r = it;
        if (r < N_WIN) { const int kb = r / 96, nbk = r % 96, d0 = 64 * nbk, sc0 = win_srccol(d0);
            const int pt = d0 >> 8; const bool sgm = (pt < 8 && ((d0 >> 7) & 1)) || pt >= 16;
            tr_item(p.in[I_WIN], 6144, 64 * kb, sc0, (bf16_t*)(ws + OFF_WIN), 1024, [=](int n) { return n - sc0 + d0; }, scr, lane, sgm ? -1.4426950408889634f : 1.0f); continue; }
        r -= N_WIN;
        if (r < 3 * N_SQ) { const int which = r / N_SQ, q = r % N_SQ, kb = q / 16, nbk = q % 16;
            const float* src = which == 0 ? p.in[I_WPA] : which == 1 ? p.in[I_WPB] : p.in[I_WO];
            bf16_t* dst = (bf16_t*)(ws + (which == 0 ? OFF_WPA : which == 1 ? OFF_WPB : OFF_WO));
            tr_item(src, 1024, 64 * kb, 64 * nbk, dst, 1024, [=](int n) { return n; }, scr, lane); continue; }
        r -= 3 * N_SQ;
        if (r < N_G) { const int ty = r / 32, q = r % 32, h = q / 4, kb = (q % 4) / 2, nbk = q % 2;
            const float* src = (ty == 0 ? p.in[I_WRF] : ty == 1 ? p.in[I_WIF] : ty == 2 ? p.in[I_WRB] : p.in[I_WIB]) + (size_t)h * 128 * 128;
            tr_item(src, 128, 64 * kb, 64 * nbk, (bf16_t*)(ws + OFF_WG), 128, [=](int n) { return h * 512 + (n >> 4) * 64 + ty * 16 + (n & 15); }, scr, lane, -1.4426950408889634f); continue; }
        r -= N_G;
        if (r < 2 * N_GU) { const int bj = r / N_GU, q = r % N_GU, e = q / 128, kb = (q % 128) / 8, nbk = q % 8;
            const float* src = (bj == 0 ? p.in[I_WGATE] : p.in[I_WUP]) + (size_t)e * 1024 * 512;
            tr_item(src, 512, 64 * kb, 64 * nbk, (bf16_t*)(ws + OFF_WGU) + (size_t)e * 1024 * 1024, 1024, [=](int n) { return 256 * (n >> 7) + 128 * bj + (n & 127); }, scr, lane); continue; }
        r -= 2 * N_GU;
        { const int e = r / 128, kb = (r % 128) / 16, nbk = r % 16;
            tr_item(p.in[I_WDOWN] + (size_t)e * 512 * 1024, 1024, 64 * kb, 64 * nbk, (bf16_t*)(ws + OFF_WDN) + (size_t)e * 1024 * 512, 512, [=](int n) { return n; }, scr, lane); }
    }
    __syncthreads();
    float* red = (float*)lds;
    float* MOD = (float*)(ws + OFF_MOD);
    for (int it = bid; it < 96; it += nb) {
        const int col = it * 64 + lane;
        float a[5] = {0.f, 0.f, 0.f, 0.f, 0.f};
        const float* W = p.in[I_WADA];
#pragma unroll 1
        for (int k0 = wave * 128; k0 < wave * 128 + 128; k0 += 16) {
            float wv[16];
#pragma unroll
            for (int kk = 0; kk < 16; ++kk) wv[kk] = W[(size_t)(k0 + kk) * 6144 + col];
#pragma unroll
            for (int kk = 0; kk < 16; ++kk)
#pragma unroll
                for (int r = 0; r < 5; ++r) { const float cv = r < 4 ? p.in[I_C][r * 1024 + k0 + kk] : p.in[I_CCTX][k0 + kk]; a[r] += silu(cv) * wv[kk]; }
        }
#pragma unroll
        for (int r = 0; r < 5; ++r) red[(wave * 5 + r) * 64 + lane] = a[r];
        __syncthreads();
        if (tid < 320) { const int r = tid / 64, l = tid % 64; float s = 0.f;
#pragma unroll
            for (int w = 0; w < 8; ++w) s += red[(w * 5 + r) * 64 + l];
            MOD[r * 6144 + it * 64 + l] = s + p.in[I_BADA][it * 64 + l]; }
        __syncthreads();
    }
    float* BINP = (float*)(ws + OFF_BINP);
    for (int i = bid * NTHR + tid; i < 6144; i += nb * NTHR) { const int pt = i >> 8; const bool sgm = (pt < 8 && ((i >> 7) & 1)) || pt >= 16; BINP[i] = p.in[I_BIN][win_srccol(i)] * (sgm ? -1.4426950408889634f : 1.0f); }
    if (bid == 0 && tid < 64) ((unsigned*)(ws + OFF_CTL))[tid] = 0u;
}

__device__ __forceinline__ void ph1_norm(const Params& p, int bid, int nb) {
    const int lane = threadIdx.x & 63, wave = threadIdx.x >> 6;
    const float* MOD = (const float*)(p.ws + OFF_MOD);
    f32x4 gm[4];
#pragma unroll
    for (int j = 0; j < 4; ++j) gm[j] = *(const f32x4*)(p.in[I_GMIX] + lane * 4 + 256 * j);
    const int r0 = bid * 8 + wave, rs = nb * 8;
    f32x4 nx[4];
    { const float* src = r0 < NT ? p.in[I_X] + (size_t)r0 * DM : p.in[I_CTX] + (size_t)(r0 - NT) * DM;
#pragma unroll
        for (int j = 0; j < 4; ++j) nx[j] = *(const f32x4*)(src + lane * 4 + 256 * j); }
#pragma unroll 1
    for (int r = r0; r < NT + NCX; r += rs) {
        const bool lat = r < NT;
        bf16_t* dst = lat ? (bf16_t*)(p.ws + OFF_SLOT) + (size_t)r * DM : (bf16_t*)(p.ws + OFF_HC) + (size_t)(r - NT) * DM;
        const float* mrow = MOD + (lat ? r / SEQ : 4) * 6144;
        f32x4 v[4]; float ss = 0.f;
#pragma unroll
        for (int j = 0; j < 4; ++j) { v[j] = nx[j]; const f32x4 sq = v[j] * v[j]; ss += (sq[0] + sq[1]) + (sq[2] + sq[3]); }
        { const int rn = r + rs < NT + NCX ? r + rs : r;
            const float* src = rn < NT ? p.in[I_X] + (size_t)rn * DM : p.in[I_CTX] + (size_t)(rn - NT) * DM;
#pragma unroll
            for (int j = 0; j < 4; ++j) nx[j] = *(const f32x4*)(src + lane * 4 + 256 * j); }
        const float rinv = rsqrtf(wave_sum_dpp(ss) * (1.0f / DM) + 1e-6f);
#pragma unroll
        for (int j = 0; j < 4; ++j) { const int c = lane * 4 + 256 * j;
            const f32x4 sh = *(const f32x4*)(mrow + c), sc = *(const f32x4*)(mrow + 1024 + c);
            const f32x4 o = v[j] * rinv * gm[j] * (1.0f + sc) + sh;
            *(u32x2*)(dst + c) = pk4(o); }
    }
}

struct Unit { int pm, pn, aux, aux2; };

#define LAS __attribute__((address_space(3)))
constexpr int BK = 64, HTB = 128 * BK * 2, STAGE_BYTES = 8 * HTB;
__device__ __forceinline__ int lds_byte(int r, int c) { const int st = (r >> 4) * 2 + (c >> 5), rr = r & 15, cc = c & 31, ob = rr * 64 + cc * 2; return st * 1024 + (ob ^ (((ob >> 9) & 1) << 5)); }
__device__ __forceinline__ void stage_rc(int b, int& R, int& C) { const int st = b / 1024, sb = b % 1024, swz = sb ^ (((sb >> 9) & 1) << 5); R = (st >> 1) * 16 + swz / 64; C = (st & 1) * 32 + (swz % 64) / 2; }

template <bool GATHER, class S, class E>
__device__ __forceinline__ void gemm_phase_pipe(unsigned char* ldsg, const S& sch, const E& epi) {
    LAS unsigned char* lds = (LAS unsigned char*)ldsg;
    const int tid = threadIdx.x, wid = __builtin_amdgcn_readfirstlane(tid >> 6), lane = tid & 63, wr = wid >> 2, wc = wid & 3, fr = lane & 15, fq = lane >> 4;
    const int K = sch.K, nt = K / BK;
    int Rr[2], Cc[2]; unsigned voffA[2], voffB[2];
#pragma unroll
    for (int i = 0; i < 2; ++i) { stage_rc(tid * 16 + i * 8192, Rr[i], Cc[i]); voffA[i] = (unsigned)(Rr[i] * K + Cc[i]) * 2u;
        const int rho = Rr[i] & 31, Rb = (Rr[i] & ~31) + 8 * ((rho & 15) >> 2) + 4 * (rho >> 4) + (rho & 3);
        voffB[i] = (unsigned)(Rb * K + Cc[i]) * 2u; }
    const size_t kstep = (size_t)(BK * 2);
    const size_t hstep = (size_t)128 * K * 2;
    const unsigned ldsw = (unsigned)wid * 1024u;
    const int aoff = lds_byte(wr * 64 + fr, fq * 8), boff = lds_byte(wc * 32 + fr, fq * 8);
#define PG8_SA(b, h) (((b) * 2 + (h)) * HTB)
#define PG8_SB(b, h) ((4 + (b) * 2 + (h)) * HTB)
#define PG8_STAGE_B(bufoff, gbase) do { _Pragma("unroll") for (int _i = 0; _i < 2; ++_i) \
        __builtin_amdgcn_global_load_lds((const unsigned*)((const char*)(gbase) + voffB[_i]), (LAS unsigned*)(lds + (bufoff) + ldsw + _i * 8192), 16, 0, 0); } while (0)
#define PG8_STAGE_A(bufoff, gbase, h, vo) do { _Pragma("unroll") for (int _i = 0; _i < 2; ++_i) \
        __builtin_amdgcn_global_load_lds((const unsigned*)((const char*)(gbase) + (GATHER ? (size_t)(vo)[h][_i] : (size_t)(h) * hstep + voffA[_i])), (LAS unsigned*)(lds + (bufoff) + ldsw + _i * 8192), 16, 0, 0); } while (0)
#define PG8_LDA(dst, b, h) do { _Pragma("unroll") for (int m = 0; m < 4; ++m) _Pragma("unroll") for (int k = 0; k < 2; ++k) dst[m][k] = *(const LAS bf16x8*)(lds + PG8_SA(b, h) + aoff + m * 2048 + k * 1024); } while (0)
#define PG8_LDB(dst, b, h) do { _Pragma("unroll") for (int n = 0; n < 2; ++n) _Pragma("unroll") for (int k = 0; k < 2; ++k) dst[n][k] = *(const LAS bf16x8*)(lds + PG8_SB(b, h) + boff + n * 2048 + k * 1024); } while (0)
#define PG8_MMA(ai, bj, At, Bt) do { __builtin_amdgcn_s_setprio(1); _Pragma("unroll") for (int m = 0; m < 4; ++m) _Pragma("unroll") for (int n = 0; n < 2; ++n) _Pragma("unroll") for (int k = 0; k < 2; ++k) \
        acc[ai][bj][m][n] = __builtin_amdgcn_mfma_f32_16x16x32_bf16(Bt[n][k], At[m][k], acc[ai][bj][m][n], 0, 0, 0); __builtin_amdgcn_s_setprio(0); } while (0)
#define PG8_WAIT_V(n) asm volatile("s_waitcnt vmcnt(" #n ")" ::: "memory")
#define PG8_WAIT_L(n) asm volatile("s_waitcnt lgkmcnt(" #n ")" ::: "memory")
#define PG8_BAR __builtin_amdgcn_s_barrier()
#define PG8_SCHED __builtin_amdgcn_sched_barrier(0)
    Unit cur, nxt; int ui = 0;
    if (!sch.next(0, cur)) return;
    f32x4 acc[2][2][4][2];
#pragma unroll
    for (int a = 0; a < 2; ++a)
#pragma unroll
        for (int b = 0; b < 2; ++b)
#pragma unroll
            for (int m = 0; m < 4; ++m)
#pragma unroll
                for (int n = 0; n < 2; ++n) acc[a][b][m][n] = (f32x4){0.f, 0.f, 0.f, 0.f};
    bf16x8 At[4][2], B0[2][2], B1[2][2];
    unsigned voAc[2][2], voAn[2][2];
#pragma unroll
    for (int h = 0; h < 2; ++h)
#pragma unroll
        for (int i = 0; i < 2; ++i) { voAc[h][i] = GATHER ? sch.aoff(cur, 128 * h + Rr[i]) + (unsigned)Cc[i] * 2u : 0u; voAn[h][i] = voAc[h][i]; }
    const char* cA = sch.abase(cur); const char* cB = sch.bbase(cur);
    PG8_STAGE_B(PG8_SB(0, 0), cB); PG8_STAGE_A(PG8_SA(0, 0), cA, 0, voAc); PG8_STAGE_B(PG8_SB(0, 1), cB + hstep); PG8_STAGE_A(PG8_SA(0, 1), cA, 1, voAc);
    if (wr == 1) PG8_BAR;
    PG8_WAIT_V(4); PG8_BAR;
    PG8_STAGE_B(PG8_SB(1, 0), cB + kstep); PG8_STAGE_A(PG8_SA(1, 0), cA + kstep, 0, voAc); PG8_STAGE_B(PG8_SB(1, 1), cB + hstep + kstep);
    PG8_WAIT_V(6); PG8_BAR;
    for (;;) {
        const bool has_next = sch.next(ui + 1, nxt);
        const char* nA = has_next ? sch.abase(nxt) : cA; const char* nB = has_next ? sch.bbase(nxt) : cB;
        if (GATHER) {
#pragma unroll
            for (int h = 0; h < 2; ++h)
#pragma unroll
                for (int i = 0; i < 2; ++i) voAn[h][i] = has_next ? sch.aoff(nxt, 128 * h + Rr[i]) + (unsigned)Cc[i] * 2u : voAc[h][i];
        }
#pragma unroll 1
        for (int t = 0; t < nt; t += 2) {
            const bool last = (t == nt - 2);
            const char* a1 = cA + (size_t)(t + 1) * kstep;
            const char* a2 = last ? nA : cA + (size_t)(t + 2) * kstep; const char* b2 = last ? nB : cB + (size_t)(t + 2) * kstep;
            const char* a3 = a2 + kstep; const char* b3 = b2 + kstep;
            unsigned vo2[2][2];
#pragma unroll
            for (int h = 0; h < 2; ++h)
#pragma unroll
                for (int i = 0; i < 2; ++i) vo2[h][i] = last ? voAn[h][i] : voAc[h][i];
            PG8_LDB(B0, 0, 0); PG8_SCHED; PG8_LDA(At, 0, 0); PG8_STAGE_A(PG8_SA(1, 1), a1, 1, voAc);
            PG8_WAIT_L(8); PG8_BAR; PG8_WAIT_L(0); PG8_MMA(0, 0, At, B0); PG8_BAR; PG8_SCHED;
            PG8_LDB(B1, 0, 1); PG8_STAGE_B(PG8_SB(0, 0), b2);
            PG8_BAR; PG8_WAIT_L(0); PG8_MMA(0, 1, At, B1); PG8_BAR;
            PG8_LDA(At, 0, 1); PG8_STAGE_A(PG8_SA(0, 0), a2, 0, vo2);
            PG8_BAR; PG8_WAIT_L(0); PG8_MMA(1, 0, At, B0); PG8_BAR; PG8_SCHED;
            PG8_STAGE_B(PG8_SB(0, 1), b2 + hstep);
            PG8_WAIT_V(6); PG8_BAR; PG8_MMA(1, 1, At, B1); PG8_BAR;
            PG8_LDB(B0, 1, 0); PG8_SCHED; PG8_LDA(At, 1, 0); PG8_STAGE_A(PG8_SA(0, 1), a2, 1, vo2);
            PG8_WAIT_L(8); PG8_BAR; PG8_WAIT_L(0); PG8_MMA(0, 0, At, B0); PG8_BAR; PG8_SCHED;
            PG8_LDB(B1, 1, 1); PG8_STAGE_B(PG8_SB(1, 0), b3);
            PG8_BAR; PG8_WAIT_L(0); PG8_MMA(0, 1, At, B1); PG8_BAR;
            PG8_LDA(At, 1, 1); PG8_STAGE_A(PG8_SA(1, 0), a3, 0, vo2);
            PG8_BAR; PG8_WAIT_L(0); PG8_MMA(1, 0, At, B0); PG8_BAR; PG8_SCHED;
            PG8_STAGE_B(PG8_SB(1, 1), b3 + hstep);
            PG8_WAIT_V(6); PG8_BAR; PG8_MMA(1, 1, At, B1); PG8_BAR;
        }
        { int frx = fr, fqx = fq; asm volatile("" : "+v"(frx), "+v"(fqx));
            const int jx = wc * 32 + 8 * fqx, rx = wr * 64 + frx;
            const typename E::Col ecol = epi.col(cur, jx);
            constexpr int PF = E::PF;
            typename E::Pre epre[8];
#pragma unroll
            for (int g = 0; g < PF; ++g) epre[g] = epi.load(cur, (g >> 2) * 128 + (g & 3) * 16 + rx, jx);
#pragma unroll
            for (int g = 0; g < 8; ++g) { const int ai = g >> 2, m = g & 3;
                if (g + PF < 8) epre[g + PF] = epi.load(cur, ((g + PF) >> 2) * 128 + ((g + PF) & 3) * 16 + rx, jx);
                epi.apply(cur, ai * 128 + m * 16 + rx, jx, ecol, epre[g], acc[ai][0][m][0], acc[ai][0][m][1], acc[ai][1][m][0], acc[ai][1][m][1]); } }
        if (!has_next) break;
#pragma unroll
        for (int a = 0; a < 2; ++a)
#pragma unroll
            for (int b = 0; b < 2; ++b)
#pragma unroll
                for (int m = 0; m < 4; ++m)
#pragma unroll
                    for (int n = 0; n < 2; ++n) acc[a][b][m][n] = (f32x4){0.f, 0.f, 0.f, 0.f};
        cur = nxt; cA = nA; cB = nB; ++ui;
#pragma unroll
        for (int h = 0; h < 2; ++h)
#pragma unroll
            for (int i = 0; i < 2; ++i) voAc[h][i] = voAn[h][i];
    }
    PG8_WAIT_V(0);
    if (wr == 0) PG8_BAR;
    PG8_BAR;
#undef PG8_SA
#undef PG8_SB
#undef PG8_STAGE_A
#undef PG8_STAGE_B
#undef PG8_LDA
#undef PG8_LDB
#undef PG8_MMA
#undef PG8_WAIT_V
#undef PG8_WAIT_L
#undef PG8_BAR
#undef PG8_SCHED
}

struct SchG1 { const bf16_t *A, *Bt; int G, c, K;
    __device__ __forceinline__ bool next(int i, Unit& u) const { const int L = i * G + c; if (L >= 128 * 24) return false; u.pm = L / 24; u.pn = L % 24; return true; }
    __device__ __forceinline__ const bf16_t* arow(const Unit& u, int r) const { return A + (size_t)(u.pm * 256 + r) * 1024; }
    __device__ __forceinline__ const bf16_t* brow(const Unit& u, int n) const { return Bt + (size_t)(u.pn * 256 + n) * 1024; }
    __device__ __forceinline__ const char* abase(const Unit& u) const { return (const char*)(A + (size_t)u.pm * 256 * 1024); }
    __device__ __forceinline__ const char* bbase(const Unit& u) const { return (const char*)(Bt + (size_t)u.pn * 256 * 1024); }
    __device__ __forceinline__ unsigned aoff(const Unit&, int) const { return 0u; } };
struct EpiG1 { bf16_t *Z, *GYG, *XR, *SGA, *SGB; const float* bias;
    static constexpr int PF = 1; struct Col { f32x4 c0, c1, c2, c3; }; struct Pre { };
    __device__ __forceinline__ Col col(const Unit& u, int j) const { const float* bp = bias + u.pn * 256 + j; return Col{*(const f32x4*)bp, *(const f32x4*)(bp + 4), *(const f32x4*)(bp + 128), *(const f32x4*)(bp + 132)}; }
    __device__ __forceinline__ Pre load(const Unit&, int, int) const { return Pre{}; }
    __device__ __forceinline__ void apply(const Unit& u, int r, int j, const Col& c, const Pre&, f32x4 a0, f32x4 a1, f32x4 b0, f32x4 b1) const {
        const size_t row = (size_t)u.pm * 256 + r;
        a0 += c.c0; a1 += c.c1; b0 += c.c2; b1 += c.c3;
        if (u.pn < 8) {
#pragma unroll
            for (int e = 0; e < 4; ++e) { a0[e] *= sigm2(b0[e]); a1[e] *= sigm2(b1[e]); }
            *(u32x4*)(Z + row * 1024 + u.pn * 128 + j) = pk8(a0, a1); }
        else { const int kind = u.pn >> 2;
            bf16_t* dst = GYG + (size_t)(kind - 2) * (SLOT / 2);
#pragma unroll
            for (int e = 0; e < 4; ++e) { if (kind == 2) { a0[e] = gelu_tanh(a0[e]); a1[e] = gelu_tanh(a1[e]); b0[e] = gelu_tanh(b0[e]); b1[e] = gelu_tanh(b1[e]); }
                else if (kind >= 4) { a0[e] = sigm2(a0[e]); a1[e] = sigm2(a1[e]); b0[e] = sigm2(b0[e]); b1[e] = sigm2(b1[e]); } }
            bf16_t* o = dst + row * 1024 + (u.pn & 3) * 256 + j;
            *(u32x4*)o = pk8(a0, a1); *(u32x4*)(o + 128) = pk8(b0, b1); }
    } };
struct SchCtx { const bf16_t *A, *Bt; int G, c, K;
    __device__ __forceinline__ bool next(int i, Unit& u) const { const int L = i * G + c; if (L >= 16) return false; u.pm = L / 4; u.pn = L % 4; return true; }
    __device__ __forceinline__ const bf16_t* arow(const Unit& u, int r) const { return A + (size_t)(u.pm * 256 + r) * 1024; }
    __device__ __forceinline__ const bf16_t* brow(const Unit& u, int n) const { return Bt + (size_t)((12 + u.pn) * 256 + n) * 1024; }
    __device__ __forceinline__ const char* abase(const Unit& u) const { return (const char*)(A + (size_t)u.pm * 256 * 1024); }
    __device__ __forceinline__ const char* bbase(const Unit& u) const { return (const char*)(Bt + (size_t)(12 + u.pn) * 256 * 1024); }
    __device__ __forceinline__ unsigned aoff(const Unit&, int) const { return 0u; } };
struct EpiCtx { bf16_t* XRC; const float* bias;
    static constexpr int PF = 1; struct Col { f32x4 c0, c1, c2, c3; }; struct Pre { };
    __device__ __forceinline__ Col col(const Unit& u, int j) const { const float* bp = bias + (12 + u.pn) * 256 + j; return Col{*(const f32x4*)bp, *(const f32x4*)(bp + 4), *(const f32x4*)(bp + 128), *(const f32x4*)(bp + 132)}; }
    __device__ __forceinline__ Pre load(const Unit&, int, int) const { return Pre{}; }
    __device__ __forceinline__ void apply(const Unit& u, int r, int j, const Col& c, const Pre&, f32x4 a0, f32x4 a1, f32x4 b0, f32x4 b1) const {
        const size_t row = (size_t)u.pm * 256 + r;
        a0 += c.c0; a1 += c.c1; b0 += c.c2; b1 += c.c3;
        bf16_t* o = XRC + row * 1024 + u.pn * 256 + j; *(u32x4*)o = pk8(a0, a1); *(u32x4*)(o + 128) = pk8(b0, b1); } };
struct SchG2 { const bf16_t *Aa, *Ab, *Wa, *Wb; int G, c, K;
    __device__ __forceinline__ bool next(int i, Unit& u) const { const int t = (i >> 1) * G + c; if (t >= 512) return false; u.pm = t >> 2; u.pn = t & 3; u.aux = i & 1; return true; }
    __device__ __forceinline__ const bf16_t* arow(const Unit& u, int r) const { return Aa + (size_t)u.aux * (SLOT / 2) + (size_t)(u.pm * 256 + r) * 1024; }
    __device__ __forceinline__ const bf16_t* brow(const Unit& u, int n) const { return Wa + (size_t)u.aux * (1024 * 1024) + (size_t)(u.pn * 256 + n) * 1024; }
    __device__ __forceinline__ const char* abase(const Unit& u) const { return (const char*)(Aa + (size_t)u.aux * (SLOT / 2) + (size_t)u.pm * 256 * 1024); }
    __device__ __forceinline__ const char* bbase(const Unit& u) const { return (const char*)(Wa + (size_t)u.aux * (1024 * 1024) + (size_t)u.pn * 256 * 1024); }
    __device__ __forceinline__ unsigned aoff(const Unit&, int) const { return 0u; } };
struct EpiG2 { const bf16_t *SGA, *SGB; bf16_t* M;
    static constexpr int PF = 2; struct Col { }; struct Pre { u32x4 g0, g1, t0, t1; };
    __device__ __forceinline__ Col col(const Unit&, int) const { return Col{}; }
    __device__ __forceinline__ Pre load(const Unit& u, int r, int j) const {
        const size_t o = ((size_t)u.pm * 256 + r) * 1024 + u.pn * 256 + j; const bf16_t* G = SGA + (size_t)u.aux * (SLOT / 2);
        Pre q; q.g0 = *(const u32x4*)(G + o); q.g1 = *(const u32x4*)(G + o + 128);
        if (u.aux) { q.t0 = *(const u32x4*)(M + o); q.t1 = *(const u32x4*)(M + o + 128); } else { q.t0 = (u32x4){0u, 0u, 0u, 0u}; q.t1 = q.t0; }
        return q; }
    __device__ __forceinline__ void apply(const Unit& u, int r, int j, const Col&, const Pre& q, f32x4 a0, f32x4 a1, f32x4 b0, f32x4 b1) const {
        const size_t o = ((size_t)u.pm * 256 + r) * 1024 + u.pn * 256 + j;
        f32x4 g0, g1, g2, g3, t0, t1, t2, t3; unpk8(q.g0, g0, g1); unpk8(q.g1, g2, g3); unpk8(q.t0, t0, t1); unpk8(q.t1, t2, t3);
        a0 = a0 * g0 + t0; a1 = a1 * g1 + t1; b0 = b0 * g2 + t2; b1 = b1 * g3 + t3;
        *(u32x4*)(M + o) = pk8(a0, a1); *(u32x4*)(M + o + 128) = pk8(b0, b1); } };
struct SchG3 { const bf16_t *A, *Bt; int G, c, K;
    __device__ __forceinline__ bool next(int i, Unit& u) const { const int L = i * G + c; if (L >= 512) return false; u.pm = L >> 2; u.pn = L & 3; return true; }
    __device__ __forceinline__ const bf16_t* arow(const Unit& u, int r) const { return A + (size_t)(u.pm * 256 + r) * 1024; }
    __device__ __forceinline__ const bf16_t* brow(const Unit& u, int n) const { return Bt + (size_t)(u.pn * 256 + n) * 1024; }
    __device__ __forceinline__ const char* abase(const Unit& u) const { return (const char*)(A + (size_t)u.pm * 256 * 1024); }
    __device__ __forceinline__ const char* bbase(const Unit& u) const { return (const char*)(Bt + (size_t)u.pn * 256 * 1024); }
    __device__ __forceinline__ unsigned aoff(const Unit&, int) const { return 0u; } };
struct EpiG3 { const float *X, *MOD; bf16_t* X1B;
    static constexpr int PF = 3; struct Col { f32x4 c0, c1, c2, c3; }; struct Pre { f32x4 x0, x1, x2, x3; };
    __device__ __forceinline__ Col col(const Unit& u, int j) const { const float* gt = MOD + ((u.pm * 256) / SEQ) * 6144 + 2 * 1024 + u.pn * 256 + j; return Col{*(const f32x4*)gt, *(const f32x4*)(gt + 4), *(const f32x4*)(gt + 128), *(const f32x4*)(gt + 132)}; }
    __device__ __forceinline__ Pre load(const Unit& u, int r, int j) const { const float* xp = X + ((size_t)u.pm * 256 + r) * 1024 + u.pn * 256 + j; return Pre{*(const f32x4*)xp, *(const f32x4*)(xp + 4), *(const f32x4*)(xp + 128), *(const f32x4*)(xp + 132)}; }
    __device__ __forceinline__ void apply(const Unit& u, int r, int j, const Col& c, const Pre& q, f32x4 a0, f32x4 a1, f32x4 b0, f32x4 b1) const {
        bf16_t* op = X1B + ((size_t)u.pm * 256 + r) * 1024 + u.pn * 256 + j;
        *(u32x4*)op = pk8(q.x0 + c.c0 * a0, q.x1 + c.c1 * a1); *(u32x4*)(op + 128) = pk8(q.x2 + c.c2 * b0, q.x3 + c.c3 * b1); } };
struct MoeMeta { const int* m;
    __device__ __forceinline__ int cnt(int e) const { return __builtin_amdgcn_readfirstlane(m[e]); }
    __device__ __forceinline__ int tb(int e) const { return __builtin_amdgcn_readfirstlane(m[16 + e]); }
    __device__ __forceinline__ int ntiles() const { return __builtin_amdgcn_readfirstlane(m[32]); }
    __device__ __forceinline__ int find(int mt) const { int e = 0;
#pragma unroll
        for (int k = 1; k < 16; ++k) e += (__builtin_amdgcn_readfirstlane(m[16 + k]) <= mt) ? 1 : 0;
        return e; } };
__device__ __forceinline__ void moe_meta_build(const Params& p, int* meta) {
    if (threadIdx.x == 0) { const unsigned* cnt = (const unsigned*)(p.ws + OFF_CTL); int t = 0;
        for (int e = 0; e < 16; ++e) { const int c = (int)__hip_atomic_load(cnt + e, __ATOMIC_RELAXED, __HIP_MEMORY_SCOPE_AGENT); meta[e] = c; meta[16 + e] = t; t += (c + 255) >> 8; }
        meta[32] = t; }
    __syncthreads();
}
struct SchUp { const bf16_t *HM, *W; const int* LIST; MoeMeta mm; int G, c, K; const int* idx;
    __device__ __forceinline__ bool next(int i, Unit& u) const { const int L = i * G + c; if (L >= 4 * mm.ntiles()) return false; const int mt = L >> 2; u.pn = L & 3; u.aux = mm.find(mt); u.aux2 = (mt - mm.tb(u.aux)) * 256; u.pm = mt | (i << 16); return true; }
    __device__ __forceinline__ const char* abase(const Unit&) const { return (const char*)HM; }
    __device__ __forceinline__ const char* bbase(const Unit& u) const { return (const char*)(W + ((size_t)u.aux * 1024 + u.pn * 256) * 1024); }
    __device__ __forceinline__ unsigned aoff(const Unit& u, int r) const { return (unsigned)idx[(u.pm >> 16) * 256 + r] * 2048u; }
    __device__ __forceinline__ const bf16_t* arow(const Unit& u, int r) const { int pos = u.aux2 + r; const int c = mm.cnt(u.aux); pos = pos < c ? pos : c - 1; return HM + (size_t)LIST[u.aux * NT + pos] * 1024; }
    __device__ __forceinline__ const bf16_t* brow(const Unit& u, int n) const { return W + ((size_t)u.aux * 1024 + u.pn * 256 + n) * 1024; } };
struct EpiUp { bf16_t* ACT; const float* WL; MoeMeta mm;
    static constexpr int PF = 2; struct Col { }; struct Pre { float wt; };
    __device__ __forceinline__ Col col(const Unit&, int) const { return Col{}; }
    __device__ __forceinline__ Pre load(const Unit& u, int r, int) const { const int pos = u.aux2 + r; return Pre{pos < mm.cnt(u.aux) ? WL[u.aux * NT + pos] : 0.f}; }
    __device__ __forceinline__ void apply(const Unit& u, int r, int j, const Col&, const Pre& q, f32x4 g0, f32x4 g1, f32x4 u0, f32x4 u1) const {
        if (u.aux2 + r >= mm.cnt(u.aux)) return;
#pragma unroll
        for (int e = 0; e < 4; ++e) { g0[e] = silu(g0[e]) * u0[e] * q.wt; g1[e] = silu(g1[e]) * u1[e] * q.wt; }
        *(u32x4*)(ACT + ((size_t)(u.pm & 0xffff) * 256 + r) * 512 + u.pn * 128 + j) = pk8(g0, g1); } };
struct SchDn { const bf16_t *ACT, *W; MoeMeta mm; int G, c, K;
    __device__ __forceinline__ bool next(int i, Unit& u) const { const int L = i * G + c; if (L >= 4 * mm.ntiles()) return false; const int mt = L >> 2; u.pn = L & 3; u.aux = mm.find(mt); u.aux2 = (mt - mm.tb(u.aux)) * 256; u.pm = mt; return true; }
    __device__ __forceinline__ const bf16_t* arow(const Unit& u, int r) const { return ACT + ((size_t)u.pm * 256 + r) * 512; }
    __device__ __forceinline__ const bf16_t* brow(const Unit& u, int n) const { return W + ((size_t)u.aux * 1024 + u.pn * 256 + n) * 512; }
    __device__ __forceinline__ const char* abase(const Unit& u) const { return (const char*)(ACT + (size_t)u.pm * 256 * 512); }
    __device__ __forceinline__ const char* bbase(const Unit& u) const { return (const char*)(W + ((size_t)u.aux * 1024 + u.pn * 256) * 512); }
    __device__ __forceinline__ unsigned aoff(const Unit&, int) const { return 0u; } };
struct EpiDn { bf16_t* Y; MoeMeta mm;
    static constexpr int PF = 1; struct Col { }; struct Pre { };
    __device__ __forceinline__ Col col(const Unit&, int) const { return Col{}; }
    __device__ __forceinline__ Pre load(const Unit&, int, int) const { return Pre{}; }
    __device__ __forceinline__ void apply(const Unit& u, int r, int j, const Col&, const Pre&, f32x4 a0, f32x4 a1, f32x4 b0, f32x4 b1) const {
        if (u.aux2 + r >= mm.cnt(u.aux)) return;
        bf16_t* o = Y + ((size_t)u.pm * 256 + r) * 1024 + u.pn * 256 + j; *(u32x4*)o = pk8(a0, a1); *(u32x4*)(o + 128) = pk8(b0, b1); } };

__device__ __forceinline__ void aprep_item(const Params& p, int g, unsigned char* lds) {
    const int tid = threadIdx.x, lane = tid & 63, wave = tid >> 6;
    const bf16_t* Z = (const bf16_t*)(p.ws + OFF_SLOT + 1 * SLOT);
    bf16_t* AA = (bf16_t*)(p.ws + OFF_SLOT + 0 * SLOT) + (size_t)g * 64 * 1024;
    const unsigned* zt = (const unsigned*)lds;
    { const u32x4* src = (const u32x4*)(Z + (size_t)g * 64 * 1024); u32x4* d = (u32x4*)lds;
        u32x4 tmp[16];
#pragma unroll
        for (int i = 0; i < 16; ++i) tmp[i] = src[tid + i * NTHR];
#pragma unroll
        for (int i = 0; i < 16; ++i) d[tid + i * NTHR] = tmp[i]; }
    __syncthreads();
    {
        f32x2 w[31];
        const float* cw = p.in[I_CONVW] + 2 * tid;
#pragma unroll
        for (int k = 0; k < 31; ++k) w[k] = *(const f32x2*)(cw + k * 1024);
        const f32x2 cb = *(const f32x2*)(p.in[I_CONVB] + 2 * tid);
#pragma unroll 1
        for (int tb = 0; tb < 4; ++tb) {
            f32x2 cz[16];
#pragma unroll
            for (int o = 0; o < 16; ++o) cz[o] = cb;
#pragma unroll
            for (int r0 = 0; r0 < 48; r0 += 8) {
                unsigned vv[8];
#pragma unroll
                for (int rr = 0; rr < 8; ++rr) if (r0 + rr < 46) { const int row = 16 * tb - 15 + r0 + rr; const bool ok = (unsigned)row < 64u; const unsigned t = zt[(ok ? row : 0) * 512 + tid]; vv[rr] = ok ? t : 0u; }
#pragma unroll
                for (int rr = 0; rr < 8; ++rr) { const int r = r0 + rr;
                    if (r < 46) { const f32x2 x = (f32x2){bflo(vv[rr]), bfhi(vv[rr])};
#pragma unroll
                        for (int o = 0; o < 16; ++o) { const int k = r - o; if (k >= 0 && k < 31) cz[o] += w[k] * x; } } }
            }
#pragma unroll
            for (int o = 0; o < 16; ++o) *(unsigned*)(AA + (size_t)(16 * tb + o) * 1024 + 2 * tid) = pk2(cz[o].x, cz[o].y);
        }
    }
    asm volatile("s_waitcnt vmcnt(0)" ::: "memory");
    __syncthreads();
    u32x4 ra[8], rb[8];
#pragma unroll
    for (int rr = 0; rr < 8; ++rr) { const bf16_t* rp = AA + (size_t)(wave * 8 + rr) * 1024 + lane * 8; ra[rr] = *(const u32x4*)rp; rb[rr] = *(const u32x4*)(rp + 512); }
    f32x4 lg0[2], lg1[2], lb0[2], lb1[2];
#pragma unroll
    for (int hh = 0; hh < 2; ++hh) { const int c0 = hh * 512 + lane * 8;
        lg0[hh] = *(const f32x4*)(p.in[I_LNG] + c0); lg1[hh] = *(const f32x4*)(p.in[I_LNG] + c0 + 4); lb0[hh] = *(const f32x4*)(p.in[I_LNB] + c0); lb1[hh] = *(const f32x4*)(p.in[I_LNB] + c0 + 4); }
#pragma unroll
    for (int rr = 0; rr < 8; ++rr) {
        const int row = wave * 8 + rr;
        f32x4 x0, x1, x2, x3; unpk8(ra[rr], x0, x1); unpk8(rb[rr], x2, x3);
        const f32x4 sv = (x0 + x1) + (x2 + x3);
        const float mean = wave_sum_dpp((sv[0] + sv[1]) + (sv[2] + sv[3])) * (1.0f / 1024.0f);
        x0 -= mean; x1 -= mean; x2 -= mean; x3 -= mean;
        const f32x4 qv = (x0 * x0 + x1 * x1) + (x2 * x2 + x3 * x3);
        const float rstd = rsqrtf(wave_sum_dpp((qv[0] + qv[1]) + (qv[2] + qv[3])) * (1.0f / 1024.0f) + 1e-6f);
        x0 = x0 * rstd * lg0[0] + lb0[0]; x1 = x1 * rstd * lg1[0] + lb1[0]; x2 = x2 * rstd * lg0[1] + lb0[1]; x3 = x3 * rstd * lg1[1] + lb1[1];
#pragma unroll
        for (int e = 0; e < 4; ++e) { x0[e] = silu(x0[e]); x1[e] = silu(x1[e]); x2[e] = silu(x2[e]); x3[e] = silu(x3[e]); }
        bf16_t* o = AA + (size_t)row * 1024 + lane * 8;
        *(u32x4*)o = pk8(x0, x1); *(u32x4*)(o + 512) = pk8(x2, x3);
    }
    __syncthreads();
}

constexpr int XC_STRIDE = 272;
constexpr int YB_STRIDE = 132;
constexpr int B_XC_OFF = 0, B_HIN_OFF = 256 * XC_STRIDE  , B_Y_OFF = B_HIN_OFF + 4096  , B_Y_BYTES = 64 * YB_STRIDE * 4  ;
constexpr size_t OFF_TOT256 = OFF_TOT + 9 * MiB;

__device__ __forceinline__ void lru_coef(float lr2, float li2, float nsp2, float xcv, float& a, float& b) {
    const float r = __builtin_amdgcn_rcpf(1.0f + __builtin_amdgcn_exp2f(lr2));
    a = __builtin_amdgcn_exp2f(nsp2 * r);
    const float v = __builtin_fmaf(-a, a, 1.0f);
    const float d = 1.0f + __builtin_amdgcn_exp2f(li2);
    b = (v * __builtin_amdgcn_rsqf(fmaxf(v * d * d, 1e-30f))) * xcv;
}

template <bool FINAL, int DIR>
__device__ __forceinline__ void lru_dir(const unsigned char* xcs, const bf16x8 (&fbr)[4], const bf16x8 (&fbi)[4], float br, float bi, float nsp, int fr, int q, int chl,
                                        float hin_v, f32x4 (&hout)[4], float& totA, float& totB) {
    f32x4 ar[4], ai[4];
#pragma unroll
    for (int m = 0; m < 4; ++m) { ar[m] = (f32x4){br, br, br, br}; ai[m] = (f32x4){bi, bi, bi, bi}; }
#pragma unroll
    for (int kk = 0; kk < 4; ++kk) {
#pragma unroll
        for (int m = 0; m < 4; ++m) { const bf16x8 fa = *(const bf16x8*)(xcs + (16 * m + fr) * XC_STRIDE + (32 * kk + 8 * q) * 2);
            ar[m] = __builtin_amdgcn_mfma_f32_16x16x32_bf16(fa, fbr[kk], ar[m], 0, 0, 0);
            ai[m] = __builtin_amdgcn_mfma_f32_16x16x32_bf16(fa, fbi[kk], ai[m], 0, 0, 0); }
    }
#pragma unroll
    for (int m = 0; m < 4; ++m)
#pragma unroll
        for (int i = 0; i < 4; ++i) {
            const float xcv = bf2f(*(const bf16_t*)(xcs + (16 * m + 4 * q + i) * XC_STRIDE + chl * 2));
            float a, b; lru_coef(ar[m][i], ai[m][i], nsp, xcv, a, b); ar[m][i] = a; ai[m][i] = b;
        }
    float At[4], Bt[4], Ae[4], Be[4];
#pragma unroll
    for (int m = 0; m < 4; ++m) {
        float A = 1.f, B = 0.f;
#pragma unroll
        for (int ii = 0; ii < 4; ++ii) { const int i = DIR ? 3 - ii : ii; B = ar[m][i] * B + ai[m][i]; A = ar[m][i] * A; }
        if (DIR == 0) {
            float tA = __shfl_up(A, 16), tB = __shfl_up(B, 16); if (q >= 1) { B = A * tB + B; A = A * tA; }
            tA = __shfl_up(A, 32); tB = __shfl_up(B, 32); if (q >= 2) { B = A * tB + B; A = A * tA; }
            Ae[m] = __shfl_up(A, 16); Be[m] = __shfl_up(B, 16); if (q == 0) { Ae[m] = 1.f; Be[m] = 0.f; }
            At[m] = __shfl(A, 48 + fr); Bt[m] = __shfl(B, 48 + fr);
        } else {
            float tA = __shfl_down(A, 16), tB = __shfl_down(B, 16); if (q <= 2) { B = A * tB + B; A = A * tA; }
            tA = __shfl_down(A, 32); tB = __shfl_down(B, 32); if (q <= 1) { B = A * tB + B; A = A * tA; }
            Ae[m] = __shfl_down(A, 16); Be[m] = __shfl_down(B, 16); if (q == 3) { Ae[m] = 1.f; Be[m] = 0.f; }
            At[m] = __shfl(A, fr); Bt[m] = __shfl(B, fr);
        }
    }
    if (!FINAL) {
        float A = 1.f, B = 0.f;
#pragma unroll
        for (int mm = 0; mm < 4; ++mm) { const int m = DIR ? 3 - mm : mm; B = At[m] * B + Bt[m]; A = At[m] * A; }
        totA = A; totB = B;
    } else {
        float hh = hin_v;
#pragma unroll
        for (int mm = 0; mm < 4; ++mm) { const int m = DIR ? 3 - mm : mm;
            float hs = Ae[m] * hh + Be[m];
#pragma unroll
            for (int ii = 0; ii < 4; ++ii) { const int i = DIR ? 3 - ii : ii; hs = ar[m][i] * hs + ai[m][i]; hout[m][i] = hs; }
            hh = At[m] * hh + Bt[m];
        }
    }
}

template <bool FINAL>
__device__ __forceinline__ void b_phase(const Params& p, int bid, int nb, unsigned char* lds) {
    const int tid = threadIdx.x, lane = tid & 63, wave = tid >> 6, fr = lane & 15, q = lane >> 4;
    f32x2* TOT = (f32x2*)(p.ws + OFF_TOT);
    f32x2* TOT256 = (f32x2*)(p.ws + OFF_TOT256);
    const bf16_t* WG = (const bf16_t*)(p.ws + OFF_WG);
    float* hin = (float*)(lds + B_HIN_OFF);
    const int chl = 16 * wave + fr;
    const int nitems = FINAL ? 1024 : 1024 + 128;
    int hprev = -1;
    bf16x8 fb[4][4];
    float* cst = (float*)(lds + B_Y_OFF + 2 * B_Y_BYTES);
    for (int it = bid; it < nitems; it += nb) {
        const bool isctx = it >= 1024;
        const int b = isctx ? (it - 1024) >> 5 : it >> 8, c256 = isctx ? -1 : (it >> 3) & 31, h = it & 7, csub = (it >> 3) & 3;
        const int seqlen = isctx ? CTXL : SEQ, sbase = isctx ? 0 : c256 * 256;
        const bf16_t* src = isctx ? (const bf16_t*)(p.ws + OFF_XRC) + (size_t)b * CTXL * 1024 : (const bf16_t*)(p.ws + OFF_SLOT + 3 * SLOT) + (size_t)b * SEQ * 1024;
        const int kc0 = isctx ? 0 : 4 + c256 * 4, k256 = isctx ? 0 : 1 + c256;
        const int ch = h * 128 + chl;
        if (h != hprev) {
            hprev = h;
#pragma unroll
            for (int ty = 0; ty < 4; ++ty)
#pragma unroll
                for (int kk = 0; kk < 4; ++kk) fb[ty][kk] = *(const bf16x8*)(WG + (size_t)(h * 512 + wave * 64 + ty * 16 + fr) * 128 + 32 * kk + 8 * q);
            if (q == 0) { const float L2E = 1.4426950408889634f;
                          cst[0 * 128 + chl] = -L2E * p.in[I_BRF][ch]; cst[1 * 128 + chl] = -L2E * p.in[I_BIF][ch]; cst[2 * 128 + chl] = -8.0f * L2E * log1pf(__expf(-p.in[I_LAMF][ch]));
                          cst[3 * 128 + chl] = -L2E * p.in[I_BRB][ch]; cst[4 * 128 + chl] = -L2E * p.in[I_BIB][ch]; cst[5 * 128 + chl] = -8.0f * L2E * log1pf(__expf(-p.in[I_LAMB][ch])); }
            wave_lds_sync();
        }
        float runAf = 1.f, runBf = 0.f, runAb = 1.f, runBb = 0.f;
        {
            const int cgp = tid & 15, c0 = h * 128 + 8 * cgp;
            float wk[4][8], bs[8];
            { const f32x4* bp = (const f32x4*)(p.in[I_LCB] + c0); const f32x4 t0_ = bp[0], t1_ = bp[1];
                bs[0] = t0_[0]; bs[1] = t0_[1]; bs[2] = t0_[2]; bs[3] = t0_[3]; bs[4] = t1_[0]; bs[5] = t1_[1]; bs[6] = t1_[2]; bs[7] = t1_[3];
#pragma unroll
                for (int k = 0; k < 4; ++k) { const f32x4* wp = (const f32x4*)(p.in[I_LCW] + k * 1024 + c0); const f32x4 w0 = wp[0], w1 = wp[1];
                    wk[k][0] = w0[0]; wk[k][1] = w0[1]; wk[k][2] = w0[2]; wk[k][3] = w0[3]; wk[k][4] = w1[0]; wk[k][5] = w1[1]; wk[k][6] = w1[2]; wk[k][7] = w1[3]; } }
#pragma unroll 1
            for (int ps = 0; ps < (isctx ? 1 : 2); ++ps) {
                if (isctx && tid >= 256) break;
                const int tq = isctx ? csub * 64 + (tid >> 4) * 4 : ps * 128 + (tid >> 4) * 4;
                float xc[4][8];
#pragma unroll
                for (int r = 0; r < 4; ++r)
#pragma unroll
                    for (int e = 0; e < 8; ++e) xc[r][e] = bs[e];
#pragma unroll
                for (int rr = 0; rr < 7; ++rr) {
                    const int row = sbase + tq + rr - 2;
                    u32x4 a = (u32x4){0u, 0u, 0u, 0u};
                    if (row >= 0 && row < seqlen) a = *(const u32x4*)(src + (size_t)row * 1024 + c0);
                    const float x[8] = {bflo(a.x), bfhi(a.x), bflo(a.y), bfhi(a.y), bflo(a.z), bfhi(a.z), bflo(a.w), bfhi(a.w)};
#pragma unroll
                    for (int r = 0; r < 4; ++r) { const int k = rr - r;
                        if (k >= 0 && k < 4) {
#pragma unroll
                            for (int e = 0; e < 8; ++e) xc[r][e] += wk[k][e] * x[e]; } }
                }
#pragma unroll
                for (int r = 0; r < 4; ++r) {
                    u32x4 o0; o0.x = pk2(xc[r][0], xc[r][1]); o0.y = pk2(xc[r][2], xc[r][3]); o0.z = pk2(xc[r][4], xc[r][5]); o0.w = pk2(xc[r][6], xc[r][7]);
                    *(u32x4*)(lds + B_XC_OFF + (tq + r) * XC_STRIDE + cgp * 16) = o0;
                }
            }
        }
        f32x2 ct[33], cs[4];
        const int cdir = (tid >> 7) & 1, ccl = tid & 127;
        if (FINAL && tid < 256) {
            const f32x2* T2 = TOT256 + ((size_t)b * 33 * 2 + cdir) * 1024 + h * 128 + ccl;
            const f32x2* T = TOT + ((size_t)b * NCH64 * 2 + cdir) * 1024 + h * 128 + ccl;
#pragma unroll
            for (int k = 1; k < 33; ++k) { const bool use = cdir == 0 ? (k < k256) : (k > k256); ct[k] = use ? T2[(size_t)k * 2048] : (f32x2){1.f, 0.f}; }
            { f32x2 c4[4];
#pragma unroll
                for (int s_ = 0; s_ < 4; ++s_) c4[s_] = T[(size_t)s_ * 2048];
                float A = 1.f, B = 0.f;
#pragma unroll
                for (int s_ = 0; s_ < 4; ++s_) { const f32x2 t = cdir == 0 ? c4[s_] : c4[3 - s_]; B = t.x * B + t.y; A = t.x * A; }
                ct[0] = (f32x2){A, B}; }
#pragma unroll
            for (int s_ = 0; s_ < 4; ++s_) cs[s_] = T[(size_t)(kc0 + s_) * 2048];
        }
        if (FINAL && tid < 256) {
            float hc = 0.f;
            if (cdir == 0) {
#pragma unroll
                for (int k = 0; k < 33; ++k) hc = ct[k].x * hc + ct[k].y;
#pragma unroll
                for (int s_ = 0; s_ < 4; ++s_) { hin[(s_ * 2 + 0) * 128 + ccl] = hc; hc = cs[s_].x * hc + cs[s_].y; }
            } else {
                hc = ct[0].y;
#pragma unroll
                for (int k = 32; k >= 1; --k) hc = ct[k].x * hc + ct[k].y;
#pragma unroll
                for (int s_ = 3; s_ >= 0; --s_) { hin[(s_ * 2 + 1) * 128 + ccl] = hc; hc = cs[s_].x * hc + cs[s_].y; }
            }
        }
        __syncthreads();
        for (int sub = isctx ? csub : 0; sub < (isctx ? csub + 1 : 4); ++sub) {
            const int t0 = sbase + 64 * sub;
            const unsigned char* xcs = lds + B_XC_OFF + 64 * sub * XC_STRIDE;
            f32x4 hf[4], hb[4]; float tA, tB;
            lru_dir<FINAL, 0>(xcs, fb[0], fb[1], cst[0 * 128 + chl], cst[1 * 128 + chl], cst[2 * 128 + chl], fr, q, chl, FINAL ? hin[(sub * 2 + 0) * 128 + chl] : 0.f, hf, tA, tB);
            if (!FINAL) { if (q == 0) TOT[((size_t)(b * NCH64 + kc0 + sub) * 2 + 0) * 1024 + ch] = (f32x2){tA, tB};
                runBf = tA * runBf + tB; runAf = tA * runAf; }
            u32x4 gy0, gy1;
            if (FINAL) { const bf16_t* GYG = (const bf16_t*)(p.ws + OFF_SLOT + 2 * SLOT) + ((size_t)b * SEQ + t0 + lane) * 1024 + h * 128 + 16 * wave;
                gy0 = *(const u32x4*)GYG; gy1 = *(const u32x4*)(GYG + 8); }
            lru_dir<FINAL, 1>(xcs, fb[2], fb[3], cst[3 * 128 + chl], cst[4 * 128 + chl], cst[5 * 128 + chl], fr, q, chl, FINAL ? hin[(sub * 2 + 1) * 128 + chl] : 0.f, hb, tA, tB);
            if (!FINAL) { if (q == 0) TOT[((size_t)(b * NCH64 + kc0 + sub) * 2 + 1) * 1024 + ch] = (f32x2){tA, tB};
                runBb = runAb * tB + runBb; runAb = runAb * tA; }
            if (FINAL) {
                float* wy = (float*)(lds + B_Y_OFF) + wave * (64 * 20);
#pragma unroll
                for (int m = 0; m < 4; ++m)
#pragma unroll
                    for (int i = 0; i < 4; ++i) wy[(16 * m + 4 * q + i) * 20 + fr] = hf[m][i] + hb[m][i];
                wave_lds_sync();
                const f32x4* yp = (const f32x4*)(wy + lane * 20);
                const f32x4 y0 = yp[0], y1 = yp[1], y2 = yp[2], y3 = yp[3];
                u32x4 o0, o1;
                o0.x = pk2(bflo(gy0.x) * y0[0], bfhi(gy0.x) * y0[1]); o0.y = pk2(bflo(gy0.y) * y0[2], bfhi(gy0.y) * y0[3]);
                o0.z = pk2(bflo(gy0.z) * y1[0], bfhi(gy0.z) * y1[1]); o0.w = pk2(bflo(gy0.w) * y1[2], bfhi(gy0.w) * y1[3]);
                o1.x = pk2(bflo(gy1.x) * y2[0], bfhi(gy1.x) * y2[1]); o1.y = pk2(bflo(gy1.y) * y2[2], bfhi(gy1.y) * y2[3]);
                o1.z = pk2(bflo(gy1.z) * y3[0], bfhi(gy1.z) * y3[1]); o1.w = pk2(bflo(gy1.w) * y3[2], bfhi(gy1.w) * y3[3]);
                bf16_t* AB = (bf16_t*)(p.ws + OFF_SLOT + 1 * SLOT) + ((size_t)b * SEQ + t0 + lane) * 1024 + h * 128 + 16 * wave;
                *(u32x4*)AB = o0; *(u32x4*)(AB + 8) = o1;
                wave_lds_sync();
            }
        }
        __syncthreads();
        if (!FINAL && q == 0 && !isctx) {
            TOT256[((size_t)(b * 33 + k256) * 2 + 0) * 1024 + ch] = (f32x2){runAf, runBf};
            TOT256[((size_t)(b * 33 + k256) * 2 + 1) * 1024 + ch] = (f32x2){runAb, runBb};
        }
    }
}

__device__ __forceinline__ void ph8_route(const Params& p, int bid, int nb, unsigned char* lds) {
    constexpr int NU = 1;
    const int tid = threadIdx.x, lane = tid & 63, wave = tid >> 6;
    float* Wl = (float*)lds;
    int* lcnt = (int*)(lds + 81920);
    int* lbase = lcnt + 16;
    int* tinfo = lcnt + 32;
    float* twt = (float*)(tinfo + 512);
#pragma unroll 1
    for (int kk = 0; kk < 2; ++kk) { const int k = tid + kk * NTHR;
        const f32x4 wg = *(const f32x4*)(p.in[I_WGRP] + k * 4);
        Wl[0 * 1024 + k] = wg[0]; Wl[1 * 1024 + k] = wg[1]; Wl[2 * 1024 + k] = wg[2]; Wl[3 * 1024 + k] = wg[3];
#pragma unroll
        for (int o4 = 0; o4 < 4; ++o4) { const f32x4 we = *(const f32x4*)(p.in[I_WER] + k * 16 + o4 * 4);
            Wl[(4 + o4 * 4 + 0) * 1024 + k] = we[0]; Wl[(4 + o4 * 4 + 1) * 1024 + k] = we[1]; Wl[(4 + o4 * 4 + 2) * 1024 + k] = we[2]; Wl[(4 + o4 * 4 + 3) * 1024 + k] = we[3]; } }
    __syncthreads();
    const float* MOD = (const float*)(p.ws + OFF_MOD);
    const bf16_t* X1B = (const bf16_t*)(p.ws + OFF_SLOT + 5 * SLOT);
    bf16_t* HM = (bf16_t*)(p.ws + OFF_SLOT + 2 * SLOT);
    unsigned* gcnt = (unsigned*)(p.ws + OFF_CTL);
    int* LIST = (int*)(p.ws + OFF_LIST); float* WLs = (float*)(p.ws + OFF_WL); int* ROUTE = (int*)(p.ws + OFF_ROUTE);
    float* bl = (float*)(lds + 81920 + 8192);
    if (tid < 20) bl[tid] = tid < 4 ? p.in[I_BGRP][tid] : p.in[I_BER][tid - 4];
    __syncthreads();
    for (int tile = bid; tile < NT / 128; tile += nb) {
        if (tid < 16) lcnt[tid] = 0;
        __syncthreads();
        const float* mrow = MOD + ((tile * 128) / SEQ) * 6144;
        f32x4 gq[4], shq[4], scq[4];
#pragma unroll
        for (int j = 0; j < 4; ++j) { const int c = lane * 4 + 256 * j; gq[j] = *(const f32x4*)(p.in[I_GFFN] + c); shq[j] = *(const f32x4*)(mrow + 3 * 1024 + c); scq[j] = *(const f32x4*)(mrow + 4 * 1024 + c); gq[j] = gq[j] * (1.0f + scq[j]); }
        u32x2 nx[4];
#pragma unroll
        for (int j = 0; j < 4; ++j) nx[j] = *(const u32x2*)(X1B + (size_t)(tile * 128 + wave * 16) * DM + lane * 4 + 256 * j);
#pragma unroll 1
        for (int tt = 0; tt < 16; tt += NU) {
            const int tl = wave * 16 + tt, tok = tile * 128 + tl;
            f32x4 v[NU][4]; float ss[NU];
#pragma unroll
            for (int u = 0; u < NU; ++u) ss[u] = 0.f;
#pragma unroll
            for (int j = 0; j < 4; ++j) { v[0][j] = (f32x4){bflo(nx[j].x), bfhi(nx[j].x), bflo(nx[j].y), bfhi(nx[j].y)}; const f32x4 sq = v[0][j] * v[0][j]; ss[0] += (sq[0] + sq[1]) + (sq[2] + sq[3]); }
            { const int tn = tt + 1 < 16 ? tok + 1 : tok;
#pragma unroll
                for (int j = 0; j < 4; ++j) nx[j] = *(const u32x2*)(X1B + (size_t)tn * DM + lane * 4 + 256 * j); }
            float lg[NU][20];
#pragma unroll
            for (int u = 0; u < NU; ++u) { const float rinv = rsqrtf(wave_sum_dpp(ss[u]) * (1.0f / DM) + 1e-6f);
#pragma unroll
                for (int j = 0; j < 4; ++j) { v[u][j] = v[u][j] * rinv * gq[j] + shq[j]; *(u32x2*)(HM + (size_t)(tok + u) * DM + lane * 4 + 256 * j) = pk4(v[u][j]); }
}
#pragma unroll
            for (int o = 0; o < 20; ++o)
            { f32x4 wv[4];
#pragma unroll
                for (int j = 0; j < 4; ++j) wv[j] = *(const f32x4*)(Wl + o * 1024 + lane * 4 + 256 * j);
#pragma unroll
                for (int u = 0; u < NU; ++u) { f32x4 pr = v[u][0] * wv[0]; pr += v[u][1] * wv[1]; pr += v[u][2] * wv[2]; pr += v[u][3] * wv[3]; lg[u][o] = (pr[0] + pr[1]) + (pr[2] + pr[3]); }
                if ((o & 3) == 3) asm volatile("" ::: "memory"); }
#pragma unroll
            for (int u = 0; u < NU; ++u) {
#pragma unroll
                for (int o = 0; o < 20; ++o) lg[u][o] = wave_sum_dpp(lg[u][o]) + bl[o];
                int gs = 0; float gm = lg[u][0];
#pragma unroll
                for (int o = 1; o < 4; ++o) if (lg[u][o] > gm) { gm = lg[u][o]; gs = o; }
                float den = 0.f;
#pragma unroll
                for (int o = 0; o < 4; ++o) den += __expf(lg[u][o] - gm);
                const float pg = 1.0f / den;
                float el[4];
#pragma unroll
                for (int o = 0; o < 4; ++o) el[o] = gs == 0 ? lg[u][4 + o] : gs == 1 ? lg[u][8 + o] : gs == 2 ? lg[u][12 + o] : lg[u][16 + o];
                int i1 = 0; float v1 = el[0];
#pragma unroll
                for (int o = 1; o < 4; ++o) if (el[o] > v1) { v1 = el[o]; i1 = o; }
                int i2 = -1; float v2 = -3.0e38f;
#pragma unroll
                for (int o = 0; o < 4; ++o) if (o != i1 && el[o] > v2) { v2 = el[o]; i2 = o; }
                const float w1 = 1.0f / (1.0f + __expf(v2 - v1)), w2 = 1.0f - w1;
                if (lane == 0) { const int e1 = gs * 4 + i1, e2 = gs * 4 + i2;
                    const int r1 = atomicAdd(&lcnt[e1], 1), r2 = atomicAdd(&lcnt[e2], 1);
                    tinfo[(tl + u) * 4 + 0] = e1; tinfo[(tl + u) * 4 + 1] = r1; tinfo[(tl + u) * 4 + 2] = e2; tinfo[(tl + u) * 4 + 3] = r2; twt[(tl + u) * 2] = pg * w1; twt[(tl + u) * 2 + 1] = pg * w2; }
            }
        }
        __syncthreads();
        if (tid < 16) lbase[tid] = (int)__hip_atomic_fetch_add(gcnt + tid, (unsigned)lcnt[tid], __ATOMIC_RELAXED, __HIP_MEMORY_SCOPE_AGENT);
        __syncthreads();
        if (tid < 128) { const int tok = tile * 128 + tid;
            const int e1 = tinfo[tid * 4], e2 = tinfo[tid * 4 + 2], p1 = lbase[e1] + tinfo[tid * 4 + 1], p2 = lbase[e2] + tinfo[tid * 4 + 3];
            LIST[e1 * NT + p1] = tok; LIST[e2 * NT + p2] = tok; WLs[e1 * NT + p1] = twt[tid * 2]; WLs[e2 * NT + p2] = twt[tid * 2 + 1];
            ROUTE[tok * 4 + 0] = e1; ROUTE[tok * 4 + 1] = p1; ROUTE[tok * 4 + 2] = e2; ROUTE[tok * 4 + 3] = p2; }
        __syncthreads();
    }
}

__device__ __forceinline__ void ph10_final(const Params& p, int bid, int nb, const int* meta) {
    const int lane = threadIdx.x & 63, wave = threadIdx.x >> 6;
    const float* MOD = (const float*)(p.ws + OFF_MOD);
    const bf16_t* Y = (const bf16_t*)(p.ws + OFF_SLOT);
    const int* ROUTE = (const int*)(p.ws + OFF_ROUTE);
    const bf16_t* X1B = (const bf16_t*)(p.ws + OFF_SLOT + 5 * SLOT); float* OUT = p.out;
    for (int r = bid * 8 + wave; r < NT; r += nb * 8) {
        const int e1 = ROUTE[r * 4], p1 = ROUTE[r * 4 + 1], e2 = ROUTE[r * 4 + 2], p2 = ROUTE[r * 4 + 3];
        const bf16_t* y1 = Y + ((size_t)meta[16 + e1] * 256 + p1) * 1024; const bf16_t* y2 = Y + ((size_t)meta[16 + e2] * 256 + p2) * 1024;
        const float* gt = MOD + (r / SEQ) * 6144 + 5 * 1024;
        f32x4 v[4]; float ss = 0.f;
#pragma unroll
        for (int j = 0; j < 4; ++j) { const int c = lane * 4 + 256 * j;
            { const u32x2 xb = *(const u32x2*)(X1B + (size_t)r * DM + c); v[j] = (f32x4){bflo(xb.x), bfhi(xb.x), bflo(xb.y), bfhi(xb.y)}; }
            const u32x2 a = *(const u32x2*)(y1 + c), bq = *(const u32x2*)(y2 + c); const f32x4 g = *(const f32x4*)(gt + c);
            v[j][0] += g[0] * (bflo(a.x) + bflo(bq.x)); v[j][1] += g[1] * (bfhi(a.x) + bfhi(bq.x)); v[j][2] += g[2] * (bflo(a.y) + bflo(bq.y)); v[j][3] += g[3] * (bfhi(a.y) + bfhi(bq.y));
            ss += v[j][0] * v[j][0] + v[j][1] * v[j][1] + v[j][2] * v[j][2] + v[j][3] * v[j][3]; }
        const float rinv = rsqrtf(wave_sum(ss) * (1.0f / DM) + 1e-6f);
#pragma unroll
        for (int j = 0; j < 4; ++j) { const int c = lane * 4 + 256 * j; const f32x4 g = *(const f32x4*)(p.in[I_GFINAL] + c);
            *(f32x4*)(OUT + (size_t)r * DM + c) = v[j] * rinv * g; }
    }
}


#define XB_TMO      128
#define XB_XCNT(j)  (256  + 64 * (j))
#define XB_XSUB(j)  (1280 + 64 * (j))
#define XB_XGEN(j)  (2304 + 64 * (j))
#define XB_TOP      3328
#define XB_TOPGEN   3392
#define XCD_BAR_WORDS 3456
#define XB_SPIN_CAP (1u << 18)
__device__ __forceinline__ unsigned xb_ld(unsigned* p)              { return __hip_atomic_load(p, __ATOMIC_RELAXED, __HIP_MEMORY_SCOPE_AGENT); }
__device__ __forceinline__ unsigned xb_add(unsigned* p, unsigned v) { return __hip_atomic_fetch_add(p, v, __ATOMIC_RELAXED, __HIP_MEMORY_SCOPE_AGENT); }
__device__ __forceinline__ unsigned xb_xcc_id() { return (unsigned)__builtin_amdgcn_s_getreg((3 << 11) | 20) & 0xFu; }
#define XB_SPIN(cond, bar) do { unsigned _sp = 0; while (cond) { __builtin_amdgcn_s_sleep(1); \
    if ((++_sp & 255u) == 0u) { if (xb_ld(&(bar)[XB_TMO])) break; if (_sp > XB_SPIN_CAP) { atomicAdd(&(bar)[XB_TMO], 1u); break; } } } } while (0)
struct XcdBarrier { unsigned* bar; unsigned x; volatile unsigned* st; };
__device__ __forceinline__ XcdBarrier xcd_barrier_post(unsigned* bar, volatile unsigned* st) {
    XcdBarrier b; b.bar = bar; b.x = xb_xcc_id(); b.st = st;
    if (threadIdx.x == 0) (void)xb_add(&bar[XB_XCNT(b.x)], 1u);
    return b;
}
__device__ __forceinline__ void xcd_barrier_complete(unsigned* bar, unsigned x, unsigned& nloc, unsigned& nx) {
    const unsigned G = gridDim.x * gridDim.y * gridDim.z;
    unsigned sum, cnt, mine, sp = 0u;
    for (;;) {
        sum = 0u; cnt = 0u; mine = 0u;
#pragma unroll
        for (unsigned j = 0; j < 16; ++j) { const unsigned c = xb_ld(&bar[XB_XCNT(j)]); sum += c; cnt += (c > 0u) ? 1u : 0u; mine = (j == x) ? c : mine; }
        if (sum == G) break;
        __builtin_amdgcn_s_sleep(1);
        if ((++sp & 255u) == 0u) { if (xb_ld(&bar[XB_TMO])) break; if (sp > XB_SPIN_CAP) { atomicAdd(&bar[XB_TMO], 1u); break; } }
    }
    nloc = mine > 0u ? mine : 1u; nx = cnt > 0u ? cnt : 1u;
}
__device__ __forceinline__ void xcd_barrier(const XcdBarrier& b) {
    asm volatile("s_waitcnt vmcnt(0)" ::: "memory");
    __syncthreads();
    if (threadIdx.x == 0) {
        unsigned* bar = b.bar;
        __builtin_amdgcn_s_waitcnt(0);
        unsigned nloc = b.st[0], nx = b.st[1];
        if (nloc == 0u) { xcd_barrier_complete(bar, b.x, nloc, nx); b.st[0] = nloc; b.st[1] = nx; }
        const unsigned old = xb_add(&bar[XB_XSUB(b.x)], 1u);
        const unsigned gen = old / nloc;
        if (old + 1u == (gen + 1u) * nloc) {
            __builtin_amdgcn_fence(__ATOMIC_RELEASE, "agent");
            asm volatile("s_waitcnt vmcnt(0)" ::: "memory");
            const unsigned og = xb_add(&bar[XB_TOP], 1u);
            const unsigned tg = og / nx;
            if (og + 1u == (tg + 1u) * nx) xb_add(&bar[XB_TOPGEN], 1u);
            else XB_SPIN(xb_ld(&bar[XB_TOPGEN]) == tg, bar);
            __builtin_amdgcn_fence(__ATOMIC_ACQUIRE, "agent");
            xb_add(&bar[XB_XGEN(b.x)], 1u);
            asm volatile("s_waitcnt vmcnt(0)" ::: "memory");
        } else {
            XB_SPIN(xb_ld(&bar[XB_XGEN(b.x)]) == gen, bar);
            __builtin_amdgcn_fence(__ATOMIC_ACQUIRE, "agent");
            asm volatile("s_waitcnt vmcnt(0)" ::: "memory");
        }
    }
    __syncthreads();
}
constexpr size_t OFF_BAR = OFF_CTL + 4096;

__global__ void __launch_bounds__(NTHR) mega(Params p, int lo, int hi) {
    extern __shared__ __attribute__((aligned(16))) unsigned char lds[];
    cg::grid_group grid = cg::this_grid();
    const int bid = blockIdx.x, nb = gridDim.x;
    unsigned char* ws = p.ws;
    bf16_t* S0 = (bf16_t*)(ws + OFF_SLOT), *S1 = (bf16_t*)(ws + OFF_SLOT + SLOT), *S2 = (bf16_t*)(ws + OFF_SLOT + 2 * SLOT), *S3 = (bf16_t*)(ws + OFF_SLOT + 3 * SLOT),
           *S4 = (bf16_t*)(ws + OFF_SLOT + 4 * SLOT), *S5 = (bf16_t*)(ws + OFF_SLOT + 5 * SLOT);
    const float* MOD = (const float*)(ws + OFF_MOD); const float* BINP = (const float*)(ws + OFF_BINP);
    int* meta = (int*)(lds + LDS_BYTES - 256);
#ifndef PHMASK
#define PHMASK 0x7ff
#endif
#define IN(k) (((PHMASK >> (k)) & 1) && lo <= (k) && (k) < hi)
#ifndef PIPE_MASK
#define PIPE_MASK 0x364
#endif
#define GEMM_RUN(k, gather, s, e) gemm_phase_pipe<gather>(lds, s, e)
    volatile unsigned* xst = (volatile unsigned*)(lds + LDS_BYTES - 16);
    if (threadIdx.x < 2) xst[threadIdx.x] = 0u;
    __syncthreads();
    XcdBarrier xbar; xbar.bar = (unsigned*)(ws + OFF_BAR); xbar.x = 0; xbar.st = xst;
    if (hi - lo > 1) xbar = xcd_barrier_post((unsigned*)(ws + OFF_BAR), xst);
    if (p.pv == 0x7eadbeef) grid.sync();
#define SEAM(k) do { if (IN(k) && IN((k) + 1)) xcd_barrier(xbar); } while (0)
    if (IN(0)) { ph0_prep(p, bid, nb, lds); } SEAM(0);
    if (IN(1)) { ph1_norm(p, bid, nb); } SEAM(1);
    if (IN(2)) {
        { SchCtx s{(const bf16_t*)(ws + OFF_HC), (const bf16_t*)(ws + OFF_WIN), nb, bid, 1024}; EpiCtx e{(bf16_t*)(ws + OFF_XRC), BINP}; GEMM_RUN(2, false, s, e); }
        { SchG1 s{S0, (const bf16_t*)(ws + OFF_WIN), nb, bid, 1024}; EpiG1 e{S1, S2, S3, S4, S5, BINP}; GEMM_RUN(2, false, s, e); }
    } SEAM(2);
    if (IN(3)) {
#ifndef NO_APREP
        for (int g = bid; g < 512; g += nb) aprep_item(p, g, lds);
#endif
#ifndef NO_BLOCAL
        b_phase<false>(p, bid, nb, lds);
#endif
    } SEAM(3);
    if (IN(4)) {
        b_phase<true>(p, bid, nb, lds);
    } SEAM(4);
    if (IN(5)) { SchG2 s{S0, S1, (const bf16_t*)(ws + OFF_WPA), (const bf16_t*)(ws + OFF_WPB), nb, bid, 1024}; EpiG2 e{S4, S5, S3}; GEMM_RUN(5, false, s, e); } SEAM(5);
    if (IN(6)) { SchG3 s{S3, (const bf16_t*)(ws + OFF_WO), nb, bid, 1024}; EpiG3 e{p.in[I_X], MOD, S5}; GEMM_RUN(6, false, s, e); } SEAM(6);
    if (IN(7)) { ph8_route(p, bid, nb, lds); } SEAM(7);
    if (IN(8)) { __syncthreads(); moe_meta_build(p, meta); MoeMeta mm{meta};
        int* idx = (int*)(lds + STAGE_BYTES);
        SchUp s{S2, (const bf16_t*)(ws + OFF_WGU), (const int*)(ws + OFF_LIST), mm, nb, bid, 1024, idx}; EpiUp e{S3, (const float*)(ws + OFF_WL), mm};
        { int iv[8]; bool ok[8];
#pragma unroll
            for (int i = 0; i < 8; ++i) { Unit u; ok[i] = s.next(i, u); iv[i] = 0;
                if (ok[i] && threadIdx.x < 256) { int pos = u.aux2 + (int)threadIdx.x; const int c = mm.cnt(u.aux); pos = pos < c ? pos : c - 1; iv[i] = s.LIST[u.aux * NT + pos]; } }
#pragma unroll
            for (int i = 0; i < 8; ++i) if (ok[i] && threadIdx.x < 256) idx[i * 256 + threadIdx.x] = iv[i]; }
        __syncthreads();
        GEMM_RUN(8, true, s, e); } SEAM(8);
    if (IN(9)) { __syncthreads(); moe_meta_build(p, meta); MoeMeta mm{meta};
        SchDn s{S3, (const bf16_t*)(ws + OFF_WDN), mm, nb, bid, 512}; EpiDn e{S0, mm}; GEMM_RUN(9, false, s, e); } SEAM(9);
    if (IN(10)) { __syncthreads(); moe_meta_build(p, meta); ph10_final(p, bid, nb, meta); }
#undef IN
#undef SEAM
}

extern "C" void kernel_launch(void* const* d_in, const int* in_sizes, int n_in, void* d_out, int out_size, void* d_ws, size_t ws_size, hipStream_t stream) {
    static int grid = 0;
    if (grid == 0) {
        if (n_in != 37 || out_size != NT * DM || ws_size < WS_END) { fprintf(stderr, "kernel_launch: unexpected shapes: n_in %d out %d ws %zu (need %zu)\n", n_in, out_size, ws_size, (size_t)WS_END); grid = -1; return; }
        int dev = 0, cus = 0, per_cu = 0;
        (void)hipGetDevice(&dev); (void)hipDeviceGetAttribute(&cus, hipDeviceAttributeMultiprocessorCount, dev);
        if (hipFuncSetAttribute((const void*)mega, hipFuncAttributeMaxDynamicSharedMemorySize, LDS_BYTES) != hipSuccess) { fprintf(stderr, "kernel_launch: hipFuncSetAttribute failed\n"); grid = -1; return; }
        if (hipOccupancyMaxActiveBlocksPerMultiprocessor(&per_cu, (const void*)mega, NTHR, LDS_BYTES) != hipSuccess || per_cu < 1) { fprintf(stderr, "kernel_launch: occupancy query says %d\n", per_cu); per_cu = 1; }
        (void)hipGetLastError();
        grid = cus * 1;
        fprintf(stderr, "kernel_launch: grid %d (cus %d, per_cu %d)\n", grid, cus, per_cu);
    }
    if (grid < 0) return;
    Params p{};
    for (int i = 0; i < 37; ++i) p.in[i] = (const float*)d_in[i];
    p.out = (float*)d_out; p.ws = (unsigned char*)d_ws;
#if ONE_LAUNCH
    (void)hipMemsetAsync((unsigned char*)d_ws + OFF_BAR, 0, XCD_BAR_WORDS * 4, stream);
    int lo = 0, hi = NPHASE; void* args[] = {&p, &lo, &hi};
    hipError_t e = hipLaunchCooperativeKernel((const void*)mega, dim3(grid), dim3(NTHR), args, LDS_BYTES, stream);
    if (e != hipSuccess) fprintf(stderr, "cooperative launch failed: %s (grid %d)\n", hipGetErrorString(e), grid);
#ifdef PROBE_PHASE
    hipLaunchKernelGGL(mega, dim3(grid), dim3(NTHR), LDS_BYTES, stream, p, PROBE_PHASE, PROBE_PHASE + 1);
#endif
#else
    for (int k = 0; k < NPHASE; ++k) hipLaunchKernelGGL(mega, dim3(grid), dim3(NTHR), LDS_BYTES, stream, p, k, k + 1);
#endif
}
```

```cpp
#include <hip/hip_runtime.h>
#include <hip/hip_cooperative_groups.h>
#include <cstdio>
#include <cstdint>
namespace cg = cooperative_groups;

#ifndef ONE_LAUNCH
#define ONE_LAUNCH 1
#endif

typedef unsigned short bf16_t;
typedef short bf16x8 __attribute__((ext_vector_type(8)));
typedef float f32x4 __attribute__((ext_vector_type(4)));
typedef float f32x2 __attribute__((ext_vector_type(2)));
typedef unsigned u32x4 __attribute__((ext_vector_type(4)));
typedef unsigned u32x2 __attribute__((ext_vector_type(2)));

constexpr int NT = 32768, NCX = 1024, DM = 1024, SEQ = 8192, CTXL = 256;
constexpr int NTHR = 512;
constexpr int NCH64 = 132;
constexpr size_t MiB = (size_t)1 << 20;
constexpr size_t OFF_CTL = 0, OFF_MOD = 1 * MiB, OFF_BINP = OFF_MOD + 128 * 1024, OFF_WIN = 2 * MiB, OFF_WPA = 14 * MiB, OFF_WPB = 16 * MiB,
                 OFF_WO = 18 * MiB, OFF_WG = 20 * MiB, OFF_WGU = 22 * MiB, OFF_WDN = 54 * MiB, OFF_HC = 70 * MiB, OFF_XRC = 72 * MiB,
                 OFF_TOT = 74 * MiB, OFF_ROUTE = 84 * MiB, OFF_LIST = 85 * MiB, OFF_WL = 87 * MiB, OFF_SLOT = 90 * MiB, SLOT = 64 * MiB,
                 WS_END = OFF_SLOT + 6 * SLOT;
constexpr int LDS_BYTES = 144 * 1024;
constexpr int NPHASE = 11;

struct Params { const float* in[37]; float* out; unsigned char* ws; int pv; int pad; };

enum { I_X = 0, I_C, I_CTX, I_CCTX, I_WADA, I_BADA, I_GMIX, I_WIN, I_BIN, I_CONVW, I_CONVB, I_LNG, I_LNB, I_WPA, I_LCW, I_LCB,
       I_WRF, I_BRF, I_WIF, I_BIF, I_LAMF, I_WRB, I_BRB, I_WIB, I_BIB, I_LAMB, I_WPB, I_WO, I_GFFN, I_WGRP, I_BGRP, I_WER, I_BER,
       I_WGATE, I_WUP, I_WDOWN, I_GFINAL };

__device__ __forceinline__ float bflo(unsigned w) { return __uint_as_float(w << 16); }
__device__ __forceinline__ float bfhi(unsigned w) { return __uint_as_float(w & 0xffff0000u); }
__device__ __forceinline__ float bf2f(bf16_t h) { return __uint_as_float(((unsigned)h) << 16); }
__device__ __forceinline__ unsigned pk2(float lo, float hi) { unsigned r; asm("v_cvt_pk_bf16_f32 %0, %1, %2" : "=v"(r) : "v"(lo), "v"(hi)); return r; }
__device__ __forceinline__ bf16_t f2bf(float f) { return (bf16_t)(pk2(f, 0.f) & 0xffffu); }
__device__ __forceinline__ float sigm(float x) { return __builtin_amdgcn_rcpf(1.0f + __expf(-x)); }
__device__ __forceinline__ float sigm2(float x2) { return __builtin_amdgcn_rcpf(1.0f + __builtin_amdgcn_exp2f(x2)); }
__device__ __forceinline__ float silu(float x) { return x * sigm(x); }
__device__ __forceinline__ float gelu_tanh(float x) { return x * sigm(1.5957691216057308f * (x + 0.044715f * x * x * x)); }
__device__ __forceinline__ float wave_sum(float v) {
#pragma unroll
    for (int o = 1; o < 64; o <<= 1) v += __shfl_xor(v, o);
    return v;
}
template <int CTRL, int RMASK> __device__ __forceinline__ float dpp_add(float v) { return v + __int_as_float(__builtin_amdgcn_update_dpp(0, __float_as_int(v), CTRL, RMASK, 0xF, false)); }
__device__ __forceinline__ float wave_sum_dpp(float v) {
    v = dpp_add<0xB1, 0xF>(v); v = dpp_add<0x4E, 0xF>(v); v = dpp_add<0x141, 0xF>(v); v = dpp_add<0x140, 0xF>(v); v = dpp_add<0x142, 0xA>(v); v = dpp_add<0x143, 0xC>(v);
    return __int_as_float(__builtin_amdgcn_readlane(__float_as_int(v), 63));
}
__device__ __forceinline__ void wave_lds_sync() { asm volatile("s_waitcnt lgkmcnt(0)" ::: "memory"); __builtin_amdgcn_wave_barrier(); }
__device__ __forceinline__ u32x2 pk4(f32x4 v) { u32x2 r; r.x = pk2(v[0], v[1]); r.y = pk2(v[2], v[3]); return r; }

__device__ __forceinline__ u32x4 pk8(f32x4 a, f32x4 b) { u32x4 r; r.x = pk2(a[0], a[1]); r.y = pk2(a[2], a[3]); r.z = pk2(b[0], b[1]); r.w = pk2(b[2], b[3]); return r; }
__device__ __forceinline__ void unpk8(u32x4 w, f32x4& a, f32x4& b) { a[0] = bflo(w.x); a[1] = bfhi(w.x); a[2] = bflo(w.y); a[3] = bfhi(w.y); b[0] = bflo(w.z); b[1] = bfhi(w.z); b[2] = bflo(w.w); b[3] = bfhi(w.w); }

template <class DRow>
__device__ __forceinline__ void tr_item(const float* __restrict__ src, int ldsrc, int k0, int n0, bf16_t* dst, int ldd, DRow drow, float* scr, int lane, float scale = 1.0f) {
    const float* sp = src + (size_t)k0 * ldsrc + n0 + lane;
    float tv[64];
#pragma unroll
    for (int kk = 0; kk < 64; ++kk) tv[kk] = sp[(size_t)kk * ldsrc];
#pragma unroll
    for (int kk = 0; kk < 64; ++kk) scr[kk * 65 + lane] = tv[kk] * scale;
    wave_lds_sync();
    const int c = lane & 7;
#pragma unroll
    for (int j = 0; j < 8; ++j) {
        const int n = (lane >> 3) + 8 * j; const float* s = scr + (8 * c) * 65 + n;
        u32x4 o; o.x = pk2(s[0], s[65]); o.y = pk2(s[130], s[195]); o.z = pk2(s[260], s[325]); o.w = pk2(s[390], s[455]);
        *(u32x4*)(dst + (size_t)drow(n0 + n) * ldd + k0 + 8 * c) = o;
    }
    wave_lds_sync();
}

__device__ __forceinline__ int win_srccol(int np) { const int p = np >> 8, r = np & 255; return p < 8 ? (r >> 7) * 1024 + 128 * p + (r & 127) : np; }

constexpr int N_WIN = 16 * 96, N_SQ = 16 * 16, N_G = 128, N_GU = 2048, N_DN = 2048;
constexpr int PREP_EARLY = N_WIN + 3 * N_SQ + N_G, PREP_ALL = PREP_EARLY + 2 * N_GU + N_DN;
__device__ __forceinline__ void prep_items(const Params& p, int first, int last, int gw, int NGW, unsigned char* lds) {
    const int lane = threadIdx.x & 63, wave = threadIdx.x >> 6;
    unsigned char* ws = p.ws;
    float* scr = (float*)lds + wave * (64 * 65);
    for (int it = first + gw; it < last; it += NGW) {
        int r = it;
        if (r < N_WIN) { const int kb = r / 96, nbk = r % 96, d0 = 64 * nbk, sc0 = win_srccol(d0);
            const int pt = d0 >> 8; const bool sgm = (pt < 8 && ((d0 >> 7) & 1)) || pt >= 16;
            tr_item(p.in[I_WIN], 6144, 64 * kb, sc0, (bf16_t*)(ws + OFF_WIN), 1024, [=](int n) { return n - sc0 + d0; }, scr, lane, sgm ? -1.4426950408889634f : 1.0f); continue; }
        r -= N_WIN;
        if (r < 3 * N_SQ) { const int which = r / N_SQ, q = r % N_SQ, kb = q / 16, nbk = q % 16;
            const float* src = which == 0 ? p.in[I_WPA] : which == 1 ? p.in[I_WPB] : p.in[I_WO];
            bf16_t* dst = (bf16_t*)(ws + (which == 0 ? OFF_WPA : which == 1 ? OFF_WPB : OFF_WO));
            tr_item(src, 1024, 64 * kb, 64 * nbk, dst, 1024, [=](int n) { return n; }, scr, lane); continue; }
        r -= 3 * N_SQ;
        if (r < N_G) { const int ty = r / 32, q = r % 32, h = q / 4, kb = (q % 4) / 2, nbk = q % 2;
            const float* src = (ty == 0 ? p.in[I_WRF] : ty == 1 ? p.in[I_WIF] : ty == 2 ? p.in[I_WRB] : p.in[I_WIB]) + (size_t)h * 128 * 128;
            tr_item(src, 128, 64 * kb, 64 * nbk, (bf16_t*)(ws + OFF_WG), 128, [=](int n) { return h * 512 + (n >> 4) * 64 + ty * 16 + (n & 15); }, scr, lane, -1.4426950408889634f); continue; }
        r -= N_G;
        if (r < 2 * N_GU) { const int bj = r / N_GU, q = r % N_GU, e = q / 128, kb = (q % 128) / 8, nbk = q % 8;
            const float* src = (bj == 0 ? p.in[I_WGATE] : p.in[I_WUP]) + (size_t)e * 1024 * 512;
            tr_item(src, 512, 64 * kb, 64 * nbk, (bf16_t*)(ws + OFF_WGU) + (size_t)e * 1024 * 1024, 1024, [=](int n) { return 256 * (n >> 7) + 128 * bj + (n & 127); }, scr, lane); continue; }
        r -= 2 * N_GU;
        { const int e = r / 128, kb = (r % 128) / 16, nbk = r % 16;
            tr_item(p.in[I_WDOWN] + (size_t)e * 512 * 1024, 1024, 64 * kb, 64 * nbk, (bf16_t*)(ws + OFF_WDN) + (size_t)e * 1024 * 512, 512, [=](int n) { return n; }, scr, lane); }
    }
}

__device__ __forceinline__ void ph0_prep(const Params& p, int bid, int nb, unsigned char* lds) {
    const int tid = threadIdx.x, lane = tid & 63, wave = tid >> 6;
    unsigned char* ws = p.ws;
    float* red = (float*)lds;
    float* MOD = (float*)(ws + OFF_MOD);
    for (int it = bid; it < 96; it += nb) {
        const int col = it * 64 + lane;
        float a[5] = {0.f, 0.f, 0.f, 0.f, 0.f};
        const float* W = p.in[I_WADA];
#pragma unroll 1
        for (int k0 = wave * 128; k0 < wave * 128 + 128; k0 += 64) {
            float wv[64];
#pragma unroll
            for (int kk = 0; kk < 64; ++kk) wv[kk] = W[(size_t)(k0 + kk) * 6144 + col];
#pragma unroll
            for (int kk = 0; kk < 64; ++kk)
#pragma unroll
                for (int r = 0; r < 5; ++r) { const float cv = r < 4 ? p.in[I_C][r * 1024 + k0 + kk] : p.in[I_CCTX][k0 + kk]; a[r] += silu(cv) * wv[kk]; }
        }
#pragma unroll
        for (int r = 0; r < 5; ++r) red[(wave * 5 + r) * 64 + lane] = a[r];
        __syncthreads();
        if (tid < 320) { const int r = tid / 64, l = tid % 64; float s = 0.f;
#pragma unroll
            for (int w = 0; w < 8; ++w) s += red[(w * 5 + r) * 64 + l];
            MOD[r * 6144 + it * 64 + l] = s + p.in[I_BADA][it * 64 + l]; }
        __syncthreads();
    }
    __syncthreads();
    if (nb > 96 + 32) { if (bid >= 96) prep_items(p, 0, PREP_EARLY, (bid - 96) * 8 + wave, (nb - 96) * 8, lds); }
    else prep_items(p, 0, PREP_EARLY, bid * 8 + wave, nb * 8, lds);
    float* BINP = (float*)(ws + OFF_BINP);
    for (int i = bid * NTHR + tid; i < 6144; i += nb * NTHR) { const int pt = i >> 8; const bool sgm = (pt < 8 && ((i >> 7) & 1)) || pt >= 16; BINP[i] = p.in[I_BIN][win_srccol(i)] * (sgm ? -1.4426950408889634f : 1.0f); }
    if (bid == 0 && tid < 64) ((unsigned*)(ws + OFF_CTL))[tid] = 0u;
}

__device__ __forceinline__ void ph1_norm(const Params& p, int bid, int nb) {
    const int lane = threadIdx.x & 63, wave = threadIdx.x >> 6;
    const float* MOD = (const float*)(p.ws + OFF_MOD);
    f32x4 gm[4];
#pragma unroll
    for (int j = 0; j < 4; ++j) gm[j] = *(const f32x4*)(p.in[I_GMIX] + lane * 4 + 256 * j);
    const int r0 = bid * 8 + wave, rs = nb * 8;
    f32x4 nx[4];
    { const float* src = r0 < NT ? p.in[I_X] + (size_t)r0 * DM : p.in[I_CTX] + (size_t)(r0 - NT) * DM;
#pragma unroll
        for (int j = 0; j < 4; ++j) nx[j] = *(const f32x4*)(src + lane * 4 + 256 * j); }
#pragma unroll 1
    for (int r = r0; r < NT + NCX; r += rs) {
        const bool lat = r < NT;
        bf16_t* dst = lat ? (bf16_t*)(p.ws + OFF_SLOT) + (size_t)r * DM : (bf16_t*)(p.ws + OFF_HC) + (size_t)(r - NT) * DM;
        const float* mrow = MOD + (lat ? r / SEQ : 4) * 6144;
        f32x4 v[4]; float ss = 0.f;
#pragma unroll
        for (int j = 0; j < 4; ++j) { v[j] = nx[j]; const f32x4 sq = v[j] * v[j]; ss += (sq[0] + sq[1]) + (sq[2] + sq[3]); }
        { const int rn = r + rs < NT + NCX ? r + rs : r;
            const float* src = rn < NT ? p.in[I_X] + (size_t)rn * DM : p.in[I_CTX] + (size_t)(rn - NT) * DM;
#pragma unroll
            for (int j = 0; j < 4; ++j) nx[j] = *(const f32x4*)(src + lane * 4 + 256 * j); }
        const float rinv = rsqrtf(wave_sum_dpp(ss) * (1.0f / DM) + 1e-6f);
#pragma unroll
        for (int j = 0; j < 4; ++j) { const int c = lane * 4 + 256 * j;
            const f32x4 sh = *(const f32x4*)(mrow + c), sc = *(const f32x4*)(mrow + 1024 + c);
            const f32x4 o = v[j] * rinv * gm[j] * (1.0f + sc) + sh;
            *(u32x2*)(dst + c) = pk4(o); }
    }
}

struct Unit { int pm, pn, aux, aux2; };

#define LAS __attribute__((address_space(3)))
constexpr int BK = 64, HTB = 128 * BK * 2, STAGE_BYTES = 8 * HTB;
__device__ __forceinline__ int lds_byte(int r, int c) { const int st = (r >> 4) * 2 + (c >> 5), rr = r & 15, cc = c & 31, ob = rr * 64 + cc * 2; return st * 1024 + (ob ^ (((ob >> 9) & 1) << 5)); }
__device__ __forceinline__ void stage_rc(int b, int& R, int& C) { const int st = b / 1024, sb = b % 1024, swz = sb ^ (((sb >> 9) & 1) << 5); R = (st >> 1) * 16 + swz / 64; C = (st & 1) * 32 + (swz % 64) / 2; }

template <bool GATHER, class S, class E>
__device__ __forceinline__ void gemm_phase_pipe(unsigned char* ldsg, const S& sch, const E& epi) {
    LAS unsigned char* lds = (LAS unsigned char*)ldsg;
    const int tid = threadIdx.x, wid = __builtin_amdgcn_readfirstlane(tid >> 6), lane = tid & 63, wr = wid >> 2, wc = wid & 3, fr = lane & 15, fq = lane >> 4;
    const int K = sch.K, nt = K / BK;
    int Rr[2], Cc[2]; unsigned voffA[2], voffB[2];
#pragma unroll
    for (int i = 0; i < 2; ++i) { stage_rc(tid * 16 + i * 8192, Rr[i], Cc[i]); voffA[i] = (unsigned)(Rr[i] * K + Cc[i]) * 2u;
        const int rho = Rr[i] & 31, Rb = (Rr[i] & ~31) + 8 * ((rho & 15) >> 2) + 4 * (rho >> 4) + (rho & 3);
        voffB[i] = (unsigned)(Rb * K + Cc[i]) * 2u; }
    const size_t kstep = (size_t)(BK * 2);
    const size_t hstep = (size_t)128 * K * 2;
    const unsigned ldsw = (unsigned)wid * 1024u;
    const int aoff = lds_byte(wr * 64 + fr, fq * 8), boff = lds_byte(wc * 32 + fr, fq * 8);
#define PG8_SA(b, h) (((b) * 2 + (h)) * HTB)
#define PG8_SB(b, h) ((4 + (b) * 2 + (h)) * HTB)
#define PG8_STAGE_B(bufoff, gbase) do { _Pragma("unroll") for (int _i = 0; _i < 2; ++_i) \
        __builtin_amdgcn_global_load_lds((const unsigned*)((const char*)(gbase) + voffB[_i]), (LAS unsigned*)(lds + (bufoff) + ldsw + _i * 8192), 16, 0, 0); } while (0)
#define PG8_STAGE_A(bufoff, gbase, h, vo) do { _Pragma("unroll") for (int _i = 0; _i < 2; ++_i) \
        __builtin_amdgcn_global_load_lds((const unsigned*)((const char*)(gbase) + (GATHER ? (size_t)(vo)[h][_i] : (size_t)(h) * hstep + voffA[_i])), (LAS unsigned*)(lds + (bufoff) + ldsw + _i * 8192), 16, 0, 0); } while (0)
#define PG8_LDA(dst, b, h) do { _Pragma("unroll") for (int m = 0; m < 4; ++m) _Pragma("unroll") for (int k = 0; k < 2; ++k) dst[m][k] = *(const LAS bf16x8*)(lds + PG8_SA(b, h) + aoff + m * 2048 + k * 1024); } while (0)
#define PG8_LDB(dst, b, h) do { _Pragma("unroll") for (int n = 0; n < 2; ++n) _Pragma("unroll") for (int k = 0; k < 2; ++k) dst[n][k] = *(const LAS bf16x8*)(lds + PG8_SB(b, h) + boff + n * 2048 + k * 1024); } while (0)
#define PG8_MMA(ai, bj, At, Bt) do { __builtin_amdgcn_s_setprio(1); _Pragma("unroll") for (int m = 0; m < 4; ++m) _Pragma("unroll") for (int n = 0; n < 2; ++n) _Pragma("unroll") for (int k = 0; k < 2; ++k) \
        acc[ai][bj][m][n] = __builtin_amdgcn_mfma_f32_16x16x32_bf16(Bt[n][k], At[m][k], acc[ai][bj][m][n], 0, 0, 0); __builtin_amdgcn_s_setprio(0); } while (0)
#define PG8_WAIT_V(n) asm volatile("s_waitcnt vmcnt(" #n ")" ::: "memory")
#define PG8_WAIT_L(n) asm volatile("s_waitcnt lgkmcnt(" #n ")" ::: "memory")
#define PG8_BAR __builtin_amdgcn_s_barrier()
#define PG8_SCHED __builtin_amdgcn_sched_barrier(0)
    Unit cur, nxt; int ui = 0;
    if (!sch.next(0, cur)) return;
    f32x4 acc[2][2][4][2];
#pragma unroll
    for (int a = 0; a < 2; ++a)
#pragma unroll
        for (int b = 0; b < 2; ++b)
#pragma unroll
            for (int m = 0; m < 4; ++m)
#pragma unroll
                for (int n = 0; n < 2; ++n) acc[a][b][m][n] = (f32x4){0.f, 0.f, 0.f, 0.f};
    bf16x8 At[4][2], B0[2][2], B1[2][2];
    unsigned voAc[2][2], voAn[2][2];
#pragma unroll
    for (int h = 0; h < 2; ++h)
#pragma unroll
        for (int i = 0; i < 2; ++i) { voAc[h][i] = GATHER ? sch.aoff(cur, 128 * h + Rr[i]) + (unsigned)Cc[i] * 2u : 0u; voAn[h][i] = voAc[h][i]; }
    const char* cA = sch.abase(cur); const char* cB = sch.bbase(cur);
    PG8_STAGE_B(PG8_SB(0, 0), cB); PG8_STAGE_A(PG8_SA(0, 0), cA, 0, voAc); PG8_STAGE_B(PG8_SB(0, 1), cB + hstep); PG8_STAGE_A(PG8_SA(0, 1), cA, 1, voAc);
    if (wr == 1) PG8_BAR;
    PG8_WAIT_V(4); PG8_BAR;
    PG8_STAGE_B(PG8_SB(1, 0), cB + kstep); PG8_STAGE_A(PG8_SA(1, 0), cA + kstep, 0, voAc); PG8_STAGE_B(PG8_SB(1, 1), cB + hstep + kstep);
    PG8_WAIT_V(6); PG8_BAR;
    for (;;) {
        const bool has_next = sch.next(ui + 1, nxt);
        const char* nA = has_next ? sch.abase(nxt) : cA; const char* nB = has_next ? sch.bbase(nxt) : cB;
        if (GATHER) {
#pragma unroll
            for (int h = 0; h < 2; ++h)
#pragma unroll
                for (int i = 0; i < 2; ++i) voAn[h][i] = has_next ? sch.aoff(nxt, 128 * h + Rr[i]) + (unsigned)Cc[i] * 2u : voAc[h][i];
        }
#pragma unroll 1
        for (int t = 0; t < nt; t += 2) {
            const bool last = (t == nt - 2);
            const char* a1 = cA + (size_t)(t + 1) * kstep;
            const char* a2 = last ? nA : cA + (size_t)(t + 2) * kstep; const char* b2 = last ? nB : cB + (size_t)(t + 2) * kstep;
            const char* a3 = a2 + kstep; const char* b3 = b2 + kstep;
            unsigned vo2[2][2];
#pragma unroll
            for (int h = 0; h < 2; ++h)
#pragma unroll
                for (int i = 0; i < 2; ++i) vo2[h][i] = last ? voAn[h][i] : voAc[h][i];
            PG8_LDB(B0, 0, 0); PG8_SCHED; PG8_LDA(At, 0, 0); PG8_STAGE_A(PG8_SA(1, 1), a1, 1, voAc);
            PG8_WAIT_L(8); PG8_BAR; PG8_WAIT_L(0); PG8_MMA(0, 0, At, B0); PG8_BAR; PG8_SCHED;
            PG8_LDB(B1, 0, 1); PG8_STAGE_B(PG8_SB(0, 0), b2);
            PG8_BAR; PG8_WAIT_L(0); PG8_MMA(0, 1, At, B1); PG8_BAR;
            PG8_LDA(At, 0, 1); PG8_STAGE_A(PG8_SA(0, 0), a2, 0, vo2);
            PG8_BAR; PG8_WAIT_L(0); PG8_MMA(1, 0, At, B0); PG8_BAR; PG8_SCHED;
            PG8_STAGE_B(PG8_SB(0, 1), b2 + hstep);
            PG8_WAIT_V(6); PG8_BAR; PG8_MMA(1, 1, At, B1); PG8_BAR;
            PG8_LDB(B0, 1, 0); PG8_SCHED; PG8_LDA(At, 1, 0); PG8_STAGE_A(PG8_SA(0, 1), a2, 1, vo2);
            PG8_WAIT_L(8); PG8_BAR; PG8_WAIT_L(0); PG8_MMA(0, 0, At, B0); PG8_BAR; PG8_SCHED;
            PG8_LDB(B1, 1, 1); PG8_STAGE_B(PG8_SB(1, 0), b3);
            PG8_BAR; PG8_WAIT_L(0); PG8_MMA(0, 1, At, B1); PG8_BAR;
            PG8_LDA(At, 1, 1); PG8_STAGE_A(PG8_SA(1, 0), a3, 0, vo2);
            PG8_BAR; PG8_WAIT_L(0); PG8_MMA(1, 0, At, B0); PG8_BAR; PG8_SCHED;
            PG8_STAGE_B(PG8_SB(1, 1), b3 + hstep);
            PG8_WAIT_V(6); PG8_BAR; PG8_MMA(1, 1, At, B1); PG8_BAR;
        }
        { int frx = fr, fqx = fq; asm volatile("" : "+v"(frx), "+v"(fqx));
            const int jx = wc * 32 + 8 * fqx, rx = wr * 64 + frx;
            const typename E::Col ecol = epi.col(cur, jx);
            constexpr int PF = E::PF;
            typename E::Pre epre[8];
#pragma unroll
            for (int g = 0; g < PF; ++g) epre[g] = epi.load(cur, (g >> 2) * 128 + (g & 3) * 16 + rx, jx);
#pragma unroll
            for (int g = 0; g < 8; ++g) { const int ai = g >> 2, m = g & 3;
                if (g + PF < 8) epre[g + PF] = epi.load(cur, ((g + PF) >> 2) * 128 + ((g + PF) & 3) * 16 + rx, jx);
                epi.apply(cur, ai * 128 + m * 16 + rx, jx, ecol, epre[g], acc[ai][0][m][0], acc[ai][0][m][1], acc[ai][1][m][0], acc[ai][1][m][1]); } }
        if (!has_next) break;
#pragma unroll
        for (int a = 0; a < 2; ++a)
#pragma unroll
            for (int b = 0; b < 2; ++b)
#pragma unroll
                for (int m = 0; m < 4; ++m)
#pragma unroll
                    for (int n = 0; n < 2; ++n) acc[a][b][m][n] = (f32x4){0.f, 0.f, 0.f, 0.f};
        cur = nxt; cA = nA; cB = nB; ++ui;
#pragma unroll
        for (int h = 0; h < 2; ++h)
#pragma unroll
            for (int i = 0; i < 2; ++i) voAc[h][i] = voAn[h][i];
    }
    PG8_WAIT_V(0);
    if (wr == 0) PG8_BAR;
    PG8_BAR;
#undef PG8_SA
#undef PG8_SB
#undef PG8_STAGE_A
#undef PG8_STAGE_B
#undef PG8_LDA
#undef PG8_LDB
#undef PG8_MMA
#undef PG8_WAIT_V
#undef PG8_WAIT_L
#undef PG8_BAR
#undef PG8_SCHED
}

struct SchG1 { const bf16_t *A, *Bt; int G, c, K;
    __device__ __forceinline__ bool next(int i, Unit& u) const { const int L = i * G + c; if (L >= 128 * 24) return false; u.pm = L / 24; u.pn = L % 24; return true; }
    __device__ __forceinline__ const bf16_t* arow(const Unit& u, int r) const { return A + (size_t)(u.pm * 256 + r) * 1024; }
    __device__ __forceinline__ const bf16_t* brow(const Unit& u, int n) const { return Bt + (size_t)(u.pn * 256 + n) * 1024; }
    __device__ __forceinline__ const char* abase(const Unit& u) const { return (const char*)(A + (size_t)u.pm * 256 * 1024); }
    __device__ __forceinline__ const char* bbase(const Unit& u) const { return (const char*)(Bt + (size_t)u.pn * 256 * 1024); }
    __device__ __forceinline__ unsigned aoff(const Unit&, int) const { return 0u; } };
struct EpiG1 { bf16_t *Z, *GYG, *XR, *SGA, *SGB; const float* bias;
    static constexpr int PF = 1; struct Col { f32x4 c0, c1, c2, c3; }; struct Pre { };
    __device__ __forceinline__ Col col(const Unit& u, int j) const { const float* bp = bias + u.pn * 256 + j; return Col{*(const f32x4*)bp, *(const f32x4*)(bp + 4), *(const f32x4*)(bp + 128), *(const f32x4*)(bp + 132)}; }
    __device__ __forceinline__ Pre load(const Unit&, int, int) const { return Pre{}; }
    __device__ __forceinline__ void apply(const Unit& u, int r, int j, const Col& c, const Pre&, f32x4 a0, f32x4 a1, f32x4 b0, f32x4 b1) const {
        const size_t row = (size_t)u.pm * 256 + r;
        a0 += c.c0; a1 += c.c1; b0 += c.c2; b1 += c.c3;
        if (u.pn < 8) {
#pragma unroll
            for (int e = 0; e < 4; ++e) { a0[e] *= sigm2(b0[e]); a1[e] *= sigm2(b1[e]); }
            *(u32x4*)(Z + row * 1024 + u.pn * 128 + j) = pk8(a0, a1); }
        else { const int kind = u.pn >> 2;
            bf16_t* dst = GYG + (size_t)(kind - 2) * (SLOT / 2);
#pragma unroll
            for (int e = 0; e < 4; ++e) { if (kind == 2) { a0[e] = gelu_tanh(a0[e]); a1[e] = gelu_tanh(a1[e]); b0[e] = gelu_tanh(b0[e]); b1[e] = gelu_tanh(b1[e]); }
                else if (kind >= 4) { a0[e] = sigm2(a0[e]); a1[e] = sigm2(a1[e]); b0[e] = sigm2(b0[e]); b1[e] = sigm2(b1[e]); } }
            bf16_t* o = dst + row * 1024 + (u.pn & 3) * 256 + j;
            *(u32x4*)o = pk8(a0, a1); *(u32x4*)(o + 128) = pk8(b0, b1); }
    } };
struct SchCtx { const bf16_t *A, *Bt; int G, c, K;
    __device__ __forceinline__ bool next(int i, Unit& u) const { const int L = i * G + c; if (L >= 16) return false; u.pm = L / 4; u.pn = L % 4; return true; }
    __device__ __forceinline__ const bf16_t* arow(const Unit& u, int r) const { return A + (size_t)(u.pm * 256 + r) * 1024; }
    __device__ __forceinline__ const bf16_t* brow(const Unit& u, int n) const { return Bt + (size_t)((12 + u.pn) * 256 + n) * 1024; }
    __device__ __forceinline__ const char* abase(const Unit& u) const { return (const char*)(A + (size_t)u.pm * 256 * 1024); }
    __device__ __forceinline__ const char* bbase(const Unit& u) const { return (const char*)(Bt + (size_t)(12 + u.pn) * 256 * 1024); }
    __device__ __forceinline__ unsigned aoff(const Unit&, int) const { return 0u; } };
struct EpiCtx { bf16_t* XRC; const float* bias;
    static constexpr int PF = 1; struct Col { f32x4 c0, c1, c2, c3; }; struct Pre { };
    __device__ __forceinline__ Col col(const Unit& u, int j) const { const float* bp = bias + (12 + u.pn) * 256 + j; return Col{*(const f32x4*)bp, *(const f32x4*)(bp + 4), *(const f32x4*)(bp + 128), *(const f32x4*)(bp + 132)}; }
    __device__ __forceinline__ Pre load(const Unit&, int, int) const { return Pre{}; }
    __device__ __forceinline__ void apply(const Unit& u, int r, int j, const Col& c, const Pre&, f32x4 a0, f32x4 a1, f32x4 b0, f32x4 b1) const {
        const size_t row = (size_t)u.pm * 256 + r;
        a0 += c.c0; a1 += c.c1; b0 += c.c2; b1 += c.c3;
        bf16_t* o = XRC + row * 1024 + u.pn * 256 + j; *(u32x4*)o = pk8(a0, a1); *(u32x4*)(o + 128) = pk8(b0, b1); } };
struct SchG2 { const bf16_t *Aa, *Ab, *Wa, *Wb; int G, c, K;
    __device__ __forceinline__ bool next(int i, Unit& u) const { const int t = (i >> 1) * G + c; if (t >= 512) return false; u.pm = t >> 2; u.pn = t & 3; u.aux = i & 1; return true; }
    __device__ __forceinline__ const bf16_t* arow(const Unit& u, int r) const { return Aa + (size_t)u.aux * (SLOT / 2) + (size_t)(u.pm * 256 + r) * 1024; }
    __device__ __forceinline__ const bf16_t* brow(const Unit& u, int n) const { return Wa + (size_t)u.aux * (1024 * 1024) + (size_t)(u.pn * 256 + n) * 1024; }
    __device__ __forceinline__ const char* abase(const Unit& u) const { return (const char*)(Aa + (size_t)u.aux * (SLOT / 2) + (size_t)u.pm * 256 * 1024); }
    __device__ __forceinline__ const char* bbase(const Unit& u) const { return (const char*)(Wa + (size_t)u.aux * (1024 * 1024) + (size_t)u.pn * 256 * 1024); }
    __device__ __forceinline__ unsigned aoff(const Unit&, int) const { return 0u; } };
struct EpiG2 { const bf16_t *SGA, *SGB; bf16_t* M;
    static constexpr int PF = 2; struct Col { }; struct Pre { u32x4 g0, g1, t0, t1; };
    __device__ __forceinline__ Col col(const Unit&, int) const { return Col{}; }
    __device__ __forceinline__ Pre load(const Unit& u, int r, int j) const {
        const size_t o = ((size_t)u.pm * 256 + r) * 1024 + u.pn * 256 + j; const bf16_t* G = SGA + (size_t)u.aux * (SLOT / 2);
        Pre q; q.g0 = *(const u32x4*)(G + o); q.g1 = *(const u32x4*)(G + o + 128);
        if (u.aux) { q.t0 = *(const u32x4*)(M + o); q.t1 = *(const u32x4*)(M + o + 128); } else { q.t0 = (u32x4){0u, 0u, 0u, 0u}; q.t1 = q.t0; }
        return q; }
    __device__ __forceinline__ void apply(const Unit& u, int r, int j, const Col&, const Pre& q, f32x4 a0, f32x4 a1, f32x4 b0, f32x4 b1) const {
        const size_t o = ((size_t)u.pm * 256 + r) * 1024 + u.pn * 256 + j;
        f32x4 g0, g1, g2, g3, t0, t1, t2, t3; unpk8(q.g0, g0, g1); unpk8(q.g1, g2, g3); unpk8(q.t0, t0, t1); unpk8(q.t1, t2, t3);
        a0 = a0 * g0 + t0; a1 = a1 * g1 + t1; b0 = b0 * g2 + t2; b1 = b1 * g3 + t3;
        *(u32x4*)(M + o) = pk8(a0, a1); *(u32x4*)(M + o + 128) = pk8(b0, b1); } };
struct SchG3 { const bf16_t *A, *Bt; int G, c, K;
    __device__ __forceinline__ bool next(int i, Unit& u) const { const int L = i * G + c; if (L >= 512) return false; u.pm = L >> 2; u.pn = L & 3; return true; }
    __device__ __forceinline__ const bf16_t* arow(const Unit& u, int r) const { return A + (size_t)(u.pm * 256 + r) * 1024; }
    __device__ __forceinline__ const bf16_t* brow(const Unit& u, int n) const { return Bt + (size_t)(u.pn * 256 + n) * 1024; }
    __device__ __forceinline__ const char* abase(const Unit& u) const { return (const char*)(A + (size_t)u.pm * 256 * 1024); }
    __device__ __forceinline__ const char* bbase(const Unit& u) const { return (const char*)(Bt + (size_t)u.pn * 256 * 1024); }
    __device__ __forceinline__ unsigned aoff(const Unit&, int) const { return 0u; } };
struct EpiG3 { const float *X, *MOD; bf16_t* X1B;
    static constexpr int PF = 3; struct Col { f32x4 c0, c1, c2, c3; }; struct Pre { f32x4 x0, x1, x2, x3; };
    __device__ __forceinline__ Col col(const Unit& u, int j) const { const float* gt = MOD + ((u.pm * 256) / SEQ) * 6144 + 2 * 1024 + u.pn * 256 + j; return Col{*(const f32x4*)gt, *(const f32x4*)(gt + 4), *(const f32x4*)(gt + 128), *(const f32x4*)(gt + 132)}; }
    __device__ __forceinline__ Pre load(const Unit& u, int r, int j) const { const float* xp = X + ((size_t)u.pm * 256 + r) * 1024 + u.pn * 256 + j; return Pre{*(const f32x4*)xp, *(const f32x4*)(xp + 4), *(const f32x4*)(xp + 128), *(const f32x4*)(xp + 132)}; }
    __device__ __forceinline__ void apply(const Unit& u, int r, int j, const Col& c, const Pre& q, f32x4 a0, f32x4 a1, f32x4 b0, f32x4 b1) const {
        bf16_t* op = X1B + ((size_t)u.pm * 256 + r) * 1024 + u.pn * 256 + j;
        *(u32x4*)op = pk8(q.x0 + c.c0 * a0, q.x1 + c.c1 * a1); *(u32x4*)(op + 128) = pk8(q.x2 + c.c2 * b0, q.x3 + c.c3 * b1); } };
struct MoeMeta { const int* m;
    __device__ __forceinline__ int cnt(int e) const { return __builtin_amdgcn_readfirstlane(m[e]); }
    __device__ __forceinline__ int tb(int e) const { return __builtin_amdgcn_readfirstlane(m[16 + e]); }
    __device__ __forceinline__ int ntiles() const { return __builtin_amdgcn_readfirstlane(m[32]); }
    __device__ __forceinline__ int find(int mt) const { int e = 0;
#pragma unroll
        for (int k = 1; k < 16; ++k) e += (__builtin_amdgcn_readfirstlane(m[16 + k]) <= mt) ? 1 : 0;
        return e; } };
__device__ __forceinline__ void moe_meta_build(const Params& p, int* meta) {
    if (threadIdx.x == 0) { const unsigned* cnt = (const unsigned*)(p.ws + OFF_CTL); int t = 0;
        for (int e = 0; e < 16; ++e) { const int c = (int)__hip_atomic_load(cnt + e, __ATOMIC_RELAXED, __HIP_MEMORY_SCOPE_AGENT); meta[e] = c; meta[16 + e] = t; t += (c + 255) >> 8; }
        meta[32] = t; }
    __syncthreads();
}
struct SchUp { const bf16_t *HM, *W; const int* LIST; MoeMeta mm; int G, c, K; const int* idx;
    __device__ __forceinline__ bool next(int i, Unit& u) const { const int L = i * G + c; if (L >= 4 * mm.ntiles()) return false; const int mt = L >> 2; u.pn = L & 3; u.aux = mm.find(mt); u.aux2 = (mt - mm.tb(u.aux)) * 256; u.pm = mt | (i << 16); return true; }
    __device__ __forceinline__ const char* abase(const Unit&) const { return (const char*)HM; }
    __device__ __forceinline__ const char* bbase(const Unit& u) const { return (const char*)(W + ((size_t)u.aux * 1024 + u.pn * 256) * 1024); }
    __device__ __forceinline__ unsigned aoff(const Unit& u, int r) const { return (unsigned)idx[(u.pm >> 16) * 256 + r] * 2048u; }
    __device__ __forceinline__ const bf16_t* arow(const Unit& u, int r) const { int pos = u.aux2 + r; const int c = mm.cnt(u.aux); pos = pos < c ? pos : c - 1; return HM + (size_t)LIST[u.aux * NT + pos] * 1024; }
    __device__ __forceinline__ const bf16_t* brow(const Unit& u, int n) const { return W + ((size_t)u.aux * 1024 + u.pn * 256 + n) * 1024; } };
struct EpiUp { bf16_t* ACT; const float* WL; MoeMeta mm;
    static constexpr int PF = 2; struct Col { }; struct Pre { float wt; };
    __device__ __forceinline__ Col col(const Unit&, int) const { return Col{}; }
    __device__ __forceinline__ Pre load(const Unit& u, int r, int) const { const int pos = u.aux2 + r; return Pre{pos < mm.cnt(u.aux) ? WL[u.aux * NT + pos] : 0.f}; }
    __device__ __forceinline__ void apply(const Unit& u, int r, int j, const Col&, const Pre& q, f32x4 g0, f32x4 g1, f32x4 u0, f32x4 u1) const {
        if (u.aux2 + r >= mm.cnt(u.aux)) return;
#pragma unroll
        for (int e = 0; e < 4; ++e) { g0[e] = silu(g0[e]) * u0[e] * q.wt; g1[e] = silu(g1[e]) * u1[e] * q.wt; }
        *(u32x4*)(ACT + ((size_t)(u.pm & 0xffff) * 256 + r) * 512 + u.pn * 128 + j) = pk8(g0, g1); } };
struct SchDn { const bf16_t *ACT, *W; MoeMeta mm; int G, c, K;
    __device__ __forceinline__ bool next(int i, Unit& u) const { const int L = i * G + c; if (L >= 4 * mm.ntiles()) return false; const int mt = L >> 2; u.pn = L & 3; u.aux = mm.find(mt); u.aux2 = (mt - mm.tb(u.aux)) * 256; u.pm = mt; return true; }
    __device__ __forceinline__ const bf16_t* arow(const Unit& u, int r) const { return ACT + ((size_t)u.pm * 256 + r) * 512; }
    __device__ __forceinline__ const bf16_t* brow(const Unit& u, int n) const { return W + ((size_t)u.aux * 1024 + u.pn * 256 + n) * 512; }
    __device__ __forceinline__ const char* abase(const Unit& u) const { return (const char*)(ACT + (size_t)u.pm * 256 * 512); }
    __device__ __forceinline__ const char* bbase(const Unit& u) const { return (const char*)(W + ((size_t)u.aux * 1024 + u.pn * 256) * 512); }
    __device__ __forceinline__ unsigned aoff(const Unit&, int) const { return 0u; } };
struct EpiDn { bf16_t* Y; MoeMeta mm;
    static constexpr int PF = 1; struct Col { }; struct Pre { };
    __device__ __forceinline__ Col col(const Unit&, int) const { return Col{}; }
    __device__ __forceinline__ Pre load(const Unit&, int, int) const { return Pre{}; }
    __device__ __forceinline__ void apply(const Unit& u, int r, int j, const Col&, const Pre&, f32x4 a0, f32x4 a1, f32x4 b0, f32x4 b1) const {
        if (u.aux2 + r >= mm.cnt(u.aux)) return;
        bf16_t* o = Y + ((size_t)u.pm * 256 + r) * 1024 + u.pn * 256 + j; *(u32x4*)o = pk8(a0, a1); *(u32x4*)(o + 128) = pk8(b0, b1); } };

__device__ __forceinline__ void aprep_item(const Params& p, int g, unsigned char* lds) {
    const int tid = threadIdx.x, lane = tid & 63, wave = tid >> 6;
    const bf16_t* Z = (const bf16_t*)(p.ws + OFF_SLOT + 1 * SLOT);
    bf16_t* AA = (bf16_t*)(p.ws + OFF_SLOT + 0 * SLOT) + (size_t)g * 64 * 1024;
    const unsigned* zt = (const unsigned*)lds;
    { const u32x4* src = (const u32x4*)(Z + (size_t)g * 64 * 1024); u32x4* d = (u32x4*)lds;
        u32x4 tmp[16];
#pragma unroll
        for (int i = 0; i < 16; ++i) tmp[i] = src[tid + i * NTHR];
#pragma unroll
        for (int i = 0; i < 16; ++i) d[tid + i * NTHR] = tmp[i]; }
    __syncthreads();
    {
        f32x2 w[31];
        const float* cw = p.in[I_CONVW] + 2 * tid;
#pragma unroll
        for (int k = 0; k < 31; ++k) w[k] = *(const f32x2*)(cw + k * 1024);
        const f32x2 cb = *(const f32x2*)(p.in[I_CONVB] + 2 * tid);
#pragma unroll 1
        for (int tb = 0; tb < 4; ++tb) {
            f32x2 cz[16];
#pragma unroll
            for (int o = 0; o < 16; ++o) cz[o] = cb;
#pragma unroll
            for (int r0 = 0; r0 < 48; r0 += 8) {
                unsigned vv[8];
#pragma unroll
                for (int rr = 0; rr < 8; ++rr) if (r0 + rr < 46) { const int row = 16 * tb - 15 + r0 + rr; const bool ok = (unsigned)row < 64u; const unsigned t = zt[(ok ? row : 0) * 512 + tid]; vv[rr] = ok ? t : 0u; }
#pragma unroll
                for (int rr = 0; rr < 8; ++rr) { const int r = r0 + rr;
                    if (r < 46) { const f32x2 x = (f32x2){bflo(vv[rr]), bfhi(vv[rr])};
#pragma unroll
                        for (int o = 0; o < 16; ++o) { const int k = r - o; if (k >= 0 && k < 31) cz[o] += w[k] * x; } } }
            }
#pragma unroll
            for (int o = 0; o < 16; ++o) *(unsigned*)(AA + (size_t)(16 * tb + o) * 1024 + 2 * tid) = pk2(cz[o].x, cz[o].y);
        }
    }
    asm volatile("s_waitcnt vmcnt(0)" ::: "memory");
    __syncthreads();
    u32x4 ra[8], rb[8];
#pragma unroll
    for (int rr = 0; rr < 8; ++rr) { const bf16_t* rp = AA + (size_t)(wave * 8 + rr) * 1024 + lane * 8; ra[rr] = *(const u32x4*)rp; rb[rr] = *(const u32x4*)(rp + 512); }
    f32x4 lg0[2], lg1[2], lb0[2], lb1[2];
#pragma unroll
    for (int hh = 0; hh < 2; ++hh) { const int c0 = hh * 512 + lane * 8;
        lg0[hh] = *(const f32x4*)(p.in[I_LNG] + c0); lg1[hh] = *(const f32x4*)(p.in[I_LNG] + c0 + 4); lb0[hh] = *(const f32x4*)(p.in[I_LNB] + c0); lb1[hh] = *(const f32x4*)(p.in[I_LNB] + c0 + 4); }
#pragma unroll
    for (int rr = 0; rr < 8; ++rr) {
        const int row = wave * 8 + rr;
        f32x4 x0, x1, x2, x3; unpk8(ra[rr], x0, x1); unpk8(rb[rr], x2, x3);
        const f32x4 sv = (x0 + x1) + (x2 + x3);
        const float mean = wave_sum_dpp((sv[0] + sv[1]) + (sv[2] + sv[3])) * (1.0f / 1024.0f);
        x0 -= mean; x1 -= mean; x2 -= mean; x3 -= mean;
        const f32x4 qv = (x0 * x0 + x1 * x1) + (x2 * x2 + x3 * x3);
        const float rstd = rsqrtf(wave_sum_dpp((qv[0] + qv[1]) + (qv[2] + qv[3])) * (1.0f / 1024.0f) + 1e-6f);
        x0 = x0 * rstd * lg0[0] + lb0[0]; x1 = x1 * rstd * lg1[0] + lb1[0]; x2 = x2 * rstd * lg0[1] + lb0[1]; x3 = x3 * rstd * lg1[1] + lb1[1];
#pragma unroll
        for (int e = 0; e < 4; ++e) { x0[e] = silu(x0[e]); x1[e] = silu(x1[e]); x2[e] = silu(x2[e]); x3[e] = silu(x3[e]); }
        bf16_t* o = AA + (size_t)row * 1024 + lane * 8;
        *(u32x4*)o = pk8(x0, x1); *(u32x4*)(o + 512) = pk8(x2, x3);
    }
    __syncthreads();
}

constexpr int XC_STRIDE = 272;
constexpr int YB_STRIDE = 132;
constexpr int B_XC_OFF = 0, B_HIN_OFF = 256 * XC_STRIDE  , B_Y_OFF = B_HIN_OFF + 4096  , B_Y_BYTES = 64 * YB_STRIDE * 4  ;
constexpr size_t OFF_TOT256 = OFF_TOT + 9 * MiB;

__device__ __forceinline__ void lru_coef(float lr2, float li2, float nsp2, float xcv, float& a, float& b) {
    const float r = __builtin_amdgcn_rcpf(1.0f + __builtin_amdgcn_exp2f(lr2));
    a = __builtin_amdgcn_exp2f(nsp2 * r);
    const float v = __builtin_fmaf(-a, a, 1.0f);
    const float d = 1.0f + __builtin_amdgcn_exp2f(li2);
    b = (v * __builtin_amdgcn_rsqf(fmaxf(v * d * d, 1e-30f))) * xcv;
}

template <bool FINAL, int DIR>
__device__ __forceinline__ void lru_dir(const unsigned char* xcs, const bf16x8 (&fbr)[4], const bf16x8 (&fbi)[4], float br, float bi, float nsp, int fr, int q, int chl,
                                        float hin_v, f32x4 (&hout)[4], float& totA, float& totB) {
    f32x4 ar[4], ai[4];
#pragma unroll
    for (int m = 0; m < 4; ++m) { ar[m] = (f32x4){br, br, br, br}; ai[m] = (f32x4){bi, bi, bi, bi}; }
#pragma unroll
    for (int kk = 0; kk < 4; ++kk) {
#pragma unroll
        for (int m = 0; m < 4; ++m) { const bf16x8 fa = *(const bf16x8*)(xcs + (16 * m + fr) * XC_STRIDE + (32 * kk + 8 * q) * 2);
            ar[m] = __builtin_amdgcn_mfma_f32_16x16x32_bf16(fa, fbr[kk], ar[m], 0, 0, 0);
            ai[m] = __builtin_amdgcn_mfma_f32_16x16x32_bf16(fa, fbi[kk], ai[m], 0, 0, 0); }
    }
#pragma unroll
    for (int m = 0; m < 4; ++m)
#pragma unroll
        for (int i = 0; i < 4; ++i) {
            const float xcv = bf2f(*(const bf16_t*)(xcs + (16 * m + 4 * q + i) * XC_STRIDE + chl * 2));
            float a, b; lru_coef(ar[m][i], ai[m][i], nsp, xcv, a, b); ar[m][i] = a; ai[m][i] = b;
        }
    float At[4], Bt[4], Ae[4], Be[4];
#pragma unroll
    for (int m = 0; m < 4; ++m) {
        float A = 1.f, B = 0.f;
#pragma unroll
        for (int ii = 0; ii < 4; ++ii) { const int i = DIR ? 3 - ii : ii; B = ar[m][i] * B + ai[m][i]; A = ar[m][i] * A; }
        if (DIR == 0) {
            float tA = __shfl_up(A, 16), tB = __shfl_up(B, 16); if (q >= 1) { B = A * tB + B; A = A * tA; }
            tA = __shfl_up(A, 32); tB = __shfl_up(B, 32); if (q >= 2) { B = A * tB + B; A = A * tA; }
            Ae[m] = __shfl_up(A, 16); Be[m] = __shfl_up(B, 16); if (q == 0) { Ae[m] = 1.f; Be[m] = 0.f; }
            At[m] = __shfl(A, 48 + fr); Bt[m] = __shfl(B, 48 + fr);
        } else {
            float tA = __shfl_down(A, 16), tB = __shfl_down(B, 16); if (q <= 2) { B = A * tB + B; A = A * tA; }
            tA = __shfl_down(A, 32); tB = __shfl_down(B, 32); if (q <= 1) { B = A * tB + B; A = A * tA; }
            Ae[m] = __shfl_down(A, 16); Be[m] = __shfl_down(B, 16); if (q == 3) { Ae[m] = 1.f; Be[m] = 0.f; }
            At[m] = __shfl(A, fr); Bt[m] = __shfl(B, fr);
        }
    }
    if (!FINAL) {
        float A = 1.f, B = 0.f;
#pragma unroll
        for (int mm = 0; mm < 4; ++mm) { const int m = DIR ? 3 - mm : mm; B = At[m] * B + Bt[m]; A = At[m] * A; }
        totA = A; totB = B;
    } else {
        float hh = hin_v;
#pragma unroll
        for (int mm = 0; mm < 4; ++mm) { const int m = DIR ? 3 - mm : mm;
            float hs = Ae[m] * hh + Be[m];
#pragma unroll
            for (int ii = 0; ii < 4; ++ii) { const int i = DIR ? 3 - ii : ii; hs = ar[m][i] * hs + ai[m][i]; hout[m][i] = hs; }
            hh = At[m] * hh + Bt[m];
        }
    }
}

template <bool FINAL>
__device__ __forceinline__ void b_phase(const Params& p, int bid, int nb, unsigned char* lds) {
    const int tid = threadIdx.x, lane = tid & 63, wave = tid >> 6, fr = lane & 15, q = lane >> 4;
    f32x2* TOT = (f32x2*)(p.ws + OFF_TOT);
    f32x2* TOT256 = (f32x2*)(p.ws + OFF_TOT256);
    const bf16_t* WG = (const bf16_t*)(p.ws + OFF_WG);
    float* hin = (float*)(lds + B_HIN_OFF);
    const int chl = 16 * wave + fr;
    const int nitems = FINAL ? 1024 : 1024 + 128;
    int hprev = -1;
    bf16x8 fb[4][4];
    float* cst = (float*)(lds + B_Y_OFF + 2 * B_Y_BYTES);
    for (int it = bid; it < nitems; it += nb) {
        const bool isctx = it >= 1024;
        const int b = isctx ? (it - 1024) >> 5 : it >> 8, c256 = isctx ? -1 : (it >> 3) & 31, h = it & 7, csub = (it >> 3) & 3;
        const int seqlen = isctx ? CTXL : SEQ, sbase = isctx ? 0 : c256 * 256;
        const bf16_t* src = isctx ? (const bf16_t*)(p.ws + OFF_XRC) + (size_t)b * CTXL * 1024 : (const bf16_t*)(p.ws + OFF_SLOT + 3 * SLOT) + (size_t)b * SEQ * 1024;
        const int kc0 = isctx ? 0 : 4 + c256 * 4, k256 = isctx ? 0 : 1 + c256;
        const int ch = h * 128 + chl;
        if (h != hprev) {
            hprev = h;
#pragma unroll
            for (int ty = 0; ty < 4; ++ty)
#pragma unroll
                for (int kk = 0; kk < 4; ++kk) fb[ty][kk] = *(const bf16x8*)(WG + (size_t)(h * 512 + wave * 64 + ty * 16 + fr) * 128 + 32 * kk + 8 * q);
            if (q == 0) { const float L2E = 1.4426950408889634f;
                          cst[0 * 128 + chl] = -L2E * p.in[I_BRF][ch]; cst[1 * 128 + chl] = -L2E * p.in[I_BIF][ch]; cst[2 * 128 + chl] = -8.0f * L2E * log1pf(__expf(-p.in[I_LAMF][ch]));
                          cst[3 * 128 + chl] = -L2E * p.in[I_BRB][ch]; cst[4 * 128 + chl] = -L2E * p.in[I_BIB][ch]; cst[5 * 128 + chl] = -8.0f * L2E * log1pf(__expf(-p.in[I_LAMB][ch])); }
            wave_lds_sync();
        }
        float runAf = 1.f, runBf = 0.f, runAb = 1.f, runBb = 0.f;
        {
            const int cgp = tid & 15, c0 = h * 128 + 8 * cgp;
            float wk[4][8], bs[8];
            { const f32x4* bp = (const f32x4*)(p.in[I_LCB] + c0); const f32x4 t0_ = bp[0], t1_ = bp[1];
                bs[0] = t0_[0]; bs[1] = t0_[1]; bs[2] = t0_[2]; bs[3] = t0_[3]; bs[4] = t1_[0]; bs[5] = t1_[1]; bs[6] = t1_[2]; bs[7] = t1_[3];
#pragma unroll
                for (int k = 0; k < 4; ++k) { const f32x4* wp = (const f32x4*)(p.in[I_LCW] + k * 1024 + c0); const f32x4 w0 = wp[0], w1 = wp[1];
                    wk[k][0] = w0[0]; wk[k][1] = w0[1]; wk[k][2] = w0[2]; wk[k][3] = w0[3]; wk[k][4] = w1[0]; wk[k][5] = w1[1]; wk[k][6] = w1[2]; wk[k][7] = w1[3]; } }
#pragma unroll 1
            for (int ps = 0; ps < (isctx ? 1 : 2); ++ps) {
                if (isctx && tid >= 256) break;
                const int tq = isctx ? csub * 64 + (tid >> 4) * 4 : ps * 128 + (tid >> 4) * 4;
                float xc[4][8];
#pragma unroll
                for (int r = 0; r < 4; ++r)
#pragma unroll
                    for (int e = 0; e < 8; ++e) xc[r][e] = bs[e];
#pragma unroll
                for (int rr = 0; rr < 7; ++rr) {
                    const int row = sbase + tq + rr - 2;
                    u32x4 a = (u32x4){0u, 0u, 0u, 0u};
                    if (row >= 0 && row < seqlen) a = *(const u32x4*)(src + (size_t)row * 1024 + c0);
                    const float x[8] = {bflo(a.x), bfhi(a.x), bflo(a.y), bfhi(a.y), bflo(a.z), bfhi(a.z), bflo(a.w), bfhi(a.w)};
#pragma unroll
                    for (int r = 0; r < 4; ++r) { const int k = rr - r;
                        if (k >= 0 && k < 4) {
#pragma unroll
                            for (int e = 0; e < 8; ++e) xc[r][e] += wk[k][e] * x[e]; } }
                }
#pragma unroll
                for (int r = 0; r < 4; ++r) {
                    u32x4 o0; o0.x = pk2(xc[r][0], xc[r][1]); o0.y = pk2(xc[r][2], xc[r][3]); o0.z = pk2(xc[r][4], xc[r][5]); o0.w = pk2(xc[r][6], xc[r][7]);
                    *(u32x4*)(lds + B_XC_OFF + (tq + r) * XC_STRIDE + cgp * 16) = o0;
                }
            }
        }
        f32x2 ct[33], cs[4];
        const int cdir = (tid >> 7) & 1, ccl = tid & 127;
        if (FINAL && tid < 256) {
            const f32x2* T2 = TOT256 + ((size_t)b * 33 * 2 + cdir) * 1024 + h * 128 + ccl;
            const f32x2* T = TOT + ((size_t)b * NCH64 * 2 + cdir) * 1024 + h * 128 + ccl;
#pragma unroll
            for (int k = 1; k < 33; ++k) { const bool use = cdir == 0 ? (k < k256) : (k > k256); ct[k] = use ? T2[(size_t)k * 2048] : (f32x2){1.f, 0.f}; }
            { f32x2 c4[4];
#pragma unroll
                for (int s_ = 0; s_ < 4; ++s_) c4[s_] = T[(size_t)s_ * 2048];
                float A = 1.f, B = 0.f;
#pragma unroll
                for (int s_ = 0; s_ < 4; ++s_) { const f32x2 t = cdir == 0 ? c4[s_] : c4[3 - s_]; B = t.x * B + t.y; A = t.x * A; }
                ct[0] = (f32x2){A, B}; }
#pragma unroll
            for (int s_ = 0; s_ < 4; ++s_) cs[s_] = T[(size_t)(kc0 + s_) * 2048];
        }
        if (FINAL && tid < 256) {
            float hc = 0.f;
            if (cdir == 0) {
#pragma unroll
                for (int k = 0; k < 33; ++k) hc = ct[k].x * hc + ct[k].y;
#pragma unroll
                for (int s_ = 0; s_ < 4; ++s_) { hin[(s_ * 2 + 0) * 128 + ccl] = hc; hc = cs[s_].x * hc + cs[s_].y; }
            } else {
                hc = ct[0].y;
#pragma unroll
                for (int k = 32; k >= 1; --k) hc = ct[k].x * hc + ct[k].y;
#pragma unroll
                for (int s_ = 3; s_ >= 0; --s_) { hin[(s_ * 2 + 1) * 128 + ccl] = hc; hc = cs[s_].x * hc + cs[s_].y; }
            }
        }
        __syncthreads();
        for (int sub = isctx ? csub : 0; sub < (isctx ? csub + 1 : 4); ++sub) {
            const int t0 = sbase + 64 * sub;
            const unsigned char* xcs = lds + B_XC_OFF + 64 * sub * XC_STRIDE;
            f32x4 hf[4], hb[4]; float tA, tB;
            lru_dir<FINAL, 0>(xcs, fb[0], fb[1], cst[0 * 128 + chl], cst[1 * 128 + chl], cst[2 * 128 + chl], fr, q, chl, FINAL ? hin[(sub * 2 + 0) * 128 + chl] : 0.f, hf, tA, tB);
            if (!FINAL) { if (q == 0) TOT[((size_t)(b * NCH64 + kc0 + sub) * 2 + 0) * 1024 + ch] = (f32x2){tA, tB};
                runBf = tA * runBf + tB; runAf = tA * runAf; }
            u32x4 gy0, gy1;
            if (FINAL) { const bf16_t* GYG = (const bf16_t*)(p.ws + OFF_SLOT + 2 * SLOT) + ((size_t)b * SEQ + t0 + lane) * 1024 + h * 128 + 16 * wave;
                gy0 = *(const u32x4*)GYG; gy1 = *(const u32x4*)(GYG + 8); }
            lru_dir<FINAL, 1>(xcs, fb[2], fb[3], cst[3 * 128 + chl], cst[4 * 128 + chl], cst[5 * 128 + chl], fr, q, chl, FINAL ? hin[(sub * 2 + 1) * 128 + chl] : 0.f, hb, tA, tB);
            if (!FINAL) { if (q == 0) TOT[((size_t)(b * NCH64 + kc0 + sub) * 2 + 1) * 1024 + ch] = (f32x2){tA, tB};
                runBb = runAb * tB + runBb; runAb = runAb * tA; }
            if (FINAL) {
                float* wy = (float*)(lds + B_Y_OFF) + wave * (64 * 20);
#pragma unroll
                for (int m = 0; m < 4; ++m)
#pragma unroll
                    for (int i = 0; i < 4; ++i) wy[(16 * m + 4 * q + i) * 20 + fr] = hf[m][i] + hb[m][i];
                wave_lds_sync();
                const f32x4* yp = (const f32x4*)(wy + lane * 20);
                const f32x4 y0 = yp[0], y1 = yp[1], y2 = yp[2], y3 = yp[3];
                u32x4 o0, o1;
                o0.x = pk2(bflo(gy0.x) * y0[0], bfhi(gy0.x) * y0[1]); o0.y = pk2(bflo(gy0.y) * y0[2], bfhi(gy0.y) * y0[3]);
                o0.z = pk2(bflo(gy0.z) * y1[0], bfhi(gy0.z) * y1[1]); o0.w = pk2(bflo(gy0.w) * y1[2], bfhi(gy0.w) * y1[3]);
                o1.x = pk2(bflo(gy1.x) * y2[0], bfhi(gy1.x) * y2[1]); o1.y = pk2(bflo(gy1.y) * y2[2], bfhi(gy1.y) * y2[3]);
                o1.z = pk2(bflo(gy1.z) * y3[0], bfhi(gy1.z) * y3[1]); o1.w = pk2(bflo(gy1.w) * y3[2], bfhi(gy1.w) * y3[3]);
                bf16_t* AB = (bf16_t*)(p.ws + OFF_SLOT + 1 * SLOT) + ((size_t)b * SEQ + t0 + lane) * 1024 + h * 128 + 16 * wave;
                *(u32x4*)AB = o0; *(u32x4*)(AB + 8) = o1;
                wave_lds_sync();
            }
        }
        __syncthreads();
        if (!FINAL && q == 0 && !isctx) {
            TOT256[((size_t)(b * 33 + k256) * 2 + 0) * 1024 + ch] = (f32x2){runAf, runBf};
            TOT256[((size_t)(b * 33 + k256) * 2 + 1) * 1024 + ch] = (f32x2){runAb, runBb};
        }
    }
}

__device__ __forceinline__ void ph8_route(const Params& p, int bid, int nb, unsigned char* lds) {
    constexpr int NU = 1;
    const int tid = threadIdx.x, lane = tid & 63, wave = tid >> 6;
    float* Wl = (float*)lds;
    int* lcnt = (int*)(lds + 81920);
    int* lbase = lcnt + 16;
    int* tinfo = lcnt + 32;
    float* twt = (float*)(tinfo + 512);
#pragma unroll 1
    for (int kk = 0; kk < 2; ++kk) { const int k = tid + kk * NTHR;
        const f32x4 wg = *(const f32x4*)(p.in[I_WGRP] + k * 4);
        Wl[0 * 1024 + k] = wg[0]; Wl[1 * 1024 + k] = wg[1]; Wl[2 * 1024 + k] = wg[2]; Wl[3 * 1024 + k] = wg[3];
#pragma unroll
        for (int o4 = 0; o4 < 4; ++o4) { const f32x4 we = *(const f32x4*)(p.in[I_WER] + k * 16 + o4 * 4);
            Wl[(4 + o4 * 4 + 0) * 1024 + k] = we[0]; Wl[(4 + o4 * 4 + 1) * 1024 + k] = we[1]; Wl[(4 + o4 * 4 + 2) * 1024 + k] = we[2]; Wl[(4 + o4 * 4 + 3) * 1024 + k] = we[3]; } }
    __syncthreads();
    const float* MOD = (const float*)(p.ws + OFF_MOD);
    const bf16_t* X1B = (const bf16_t*)(p.ws + OFF_SLOT + 5 * SLOT);
    bf16_t* HM = (bf16_t*)(p.ws + OFF_SLOT + 2 * SLOT);
    unsigned* gcnt = (unsigned*)(p.ws + OFF_CTL);
    int* LIST = (int*)(p.ws + OFF_LIST); float* WLs = (float*)(p.ws + OFF_WL); int* ROUTE = (int*)(p.ws + OFF_ROUTE);
    float* bl = (float*)(lds + 81920 + 8192);
    if (tid < 20) bl[tid] = tid < 4 ? p.in[I_BGRP][tid] : p.in[I_BER][tid - 4];
    __syncthreads();
    for (int tile = bid; tile < NT / 128; tile += nb) {
        if (tid < 16) lcnt[tid] = 0;
        __syncthreads();
        const float* mrow = MOD + ((tile * 128) / SEQ) * 6144;
        f32x4 gq[4], shq[4], scq[4];
#pragma unroll
        for (int j = 0; j < 4; ++j) { const int c = lane * 4 + 256 * j; gq[j] = *(const f32x4*)(p.in[I_GFFN] + c); shq[j] = *(const f32x4*)(mrow + 3 * 1024 + c); scq[j] = *(const f32x4*)(mrow + 4 * 1024 + c); gq[j] = gq[j] * (1.0f + scq[j]); }
        u32x2 nx[4];
#pragma unroll
        for (int j = 0; j < 4; ++j) nx[j] = *(const u32x2*)(X1B + (size_t)(tile * 128 + wave * 16) * DM + lane * 4 + 256 * j);
#pragma unroll 1
        for (int tt = 0; tt < 16; tt += NU) {
            const int tl = wave * 16 + tt, tok = tile * 128 + tl;
            f32x4 v[NU][4]; float ss[NU];
#pragma unroll
            for (int u = 0; u < NU; ++u) ss[u] = 0.f;
#pragma unroll
            for (int j = 0; j < 4; ++j) { v[0][j] = (f32x4){bflo(nx[j].x), bfhi(nx[j].x), bflo(nx[j].y), bfhi(nx[j].y)}; const f32x4 sq = v[0][j] * v[0][j]; ss[0] += (sq[0] + sq[1]) + (sq[2] + sq[3]); }
            { const int tn = tt + 1 < 16 ? tok + 1 : tok;
#pragma unroll
                for (int j = 0; j < 4; ++j) nx[j] = *(const u32x2*)(X1B + (size_t)tn * DM + lane * 4 + 256 * j); }
            float lg[NU][20];
#pragma unroll
            for (int u = 0; u < NU; ++u) { const float rinv = rsqrtf(wave_sum_dpp(ss[u]) * (1.0f / DM) + 1e-6f);
#pragma unroll
                for (int j = 0; j < 4; ++j) { v[u][j] = v[u][j] * rinv * gq[j] + shq[j]; *(u32x2*)(HM + (size_t)(tok + u) * DM + lane * 4 + 256 * j) = pk4(v[u][j]); }
}
#pragma unroll
            for (int o = 0; o < 20; ++o)
            { f32x4 wv[4];
#pragma unroll
                for (int j = 0; j < 4; ++j) wv[j] = *(const f32x4*)(Wl + o * 1024 + lane * 4 + 256 * j);
#pragma unroll
                for (int u = 0; u < NU; ++u) { f32x4 pr = v[u][0] * wv[0]; pr += v[u][1] * wv[1]; pr += v[u][2] * wv[2]; pr += v[u][3] * wv[3]; lg[u][o] = (pr[0] + pr[1]) + (pr[2] + pr[3]); }
                if ((o & 3) == 3) asm volatile("" ::: "memory"); }
#pragma unroll
            for (int u = 0; u < NU; ++u) {
#pragma unroll
                for (int o = 0; o < 20; ++o) lg[u][o] = wave_sum_dpp(lg[u][o]) + bl[o];
                int gs = 0; float gm = lg[u][0];
#pragma unroll
                for (int o = 1; o < 4; ++o) if (lg[u][o] > gm) { gm = lg[u][o]; gs = o; }
                float den = 0.f;
#pragma unroll
                for (int o = 0; o < 4; ++o) den += __expf(lg[u][o] - gm);
                const float pg = 1.0f / den;
                float el[4];
#pragma unroll
                for (int o = 0; o < 4; ++o) el[o] = gs == 0 ? lg[u][4 + o] : gs == 1 ? lg[u][8 + o] : gs == 2 ? lg[u][12 + o] : lg[u][16 + o];
                int i1 = 0; float v1 = el[0];
#pragma unroll
                for (int o = 1; o < 4; ++o) if (el[o] > v1) { v1 = el[o]; i1 = o; }
                int i2 = -1; float v2 = -3.0e38f;
#pragma unroll
                for (int o = 0; o < 4; ++o) if (o != i1 && el[o] > v2) { v2 = el[o]; i2 = o; }
                const float w1 = 1.0f / (1.0f + __expf(v2 - v1)), w2 = 1.0f - w1;
                if (lane == 0) { const int e1 = gs * 4 + i1, e2 = gs * 4 + i2;
                    const int r1 = atomicAdd(&lcnt[e1], 1), r2 = atomicAdd(&lcnt[e2], 1);
                    tinfo[(tl + u) * 4 + 0] = e1; tinfo[(tl + u) * 4 + 1] = r1; tinfo[(tl + u) * 4 + 2] = e2; tinfo[(tl + u) * 4 + 3] = r2; twt[(tl + u) * 2] = pg * w1; twt[(tl + u) * 2 + 1] = pg * w2; }
            }
        }
        __syncthreads();
        if (tid < 16) lbase[tid] = (int)__hip_atomic_fetch_add(gcnt + tid, (unsigned)lcnt[tid], __ATOMIC_RELAXED, __HIP_MEMORY_SCOPE_AGENT);
        __syncthreads();
        if (tid < 128) { const int tok = tile * 128 + tid;
            const int e1 = tinfo[tid * 4], e2 = tinfo[tid * 4 + 2], p1 = lbase[e1] + tinfo[tid * 4 + 1], p2 = lbase[e2] + tinfo[tid * 4 + 3];
            LIST[e1 * NT + p1] = tok; LIST[e2 * NT + p2] = tok; WLs[e1 * NT + p1] = twt[tid * 2]; WLs[e2 * NT + p2] = twt[tid * 2 + 1];
            ROUTE[tok * 4 + 0] = e1; ROUTE[tok * 4 + 1] = p1; ROUTE[tok * 4 + 2] = e2; ROUTE[tok * 4 + 3] = p2; }
        __syncthreads();
    }
}

__device__ __forceinline__ void ph10_final(const Params& p, int bid, int nb, const int* meta) {
    const int lane = threadIdx.x & 63, wave = threadIdx.x >> 6;
    const float* MOD = (const float*)(p.ws + OFF_MOD);
    const bf16_t* Y = (const bf16_t*)(p.ws + OFF_SLOT);
    const int* ROUTE = (const int*)(p.ws + OFF_ROUTE);
    const bf16_t* X1B = (const bf16_t*)(p.ws + OFF_SLOT + 5 * SLOT); float* OUT = p.out;
    for (int r = bid * 8 + wave; r < NT; r += nb * 8) {
        const int e1 = ROUTE[r * 4], p1 = ROUTE[r * 4 + 1], e2 = ROUTE[r * 4 + 2], p2 = ROUTE[r * 4 + 3];
        const bf16_t* y1 = Y + ((size_t)meta[16 + e1] * 256 + p1) * 1024; const bf16_t* y2 = Y + ((size_t)meta[16 + e2] * 256 + p2) * 1024;
        const float* gt = MOD + (r / SEQ) * 6144 + 5 * 1024;
        f32x4 v[4]; float ss = 0.f;
#pragma unroll
        for (int j = 0; j < 4; ++j) { const int c = lane * 4 + 256 * j;
            { const u32x2 xb = *(const u32x2*)(X1B + (size_t)r * DM + c); v[j] = (f32x4){bflo(xb.x), bfhi(xb.x), bflo(xb.y), bfhi(xb.y)}; }
            const u32x2 a = *(const u32x2*)(y1 + c), bq = *(const u32x2*)(y2 + c); const f32x4 g = *(const f32x4*)(gt + c);
            v[j][0] += g[0] * (bflo(a.x) + bflo(bq.x)); v[j][1] += g[1] * (bfhi(a.x) + bfhi(bq.x)); v[j][2] += g[2] * (bflo(a.y) + bflo(bq.y)); v[j][3] += g[3] * (bfhi(a.y) + bfhi(bq.y));
            ss += v[j][0] * v[j][0] + v[j][1] * v[j][1] + v[j][2] * v[j][2] + v[j][3] * v[j][3]; }
        const float rinv = rsqrtf(wave_sum(ss) * (1.0f / DM) + 1e-6f);
#pragma unroll
        for (int j = 0; j < 4; ++j) { const int c = lane * 4 + 256 * j; const f32x4 g = *(const f32x4*)(p.in[I_GFINAL] + c);
            *(f32x4*)(OUT + (size_t)r * DM + c) = v[j] * rinv * g; }
    }
}


#define XB_TMO      128
#define XB_XCNT(j)  (256  + 64 * (j))
#define XB_XSUB(j)  (1280 + 64 * (j))
#define XB_XGEN(j)  (2304 + 64 * (j))
#define XB_TOP      3328
#define XB_TOPGEN   3392
#define XCD_BAR_WORDS 3456
#define XB_SPIN_CAP (1u << 18)
__device__ __forceinline__ unsigned xb_ld(unsigned* p)              { return __hip_atomic_load(p, __ATOMIC_RELAXED, __HIP_MEMORY_SCOPE_AGENT); }
__device__ __forceinline__ unsigned xb_add(unsigned* p, unsigned v) { return __hip_atomic_fetch_add(p, v, __ATOMIC_RELAXED, __HIP_MEMORY_SCOPE_AGENT); }
__device__ __forceinline__ unsigned xb_xcc_id() { return (unsigned)__builtin_amdgcn_s_getreg((3 << 11) | 20) & 0xFu; }
#define XB_SPIN(cond, bar) do { unsigned _sp = 0; while (cond) { __builtin_amdgcn_s_sleep(1); \
    if ((++_sp & 255u) == 0u) { if (xb_ld(&(bar)[XB_TMO])) break; if (_sp > XB_SPIN_CAP) { atomicAdd(&(bar)[XB_TMO], 1u); break; } } } } while (0)
struct XcdBarrier { unsigned* bar; unsigned x; volatile unsigned* st; };
__device__ __forceinline__ XcdBarrier xcd_barrier_post(unsigned* bar, volatile unsigned* st) {
    XcdBarrier b; b.bar = bar; b.x = xb_xcc_id(); b.st = st;
    if (threadIdx.x == 0) (void)xb_add(&bar[XB_XCNT(b.x)], 1u);
    return b;
}
__device__ __forceinline__ void xcd_barrier_complete(unsigned* bar, unsigned x, unsigned& nloc, unsigned& nx) {
    const unsigned G = gridDim.x * gridDim.y * gridDim.z;
    unsigned sum, cnt, mine, sp = 0u;
    for (;;) {
        sum = 0u; cnt = 0u; mine = 0u;
#pragma unroll
        for (unsigned j = 0; j < 16; ++j) { const unsigned c = xb_ld(&bar[XB_XCNT(j)]); sum += c; cnt += (c > 0u) ? 1u : 0u; mine = (j == x) ? c : mine; }
        if (sum == G) break;
        __builtin_amdgcn_s_sleep(1);
        if ((++sp & 255u) == 0u) { if (xb_ld(&bar[XB_TMO])) break; if (sp > XB_SPIN_CAP) { atomicAdd(&bar[XB_TMO], 1u); break; } }
    }
    nloc = mine > 0u ? mine : 1u; nx = cnt > 0u ? cnt : 1u;
}
__device__ __forceinline__ void xcd_barrier(const XcdBarrier& b) {
    asm volatile("s_waitcnt vmcnt(0)" ::: "memory");
    __syncthreads();
    if (threadIdx.x == 0) {
        unsigned* bar = b.bar;
        __builtin_amdgcn_s_waitcnt(0);
        unsigned nloc = b.st[0], nx = b.st[1];
        if (nloc == 0u) { xcd_barrier_complete(bar, b.x, nloc, nx); b.st[0] = nloc; b.st[1] = nx; }
        const unsigned old = xb_add(&bar[XB_XSUB(b.x)], 1u);
        const unsigned gen = old / nloc;
        if (old + 1u == (gen + 1u) * nloc) {
            __builtin_amdgcn_fence(__ATOMIC_RELEASE, "agent");
            asm volatile("s_waitcnt vmcnt(0)" ::: "memory");
            const unsigned og = xb_add(&bar[XB_TOP], 1u);
            const unsigned tg = og / nx;
            if (og + 1u == (tg + 1u) * nx) xb_add(&bar[XB_TOPGEN], 1u);
            else XB_SPIN(xb_ld(&bar[XB_TOPGEN]) == tg, bar);
            __builtin_amdgcn_fence(__ATOMIC_ACQUIRE, "agent");
            xb_add(&bar[XB_XGEN(b.x)], 1u);
            asm volatile("s_waitcnt vmcnt(0)" ::: "memory");
        } else {
            XB_SPIN(xb_ld(&bar[XB_XGEN(b.x)]) == gen, bar);
            __builtin_amdgcn_fence(__ATOMIC_ACQUIRE, "agent");
            asm volatile("s_waitcnt vmcnt(0)" ::: "memory");
        }
    }
    __syncthreads();
}
constexpr size_t OFF_BAR = OFF_CTL + 4096;

__global__ void __launch_bounds__(NTHR) mega(Params p, int lo, int hi) {
    extern __shared__ __attribute__((aligned(16))) unsigned char lds[];
    cg::grid_group grid = cg::this_grid();
    const int bid = blockIdx.x, nb = gridDim.x;
    unsigned char* ws = p.ws;
    bf16_t* S0 = (bf16_t*)(ws + OFF_SLOT), *S1 = (bf16_t*)(ws + OFF_SLOT + SLOT), *S2 = (bf16_t*)(ws + OFF_SLOT + 2 * SLOT), *S3 = (bf16_t*)(ws + OFF_SLOT + 3 * SLOT),
           *S4 = (bf16_t*)(ws + OFF_SLOT + 4 * SLOT), *S5 = (bf16_t*)(ws + OFF_SLOT + 5 * SLOT);
    const float* MOD = (const float*)(ws + OFF_MOD); const float* BINP = (const float*)(ws + OFF_BINP);
    int* meta = (int*)(lds + LDS_BYTES - 256);
#ifndef PHMASK
#define PHMASK 0x7ff
#endif
#define IN(k) (((PHMASK >> (k)) & 1) && lo <= (k) && (k) < hi)
#ifndef PIPE_MASK
#define PIPE_MASK 0x364
#endif
#define GEMM_RUN(k, gather, s, e) gemm_phase_pipe<gather>(lds, s, e)
    volatile unsigned* xst = (volatile unsigned*)(lds + LDS_BYTES - 16);
    if (threadIdx.x < 2) xst[threadIdx.x] = 0u;
    __syncthreads();
    XcdBarrier xbar; xbar.bar = (unsigned*)(ws + OFF_BAR); xbar.x = 0; xbar.st = xst;
    if (hi - lo > 1) xbar = xcd_barrier_post((unsigned*)(ws + OFF_BAR), xst);
    if (p.pv == 0x7eadbeef) grid.sync();
#define SEAM(k) do { if (IN(k) && IN((k) + 1)) xcd_barrier(xbar); } while (0)
    if (IN(0)) { ph0_prep(p, bid, nb, lds); } SEAM(0);
    if (IN(1)) { ph1_norm(p, bid, nb); } SEAM(1);
    if (IN(2)) {
        { SchCtx s{(const bf16_t*)(ws + OFF_HC), (const bf16_t*)(ws + OFF_WIN), nb, bid, 1024}; EpiCtx e{(bf16_t*)(ws + OFF_XRC), BINP}; GEMM_RUN(2, false, s, e); }
        { SchG1 s{S0, (const bf16_t*)(ws + OFF_WIN), nb, bid, 1024}; EpiG1 e{S1, S2, S3, S4, S5, BINP}; GEMM_RUN(2, false, s, e); }
    } SEAM(2);
    if (IN(3)) {
#ifndef NO_APREP
        for (int g = bid; g < 512; g += nb) aprep_item(p, g, lds);
#endif
#ifndef NO_BLOCAL
        b_phase<false>(p, bid, nb, lds);
#endif
    } SEAM(3);
    if (IN(4)) {
        if (!(bid & 1)) { prep_items(p, PREP_EARLY, PREP_ALL, bid * 8 + (int)(threadIdx.x >> 6), nb * 8, lds); __syncthreads(); }
        b_phase<true>(p, bid, nb, lds);
        if (bid & 1) { __syncthreads(); prep_items(p, PREP_EARLY, PREP_ALL, bid * 8 + (int)(threadIdx.x >> 6), nb * 8, lds); }
    } SEAM(4);
    if (IN(5)) { SchG2 s{S0, S1, (const bf16_t*)(ws + OFF_WPA), (const bf16_t*)(ws + OFF_WPB), nb, bid, 1024}; EpiG2 e{S4, S5, S3}; GEMM_RUN(5, false, s, e); } SEAM(5);
    if (IN(6)) { SchG3 s{S3, (const bf16_t*)(ws + OFF_WO), nb, bid, 1024}; EpiG3 e{p.in[I_X], MOD, S5}; GEMM_RUN(6, false, s, e); } SEAM(6);
    if (IN(7)) { ph8_route(p, bid, nb, lds); } SEAM(7);
    if (IN(8)) { __syncthreads(); moe_meta_build(p, meta); MoeMeta mm{meta};
        int* idx = (int*)(lds + STAGE_BYTES);
        SchUp s{S2, (const bf16_t*)(ws + OFF_WGU), (const int*)(ws + OFF_LIST), mm, nb, bid, 1024, idx}; EpiUp e{S3, (const float*)(ws + OFF_WL), mm};
        { int iv[8]; bool ok[8];
#pragma unroll
            for (int i = 0; i < 8; ++i) { Unit u; ok[i] = s.next(i, u); iv[i] = 0;
                if (ok[i] && threadIdx.x < 256) { int pos = u.aux2 + (int)threadIdx.x; const int c = mm.cnt(u.aux); pos = pos < c ? pos : c - 1; iv[i] = s.LIST[u.aux * NT + pos]; } }
#pragma unroll
            for (int i = 0; i < 8; ++i) if (ok[i] && threadIdx.x < 256) idx[i * 256 + threadIdx.x] = iv[i]; }
        __syncthreads();
        GEMM_RUN(8, true, s, e); } SEAM(8);
    if (IN(9)) { __syncthreads(); moe_meta_build(p, meta); MoeMeta mm{meta};
        SchDn s{S3, (const bf16_t*)(ws + OFF_WDN), mm, nb, bid, 512}; EpiDn e{S0, mm}; GEMM_RUN(9, false, s, e); } SEAM(9);
    if (IN(10)) { __syncthreads(); moe_meta_build(p, meta); ph10_final(p, bid, nb, meta); }
#undef IN
#undef SEAM
}

extern "C" void kernel_launch(void* const* d_in, const int* in_sizes, int n_in, void* d_out, int out_size, void* d_ws, size_t ws_size, hipStream_t stream) {
    static int grid = 0;
    if (grid == 0) {
        if (n_in != 37 || out_size != NT * DM || ws_size < WS_END) { fprintf(stderr, "kernel_launch: unexpected shapes: n_in %d out %d ws %zu (need %zu)\n", n_in, out_size, ws_size, (size_t)WS_END); grid = -1; return; }
        int dev = 0, cus = 0, per_cu = 0;
        (void)hipGetDevice(&dev); (void)hipDeviceGetAttribute(&cus, hipDeviceAttributeMultiprocessorCount, dev);
        if (hipFuncSetAttribute((const void*)mega, hipFuncAttributeMaxDynamicSharedMemorySize, LDS_BYTES) != hipSuccess) { fprintf(stderr, "kernel_launch: hipFuncSetAttribute failed\n"); grid = -1; return; }
        if (hipOccupancyMaxActiveBlocksPerMultiprocessor(&per_cu, (const void*)mega, NTHR, LDS_BYTES) != hipSuccess || per_cu < 1) { fprintf(stderr, "kernel_launch: occupancy query says %d\n", per_cu); per_cu = 1; }
        (void)hipGetLastError();
        grid = cus * 1;
        fprintf(stderr, "kernel_launch: grid %d (cus %d, per_cu %d)\n", grid, cus, per_cu);
    }
    if (grid < 0) return;
    Params p{};
    for (int i = 0; i < 37; ++i) p.in[i] = (const float*)d_in[i];
    p.out = (float*)d_out; p.ws = (unsigned char*)d_ws;
#if ONE_LAUNCH
    (void)hipMemsetAsync((unsigned char*)d_ws + OFF_BAR, 0, XCD_BAR_WORDS * 4, stream);
    int lo = 0, hi = NPHASE; void* args[] = {&p, &lo, &hi};
    hipError_t e = hipLaunchCooperativeKernel((const void*)mega, dim3(grid), dim3(NTHR), args, LDS_BYTES, stream);
    if (e != hipSuccess) fprintf(stderr, "cooperative launch failed: %s (grid %d)\n", hipGetErrorString(e), grid);
#ifdef PROBE_PHASE
    hipLaunchKernelGGL(mega, dim3(grid), dim3(NTHR), LDS_BYTES, stream, p, PROBE_PHASE, PROBE_PHASE + 1);
#endif
#else
    for (int k = 0; k < NPHASE; ++k) hipLaunchKernelGGL(mega, dim3(grid), dim3(NTHR), LDS_BYTES, stream, p, k, k + 1);
#endif
}
```

```cpp
#include <hip/hip_runtime.h>
#include <hip/hip_cooperative_groups.h>
#include <cstdio>
#include <cstdint>
namespace cg = cooperative_groups;

#ifndef ONE_LAUNCH
#define ONE_LAUNCH 1
#endif

typedef unsigned short bf16_t;
typedef short bf16x8 __attribute__((ext_vector_type(8)));
typedef float f32x4 __attribute__((ext_vector_type(4)));
typedef float f32x2 __attribute__((ext_vector_type(2)));
typedef unsigned u32x4 __attribute__((ext_vector_type(4)));
typedef unsigned u32x2 __attribute__((ext_vector_type(2)));

constexpr int NT = 32768, NCX = 1024, DM = 1024, SEQ = 8192, CTXL = 256;
constexpr int NTHR = 512;
constexpr int NCH64 = 132;
constexpr size_t MiB = (size_t)1 << 20;
constexpr size_t OFF_CTL = 0, OFF_MOD = 1 * MiB, OFF_BINP = OFF_MOD + 128 * 1024, OFF_WIN = 2 * MiB, OFF_WPA = 14 * MiB, OFF_WPB = 16 * MiB,
                 OFF_WO = 18 * MiB, OFF_WG = 20 * MiB, OFF_WGU = 22 * MiB, OFF_WDN = 54 * MiB, OFF_HC = 70 * MiB, OFF_XRC = 72 * MiB,
                 OFF_TOT = 74 * MiB, OFF_ROUTE = 84 * MiB, OFF_LIST = 85 * MiB, OFF_WL = 87 * MiB, OFF_SLOT = 90 * MiB, SLOT = 64 * MiB,
                 WS_END = OFF_SLOT + 6 * SLOT;
constexpr int LDS_BYTES = 144 * 1024;
constexpr int NPHASE = 11;

struct Params { const float* in[37]; float* out; unsigned char* ws; int pv; int pad; };

enum { I_X = 0, I_C, I_CTX, I_CCTX, I_WADA, I_BADA, I_GMIX, I_WIN, I_BIN, I_CONVW, I_CONVB, I_LNG, I_LNB, I_WPA, I_LCW, I_LCB,
       I_WRF, I_BRF, I_WIF, I_BIF, I_LAMF, I_WRB, I_BRB, I_WIB, I_BIB, I_LAMB, I_WPB, I_WO, I_GFFN, I_WGRP, I_BGRP, I_WER, I_BER,
       I_WGATE, I_WUP, I_WDOWN, I_GFINAL };

__device__ __forceinline__ float bflo(unsigned w) { return __uint_as_float(w << 16); }
__device__ __forceinline__ float bfhi(unsigned w) { return __uint_as_float(w & 0xffff0000u); }
__device__ __forceinline__ float bf2f(bf16_t h) { return __uint_as_float(((unsigned)h) << 16); }
__device__ __forceinline__ unsigned pk2(float lo, float hi) { unsigned r; asm("v_cvt_pk_bf16_f32 %0, %1, %2" : "=v"(r) : "v"(lo), "v"(hi)); return r; }
__device__ __forceinline__ bf16_t f2bf(float f) { return (bf16_t)(pk2(f, 0.f) & 0xffffu); }
__device__ __forceinline__ float sigm(float x) { return __builtin_amdgcn_rcpf(1.0f + __expf(-x)); }
__device__ __forceinline__ float sigm2(float x2) { return __builtin_amdgcn_rcpf(1.0f + __builtin_amdgcn_exp2f(x2)); }
__device__ __forceinline__ float silu(float x) { return x * sigm(x); }
__device__ __forceinline__ float gelu_tanh(float x) { return x * sigm(1.5957691216057308f * (x + 0.044715f * x * x * x)); }
__device__ __forceinline__ float wave_sum(float v) {
#pragma unroll
    for (int o = 1; o < 64; o <<= 1) v += __shfl_xor(v, o);
    return v;
}
template <int CTRL, int RMASK> __device__ __forceinline__ float dpp_add(float v) { return v + __int_as_float(__builtin_amdgcn_update_dpp(0, __float_as_int(v), CTRL, RMASK, 0xF, false)); }
__device__ __forceinline__ float wave_sum_dpp(float v) {
    v = dpp_add<0xB1, 0xF>(v); v = dpp_add<0x4E, 0xF>(v); v = dpp_add<0x141, 0xF>(v); v = dpp_add<0x140, 0xF>(v); v = dpp_add<0x142, 0xA>(v); v = dpp_add<0x143, 0xC>(v);
    return __int_as_float(__builtin_amdgcn_readlane(__float_as_int(v), 63));
}
__device__ __forceinline__ void wave_lds_sync() { asm volatile("s_waitcnt lgkmcnt(0)" ::: "memory"); __builtin_amdgcn_wave_barrier(); }
__device__ __forceinline__ u32x2 pk4(f32x4 v) { u32x2 r; r.x = pk2(v[0], v[1]); r.y = pk2(v[2], v[3]); return r; }

__device__ __forceinline__ u32x4 pk8(f32x4 a, f32x4 b) { u32x4 r; r.x = pk2(a[0], a[1]); r.y = pk2(a[2], a[3]); r.z = pk2(b[0], b[1]); r.w = pk2(b[2], b[3]); return r; }
__device__ __forceinline__ void unpk8(u32x4 w, f32x4& a, f32x4& b) { a[0] = bflo(w.x); a[1] = bfhi(w.x); a[2] = bflo(w.y); a[3] = bfhi(w.y); b[0] = bflo(w.z); b[1] = bfhi(w.z); b[2] = bflo(w.w); b[3] = bfhi(w.w); }

template <class DRow>
__device__ __forceinline__ void tr_item(const float* __restrict__ src, int ldsrc, int k0, int n0, bf16_t* dst, int ldd, DRow drow, float* scr, int lane, float scale = 1.0f) {
    const float* sp = src + (size_t)k0 * ldsrc + n0 + lane;
    float tv[64];
#pragma unroll
    for (int kk = 0; kk < 64; ++kk) tv[kk] = sp[(size_t)kk * ldsrc];
#pragma unroll
    for (int kk = 0; kk < 64; ++kk) scr[kk * 65 + lane] = tv[kk] * scale;
    wave_lds_sync();
    const int c = lane & 7;
#pragma unroll
    for (int j = 0; j < 8; ++j) {
        const int n = (lane >> 3) + 8 * j; const float* s = scr + (8 * c) * 65 + n;
        u32x4 o; o.x = pk2(s[0], s[65]); o.y = pk2(s[130], s[195]); o.z = pk2(s[260], s[325]); o.w = pk2(s[390], s[455]);
        *(u32x4*)(dst + (size_t)drow(n0 + n) * ldd + k0 + 8 * c) = o;
    }
    wave_lds_sync();
}

__device__ __forceinline__ int win_srccol(int np) { const int p = np >> 8, r = np & 255; return p < 8 ? (r >> 7) * 1024 + 128 * p + (r & 127) : np; }

constexpr int N_WIN = 16 * 96, N_SQ = 16 * 16, N_G = 128, N_GU = 2048, N_DN = 2048;
constexpr int PREP_EARLY = N_WIN + 3 * N_SQ + N_G, PREP_ALL = PREP_EARLY + 2 * N_GU + N_DN;
__device__ __forceinline__ void prep_items(const Params& p, int first, int last, int gw, int NGW, unsigned char* lds) {
    const int lane = threadIdx.x & 63, wave = threadIdx.x >> 6;
    unsigned char* ws = p.ws;
    float* scr = (float*)lds + wave * (64 * 65);
    for (int it = first + gw; it < last; it += NGW) {
        int r = it;
        if (r < N_WIN) { const int kb = r / 96, nbk = r % 96, d0 = 64 * nbk, sc0 = win_srccol(d0);
            const int pt = d0 >> 8; const bool sgm = (pt < 8 && ((d0 >> 7) & 1)) || pt >= 16;
            tr_item(p.in[I_WIN], 6144, 64 * kb, sc0, (bf16_t*)(ws + OFF_WIN), 1024, [=](int n) { return n - sc0 + d0; }, scr, lane, sgm ? -1.4426950408889634f : 1.0f); continue; }
        r -= N_WIN;
        if (r < 3 * N_SQ) { const int which = r / N_SQ, q = r % N_SQ, kb = q / 16, nbk = q % 16;
            const float* src = which == 0 ? p.in[I_WPA] : which == 1 ? p.in[I_WPB] : p.in[I_WO];
            bf16_t* dst = (bf16_t*)(ws + (which == 0 ? OFF_WPA : which == 1 ? OFF_WPB : OFF_WO));
            tr_item(src, 1024, 64 * kb, 64 * nbk, dst, 1024, [=](int n) { return n; }, scr, lane); continue; }
        r -= 3 * N_SQ;
        if (r < N_G) { const int ty = r / 32, q = r % 32, h = q / 4, kb = (q % 4) / 2, nbk = q % 2;
            const float* src = (ty == 0 ? p.in[I_WRF] : ty == 1 ? p.in[I_WIF] : ty == 2 ? p.in[I_WRB] : p.in[I_WIB]) + (size_t)h * 128 * 128;
            tr_item(src, 128, 64 * kb, 64 * nbk, (bf16_t*)(ws + OFF_WG), 128, [=](int n) { return h * 512 + (n >> 4) * 64 + ty * 16 + (n & 15); }, scr, lane, -1.4426950408889634f); continue; }
        r -= N_G;
        if (r < 2 * N_GU) { const int bj = r / N_GU, q = r % N_GU, e = q / 128, kb = (q % 128) / 8, nbk = q % 8;
            const float* src = (bj == 0 ? p.in[I_WGATE] : p.in[I_WUP]) + (size_t)e * 1024 * 512;
            tr_item(src, 512, 64 * kb, 64 * nbk, (bf16_t*)(ws + OFF_WGU) + (size_t)e * 1024 * 1024, 1024, [=](int n) { return 256 * (n >> 7) + 128 * bj + (n & 127); }, scr, lane); continue; }
        r -= 2 * N_GU;
        { const int e = r / 128, kb = (r % 128) / 16, nbk = r % 16;
            tr_item(p.in[I_WDOWN] + (size_t)e * 512 * 1024, 1024, 64 * kb, 64 * nbk, (bf16_t*)(ws + OFF_WDN) + (size_t)e * 1024 * 512, 512, [=](int n) { return n; }, scr, lane); }
    }
}

__device__ __forceinline__ void ph0_prep(const Params& p, int bid, int nb, unsigned char* lds) {
    const int tid = threadIdx.x, lane = tid & 63, wave = tid >> 6;
    unsigned char* ws = p.ws;
    float* red = (float*)lds;
    float* MOD = (float*)(ws + OFF_MOD);
    for (int it = bid; it < 96; it += nb) {
        const int col = it * 64 + lane;
        float a[5] = {0.f, 0.f, 0.f, 0.f, 0.f};
        const float* W = p.in[I_WADA];
#pragma unroll 1
        for (int k0 = wave * 128; k0 < wave * 128 + 128; k0 += 64) {
            float wv[64];
#pragma unroll
            for (int kk = 0; kk < 64; ++kk) wv[kk] = W[(size_t)(k0 + kk) * 6144 + col];
#pragma unroll
            for (int kk = 0; kk < 64; ++kk)
#pragma unroll
                for (int r = 0; r < 5; ++r) { const float cv = r < 4 ? p.in[I_C][r * 1024 + k0 + kk] : p.in[I_CCTX][k0 + kk]; a[r] += silu(cv) * wv[kk]; }
        }
#pragma unroll
        for (int r = 0; r < 5; ++r) red[(wave * 5 + r) * 64 + lane] = a[r];
        __syncthreads();
        if (tid < 320) { const int r = tid / 64, l = tid % 64; float s = 0.f;
#pragma unroll
            for (int w = 0; w < 8; ++w) s += red[(w * 5 + r) * 64 + l];
            MOD[r * 6144 + it * 64 + l] = s + p.in[I_BADA][it * 64 + l]; }
        __syncthreads();
    }
    __syncthreads();
    if (nb > 96 + 32) { if (bid >= 96) prep_items(p, 0, PREP_EARLY, (bid - 96) * 8 + wave, (nb - 96) * 8, lds); }
    else prep_items(p, 0, PREP_EARLY, bid * 8 + wave, nb * 8, lds);
    float* BINP = (float*)(ws + OFF_BINP);
    for (int i = bid * NTHR + tid; i < 6144; i += nb * NTHR) { const int pt = i >> 8; const bool sgm = (pt < 8 && ((i >> 7) & 1)) || pt >= 16; BINP[i] = p.in[I_BIN][win_srccol(i)] * (sgm ? -1.4426950408889634f : 1.0f); }
    if (bid == 0 && tid < 64) ((unsigned*)(ws + OFF_CTL))[tid] = 0u;
}

template <bool WT>
__device__ __forceinline__ void norm_row(const f32x4 (&v)[4], float ss, const f32x4 (&gsv)[4], const f32x4 (&shv)[4], bf16_t* dst, int lane) {
    const float rinv = rsqrtf(wave_sum_dpp(ss) * (1.0f / DM) + 1e-6f);
#pragma unroll
    for (int j = 0; j < 4; ++j) { const int c = lane * 4 + 256 * j;
        const u32x2 o = pk4(v[j] * rinv * gsv[j] + shv[j]);
        if (WT) __hip_atomic_store((unsigned long long*)(dst + c), ((unsigned long long)o.y << 32) | o.x, __ATOMIC_RELAXED, __HIP_MEMORY_SCOPE_AGENT);
        else *(u32x2*)(dst + c) = o; }
}
constexpr int CTX_GEMM_WGS = 16;
__device__ __forceinline__ bool ph1_norm(const Params& p, int bid, int nb) {
    const int lane = threadIdx.x & 63, wave = threadIdx.x >> 6;
    const float* MOD = (const float*)(p.ws + OFF_MOD);
    unsigned* ctxcnt = (unsigned*)(p.ws + OFF_CTL) + 32;
    f32x4 gm[4];
#pragma unroll
    for (int j = 0; j < 4; ++j) gm[j] = *(const f32x4*)(p.in[I_GMIX] + lane * 4 + 256 * j);
    f32x4 shv[4], gsv[4];
    const bool split = nb >= 4 * CTX_GEMM_WGS;
    for (int cr = bid * 8 + wave; cr < NCX; cr += nb * 8) {
        const float* mrow = MOD + 4 * 6144;
        f32x4 v[4]; float ss = 0.f;
#pragma unroll
        for (int j = 0; j < 4; ++j) { const int c = lane * 4 + 256 * j; v[j] = *(const f32x4*)(p.in[I_CTX] + (size_t)cr * DM + c); const f32x4 sq = v[j] * v[j]; ss += (sq[0] + sq[1]) + (sq[2] + sq[3]);
            shv[j] = *(const f32x4*)(mrow + c); gsv[j] = gm[j] * (1.0f + *(const f32x4*)(mrow + 1024 + c)); }
        norm_row<true>(v, ss, gsv, shv, (bf16_t*)(p.ws + OFF_HC) + (size_t)cr * DM, lane);
        asm volatile("s_waitcnt vmcnt(0)" ::: "memory");
        if (lane == 0) __hip_atomic_fetch_add(ctxcnt, 1u, __ATOMIC_RELAXED, __HIP_MEMORY_SCOPE_AGENT);
    }
    if (split && bid < CTX_GEMM_WGS) {
        if (threadIdx.x == 0) { unsigned sp = 0;
            while (__hip_atomic_load(ctxcnt, __ATOMIC_RELAXED, __HIP_MEMORY_SCOPE_AGENT) < (unsigned)NCX) { __builtin_amdgcn_s_sleep(2); if (++sp > (1u << 22)) break; }
            __builtin_amdgcn_fence(__ATOMIC_ACQUIRE, "agent");
            asm volatile("s_waitcnt vmcnt(0)" ::: "memory"); }
        __syncthreads();
        return true;
    }
    const int wg0 = split ? CTX_GEMM_WGS : 0;
    const int r0 = (bid - wg0) * 8 + wave, rs = (nb - wg0) * 8;
    int mprev = -1;
    f32x4 nx[4];
#pragma unroll
    for (int j = 0; j < 4; ++j) nx[j] = *(const f32x4*)(p.in[I_X] + (size_t)r0 * DM + lane * 4 + 256 * j);
#pragma unroll 1
    for (int r = r0; r < NT; r += rs) {
        const int mb = r / SEQ;
        if (mb != mprev) { mprev = mb; const float* mrow = MOD + mb * 6144;
#pragma unroll
            for (int j = 0; j < 4; ++j) { const int c = lane * 4 + 256 * j; shv[j] = *(const f32x4*)(mrow + c); gsv[j] = gm[j] * (1.0f + *(const f32x4*)(mrow + 1024 + c)); } }
        f32x4 v[4]; float ss = 0.f;
#pragma unroll
        for (int j = 0; j < 4; ++j) { v[j] = nx[j]; const f32x4 sq = v[j] * v[j]; ss += (sq[0] + sq[1]) + (sq[2] + sq[3]); }
        { const int rn = r + rs < NT ? r + rs : r;
#pragma unroll
            for (int j = 0; j < 4; ++j) nx[j] = *(const f32x4*)(p.in[I_X] + (size_t)rn * DM + lane * 4 + 256 * j); }
        norm_row<false>(v, ss, gsv, shv, (bf16_t*)(p.ws + OFF_SLOT) + (size_t)r * DM, lane);
    }
    return false;
}

struct Unit { int pm, pn, aux, aux2; };

#define LAS __attribute__((address_space(3)))
constexpr int BK = 64, HTB = 128 * BK * 2, STAGE_BYTES = 8 * HTB;
__device__ __forceinline__ int lds_byte(int r, int c) { const int st = (r >> 4) * 2 + (c >> 5), rr = r & 15, cc = c & 31, ob = rr * 64 + cc * 2; return st * 1024 + (ob ^ (((ob >> 9) & 1) << 5)); }
__device__ __forceinline__ void stage_rc(int b, int& R, int& C) { const int st = b / 1024, sb = b % 1024, swz = sb ^ (((sb >> 9) & 1) << 5); R = (st >> 1) * 16 + swz / 64; C = (st & 1) * 32 + (swz % 64) / 2; }

template <bool GATHER, class S, class E>
__device__ __forceinline__ void gemm_phase_pipe(unsigned char* ldsg, const S& sch, const E& epi) {
    LAS unsigned char* lds = (LAS unsigned char*)ldsg;
    const int tid = threadIdx.x, wid = __builtin_amdgcn_readfirstlane(tid >> 6), lane = tid & 63, wr = wid >> 2, wc = wid & 3, fr = lane & 15, fq = lane >> 4;
    const int K = sch.K, nt = K / BK;
    int Rr[2], Cc[2]; unsigned voffA[2], voffB[2];
#pragma unroll
    for (int i = 0; i < 2; ++i) { stage_rc(tid * 16 + i * 8192, Rr[i], Cc[i]); voffA[i] = (unsigned)(Rr[i] * K + Cc[i]) * 2u;
        const int rho = Rr[i] & 31, Rb = (Rr[i] & ~31) + 8 * ((rho & 15) >> 2) + 4 * (rho >> 4) + (rho & 3);
        voffB[i] = (unsigned)(Rb * K + Cc[i]) * 2u; }
    const size_t kstep = (size_t)(BK * 2);
    const size_t hstep = (size_t)128 * K * 2;
    const unsigned ldsw = (unsigned)wid * 1024u;
    const int aoff = lds_byte(wr * 64 + fr, fq * 8), boff = lds_byte(wc * 32 + fr, fq * 8);
#define PG8_SA(b, h) (((b) * 2 + (h)) * HTB)
#define PG8_SB(b, h) ((4 + (b) * 2 + (h)) * HTB)
#define PG8_STAGE_B(bufoff, gbase) do { _Pragma("unroll") for (int _i = 0; _i < 2; ++_i) \
        __builtin_amdgcn_global_load_lds((const unsigned*)((const char*)(gbase) + voffB[_i]), (LAS unsigned*)(lds + (bufoff) + ldsw + _i * 8192), 16, 0, 0); } while (0)
#define PG8_STAGE_A(bufoff, gbase, h, vo) do { _Pragma("unroll") for (int _i = 0; _i < 2; ++_i) \
        __builtin_amdgcn_global_load_lds((const unsigned*)((const char*)(gbase) + (GATHER ? (size_t)(vo)[h][_i] : (size_t)(h) * hstep + voffA[_i])), (LAS unsigned*)(lds + (bufoff) + ldsw + _i * 8192), 16, 0, 0); } while (0)
#define PG8_LDA(dst, b, h) do { _Pragma("unroll") for (int m = 0; m < 4; ++m) _Pragma("unroll") for (int k = 0; k < 2; ++k) dst[m][k] = *(const LAS bf16x8*)(lds + PG8_SA(b, h) + aoff + m * 2048 + k * 1024); } while (0)
#define PG8_LDB(dst, b, h) do { _Pragma("unroll") for (int n = 0; n < 2; ++n) _Pragma("unroll") for (int k = 0; k < 2; ++k) dst[n][k] = *(const LAS bf16x8*)(lds + PG8_SB(b, h) + boff + n * 2048 + k * 1024); } while (0)
#define PG8_MMA(ai, bj, At, Bt) do { __builtin_amdgcn_s_setprio(1); _Pragma("unroll") for (int m = 0; m < 4; ++m) _Pragma("unroll") for (int n = 0; n < 2; ++n) _Pragma("unroll") for (int k = 0; k < 2; ++k) \
        acc[ai][bj][m][n] = __builtin_amdgcn_mfma_f32_16x16x32_bf16(Bt[n][k], At[m][k], acc[ai][bj][m][n], 0, 0, 0); __builtin_amdgcn_s_setprio(0); } while (0)
#define PG8_WAIT_V(n) asm volatile("s_waitcnt vmcnt(" #n ")" ::: "memory")
#define PG8_WAIT_L(n) asm volatile("s_waitcnt lgkmcnt(" #n ")" ::: "memory")
#define PG8_BAR __builtin_amdgcn_s_barrier()
#define PG8_SCHED __builtin_amdgcn_sched_barrier(0)
    Unit cur, nxt; int ui = 0;
    if (!sch.next(0, cur)) return;
    f32x4 acc[2][2][4][2];
#pragma unroll
    for (int a = 0; a < 2; ++a)
#pragma unroll
        for (int b = 0; b < 2; ++b)
#pragma unroll
            for (int m = 0; m < 4; ++m)
#pragma unroll
                for (int n = 0; n < 2; ++n) acc[a][b][m][n] = (f32x4){0.f, 0.f, 0.f, 0.f};
    bf16x8 At[4][2], B0[2][2], B1[2][2];
    unsigned voAc[2][2], voAn[2][2];
#pragma unroll
    for (int h = 0; h < 2; ++h)
#pragma unroll
        for (int i = 0; i < 2; ++i) { voAc[h][i] = GATHER ? sch.aoff(cur, 128 * h + Rr[i]) + (unsigned)Cc[i] * 2u : 0u; voAn[h][i] = voAc[h][i]; }
    const char* cA = sch.abase(cur); const char* cB = sch.bbase(cur);
    PG8_STAGE_B(PG8_SB(0, 0), cB); PG8_STAGE_A(PG8_SA(0, 0), cA, 0, voAc); PG8_STAGE_B(PG8_SB(0, 1), cB + hstep); PG8_STAGE_A(PG8_SA(0, 1), cA, 1, voAc);
    if (wr == 1) PG8_BAR;
    PG8_WAIT_V(4); PG8_BAR;
    PG8_STAGE_B(PG8_SB(1, 0), cB + kstep); PG8_STAGE_A(PG8_SA(1, 0), cA + kstep, 0, voAc); PG8_STAGE_B(PG8_SB(1, 1), cB + hstep + kstep);
    PG8_WAIT_V(6); PG8_BAR;
    for (;;) {
        const bool has_next = sch.next(ui + 1, nxt);
        const char* nA = has_next ? sch.abase(nxt) : cA; const char* nB = has_next ? sch.bbase(nxt) : cB;
        if (GATHER) {
#pragma unroll
            for (int h = 0; h < 2; ++h)
#pragma unroll
                for (int i = 0; i < 2; ++i) voAn[h][i] = has_next ? sch.aoff(nxt, 128 * h + Rr[i]) + (unsigned)Cc[i] * 2u : voAc[h][i];
        }
#pragma unroll 1
        for (int t = 0; t < nt; t += 2) {
            const bool last = (t == nt - 2);
            const char* a1 = cA + (size_t)(t + 1) * kstep;
            const char* a2 = last ? nA : cA + (size_t)(t + 2) * kstep; const char* b2 = last ? nB : cB + (size_t)(t + 2) * kstep;
            const char* a3 = a2 + kstep; const char* b3 = b2 + kstep;
            unsigned vo2[2][2];
#pragma unroll
            for (int h = 0; h < 2; ++h)
#pragma unroll
                for (int i = 0; i < 2; ++i) vo2[h][i] = last ? voAn[h][i] : voAc[h][i];
            PG8_LDB(B0, 0, 0); PG8_SCHED; PG8_LDA(At, 0, 0); PG8_STAGE_A(PG8_SA(1, 1), a1, 1, voAc);
            PG8_WAIT_L(8); PG8_BAR; PG8_WAIT_L(0); PG8_MMA(0, 0, At, B0); PG8_BAR; PG8_SCHED;
            PG8_LDB(B1, 0, 1); PG8_STAGE_B(PG8_SB(0, 0), b2);
            PG8_BAR; PG8_WAIT_L(0); PG8_MMA(0, 1, At, B1); PG8_BAR;
            PG8_LDA(At, 0, 1); PG8_STAGE_A(PG8_SA(0, 0), a2, 0, vo2);
            PG8_BAR; PG8_WAIT_L(0); PG8_MMA(1, 0, At, B0); PG8_BAR; PG8_SCHED;
            PG8_STAGE_B(PG8_SB(0, 1), b2 + hstep);
            PG8_WAIT_V(6); PG8_BAR; PG8_MMA(1, 1, At, B1); PG8_BAR;
            PG8_LDB(B0, 1, 0); PG8_SCHED; PG8_LDA(At, 1, 0); PG8_STAGE_A(PG8_SA(0, 1), a2, 1, vo2);
            PG8_WAIT_L(8); PG8_BAR; PG8_WAIT_L(0); PG8_MMA(0, 0, At, B0); PG8_BAR; PG8_SCHED;
            PG8_LDB(B1, 1, 1); PG8_STAGE_B(PG8_SB(1, 0), b3);
            PG8_BAR; PG8_WAIT_L(0); PG8_MMA(0, 1, At, B1); PG8_BAR;
            PG8_LDA(At, 1, 1); PG8_STAGE_A(PG8_SA(1, 0), a3, 0, vo2);
            PG8_BAR; PG8_WAIT_L(0); PG8_MMA(1, 0, At, B0); PG8_BAR; PG8_SCHED;
            PG8_STAGE_B(PG8_SB(1, 1), b3 + hstep);
            PG8_WAIT_V(6); PG8_BAR; PG8_MMA(1, 1, At, B1); PG8_BAR;
        }
        { int frx = fr, fqx = fq; asm volatile("" : "+v"(frx), "+v"(fqx));
            const int jx = wc * 32 + 8 * fqx, rx = wr * 64 + frx;
            const typename E::Col ecol = epi.col(cur, jx);
            constexpr int PF = E::PF;
            typename E::Pre epre[8];
#pragma unroll
            for (int g = 0; g < PF; ++g) epre[g] = epi.load(cur, (g >> 2) * 128 + (g & 3) * 16 + rx, jx);
#pragma unroll
            for (int g = 0; g < 8; ++g) { const int ai = g >> 2, m = g & 3;
                if (g + PF < 8) epre[g + PF] = epi.load(cur, ((g + PF) >> 2) * 128 + ((g + PF) & 3) * 16 + rx, jx);
                epi.apply(cur, ai * 128 + m * 16 + rx, jx, ecol, epre[g], acc[ai][0][m][0], acc[ai][0][m][1], acc[ai][1][m][0], acc[ai][1][m][1]); } }
        if (!has_next) break;
#pragma unroll
        for (int a = 0; a < 2; ++a)
#pragma unroll
            for (int b = 0; b < 2; ++b)
#pragma unroll
                for (int m = 0; m < 4; ++m)
#pragma unroll
                    for (int n = 0; n < 2; ++n) acc[a][b][m][n] = (f32x4){0.f, 0.f, 0.f, 0.f};
        cur = nxt; cA = nA; cB = nB; ++ui;
#pragma unroll
        for (int h = 0; h < 2; ++h)
#pragma unroll
            for (int i = 0; i < 2; ++i) voAc[h][i] = voAn[h][i];
    }
    PG8_WAIT_V(0);
    if (wr == 0) PG8_BAR;
    PG8_BAR;
#undef PG8_SA
#undef PG8_SB
#undef PG8_STAGE_A
#undef PG8_STAGE_B
#undef PG8_LDA
#undef PG8_LDB
#undef PG8_MMA
#undef PG8_WAIT_V
#undef PG8_WAIT_L
#undef PG8_BAR
#undef PG8_SCHED
}

struct SchG1 { const bf16_t *A, *Bt; int G, c, K;
    __device__ __forceinline__ bool next(int i, Unit& u) const { const int L = i * G + c; if (L >= 128 * 24) return false; u.pm = L / 24; u.pn = L % 24; return true; }
    __device__ __forceinline__ const bf16_t* arow(const Unit& u, int r) const { return A + (size_t)(u.pm * 256 + r) * 1024; }
    __device__ __forceinline__ const bf16_t* brow(const Unit& u, int n) const { return Bt + (size_t)(u.pn * 256 + n) * 1024; }
    __device__ __forceinline__ const char* abase(const Unit& u) const { return (const char*)(A + (size_t)u.pm * 256 * 1024); }
    __device__ __forceinline__ const char* bbase(const Unit& u) const { return (const char*)(Bt + (size_t)u.pn * 256 * 1024); }
    __device__ __forceinline__ unsigned aoff(const Unit&, int) const { return 0u; } };
struct EpiG1 { bf16_t *Z, *GYG, *XR, *SGA, *SGB; const float* bias;
    static constexpr int PF = 1; struct Col { f32x4 c0, c1, c2, c3; }; struct Pre { };
    __device__ __forceinline__ Col col(const Unit& u, int j) const { const float* bp = bias + u.pn * 256 + j; return Col{*(const f32x4*)bp, *(const f32x4*)(bp + 4), *(const f32x4*)(bp + 128), *(const f32x4*)(bp + 132)}; }
    __device__ __forceinline__ Pre load(const Unit&, int, int) const { return Pre{}; }
    __device__ __forceinline__ void apply(const Unit& u, int r, int j, const Col& c, const Pre&, f32x4 a0, f32x4 a1, f32x4 b0, f32x4 b1) const {
        const size_t row = (size_t)u.pm * 256 + r;
        a0 += c.c0; a1 += c.c1; b0 += c.c2; b1 += c.c3;
        if (u.pn < 8) {
#pragma unroll
            for (int e = 0; e < 4; ++e) { a0[e] *= sigm2(b0[e]); a1[e] *= sigm2(b1[e]); }
            *(u32x4*)(Z + row * 1024 + u.pn * 128 + j) = pk8(a0, a1); }
        else { const int kind = u.pn >> 2;
            bf16_t* dst = GYG + (size_t)(kind - 2) * (SLOT / 2);
#pragma unroll
            for (int e = 0; e < 4; ++e) { if (kind == 2) { a0[e] = gelu_tanh(a0[e]); a1[e] = gelu_tanh(a1[e]); b0[e] = gelu_tanh(b0[e]); b1[e] = gelu_tanh(b1[e]); }
                else if (kind >= 4) { a0[e] = sigm2(a0[e]); a1[e] = sigm2(a1[e]); b0[e] = sigm2(b0[e]); b1[e] = sigm2(b1[e]); } }
            bf16_t* o = dst + row * 1024 + (u.pn & 3) * 256 + j;
            *(u32x4*)o = pk8(a0, a1); *(u32x4*)(o + 128) = pk8(b0, b1); }
    } };
struct SchCtx { const bf16_t *A, *Bt; int G, c, K;
    __device__ __forceinline__ bool next(int i, Unit& u) const { const int L = i * G + c; if (L >= 16) return false; u.pm = L / 4; u.pn = L % 4; return true; }
    __device__ __forceinline__ const bf16_t* arow(const Unit& u, int r) const { return A + (size_t)(u.pm * 256 + r) * 1024; }
    __device__ __forceinline__ const bf16_t* brow(const Unit& u, int n) const { return Bt + (size_t)((12 + u.pn) * 256 + n) * 1024; }
    __device__ __forceinline__ const char* abase(const Unit& u) const { return (const char*)(A + (size_t)u.pm * 256 * 1024); }
    __device__ __forceinline__ const char* bbase(const Unit& u) const { return (const char*)(Bt + (size_t)(12 + u.pn) * 256 * 1024); }
    __device__ __forceinline__ unsigned aoff(const Unit&, int) const { return 0u; } };
struct EpiCtx { bf16_t* XRC; const float* bias;
    static constexpr int PF = 1; struct Col { f32x4 c0, c1, c2, c3; }; struct Pre { };
    __device__ __forceinline__ Col col(const Unit& u, int j) const { const float* bp = bias + (12 + u.pn) * 256 + j; return Col{*(const f32x4*)bp, *(const f32x4*)(bp + 4), *(const f32x4*)(bp + 128), *(const f32x4*)(bp + 132)}; }
    __device__ __forceinline__ Pre load(const Unit&, int, int) const { return Pre{}; }
    __device__ __forceinline__ void apply(const Unit& u, int r, int j, const Col& c, const Pre&, f32x4 a0, f32x4 a1, f32x4 b0, f32x4 b1) const {
        const size_t row = (size_t)u.pm * 256 + r;
        a0 += c.c0; a1 += c.c1; b0 += c.c2; b1 += c.c3;
        bf16_t* o = XRC + row * 1024 + u.pn * 256 + j; *(u32x4*)o = pk8(a0, a1); *(u32x4*)(o + 128) = pk8(b0, b1); } };
struct SchG2 { const bf16_t *Aa, *Ab, *Wa, *Wb; int G, c, K;
    __device__ __forceinline__ bool next(int i, Unit& u) const { const int t = (i >> 1) * G + c; if (t >= 512) return false; u.pm = t >> 2; u.pn = t & 3; u.aux = i & 1; return true; }
    __device__ __forceinline__ const bf16_t* arow(const Unit& u, int r) const { return Aa + (size_t)u.aux * (SLOT / 2) + (size_t)(u.pm * 256 + r) * 1024; }
    __device__ __forceinline__ const bf16_t* brow(const Unit& u, int n) const { return Wa + (size_t)u.aux * (1024 * 1024) + (size_t)(u.pn * 256 + n) * 1024; }
    __device__ __forceinline__ const char* abase(const Unit& u) const { return (const char*)(Aa + (size_t)u.aux * (SLOT / 2) + (size_t)u.pm * 256 * 1024); }
    __device__ __forceinline__ const char* bbase(const Unit& u) const { return (const char*)(Wa + (size_t)u.aux * (1024 * 1024) + (size_t)u.pn * 256 * 1024); }
    __device__ __forceinline__ unsigned aoff(const Unit&, int) const { return 0u; } };
struct EpiG2 { const bf16_t *SGA, *SGB; bf16_t* M;
    static constexpr int PF = 2; struct Col { }; struct Pre { u32x4 g0, g1, t0, t1; };
    __device__ __forceinline__ Col col(const Unit&, int) const { return Col{}; }
    __device__ __forceinline__ Pre load(const Unit& u, int r, int j) const {
        const size_t o = ((size_t)u.pm * 256 + r) * 1024 + u.pn * 256 + j; const bf16_t* G = SGA + (size_t)u.aux * (SLOT / 2);
        Pre q; q.g0 = *(const u32x4*)(G + o); q.g1 = *(const u32x4*)(G + o + 128);
        if (u.aux) { q.t0 = *(const u32x4*)(M + o); q.t1 = *(const u32x4*)(M + o + 128); } else { q.t0 = (u32x4){0u, 0u, 0u, 0u}; q.t1 = q.t0; }
        return q; }
    __device__ __forceinline__ void apply(const Unit& u, int r, int j, const Col&, const Pre& q, f32x4 a0, f32x4 a1, f32x4 b0, f32x4 b1) const {
        const size_t o = ((size_t)u.pm * 256 + r) * 1024 + u.pn * 256 + j;
        f32x4 g0, g1, g2, g3, t0, t1, t2, t3; unpk8(q.g0, g0, g1); unpk8(q.g1, g2, g3); unpk8(q.t0, t0, t1); unpk8(q.t1, t2, t3);
        a0 = a0 * g0 + t0; a1 = a1 * g1 + t1; b0 = b0 * g2 + t2; b1 = b1 * g3 + t3;
        *(u32x4*)(M + o) = pk8(a0, a1); *(u32x4*)(M + o + 128) = pk8(b0, b1); } };
struct SchG3 { const bf16_t *A, *Bt; int G, c, K;
    __device__ __forceinline__ bool next(int i, Unit& u) const { const int L = i * G + c; if (L >= 512) return false; u.pm = L >> 2; u.pn = L & 3; return true; }
    __device__ __forceinline__ const bf16_t* arow(const Unit& u, int r) const { return A + (size_t)(u.pm * 256 + r) * 1024; }
    __device__ __forceinline__ const bf16_t* brow(const Unit& u, int n) const { return Bt + (size_t)(u.pn * 256 + n) * 1024; }
    __device__ __forceinline__ const char* abase(const Unit& u) const { return (const char*)(A + (size_t)u.pm * 256 * 1024); }
    __device__ __forceinline__ const char* bbase(const Unit& u) const { return (const char*)(Bt + (size_t)u.pn * 256 * 1024); }
    __device__ __forceinline__ unsigned aoff(const Unit&, int) const { return 0u; } };
struct EpiG3 { const float *X, *MOD; bf16_t* X1B;
    static constexpr int PF = 3; struct Col { f32x4 c0, c1, c2, c3; }; struct Pre { f32x4 x0, x1, x2, x3; };
    __device__ __forceinline__ Col col(const Unit& u, int j) const { const float* gt = MOD + ((u.pm * 256) / SEQ) * 6144 + 2 * 1024 + u.pn * 256 + j; return Col{*(const f32x4*)gt, *(const f32x4*)(gt + 4), *(const f32x4*)(gt + 128), *(const f32x4*)(gt + 132)}; }
    __device__ __forceinline__ Pre load(const Unit& u, int r, int j) const { const float* xp = X + ((size_t)u.pm * 256 + r) * 1024 + u.pn * 256 + j; return Pre{*(const f32x4*)xp, *(const f32x4*)(xp + 4), *(const f32x4*)(xp + 128), *(const f32x4*)(xp + 132)}; }
    __device__ __forceinline__ void apply(const Unit& u, int r, int j, const Col& c, const Pre& q, f32x4 a0, f32x4 a1, f32x4 b0, f32x4 b1) const {
        bf16_t* op = X1B + ((size_t)u.pm * 256 + r) * 1024 + u.pn * 256 + j;
        *(u32x4*)op = pk8(q.x0 + c.c0 * a0, q.x1 + c.c1 * a1); *(u32x4*)(op + 128) = pk8(q.x2 + c.c2 * b0, q.x3 + c.c3 * b1); } };
struct MoeMeta { const int* m;
    __device__ __forceinline__ int cnt(int e) const { return __builtin_amdgcn_readfirstlane(m[e]); }
    __device__ __forceinline__ int tb(int e) const { return __builtin_amdgcn_readfirstlane(m[16 + e]); }
    __device__ __forceinline__ int ntiles() const { return __builtin_amdgcn_readfirstlane(m[32]); }
    __device__ __forceinline__ int find(int mt) const { int e = 0;
#pragma unroll
        for (int k = 1; k < 16; ++k) e += (__builtin_amdgcn_readfirstlane(m[16 + k]) <= mt) ? 1 : 0;
        return e; } };
__device__ __forceinline__ void moe_meta_build(const Params& p, int* meta) {
    if (threadIdx.x == 0) { const unsigned* cnt = (const unsigned*)(p.ws + OFF_CTL); int t = 0;
        for (int e = 0; e < 16; ++e) { const int c = (int)__hip_atomic_load(cnt + e, __ATOMIC_RELAXED, __HIP_MEMORY_SCOPE_AGENT); meta[e] = c; meta[16 + e] = t; t += (c + 255) >> 8; }
        meta[32] = t; }
    __syncthreads();
}
struct SchUp { const bf16_t *HM, *W; const int* LIST; MoeMeta mm; int G, c, K; const int* idx;
    __device__ __forceinline__ bool next(int i, Unit& u) const { const int L = i * G + c; if (L >= 4 * mm.ntiles()) return false; const int mt = L >> 2; u.pn = L & 3; u.aux = mm.find(mt); u.aux2 = (mt - mm.tb(u.aux)) * 256; u.pm = mt | (i << 16); return true; }
    __device__ __forceinline__ const char* abase(const Unit&) const { return (const char*)HM; }
    __device__ __forceinline__ const char* bbase(const Unit& u) const { return (const char*)(W + ((size_t)u.aux * 1024 + u.pn * 256) * 1024); }
    __device__ __forceinline__ unsigned aoff(const Unit& u, int r) const { return (unsigned)idx[(u.pm >> 16) * 256 + r] * 2048u; }
    __device__ __forceinline__ const bf16_t* arow(const Unit& u, int r) const { int pos = u.aux2 + r; const int c = mm.cnt(u.aux); pos = pos < c ? pos : c - 1; return HM + (size_t)LIST[u.aux * NT + pos] * 1024; }
    __device__ __forceinline__ const bf16_t* brow(const Unit& u, int n) const { return W + ((size_t)u.aux * 1024 + u.pn * 256 + n) * 1024; } };
struct EpiUp { bf16_t* ACT; const float* WL; MoeMeta mm;
    static constexpr int PF = 2; struct Col { }; struct Pre { float wt; };
    __device__ __forceinline__ Col col(const Unit&, int) const { return Col{}; }
    __device__ __forceinline__ Pre load(const Unit& u, int r, int) const { const int pos = u.aux2 + r; return Pre{pos < mm.cnt(u.aux) ? WL[u.aux * NT + pos] : 0.f}; }
    __device__ __forceinline__ void apply(const Unit& u, int r, int j, const Col&, const Pre& q, f32x4 g0, f32x4 g1, f32x4 u0, f32x4 u1) const {
        if (u.aux2 + r >= mm.cnt(u.aux)) return;
#pragma unroll
        for (int e = 0; e < 4; ++e) { g0[e] = silu(g0[e]) * u0[e] * q.wt; g1[e] = silu(g1[e]) * u1[e] * q.wt; }
        *(u32x4*)(ACT + ((size_t)(u.pm & 0xffff) * 256 + r) * 512 + u.pn * 128 + j) = pk8(g0, g1); } };
struct SchDn { const bf16_t *ACT, *W; MoeMeta mm; int G, c, K;
    __device__ __forceinline__ bool next(int i, Unit& u) const { const int L = i * G + c; if (L >= 4 * mm.ntiles()) return false; const int mt = L >> 2; u.pn = L & 3; u.aux = mm.find(mt); u.aux2 = (mt - mm.tb(u.aux)) * 256; u.pm = mt; return true; }
    __device__ __forceinline__ const bf16_t* arow(const Unit& u, int r) const { return ACT + ((size_t)u.pm * 256 + r) * 512; }
    __device__ __forceinline__ const bf16_t* brow(const Unit& u, int n) const { return W + ((size_t)u.aux * 1024 + u.pn * 256 + n) * 512; }
    __device__ __forceinline__ const char* abase(const Unit& u) const { return (const char*)(ACT + (size_t)u.pm * 256 * 512); }
    __device__ __forceinline__ const char* bbase(const Unit& u) const { return (const char*)(W + ((size_t)u.aux * 1024 + u.pn * 256) * 512); }
    __device__ __forceinline__ unsigned aoff(const Unit&, int) const { return 0u; } };
struct EpiDn { bf16_t* Y; MoeMeta mm;
    static constexpr int PF = 1; struct Col { }; struct Pre { };
    __device__ __forceinline__ Col col(const Unit&, int) const { return Col{}; }
    __device__ __forceinline__ Pre load(const Unit&, int, int) const { return Pre{}; }
    __device__ __forceinline__ void apply(const Unit& u, int r, int j, const Col&, const Pre&, f32x4 a0, f32x4 a1, f32x4 b0, f32x4 b1) const {
        if (u.aux2 + r >= mm.cnt(u.aux)) return;
        bf16_t* o = Y + ((size_t)u.pm * 256 + r) * 1024 + u.pn * 256 + j; *(u32x4*)o = pk8(a0, a1); *(u32x4*)(o + 128) = pk8(b0, b1); } };

__device__ __forceinline__ void aprep_item(const Params& p, int g, unsigned char* lds) {
    const int tid = threadIdx.x, lane = tid & 63, wave = tid >> 6;
    const bf16_t* Z = (const bf16_t*)(p.ws + OFF_SLOT + 1 * SLOT);
    bf16_t* AA = (bf16_t*)(p.ws + OFF_SLOT + 0 * SLOT) + (size_t)g * 64 * 1024;
    const unsigned* zt = (const unsigned*)lds;
    { const u32x4* src = (const u32x4*)(Z + (size_t)g * 64 * 1024); u32x4* d = (u32x4*)lds;
        u32x4 tmp[16];
#pragma unroll
        for (int i = 0; i < 16; ++i) tmp[i] = src[tid + i * NTHR];
#pragma unroll
        for (int i = 0; i < 16; ++i) d[tid + i * NTHR] = tmp[i]; }
    __syncthreads();
    {
        f32x2 w[31];
        const float* cw = p.in[I_CONVW] + 2 * tid;
#pragma unroll
        for (int k = 0; k < 31; ++k) w[k] = *(const f32x2*)(cw + k * 1024);
        const f32x2 cb = *(const f32x2*)(p.in[I_CONVB] + 2 * tid);
#pragma unroll 1
        for (int tb = 0; tb < 4; ++tb) {
            f32x2 cz[16];
#pragma unroll
            for (int o = 0; o < 16; ++o) cz[o] = cb;
#pragma unroll
            for (int r0 = 0; r0 < 48; r0 += 8) {
                unsigned vv[8];
#pragma unroll
                for (int rr = 0; rr < 8; ++rr) if (r0 + rr < 46) { const int row = 16 * tb - 15 + r0 + rr; const bool ok = (unsigned)row < 64u; const unsigned t = zt[(ok ? row : 0) * 512 + tid]; vv[rr] = ok ? t : 0u; }
#pragma unroll
                for (int rr = 0; rr < 8; ++rr) { const int r = r0 + rr;
                    if (r < 46) { const f32x2 x = (f32x2){bflo(vv[rr]), bfhi(vv[rr])};
#pragma unroll
                        for (int o = 0; o < 16; ++o) { const int k = r - o; if (k >= 0 && k < 31) cz[o] += w[k] * x; } } }
            }
#pragma unroll
            for (int o = 0; o < 16; ++o) *(unsigned*)(AA + (size_t)(16 * tb + o) * 1024 + 2 * tid) = pk2(cz[o].x, cz[o].y);
        }
    }
    asm volatile("s_waitcnt vmcnt(0)" ::: "memory");
    __syncthreads();
    u32x4 ra[8], rb[8];
#pragma unroll
    for (int rr = 0; rr < 8; ++rr) { const bf16_t* rp = AA + (size_t)(wave * 8 + rr) * 1024 + lane * 8; ra[rr] = *(const u32x4*)rp; rb[rr] = *(const u32x4*)(rp + 512); }
    f32x4 lg0[2], lg1[2], lb0[2], lb1[2];
#pragma unroll
    for (int hh = 0; hh < 2; ++hh) { const int c0 = hh * 512 + lane * 8;
        lg0[hh] = *(const f32x4*)(p.in[I_LNG] + c0); lg1[hh] = *(const f32x4*)(p.in[I_LNG] + c0 + 4); lb0[hh] = *(const f32x4*)(p.in[I_LNB] + c0); lb1[hh] = *(const f32x4*)(p.in[I_LNB] + c0 + 4); }
#pragma unroll
    for (int rr = 0; rr < 8; ++rr) {
        const int row = wave * 8 + rr;
        f32x4 x0, x1, x2, x3; unpk8(ra[rr], x0, x1); unpk8(rb[rr], x2, x3);
        const f32x4 sv = (x0 + x1) + (x2 + x3);
        const float mean = wave_sum_dpp((sv[0] + sv[1]) + (sv[2] + sv[3])) * (1.0f / 1024.0f);
        x0 -= mean; x1 -= mean; x2 -= mean; x3 -= mean;
        const f32x4 qv = (x0 * x0 + x1 * x1) + (x2 * x2 + x3 * x3);
        const float rstd = rsqrtf(wave_sum_dpp((qv[0] + qv[1]) + (qv[2] + qv[3])) * (1.0f / 1024.0f) + 1e-6f);
        x0 = x0 * rstd * lg0[0] + lb0[0]; x1 = x1 * rstd * lg1[0] + lb1[0]; x2 = x2 * rstd * lg0[1] + lb0[1]; x3 = x3 * rstd * lg1[1] + lb1[1];
#pragma unroll
        for (int e = 0; e < 4; ++e) { x0[e] = silu(x0[e]); x1[e] = silu(x1[e]); x2[e] = silu(x2[e]); x3[e] = silu(x3[e]); }
        bf16_t* o = AA + (size_t)row * 1024 + lane * 8;
        *(u32x4*)o = pk8(x0, x1); *(u32x4*)(o + 512) = pk8(x2, x3);
    }
    __syncthreads();
}

constexpr int XC_STRIDE = 272;
constexpr int YB_STRIDE = 132;
constexpr int B_XC_OFF = 0, B_HIN_OFF = 256 * XC_STRIDE  , B_Y_OFF = B_HIN_OFF + 4096  , B_Y_BYTES = 64 * YB_STRIDE * 4  ;
constexpr size_t OFF_TOT256 = OFF_TOT + 9 * MiB;

__device__ __forceinline__ void lru_coef(float lr2, float li2, float nsp2, float xcv, float& a, float& b) {
    const float r = __builtin_amdgcn_rcpf(1.0f + __builtin_amdgcn_exp2f(lr2));
    a = __builtin_amdgcn_exp2f(nsp2 * r);
    const float v = __builtin_fmaf(-a, a, 1.0f);
    const float d = 1.0f + __builtin_amdgcn_exp2f(li2);
    b = (v * __builtin_amdgcn_rsqf(fmaxf(v * d * d, 1e-30f))) * xcv;
}

template <bool FINAL, int DIR>
__device__ __forceinline__ void lru_dir(const unsigned char* xcs, const bf16x8 (&fbr)[4], const bf16x8 (&fbi)[4], float br, float bi, float nsp, int fr, int q, int chl,
                                        float hin_v, f32x4 (&hout)[4], float& totA, float& totB) {
    f32x4 ar[4], ai[4];
#pragma unroll
    for (int m = 0; m < 4; ++m) { ar[m] = (f32x4){br, br, br, br}; ai[m] = (f32x4){bi, bi, bi, bi}; }
#pragma unroll
    for (int kk = 0; kk < 4; ++kk) {
#pragma unroll
        for (int m = 0; m < 4; ++m) { const bf16x8 fa = *(const bf16x8*)(xcs + (16 * m + fr) * XC_STRIDE + (32 * kk + 8 * q) * 2);
            ar[m] = __builtin_amdgcn_mfma_f32_16x16x32_bf16(fa, fbr[kk], ar[m], 0, 0, 0);
            ai[m] = __builtin_amdgcn_mfma_f32_16x16x32_bf16(fa, fbi[kk], ai[m], 0, 0, 0); }
    }
#pragma unroll
    for (int m = 0; m < 4; ++m)
#pragma unroll
        for (int i = 0; i < 4; ++i) {
            const float xcv = bf2f(*(const bf16_t*)(xcs + (16 * m + 4 * q + i) * XC_STRIDE + chl * 2));
            float a, b; lru_coef(ar[m][i], ai[m][i], nsp, xcv, a, b); ar[m][i] = a; ai[m][i] = b;
        }
    float At[4], Bt[4], Ae[4], Be[4];
#pragma unroll
    for (int m = 0; m < 4; ++m) {
        float A = 1.f, B = 0.f;
#pragma unroll
        for (int ii = 0; ii < 4; ++ii) { const int i = DIR ? 3 - ii : ii; B = ar[m][i] * B + ai[m][i]; A = ar[m][i] * A; }
        if (DIR == 0) {
            float tA = __shfl_up(A, 16), tB = __shfl_up(B, 16); if (q >= 1) { B = A * tB + B; A = A * tA; }
            tA = __shfl_up(A, 32); tB = __shfl_up(B, 32); if (q >= 2) { B = A * tB + B; A = A * tA; }
            Ae[m] = __shfl_up(A, 16); Be[m] = __shfl_up(B, 16); if (q == 0) { Ae[m] = 1.f; Be[m] = 0.f; }
            At[m] = __shfl(A, 48 + fr); Bt[m] = __shfl(B, 48 + fr);
        } else {
            float tA = __shfl_down(A, 16), tB = __shfl_down(B, 16); if (q <= 2) { B = A * tB + B; A = A * tA; }
            tA = __shfl_down(A, 32); tB = __shfl_down(B, 32); if (q <= 1) { B = A * tB + B; A = A * tA; }
            Ae[m] = __shfl_down(A, 16); Be[m] = __shfl_down(B, 16); if (q == 3) { Ae[m] = 1.f; Be[m] = 0.f; }
            At[m] = __shfl(A, fr); Bt[m] = __shfl(B, fr);
        }
    }
    if (!FINAL) {
        float A = 1.f, B = 0.f;
#pragma unroll
        for (int mm = 0; mm < 4; ++mm) { const int m = DIR ? 3 - mm : mm; B = At[m] * B + Bt[m]; A = At[m] * A; }
        totA = A; totB = B;
    } else {
        float hh = hin_v;
#pragma unroll
        for (int mm = 0; mm < 4; ++mm) { const int m = DIR ? 3 - mm : mm;
            float hs = Ae[m] * hh + Be[m];
#pragma unroll
            for (int ii = 0; ii < 4; ++ii) { const int i = DIR ? 3 - ii : ii; hs = ar[m][i] * hs + ai[m][i]; hout[m][i] = hs; }
            hh = At[m] * hh + Bt[m];
        }
    }
}

template <bool FINAL>
__device__ __forceinline__ void b_phase(const Params& p, int bid, int nb, unsigned char* lds) {
    const int tid = threadIdx.x, lane = tid & 63, wave = tid >> 6, fr = lane & 15, q = lane >> 4;
    f32x2* TOT = (f32x2*)(p.ws + OFF_TOT);
    f32x2* TOT256 = (f32x2*)(p.ws + OFF_TOT256);
    const bf16_t* WG = (const bf16_t*)(p.ws + OFF_WG);
    float* hin = (float*)(lds + B_HIN_OFF);
    const int chl = 16 * wave + fr;
    const int nitems = FINAL ? 1024 : 1024 + 128;
    int hprev = -1;
    bf16x8 fb[4][4];
    float* cst = (float*)(lds + B_Y_OFF + 2 * B_Y_BYTES);
    for (int it = bid; it < nitems; it += nb) {
        const bool isctx = it >= 1024;
        const int b = isctx ? (it - 1024) >> 5 : it >> 8, c256 = isctx ? -1 : (it >> 3) & 31, h = it & 7, csub = (it >> 3) & 3;
        const int seqlen = isctx ? CTXL : SEQ, sbase = isctx ? 0 : c256 * 256;
        const bf16_t* src = isctx ? (const bf16_t*)(p.ws + OFF_XRC) + (size_t)b * CTXL * 1024 : (const bf16_t*)(p.ws + OFF_SLOT + 3 * SLOT) + (size_t)b * SEQ * 1024;
        const int kc0 = isctx ? 0 : 4 + c256 * 4, k256 = isctx ? 0 : 1 + c256;
        const int ch = h * 128 + chl;
        if (h != hprev) {
            hprev = h;
#pragma unroll
            for (int ty = 0; ty < 4; ++ty)
#pragma unroll
                for (int kk = 0; kk < 4; ++kk) fb[ty][kk] = *(const bf16x8*)(WG + (size_t)(h * 512 + wave * 64 + ty * 16 + fr) * 128 + 32 * kk + 8 * q);
            if (q == 0) { const float L2E = 1.4426950408889634f;
                          cst[0 * 128 + chl] = -L2E * p.in[I_BRF][ch]; cst[1 * 128 + chl] = -L2E * p.in[I_BIF][ch]; cst[2 * 128 + chl] = -8.0f * L2E * log1pf(__expf(-p.in[I_LAMF][ch]));
                          cst[3 * 128 + chl] = -L2E * p.in[I_BRB][ch]; cst[4 * 128 + chl] = -L2E * p.in[I_BIB][ch]; cst[5 * 128 + chl] = -8.0f * L2E * log1pf(__expf(-p.in[I_LAMB][ch])); }
            wave_lds_sync();
        }
        float runAf = 1.f, runBf = 0.f, runAb = 1.f, runBb = 0.f;
        {
            const int cgp = tid & 15, c0 = h * 128 + 8 * cgp;
            float wk[4][8], bs[8];
            { const f32x4* bp = (const f32x4*)(p.in[I_LCB] + c0); const f32x4 t0_ = bp[0], t1_ = bp[1];
                bs[0] = t0_[0]; bs[1] = t0_[1]; bs[2] = t0_[2]; bs[3] = t0_[3]; bs[4] = t1_[0]; bs[5] = t1_[1]; bs[6] = t1_[2]; bs[7] = t1_[3];
#pragma unroll
                for (int k = 0; k < 4; ++k) { const f32x4* wp = (const f32x4*)(p.in[I_LCW] + k * 1024 + c0); const f32x4 w0 = wp[0], w1 = wp[1];
                    wk[k][0] = w0[0]; wk[k][1] = w0[1]; wk[k][2] = w0[2]; wk[k][3] = w0[3]; wk[k][4] = w1[0]; wk[k][5] = w1[1]; wk[k][6] = w1[2]; wk[k][7] = w1[3]; } }
#pragma unroll 1
            for (int ps = 0; ps < (isctx ? 1 : 2); ++ps) {
                if (isctx && tid >= 256) break;
                const int tq = isctx ? csub * 64 + (tid >> 4) * 4 : ps * 128 + (tid >> 4) * 4;
                float xc[4][8];
#pragma unroll
                for (int r = 0; r < 4; ++r)
#pragma unroll
                    for (int e = 0; e < 8; ++e) xc[r][e] = bs[e];
#pragma unroll
                for (int rr = 0; rr < 7; ++rr) {
                    const int row = sbase + tq + rr - 2;
                    u32x4 a = (u32x4){0u, 0u, 0u, 0u};
                    if (row >= 0 && row < seqlen) a = *(const u32x4*)(src + (size_t)row * 1024 + c0);
                    const float x[8] = {bflo(a.x), bfhi(a.x), bflo(a.y), bfhi(a.y), bflo(a.z), bfhi(a.z), bflo(a.w), bfhi(a.w)};
#pragma unroll
                    for (int r = 0; r < 4; ++r) { const int k = rr - r;
                        if (k >= 0 && k < 4) {
#pragma unroll
                            for (int e = 0; e < 8; ++e) xc[r][e] += wk[k][e] * x[e]; } }
                }
#pragma unroll
                for (int r = 0; r < 4; ++r) {
                    u32x4 o0; o0.x = pk2(xc[r][0], xc[r][1]); o0.y = pk2(xc[r][2], xc[r][3]); o0.z = pk2(xc[r][4], xc[r][5]); o0.w = pk2(xc[r][6], xc[r][7]);
                    *(u32x4*)(lds + B_XC_OFF + (tq + r) * XC_STRIDE + cgp * 16) = o0;
                }
            }
        }
        f32x2 ct[33], cs[4];
        const int cdir = (tid >> 7) & 1, ccl = tid & 127;
        if (FINAL && tid < 256) {
            const f32x2* T2 = TOT256 + ((size_t)b * 33 * 2 + cdir) * 1024 + h * 128 + ccl;
            const f32x2* T = TOT + ((size_t)b * NCH64 * 2 + cdir) * 1024 + h * 128 + ccl;
#pragma unroll
            for (int k = 1; k < 33; ++k) { const bool use = cdir == 0 ? (k < k256) : (k > k256); ct[k] = use ? T2[(size_t)k * 2048] : (f32x2){1.f, 0.f}; }
            { f32x2 c4[4];
#pragma unroll
                for (int s_ = 0; s_ < 4; ++s_) c4[s_] = T[(size_t)s_ * 2048];
                float A = 1.f, B = 0.f;
#pragma unroll
                for (int s_ = 0; s_ < 4; ++s_) { const f32x2 t = cdir == 0 ? c4[s_] : c4[3 - s_]; B = t.x * B + t.y; A = t.x * A; }
                ct[0] = (f32x2){A, B}; }
#pragma unroll
            for (int s_ = 0; s_ < 4; ++s_) cs[s_] = T[(size_t)(kc0 + s_) * 2048];
        }
        if (FINAL && tid < 256) {
            float hc = 0.f;
            if (cdir == 0) {
#pragma unroll
                for (int k = 0; k < 33; ++k) hc = ct[k].x * hc + ct[k].y;
#pragma unroll
                for (int s_ = 0; s_ < 4; ++s_) { hin[(s_ * 2 + 0) * 128 + ccl] = hc; hc = cs[s_].x * hc + cs[s_].y; }
            } else {
                hc = ct[0].y;
#pragma unroll
                for (int k = 32; k >= 1; --k) hc = ct[k].x * hc + ct[k].y;
#pragma unroll
                for (int s_ = 3; s_ >= 0; --s_) { hin[(s_ * 2 + 1) * 128 + ccl] = hc; hc = cs[s_].x * hc + cs[s_].y; }
            }
        }
        __syncthreads();
        for (int sub = isctx ? csub : 0; sub < (isctx ? csub + 1 : 4); ++sub) {
            const int t0 = sbase + 64 * sub;
            const unsigned char* xcs = lds + B_XC_OFF + 64 * sub * XC_STRIDE;
            f32x4 hf[4], hb[4]; float tA, tB;
            lru_dir<FINAL, 0>(xcs, fb[0], fb[1], cst[0 * 128 + chl], cst[1 * 128 + chl], cst[2 * 128 + chl], fr, q, chl, FINAL ? hin[(sub * 2 + 0) * 128 + chl] : 0.f, hf, tA, tB);
            if (!FINAL) { if (q == 0) TOT[((size_t)(b * NCH64 + kc0 + sub) * 2 + 0) * 1024 + ch] = (f32x2){tA, tB};
                runBf = tA * runBf + tB; runAf = tA * runAf; }
            u32x4 gy0, gy1;
            if (FINAL) { const bf16_t* GYG = (const bf16_t*)(p.ws + OFF_SLOT + 2 * SLOT) + ((size_t)b * SEQ + t0 + lane) * 1024 + h * 128 + 16 * wave;
                gy0 = *(const u32x4*)GYG; gy1 = *(const u32x4*)(GYG + 8); }
            lru_dir<FINAL, 1>(xcs, fb[2], fb[3], cst[3 * 128 + chl], cst[4 * 128 + chl], cst[5 * 128 + chl], fr, q, chl, FINAL ? hin[(sub * 2 + 1) * 128 + chl] : 0.f, hb, tA, tB);
            if (!FINAL) { if (q == 0) TOT[((size_t)(b * NCH64 + kc0 + sub) * 2 + 1) * 1024 + ch] = (f32x2){tA, tB};
                runBb = runAb * tB + runBb; runAb = runAb * tA; }
            if (FINAL) {
                float* wy = (float*)(lds + B_Y_OFF) + wave * (64 * 20);
#pragma unroll
                for (int m = 0; m < 4; ++m)
#pragma unroll
                    for (int i = 0; i < 4; ++i) wy[(16 * m + 4 * q + i) * 20 + fr] = hf[m][i] + hb[m][i];
                wave_lds_sync();
                const f32x4* yp = (const f32x4*)(wy + lane * 20);
                const f32x4 y0 = yp[0], y1 = yp[1], y2 = yp[2], y3 = yp[3];
                u32x4 o0, o1;
                o0.x = pk2(bflo(gy0.x) * y0[0], bfhi(gy0.x) * y0[1]); o0.y = pk2(bflo(gy0.y) * y0[2], bfhi(gy0.y) * y0[3]);
                o0.z = pk2(bflo(gy0.z) * y1[0], bfhi(gy0.z) * y1[1]); o0.w = pk2(bflo(gy0.w) * y1[2], bfhi(gy0.w) * y1[3]);
                o1.x = pk2(bflo(gy1.x) * y2[0], bfhi(gy1.x) * y2[1]); o1.y = pk2(bflo(gy1.y) * y2[2], bfhi(gy1.y) * y2[3]);
                o1.z = pk2(bflo(gy1.z) * y3[0], bfhi(gy1.z) * y3[1]); o1.w = pk2(bflo(gy1.w) * y3[2], bfhi(gy1.w) * y3[3]);
                bf16_t* AB = (bf16_t*)(p.ws + OFF_SLOT + 1 * SLOT) + ((size_t)b * SEQ + t0 + lane) * 1024 + h * 128 + 16 * wave;
                *(u32x4*)AB = o0; *(u32x4*)(AB + 8) = o1;
                wave_lds_sync();
            }
        }
        __syncthreads();
        if (!FINAL && q == 0 && !isctx) {
            TOT256[((size_t)(b * 33 + k256) * 2 + 0) * 1024 + ch] = (f32x2){runAf, runBf};
            TOT256[((size_t)(b * 33 + k256) * 2 + 1) * 1024 + ch] = (f32x2){runAb, runBb};
        }
    }
}

__device__ __forceinline__ void ph8_route(const Params& p, int bid, int nb, unsigned char* lds) {
    constexpr int NU = 1;
    const int tid = threadIdx.x, lane = tid & 63, wave = tid >> 6;
    float* Wl = (float*)lds;
    int* lcnt = (int*)(lds + 81920);
    int* lbase = lcnt + 16;
    int* tinfo = lcnt + 32;
    float* twt = (float*)(tinfo + 512);
#pragma unroll 1
    for (int kk = 0; kk < 2; ++kk) { const int k = tid + kk * NTHR;
        const f32x4 wg = *(const f32x4*)(p.in[I_WGRP] + k * 4);
        Wl[0 * 1024 + k] = wg[0]; Wl[1 * 1024 + k] = wg[1]; Wl[2 * 1024 + k] = wg[2]; Wl[3 * 1024 + k] = wg[3];
#pragma unroll
        for (int o4 = 0; o4 < 4; ++o4) { const f32x4 we = *(const f32x4*)(p.in[I_WER] + k * 16 + o4 * 4);
            Wl[(4 + o4 * 4 + 0) * 1024 + k] = we[0]; Wl[(4 + o4 * 4 + 1) * 1024 + k] = we[1]; Wl[(4 + o4 * 4 + 2) * 1024 + k] = we[2]; Wl[(4 + o4 * 4 + 3) * 1024 + k] = we[3]; } }
    __syncthreads();
    const float* MOD = (const float*)(p.ws + OFF_MOD);
    const bf16_t* X1B = (const bf16_t*)(p.ws + OFF_SLOT + 5 * SLOT);
    bf16_t* HM = (bf16_t*)(p.ws + OFF_SLOT + 2 * SLOT);
    unsigned* gcnt = (unsigned*)(p.ws + OFF_CTL);
    int* LIST = (int*)(p.ws + OFF_LIST); float* WLs = (float*)(p.ws + OFF_WL); int* ROUTE = (int*)(p.ws + OFF_ROUTE);
    float* bl = (float*)(lds + 81920 + 8192);
    if (tid < 20) bl[tid] = tid < 4 ? p.in[I_BGRP][tid] : p.in[I_BER][tid - 4];
    __syncthreads();
    for (int tile = bid; tile < NT / 128; tile += nb) {
        if (tid < 16) lcnt[tid] = 0;
        __syncthreads();
        const float* mrow = MOD + ((tile * 128) / SEQ) * 6144;
        f32x4 gq[4], shq[4], scq[4];
#pragma unroll
        for (int j = 0; j < 4; ++j) { const int c = lane * 4 + 256 * j; gq[j] = *(const f32x4*)(p.in[I_GFFN] + c); shq[j] = *(const f32x4*)(mrow + 3 * 1024 + c); scq[j] = *(const f32x4*)(mrow + 4 * 1024 + c); gq[j] = gq[j] * (1.0f + scq[j]); }
        u32x2 nx[4];
#pragma unroll
        for (int j = 0; j < 4; ++j) nx[j] = *(const u32x2*)(X1B + (size_t)(tile * 128 + wave * 16) * DM + lane * 4 + 256 * j);
#pragma unroll 1
        for (int tt = 0; tt < 16; tt += NU) {
            const int tl = wave * 16 + tt, tok = tile * 128 + tl;
            f32x4 v[NU][4]; float ss[NU];
#pragma unroll
            for (int u = 0; u < NU; ++u) ss[u] = 0.f;
#pragma unroll
            for (int j = 0; j < 4; ++j) { v[0][j] = (f32x4){bflo(nx[j].x), bfhi(nx[j].x), bflo(nx[j].y), bfhi(nx[j].y)}; const f32x4 sq = v[0][j] * v[0][j]; ss[0] += (sq[0] + sq[1]) + (sq[2] + sq[3]); }
            { const int tn = tt + 1 < 16 ? tok + 1 : tok;
#pragma unroll
                for (int j = 0; j < 4; ++j) nx[j] = *(const u32x2*)(X1B + (size_t)tn * DM + lane * 4 + 256 * j); }
            float lg[NU][20];
#pragma unroll
            for (int u = 0; u < NU; ++u) { const float rinv = rsqrtf(wave_sum_dpp(ss[u]) * (1.0f / DM) + 1e-6f);
#pragma unroll
                for (int j = 0; j < 4; ++j) { v[u][j] = v[u][j] * rinv * gq[j] + shq[j]; *(u32x2*)(HM + (size_t)(tok + u) * DM + lane * 4 + 256 * j) = pk4(v[u][j]); }
}
#pragma unroll
            for (int o = 0; o < 20; ++o)
            { f32x4 wv[4];
#pragma unroll
                for (int j = 0; j < 4; ++j) wv[j] = *(const f32x4*)(Wl + o * 1024 + lane * 4 + 256 * j);
#pragma unroll
                for (int u = 0; u < NU; ++u) { f32x4 pr = v[u][0] * wv[0]; pr += v[u][1] * wv[1]; pr += v[u][2] * wv[2]; pr += v[u][3] * wv[3]; lg[u][o] = (pr[0] + pr[1]) + (pr[2] + pr[3]); }
                if ((o & 3) == 3) asm volatile("" ::: "memory"); }
#pragma unroll
            for (int u = 0; u < NU; ++u) {
#pragma unroll
                for (int o = 0; o < 20; ++o) lg[u][o] = wave_sum_dpp(lg[u][o]) + bl[o];
                int gs = 0; float gm = lg[u][0];
#pragma unroll
                for (int o = 1; o < 4; ++o) if (lg[u][o] > gm) { gm = lg[u][o]; gs = o; }
                float den = 0.f;
#pragma unroll
                for (int o = 0; o < 4; ++o) den += __expf(lg[u][o] - gm);
                const float pg = 1.0f / den;
                float el[4];
#pragma unroll
                for (int o = 0; o < 4; ++o) el[o] = gs == 0 ? lg[u][4 + o] : gs == 1 ? lg[u][8 + o] : gs == 2 ? lg[u][12 + o] : lg[u][16 + o];
                int i1 = 0; float v1 = el[0];
#pragma unroll
                for (int o = 1; o < 4; ++o) if (el[o] > v1) { v1 = el[o]; i1 = o; }
                int i2 = -1; float v2 = -3.0e38f;
#pragma unroll
                for (int o = 0; o < 4; ++o) if (o != i1 && el[o] > v2) { v2 = el[o]; i2 = o; }
                const float w1 = 1.0f / (1.0f + __expf(v2 - v1)), w2 = 1.0f - w1;
                if (lane == 0) { const int e1 = gs * 4 + i1, e2 = gs * 4 + i2;
                    const int r1 = atomicAdd(&lcnt[e1], 1), r2 = atomicAdd(&lcnt[e2], 1);
                    tinfo[(tl + u) * 4 + 0] = e1; tinfo[(tl + u) * 4 + 1] = r1; tinfo[(tl + u) * 4 + 2] = e2; tinfo[(tl + u) * 4 + 3] = r2; twt[(tl + u) * 2] = pg * w1; twt[(tl + u) * 2 + 1] = pg * w2; }
            }
        }
        __syncthreads();
        if (tid < 16) lbase[tid] = (int)__hip_atomic_fetch_add(gcnt + tid, (unsigned)lcnt[tid], __ATOMIC_RELAXED, __HIP_MEMORY_SCOPE_AGENT);
        __syncthreads();
        if (tid < 128) { const int tok = tile * 128 + tid;
            const int e1 = tinfo[tid * 4], e2 = tinfo[tid * 4 + 2], p1 = lbase[e1] + tinfo[tid * 4 + 1], p2 = lbase[e2] + tinfo[tid * 4 + 3];
            LIST[e1 * NT + p1] = tok; LIST[e2 * NT + p2] = tok; WLs[e1 * NT + p1] = twt[tid * 2]; WLs[e2 * NT + p2] = twt[tid * 2 + 1];
            ROUTE[tok * 4 + 0] = e1; ROUTE[tok * 4 + 1] = p1; ROUTE[tok * 4 + 2] = e2; ROUTE[tok * 4 + 3] = p2; }
        __syncthreads();
    }
}

__device__ __forceinline__ void ph10_final(const Params& p, int bid, int nb, const int* meta) {
    const int lane = threadIdx.x & 63, wave = threadIdx.x >> 6;
    const float* MOD = (const float*)(p.ws + OFF_MOD);
    const bf16_t* Y = (const bf16_t*)(p.ws + OFF_SLOT);
    const int* ROUTE = (const int*)(p.ws + OFF_ROUTE);
    const bf16_t* X1B = (const bf16_t*)(p.ws + OFF_SLOT + 5 * SLOT); float* OUT = p.out;
    const int r0 = bid * 8 + wave, rs = nb * 8;
    f32x4 gf[4], gtv[4]; int mprev = -1;
#pragma unroll
    for (int j = 0; j < 4; ++j) gf[j] = *(const f32x4*)(p.in[I_GFINAL] + lane * 4 + 256 * j);
    auto yrow = [&](int r, int k) -> const bf16_t* { const int e = ROUTE[r * 4 + 2 * k], pp = ROUTE[r * 4 + 2 * k + 1]; return Y + ((size_t)meta[16 + e] * 256 + pp) * 1024; };
    u32x2 nx[4], na[4], nb2[4];
    const bf16_t *ya = yrow(r0, 0), *yb = yrow(r0, 1);
#pragma unroll
    for (int j = 0; j < 4; ++j) { const int c = lane * 4 + 256 * j; nx[j] = *(const u32x2*)(X1B + (size_t)r0 * DM + c); na[j] = *(const u32x2*)(ya + c); nb2[j] = *(const u32x2*)(yb + c); }
    { const int rn = r0 + rs < NT ? r0 + rs : r0; ya = yrow(rn, 0); yb = yrow(rn, 1); }
#pragma unroll 1
    for (int r = r0; r < NT; r += rs) {
        const int mb = r / SEQ;
        if (mb != mprev) { mprev = mb;
#pragma unroll
            for (int j = 0; j < 4; ++j) gtv[j] = *(const f32x4*)(MOD + mb * 6144 + 5 * 1024 + lane * 4 + 256 * j); }
        f32x4 v[4]; float ss = 0.f;
#pragma unroll
        for (int j = 0; j < 4; ++j) {
            v[j] = (f32x4){bflo(nx[j].x), bfhi(nx[j].x), bflo(nx[j].y), bfhi(nx[j].y)};
            const f32x4 ys = (f32x4){bflo(na[j].x) + bflo(nb2[j].x), bfhi(na[j].x) + bfhi(nb2[j].x), bflo(na[j].y) + bflo(nb2[j].y), bfhi(na[j].y) + bfhi(nb2[j].y)};
            v[j] += gtv[j] * ys; const f32x4 sq = v[j] * v[j]; ss += (sq[0] + sq[1]) + (sq[2] + sq[3]); }
        { const int rn = r + rs < NT ? r + rs : r;
#pragma unroll
            for (int j = 0; j < 4; ++j) { const int c = lane * 4 + 256 * j; nx[j] = *(const u32x2*)(X1B + (size_t)rn * DM + c); na[j] = *(const u32x2*)(ya + c); nb2[j] = *(const u32x2*)(yb + c); }
            const int rn2 = r + 2 * rs < NT ? r + 2 * rs : rn; ya = yrow(rn2, 0); yb = yrow(rn2, 1); }
        const float rinv = rsqrtf(wave_sum_dpp(ss) * (1.0f / DM) + 1e-6f);
#pragma unroll
        for (int j = 0; j < 4; ++j) *(f32x4*)(OUT + (size_t)r * DM + lane * 4 + 256 * j) = v[j] * rinv * gf[j];
    }
}

#define XB_TMO      128
#define XB_XCNT(j)  (256  + 64 * (j))
#define XB_XSUB(j)  (1280 + 64 * (j))
#define XB_XGEN(j)  (2304 + 64 * (j))
#define XB_TOP      3328
#define XB_TOPGEN   3392
#define XCD_BAR_WORDS 3456
#define XB_SPIN_CAP (1u << 18)
__device__ __forceinline__ unsigned xb_ld(unsigned* p)              { return __hip_atomic_load(p, __ATOMIC_RELAXED, __HIP_MEMORY_SCOPE_AGENT); }
__device__ __forceinline__ unsigned xb_add(unsigned* p, unsigned v) { return __hip_atomic_fetch_add(p, v, __ATOMIC_RELAXED, __HIP_MEMORY_SCOPE_AGENT); }
__device__ __forceinline__ unsigned xb_xcc_id() { return (unsigned)__builtin_amdgcn_s_getreg((3 << 11) | 20) & 0xFu; }
#define XB_SPIN(cond, bar) do { unsigned _sp = 0; while (cond) { __builtin_amdgcn_s_sleep(1); \
    if ((++_sp & 255u) == 0u) { if (xb_ld(&(bar)[XB_TMO])) break; if (_sp > XB_SPIN_CAP) { atomicAdd(&(bar)[XB_TMO], 1u); break; } } } } while (0)
struct XcdBarrier { unsigned* bar; unsigned x; volatile unsigned* st; };
__device__ __forceinline__ XcdBarrier xcd_barrier_post(unsigned* bar, volatile unsigned* st) {
    XcdBarrier b; b.bar = bar; b.x = xb_xcc_id(); b.st = st;
    if (threadIdx.x == 0) (void)xb_add(&bar[XB_XCNT(b.x)], 1u);
    return b;
}
__device__ __forceinline__ void xcd_barrier_complete(unsigned* bar, unsigned x, unsigned& nloc, unsigned& nx) {
    const unsigned G = gridDim.x * gridDim.y * gridDim.z;
    unsigned sum, cnt, mine, sp = 0u;
    for (;;) {
        sum = 0u; cnt = 0u; mine = 0u;
#pragma unroll
        for (unsigned j = 0; j < 16; ++j) { const unsigned c = xb_ld(&bar[XB_XCNT(j)]); sum += c; cnt += (c > 0u) ? 1u : 0u; mine = (j == x) ? c : mine; }
        if (sum == G) break;
        __builtin_amdgcn_s_sleep(1);
        if ((++sp & 255u) == 0u) { if (xb_ld(&bar[XB_TMO])) break; if (sp > XB_SPIN_CAP) { atomicAdd(&bar[XB_TMO], 1u); break; } }
    }
    nloc = mine > 0u ? mine : 1u; nx = cnt > 0u ? cnt : 1u;
}
__device__ __forceinline__ void xcd_barrier(const XcdBarrier& b) {
    asm volatile("s_waitcnt vmcnt(0)" ::: "memory");
    __syncthreads();
    if (threadIdx.x == 0) {
        unsigned* bar = b.bar;
        __builtin_amdgcn_s_waitcnt(0);
        unsigned nloc = b.st[0], nx = b.st[1];
        if (nloc == 0u) { xcd_barrier_complete(bar, b.x, nloc, nx); b.st[0] = nloc; b.st[1] = nx; }
        const unsigned old = xb_add(&bar[XB_XSUB(b.x)], 1u);
        const unsigned gen = old / nloc;
        if (old + 1u == (gen + 1u) * nloc) {
            __builtin_amdgcn_fence(__ATOMIC_RELEASE, "agent");
            asm volatile("s_waitcnt vmcnt(0)" ::: "memory");
            const unsigned og = xb_add(&bar[XB_TOP], 1u);
            const unsigned tg = og / nx;
            if (og + 1u == (tg + 1u) * nx) xb_add(&bar[XB_TOPGEN], 1u);
            else XB_SPIN(xb_ld(&bar[XB_TOPGEN]) == tg, bar);
            __builtin_amdgcn_fence(__ATOMIC_ACQUIRE, "agent");
            xb_add(&bar[XB_XGEN(b.x)], 1u);
            asm volatile("s_waitcnt vmcnt(0)" ::: "memory");
        } else {
            XB_SPIN(xb_ld(&bar[XB_XGEN(b.x)]) == gen, bar);
            __builtin_amdgcn_fence(__ATOMIC_ACQUIRE, "agent");
            asm volatile("s_waitcnt vmcnt(0)" ::: "memory");
        }
    }
    __syncthreads();
}
constexpr size_t OFF_BAR = OFF_CTL + 4096;

__global__ void __launch_bounds__(NTHR) mega(Params p, int lo, int hi) {
    extern __shared__ __attribute__((aligned(16))) unsigned char lds[];
    cg::grid_group grid = cg::this_grid();
    const int bid = blockIdx.x, nb = gridDim.x;
    unsigned char* ws = p.ws;
    bf16_t* S0 = (bf16_t*)(ws + OFF_SLOT), *S1 = (bf16_t*)(ws + OFF_SLOT + SLOT), *S2 = (bf16_t*)(ws + OFF_SLOT + 2 * SLOT), *S3 = (bf16_t*)(ws + OFF_SLOT + 3 * SLOT),
           *S4 = (bf16_t*)(ws + OFF_SLOT + 4 * SLOT), *S5 = (bf16_t*)(ws + OFF_SLOT + 5 * SLOT);
    const float* MOD = (const float*)(ws + OFF_MOD); const float* BINP = (const float*)(ws + OFF_BINP);
    int* meta = (int*)(lds + LDS_BYTES - 256);
#ifndef PHMASK
#define PHMASK 0x7ff
#endif
#define IN(k) (((PHMASK >> (k)) & 1) && lo <= (k) && (k) < hi)
#ifndef PIPE_MASK
#define PIPE_MASK 0x364
#endif
#define GEMM_RUN(k, gather, s, e) gemm_phase_pipe<gather>(lds, s, e)
    volatile unsigned* xst = (volatile unsigned*)(lds + LDS_BYTES - 16);
    if (threadIdx.x < 2) xst[threadIdx.x] = 0u;
    __syncthreads();
    XcdBarrier xbar; xbar.bar = (unsigned*)(ws + OFF_BAR); xbar.x = 0; xbar.st = xst;
    if (hi - lo > 1) xbar = xcd_barrier_post((unsigned*)(ws + OFF_BAR), xst);
    if (p.pv == 0x7eadbeef) grid.sync();
#define SEAM(k) do { if (IN(k) && IN((k) + 1)) xcd_barrier(xbar); } while (0)
    if (IN(0)) { ph0_prep(p, bid, nb, lds); } SEAM(0);
    if (IN(1)) { if (ph1_norm(p, bid, nb)) { SchCtx s{(const bf16_t*)(ws + OFF_HC), (const bf16_t*)(ws + OFF_WIN), CTX_GEMM_WGS, bid, 1024}; EpiCtx e{(bf16_t*)(ws + OFF_XRC), BINP}; GEMM_RUN(1, false, s, e); } } SEAM(1);
    if (IN(2)) {
        if (nb < 4 * CTX_GEMM_WGS) { SchCtx s{(const bf16_t*)(ws + OFF_HC), (const bf16_t*)(ws + OFF_WIN), nb, bid, 1024}; EpiCtx e{(bf16_t*)(ws + OFF_XRC), BINP}; GEMM_RUN(2, false, s, e); }
        { SchG1 s{S0, (const bf16_t*)(ws + OFF_WIN), nb, bid, 1024}; EpiG1 e{S1, S2, S3, S4, S5, BINP}; GEMM_RUN(2, false, s, e); }
    } SEAM(2);
    if (IN(3)) {
#ifndef NO_APREP
        for (int g = bid; g < 512; g += nb) aprep_item(p, g, lds);
#endif
#ifndef NO_BLOCAL
        b_phase<false>(p, bid, nb, lds);
#endif
    } SEAM(3);
    if (IN(4)) {
        if (!(bid & 1)) { prep_items(p, PREP_EARLY, PREP_ALL, bid * 8 + (int)(threadIdx.x >> 6), nb * 8, lds); __syncthreads(); }
        b_phase<true>(p, bid, nb, lds);
        if (bid & 1) { __syncthreads(); prep_items(p, PREP_EARLY, PREP_ALL, bid * 8 + (int)(threadIdx.x >> 6), nb * 8, lds); }
    } SEAM(4);
    if (IN(5)) { SchG2 s{S0, S1, (const bf16_t*)(ws + OFF_WPA), (const bf16_t*)(ws + OFF_WPB), nb, bid, 1024}; EpiG2 e{S4, S5, S3}; GEMM_RUN(5, false, s, e); } SEAM(5);
    if (IN(6)) { SchG3 s{S3, (const bf16_t*)(ws + OFF_WO), nb, bid, 1024}; EpiG3 e{p.in[I_X], MOD, S5}; GEMM_RUN(6, false, s, e); } SEAM(6);
    if (IN(7)) { ph8_route(p, bid, nb, lds); } SEAM(7);
    if (IN(8)) { __syncthreads(); moe_meta_build(p, meta); MoeMeta mm{meta};
        int* idx = (int*)(lds + STAGE_BYTES);
        SchUp s{S2, (const bf16_t*)(ws + OFF_WGU), (const int*)(ws + OFF_LIST), mm, nb, bid, 1024, idx}; EpiUp e{S3, (const float*)(ws + OFF_WL), mm};
        { int iv[8]; bool ok[8];
#pragma unroll
            for (int i = 0; i < 8; ++i) { Unit u; ok[i] = s.next(i, u); iv[i] = 0;
                if (ok[i] && threadIdx.x < 256) { int pos = u.aux2 + (int)threadIdx.x; const int c = mm.cnt(u.aux); pos = pos < c ? pos : c - 1; iv[i] = s.LIST[u.aux * NT + pos]; } }
#pragma unroll
            for (int i = 0; i < 8; ++i) if (ok[i] && threadIdx.x < 256) idx[i * 256 + threadIdx.x] = iv[i]; }
        __syncthreads();
        GEMM_RUN(8, true, s, e); } SEAM(8);
    if (IN(9)) { __syncthreads(); moe_meta_build(p, meta); MoeMeta mm{meta};
        SchDn s{S3, (const bf16_t*)(ws + OFF_WDN), mm, nb, bid, 512}; EpiDn e{S0, mm}; GEMM_RUN(9, false, s, e); } SEAM(9);
    if (IN(10)) { __syncthreads(); moe_meta_build(p, meta); ph10_final(p, bid, nb, meta); }
#undef IN
#undef SEAM
}

extern "C" void kernel_launch(void* const* d_in, const int* in_sizes, int n_in, void* d_out, int out_size, void* d_ws, size_t ws_size, hipStream_t stream) {
    static int grid = 0;
    if (grid == 0) {
        if (n_in != 37 || out_size != NT * DM || ws_size < WS_END) { fprintf(stderr, "kernel_launch: unexpected shapes: n_in %d out %d ws %zu (need %zu)\n", n_in, out_size, ws_size, (size_t)WS_END); grid = -1; return; }
        int dev = 0, cus = 0, per_cu = 0;
        (void)hipGetDevice(&dev); (void)hipDeviceGetAttribute(&cus, hipDeviceAttributeMultiprocessorCount, dev);
        if (hipFuncSetAttribute((const void*)mega, hipFuncAttributeMaxDynamicSharedMemorySize, LDS_BYTES) != hipSuccess) { fprintf(stderr, "kernel_launch: hipFuncSetAttribute failed\n"); grid = -1; return; }
        if (hipOccupancyMaxActiveBlocksPerMultiprocessor(&per_cu, (const void*)mega, NTHR, LDS_BYTES) != hipSuccess || per_cu < 1) { fprintf(stderr, "kernel_launch: occupancy query says %d\n", per_cu); per_cu = 1; }
        (void)hipGetLastError();
        grid = cus * 1;
        fprintf(stderr, "kernel_launch: grid %d (cus %d, per_cu %d)\n", grid, cus, per_cu);
    }
    if (grid < 0) return;
    Params p{};
    for (int i = 0; i < 37; ++i) p.in[i] = (const float*)d_in[i];
    p.out = (float*)d_out; p.ws = (unsigned char*)d_ws;
#if ONE_LAUNCH
    (void)hipMemsetAsync((unsigned char*)d_ws + OFF_BAR, 0, XCD_BAR_WORDS * 4, stream);
    int lo = 0, hi = NPHASE; void* args[] = {&p, &lo, &hi};
    hipError_t e = hipLaunchCooperativeKernel((const void*)mega, dim3(grid), dim3(NTHR), args, LDS_BYTES, stream);
    if (e != hipSuccess) fprintf(stderr, "cooperative launch failed: %s (grid %d)\n", hipGetErrorString(e), grid);
#ifdef PROBE_PHASE
    hipLaunchKernelGGL(mega, dim3(grid), dim3(NTHR), LDS_BYTES, stream, p, PROBE_PHASE, PROBE_PHASE + 1);
#endif
#else
    for (int k = 0; k < NPHASE; ++k) hipLaunchKernelGGL(mega, dim3(grid), dim3(NTHR), LDS_BYTES, stream, p, k, k + 1);
#endif
}
```

```cpp
#include <hip/hip_runtime.h>
#include <hip/hip_cooperative_groups.h>
#include <cstdio>
#include <cstdint>
namespace cg = cooperative_groups;

#ifndef ONE_LAUNCH
#define ONE_LAUNCH 1
#endif

typedef unsigned short bf16_t;
typedef short bf16x8 __attribute__((ext_vector_type(8)));
typedef float f32x4 __attribute__((ext_vector_type(4)));
typedef float f32x2 __attribute__((ext_vector_type(2)));
typedef unsigned u32x4 __attribute__((ext_vector_type(4)));
typedef unsigned u32x2 __attribute__((ext_vector_type(2)));

constexpr int NT = 32768, NCX = 1024, DM = 1024, SEQ = 8192, CTXL = 256;
constexpr int NTHR = 512;
constexpr int NCH64 = 132;
constexpr size_t MiB = (size_t)1 << 20;
constexpr size_t OFF_CTL = 0, OFF_MOD = 1 * MiB, OFF_BINP = OFF_MOD + 128 * 1024, OFF_WIN = 2 * MiB, OFF_WPA = 14 * MiB, OFF_WPB = 16 * MiB,
                 OFF_WO = 18 * MiB, OFF_WG = 20 * MiB, OFF_WGU = 22 * MiB, OFF_WDN = 54 * MiB, OFF_HC = 70 * MiB, OFF_XRC = 72 * MiB,
                 OFF_TOT = 74 * MiB, OFF_ROUTE = 84 * MiB, OFF_LIST = 85 * MiB, OFF_WL = 87 * MiB, OFF_SLOT = 90 * MiB, SLOT = 64 * MiB,
                 WS_END = OFF_SLOT + 6 * SLOT;
constexpr int LDS_BYTES = 144 * 1024;
constexpr int NPHASE = 11;

struct Params { const float* in[37]; float* out; unsigned char* ws; int pv; int pad; };

enum { I_X = 0, I_C, I_CTX, I_CCTX, I_WADA, I_BADA, I_GMIX, I_WIN, I_BIN, I_CONVW, I_CONVB, I_LNG, I_LNB, I_WPA, I_LCW, I_LCB,
       I_WRF, I_BRF, I_WIF, I_BIF, I_LAMF, I_WRB, I_BRB, I_WIB, I_BIB, I_LAMB, I_WPB, I_WO, I_GFFN, I_WGRP, I_BGRP, I_WER, I_BER,
       I_WGATE, I_WUP, I_WDOWN, I_GFINAL };

__device__ __forceinline__ float bflo(unsigned w) { return __uint_as_float(w << 16); }
__device__ __forceinline__ float bfhi(unsigned w) { return __uint_as_float(w & 0xffff0000u); }
__device__ __forceinline__ float bf2f(bf16_t h) { return __uint_as_float(((unsigned)h) << 16); }
__device__ __forceinline__ unsigned pk2(float lo, float hi) { unsigned r; asm("v_cvt_pk_bf16_f32 %0, %1, %2" : "=v"(r) : "v"(lo), "v"(hi)); return r; }
__device__ __forceinline__ bf16_t f2bf(float f) { return (bf16_t)(pk2(f, 0.f) & 0xffffu); }
__device__ __forceinline__ float sigm(float x) { return __builtin_amdgcn_rcpf(1.0f + __expf(-x)); }
__device__ __forceinline__ float sigm2(float x2) { return __builtin_amdgcn_rcpf(1.0f + __builtin_amdgcn_exp2f(x2)); }
__device__ __forceinline__ float silu(float x) { return x * sigm(x); }
__device__ __forceinline__ float gelu_tanh(float x) { return x * sigm(1.5957691216057308f * (x + 0.044715f * x * x * x)); }
__device__ __forceinline__ float wave_sum(float v) {
#pragma unroll
    for (int o = 1; o < 64; o <<= 1) v += __shfl_xor(v, o);
    return v;
}
template <int CTRL, int RMASK> __device__ __forceinline__ float dpp_add(float v) { return v + __int_as_float(__builtin_amdgcn_update_dpp(0, __float_as_int(v), CTRL, RMASK, 0xF, false)); }
__device__ __forceinline__ float wave_sum_dpp(float v) {
    v = dpp_add<0xB1, 0xF>(v); v = dpp_add<0x4E, 0xF>(v); v = dpp_add<0x141, 0xF>(v); v = dpp_add<0x140, 0xF>(v); v = dpp_add<0x142, 0xA>(v); v = dpp_add<0x143, 0xC>(v);
    return __int_as_float(__builtin_amdgcn_readlane(__float_as_int(v), 63));
}
__device__ __forceinline__ void wave_lds_sync() { asm volatile("s_waitcnt lgkmcnt(0)" ::: "memory"); __builtin_amdgcn_wave_barrier(); }
__device__ __forceinline__ u32x2 pk4(f32x4 v) { u32x2 r; r.x = pk2(v[0], v[1]); r.y = pk2(v[2], v[3]); return r; }

__device__ __forceinline__ u32x4 pk8(f32x4 a, f32x4 b) { u32x4 r; r.x = pk2(a[0], a[1]); r.y = pk2(a[2], a[3]); r.z = pk2(b[0], b[1]); r.w = pk2(b[2], b[3]); return r; }
__device__ __forceinline__ void unpk8(u32x4 w, f32x4& a, f32x4& b) { a[0] = bflo(w.x); a[1] = bfhi(w.x); a[2] = bflo(w.y); a[3] = bfhi(w.y); b[0] = bflo(w.z); b[1] = bfhi(w.z); b[2] = bflo(w.w); b[3] = bfhi(w.w); }

template <class DRow>
__device__ __forceinline__ void tr_item(const float* __restrict__ src, int ldsrc, int k0, int n0, bf16_t* dst, int ldd, DRow drow, float* scr, int lane, float scale = 1.0f) {
    const float* sp = src + (size_t)k0 * ldsrc + n0 + lane;
    float tv[64];
#pragma unroll
    for (int kk = 0; kk < 64; ++kk) tv[kk] = sp[(size_t)kk * ldsrc];
#pragma unroll
    for (int kk = 0; kk < 64; ++kk) scr[kk * 65 + lane] = tv[kk] * scale;
    wave_lds_sync();
    const int c = lane & 7;
#pragma unroll
    for (int j = 0; j < 8; ++j) {
        const int n = (lane >> 3) + 8 * j; const float* s = scr + (8 * c) * 65 + n;
        u32x4 o; o.x = pk2(s[0], s[65]); o.y = pk2(s[130], s[195]); o.z = pk2(s[260], s[325]); o.w = pk2(s[390], s[455]);
        *(u32x4*)(dst + (size_t)drow(n0 + n) * ldd + k0 + 8 * c) = o;
    }
    wave_lds_sync();
}

__device__ __forceinline__ int win_srccol(int np) { const int p = np >> 8, r = np & 255; return p < 8 ? (r >> 7) * 1024 + 128 * p + (r & 127) : np; }

constexpr int N_WIN = 16 * 96, N_SQ = 16 * 16, N_G = 128, N_GU = 2048, N_DN = 2048;
constexpr int PREP_EARLY = N_WIN + 3 * N_SQ + N_G, PREP_ALL = PREP_EARLY + 2 * N_GU + N_DN;
__device__ __forceinline__ void prep_items(const Params& p, int first, int last, int gw, int NGW, unsigned char* lds) {
    const int lane = threadIdx.x & 63, wave = threadIdx.x >> 6;
    unsigned char* ws = p.ws;
    float* scr = (float*)lds + wave * (64 * 65);
    for (int it = first + gw; it < last; it += NGW) {
        int r = it;
        if (r < N_WIN) { const int kb = r / 96, nbk = r % 96, d0 = 64 * nbk, sc0 = win_srccol(d0);
            const int pt = d0 >> 8; const bool sgm = (pt < 8 && ((d0 >> 7) & 1)) || pt >= 16;
            tr_item(p.in[I_WIN], 6144, 64 * kb, sc0, (bf16_t*)(ws + OFF_WIN), 1024, [=](int n) { return n - sc0 + d0; }, scr, lane, sgm ? -1.4426950408889634f : 1.0f); continue; }
        r -= N_WIN;
        if (r < 3 * N_SQ) { const int which = r / N_SQ, q = r % N_SQ, kb = q / 16, nbk = q % 16;
            const float* src = which == 0 ? p.in[I_WPA] : which == 1 ? p.in[I_WPB] : p.in[I_WO];
            bf16_t* dst = (bf16_t*)(ws + (which == 0 ? OFF_WPA : which == 1 ? OFF_WPB : OFF_WO));
            tr_item(src, 1024, 64 * kb, 64 * nbk, dst, 1024, [=](int n) { return n; }, scr, lane); continue; }
        r -= 3 * N_SQ;
        if (r < N_G) { const int ty = r / 32, q = r % 32, h = q / 4, kb = (q % 4) / 2, nbk = q % 2;
            const float* src = (ty == 0 ? p.in[I_WRF] : ty == 1 ? p.in[I_WIF] : ty == 2 ? p.in[I_WRB] : p.in[I_WIB]) + (size_t)h * 128 * 128;
            tr_item(src, 128, 64 * kb, 64 * nbk, (bf16_t*)(ws + OFF_WG), 128, [=](int n) { return h * 512 + (n >> 4) * 64 + ty * 16 + (n & 15); }, scr, lane, -1.4426950408889634f); continue; }
        r -= N_G;
        if (r < 2 * N_GU) { const int bj = r / N_GU, q = r % N_GU, e = q / 128, kb = (q % 128) / 8, nbk = q % 8;
            const float* src = (bj == 0 ? p.in[I_WGATE] : p.in[I_WUP]) + (size_t)e * 1024 * 512;
            tr_item(src, 512, 64 * kb, 64 * nbk, (bf16_t*)(ws + OFF_WGU) + (size_t)e * 1024 * 1024, 1024, [=](int n) { return 256 * (n >> 7) + 128 * bj + (n & 127); }, scr, lane); continue; }
        r -= 2 * N_GU;
        { const int e = r / 128, kb = (r % 128) / 16, nbk = r % 16;
            tr_item(p.in[I_WDOWN] + (size_t)e * 512 * 1024, 1024, 64 * kb, 64 * nbk, (bf16_t*)(ws + OFF_WDN) + (size_t)e * 1024 * 512, 512, [=](int n) { return n; }, scr, lane); }
    }
}

__device__ __forceinline__ void ph0_prep(const Params& p, int bid, int nb, unsigned char* lds) {
    const int tid = threadIdx.x, lane = tid & 63, wave = tid >> 6;
    unsigned char* ws = p.ws;
    float* red = (float*)lds;
    float* MOD = (float*)(ws + OFF_MOD);
    for (int it = bid; it < 96; it += nb) {
        const int col = it * 64 + lane;
        float a[5] = {0.f, 0.f, 0.f, 0.f, 0.f};
        const float* W = p.in[I_WADA];
#pragma unroll 1
        for (int k0 = wave * 128; k0 < wave * 128 + 128; k0 += 64) {
            float wv[64];
#pragma unroll
            for (int kk = 0; kk < 64; ++kk) wv[kk] = W[(size_t)(k0 + kk) * 6144 + col];
#pragma unroll
            for (int kk = 0; kk < 64; ++kk)
#pragma unroll
                for (int r = 0; r < 5; ++r) { const float cv = r < 4 ? p.in[I_C][r * 1024 + k0 + kk] : p.in[I_CCTX][k0 + kk]; a[r] += silu(cv) * wv[kk]; }
        }
#pragma unroll
        for (int r = 0; r < 5; ++r) red[(wave * 5 + r) * 64 + lane] = a[r];
        __syncthreads();
        if (tid < 320) { const int r = tid / 64, l = tid % 64; float s = 0.f;
#pragma unroll
            for (int w = 0; w < 8; ++w) s += red[(w * 5 + r) * 64 + l];
            MOD[r * 6144 + it * 64 + l] = s + p.in[I_BADA][it * 64 + l]; }
        __syncthreads();
    }
    __syncthreads();
    if (nb > 96 + 32) { if (bid >= 96) prep_items(p, 0, PREP_EARLY, (bid - 96) * 8 + wave, (nb - 96) * 8, lds); }
    else prep_items(p, 0, PREP_EARLY, bid * 8 + wave, nb * 8, lds);
    float* BINP = (float*)(ws + OFF_BINP);
    for (int i = bid * NTHR + tid; i < 6144; i += nb * NTHR) { const int pt = i >> 8; const bool sgm = (pt < 8 && ((i >> 7) & 1)) || pt >= 16; BINP[i] = p.in[I_BIN][win_srccol(i)] * (sgm ? -1.4426950408889634f : 1.0f); }
    if (bid == 0) ((unsigned*)(ws + OFF_CTL))[tid] = 0u;
}

template <bool WT>
__device__ __forceinline__ void norm_row(const f32x4 (&v)[4], float ss, const f32x4 (&gsv)[4], const f32x4 (&shv)[4], bf16_t* dst, int lane) {
    const float rinv = rsqrtf(wave_sum_dpp(ss) * (1.0f / DM) + 1e-6f);
#pragma unroll
    for (int j = 0; j < 4; ++j) { const int c = lane * 4 + 256 * j;
        const u32x2 o = pk4(v[j] * rinv * gsv[j] + shv[j]);
        if (WT) __hip_atomic_store((unsigned long long*)(dst + c), ((unsigned long long)o.y << 32) | o.x, __ATOMIC_RELAXED, __HIP_MEMORY_SCOPE_AGENT);
        else *(u32x2*)(dst + c) = o; }
}
constexpr int CTX_GEMM_WGS = 16;
__device__ __forceinline__ bool ph1_norm(const Params& p, int bid, int nb) {
    const int lane = threadIdx.x & 63, wave = threadIdx.x >> 6;
    const float* MOD = (const float*)(p.ws + OFF_MOD);
    unsigned* ctxcnt = (unsigned*)(p.ws + OFF_CTL) + 32;
    f32x4 gm[4];
#pragma unroll
    for (int j = 0; j < 4; ++j) gm[j] = *(const f32x4*)(p.in[I_GMIX] + lane * 4 + 256 * j);
    f32x4 shv[4], gsv[4];
    const bool split = nb >= 4 * CTX_GEMM_WGS;
    for (int cr = bid * 8 + wave; cr < NCX; cr += nb * 8) {
        const float* mrow = MOD + 4 * 6144;
        f32x4 v[4]; float ss = 0.f;
#pragma unroll
        for (int j = 0; j < 4; ++j) { const int c = lane * 4 + 256 * j; v[j] = *(const f32x4*)(p.in[I_CTX] + (size_t)cr * DM + c); const f32x4 sq = v[j] * v[j]; ss += (sq[0] + sq[1]) + (sq[2] + sq[3]);
            shv[j] = *(const f32x4*)(mrow + c); gsv[j] = gm[j] * (1.0f + *(const f32x4*)(mrow + 1024 + c)); }
        norm_row<true>(v, ss, gsv, shv, (bf16_t*)(p.ws + OFF_HC) + (size_t)cr * DM, lane);
        asm volatile("s_waitcnt vmcnt(0)" ::: "memory");
        if (lane == 0) __hip_atomic_fetch_add(ctxcnt, 1u, __ATOMIC_RELAXED, __HIP_MEMORY_SCOPE_AGENT);
    }
    if (split && bid < CTX_GEMM_WGS) {
        if (threadIdx.x == 0) { unsigned sp = 0;
            while (__hip_atomic_load(ctxcnt, __ATOMIC_RELAXED, __HIP_MEMORY_SCOPE_AGENT) < (unsigned)NCX) { __builtin_amdgcn_s_sleep(2); if (++sp > (1u << 22)) break; }
            __builtin_amdgcn_fence(__ATOMIC_ACQUIRE, "agent");
            asm volatile("s_waitcnt vmcnt(0)" ::: "memory"); }
        __syncthreads();
        return true;
    }
    const int wg0 = split ? CTX_GEMM_WGS : 0;
    const int r0 = (bid - wg0) * 8 + wave, rs = (nb - wg0) * 8;
    int mprev = -1;
    f32x4 nx[4];
#pragma unroll
    for (int j = 0; j < 4; ++j) nx[j] = *(const f32x4*)(p.in[I_X] + (size_t)r0 * DM + lane * 4 + 256 * j);
#pragma unroll 1
    for (int r = r0; r < NT; r += rs) {
        const int mb = r / SEQ;
        if (mb != mprev) { mprev = mb; const float* mrow = MOD + mb * 6144;
#pragma unroll
            for (int j = 0; j < 4; ++j) { const int c = lane * 4 + 256 * j; shv[j] = *(const f32x4*)(mrow + c); gsv[j] = gm[j] * (1.0f + *(const f32x4*)(mrow + 1024 + c)); } }
        f32x4 v[4]; float ss = 0.f;
#pragma unroll
        for (int j = 0; j < 4; ++j) { v[j] = nx[j]; const f32x4 sq = v[j] * v[j]; ss += (sq[0] + sq[1]) + (sq[2] + sq[3]); }
        { const int rn = r + rs < NT ? r + rs : r;
#pragma unroll
            for (int j = 0; j < 4; ++j) nx[j] = *(const f32x4*)(p.in[I_X] + (size_t)rn * DM + lane * 4 + 256 * j); }
        norm_row<false>(v, ss, gsv, shv, (bf16_t*)(p.ws + OFF_SLOT) + (size_t)r * DM, lane);
    }
    return false;
}

struct Unit { int pm, pn, aux, aux2; };

#define LAS __attribute__((address_space(3)))
constexpr int BK = 64, HTB = 128 * BK * 2, STAGE_BYTES = 8 * HTB;
__device__ __forceinline__ int lds_byte(int r, int c) { const int st = (r >> 4) * 2 + (c >> 5), rr = r & 15, cc = c & 31, ob = rr * 64 + cc * 2; return st * 1024 + (ob ^ (((ob >> 9) & 1) << 5)); }
__device__ __forceinline__ void stage_rc(int b, int& R, int& C) { const int st = b / 1024, sb = b % 1024, swz = sb ^ (((sb >> 9) & 1) << 5); R = (st >> 1) * 16 + swz / 64; C = (st & 1) * 32 + (swz % 64) / 2; }

template <bool GATHER, class S, class E>
__device__ __forceinline__ void gemm_phase_pipe(unsigned char* ldsg, const S& sch, const E& epi) {
    LAS unsigned char* lds = (LAS unsigned char*)ldsg;
    const int tid = threadIdx.x, wid = __builtin_amdgcn_readfirstlane(tid >> 6), lane = tid & 63, wr = wid >> 2, wc = wid & 3, fr = lane & 15, fq = lane >> 4;
    const int K = sch.K, nt = K / BK;
    int Rr[2], Cc[2]; unsigned voffA[2], voffB[2];
#pragma unroll
    for (int i = 0; i < 2; ++i) { stage_rc(tid * 16 + i * 8192, Rr[i], Cc[i]); voffA[i] = (unsigned)(Rr[i] * K + Cc[i]) * 2u;
        const int rho = Rr[i] & 31, Rb = (Rr[i] & ~31) + 8 * ((rho & 15) >> 2) + 4 * (rho >> 4) + (rho & 3);
        voffB[i] = (unsigned)(Rb * K + Cc[i]) * 2u; }
    const size_t kstep = (size_t)(BK * 2);
    const size_t hstep = (size_t)128 * K * 2;
    const unsigned ldsw = (unsigned)wid * 1024u;
    const int aoff = lds_byte(wr * 64 + fr, fq * 8), boff = lds_byte(wc * 32 + fr, fq * 8);
#define PG8_SA(b, h) (((b) * 2 + (h)) * HTB)
#define PG8_SB(b, h) ((4 + (b) * 2 + (h)) * HTB)
#define PG8_STAGE_B(bufoff, gbase) do { _Pragma("unroll") for (int _i = 0; _i < 2; ++_i) \
        __builtin_amdgcn_global_load_lds((const unsigned*)((const char*)(gbase) + voffB[_i]), (LAS unsigned*)(lds + (bufoff) + ldsw + _i * 8192), 16, 0, 0); } while (0)
#define PG8_STAGE_A(bufoff, gbase, h, vo) do { _Pragma("unroll") for (int _i = 0; _i < 2; ++_i) \
        __builtin_amdgcn_global_load_lds((const unsigned*)((const char*)(gbase) + (GATHER ? (size_t)(vo)[h][_i] : (size_t)(h) * hstep + voffA[_i])), (LAS unsigned*)(lds + (bufoff) + ldsw + _i * 8192), 16, 0, 0); } while (0)
#define PG8_LDA(dst, b, h) do { _Pragma("unroll") for (int m = 0; m < 4; ++m) _Pragma("unroll") for (int k = 0; k < 2; ++k) dst[m][k] = *(const LAS bf16x8*)(lds + PG8_SA(b, h) + aoff + m * 2048 + k * 1024); } while (0)
#define PG8_LDB(dst, b, h) do { _Pragma("unroll") for (int n = 0; n < 2; ++n) _Pragma("unroll") for (int k = 0; k < 2; ++k) dst[n][k] = *(const LAS bf16x8*)(lds + PG8_SB(b, h) + boff + n * 2048 + k * 1024); } while (0)
#define PG8_MMA(ai, bj, At, Bt) do { __builtin_amdgcn_s_setprio(1); _Pragma("unroll") for (int m = 0; m < 4; ++m) _Pragma("unroll") for (int n = 0; n < 2; ++n) _Pragma("unroll") for (int k = 0; k < 2; ++k) \
        acc[ai][bj][m][n] = __builtin_amdgcn_mfma_f32_16x16x32_bf16(Bt[n][k], At[m][k], acc[ai][bj][m][n], 0, 0, 0); __builtin_amdgcn_s_setprio(0); } while (0)
#define PG8_WAIT_V(n) asm volatile("s_waitcnt vmcnt(" #n ")" ::: "memory")
#define PG8_WAIT_L(n) asm volatile("s_waitcnt lgkmcnt(" #n ")" ::: "memory")
#define PG8_BAR __builtin_amdgcn_s_barrier()
#define PG8_SCHED __builtin_amdgcn_sched_barrier(0)
    Unit cur, nxt; int ui = 0;
    if (!sch.next(0, cur)) return;
    f32x4 acc[2][2][4][2];
#pragma unroll
    for (int a = 0; a < 2; ++a)
#pragma unroll
        for (int b = 0; b < 2; ++b)
#pragma unroll
            for (int m = 0; m < 4; ++m)
#pragma unroll
                for (int n = 0; n < 2; ++n) acc[a][b][m][n] = (f32x4){0.f, 0.f, 0.f, 0.f};
    bf16x8 At[4][2], B0[2][2], B1[2][2];
    unsigned voAc[2][2], voAn[2][2];
#pragma unroll
    for (int h = 0; h < 2; ++h)
#pragma unroll
        for (int i = 0; i < 2; ++i) { voAc[h][i] = GATHER ? sch.aoff(cur, 128 * h + Rr[i]) + (unsigned)Cc[i] * 2u : 0u; voAn[h][i] = voAc[h][i]; }
    const char* cA = sch.abase(cur); const char* cB = sch.bbase(cur);
    sch.a_ready(cur);
    PG8_STAGE_B(PG8_SB(0, 0), cB); PG8_STAGE_A(PG8_SA(0, 0), cA, 0, voAc); PG8_STAGE_B(PG8_SB(0, 1), cB + hstep); PG8_STAGE_A(PG8_SA(0, 1), cA, 1, voAc);
    if (wr == 1) PG8_BAR;
    PG8_WAIT_V(4); PG8_BAR;
    PG8_STAGE_B(PG8_SB(1, 0), cB + kstep); PG8_STAGE_A(PG8_SA(1, 0), cA + kstep, 0, voAc); PG8_STAGE_B(PG8_SB(1, 1), cB + hstep + kstep);
    PG8_WAIT_V(6); PG8_BAR;
    for (;;) {
        const bool has_next = sch.next(ui + 1, nxt);
        const char* nA = has_next ? sch.abase(nxt) : cA; const char* nB = has_next ? sch.bbase(nxt) : cB;
        if (GATHER) {
#pragma unroll
            for (int h = 0; h < 2; ++h)
#pragma unroll
                for (int i = 0; i < 2; ++i) voAn[h][i] = has_next ? sch.aoff(nxt, 128 * h + Rr[i]) + (unsigned)Cc[i] * 2u : voAc[h][i];
        }
#pragma unroll 1
        for (int t = 0; t < nt; t += 2) {
            const bool last = (t == nt - 2);
            const char* a1 = cA + (size_t)(t + 1) * kstep;
            const char* a2 = last ? nA : cA + (size_t)(t + 2) * kstep; const char* b2 = last ? nB : cB + (size_t)(t + 2) * kstep;
            const char* a3 = a2 + kstep; const char* b3 = b2 + kstep;
            if (last && has_next) sch.a_ready(nxt);
            unsigned vo2[2][2];
#pragma unroll
            for (int h = 0; h < 2; ++h)
#pragma unroll
                for (int i = 0; i < 2; ++i) vo2[h][i] = last ? voAn[h][i] : voAc[h][i];
            PG8_LDB(B0, 0, 0); PG8_SCHED; PG8_LDA(At, 0, 0); PG8_STAGE_A(PG8_SA(1, 1), a1, 1, voAc);
            PG8_WAIT_L(8); PG8_BAR; PG8_WAIT_L(0); PG8_MMA(0, 0, At, B0); PG8_BAR; PG8_SCHED;
            PG8_LDB(B1, 0, 1); PG8_STAGE_B(PG8_SB(0, 0), b2);
            PG8_BAR; PG8_WAIT_L(0); PG8_MMA(0, 1, At, B1); PG8_BAR;
            PG8_LDA(At, 0, 1); PG8_STAGE_A(PG8_SA(0, 0), a2, 0, vo2);
            PG8_BAR; PG8_WAIT_L(0); PG8_MMA(1, 0, At, B0); PG8_BAR; PG8_SCHED;
            PG8_STAGE_B(PG8_SB(0, 1), b2 + hstep);
            PG8_WAIT_V(6); PG8_BAR; PG8_MMA(1, 1, At, B1); PG8_BAR;
            PG8_LDB(B0, 1, 0); PG8_SCHED; PG8_LDA(At, 1, 0); PG8_STAGE_A(PG8_SA(0, 1), a2, 1, vo2);
            PG8_WAIT_L(8); PG8_BAR; PG8_WAIT_L(0); PG8_MMA(0, 0, At, B0); PG8_BAR; PG8_SCHED;
            PG8_LDB(B1, 1, 1); PG8_STAGE_B(PG8_SB(1, 0), b3);
            PG8_BAR; PG8_WAIT_L(0); PG8_MMA(0, 1, At, B1); PG8_BAR;
            PG8_LDA(At, 1, 1); PG8_STAGE_A(PG8_SA(1, 0), a3, 0, vo2);
            PG8_BAR; PG8_WAIT_L(0); PG8_MMA(1, 0, At, B0); PG8_BAR; PG8_SCHED;
            PG8_STAGE_B(PG8_SB(1, 1), b3 + hstep);
            PG8_WAIT_V(6); PG8_BAR; PG8_MMA(1, 1, At, B1); PG8_BAR;
        }
        { int frx = fr, fqx = fq; asm volatile("" : "+v"(frx), "+v"(fqx));
            const int jx = wc * 32 + 8 * fqx, rx = wr * 64 + frx;
            const typename E::Col ecol = epi.col(cur, jx);
            constexpr int PF = E::PF;
            typename E::Pre epre[8];
#pragma unroll
            for (int g = 0; g < PF; ++g) epre[g] = epi.load(cur, (g >> 2) * 128 + (g & 3) * 16 + rx, jx);
#pragma unroll
            for (int g = 0; g < 8; ++g) { const int ai = g >> 2, m = g & 3;
                if (g + PF < 8) epre[g + PF] = epi.load(cur, ((g + PF) >> 2) * 128 + ((g + PF) & 3) * 16 + rx, jx);
                epi.apply(cur, ai * 128 + m * 16 + rx, jx, ecol, epre[g], acc[ai][0][m][0], acc[ai][0][m][1], acc[ai][1][m][0], acc[ai][1][m][1]); } }
        sch.done(cur);
        if (!has_next) break;
#pragma unroll
        for (int a = 0; a < 2; ++a)
#pragma unroll
            for (int b = 0; b < 2; ++b)
#pragma unroll
                for (int m = 0; m < 4; ++m)
#pragma unroll
                    for (int n = 0; n < 2; ++n) acc[a][b][m][n] = (f32x4){0.f, 0.f, 0.f, 0.f};
        cur = nxt; cA = nA; cB = nB; ++ui;
#pragma unroll
        for (int h = 0; h < 2; ++h)
#pragma unroll
            for (int i = 0; i < 2; ++i) voAc[h][i] = voAn[h][i];
    }
    PG8_WAIT_V(0);
    if (wr == 0) PG8_BAR;
    PG8_BAR;
#undef PG8_SA
#undef PG8_SB
#undef PG8_STAGE_A
#undef PG8_STAGE_B
#undef PG8_LDA
#undef PG8_LDB
#undef PG8_MMA
#undef PG8_WAIT_V
#undef PG8_WAIT_L
#undef PG8_BAR
#undef PG8_SCHED
}

struct NoHooks {
    __device__ __forceinline__ void a_ready(const Unit&) const {}
    __device__ __forceinline__ void done(const Unit&) const {}
};
struct SchG1 { const bf16_t *A, *Bt; int G, c, K;
    __device__ __forceinline__ void a_ready(const Unit&) const {}
    __device__ __forceinline__ void done(const Unit&) const {}
    __device__ __forceinline__ bool next(int i, Unit& u) const { const int L = i * G + c; if (L >= 128 * 24) return false; u.pm = L / 24; u.pn = L % 24; return true; }
    __device__ __forceinline__ const bf16_t* arow(const Unit& u, int r) const { return A + (size_t)(u.pm * 256 + r) * 1024; }
    __device__ __forceinline__ const bf16_t* brow(const Unit& u, int n) const { return Bt + (size_t)(u.pn * 256 + n) * 1024; }
    __device__ __forceinline__ const char* abase(const Unit& u) const { return (const char*)(A + (size_t)u.pm * 256 * 1024); }
    __device__ __forceinline__ const char* bbase(const Unit& u) const { return (const char*)(Bt + (size_t)u.pn * 256 * 1024); }
    __device__ __forceinline__ unsigned aoff(const Unit&, int) const { return 0u; } };
struct EpiG1 { bf16_t *Z, *GYG, *XR, *SGA, *SGB; const float* bias;
    static constexpr int PF = 1; struct Col { f32x4 c0, c1, c2, c3; }; struct Pre { };
    __device__ __forceinline__ Col col(const Unit& u, int j) const { const float* bp = bias + u.pn * 256 + j; return Col{*(const f32x4*)bp, *(const f32x4*)(bp + 4), *(const f32x4*)(bp + 128), *(const f32x4*)(bp + 132)}; }
    __device__ __forceinline__ Pre load(const Unit&, int, int) const { return Pre{}; }
    __device__ __forceinline__ void apply(const Unit& u, int r, int j, const Col& c, const Pre&, f32x4 a0, f32x4 a1, f32x4 b0, f32x4 b1) const {
        const size_t row = (size_t)u.pm * 256 + r;
        a0 += c.c0; a1 += c.c1; b0 += c.c2; b1 += c.c3;
        if (u.pn < 8) {
#pragma unroll
            for (int e = 0; e < 4; ++e) { a0[e] *= sigm2(b0[e]); a1[e] *= sigm2(b1[e]); }
            *(u32x4*)(Z + row * 1024 + u.pn * 128 + j) = pk8(a0, a1); }
        else { const int kind = u.pn >> 2;
            bf16_t* dst = GYG + (size_t)(kind - 2) * (SLOT / 2);
#pragma unroll
            for (int e = 0; e < 4; ++e) { if (kind == 2) { a0[e] = gelu_tanh(a0[e]); a1[e] = gelu_tanh(a1[e]); b0[e] = gelu_tanh(b0[e]); b1[e] = gelu_tanh(b1[e]); }
                else if (kind >= 4) { a0[e] = sigm2(a0[e]); a1[e] = sigm2(a1[e]); b0[e] = sigm2(b0[e]); b1[e] = sigm2(b1[e]); } }
            bf16_t* o = dst + row * 1024 + (u.pn & 3) * 256 + j;
            *(u32x4*)o = pk8(a0, a1); *(u32x4*)(o + 128) = pk8(b0, b1); }
    } };
struct SchCtx { const bf16_t *A, *Bt; int G, c, K;
    __device__ __forceinline__ void a_ready(const Unit&) const {}
    __device__ __forceinline__ void done(const Unit&) const {}
    __device__ __forceinline__ bool next(int i, Unit& u) const { const int L = i * G + c; if (L >= 16) return false; u.pm = L / 4; u.pn = L % 4; return true; }
    __device__ __forceinline__ const bf16_t* arow(const Unit& u, int r) const { return A + (size_t)(u.pm * 256 + r) * 1024; }
    __device__ __forceinline__ const bf16_t* brow(const Unit& u, int n) const { return Bt + (size_t)((12 + u.pn) * 256 + n) * 1024; }
    __device__ __forceinline__ const char* abase(const Unit& u) const { return (const char*)(A + (size_t)u.pm * 256 * 1024); }
    __device__ __forceinline__ const char* bbase(const Unit& u) const { return (const char*)(Bt + (size_t)(12 + u.pn) * 256 * 1024); }
    __device__ __forceinline__ unsigned aoff(const Unit&, int) const { return 0u; } };
struct EpiCtx { bf16_t* XRC; const float* bias;
    static constexpr int PF = 1; struct Col { f32x4 c0, c1, c2, c3; }; struct Pre { };
    __device__ __forceinline__ Col col(const Unit& u, int j) const { const float* bp = bias + (12 + u.pn) * 256 + j; return Col{*(const f32x4*)bp, *(const f32x4*)(bp + 4), *(const f32x4*)(bp + 128), *(const f32x4*)(bp + 132)}; }
    __device__ __forceinline__ Pre load(const Unit&, int, int) const { return Pre{}; }
    __device__ __forceinline__ void apply(const Unit& u, int r, int j, const Col& c, const Pre&, f32x4 a0, f32x4 a1, f32x4 b0, f32x4 b1) const {
        const size_t row = (size_t)u.pm * 256 + r;
        a0 += c.c0; a1 += c.c1; b0 += c.c2; b1 += c.c3;
        bf16_t* o = XRC + row * 1024 + u.pn * 256 + j; *(u32x4*)o = pk8(a0, a1); *(u32x4*)(o + 128) = pk8(b0, b1); } };
struct SchG2 { const bf16_t *Aa, *Ab, *Wa, *Wb; int G, c, K;
    __device__ __forceinline__ void a_ready(const Unit&) const {}
    __device__ __forceinline__ void done(const Unit&) const {}
    __device__ __forceinline__ bool next(int i, Unit& u) const { const int t = (i >> 1) * G + c; if (t >= 512) return false; u.pm = t >> 2; u.pn = t & 3; u.aux = i & 1; return true; }
    __device__ __forceinline__ const bf16_t* arow(const Unit& u, int r) const { return Aa + (size_t)u.aux * (SLOT / 2) + (size_t)(u.pm * 256 + r) * 1024; }
    __device__ __forceinline__ const bf16_t* brow(const Unit& u, int n) const { return Wa + (size_t)u.aux * (1024 * 1024) + (size_t)(u.pn * 256 + n) * 1024; }
    __device__ __forceinline__ const char* abase(const Unit& u) const { return (const char*)(Aa + (size_t)u.aux * (SLOT / 2) + (size_t)u.pm * 256 * 1024); }
    __device__ __forceinline__ const char* bbase(const Unit& u) const { return (const char*)(Wa + (size_t)u.aux * (1024 * 1024) + (size_t)u.pn * 256 * 1024); }
    __device__ __forceinline__ unsigned aoff(const Unit&, int) const { return 0u; } };
struct EpiG2 { const bf16_t *SGA, *SGB; bf16_t* M;
    static constexpr int PF = 2; struct Col { }; struct Pre { u32x4 g0, g1, t0, t1; };
    __device__ __forceinline__ Col col(const Unit&, int) const { return Col{}; }
    __device__ __forceinline__ Pre load(const Unit& u, int r, int j) const {
        const size_t o = ((size_t)u.pm * 256 + r) * 1024 + u.pn * 256 + j; const bf16_t* G = SGA + (size_t)u.aux * (SLOT / 2);
        Pre q; q.g0 = *(const u32x4*)(G + o); q.g1 = *(const u32x4*)(G + o + 128);
        if (u.aux) { q.t0 = *(const u32x4*)(M + o); q.t1 = *(const u32x4*)(M + o + 128); } else { q.t0 = (u32x4){0u, 0u, 0u, 0u}; q.t1 = q.t0; }
        return q; }
    __device__ __forceinline__ void apply(const Unit& u, int r, int j, const Col&, const Pre& q, f32x4 a0, f32x4 a1, f32x4 b0, f32x4 b1) const {
        const size_t o = ((size_t)u.pm * 256 + r) * 1024 + u.pn * 256 + j;
        f32x4 g0, g1, g2, g3, t0, t1, t2, t3; unpk8(q.g0, g0, g1); unpk8(q.g1, g2, g3); unpk8(q.t0, t0, t1); unpk8(q.t1, t2, t3);
        a0 = a0 * g0 + t0; a1 = a1 * g1 + t1; b0 = b0 * g2 + t2; b1 = b1 * g3 + t3;
        *(u32x4*)(M + o) = pk8(a0, a1); *(u32x4*)(M + o + 128) = pk8(b0, b1); } };
struct SchG3 { const bf16_t *A, *Bt; int G, c, K;
    __device__ __forceinline__ void a_ready(const Unit&) const {}
    __device__ __forceinline__ void done(const Unit&) const {}
    __device__ __forceinline__ bool next(int i, Unit& u) const { const int L = i * G + c; if (L >= 512) return false; u.pm = L >> 2; u.pn = L & 3; return true; }
    __device__ __forceinline__ const bf16_t* arow(const Unit& u, int r) const { return A + (size_t)(u.pm * 256 + r) * 1024; }
    __device__ __forceinline__ const bf16_t* brow(const Unit& u, int n) const { return Bt + (size_t)(u.pn * 256 + n) * 1024; }
    __device__ __forceinline__ const char* abase(const Unit& u) const { return (const char*)(A + (size_t)u.pm * 256 * 1024); }
    __device__ __forceinline__ const char* bbase(const Unit& u) const { return (const char*)(Bt + (size_t)u.pn * 256 * 1024); }
    __device__ __forceinline__ unsigned aoff(const Unit&, int) const { return 0u; } };
struct EpiG3 { const float *X, *MOD; bf16_t* X1B;
    static constexpr int PF = 3; struct Col { f32x4 c0, c1, c2, c3; }; struct Pre { f32x4 x0, x1, x2, x3; };
    __device__ __forceinline__ Col col(const Unit& u, int j) const { const float* gt = MOD + ((u.pm * 256) / SEQ) * 6144 + 2 * 1024 + u.pn * 256 + j; return Col{*(const f32x4*)gt, *(const f32x4*)(gt + 4), *(const f32x4*)(gt + 128), *(const f32x4*)(gt + 132)}; }
    __device__ __forceinline__ Pre load(const Unit& u, int r, int j) const { const float* xp = X + ((size_t)u.pm * 256 + r) * 1024 + u.pn * 256 + j; return Pre{*(const f32x4*)xp, *(const f32x4*)(xp + 4), *(const f32x4*)(xp + 128), *(const f32x4*)(xp + 132)}; }
    __device__ __forceinline__ void apply(const Unit& u, int r, int j, const Col& c, const Pre& q, f32x4 a0, f32x4 a1, f32x4 b0, f32x4 b1) const {
        bf16_t* op = X1B + ((size_t)u.pm * 256 + r) * 1024 + u.pn * 256 + j;
        *(u32x4*)op = pk8(q.x0 + c.c0 * a0, q.x1 + c.c1 * a1); *(u32x4*)(op + 128) = pk8(q.x2 + c.c2 * b0, q.x3 + c.c3 * b1); } };
struct MoeMeta { const int* m;
    __device__ __forceinline__ int cnt(int e) const { return __builtin_amdgcn_readfirstlane(m[e]); }
    __device__ __forceinline__ int tb(int e) const { return __builtin_amdgcn_readfirstlane(m[16 + e]); }
    __device__ __forceinline__ int ntiles() const { return __builtin_amdgcn_readfirstlane(m[32]); }
    __device__ __forceinline__ int find(int mt) const { int e = 0;
#pragma unroll
        for (int k = 1; k < 16; ++k) e += (__builtin_amdgcn_readfirstlane(m[16 + k]) <= mt) ? 1 : 0;
        return e; } };
__device__ __forceinline__ void moe_meta_build(const Params& p, int* meta) {
    if (threadIdx.x == 0) { const unsigned* cnt = (const unsigned*)(p.ws + OFF_CTL); int t = 0;
        for (int e = 0; e < 16; ++e) { const int c = (int)__hip_atomic_load(cnt + e, __ATOMIC_RELAXED, __HIP_MEMORY_SCOPE_AGENT); meta[e] = c; meta[16 + e] = t; t += (c + 255) >> 8; }
        meta[32] = t; }
    __syncthreads();
}
struct SchUp { const bf16_t *HM, *W; const int* LIST; MoeMeta mm; int G, c, K; const int* idx; unsigned* cntM;
    __device__ __forceinline__ bool next(int i, Unit& u) const { const int L = i * G + c; if (L >= 4 * mm.ntiles()) return false; const int mt = L >> 2; u.pn = L & 3; u.aux = mm.find(mt); u.aux2 = (mt - mm.tb(u.aux)) * 256; u.pm = mt | (i << 16); return true; }
    __device__ __forceinline__ void a_ready(const Unit&) const {}
    __device__ __forceinline__ void done(const Unit& u) const { asm volatile("s_waitcnt vmcnt(0)" ::: "memory");
        if ((threadIdx.x & 63) == 0) __hip_atomic_fetch_add(cntM + (u.pm & 0xffff), 1u, __ATOMIC_RELAXED, __HIP_MEMORY_SCOPE_AGENT); }
    __device__ __forceinline__ const char* abase(const Unit&) const { return (const char*)HM; }
    __device__ __forceinline__ const char* bbase(const Unit& u) const { return (const char*)(W + ((size_t)u.aux * 1024 + u.pn * 256) * 1024); }
    __device__ __forceinline__ unsigned aoff(const Unit& u, int r) const { return (unsigned)idx[(u.pm >> 16) * 256 + r] * 2048u; }
    __device__ __forceinline__ const bf16_t* arow(const Unit& u, int r) const { int pos = u.aux2 + r; const int c = mm.cnt(u.aux); pos = pos < c ? pos : c - 1; return HM + (size_t)LIST[u.aux * NT + pos] * 1024; }
    __device__ __forceinline__ const bf16_t* brow(const Unit& u, int n) const { return W + ((size_t)u.aux * 1024 + u.pn * 256 + n) * 1024; } };
struct EpiUp { bf16_t* ACT; const float* WL; MoeMeta mm;
    static constexpr int PF = 2; struct Col { }; struct Pre { float wt; };
    __device__ __forceinline__ Col col(const Unit&, int) const { return Col{}; }
    __device__ __forceinline__ Pre load(const Unit& u, int r, int) const { const int pos = u.aux2 + r; return Pre{pos < mm.cnt(u.aux) ? WL[u.aux * NT + pos] : 0.f}; }
    __device__ __forceinline__ void apply(const Unit& u, int r, int j, const Col&, const Pre& q, f32x4 g0, f32x4 g1, f32x4 u0, f32x4 u1) const {
        if (u.aux2 + r >= mm.cnt(u.aux)) return;
#pragma unroll
        for (int e = 0; e < 4; ++e) { g0[e] = silu(g0[e]) * u0[e] * q.wt; g1[e] = silu(g1[e]) * u1[e] * q.wt; }
        const u32x4 w = pk8(g0, g1); unsigned long long* op = (unsigned long long*)(ACT + ((size_t)(u.pm & 0xffff) * 256 + r) * 512 + u.pn * 128 + j);
        __hip_atomic_store(op, ((unsigned long long)w.y << 32) | w.x, __ATOMIC_RELAXED, __HIP_MEMORY_SCOPE_AGENT);
        __hip_atomic_store(op + 1, ((unsigned long long)w.w << 32) | w.z, __ATOMIC_RELAXED, __HIP_MEMORY_SCOPE_AGENT); } };
struct SchDn { const bf16_t *ACT, *W; MoeMeta mm; int G, c, K; unsigned* cntM; bool waitc;
    __device__ __forceinline__ bool next(int i, Unit& u) const {
        const int D = 4 * mm.ntiles(), umin = D / G, n5 = D - umin * G;
        int xh = (D - 2 * (G - n5)) / G; xh = xh < 0 ? 0 : xh; if (n5 == 0) xh = 0;
        int L;
        if (c < n5) { if (i >= xh) return false; L = c * xh + i; } else { L = n5 * xh + (c - n5) + (G - n5) * i; }
        if (L >= D) return false;
        const int mt = L >> 2; u.pn = L & 3; u.aux = mm.find(mt); u.aux2 = (mt - mm.tb(u.aux)) * 256; u.pm = mt; return true; }
    __device__ __forceinline__ void a_ready(const Unit& u) const {
        if (!waitc) return;
        if (threadIdx.x < 64) { unsigned sp = 0;
            while (__hip_atomic_load(cntM + u.pm, __ATOMIC_RELAXED, __HIP_MEMORY_SCOPE_AGENT) < 32u) { __builtin_amdgcn_s_sleep(2); if (++sp > (1u << 22)) break; }
            __builtin_amdgcn_fence(__ATOMIC_ACQUIRE, "agent");
            asm volatile("s_waitcnt vmcnt(0)" ::: "memory"); }
        asm volatile("" ::: "memory"); __builtin_amdgcn_s_barrier(); asm volatile("" ::: "memory"); }
    __device__ __forceinline__ void done(const Unit&) const {}
    __device__ __forceinline__ const char* abase(const Unit& u) const { return (const char*)(ACT + (size_t)u.pm * 256 * 512); }
    __device__ __forceinline__ const char* bbase(const Unit& u) const { return (const char*)(W + ((size_t)u.aux * 1024 + u.pn * 256) * 512); }
    __device__ __forceinline__ unsigned aoff(const Unit&, int) const { return 0u; } };
struct EpiDn { bf16_t* Y; MoeMeta mm;
    static constexpr int PF = 1; struct Col { }; struct Pre { };
    __device__ __forceinline__ Col col(const Unit&, int) const { return Col{}; }
    __device__ __forceinline__ Pre load(const Unit&, int, int) const { return Pre{}; }
    __device__ __forceinline__ void apply(const Unit& u, int r, int j, const Col&, const Pre&, f32x4 a0, f32x4 a1, f32x4 b0, f32x4 b1) const {
        if (u.aux2 + r >= mm.cnt(u.aux)) return;
        bf16_t* o = Y + ((size_t)u.pm * 256 + r) * 1024 + u.pn * 256 + j; *(u32x4*)o = pk8(a0, a1); *(u32x4*)(o + 128) = pk8(b0, b1); } };

__device__ __forceinline__ void aprep_item(const Params& p, int g, unsigned char* lds, bool have_tile, int g_next) {
    const int tid = threadIdx.x, lane = tid & 63, wave = tid >> 6;
    const bf16_t* Z = (const bf16_t*)(p.ws + OFF_SLOT + 1 * SLOT);
    bf16_t* AA = (bf16_t*)(p.ws + OFF_SLOT + 0 * SLOT) + (size_t)g * 64 * 1024;
    const unsigned* zt = (const unsigned*)lds;
    if (!have_tile) { const u32x4* src = (const u32x4*)(Z + (size_t)g * 64 * 1024); u32x4* d = (u32x4*)lds;
        u32x4 tmp[16];
#pragma unroll
        for (int i = 0; i < 16; ++i) tmp[i] = src[tid + i * NTHR];
#pragma unroll
        for (int i = 0; i < 16; ++i) d[tid + i * NTHR] = tmp[i]; }
    __syncthreads();
    {
        f32x2 w[31];
        const float* cw = p.in[I_CONVW] + 2 * tid;
#pragma unroll
        for (int k = 0; k < 31; ++k) w[k] = *(const f32x2*)(cw + k * 1024);
        const f32x2 cb = *(const f32x2*)(p.in[I_CONVB] + 2 * tid);
#pragma unroll 1
        for (int tb = 0; tb < 4; ++tb) {
            f32x2 cz[16];
#pragma unroll
            for (int o = 0; o < 16; ++o) cz[o] = cb;
#pragma unroll
            for (int r0 = 0; r0 < 48; r0 += 8) {
                unsigned vv[8];
#pragma unroll
                for (int rr = 0; rr < 8; ++rr) if (r0 + rr < 46) { const int row = 16 * tb - 15 + r0 + rr; const bool ok = (unsigned)row < 64u; const unsigned t = zt[(ok ? row : 0) * 512 + tid]; vv[rr] = ok ? t : 0u; }
#pragma unroll
                for (int rr = 0; rr < 8; ++rr) { const int r = r0 + rr;
                    if (r < 46) { const f32x2 x = (f32x2){bflo(vv[rr]), bfhi(vv[rr])};
#pragma unroll
                        for (int o = 0; o < 16; ++o) { const int k = r - o; if (k >= 0 && k < 31) cz[o] += w[k] * x; } } }
            }
#pragma unroll
            for (int o = 0; o < 16; ++o) *(unsigned*)(AA + (size_t)(16 * tb + o) * 1024 + 2 * tid) = pk2(cz[o].x, cz[o].y);
        }
    }
    asm volatile("s_waitcnt vmcnt(0)" ::: "memory");
    __syncthreads();
    u32x4 ntile[16];
    if (g_next >= 0) { const u32x4* src = (const u32x4*)(Z + (size_t)g_next * 64 * 1024);
#pragma unroll
        for (int i = 0; i < 16; ++i) ntile[i] = src[tid + i * NTHR]; }
    f32x4 lg0[2], lg1[2], lb0[2], lb1[2];
#pragma unroll
    for (int hh = 0; hh < 2; ++hh) { const int c0 = hh * 512 + lane * 8;
        lg0[hh] = *(const f32x4*)(p.in[I_LNG] + c0); lg1[hh] = *(const f32x4*)(p.in[I_LNG] + c0 + 4); lb0[hh] = *(const f32x4*)(p.in[I_LNB] + c0); lb1[hh] = *(const f32x4*)(p.in[I_LNB] + c0 + 4); }
#pragma unroll 1
    for (int half = 0; half < 2; ++half) {
        u32x4 ra[4], rb[4];
#pragma unroll
        for (int rr = 0; rr < 4; ++rr) { const bf16_t* rp = AA + (size_t)(wave * 8 + half * 4 + rr) * 1024 + lane * 8; ra[rr] = *(const u32x4*)rp; rb[rr] = *(const u32x4*)(rp + 512); }
#pragma unroll
        for (int rr = 0; rr < 4; ++rr) {
            const int row = wave * 8 + half * 4 + rr;
            f32x4 x0, x1, x2, x3; unpk8(ra[rr], x0, x1); unpk8(rb[rr], x2, x3);
            const f32x4 sv = (x0 + x1) + (x2 + x3);
            const float mean = wave_sum_dpp((sv[0] + sv[1]) + (sv[2] + sv[3])) * (1.0f / 1024.0f);
            x0 -= mean; x1 -= mean; x2 -= mean; x3 -= mean;
            const f32x4 qv = (x0 * x0 + x1 * x1) + (x2 * x2 + x3 * x3);
            const float rstd = rsqrtf(wave_sum_dpp((qv[0] + qv[1]) + (qv[2] + qv[3])) * (1.0f / 1024.0f) + 1e-6f);
            x0 = x0 * rstd * lg0[0] + lb0[0]; x1 = x1 * rstd * lg1[0] + lb1[0]; x2 = x2 * rstd * lg0[1] + lb0[1]; x3 = x3 * rstd * lg1[1] + lb1[1];
#pragma unroll
            for (int e = 0; e < 4; ++e) { x0[e] = silu(x0[e]); x1[e] = silu(x1[e]); x2[e] = silu(x2[e]); x3[e] = silu(x3[e]); }
            bf16_t* o = AA + (size_t)row * 1024 + lane * 8;
            *(u32x4*)o = pk8(x0, x1); *(u32x4*)(o + 512) = pk8(x2, x3);
        }
    }
    if (g_next >= 0) { u32x4* d = (u32x4*)lds;
#pragma unroll
        for (int i = 0; i < 16; ++i) d[tid + i * NTHR] = ntile[i]; }
    __syncthreads();
}

constexpr int XC_STRIDE = 272;
constexpr int YB_STRIDE = 132;
constexpr int B_XC_OFF = 0, B_HIN_OFF = 256 * XC_STRIDE  , B_Y_OFF = B_HIN_OFF + 4096  , B_Y_BYTES = 64 * YB_STRIDE * 4  ;
constexpr size_t OFF_TOT256 = OFF_TOT + 9 * MiB;

__device__ __forceinline__ void lru_coef(float lr2, float li2, float nsp2, float xcv, float& a, float& b) {
    const float r = __builtin_amdgcn_rcpf(1.0f + __builtin_amdgcn_exp2f(lr2));
    a = __builtin_amdgcn_exp2f(nsp2 * r);
    const float v = __builtin_fmaf(-a, a, 1.0f);
    const float d = 1.0f + __builtin_amdgcn_exp2f(li2);
    b = (v * __builtin_amdgcn_rsqf(fmaxf(v * d * d, 1e-30f))) * xcv;
}

template <bool FINAL, int DIR>
__device__ __forceinline__ void lru_dir(const unsigned char* xcs, const bf16x8 (&fbr)[4], const bf16x8 (&fbi)[4], float br, float bi, float nsp, int fr, int q, int chl,
                                        float hin_v, f32x4 (&hout)[4], float& totA, float& totB) {
    f32x4 ar[4], ai[4];
#pragma unroll
    for (int m = 0; m < 4; ++m) { ar[m] = (f32x4){br, br, br, br}; ai[m] = (f32x4){bi, bi, bi, bi}; }
#pragma unroll
    for (int kk = 0; kk < 4; ++kk) {
#pragma unroll
        for (int m = 0; m < 4; ++m) { const bf16x8 fa = *(const bf16x8*)(xcs + (16 * m + fr) * XC_STRIDE + (32 * kk + 8 * q) * 2);
            ar[m] = __builtin_amdgcn_mfma_f32_16x16x32_bf16(fa, fbr[kk], ar[m], 0, 0, 0);
            ai[m] = __builtin_amdgcn_mfma_f32_16x16x32_bf16(fa, fbi[kk], ai[m], 0, 0, 0); }
    }
#pragma unroll
    for (int m = 0; m < 4; ++m)
#pragma unroll
        for (int i = 0; i < 4; ++i) {
            const float xcv = bf2f(*(const bf16_t*)(xcs + (16 * m + 4 * q + i) * XC_STRIDE + chl * 2));
            float a, b; lru_coef(ar[m][i], ai[m][i], nsp, xcv, a, b); ar[m][i] = a; ai[m][i] = b;
        }
    float At[4], Bt[4], Ae[4], Be[4];
#pragma unroll
    for (int m = 0; m < 4; ++m) {
        float A = 1.f, B = 0.f;
#pragma unroll
        for (int ii = 0; ii < 4; ++ii) { const int i = DIR ? 3 - ii : ii; B = ar[m][i] * B + ai[m][i]; A = ar[m][i] * A; }
        if (DIR == 0) {
            float tA = __shfl_up(A, 16), tB = __shfl_up(B, 16); if (q >= 1) { B = A * tB + B; A = A * tA; }
            tA = __shfl_up(A, 32); tB = __shfl_up(B, 32); if (q >= 2) { B = A * tB + B; A = A * tA; }
            Ae[m] = __shfl_up(A, 16); Be[m] = __shfl_up(B, 16); if (q == 0) { Ae[m] = 1.f; Be[m] = 0.f; }
            At[m] = __shfl(A, 48 + fr); Bt[m] = __shfl(B, 48 + fr);
        } else {
            float tA = __shfl_down(A, 16), tB = __shfl_down(B, 16); if (q <= 2) { B = A * tB + B; A = A * tA; }
            tA = __shfl_down(A, 32); tB = __shfl_down(B, 32); if (q <= 1) { B = A * tB + B; A = A * tA; }
            Ae[m] = __shfl_down(A, 16); Be[m] = __shfl_down(B, 16); if (q == 3) { Ae[m] = 1.f; Be[m] = 0.f; }
            At[m] = __shfl(A, fr); Bt[m] = __shfl(B, fr);
        }
    }
    if (!FINAL) {
        float A = 1.f, B = 0.f;
#pragma unroll
        for (int mm = 0; mm < 4; ++mm) { const int m = DIR ? 3 - mm : mm; B = At[m] * B + Bt[m]; A = At[m] * A; }
        totA = A; totB = B;
    } else {
        float hh = hin_v;
#pragma unroll
        for (int mm = 0; mm < 4; ++mm) { const int m = DIR ? 3 - mm : mm;
            float hs = Ae[m] * hh + Be[m];
#pragma unroll
            for (int ii = 0; ii < 4; ++ii) { const int i = DIR ? 3 - ii : ii; hs = ar[m][i] * hs + ai[m][i]; hout[m][i] = hs; }
            hh = At[m] * hh + Bt[m];
        }
    }
}

template <bool FINAL>
__device__ __forceinline__ void b_phase(const Params& p, int bid, int nb, unsigned char* lds) {
    const int tid = threadIdx.x, lane = tid & 63, wave = tid >> 6, fr = lane & 15, q = lane >> 4;
    f32x2* TOT = (f32x2*)(p.ws + OFF_TOT);
    f32x2* TOT256 = (f32x2*)(p.ws + OFF_TOT256);
    const bf16_t* WG = (const bf16_t*)(p.ws + OFF_WG);
    float* hin = (float*)(lds + B_HIN_OFF);
    const int chl = 16 * wave + fr;
    const int nitems = FINAL ? 1024 : 1024 + 128;
    int hprev = -1;
    bf16x8 fb[4][4];
    float* cst = (float*)(lds + B_Y_OFF + 2 * B_Y_BYTES);
    for (int it = bid; it < nitems; it += nb) {
        const bool isctx = it >= 1024;
        const int b = isctx ? (it - 1024) >> 5 : it >> 8, c256 = isctx ? -1 : (it >> 3) & 31, h = it & 7, csub = (it >> 3) & 3;
        const int seqlen = isctx ? CTXL : SEQ, sbase = isctx ? 0 : c256 * 256;
        const bf16_t* src = isctx ? (const bf16_t*)(p.ws + OFF_XRC) + (size_t)b * CTXL * 1024 : (const bf16_t*)(p.ws + OFF_SLOT + 3 * SLOT) + (size_t)b * SEQ * 1024;
        const int kc0 = isctx ? 0 : 4 + c256 * 4, k256 = isctx ? 0 : 1 + c256;
        const int ch = h * 128 + chl;
        if (h != hprev) {
            hprev = h;
#pragma unroll
            for (int ty = 0; ty < 4; ++ty)
#pragma unroll
                for (int kk = 0; kk < 4; ++kk) fb[ty][kk] = *(const bf16x8*)(WG + (size_t)(h * 512 + wave * 64 + ty * 16 + fr) * 128 + 32 * kk + 8 * q);
            if (q == 0) { const float L2E = 1.4426950408889634f;
                          cst[0 * 128 + chl] = -L2E * p.in[I_BRF][ch]; cst[1 * 128 + chl] = -L2E * p.in[I_BIF][ch]; cst[2 * 128 + chl] = -8.0f * L2E * log1pf(__expf(-p.in[I_LAMF][ch]));
                          cst[3 * 128 + chl] = -L2E * p.in[I_BRB][ch]; cst[4 * 128 + chl] = -L2E * p.in[I_BIB][ch]; cst[5 * 128 + chl] = -8.0f * L2E * log1pf(__expf(-p.in[I_LAMB][ch])); }
            wave_lds_sync();
        }
        float runAf = 1.f, runBf = 0.f, runAb = 1.f, runBb = 0.f;
        {
            const int cgp = tid & 15, c0 = h * 128 + 8 * cgp;
            float wk[4][8], bs[8];
            { const f32x4* bp = (const f32x4*)(p.in[I_LCB] + c0); const f32x4 t0_ = bp[0], t1_ = bp[1];
                bs[0] = t0_[0]; bs[1] = t0_[1]; bs[2] = t0_[2]; bs[3] = t0_[3]; bs[4] = t1_[0]; bs[5] = t1_[1]; bs[6] = t1_[2]; bs[7] = t1_[3];
#pragma unroll
                for (int k = 0; k < 4; ++k) { const f32x4* wp = (const f32x4*)(p.in[I_LCW] + k * 1024 + c0); const f32x4 w0 = wp[0], w1 = wp[1];
                    wk[k][0] = w0[0]; wk[k][1] = w0[1]; wk[k][2] = w0[2]; wk[k][3] = w0[3]; wk[k][4] = w1[0]; wk[k][5] = w1[1]; wk[k][6] = w1[2]; wk[k][7] = w1[3]; } }
#pragma unroll 1
            for (int ps = 0; ps < (isctx ? 1 : 2); ++ps) {
                if (isctx && tid >= 256) break;
                const int tq = isctx ? csub * 64 + (tid >> 4) * 4 : ps * 128 + (tid >> 4) * 4;
                float xc[4][8];
#pragma unroll
                for (int r = 0; r < 4; ++r)
#pragma unroll
                    for (int e = 0; e < 8; ++e) xc[r][e] = bs[e];
#pragma unroll
                for (int rr = 0; rr < 7; ++rr) {
                    const int row = sbase + tq + rr - 2;
                    u32x4 a = (u32x4){0u, 0u, 0u, 0u};
                    if (row >= 0 && row < seqlen) a = *(const u32x4*)(src + (size_t)row * 1024 + c0);
                    const float x[8] = {bflo(a.x), bfhi(a.x), bflo(a.y), bfhi(a.y), bflo(a.z), bfhi(a.z), bflo(a.w), bfhi(a.w)};
#pragma unroll
                    for (int r = 0; r < 4; ++r) { const int k = rr - r;
                        if (k >= 0 && k < 4) {
#pragma unroll
                            for (int e = 0; e < 8; ++e) xc[r][e] += wk[k][e] * x[e]; } }
                }
#pragma unroll
                for (int r = 0; r < 4; ++r) {
                    u32x4 o0; o0.x = pk2(xc[r][0], xc[r][1]); o0.y = pk2(xc[r][2], xc[r][3]); o0.z = pk2(xc[r][4], xc[r][5]); o0.w = pk2(xc[r][6], xc[r][7]);
                    *(u32x4*)(lds + B_XC_OFF + (tq + r) * XC_STRIDE + cgp * 16) = o0;
                }
            }
        }
        f32x2 ct[33], cs[4];
        const int cdir = (tid >> 7) & 1, ccl = tid & 127;
        if (FINAL && tid < 256) {
            const f32x2* T2 = TOT256 + ((size_t)b * 33 * 2 + cdir) * 1024 + h * 128 + ccl;
            const f32x2* T = TOT + ((size_t)b * NCH64 * 2 + cdir) * 1024 + h * 128 + ccl;
#pragma unroll
            for (int k = 1; k < 33; ++k) { const bool use = cdir == 0 ? (k < k256) : (k > k256); ct[k] = use ? T2[(size_t)k * 2048] : (f32x2){1.f, 0.f}; }
            { f32x2 c4[4];
#pragma unroll
                for (int s_ = 0; s_ < 4; ++s_) c4[s_] = T[(size_t)s_ * 2048];
                float A = 1.f, B = 0.f;
#pragma unroll
                for (int s_ = 0; s_ < 4; ++s_) { const f32x2 t = cdir == 0 ? c4[s_] : c4[3 - s_]; B = t.x * B + t.y; A = t.x * A; }
                ct[0] = (f32x2){A, B}; }
#pragma unroll
            for (int s_ = 0; s_ < 4; ++s_) cs[s_] = T[(size_t)(kc0 + s_) * 2048];
        }
        if (FINAL && tid < 256) {
            float hc = 0.f;
            if (cdir == 0) {
#pragma unroll
                for (int k = 0; k < 33; ++k) hc = ct[k].x * hc + ct[k].y;
#pragma unroll
                for (int s_ = 0; s_ < 4; ++s_) { hin[(s_ * 2 + 0) * 128 + ccl] = hc; hc = cs[s_].x * hc + cs[s_].y; }
            } else {
                hc = ct[0].y;
#pragma unroll
                for (int k = 32; k >= 1; --k) hc = ct[k].x * hc + ct[k].y;
#pragma unroll
                for (int s_ = 3; s_ >= 0; --s_) { hin[(s_ * 2 + 1) * 128 + ccl] = hc; hc = cs[s_].x * hc + cs[s_].y; }
            }
        }
        __syncthreads();
        for (int sub = isctx ? csub : 0; sub < (isctx ? csub + 1 : 4); ++sub) {
            const int t0 = sbase + 64 * sub;
            const unsigned char* xcs = lds + B_XC_OFF + 64 * sub * XC_STRIDE;
            f32x4 hf[4], hb[4]; float tA, tB;
            lru_dir<FINAL, 0>(xcs, fb[0], fb[1], cst[0 * 128 + chl], cst[1 * 128 + chl], cst[2 * 128 + chl], fr, q, chl, FINAL ? hin[(sub * 2 + 0) * 128 + chl] : 0.f, hf, tA, tB);
            if (!FINAL) { if (q == 0) TOT[((size_t)(b * NCH64 + kc0 + sub) * 2 + 0) * 1024 + ch] = (f32x2){tA, tB};
                runBf = tA * runBf + tB; runAf = tA * runAf; }
            u32x4 gy0, gy1;
            if (FINAL) { const bf16_t* GYG = (const bf16_t*)(p.ws + OFF_SLOT + 2 * SLOT) + ((size_t)b * SEQ + t0 + lane) * 1024 + h * 128 + 16 * wave;
                gy0 = *(const u32x4*)GYG; gy1 = *(const u32x4*)(GYG + 8); }
            lru_dir<FINAL, 1>(xcs, fb[2], fb[3], cst[3 * 128 + chl], cst[4 * 128 + chl], cst[5 * 128 + chl], fr, q, chl, FINAL ? hin[(sub * 2 + 1) * 128 + chl] : 0.f, hb, tA, tB);
            if (!FINAL) { if (q == 0) TOT[((size_t)(b * NCH64 + kc0 + sub) * 2 + 1) * 1024 + ch] = (f32x2){tA, tB};
                runBb = runAb * tB + runBb; runAb = runAb * tA; }
            if (FINAL) {
                float* wy = (float*)(lds + B_Y_OFF) + wave * (64 * 20);
#pragma unroll
                for (int m = 0; m < 4; ++m)
#pragma unroll
                    for (int i = 0; i < 4; ++i) wy[(16 * m + 4 * q + i) * 20 + fr] = hf[m][i] + hb[m][i];
                wave_lds_sync();
                const f32x4* yp = (const f32x4*)(wy + lane * 20);
                const f32x4 y0 = yp[0], y1 = yp[1], y2 = yp[2], y3 = yp[3];
                u32x4 o0, o1;
                o0.x = pk2(bflo(gy0.x) * y0[0], bfhi(gy0.x) * y0[1]); o0.y = pk2(bflo(gy0.y) * y0[2], bfhi(gy0.y) * y0[3]);
                o0.z = pk2(bflo(gy0.z) * y1[0], bfhi(gy0.z) * y1[1]); o0.w = pk2(bflo(gy0.w) * y1[2], bfhi(gy0.w) * y1[3]);
                o1.x = pk2(bflo(gy1.x) * y2[0], bfhi(gy1.x) * y2[1]); o1.y = pk2(bflo(gy1.y) * y2[2], bfhi(gy1.y) * y2[3]);
                o1.z = pk2(bflo(gy1.z) * y3[0], bfhi(gy1.z) * y3[1]); o1.w = pk2(bflo(gy1.w) * y3[2], bfhi(gy1.w) * y3[3]);
                bf16_t* AB = (bf16_t*)(p.ws + OFF_SLOT + 1 * SLOT) + ((size_t)b * SEQ + t0 + lane) * 1024 + h * 128 + 16 * wave;
                *(u32x4*)AB = o0; *(u32x4*)(AB + 8) = o1;
                wave_lds_sync();
            }
        }
        __syncthreads();
        if (!FINAL && q == 0 && !isctx) {
            TOT256[((size_t)(b * 33 + k256) * 2 + 0) * 1024 + ch] = (f32x2){runAf, runBf};
            TOT256[((size_t)(b * 33 + k256) * 2 + 1) * 1024 + ch] = (f32x2){runAb, runBb};
        }
    }
}

__device__ __forceinline__ void ph8_route(const Params& p, int bid, int nb, unsigned char* lds) {
    constexpr int NU = 1;
    const int tid = threadIdx.x, lane = tid & 63, wave = tid >> 6;
    float* Wl = (float*)lds;
    int* lcnt = (int*)(lds + 81920);
    int* lbase = lcnt + 16;
    int* tinfo = lcnt + 32;
    float* twt = (float*)(tinfo + 512);
#pragma unroll 1
    for (int kk = 0; kk < 2; ++kk) { const int k = tid + kk * NTHR;
        const f32x4 wg = *(const f32x4*)(p.in[I_WGRP] + k * 4);
        Wl[0 * 1024 + k] = wg[0]; Wl[1 * 1024 + k] = wg[1]; Wl[2 * 1024 + k] = wg[2]; Wl[3 * 1024 + k] = wg[3];
#pragma unroll
        for (int o4 = 0; o4 < 4; ++o4) { const f32x4 we = *(const f32x4*)(p.in[I_WER] + k * 16 + o4 * 4);
            Wl[(4 + o4 * 4 + 0) * 1024 + k] = we[0]; Wl[(4 + o4 * 4 + 1) * 1024 + k] = we[1]; Wl[(4 + o4 * 4 + 2) * 1024 + k] = we[2]; Wl[(4 + o4 * 4 + 3) * 1024 + k] = we[3]; } }
    __syncthreads();
    const float* MOD = (const float*)(p.ws + OFF_MOD);
    const bf16_t* X1B = (const bf16_t*)(p.ws + OFF_SLOT + 5 * SLOT);
    bf16_t* HM = (bf16_t*)(p.ws + OFF_SLOT + 2 * SLOT);
    unsigned* gcnt = (unsigned*)(p.ws + OFF_CTL);
    int* LIST = (int*)(p.ws + OFF_LIST); float* WLs = (float*)(p.ws + OFF_WL); int* ROUTE = (int*)(p.ws + OFF_ROUTE);
    float* bl = (float*)(lds + 81920 + 8192);
    if (tid < 20) bl[tid] = tid < 4 ? p.in[I_BGRP][tid] : p.in[I_BER][tid - 4];
    __syncthreads();
    for (int tile = bid; tile < NT / 128; tile += nb) {
        if (tid < 16) lcnt[tid] = 0;
        __syncthreads();
        const float* mrow = MOD + ((tile * 128) / SEQ) * 6144;
        f32x4 gq[4], shq[4], scq[4];
#pragma unroll
        for (int j = 0; j < 4; ++j) { const int c = lane * 4 + 256 * j; gq[j] = *(const f32x4*)(p.in[I_GFFN] + c); shq[j] = *(const f32x4*)(mrow + 3 * 1024 + c); scq[j] = *(const f32x4*)(mrow + 4 * 1024 + c); gq[j] = gq[j] * (1.0f + scq[j]); }
        u32x2 nx[4];
#pragma unroll
        for (int j = 0; j < 4; ++j) nx[j] = *(const u32x2*)(X1B + (size_t)(tile * 128 + wave * 16) * DM + lane * 4 + 256 * j);
#pragma unroll 1
        for (int tt = 0; tt < 16; tt += NU) {
            const int tl = wave * 16 + tt, tok = tile * 128 + tl;
            f32x4 v[NU][4]; float ss[NU];
#pragma unroll
            for (int u = 0; u < NU; ++u) ss[u] = 0.f;
#pragma unroll
            for (int j = 0; j < 4; ++j) { v[0][j] = (f32x4){bflo(nx[j].x), bfhi(nx[j].x), bflo(nx[j].y), bfhi(nx[j].y)}; const f32x4 sq = v[0][j] * v[0][j]; ss[0] += (sq[0] + sq[1]) + (sq[2] + sq[3]); }
            { const int tn = tt + 1 < 16 ? tok + 1 : tok;
#pragma unroll
                for (int j = 0; j < 4; ++j) nx[j] = *(const u32x2*)(X1B + (size_t)tn * DM + lane * 4 + 256 * j); }
            float lg[NU][20];
#pragma unroll
            for (int u = 0; u < NU; ++u) { const float rinv = rsqrtf(wave_sum_dpp(ss[u]) * (1.0f / DM) + 1e-6f);
#pragma unroll
                for (int j = 0; j < 4; ++j) { v[u][j] = v[u][j] * rinv * gq[j] + shq[j]; *(u32x2*)(HM + (size_t)(tok + u) * DM + lane * 4 + 256 * j) = pk4(v[u][j]); }
}
#pragma unroll
            for (int o = 0; o < 20; ++o)
            { f32x4 wv[4];
#pragma unroll
                for (int j = 0; j < 4; ++j) wv[j] = *(const f32x4*)(Wl + o * 1024 + lane * 4 + 256 * j);
#pragma unroll
                for (int u = 0; u < NU; ++u) { f32x4 pr = v[u][0] * wv[0]; pr += v[u][1] * wv[1]; pr += v[u][2] * wv[2]; pr += v[u][3] * wv[3]; lg[u][o] = (pr[0] + pr[1]) + (pr[2] + pr[3]); }
                if ((o & 3) == 3) asm volatile("" ::: "memory"); }
#pragma unroll
            for (int u = 0; u < NU; ++u) {
#pragma unroll
                for (int o = 0; o < 20; ++o) lg[u][o] = wave_sum_dpp(lg[u][o]) + bl[o];
                int gs = 0; float gm = lg[u][0];
#pragma unroll
                for (int o = 1; o < 4; ++o) if (lg[u][o] > gm) { gm = lg[u][o]; gs = o; }
                float den = 0.f;
#pragma unroll
                for (int o = 0; o < 4; ++o) den += __expf(lg[u][o] - gm);
                const float pg = 1.0f / den;
                float el[4];
#pragma unroll
                for (int o = 0; o < 4; ++o) el[o] = gs == 0 ? lg[u][4 + o] : gs == 1 ? lg[u][8 + o] : gs == 2 ? lg[u][12 + o] : lg[u][16 + o];
                int i1 = 0; float v1 = el[0];
#pragma unroll
                for (int o = 1; o < 4; ++o) if (el[o] > v1) { v1 = el[o]; i1 = o; }
                int i2 = -1; float v2 = -3.0e38f;
#pragma unroll
                for (int o = 0; o < 4; ++o) if (o != i1 && el[o] > v2) { v2 = el[o]; i2 = o; }
                const float w1 = 1.0f / (1.0f + __expf(v2 - v1)), w2 = 1.0f - w1;
                if (lane == 0) { const int e1 = gs * 4 + i1, e2 = gs * 4 + i2;
                    const int r1 = atomicAdd(&lcnt[e1], 1), r2 = atomicAdd(&lcnt[e2], 1);
                    tinfo[(tl + u) * 4 + 0] = e1; tinfo[(tl + u) * 4 + 1] = r1; tinfo[(tl + u) * 4 + 2] = e2; tinfo[(tl + u) * 4 + 3] = r2; twt[(tl + u) * 2] = pg * w1; twt[(tl + u) * 2 + 1] = pg * w2; }
            }
        }
        __syncthreads();
        if (tid < 16) lbase[tid] = (int)__hip_atomic_fetch_add(gcnt + tid, (unsigned)lcnt[tid], __ATOMIC_RELAXED, __HIP_MEMORY_SCOPE_AGENT);
        __syncthreads();
        if (tid < 128) { const int tok = tile * 128 + tid;
            const int e1 = tinfo[tid * 4], e2 = tinfo[tid * 4 + 2], p1 = lbase[e1] + tinfo[tid * 4 + 1], p2 = lbase[e2] + tinfo[tid * 4 + 3];
            LIST[e1 * NT + p1] = tok; LIST[e2 * NT + p2] = tok; WLs[e1 * NT + p1] = twt[tid * 2]; WLs[e2 * NT + p2] = twt[tid * 2 + 1];
            ROUTE[tok * 4 + 0] = e1; ROUTE[tok * 4 + 1] = p1; ROUTE[tok * 4 + 2] = e2; ROUTE[tok * 4 + 3] = p2; }
        __syncthreads();
    }
}

__device__ __forceinline__ void ph10_final(const Params& p, int bid, int nb, const int* meta) {
    const int lane = threadIdx.x & 63, wave = threadIdx.x >> 6;
    const float* MOD = (const float*)(p.ws + OFF_MOD);
    const bf16_t* Y = (const bf16_t*)(p.ws + OFF_SLOT);
    const int* ROUTE = (const int*)(p.ws + OFF_ROUTE);
    const bf16_t* X1B = (const bf16_t*)(p.ws + OFF_SLOT + 5 * SLOT); float* OUT = p.out;
    const int r0 = bid * 8 + wave, rs = nb * 8;
    f32x4 gf[4], gtv[4]; int mprev = -1;
#pragma unroll
    for (int j = 0; j < 4; ++j) gf[j] = *(const f32x4*)(p.in[I_GFINAL] + lane * 4 + 256 * j);
    auto yrow = [&](int r, int k) -> const bf16_t* { const int e = ROUTE[r * 4 + 2 * k], pp = ROUTE[r * 4 + 2 * k + 1]; return Y + ((size_t)meta[16 + e] * 256 + pp) * 1024; };
    u32x2 nx[4], na[4], nb2[4];
    const bf16_t *ya = yrow(r0, 0), *yb = yrow(r0, 1);
#pragma unroll
    for (int j = 0; j < 4; ++j) { const int c = lane * 4 + 256 * j; nx[j] = *(const u32x2*)(X1B + (size_t)r0 * DM + c); na[j] = *(const u32x2*)(ya + c); nb2[j] = *(const u32x2*)(yb + c); }
    { const int rn = r0 + rs < NT ? r0 + rs : r0; ya = yrow(rn, 0); yb = yrow(rn, 1); }
#pragma unroll 1
    for (int r = r0; r < NT; r += rs) {
        const int mb = r / SEQ;
        if (mb != mprev) { mprev = mb;
#pragma unroll
            for (int j = 0; j < 4; ++j) gtv[j] = *(const f32x4*)(MOD + mb * 6144 + 5 * 1024 + lane * 4 + 256 * j); }
        f32x4 v[4]; float ss = 0.f;
#pragma unroll
        for (int j = 0; j < 4; ++j) {
            v[j] = (f32x4){bflo(nx[j].x), bfhi(nx[j].x), bflo(nx[j].y), bfhi(nx[j].y)};
            const f32x4 ys = (f32x4){bflo(na[j].x) + bflo(nb2[j].x), bfhi(na[j].x) + bfhi(nb2[j].x), bflo(na[j].y) + bflo(nb2[j].y), bfhi(na[j].y) + bfhi(nb2[j].y)};
            v[j] += gtv[j] * ys; const f32x4 sq = v[j] * v[j]; ss += (sq[0] + sq[1]) + (sq[2] + sq[3]); }
        { const int rn = r + rs < NT ? r + rs : r;
#pragma unroll
            for (int j = 0; j < 4; ++j) { const int c = lane * 4 + 256 * j; nx[j] = *(const u32x2*)(X1B + (size_t)rn * DM + c); na[j] = *(const u32x2*)(ya + c); nb2[j] = *(const u32x2*)(yb + c); }
            const int rn2 = r + 2 * rs < NT ? r + 2 * rs : rn; ya = yrow(rn2, 0); yb = yrow(rn2, 1); }
        const float rinv = rsqrtf(wave_sum_dpp(ss) * (1.0f / DM) + 1e-6f);
#pragma unroll
        for (int j = 0; j < 4; ++j) *(f32x4*)(OUT + (size_t)r * DM + lane * 4 + 256 * j) = v[j] * rinv * gf[j];
    }
}

#define XB_TMO      128
#define XB_XCNT(j)  (256  + 64 * (j))
#define XB_XSUB(j)  (1280 + 64 * (j))
#define XB_XGEN(j)  (2304 + 64 * (j))
#define XB_TOP      3328
#define XB_TOPGEN   3392
#define XCD_BAR_WORDS 3456
#define XB_SPIN_CAP (1u << 18)
__device__ __forceinline__ unsigned xb_ld(unsigned* p)              { return __hip_atomic_load(p, __ATOMIC_RELAXED, __HIP_MEMORY_SCOPE_AGENT); }
__device__ __forceinline__ unsigned xb_add(unsigned* p, unsigned v) { return __hip_atomic_fetch_add(p, v, __ATOMIC_RELAXED, __HIP_MEMORY_SCOPE_AGENT); }
__device__ __forceinline__ unsigned xb_xcc_id() { return (unsigned)__builtin_amdgcn_s_getreg((3 << 11) | 20) & 0xFu; }
#define XB_SPIN(cond, bar) do { unsigned _sp = 0; while (cond) { __builtin_amdgcn_s_sleep(1); \
    if ((++_sp & 255u) == 0u) { if (xb_ld(&(bar)[XB_TMO])) break; if (_sp > XB_SPIN_CAP) { atomicAdd(&(bar)[XB_TMO], 1u); break; } } } } while (0)
struct XcdBarrier { unsigned* bar; unsigned x; volatile unsigned* st; };
__device__ __forceinline__ XcdBarrier xcd_barrier_post(unsigned* bar, volatile unsigned* st) {
    XcdBarrier b; b.bar = bar; b.x = xb_xcc_id(); b.st = st;
    if (threadIdx.x == 0) (void)xb_add(&bar[XB_XCNT(b.x)], 1u);
    return b;
}
__device__ __forceinline__ void xcd_barrier_complete(unsigned* bar, unsigned x, unsigned& nloc, unsigned& nx) {
    const unsigned G = gridDim.x * gridDim.y * gridDim.z;
    unsigned sum, cnt, mine, sp = 0u;
    for (;;) {
        sum = 0u; cnt = 0u; mine = 0u;
#pragma unroll
        for (unsigned j = 0; j < 16; ++j) { const unsigned c = xb_ld(&bar[XB_XCNT(j)]); sum += c; cnt += (c > 0u) ? 1u : 0u; mine = (j == x) ? c : mine; }
        if (sum == G) break;
        __builtin_amdgcn_s_sleep(1);
        if ((++sp & 255u) == 0u) { if (xb_ld(&bar[XB_TMO])) break; if (sp > XB_SPIN_CAP) { atomicAdd(&bar[XB_TMO], 1u); break; } }
    }
    nloc = mine > 0u ? mine : 1u; nx = cnt > 0u ? cnt : 1u;
}
__device__ __forceinline__ void xcd_barrier(const XcdBarrier& b) {
    asm volatile("s_waitcnt vmcnt(0)" ::: "memory");
    __syncthreads();
    if (threadIdx.x == 0) {
        unsigned* bar = b.bar;
        __builtin_amdgcn_s_waitcnt(0);
        unsigned nloc = b.st[0], nx = b.st[1];
        if (nloc == 0u) { xcd_barrier_complete(bar, b.x, nloc, nx); b.st[0] = nloc; b.st[1] = nx; }
        const unsigned old = xb_add(&bar[XB_XSUB(b.x)], 1u);
        const unsigned gen = old / nloc;
        if (old + 1u == (gen + 1u) * nloc) {
            __builtin_amdgcn_fence(__ATOMIC_RELEASE, "agent");
            asm volatile("s_waitcnt vmcnt(0)" ::: "memory");
            const unsigned og = xb_add(&bar[XB_TOP], 1u);
            const unsigned tg = og / nx;
            if (og + 1u == (tg + 1u) * nx) xb_add(&bar[XB_TOPGEN], 1u);
            else XB_SPIN(xb_ld(&bar[XB_TOPGEN]) == tg, bar);
            __builtin_amdgcn_fence(__ATOMIC_ACQUIRE, "agent");
            xb_add(&bar[XB_XGEN(b.x)], 1u);
            asm volatile("s_waitcnt vmcnt(0)" ::: "memory");
        } else {
            XB_SPIN(xb_ld(&bar[XB_XGEN(b.x)]) == gen, bar);
            __builtin_amdgcn_fence(__ATOMIC_ACQUIRE, "agent");
            asm volatile("s_waitcnt vmcnt(0)" ::: "memory");
        }
    }
    __syncthreads();
}
constexpr size_t OFF_BAR = OFF_CTL + 4096;

__global__ void __launch_bounds__(NTHR) mega(Params p, int lo, int hi) {
    extern __shared__ __attribute__((aligned(16))) unsigned char lds[];
    cg::grid_group grid = cg::this_grid();
    const int bid = blockIdx.x, nb = gridDim.x;
    unsigned char* ws = p.ws;
    bf16_t* S0 = (bf16_t*)(ws + OFF_SLOT), *S1 = (bf16_t*)(ws + OFF_SLOT + SLOT), *S2 = (bf16_t*)(ws + OFF_SLOT + 2 * SLOT), *S3 = (bf16_t*)(ws + OFF_SLOT + 3 * SLOT),
           *S4 = (bf16_t*)(ws + OFF_SLOT + 4 * SLOT), *S5 = (bf16_t*)(ws + OFF_SLOT + 5 * SLOT);
    const float* MOD = (const float*)(ws + OFF_MOD); const float* BINP = (const float*)(ws + OFF_BINP);
    int* meta = (int*)(lds + LDS_BYTES - 256);
#ifndef PHMASK
#define PHMASK 0x7ff
#endif
#define IN(k) (((PHMASK >> (k)) & 1) && lo <= (k) && (k) < hi)
#ifndef PIPE_MASK
#define PIPE_MASK 0x364
#endif
#define GEMM_RUN(k, gather, s, e) gemm_phase_pipe<gather>(lds, s, e)
    volatile unsigned* xst = (volatile unsigned*)(lds + LDS_BYTES - 16);
    if (threadIdx.x < 2) xst[threadIdx.x] = 0u;
    __syncthreads();
    XcdBarrier xbar; xbar.bar = (unsigned*)(ws + OFF_BAR); xbar.x = 0; xbar.st = xst;
    if (hi - lo > 1) xbar = xcd_barrier_post((unsigned*)(ws + OFF_BAR), xst);
    if (p.pv == 0x7eadbeef) grid.sync();
#define SEAM(k) do { if (IN(k) && IN((k) + 1)) xcd_barrier(xbar); } while (0)
    if (IN(0)) { ph0_prep(p, bid, nb, lds); } SEAM(0);
    if (IN(1)) { if (ph1_norm(p, bid, nb)) { SchCtx s{(const bf16_t*)(ws + OFF_HC), (const bf16_t*)(ws + OFF_WIN), CTX_GEMM_WGS, bid, 1024}; EpiCtx e{(bf16_t*)(ws + OFF_XRC), BINP}; GEMM_RUN(1, false, s, e); } } SEAM(1);
    if (IN(2)) {
        if (nb < 4 * CTX_GEMM_WGS) { SchCtx s{(const bf16_t*)(ws + OFF_HC), (const bf16_t*)(ws + OFF_WIN), nb, bid, 1024}; EpiCtx e{(bf16_t*)(ws + OFF_XRC), BINP}; GEMM_RUN(2, false, s, e); }
        { SchG1 s{S0, (const bf16_t*)(ws + OFF_WIN), nb, bid, 1024}; EpiG1 e{S1, S2, S3, S4, S5, BINP}; GEMM_RUN(2, false, s, e); }
    } SEAM(2);
    if (IN(3)) {
#ifndef NO_APREP
        { bool have = false; for (int g = bid; g < 512; g += nb) { const int gn = g + nb < 512 ? g + nb : -1; aprep_item(p, g, lds, have, gn); have = gn >= 0; } }
#endif
#ifndef NO_BLOCAL
        b_phase<false>(p, bid, nb, lds);
#endif
    } SEAM(3);
    if (IN(4)) {
        if (!(bid & 1)) { prep_items(p, PREP_EARLY, PREP_ALL, bid * 8 + (int)(threadIdx.x >> 6), nb * 8, lds); __syncthreads(); }
        b_phase<true>(p, bid, nb, lds);
        if (bid & 1) { __syncthreads(); prep_items(p, PREP_EARLY, PREP_ALL, bid * 8 + (int)(threadIdx.x >> 6), nb * 8, lds); }
    } SEAM(4);
    if (IN(5)) { SchG2 s{S0, S1, (const bf16_t*)(ws + OFF_WPA), (const bf16_t*)(ws + OFF_WPB), nb, bid, 1024}; EpiG2 e{S4, S5, S3}; GEMM_RUN(5, false, s, e); } SEAM(5);
    if (IN(6)) { SchG3 s{S3, (const bf16_t*)(ws + OFF_WO), nb, bid, 1024}; EpiG3 e{p.in[I_X], MOD, S5}; GEMM_RUN(6, false, s, e); } SEAM(6);
    if (IN(7)) { ph8_route(p, bid, nb, lds); } SEAM(7);
    if (IN(8)) { __syncthreads(); moe_meta_build(p, meta); MoeMeta mm{meta};
        int* idx = (int*)(lds + STAGE_BYTES);
        SchUp s{S2, (const bf16_t*)(ws + OFF_WGU), (const int*)(ws + OFF_LIST), mm, nb, bid, 1024, idx, (unsigned*)(ws + OFF_CTL) + 64}; EpiUp e{S3, (const float*)(ws + OFF_WL), mm};
        { int iv[8]; bool ok[8];
#pragma unroll
            for (int i = 0; i < 8; ++i) { Unit u; ok[i] = s.next(i, u); iv[i] = 0;
                if (ok[i] && threadIdx.x < 256) { int pos = u.aux2 + (int)threadIdx.x; const int c = mm.cnt(u.aux); pos = pos < c ? pos : c - 1; iv[i] = s.LIST[u.aux * NT + pos]; } }
#pragma unroll
            for (int i = 0; i < 8; ++i) if (ok[i] && threadIdx.x < 256) idx[i * 256 + threadIdx.x] = iv[i]; }
        __syncthreads();
        GEMM_RUN(8, true, s, e); }
    if (IN(9)) { __syncthreads(); moe_meta_build(p, meta); MoeMeta mm{meta};
        SchDn s{S3, (const bf16_t*)(ws + OFF_WDN), mm, nb, bid, 512, (unsigned*)(ws + OFF_CTL) + 64, IN(8)}; EpiDn e{S0, mm}; GEMM_RUN(9, false, s, e); } SEAM(9);
    if (IN(10)) { __syncthreads(); moe_meta_build(p, meta); ph10_final(p, bid, nb, meta); }
#undef IN
#undef SEAM
}

extern "C" void kernel_launch(void* const* d_in, const int* in_sizes, int n_in, void* d_out, int out_size, void* d_ws, size_t ws_size, hipStream_t stream) {
    static int grid = 0;
    if (grid == 0) {
        if (n_in != 37 || out_size != NT * DM || ws_size < WS_END) { fprintf(stderr, "kernel_launch: unexpected shapes: n_in %d out %d ws %zu (need %zu)\n", n_in, out_size, ws_size, (size_t)WS_END); grid = -1; return; }
        int dev = 0, cus = 0, per_cu = 0;
        (void)hipGetDevice(&dev); (void)hipDeviceGetAttribute(&cus, hipDeviceAttributeMultiprocessorCount, dev);
        if (hipFuncSetAttribute((const void*)mega, hipFuncAttributeMaxDynamicSharedMemorySize, LDS_BYTES) != hipSuccess) { fprintf(stderr, "kernel_launch: hipFuncSetAttribute failed\n"); grid = -1; return; }
        if (hipOccupancyMaxActiveBlocksPerMultiprocessor(&per_cu, (const void*)mega, NTHR, LDS_BYTES) != hipSuccess || per_cu < 1) { fprintf(stderr, "kernel_launch: occupancy query says %d\n", per_cu); per_cu = 1; }
        (void)hipGetLastError();
        grid = cus * 1;
        fprintf(stderr, "kernel_launch: grid %d (cus %d, per_cu %d)\n", grid, cus, per_cu);
    }
    if (grid < 0) return;
    Params p{};
    for (int i = 0; i < 37; ++i) p.in[i] = (const float*)d_in[i];
    p.out = (float*)d_out; p.ws = (unsigned char*)d_ws;
#if ONE_LAUNCH
    (void)hipMemsetAsync((unsigned char*)d_ws + OFF_BAR, 0, XCD_BAR_WORDS * 4, stream);
    int lo = 0, hi = NPHASE; void* args[] = {&p, &lo, &hi};
    hipError_t e = hipLaunchCooperativeKernel((const void*)mega, dim3(grid), dim3(NTHR), args, LDS_BYTES, stream);
    if (e != hipSuccess) fprintf(stderr, "cooperative launch failed: %s (grid %d)\n", hipGetErrorString(e), grid);
#ifdef PROBE_PHASE
    hipLaunchKernelGGL(mega, dim3(grid), dim3(NTHR), LDS_BYTES, stream, p, PROBE_PHASE, PROBE_PHASE + 1);
#endif
#else
    for (int k = 0; k < NPHASE; ++k) hipLaunchKernelGGL(mega, dim3(grid), dim3(NTHR), LDS_BYTES, stream, p, k, k + 1);
#endif
}
```

```cpp
#include <hip/hip_runtime.h>
#include <hip/hip_cooperative_groups.h>
#include <cstdio>
#include <cstdint>
namespace cg = cooperative_groups;

#ifndef ONE_LAUNCH
#define ONE_LAUNCH 1
#endif

typedef unsigned short bf16_t;
typedef short bf16x8 __attribute__((ext_vector_type(8)));
typedef float f32x4 __attribute__((ext_vector_type(4)));
typedef float f32x2 __attribute__((ext_vector_type(2)));
typedef unsigned u32x4 __attribute__((ext_vector_type(4)));
typedef unsigned u32x2 __attribute__((ext_vector_type(2)));

constexpr int NT = 32768, NCX = 1024, DM = 1024, SEQ = 8192, CTXL = 256;
constexpr int NTHR = 512;
constexpr int NCH64 = 132;
constexpr size_t MiB = (size_t)1 << 20;
constexpr size_t OFF_CTL = 0, OFF_MOD = 1 * MiB, OFF_BINP = OFF_MOD + 128 * 1024, OFF_WIN = 2 * MiB, OFF_WPA = 14 * MiB, OFF_WPB = 16 * MiB,
                 OFF_WO = 18 * MiB, OFF_WG = 20 * MiB, OFF_WGU = 22 * MiB, OFF_WDN = 54 * MiB, OFF_HC = 70 * MiB, OFF_XRC = 72 * MiB,
                 OFF_TOT = 74 * MiB, OFF_ROUTE = 84 * MiB, OFF_LIST = 85 * MiB, OFF_WL = 87 * MiB, OFF_SLOT = 90 * MiB, SLOT = 64 * MiB,
                 WS_END = OFF_SLOT + 6 * SLOT;
constexpr int LDS_BYTES = 144 * 1024;
constexpr int NPHASE = 11;

struct Params { const float* in[37]; float* out; unsigned char* ws; int pv; int pad; };

enum { I_X = 0, I_C, I_CTX, I_CCTX, I_WADA, I_BADA, I_GMIX, I_WIN, I_BIN, I_CONVW, I_CONVB, I_LNG, I_LNB, I_WPA, I_LCW, I_LCB,
       I_WRF, I_BRF, I_WIF, I_BIF, I_LAMF, I_WRB, I_BRB, I_WIB, I_BIB, I_LAMB, I_WPB, I_WO, I_GFFN, I_WGRP, I_BGRP, I_WER, I_BER,
       I_WGATE, I_WUP, I_WDOWN, I_GFINAL };

__device__ __forceinline__ float bflo(unsigned w) { return __uint_as_float(w << 16); }
__device__ __forceinline__ float bfhi(unsigned w) { return __uint_as_float(w & 0xffff0000u); }
__device__ __forceinline__ float bf2f(bf16_t h) { return __uint_as_float(((unsigned)h) << 16); }
__device__ __forceinline__ unsigned pk2(float lo, float hi) { unsigned r; asm("v_cvt_pk_bf16_f32 %0, %1, %2" : "=v"(r) : "v"(lo), "v"(hi)); return r; }
__device__ __forceinline__ bf16_t f2bf(float f) { return (bf16_t)(pk2(f, 0.f) & 0xffffu); }
__device__ __forceinline__ float sigm(float x) { return __builtin_amdgcn_rcpf(1.0f + __expf(-x)); }
__device__ __forceinline__ float sigm2(float x2) { return __builtin_amdgcn_rcpf(1.0f + __builtin_amdgcn_exp2f(x2)); }
__device__ __forceinline__ float silu(float x) { return x * sigm(x); }
__device__ __forceinline__ float gelu_tanh(float x) { return x * sigm(1.5957691216057308f * (x + 0.044715f * x * x * x)); }
__device__ __forceinline__ float wave_sum(float v) {
#pragma unroll
    for (int o = 1; o < 64; o <<= 1) v += __shfl_xor(v, o);
    return v;
}
template <int CTRL, int RMASK> __device__ __forceinline__ float dpp_add(float v) { return v + __int_as_float(__builtin_amdgcn_update_dpp(0, __float_as_int(v), CTRL, RMASK, 0xF, false)); }
__device__ __forceinline__ float wave_sum_dpp(float v) {
    v = dpp_add<0xB1, 0xF>(v); v = dpp_add<0x4E, 0xF>(v); v = dpp_add<0x141, 0xF>(v); v = dpp_add<0x140, 0xF>(v); v = dpp_add<0x142, 0xA>(v); v = dpp_add<0x143, 0xC>(v);
    return __int_as_float(__builtin_amdgcn_readlane(__float_as_int(v), 63));
}
__device__ __forceinline__ void wave_lds_sync() { asm volatile("s_waitcnt lgkmcnt(0)" ::: "memory"); __builtin_amdgcn_wave_barrier(); }
__device__ __forceinline__ u32x2 pk4(f32x4 v) { u32x2 r; r.x = pk2(v[0], v[1]); r.y = pk2(v[2], v[3]); return r; }

__device__ __forceinline__ u32x4 pk8(f32x4 a, f32x4 b) { u32x4 r; r.x = pk2(a[0], a[1]); r.y = pk2(a[2], a[3]); r.z = pk2(b[0], b[1]); r.w = pk2(b[2], b[3]); return r; }
__device__ __forceinline__ void unpk8(u32x4 w, f32x4& a, f32x4& b) { a[0] = bflo(w.x); a[1] = bfhi(w.x); a[2] = bflo(w.y); a[3] = bfhi(w.y); b[0] = bflo(w.z); b[1] = bfhi(w.z); b[2] = bflo(w.w); b[3] = bfhi(w.w); }

template <class DRow>
__device__ __forceinline__ void tr_item(const float* __restrict__ src, int ldsrc, int k0, int n0, bf16_t* dst, int ldd, DRow drow, float* scr, int lane, float scale = 1.0f) {
    const float* sp = src + (size_t)k0 * ldsrc + n0 + lane;
    float tv[64];
#pragma unroll
    for (int kk = 0; kk < 64; ++kk) tv[kk] = sp[(size_t)kk * ldsrc];
#pragma unroll
    for (int kk = 0; kk < 64; ++kk) scr[kk * 65 + lane] = tv[kk] * scale;
    wave_lds_sync();
    const int c = lane & 7;
#pragma unroll
    for (int j = 0; j < 8; ++j) {
        const int n = (lane >> 3) + 8 * j; const float* s = scr + (8 * c) * 65 + n;
        u32x4 o; o.x = pk2(s[0], s[65]); o.y = pk2(s[130], s[195]); o.z = pk2(s[260], s[325]); o.w = pk2(s[390], s[455]);
        *(u32x4*)(dst + (size_t)drow(n0 + n) * ldd + k0 + 8 * c) = o;
    }
    wave_lds_sync();
}

__device__ __forceinline__ int win_srccol(int np) { const int p = np >> 8, r = np & 255; return p < 8 ? (r >> 7) * 1024 + 128 * p + (r & 127) : np; }

constexpr int N_WIN = 16 * 96, N_SQ = 16 * 16, N_G = 128, N_GU = 2048, N_DN = 2048;
constexpr int PREP_EARLY = N_WIN + 3 * N_SQ + N_G, PREP_ALL = PREP_EARLY + 2 * N_GU + N_DN;
__device__ __forceinline__ void prep_items(const Params& p, int first, int last, int gw, int NGW, unsigned char* lds) {
    const int lane = threadIdx.x & 63, wave = threadIdx.x >> 6;
    unsigned char* ws = p.ws;
    float* scr = (float*)lds + wave * (64 * 65);
    for (int it = first + gw; it < last; it += NGW) {
        int r = it;
        if (r < N_WIN) { const int kb = r / 96, nbk = r % 96, d0 = 64 * nbk, sc0 = win_srccol(d0);
            const int pt = d0 >> 8; const bool sgm = (pt < 8 && ((d0 >> 7) & 1)) || pt >= 16;
            tr_item(p.in[I_WIN], 6144, 64 * kb, sc0, (bf16_t*)(ws + OFF_WIN), 1024, [=](int n) { return n - sc0 + d0; }, scr, lane, sgm ? -1.4426950408889634f : 1.0f); continue; }
        r -= N_WIN;
        if (r < 3 * N_SQ) { const int which = r / N_SQ, q = r % N_SQ, kb = q / 16, nbk = q % 16;
            const float* src = which == 0 ? p.in[I_WPA] : which == 1 ? p.in[I_WPB] : p.in[I_WO];
            bf16_t* dst = (bf16_t*)(ws + (which == 0 ? OFF_WPA : which == 1 ? OFF_WPB : OFF_WO));
            tr_item(src, 1024, 64 * kb, 64 * nbk, dst, 1024, [=](int n) { return n; }, scr, lane); continue; }
        r -= 3 * N_SQ;
        if (r < N_G) { const int ty = r / 32, q = r % 32, h = q / 4, kb = (q % 4) / 2, nbk = q % 2;
            const float* src = (ty == 0 ? p.in[I_WRF] : ty == 1 ? p.in[I_WIF] : ty == 2 ? p.in[I_WRB] : p.in[I_WIB]) + (size_t)h * 128 * 128;
            tr_item(src, 128, 64 * kb, 64 * nbk, (bf16_t*)(ws + OFF_WG), 128, [=](int n) { return h * 512 + (n >> 4) * 64 + ty * 16 + (n & 15); }, scr, lane, -1.4426950408889634f); continue; }
        r -= N_G;
        if (r < 2 * N_GU) { const int bj = r / N_GU, q = r % N_GU, e = q / 128, kb = (q % 128) / 8, nbk = q % 8;
            const float* src = (bj == 0 ? p.in[I_WGATE] : p.in[I_WUP]) + (size_t)e * 1024 * 512;
            tr_item(src, 512, 64 * kb, 64 * nbk, (bf16_t*)(ws + OFF_WGU) + (size_t)e * 1024 * 1024, 1024, [=](int n) { return 256 * (n >> 7) + 128 * bj + (n & 127); }, scr, lane); continue; }
        r -= 2 * N_GU;
        { const int e = r / 128, kb = (r % 128) / 16, nbk = r % 16;
            tr_item(p.in[I_WDOWN] + (size_t)e * 512 * 1024, 1024, 64 * kb, 64 * nbk, (bf16_t*)(ws + OFF_WDN) + (size_t)e * 1024 * 512, 512, [=](int n) { return n; }, scr, lane); }
    }
}

__device__ __forceinline__ void ph0_prep(const Params& p, int bid, int nb, unsigned char* lds) {
    const int tid = threadIdx.x, lane = tid & 63, wave = tid >> 6;
    unsigned char* ws = p.ws;
    float* red = (float*)lds;
    float* MOD = (float*)(ws + OFF_MOD);
    for (int it = bid; it < 96; it += nb) {
        const int col = it * 64 + lane;
        float a[5] = {0.f, 0.f, 0.f, 0.f, 0.f};
        const float* W = p.in[I_WADA];
#pragma unroll 1
        for (int k0 = wave * 128; k0 < wave * 128 + 128; k0 += 64) {
            float wv[64];
#pragma unroll
            for (int kk = 0; kk < 64; ++kk) wv[kk] = W[(size_t)(k0 + kk) * 6144 + col];
#pragma unroll
            for (int kk = 0; kk < 64; ++kk)
#pragma unroll
                for (int r = 0; r < 5; ++r) { const float cv = r < 4 ? p.in[I_C][r * 1024 + k0 + kk] : p.in[I_CCTX][k0 + kk]; a[r] += silu(cv) * wv[kk]; }
        }
#pragma unroll
        for (int r = 0; r < 5; ++r) red[(wave * 5 + r) * 64 + lane] = a[r];
        __syncthreads();
        if (tid < 320) { const int r = tid / 64, l = tid % 64; float s = 0.f;
#pragma unroll
            for (int w = 0; w < 8; ++w) s += red[(w * 5 + r) * 64 + l];
            MOD[r * 6144 + it * 64 + l] = s + p.in[I_BADA][it * 64 + l]; }
        __syncthreads();
    }
    __syncthreads();
    if (nb > 96 + 32) { if (bid >= 96) prep_items(p, 0, PREP_EARLY, (bid - 96) * 8 + wave, (nb - 96) * 8, lds); }
    else prep_items(p, 0, PREP_EARLY, bid * 8 + wave, nb * 8, lds);
    float* BINP = (float*)(ws + OFF_BINP);
    for (int i = bid * NTHR + tid; i < 6144; i += nb * NTHR) { const int pt = i >> 8; const bool sgm = (pt < 8 && ((i >> 7) & 1)) || pt >= 16; BINP[i] = p.in[I_BIN][win_srccol(i)] * (sgm ? -1.4426950408889634f : 1.0f); }
    if (bid == 0) ((unsigned*)(ws + OFF_CTL))[tid] = 0u;
}

template <bool WT>
__device__ __forceinline__ void norm_row(const f32x4 (&v)[4], float ss, const f32x4 (&gsv)[4], const f32x4 (&shv)[4], bf16_t* dst, int lane) {
    const float rinv = rsqrtf(wave_sum_dpp(ss) * (1.0f / DM) + 1e-6f);
#pragma unroll
    for (int j = 0; j < 4; ++j) { const int c = lane * 4 + 256 * j;
        const u32x2 o = pk4(v[j] * rinv * gsv[j] + shv[j]);
        if (WT) __hip_atomic_store((unsigned long long*)(dst + c), ((unsigned long long)o.y << 32) | o.x, __ATOMIC_RELAXED, __HIP_MEMORY_SCOPE_AGENT);
        else *(u32x2*)(dst + c) = o; }
}
constexpr int CTX_GEMM_WGS = 16;
__device__ __forceinline__ bool ph1_norm(const Params& p, int bid, int nb) {
    const int lane = threadIdx.x & 63, wave = threadIdx.x >> 6;
    const float* MOD = (const float*)(p.ws + OFF_MOD);
    unsigned* ctxcnt = (unsigned*)(p.ws + OFF_CTL) + 32;
    f32x4 gm[4];
#pragma unroll
    for (int j = 0; j < 4; ++j) gm[j] = *(const f32x4*)(p.in[I_GMIX] + lane * 4 + 256 * j);
    f32x4 shv[4], gsv[4];
    const bool split = nb >= 4 * CTX_GEMM_WGS;
    for (int cr = bid * 8 + wave; cr < NCX; cr += nb * 8) {
        const float* mrow = MOD + 4 * 6144;
        f32x4 v[4]; float ss = 0.f;
#pragma unroll
        for (int j = 0; j < 4; ++j) { const int c = lane * 4 + 256 * j; v[j] = *(const f32x4*)(p.in[I_CTX] + (size_t)cr * DM + c); const f32x4 sq = v[j] * v[j]; ss += (sq[0] + sq[1]) + (sq[2] + sq[3]);
            shv[j] = *(const f32x4*)(mrow + c); gsv[j] = gm[j] * (1.0f + *(const f32x4*)(mrow + 1024 + c)); }
        norm_row<true>(v, ss, gsv, shv, (bf16_t*)(p.ws + OFF_HC) + (size_t)cr * DM, lane);
        asm volatile("s_waitcnt vmcnt(0)" ::: "memory");
        if (lane == 0) __hip_atomic_fetch_add(ctxcnt, 1u, __ATOMIC_RELAXED, __HIP_MEMORY_SCOPE_AGENT);
    }
    if (split && bid < CTX_GEMM_WGS) {
        if (threadIdx.x == 0) { unsigned sp = 0;
            while (__hip_atomic_load(ctxcnt, __ATOMIC_RELAXED, __HIP_MEMORY_SCOPE_AGENT) < (unsigned)NCX) { __builtin_amdgcn_s_sleep(2); if (++sp > (1u << 22)) break; }
            __builtin_amdgcn_fence(__ATOMIC_ACQUIRE, "agent");
            asm volatile("s_waitcnt vmcnt(0)" ::: "memory"); }
        __syncthreads();
        return true;
    }
    const int wg0 = split ? CTX_GEMM_WGS : 0;
    const int r0 = (bid - wg0) * 8 + wave, rs = (nb - wg0) * 8;
    int mprev = -1;
    f32x4 nx[4];
#pragma unroll
    for (int j = 0; j < 4; ++j) nx[j] = *(const f32x4*)(p.in[I_X] + (size_t)r0 * DM + lane * 4 + 256 * j);
#pragma unroll 1
    for (int r = r0; r < NT; r += rs) {
        const int mb = r / SEQ;
        if (mb != mprev) { mprev = mb; const float* mrow = MOD + mb * 6144;
#pragma unroll
            for (int j = 0; j < 4; ++j) { const int c = lane * 4 + 256 * j; shv[j] = *(const f32x4*)(mrow + c); gsv[j] = gm[j] * (1.0f + *(const f32x4*)(mrow + 1024 + c)); } }
        f32x4 v[4]; float ss = 0.f;
#pragma unroll
        for (int j = 0; j < 4; ++j) { v[j] = nx[j]; const f32x4 sq = v[j] * v[j]; ss += (sq[0] + sq[1]) + (sq[2] + sq[3]); }
        { const int rn = r + rs < NT ? r + rs : r;
#pragma unroll
            for (int j = 0; j < 4; ++j) nx[j] = *(const f32x4*)(p.in[I_X] + (size_t)rn * DM + lane * 4 + 256 * j); }
        norm_row<false>(v, ss, gsv, shv, (bf16_t*)(p.ws + OFF_SLOT) + (size_t)r * DM, lane);
    }
    return false;
}

struct Unit { int pm, pn, aux, aux2; };

#define LAS __attribute__((address_space(3)))
constexpr int BK = 64, HTB = 128 * BK * 2, STAGE_BYTES = 8 * HTB;
__device__ __forceinline__ int lds_byte(int r, int c) { const int st = (r >> 4) * 2 + (c >> 5), rr = r & 15, cc = c & 31, ob = rr * 64 + cc * 2; return st * 1024 + (ob ^ (((ob >> 9) & 1) << 5)); }
__device__ __forceinline__ void stage_rc(int b, int& R, int& C) { const int st = b / 1024, sb = b % 1024, swz = sb ^ (((sb >> 9) & 1) << 5); R = (st >> 1) * 16 + swz / 64; C = (st & 1) * 32 + (swz % 64) / 2; }

template <bool GATHER, class S, class E>
__device__ __forceinline__ void gemm_phase_pipe(unsigned char* ldsg, const S& sch, const E& epi) {
    LAS unsigned char* lds = (LAS unsigned char*)ldsg;
    const int tid = threadIdx.x, wid = __builtin_amdgcn_readfirstlane(tid >> 6), lane = tid & 63, wr = wid >> 2, wc = wid & 3, fr = lane & 15, fq = lane >> 4;
    const int K = sch.K, nt = K / BK;
    int Rr[2], Cc[2]; unsigned voffA[2], voffB[2];
#pragma unroll
    for (int i = 0; i < 2; ++i) { stage_rc(tid * 16 + i * 8192, Rr[i], Cc[i]); voffA[i] = (unsigned)(Rr[i] * K + Cc[i]) * 2u;
        const int rho = Rr[i] & 31, Rb = (Rr[i] & ~31) + 8 * ((rho & 15) >> 2) + 4 * (rho >> 4) + (rho & 3);
        voffB[i] = (unsigned)(Rb * K + Cc[i]) * 2u; }
    const size_t kstep = (size_t)(BK * 2);
    const size_t hstep = (size_t)128 * K * 2;
    const unsigned ldsw = (unsigned)wid * 1024u;
    const int aoff = lds_byte(wr * 64 + fr, fq * 8), boff = lds_byte(wc * 32 + fr, fq * 8);
#define PG8_SA(b, h) (((b) * 2 + (h)) * HTB)
#define PG8_SB(b, h) ((4 + (b) * 2 + (h)) * HTB)
#define PG8_STAGE_B(bufoff, gbase) do { _Pragma("unroll") for (int _i = 0; _i < 2; ++_i) \
        __builtin_amdgcn_global_load_lds((const unsigned*)((const char*)(gbase) + voffB[_i]), (LAS unsigned*)(lds + (bufoff) + ldsw + _i * 8192), 16, 0, 0); } while (0)
#define PG8_STAGE_A(bufoff, gbase, h, vo) do { _Pragma("unroll") for (int _i = 0; _i < 2; ++_i) \
        __builtin_amdgcn_global_load_lds((const unsigned*)((const char*)(gbase) + (GATHER ? (size_t)(vo)[h][_i] : (size_t)(h) * hstep + voffA[_i])), (LAS unsigned*)(lds + (bufoff) + ldsw + _i * 8192), 16, 0, 0); } while (0)
#define PG8_LDA(dst, b, h) do { _Pragma("unroll") for (int m = 0; m < 4; ++m) _Pragma("unroll") for (int k = 0; k < 2; ++k) dst[m][k] = *(const LAS bf16x8*)(lds + PG8_SA(b, h) + aoff + m * 2048 + k * 1024); } while (0)
#define PG8_LDB(dst, b, h) do { _Pragma("unroll") for (int n = 0; n < 2; ++n) _Pragma("unroll") for (int k = 0; k < 2; ++k) dst[n][k] = *(const LAS bf16x8*)(lds + PG8_SB(b, h) + boff + n * 2048 + k * 1024); } while (0)
#define PG8_MMA(ai, bj, At, Bt) do { __builtin_amdgcn_s_setprio(1); _Pragma("unroll") for (int m = 0; m < 4; ++m) _Pragma("unroll") for (int n = 0; n < 2; ++n) _Pragma("unroll") for (int k = 0; k < 2; ++k) \
        acc[ai][bj][m][n] = __builtin_amdgcn_mfma_f32_16x16x32_bf16(Bt[n][k], At[m][k], acc[ai][bj][m][n], 0, 0, 0); __builtin_amdgcn_s_setprio(0); } while (0)
#define PG8_WAIT_V(n) asm volatile("s_waitcnt vmcnt(" #n ")" ::: "memory")
#define PG8_WAIT_L(n) asm volatile("s_waitcnt lgkmcnt(" #n ")" ::: "memory")
#define PG8_BAR __builtin_amdgcn_s_barrier()
#define PG8_SCHED __builtin_amdgcn_sched_barrier(0)
    Unit cur, nxt; int ui = 0;
    if (!sch.next(0, cur)) return;
    f32x4 acc[2][2][4][2];
#pragma unroll
    for (int a = 0; a < 2; ++a)
#pragma unroll
        for (int b = 0; b < 2; ++b)
#pragma unroll
            for (int m = 0; m < 4; ++m)
#pragma unroll
                for (int n = 0; n < 2; ++n) acc[a][b][m][n] = (f32x4){0.f, 0.f, 0.f, 0.f};
    bf16x8 At[4][2], B0[2][2], B1[2][2];
    unsigned voAc[2][2], voAn[2][2];
#pragma unroll
    for (int h = 0; h < 2; ++h)
#pragma unroll
        for (int i = 0; i < 2; ++i) { voAc[h][i] = GATHER ? sch.aoff(cur, 128 * h + Rr[i]) + (unsigned)Cc[i] * 2u : 0u; voAn[h][i] = voAc[h][i]; }
    const char* cA = sch.abase(cur); const char* cB = sch.bbase(cur);
    sch.a_ready(cur);
    PG8_STAGE_B(PG8_SB(0, 0), cB); PG8_STAGE_A(PG8_SA(0, 0), cA, 0, voAc); PG8_STAGE_B(PG8_SB(0, 1), cB + hstep); PG8_STAGE_A(PG8_SA(0, 1), cA, 1, voAc);
    if (wr == 1) PG8_BAR;
    PG8_WAIT_V(4); PG8_BAR;
    PG8_STAGE_B(PG8_SB(1, 0), cB + kstep); PG8_STAGE_A(PG8_SA(1, 0), cA + kstep, 0, voAc); PG8_STAGE_B(PG8_SB(1, 1), cB + hstep + kstep);
    PG8_WAIT_V(6); PG8_BAR;
    for (;;) {
        const bool has_next = sch.next(ui + 1, nxt);
        const char* nA = has_next ? sch.abase(nxt) : cA; const char* nB = has_next ? sch.bbase(nxt) : cB;
        if (GATHER) {
#pragma unroll
            for (int h = 0; h < 2; ++h)
#pragma unroll
                for (int i = 0; i < 2; ++i) voAn[h][i] = has_next ? sch.aoff(nxt, 128 * h + Rr[i]) + (unsigned)Cc[i] * 2u : voAc[h][i];
        }
#pragma unroll 1
        for (int t = 0; t < nt; t += 2) {
            const bool last = (t == nt - 2);
            const char* a1 = cA + (size_t)(t + 1) * kstep;
            const char* a2 = last ? nA : cA + (size_t)(t + 2) * kstep; const char* b2 = last ? nB : cB + (size_t)(t + 2) * kstep;
            const char* a3 = a2 + kstep; const char* b3 = b2 + kstep;
            if (last && has_next) sch.a_ready(nxt);
            unsigned vo2[2][2];
#pragma unroll
            for (int h = 0; h < 2; ++h)
#pragma unroll
                for (int i = 0; i < 2; ++i) vo2[h][i] = last ? voAn[h][i] : voAc[h][i];
            PG8_LDB(B0, 0, 0); PG8_SCHED; PG8_LDA(At, 0, 0); PG8_STAGE_A(PG8_SA(1, 1), a1, 1, voAc);
            PG8_WAIT_L(8); PG8_BAR; PG8_WAIT_L(0); PG8_MMA(0, 0, At, B0); PG8_BAR; PG8_SCHED;
            PG8_LDB(B1, 0, 1); PG8_STAGE_B(PG8_SB(0, 0), b2);
            PG8_BAR; PG8_WAIT_L(0); PG8_MMA(0, 1, At, B1); PG8_BAR;
            PG8_LDA(At, 0, 1); PG8_STAGE_A(PG8_SA(0, 0), a2, 0, vo2);
            PG8_BAR; PG8_WAIT_L(0); PG8_MMA(1, 0, At, B0); PG8_BAR; PG8_SCHED;
            PG8_STAGE_B(PG8_SB(0, 1), b2 + hstep);
            PG8_WAIT_V(6); PG8_BAR; PG8_MMA(1, 1, At, B1); PG8_BAR;
            PG8_LDB(B0, 1, 0); PG8_SCHED; PG8_LDA(At, 1, 0); PG8_STAGE_A(PG8_SA(0, 1), a2, 1, vo2);
            PG8_WAIT_L(8); PG8_BAR; PG8_WAIT_L(0); PG8_MMA(0, 0, At, B0); PG8_BAR; PG8_SCHED;
            PG8_LDB(B1, 1, 1); PG8_STAGE_B(PG8_SB(1, 0), b3);
            PG8_BAR; PG8_WAIT_L(0); PG8_MMA(0, 1, At, B1); PG8_BAR;
            PG8_LDA(At, 1, 1); PG8_STAGE_A(PG8_SA(1, 0), a3, 0, vo2);
            PG8_BAR; PG8_WAIT_L(0); PG8_MMA(1, 0, At, B0); PG8_BAR; PG8_SCHED;
            PG8_STAGE_B(PG8_SB(1, 1), b3 + hstep);
            PG8_WAIT_V(6); PG8_BAR; PG8_MMA(1, 1, At, B1); PG8_BAR;
        }
        { int frx = fr, fqx = fq; asm volatile("" : "+v"(frx), "+v"(fqx));
            const int jx = wc * 32 + 8 * fqx, rx = wr * 64 + frx;
            const typename E::Col ecol = epi.col(cur, jx);
            constexpr int PF = E::PF;
            typename E::Pre epre[8];
#pragma unroll
            for (int g = 0; g < PF; ++g) epre[g] = epi.load(cur, (g >> 2) * 128 + (g & 3) * 16 + rx, jx);
#pragma unroll
            for (int g = 0; g < 8; ++g) { const int ai = g >> 2, m = g & 3;
                if (g + PF < 8) epre[g + PF] = epi.load(cur, ((g + PF) >> 2) * 128 + ((g + PF) & 3) * 16 + rx, jx);
                epi.apply(cur, ai * 128 + m * 16 + rx, jx, ecol, epre[g], acc[ai][0][m][0], acc[ai][0][m][1], acc[ai][1][m][0], acc[ai][1][m][1]); } }
        sch.done(cur);
        if (!has_next) break;
#pragma unroll
        for (int a = 0; a < 2; ++a)
#pragma unroll
            for (int b = 0; b < 2; ++b)
#pragma unroll
                for (int m = 0; m < 4; ++m)
#pragma unroll
                    for (int n = 0; n < 2; ++n) acc[a][b][m][n] = (f32x4){0.f, 0.f, 0.f, 0.f};
        cur = nxt; cA = nA; cB = nB; ++ui;
#pragma unroll
        for (int h = 0; h < 2; ++h)
#pragma unroll
            for (int i = 0; i < 2; ++i) voAc[h][i] = voAn[h][i];
    }
    PG8_WAIT_V(0);
    if (wr == 0) PG8_BAR;
    PG8_BAR;
#undef PG8_SA
#undef PG8_SB
#undef PG8_STAGE_A
#undef PG8_STAGE_B
#undef PG8_LDA
#undef PG8_LDB
#undef PG8_MMA
#undef PG8_WAIT_V
#undef PG8_WAIT_L
#undef PG8_BAR
#undef PG8_SCHED
}

struct NoHooks {
    __device__ __forceinline__ void a_ready(const Unit&) const {}
    __device__ __forceinline__ void done(const Unit&) const {}
};
struct SchG1 { const bf16_t *A, *Bt; int G, c, K;
    __device__ __forceinline__ void a_ready(const Unit&) const {}
    __device__ __forceinline__ void done(const Unit&) const {}
    __device__ __forceinline__ bool next(int i, Unit& u) const { const int L = i * G + c; if (L >= 128 * 24) return false; u.pm = L / 24; u.pn = L % 24; return true; }
    __device__ __forceinline__ const bf16_t* arow(const Unit& u, int r) const { return A + (size_t)(u.pm * 256 + r) * 1024; }
    __device__ __forceinline__ const bf16_t* brow(const Unit& u, int n) const { return Bt + (size_t)(u.pn * 256 + n) * 1024; }
    __device__ __forceinline__ const char* abase(const Unit& u) const { return (const char*)(A + (size_t)u.pm * 256 * 1024); }
    __device__ __forceinline__ const char* bbase(const Unit& u) const { return (const char*)(Bt + (size_t)u.pn * 256 * 1024); }
    __device__ __forceinline__ unsigned aoff(const Unit&, int) const { return 0u; } };
struct EpiG1 { bf16_t *Z, *GYG, *XR, *SGA, *SGB; const float* bias;
    static constexpr int PF = 1; struct Col { f32x4 c0, c1, c2, c3; }; struct Pre { };
    __device__ __forceinline__ Col col(const Unit& u, int j) const { const float* bp = bias + u.pn * 256 + j; return Col{*(const f32x4*)bp, *(const f32x4*)(bp + 4), *(const f32x4*)(bp + 128), *(const f32x4*)(bp + 132)}; }
    __device__ __forceinline__ Pre load(const Unit&, int, int) const { return Pre{}; }
    __device__ __forceinline__ void apply(const Unit& u, int r, int j, const Col& c, const Pre&, f32x4 a0, f32x4 a1, f32x4 b0, f32x4 b1) const {
        const size_t row = (size_t)u.pm * 256 + r;
        a0 += c.c0; a1 += c.c1; b0 += c.c2; b1 += c.c3;
        if (u.pn < 8) {
#pragma unroll
            for (int e = 0; e < 4; ++e) { a0[e] *= sigm2(b0[e]); a1[e] *= sigm2(b1[e]); }
            *(u32x4*)(Z + row * 1024 + u.pn * 128 + j) = pk8(a0, a1); }
        else { const int kind = u.pn >> 2;
            bf16_t* dst = GYG + (size_t)(kind - 2) * (SLOT / 2);
#pragma unroll
            for (int e = 0; e < 4; ++e) { if (kind == 2) { a0[e] = gelu_tanh(a0[e]); a1[e] = gelu_tanh(a1[e]); b0[e] = gelu_tanh(b0[e]); b1[e] = gelu_tanh(b1[e]); }
                else if (kind >= 4) { a0[e] = sigm2(a0[e]); a1[e] = sigm2(a1[e]); b0[e] = sigm2(b0[e]); b1[e] = sigm2(b1[e]); } }
            bf16_t* o = dst + row * 1024 + (u.pn & 3) * 256 + j;
            *(u32x4*)o = pk8(a0, a1); *(u32x4*)(o + 128) = pk8(b0, b1); }
    } };
struct SchCtx { const bf16_t *A, *Bt; int G, c, K;
    __device__ __forceinline__ void a_ready(const Unit&) const {}
    __device__ __forceinline__ void done(const Unit&) const {}
    __device__ __forceinline__ bool next(int i, Unit& u) const { const int L = i * G + c; if (L >= 16) return false; u.pm = L / 4; u.pn = L % 4; return true; }
    __device__ __forceinline__ const bf16_t* arow(const Unit& u, int r) const { return A + (size_t)(u.pm * 256 + r) * 1024; }
    __device__ __forceinline__ const bf16_t* brow(const Unit& u, int n) const { return Bt + (size_t)((12 + u.pn) * 256 + n) * 1024; }
    __device__ __forceinline__ const char* abase(const Unit& u) const { return (const char*)(A + (size_t)u.pm * 256 * 1024); }
    __device__ __forceinline__ const char* bbase(const Unit& u) const { return (const char*)(Bt + (size_t)(12 + u.pn) * 256 * 1024); }
    __device__ __forceinline__ unsigned aoff(const Unit&, int) const { return 0u; } };
struct EpiCtx { bf16_t* XRC; const float* bias;
    static constexpr int PF = 1; struct Col { f32x4 c0, c1, c2, c3; }; struct Pre { };
    __device__ __forceinline__ Col col(const Unit& u, int j) const { const float* bp = bias + (12 + u.pn) * 256 + j; return Col{*(const f32x4*)bp, *(const f32x4*)(bp + 4), *(const f32x4*)(bp + 128), *(const f32x4*)(bp + 132)}; }
    __device__ __forceinline__ Pre load(const Unit&, int, int) const { return Pre{}; }
    __device__ __forceinline__ void apply(const Unit& u, int r, int j, const Col& c, const Pre&, f32x4 a0, f32x4 a1, f32x4 b0, f32x4 b1) const {
        const size_t row = (size_t)u.pm * 256 + r;
        a0 += c.c0; a1 += c.c1; b0 += c.c2; b1 += c.c3;
        bf16_t* o = XRC + row * 1024 + u.pn * 256 + j; *(u32x4*)o = pk8(a0, a1); *(u32x4*)(o + 128) = pk8(b0, b1); } };
struct SchG2 { const bf16_t *Aa, *Ab, *Wa, *Wb; int G, c, K;
    __device__ __forceinline__ void a_ready(const Unit&) const {}
    __device__ __forceinline__ void done(const Unit&) const {}
    __device__ __forceinline__ bool next(int i, Unit& u) const { const int t = (i >> 1) * G + c; if (t >= 512) return false; u.pm = t >> 2; u.pn = t & 3; u.aux = i & 1; return true; }
    __device__ __forceinline__ const bf16_t* arow(const Unit& u, int r) const { return Aa + (size_t)u.aux * (SLOT / 2) + (size_t)(u.pm * 256 + r) * 1024; }
    __device__ __forceinline__ const bf16_t* brow(const Unit& u, int n) const { return Wa + (size_t)u.aux * (1024 * 1024) + (size_t)(u.pn * 256 + n) * 1024; }
    __device__ __forceinline__ const char* abase(const Unit& u) const { return (const char*)(Aa + (size_t)u.aux * (SLOT / 2) + (size_t)u.pm * 256 * 1024); }
    __device__ __forceinline__ const char* bbase(const Unit& u) const { return (const char*)(Wa + (size_t)u.aux * (1024 * 1024) + (size_t)u.pn * 256 * 1024); }
    __device__ __forceinline__ unsigned aoff(const Unit&, int) const { return 0u; } };
struct EpiG2 { const bf16_t *SGA, *SGB; bf16_t* M;
    static constexpr int PF = 2; struct Col { }; struct Pre { u32x4 g0, g1, t0, t1; };
    __device__ __forceinline__ Col col(const Unit&, int) const { return Col{}; }
    __device__ __forceinline__ Pre load(const Unit& u, int r, int j) const {
        const size_t o = ((size_t)u.pm * 256 + r) * 1024 + u.pn * 256 + j; const bf16_t* G = SGA + (size_t)u.aux * (SLOT / 2);
        Pre q; q.g0 = *(const u32x4*)(G + o); q.g1 = *(const u32x4*)(G + o + 128);
        if (u.aux) { q.t0 = *(const u32x4*)(M + o); q.t1 = *(const u32x4*)(M + o + 128); } else { q.t0 = (u32x4){0u, 0u, 0u, 0u}; q.t1 = q.t0; }
        return q; }
    __device__ __forceinline__ void apply(const Unit& u, int r, int j, const Col&, const Pre& q, f32x4 a0, f32x4 a1, f32x4 b0, f32x4 b1) const {
        const size_t o = ((size_t)u.pm * 256 + r) * 1024 + u.pn * 256 + j;
        f32x4 g0, g1, g2, g3, t0, t1, t2, t3; unpk8(q.g0, g0, g1); unpk8(q.g1, g2, g3); unpk8(q.t0, t0, t1); unpk8(q.t1, t2, t3);
        a0 = a0 * g0 + t0; a1 = a1 * g1 + t1; b0 = b0 * g2 + t2; b1 = b1 * g3 + t3;
        *(u32x4*)(M + o) = pk8(a0, a1); *(u32x4*)(M + o + 128) = pk8(b0, b1); } };
struct SchG3 { const bf16_t *A, *Bt; int G, c, K;
    __device__ __forceinline__ void a_ready(const Unit&) const {}
    __device__ __forceinline__ void done(const Unit&) const {}
    __device__ __forceinline__ bool next(int i, Unit& u) const { const int L = i * G + c; if (L >= 512) return false; u.pm = L >> 2; u.pn = L & 3; return true; }
    __device__ __forceinline__ const bf16_t* arow(const Unit& u, int r) const { return A + (size_t)(u.pm * 256 + r) * 1024; }
    __device__ __forceinline__ const bf16_t* brow(const Unit& u, int n) const { return Bt + (size_t)(u.pn * 256 + n) * 1024; }
    __device__ __forceinline__ const char* abase(const Unit& u) const { return (const char*)(A + (size_t)u.pm * 256 * 1024); }
    __device__ __forceinline__ const char* bbase(const Unit& u) const { return (const char*)(Bt + (size_t)u.pn * 256 * 1024); }
    __device__ __forceinline__ unsigned aoff(const Unit&, int) const { return 0u; } };
struct EpiG3 { const float *X, *MOD; bf16_t* X1B;
    static constexpr int PF = 3; struct Col { f32x4 c0, c1, c2, c3; }; struct Pre { f32x4 x0, x1, x2, x3; };
    __device__ __forceinline__ Col col(const Unit& u, int j) const { const float* gt = MOD + ((u.pm * 256) / SEQ) * 6144 + 2 * 1024 + u.pn * 256 + j; return Col{*(const f32x4*)gt, *(const f32x4*)(gt + 4), *(const f32x4*)(gt + 128), *(const f32x4*)(gt + 132)}; }
    __device__ __forceinline__ Pre load(const Unit& u, int r, int j) const { const float* xp = X + ((size_t)u.pm * 256 + r) * 1024 + u.pn * 256 + j; return Pre{*(const f32x4*)xp, *(const f32x4*)(xp + 4), *(const f32x4*)(xp + 128), *(const f32x4*)(xp + 132)}; }
    __device__ __forceinline__ void apply(const Unit& u, int r, int j, const Col& c, const Pre& q, f32x4 a0, f32x4 a1, f32x4 b0, f32x4 b1) const {
        bf16_t* op = X1B + ((size_t)u.pm * 256 + r) * 1024 + u.pn * 256 + j;
        *(u32x4*)op = pk8(q.x0 + c.c0 * a0, q.x1 + c.c1 * a1); *(u32x4*)(op + 128) = pk8(q.x2 + c.c2 * b0, q.x3 + c.c3 * b1); } };
struct MoeMeta { const int* m;
    __device__ __forceinline__ int cnt(int e) const { return __builtin_amdgcn_readfirstlane(m[e]); }
    __device__ __forceinline__ int tb(int e) const { return __builtin_amdgcn_readfirstlane(m[16 + e]); }
    __device__ __forceinline__ int ntiles() const { return __builtin_amdgcn_readfirstlane(m[32]); }
    __device__ __forceinline__ int find(int mt) const { int e = 0;
#pragma unroll
        for (int k = 1; k < 16; ++k) e += (__builtin_amdgcn_readfirstlane(m[16 + k]) <= mt) ? 1 : 0;
        return e; } };
__device__ __forceinline__ void moe_meta_build(const Params& p, int* meta) {
    if (threadIdx.x == 0) { const unsigned* cnt = (const unsigned*)(p.ws + OFF_CTL); int t = 0;
        for (int e = 0; e < 16; ++e) { const int c = (int)__hip_atomic_load(cnt + e, __ATOMIC_RELAXED, __HIP_MEMORY_SCOPE_AGENT); meta[e] = c; meta[16 + e] = t; t += (c + 255) >> 8; }
        meta[32] = t; }
    __syncthreads();
}
struct SchUp { const bf16_t *HM, *W; const int* LIST; MoeMeta mm; int G, c, K; const int* idx; unsigned* cntM;
    __device__ __forceinline__ bool next(int i, Unit& u) const { const int L = i * G + c; if (L >= 4 * mm.ntiles()) return false; const int mt = L >> 2; u.pn = L & 3; u.aux = mm.find(mt); u.aux2 = (mt - mm.tb(u.aux)) * 256; u.pm = mt | (i << 16); return true; }
    __device__ __forceinline__ void a_ready(const Unit&) const {}
    __device__ __forceinline__ void done(const Unit& u) const { asm volatile("s_waitcnt vmcnt(0)" ::: "memory");
        if ((threadIdx.x & 63) == 0) __hip_atomic_fetch_add(cntM + (u.pm & 0xffff), 1u, __ATOMIC_RELAXED, __HIP_MEMORY_SCOPE_AGENT); }
    __device__ __forceinline__ const char* abase(const Unit&) const { return (const char*)HM; }
    __device__ __forceinline__ const char* bbase(const Unit& u) const { return (const char*)(W + ((size_t)u.aux * 1024 + u.pn * 256) * 1024); }
    __device__ __forceinline__ unsigned aoff(const Unit& u, int r) const { return (unsigned)idx[(u.pm >> 16) * 256 + r] * 2048u; }
    __device__ __forceinline__ const bf16_t* arow(const Unit& u, int r) const { int pos = u.aux2 + r; const int c = mm.cnt(u.aux); pos = pos < c ? pos : c - 1; return HM + (size_t)LIST[u.aux * NT + pos] * 1024; }
    __device__ __forceinline__ const bf16_t* brow(const Unit& u, int n) const { return W + ((size_t)u.aux * 1024 + u.pn * 256 + n) * 1024; } };
struct EpiUp { bf16_t* ACT; const float* WL; MoeMeta mm;
    static constexpr int PF = 2; struct Col { }; struct Pre { float wt; };
    __device__ __forceinline__ Col col(const Unit&, int) const { return Col{}; }
    __device__ __forceinline__ Pre load(const Unit& u, int r, int) const { const int pos = u.aux2 + r; return Pre{pos < mm.cnt(u.aux) ? WL[u.aux * NT + pos] : 0.f}; }
    __device__ __forceinline__ void apply(const Unit& u, int r, int j, const Col&, const Pre& q, f32x4 g0, f32x4 g1, f32x4 u0, f32x4 u1) const {
        if (u.aux2 + r >= mm.cnt(u.aux)) return;
#pragma unroll
        for (int e = 0; e < 4; ++e) { g0[e] = silu(g0[e]) * u0[e] * q.wt; g1[e] = silu(g1[e]) * u1[e] * q.wt; }
        const __amdgpu_buffer_rsrc_t rsrc = __builtin_amdgcn_make_buffer_rsrc((void*)ACT, 0, 0x7fffffff, 0x00020000);
        __builtin_amdgcn_raw_buffer_store_b128(pk8(g0, g1), rsrc, (int)((((unsigned)(u.pm & 0xffff) * 256u + (unsigned)r) * 512u + (unsigned)(u.pn * 128 + j)) * 2u), 0, 16); } };
struct SchDn { const bf16_t *ACT, *W; MoeMeta mm; int G, c, K; unsigned* cntM; bool waitc;
    __device__ __forceinline__ bool next(int i, Unit& u) const {
        const int D = 4 * mm.ntiles(), umin = D / G, n5 = D - umin * G;
        int xh = (D - 2 * (G - n5)) / G; xh = xh < 0 ? 0 : xh; if (n5 == 0) xh = 0;
        int L;
        if (c < n5) { if (i >= xh) return false; L = c * xh + i; } else { L = n5 * xh + (c - n5) + (G - n5) * i; }
        if (L >= D) return false;
        const int mt = L >> 2; u.pn = L & 3; u.aux = mm.find(mt); u.aux2 = (mt - mm.tb(u.aux)) * 256; u.pm = mt; return true; }
    __device__ __forceinline__ void a_ready(const Unit& u) const {
        if (!waitc) return;
        if (threadIdx.x < 64) { unsigned sp = 0;
            while (__hip_atomic_load(cntM + u.pm, __ATOMIC_RELAXED, __HIP_MEMORY_SCOPE_AGENT) < 32u) { __builtin_amdgcn_s_sleep(2); if (++sp > (1u << 22)) break; }
            __builtin_amdgcn_fence(__ATOMIC_ACQUIRE, "agent");
            asm volatile("s_waitcnt vmcnt(0)" ::: "memory"); }
        asm volatile("" ::: "memory"); __builtin_amdgcn_s_barrier(); asm volatile("" ::: "memory"); }
    __device__ __forceinline__ void done(const Unit&) const {}
    __device__ __forceinline__ const char* abase(const Unit& u) const { return (const char*)(ACT + (size_t)u.pm * 256 * 512); }
    __device__ __forceinline__ const char* bbase(const Unit& u) const { return (const char*)(W + ((size_t)u.aux * 1024 + u.pn * 256) * 512); }
    __device__ __forceinline__ unsigned aoff(const Unit&, int) const { return 0u; } };
struct EpiDn { bf16_t* Y; MoeMeta mm;
    static constexpr int PF = 1; struct Col { }; struct Pre { };
    __device__ __forceinline__ Col col(const Unit&, int) const { return Col{}; }
    __device__ __forceinline__ Pre load(const Unit&, int, int) const { return Pre{}; }
    __device__ __forceinline__ void apply(const Unit& u, int r, int j, const Col&, const Pre&, f32x4 a0, f32x4 a1, f32x4 b0, f32x4 b1) const {
        if (u.aux2 + r >= mm.cnt(u.aux)) return;
        bf16_t* o = Y + ((size_t)u.pm * 256 + r) * 1024 + u.pn * 256 + j; *(u32x4*)o = pk8(a0, a1); *(u32x4*)(o + 128) = pk8(b0, b1); } };

__device__ __forceinline__ void aprep_item(const Params& p, int g, unsigned char* lds, bool have_tile, int g_next) {
    const int tid = threadIdx.x, lane = tid & 63, wave = tid >> 6;
    const bf16_t* Z = (const bf16_t*)(p.ws + OFF_SLOT + 1 * SLOT);
    bf16_t* AA = (bf16_t*)(p.ws + OFF_SLOT + 0 * SLOT) + (size_t)g * 64 * 1024;
    const unsigned* zt = (const unsigned*)lds;
    if (!have_tile) { const u32x4* src = (const u32x4*)(Z + (size_t)g * 64 * 1024); u32x4* d = (u32x4*)lds;
        u32x4 tmp[16];
#pragma unroll
        for (int i = 0; i < 16; ++i) tmp[i] = src[tid + i * NTHR];
#pragma unroll
        for (int i = 0; i < 16; ++i) d[tid + i * NTHR] = tmp[i]; }
    __syncthreads();
    {
        f32x2 w[31];
        const float* cw = p.in[I_CONVW] + 2 * tid;
#pragma unroll
        for (int k = 0; k < 31; ++k) w[k] = *(const f32x2*)(cw + k * 1024);
        const f32x2 cb = *(const f32x2*)(p.in[I_CONVB] + 2 * tid);
#pragma unroll 1
        for (int tb = 0; tb < 4; ++tb) {
            f32x2 cz[16];
#pragma unroll
            for (int o = 0; o < 16; ++o) cz[o] = cb;
#pragma unroll
            for (int r0 = 0; r0 < 48; r0 += 8) {
                unsigned vv[8];
#pragma unroll
                for (int rr = 0; rr < 8; ++rr) if (r0 + rr < 46) { const int row = 16 * tb - 15 + r0 + rr; const bool ok = (unsigned)row < 64u; const unsigned t = zt[(ok ? row : 0) * 512 + tid]; vv[rr] = ok ? t : 0u; }
#pragma unroll
                for (int rr = 0; rr < 8; ++rr) { const int r = r0 + rr;
                    if (r < 46) { const f32x2 x = (f32x2){bflo(vv[rr]), bfhi(vv[rr])};
#pragma unroll
                        for (int o = 0; o < 16; ++o) { const int k = r - o; if (k >= 0 && k < 31) cz[o] += w[k] * x; } } }
            }
#pragma unroll
            for (int o = 0; o < 16; ++o) *(unsigned*)(AA + (size_t)(16 * tb + o) * 1024 + 2 * tid) = pk2(cz[o].x, cz[o].y);
        }
    }
    asm volatile("s_waitcnt vmcnt(0)" ::: "memory");
    __syncthreads();
    u32x4 ntile[16];
    if (g_next >= 0) { const u32x4* src = (const u32x4*)(Z + (size_t)g_next * 64 * 1024);
#pragma unroll
        for (int i = 0; i < 16; ++i) ntile[i] = src[tid + i * NTHR]; }
    f32x4 lg0[2], lg1[2], lb0[2], lb1[2];
#pragma unroll
    for (int hh = 0; hh < 2; ++hh) { const int c0 = hh * 512 + lane * 8;
        lg0[hh] = *(const f32x4*)(p.in[I_LNG] + c0); lg1[hh] = *(const f32x4*)(p.in[I_LNG] + c0 + 4); lb0[hh] = *(const f32x4*)(p.in[I_LNB] + c0); lb1[hh] = *(const f32x4*)(p.in[I_LNB] + c0 + 4); }
#pragma unroll 1
    for (int half = 0; half < 2; ++half) {
        u32x4 ra[4], rb[4];
#pragma unroll
        for (int rr = 0; rr < 4; ++rr) { const bf16_t* rp = AA + (size_t)(wave * 8 + half * 4 + rr) * 1024 + lane * 8; ra[rr] = *(const u32x4*)rp; rb[rr] = *(const u32x4*)(rp + 512); }
#pragma unroll
        for (int rr = 0; rr < 4; ++rr) {
            const int row = wave * 8 + half * 4 + rr;
            f32x4 x0, x1, x2, x3; unpk8(ra[rr], x0, x1); unpk8(rb[rr], x2, x3);
            const f32x4 sv = (x0 + x1) + (x2 + x3);
            const float mean = wave_sum_dpp((sv[0] + sv[1]) + (sv[2] + sv[3])) * (1.0f / 1024.0f);
            x0 -= mean; x1 -= mean; x2 -= mean; x3 -= mean;
            const f32x4 qv = (x0 * x0 + x1 * x1) + (x2 * x2 + x3 * x3);
            const float rstd = rsqrtf(wave_sum_dpp((qv[0] + qv[1]) + (qv[2] + qv[3])) * (1.0f / 1024.0f) + 1e-6f);
            x0 = x0 * rstd * lg0[0] + lb0[0]; x1 = x1 * rstd * lg1[0] + lb1[0]; x2 = x2 * rstd * lg0[1] + lb0[1]; x3 = x3 * rstd * lg1[1] + lb1[1];
#pragma unroll
            for (int e = 0; e < 4; ++e) { x0[e] = silu(x0[e]); x1[e] = silu(x1[e]); x2[e] = silu(x2[e]); x3[e] = silu(x3[e]); }
            bf16_t* o = AA + (size_t)row * 1024 + lane * 8;
            *(u32x4*)o = pk8(x0, x1); *(u32x4*)(o + 512) = pk8(x2, x3);
        }
    }
    if (g_next >= 0) { u32x4* d = (u32x4*)lds;
#pragma unroll
        for (int i = 0; i < 16; ++i) d[tid + i * NTHR] = ntile[i]; }
    __syncthreads();
}

constexpr int XC_STRIDE = 272;
constexpr int YB_STRIDE = 132;
constexpr int B_XC_OFF = 0, B_HIN_OFF = 256 * XC_STRIDE  , B_Y_OFF = B_HIN_OFF + 4096  , B_Y_BYTES = 64 * YB_STRIDE * 4  ;
constexpr size_t OFF_TOT256 = OFF_TOT + 9 * MiB;

__device__ __forceinline__ void lru_coef(float lr2, float li2, float nsp2, float xcv, float& a, float& b) {
    const float r = __builtin_amdgcn_rcpf(1.0f + __builtin_amdgcn_exp2f(lr2));
    a = __builtin_amdgcn_exp2f(nsp2 * r);
    const float v = __builtin_fmaf(-a, a, 1.0f);
    const float d = 1.0f + __builtin_amdgcn_exp2f(li2);
    b = (v * __builtin_amdgcn_rsqf(fmaxf(v * d * d, 1e-30f))) * xcv;
}

template <bool FINAL, int DIR>
__device__ __forceinline__ void lru_dir(const unsigned char* xcs, const bf16x8 (&fbr)[4], const bf16x8 (&fbi)[4], float br, float bi, float nsp, int fr, int q, int chl,
                                        float hin_v, f32x4 (&hout)[4], float& totA, float& totB) {
    f32x4 ar[4], ai[4];
#pragma unroll
    for (int m = 0; m < 4; ++m) { ar[m] = (f32x4){br, br, br, br}; ai[m] = (f32x4){bi, bi, bi, bi}; }
#pragma unroll
    for (int kk = 0; kk < 4; ++kk) {
#pragma unroll
        for (int m = 0; m < 4; ++m) { const bf16x8 fa = *(const bf16x8*)(xcs + (16 * m + fr) * XC_STRIDE + (32 * kk + 8 * q) * 2);
            ar[m] = __builtin_amdgcn_mfma_f32_16x16x32_bf16(fa, fbr[kk], ar[m], 0, 0, 0);
            ai[m] = __builtin_amdgcn_mfma_f32_16x16x32_bf16(fa, fbi[kk], ai[m], 0, 0, 0); }
    }
#pragma unroll
    for (int m = 0; m < 4; ++m)
#pragma unroll
        for (int i = 0; i < 4; ++i) {
            const float xcv = bf2f(*(const bf16_t*)(xcs + (16 * m + 4 * q + i) * XC_STRIDE + chl * 2));
            float a, b; lru_coef(ar[m][i], ai[m][i], nsp, xcv, a, b); ar[m][i] = a; ai[m][i] = b;
        }
    float At[4], Bt[4], Ae[4], Be[4];
#pragma unroll
    for (int m = 0; m < 4; ++m) {
        float A = 1.f, B = 0.f;
#pragma unroll
        for (int ii = 0; ii < 4; ++ii) { const int i = DIR ? 3 - ii : ii; B = ar[m][i] * B + ai[m][i]; A = ar[m][i] * A; }
        if (DIR == 0) {
            float tA = __shfl_up(A, 16), tB = __shfl_up(B, 16); if (q >= 1) { B = A * tB + B; A = A * tA; }
            tA = __shfl_up(A, 32); tB = __shfl_up(B, 32); if (q >= 2) { B = A * tB + B; A = A * tA; }
            Ae[m] = __shfl_up(A, 16); Be[m] = __shfl_up(B, 16); if (q == 0) { Ae[m] = 1.f; Be[m] = 0.f; }
            At[m] = __shfl(A, 48 + fr); Bt[m] = __shfl(B, 48 + fr);
        } else {
            float tA = __shfl_down(A, 16), tB = __shfl_down(B, 16); if (q <= 2) { B = A * tB + B; A = A * tA; }
            tA = __shfl_down(A, 32); tB = __shfl_down(B, 32); if (q <= 1) { B = A * tB + B; A = A * tA; }
            Ae[m] = __shfl_down(A, 16); Be[m] = __shfl_down(B, 16); if (q == 3) { Ae[m] = 1.f; Be[m] = 0.f; }
            At[m] = __shfl(A, fr); Bt[m] = __shfl(B, fr);
        }
    }
    if (!FINAL) {
        float A = 1.f, B = 0.f;
#pragma unroll
        for (int mm = 0; mm < 4; ++mm) { const int m = DIR ? 3 - mm : mm; B = At[m] * B + Bt[m]; A = At[m] * A; }
        totA = A; totB = B;
    } else {
        float hh = hin_v;
#pragma unroll
        for (int mm = 0; mm < 4; ++mm) { const int m = DIR ? 3 - mm : mm;
            float hs = Ae[m] * hh + Be[m];
#pragma unroll
            for (int ii = 0; ii < 4; ++ii) { const int i = DIR ? 3 - ii : ii; hs = ar[m][i] * hs + ai[m][i]; hout[m][i] = hs; }
            hh = At[m] * hh + Bt[m];
        }
    }
}

template <bool FINAL>
__device__ __forceinline__ void b_phase(const Params& p, int bid, int nb, unsigned char* lds) {
    const int tid = threadIdx.x, lane = tid & 63, wave = tid >> 6, fr = lane & 15, q = lane >> 4;
    f32x2* TOT = (f32x2*)(p.ws + OFF_TOT);
    f32x2* TOT256 = (f32x2*)(p.ws + OFF_TOT256);
    const bf16_t* WG = (const bf16_t*)(p.ws + OFF_WG);
    float* hin = (float*)(lds + B_HIN_OFF);
    const int chl = 16 * wave + fr;
    const int nitems = FINAL ? 1024 : 1024 + 128;
    int hprev = -1;
    bf16x8 fb[4][4];
    float* cst = (float*)(lds + B_Y_OFF + 2 * B_Y_BYTES);
    for (int it = bid; it < nitems; it += nb) {
        const bool isctx = it >= 1024;
        const int b = isctx ? (it - 1024) >> 5 : it >> 8, c256 = isctx ? -1 : (it >> 3) & 31, h = it & 7, csub = (it >> 3) & 3;
        const int seqlen = isctx ? CTXL : SEQ, sbase = isctx ? 0 : c256 * 256;
        const bf16_t* src = isctx ? (const bf16_t*)(p.ws + OFF_XRC) + (size_t)b * CTXL * 1024 : (const bf16_t*)(p.ws + OFF_SLOT + 3 * SLOT) + (size_t)b * SEQ * 1024;
        const int kc0 = isctx ? 0 : 4 + c256 * 4, k256 = isctx ? 0 : 1 + c256;
        const int ch = h * 128 + chl;
        if (h != hprev) {
            hprev = h;
#pragma unroll
            for (int ty = 0; ty < 4; ++ty)
#pragma unroll
                for (int kk = 0; kk < 4; ++kk) fb[ty][kk] = *(const bf16x8*)(WG + (size_t)(h * 512 + wave * 64 + ty * 16 + fr) * 128 + 32 * kk + 8 * q);
            if (q == 0) { const float L2E = 1.4426950408889634f;
                          cst[0 * 128 + chl] = -L2E * p.in[I_BRF][ch]; cst[1 * 128 + chl] = -L2E * p.in[I_BIF][ch]; cst[2 * 128 + chl] = -8.0f * L2E * log1pf(__expf(-p.in[I_LAMF][ch]));
                          cst[3 * 128 + chl] = -L2E * p.in[I_BRB][ch]; cst[4 * 128 + chl] = -L2E * p.in[I_BIB][ch]; cst[5 * 128 + chl] = -8.0f * L2E * log1pf(__expf(-p.in[I_LAMB][ch])); }
            wave_lds_sync();
        }
        float runAf = 1.f, runBf = 0.f, runAb = 1.f, runBb = 0.f;
        {
            const int cgp = tid & 15, c0 = h * 128 + 8 * cgp;
            float wk[4][8], bs[8];
            { const f32x4* bp = (const f32x4*)(p.in[I_LCB] + c0); const f32x4 t0_ = bp[0], t1_ = bp[1];
                bs[0] = t0_[0]; bs[1] = t0_[1]; bs[2] = t0_[2]; bs[3] = t0_[3]; bs[4] = t1_[0]; bs[5] = t1_[1]; bs[6] = t1_[2]; bs[7] = t1_[3];
#pragma unroll
                for (int k = 0; k < 4; ++k) { const f32x4* wp = (const f32x4*)(p.in[I_LCW] + k * 1024 + c0); const f32x4 w0 = wp[0], w1 = wp[1];
                    wk[k][0] = w0[0]; wk[k][1] = w0[1]; wk[k][2] = w0[2]; wk[k][3] = w0[3]; wk[k][4] = w1[0]; wk[k][5] = w1[1]; wk[k][6] = w1[2]; wk[k][7] = w1[3]; } }
#pragma unroll 1
            for (int ps = 0; ps < (isctx ? 1 : 2); ++ps) {
                if (isctx && tid >= 256) break;
                const int tq = isctx ? csub * 64 + (tid >> 4) * 4 : ps * 128 + (tid >> 4) * 4;
                float xc[4][8];
#pragma unroll
                for (int r = 0; r < 4; ++r)
#pragma unroll
                    for (int e = 0; e < 8; ++e) xc[r][e] = bs[e];
#pragma unroll
                for (int rr = 0; rr < 7; ++rr) {
                    const int row = sbase + tq + rr - 2;
                    u32x4 a = (u32x4){0u, 0u, 0u, 0u};
                    if (row >= 0 && row < seqlen) a = *(const u32x4*)(src + (size_t)row * 1024 + c0);
                    const float x[8] = {bflo(a.x), bfhi(a.x), bflo(a.y), bfhi(a.y), bflo(a.z), bfhi(a.z), bflo(a.w), bfhi(a.w)};
#pragma unroll
                    for (int r = 0; r < 4; ++r) { const int k = rr - r;
                        if (k >= 0 && k < 4) {
#pragma unroll
                            for (int e = 0; e < 8; ++e) xc[r][e] += wk[k][e] * x[e]; } }
                }
#pragma unroll
                for (int r = 0; r < 4; ++r) {
                    u32x4 o0; o0.x = pk2(xc[r][0], xc[r][1]); o0.y = pk2(xc[r][2], xc[r][3]); o0.z = pk2(xc[r][4], xc[r][5]); o0.w = pk2(xc[r][6], xc[r][7]);
                    *(u32x4*)(lds + B_XC_OFF + (tq + r) * XC_STRIDE + cgp * 16) = o0;
                }
            }
        }
        f32x2 ct[33], cs[4];
        const int cdir = (tid >> 7) & 1, ccl = tid & 127;
        if (FINAL && tid < 256) {
            const f32x2* T2 = TOT256 + ((size_t)b * 33 * 2 + cdir) * 1024 + h * 128 + ccl;
            const f32x2* T = TOT + ((size_t)b * NCH64 * 2 + cdir) * 1024 + h * 128 + ccl;
#pragma unroll
            for (int k = 1; k < 33; ++k) { const bool use = cdir == 0 ? (k < k256) : (k > k256); ct[k] = use ? T2[(size_t)k * 2048] : (f32x2){1.f, 0.f}; }
            { f32x2 c4[4];
#pragma unroll
                for (int s_ = 0; s_ < 4; ++s_) c4[s_] = T[(size_t)s_ * 2048];
                float A = 1.f, B = 0.f;
#pragma unroll
                for (int s_ = 0; s_ < 4; ++s_) { const f32x2 t = cdir == 0 ? c4[s_] : c4[3 - s_]; B = t.x * B + t.y; A = t.x * A; }
                ct[0] = (f32x2){A, B}; }
#pragma unroll
            for (int s_ = 0; s_ < 4; ++s_) cs[s_] = T[(size_t)(kc0 + s_) * 2048];
        }
        if (FINAL && tid < 256) {
            float hc = 0.f;
            if (cdir == 0) {
#pragma unroll
                for (int k = 0; k < 33; ++k) hc = ct[k].x * hc + ct[k].y;
#pragma unroll
                for (int s_ = 0; s_ < 4; ++s_) { hin[(s_ * 2 + 0) * 128 + ccl] = hc; hc = cs[s_].x * hc + cs[s_].y; }
            } else {
                hc = ct[0].y;
#pragma unroll
                for (int k = 32; k >= 1; --k) hc = ct[k].x * hc + ct[k].y;
#pragma unroll
                for (int s_ = 3; s_ >= 0; --s_) { hin[(s_ * 2 + 1) * 128 + ccl] = hc; hc = cs[s_].x * hc + cs[s_].y; }
            }
        }
        __syncthreads();
        for (int sub = isctx ? csub : 0; sub < (isctx ? csub + 1 : 4); ++sub) {
            const int t0 = sbase + 64 * sub;
            const unsigned char* xcs = lds + B_XC_OFF + 64 * sub * XC_STRIDE;
            f32x4 hf[4], hb[4]; float tA, tB;
            lru_dir<FINAL, 0>(xcs, fb[0], fb[1], cst[0 * 128 + chl], cst[1 * 128 + chl], cst[2 * 128 + chl], fr, q, chl, FINAL ? hin[(sub * 2 + 0) * 128 + chl] : 0.f, hf, tA, tB);
            if (!FINAL) { if (q == 0) TOT[((size_t)(b * NCH64 + kc0 + sub) * 2 + 0) * 1024 + ch] = (f32x2){tA, tB};
                runBf = tA * runBf + tB; runAf = tA * runAf; }
            u32x4 gy0, gy1;
            if (FINAL) { const bf16_t* GYG = (const bf16_t*)(p.ws + OFF_SLOT + 2 * SLOT) + ((size_t)b * SEQ + t0 + lane) * 1024 + h * 128 + 16 * wave;
                gy0 = *(const u32x4*)GYG; gy1 = *(const u32x4*)(GYG + 8); }
            lru_dir<FINAL, 1>(xcs, fb[2], fb[3], cst[3 * 128 + chl], cst[4 * 128 + chl], cst[5 * 128 + chl], fr, q, chl, FINAL ? hin[(sub * 2 + 1) * 128 + chl] : 0.f, hb, tA, tB);
            if (!FINAL) { if (q == 0) TOT[((size_t)(b * NCH64 + kc0 + sub) * 2 + 1) * 1024 + ch] = (f32x2){tA, tB};
                runBb = runAb * tB + runBb; runAb = runAb * tA; }
            if (FINAL) {
                float* wy = (float*)(lds + B_Y_OFF) + wave * (64 * 20);
#pragma unroll
                for (int m = 0; m < 4; ++m)
#pragma unroll
                    for (int i = 0; i < 4; ++i) wy[(16 * m + 4 * q + i) * 20 + fr] = hf[m][i] + hb[m][i];
                wave_lds_sync();
                const f32x4* yp = (const f32x4*)(wy + lane * 20);
                const f32x4 y0 = yp[0], y1 = yp[1], y2 = yp[2], y3 = yp[3];
                u32x4 o0, o1;
                o0.x = pk2(bflo(gy0.x) * y0[0], bfhi(gy0.x) * y0[1]); o0.y = pk2(bflo(gy0.y) * y0[2], bfhi(gy0.y) * y0[3]);
                o0.z = pk2(bflo(gy0.z) * y1[0], bfhi(gy0.z) * y1[1]); o0.w = pk2(bflo(gy0.w) * y1[2], bfhi(gy0.w) * y1[3]);
                o1.x = pk2(bflo(gy1.x) * y2[0], bfhi(gy1.x) * y2[1]); o1.y = pk2(bflo(gy1.y) * y2[2], bfhi(gy1.y) * y2[3]);
                o1.z = pk2(bflo(gy1.z) * y3[0], bfhi(gy1.z) * y3[1]); o1.w = pk2(bflo(gy1.w) * y3[2], bfhi(gy1.w) * y3[3]);
                bf16_t* AB = (bf16_t*)(p.ws + OFF_SLOT + 1 * SLOT) + ((size_t)b * SEQ + t0 + lane) * 1024 + h * 128 + 16 * wave;
                *(u32x4*)AB = o0; *(u32x4*)(AB + 8) = o1;
                wave_lds_sync();
            }
        }
        __syncthreads();
        if (!FINAL && q == 0 && !isctx) {
            TOT256[((size_t)(b * 33 + k256) * 2 + 0) * 1024 + ch] = (f32x2){runAf, runBf};
            TOT256[((size_t)(b * 33 + k256) * 2 + 1) * 1024 + ch] = (f32x2){runAb, runBb};
        }
    }
}

__device__ __forceinline__ void ph8_route(const Params& p, int bid, int nb, unsigned char* lds) {
    constexpr int NU = 1;
    const int tid = threadIdx.x, lane = tid & 63, wave = tid >> 6;
    float* Wl = (float*)lds;
    int* lcnt = (int*)(lds + 81920);
    int* lbase = lcnt + 16;
    int* tinfo = lcnt + 32;
    float* twt = (float*)(tinfo + 512);
#pragma unroll 1
    for (int kk = 0; kk < 2; ++kk) { const int k = tid + kk * NTHR;
        const f32x4 wg = *(const f32x4*)(p.in[I_WGRP] + k * 4);
        Wl[0 * 1024 + k] = wg[0]; Wl[1 * 1024 + k] = wg[1]; Wl[2 * 1024 + k] = wg[2]; Wl[3 * 1024 + k] = wg[3];
#pragma unroll
        for (int o4 = 0; o4 < 4; ++o4) { const f32x4 we = *(const f32x4*)(p.in[I_WER] + k * 16 + o4 * 4);
            Wl[(4 + o4 * 4 + 0) * 1024 + k] = we[0]; Wl[(4 + o4 * 4 + 1) * 1024 + k] = we[1]; Wl[(4 + o4 * 4 + 2) * 1024 + k] = we[2]; Wl[(4 + o4 * 4 + 3) * 1024 + k] = we[3]; } }
    __syncthreads();
    const float* MOD = (const float*)(p.ws + OFF_MOD);
    const bf16_t* X1B = (const bf16_t*)(p.ws + OFF_SLOT + 5 * SLOT);
    bf16_t* HM = (bf16_t*)(p.ws + OFF_SLOT + 2 * SLOT);
    unsigned* gcnt = (unsigned*)(p.ws + OFF_CTL);
    int* LIST = (int*)(p.ws + OFF_LIST); float* WLs = (float*)(p.ws + OFF_WL); int* ROUTE = (int*)(p.ws + OFF_ROUTE);
    float* bl = (float*)(lds + 81920 + 8192);
    if (tid < 20) bl[tid] = tid < 4 ? p.in[I_BGRP][tid] : p.in[I_BER][tid - 4];
    __syncthreads();
    for (int tile = bid; tile < NT / 128; tile += nb) {
        if (tid < 16) lcnt[tid] = 0;
        __syncthreads();
        const float* mrow = MOD + ((tile * 128) / SEQ) * 6144;
        f32x4 gq[4], shq[4], scq[4];
#pragma unroll
        for (int j = 0; j < 4; ++j) { const int c = lane * 4 + 256 * j; gq[j] = *(const f32x4*)(p.in[I_GFFN] + c); shq[j] = *(const f32x4*)(mrow + 3 * 1024 + c); scq[j] = *(const f32x4*)(mrow + 4 * 1024 + c); gq[j] = gq[j] * (1.0f + scq[j]); }
        u32x2 nx[4];
#pragma unroll
        for (int j = 0; j < 4; ++j) nx[j] = *(const u32x2*)(X1B + (size_t)(tile * 128 + wave * 16) * DM + lane * 4 + 256 * j);
#pragma unroll 1
        for (int tt = 0; tt < 16; tt += NU) {
            const int tl = wave * 16 + tt, tok = tile * 128 + tl;
            f32x4 v[NU][4]; float ss[NU];
#pragma unroll
            for (int u = 0; u < NU; ++u) ss[u] = 0.f;
#pragma unroll
            for (int j = 0; j < 4; ++j) { v[0][j] = (f32x4){bflo(nx[j].x), bfhi(nx[j].x), bflo(nx[j].y), bfhi(nx[j].y)}; const f32x4 sq = v[0][j] * v[0][j]; ss[0] += (sq[0] + sq[1]) + (sq[2] + sq[3]); }
            { const int tn = tt + 1 < 16 ? tok + 1 : tok;
#pragma unroll
                for (int j = 0; j < 4; ++j) nx[j] = *(const u32x2*)(X1B + (size_t)tn * DM + lane * 4 + 256 * j); }
            float lg[NU][20];
#pragma unroll
            for (int u = 0; u < NU; ++u) { const float rinv = rsqrtf(wave_sum_dpp(ss[u]) * (1.0f / DM) + 1e-6f);
#pragma unroll
                for (int j = 0; j < 4; ++j) { v[u][j] = v[u][j] * rinv * gq[j] + shq[j]; *(u32x2*)(HM + (size_t)(tok + u) * DM + lane * 4 + 256 * j) = pk4(v[u][j]); }
}
#pragma unroll
            for (int o = 0; o < 20; ++o)
            { f32x4 wv[4];
#pragma unroll
                for (int j = 0; j < 4; ++j) wv[j] = *(const f32x4*)(Wl + o * 1024 + lane * 4 + 256 * j);
#pragma unroll
                for (int u = 0; u < NU; ++u) { f32x4 pr = v[u][0] * wv[0]; pr += v[u][1] * wv[1]; pr += v[u][2] * wv[2]; pr += v[u][3] * wv[3]; lg[u][o] = (pr[0] + pr[1]) + (pr[2] + pr[3]); }
                if ((o & 3) == 3) asm volatile("" ::: "memory"); }
#pragma unroll
            for (int u = 0; u < NU; ++u) {
#pragma unroll
                for (int o = 0; o < 20; ++o) lg[u][o] = wave_sum_dpp(lg[u][o]) + bl[o];
                int gs = 0; float gm = lg[u][0];
#pragma unroll
                for (int o = 1; o < 4; ++o) if (lg[u][o] > gm) { gm = lg[u][o]; gs = o; }
                float den = 0.f;
#pragma unroll
                for (int o = 0; o < 4; ++o) den += __expf(lg[u][o] - gm);
                const float pg = 1.0f / den;
                float el[4];
#pragma unroll
                for (int o = 0; o < 4; ++o) el[o] = gs == 0 ? lg[u][4 + o] : gs == 1 ? lg[u][8 + o] : gs == 2 ? lg[u][12 + o] : lg[u][16 + o];
                int i1 = 0; float v1 = el[0];
#pragma unroll
                for (int o = 1; o < 4; ++o) if (el[o] > v1) { v1 = el[o]; i1 = o; }
                int i2 = -1; float v2 = -3.0e38f;
#pragma unroll
                for (int o = 0; o < 4; ++o) if (o != i1 && el[o] > v2) { v2 = el[o]; i2 = o; }
                const float w1 = 1.0f / (1.0f + __expf(v2 - v1)), w2 = 1.0f - w1;
                if (lane == 0) { const int e1 = gs * 4 + i1, e2 = gs * 4 + i2;
                    const int r1 = atomicAdd(&lcnt[e1], 1), r2 = atomicAdd(&lcnt[e2], 1);
                    tinfo[(tl + u) * 4 + 0] = e1; tinfo[(tl + u) * 4 + 1] = r1; tinfo[(tl + u) * 4 + 2] = e2; tinfo[(tl + u) * 4 + 3] = r2; twt[(tl + u) * 2] = pg * w1; twt[(tl + u) * 2 + 1] = pg * w2; }
            }
        }
        __syncthreads();
        if (tid < 16) lbase[tid] = (int)__hip_atomic_fetch_add(gcnt + tid, (unsigned)lcnt[tid], __ATOMIC_RELAXED, __HIP_MEMORY_SCOPE_AGENT);
        __syncthreads();
        if (tid < 128) { const int tok = tile * 128 + tid;
            const int e1 = tinfo[tid * 4], e2 = tinfo[tid * 4 + 2], p1 = lbase[e1] + tinfo[tid * 4 + 1], p2 = lbase[e2] + tinfo[tid * 4 + 3];
            LIST[e1 * NT + p1] = tok; LIST[e2 * NT + p2] = tok; WLs[e1 * NT + p1] = twt[tid * 2]; WLs[e2 * NT + p2] = twt[tid * 2 + 1];
            ROUTE[tok * 4 + 0] = e1; ROUTE[tok * 4 + 1] = p1; ROUTE[tok * 4 + 2] = e2; ROUTE[tok * 4 + 3] = p2; }
        __syncthreads();
    }
}

__device__ __forceinline__ void ph10_final(const Params& p, int bid, int nb, const int* meta) {
    const int lane = threadIdx.x & 63, wave = threadIdx.x >> 6;
    const float* MOD = (const float*)(p.ws + OFF_MOD);
    const bf16_t* Y = (const bf16_t*)(p.ws + OFF_SLOT);
    const int* ROUTE = (const int*)(p.ws + OFF_ROUTE);
    const bf16_t* X1B = (const bf16_t*)(p.ws + OFF_SLOT + 5 * SLOT); float* OUT = p.out;
    const int r0 = bid * 8 + wave, rs = nb * 8;
    f32x4 gf[4], gtv[4]; int mprev = -1;
#pragma unroll
    for (int j = 0; j < 4; ++j) gf[j] = *(const f32x4*)(p.in[I_GFINAL] + lane * 4 + 256 * j);
    auto yrow = [&](int r, int k) -> const bf16_t* { const int e = ROUTE[r * 4 + 2 * k], pp = ROUTE[r * 4 + 2 * k + 1]; return Y + ((size_t)meta[16 + e] * 256 + pp) * 1024; };
    u32x2 nx[4], na[4], nb2[4];
    const bf16_t *ya = yrow(r0, 0), *yb = yrow(r0, 1);
#pragma unroll
    for (int j = 0; j < 4; ++j) { const int c = lane * 4 + 256 * j; nx[j] = *(const u32x2*)(X1B + (size_t)r0 * DM + c); na[j] = *(const u32x2*)(ya + c); nb2[j] = *(const u32x2*)(yb + c); }
    { const int rn = r0 + rs < NT ? r0 + rs : r0; ya = yrow(rn, 0); yb = yrow(rn, 1); }
#pragma unroll 1
    for (int r = r0; r < NT; r += rs) {
        const int mb = r / SEQ;
        if (mb != mprev) { mprev = mb;
#pragma unroll
            for (int j = 0; j < 4; ++j) gtv[j] = *(const f32x4*)(MOD + mb * 6144 + 5 * 1024 + lane * 4 + 256 * j); }
        f32x4 v[4]; float ss = 0.f;
#pragma unroll
        for (int j = 0; j < 4; ++j) {
            v[j] = (f32x4){bflo(nx[j].x), bfhi(nx[j].x), bflo(nx[j].y), bfhi(nx[j].y)};
            const f32x4 ys = (f32x4){bflo(na[j].x) + bflo(nb2[j].x), bfhi(na[j].x) + bfhi(nb2[j].x), bflo(na[j].y) + bflo(nb2[j].y), bfhi(na[j].y) + bfhi(nb2[j].y)};
            v[j] += gtv[j] * ys; const f32x4 sq = v[j] * v[j]; ss += (sq[0] + sq[1]) + (sq[2] + sq[3]); }
        { const int rn = r + rs < NT ? r + rs : r;
#pragma unroll
            for (int j = 0; j < 4; ++j) { const int c = lane * 4 + 256 * j; nx[j] = *(const u32x2*)(X1B + (size_t)rn * DM + c); na[j] = *(const u32x2*)(ya + c); nb2[j] = *(const u32x2*)(yb + c); }
            const int rn2 = r + 2 * rs < NT ? r + 2 * rs : rn; ya = yrow(rn2, 0); yb = yrow(rn2, 1); }
        const float rinv = rsqrtf(wave_sum_dpp(ss) * (1.0f / DM) + 1e-6f);
#pragma unroll
        for (int j = 0; j < 4; ++j) *(f32x4*)(OUT + (size_t)r * DM + lane * 4 + 256 * j) = v[j] * rinv * gf[j];
    }
}

#define XB_TMO      128
#define XB_XCNT(j)  (256  + 64 * (j))
#define XB_XSUB(j)  (1280 + 64 * (j))
#define XB_XGEN(j)  (2304 + 64 * (j))
#define XB_TOP      3328
#define XB_TOPGEN   3392
#define XCD_BAR_WORDS 3456
#define XB_SPIN_CAP (1u << 18)
__device__ __forceinline__ unsigned xb_ld(unsigned* p)              { return __hip_atomic_load(p, __ATOMIC_RELAXED, __HIP_MEMORY_SCOPE_AGENT); }
__device__ __forceinline__ unsigned xb_add(unsigned* p, unsigned v) { return __hip_atomic_fetch_add(p, v, __ATOMIC_RELAXED, __HIP_MEMORY_SCOPE_AGENT); }
__device__ __forceinline__ unsigned xb_xcc_id() { return (unsigned)__builtin_amdgcn_s_getreg((3 << 11) | 20) & 0xFu; }
#define XB_SPIN(cond, bar) do { unsigned _sp = 0; while (cond) { __builtin_amdgcn_s_sleep(1); \
    if ((++_sp & 255u) == 0u) { if (xb_ld(&(bar)[XB_TMO])) break; if (_sp > XB_SPIN_CAP) { atomicAdd(&(bar)[XB_TMO], 1u); break; } } } } while (0)
struct XcdBarrier { unsigned* bar; unsigned x; volatile unsigned* st; };
__device__ __forceinline__ XcdBarrier xcd_barrier_post(unsigned* bar, volatile unsigned* st) {
    XcdBarrier b; b.bar = bar; b.x = xb_xcc_id(); b.st = st;
    if (threadIdx.x == 0) (void)xb_add(&bar[XB_XCNT(b.x)], 1u);
    return b;
}
__device__ __forceinline__ void xcd_barrier_complete(unsigned* bar, unsigned x, unsigned& nloc, unsigned& nx) {
    const unsigned G = gridDim.x * gridDim.y * gridDim.z;
    unsigned sum, cnt, mine, sp = 0u;
    for (;;) {
        sum = 0u; cnt = 0u; mine = 0u;
#pragma unroll
        for (unsigned j = 0; j < 16; ++j) { const unsigned c = xb_ld(&bar[XB_XCNT(j)]); sum += c; cnt += (c > 0u) ? 1u : 0u; mine = (j == x) ? c : mine; }
        if (sum == G) break;
        __builtin_amdgcn_s_sleep(1);
        if ((++sp & 255u) == 0u) { if (xb_ld(&bar[XB_TMO])) break; if (sp > XB_SPIN_CAP) { atomicAdd(&bar[XB_TMO], 1u); break; } }
    }
    nloc = mine > 0u ? mine : 1u; nx = cnt > 0u ? cnt : 1u;
}
__device__ __forceinline__ void xcd_barrier(const XcdBarrier& b) {
    asm volatile("s_waitcnt vmcnt(0)" ::: "memory");
    __syncthreads();
    if (threadIdx.x == 0) {
        unsigned* bar = b.bar;
        __builtin_amdgcn_s_waitcnt(0);
        unsigned nloc = b.st[0], nx = b.st[1];
        if (nloc == 0u) { xcd_barrier_complete(bar, b.x, nloc, nx); b.st[0] = nloc; b.st[1] = nx; }
        const unsigned old = xb_add(&bar[XB_XSUB(b.x)], 1u);
        const unsigned gen = old / nloc;
        if (old + 1u == (gen + 1u) * nloc) {
            __builtin_amdgcn_fence(__ATOMIC_RELEASE, "agent");
            asm volatile("s_waitcnt vmcnt(0)" ::: "memory");
            const unsigned og = xb_add(&bar[XB_TOP], 1u);
            const unsigned tg = og / nx;
            if (og + 1u == (tg + 1u) * nx) xb_add(&bar[XB_TOPGEN], 1u);
            else XB_SPIN(xb_ld(&bar[XB_TOPGEN]) == tg, bar);
            __builtin_amdgcn_fence(__ATOMIC_ACQUIRE, "agent");
            xb_add(&bar[XB_XGEN(b.x)], 1u);
            asm volatile("s_waitcnt vmcnt(0)" ::: "memory");
        } else {
            XB_SPIN(xb_ld(&bar[XB_XGEN(b.x)]) == gen, bar);
            __builtin_amdgcn_fence(__ATOMIC_ACQUIRE, "agent");
            asm volatile("s_waitcnt vmcnt(0)" ::: "memory");
        }
    }
    __syncthreads();
}
constexpr size_t OFF_BAR = OFF_CTL + 4096;

__global__ void __launch_bounds__(NTHR) mega(Params p, int lo, int hi) {
    extern __shared__ __attribute__((aligned(16))) unsigned char lds[];
    cg::grid_group grid = cg::this_grid();
    const int bid = blockIdx.x, nb = gridDim.x;
    unsigned char* ws = p.ws;
    bf16_t* S0 = (bf16_t*)(ws + OFF_SLOT), *S1 = (bf16_t*)(ws + OFF_SLOT + SLOT), *S2 = (bf16_t*)(ws + OFF_SLOT + 2 * SLOT), *S3 = (bf16_t*)(ws + OFF_SLOT + 3 * SLOT),
           *S4 = (bf16_t*)(ws + OFF_SLOT + 4 * SLOT), *S5 = (bf16_t*)(ws + OFF_SLOT + 5 * SLOT);
    const float* MOD = (const float*)(ws + OFF_MOD); const float* BINP = (const float*)(ws + OFF_BINP);
    int* meta = (int*)(lds + LDS_BYTES - 256);
#ifndef PHMASK
#define PHMASK 0x7ff
#endif
#define IN(k) (((PHMASK >> (k)) & 1) && lo <= (k) && (k) < hi)
#ifndef PIPE_MASK
#define PIPE_MASK 0x364
#endif
#define GEMM_RUN(k, gather, s, e) gemm_phase_pipe<gather>(lds, s, e)
    volatile unsigned* xst = (volatile unsigned*)(lds + LDS_BYTES - 16);
    if (threadIdx.x < 2) xst[threadIdx.x] = 0u;
    __syncthreads();
    XcdBarrier xbar; xbar.bar = (unsigned*)(ws + OFF_BAR); xbar.x = 0; xbar.st = xst;
    if (hi - lo > 1) xbar = xcd_barrier_post((unsigned*)(ws + OFF_BAR), xst);
    if (p.pv == 0x7eadbeef) grid.sync();
#define SEAM(k) do { if (IN(k) && IN((k) + 1)) xcd_barrier(xbar); } while (0)
    if (IN(0)) { ph0_prep(p, bid, nb, lds); } SEAM(0);
    if (IN(1)) { if (ph1_norm(p, bid, nb)) { SchCtx s{(const bf16_t*)(ws + OFF_HC), (const bf16_t*)(ws + OFF_WIN), CTX_GEMM_WGS, bid, 1024}; EpiCtx e{(bf16_t*)(ws + OFF_XRC), BINP}; GEMM_RUN(1, false, s, e); } } SEAM(1);
    if (IN(2)) {
        if (nb < 4 * CTX_GEMM_WGS) { SchCtx s{(const bf16_t*)(ws + OFF_HC), (const bf16_t*)(ws + OFF_WIN), nb, bid, 1024}; EpiCtx e{(bf16_t*)(ws + OFF_XRC), BINP}; GEMM_RUN(2, false, s, e); }
        { SchG1 s{S0, (const bf16_t*)(ws + OFF_WIN), nb, bid, 1024}; EpiG1 e{S1, S2, S3, S4, S5, BINP}; GEMM_RUN(2, false, s, e); }
    } SEAM(2);
    if (IN(3)) {
#ifndef NO_APREP
        { bool have = false; for (int g = bid; g < 512; g += nb) { const int gn = g + nb < 512 ? g + nb : -1; aprep_item(p, g, lds, have, gn); have = gn >= 0; } }
#endif
#ifndef NO_BLOCAL
        b_phase<false>(p, bid, nb, lds);
#endif
    } SEAM(3);
    if (IN(4)) {
        if (!(bid & 1)) { prep_items(p, PREP_EARLY, PREP_ALL, bid * 8 + (int)(threadIdx.x >> 6), nb * 8, lds); __syncthreads(); }
        b_phase<true>(p, bid, nb, lds);
        if (bid & 1) { __syncthreads(); prep_items(p, PREP_EARLY, PREP_ALL, bid * 8 + (int)(threadIdx.x >> 6), nb * 8, lds); }
    } SEAM(4);
    if (IN(5)) { SchG2 s{S0, S1, (const bf16_t*)(ws + OFF_WPA), (const bf16_t*)(ws + OFF_WPB), nb, bid, 1024}; EpiG2 e{S4, S5, S3}; GEMM_RUN(5, false, s, e); } SEAM(5);
    if (IN(6)) { SchG3 s{S3, (const bf16_t*)(ws + OFF_WO), nb, bid, 1024}; EpiG3 e{p.in[I_X], MOD, S5}; GEMM_RUN(6, false, s, e); } SEAM(6);
    if (IN(7)) { ph8_route(p, bid, nb, lds); } SEAM(7);
    if (IN(8)) { __syncthreads(); moe_meta_build(p, meta); MoeMeta mm{meta};
        int* idx = (int*)(lds + STAGE_BYTES);
        SchUp s{S2, (const bf16_t*)(ws + OFF_WGU), (const int*)(ws + OFF_LIST), mm, nb, bid, 1024, idx, (unsigned*)(ws + OFF_CTL) + 64}; EpiUp e{S3, (const float*)(ws + OFF_WL), mm};
        { int iv[8]; bool ok[8];
#pragma unroll
            for (int i = 0; i < 8; ++i) { Unit u; ok[i] = s.next(i, u); iv[i] = 0;
                if (ok[i] && threadIdx.x < 256) { int pos = u.aux2 + (int)threadIdx.x; const int c = mm.cnt(u.aux); pos = pos < c ? pos : c - 1; iv[i] = s.LIST[u.aux * NT + pos]; } }
#pragma unroll
            for (int i = 0; i < 8; ++i) if (ok[i] && threadIdx.x < 256) idx[i * 256 + threadIdx.x] = iv[i]; }
        __syncthreads();
        GEMM_RUN(8, true, s, e); }
    if (IN(9)) { __syncthreads(); moe_meta_build(p, meta); MoeMeta mm{meta};
        SchDn s{S3, (const bf16_t*)(ws + OFF_WDN), mm, nb, bid, 512, (unsigned*)(ws + OFF_CTL) + 64, IN(8)}; EpiDn e{S0, mm}; GEMM_RUN(9, false, s, e); } SEAM(9);
    if (IN(10)) { __syncthreads(); moe_meta_build(p, meta); ph10_final(p, bid, nb, meta); }
#undef IN
#undef SEAM
}

extern "C" void kernel_launch(void* const* d_in, const int* in_sizes, int n_in, void* d_out, int out_size, void* d_ws, size_t ws_size, hipStream_t stream) {
    static int grid = 0;
    if (grid == 0) {
        if (n_in != 37 || out_size != NT * DM || ws_size < WS_END) { fprintf(stderr, "kernel_launch: unexpected shapes: n_in %d out %d ws %zu (need %zu)\n", n_in, out_size, ws_size, (size_t)WS_END); grid = -1; return; }
        int dev = 0, cus = 0, per_cu = 0;
        (void)hipGetDevice(&dev); (void)hipDeviceGetAttribute(&cus, hipDeviceAttributeMultiprocessorCount, dev);
        if (hipFuncSetAttribute((const void*)mega, hipFuncAttributeMaxDynamicSharedMemorySize, LDS_BYTES) != hipSuccess) { fprintf(stderr, "kernel_launch: hipFuncSetAttribute failed\n"); grid = -1; return; }
        if (hipOccupancyMaxActiveBlocksPerMultiprocessor(&per_cu, (const void*)mega, NTHR, LDS_BYTES) != hipSuccess || per_cu < 1) { fprintf(stderr, "kernel_launch: occupancy query says %d\n", per_cu); per_cu = 1; }
        (void)hipGetLastError();
        grid = cus * 1;
        fprintf(stderr, "kernel_launch: grid %d (cus %d, per_cu %d)\n", grid, cus, per_cu);
    }
    if (grid < 0) return;
    Params p{};
    for (int i = 0; i < 37; ++i) p.in[i] = (const float*)d_in[i];
    p.out = (float*)d_out; p.ws = (unsigned char*)d_ws;
#if ONE_LAUNCH
    (void)hipMemsetAsync((unsigned char*)d_ws + OFF_BAR, 0, XCD_BAR_WORDS * 4, stream);
    int lo = 0, hi = NPHASE; void* args[] = {&p, &lo, &hi};
    hipError_t e = hipLaunchCooperativeKernel((const void*)mega, dim3(grid), dim3(NTHR), args, LDS_BYTES, stream);
    if (e != hipSuccess) fprintf(stderr, "cooperative launch failed: %s (grid %d)\n", hipGetErrorString(e), grid);
#ifdef PROBE_PHASE
    hipLaunchKernelGGL(mega, dim3(grid), dim3(NTHR), LDS_BYTES, stream, p, PROBE_PHASE, PROBE_PHASE + 1);
#endif
#else
    for (int k = 0; k < NPHASE; ++k) hipLaunchKernelGGL(mega, dim3(grid), dim3(NTHR), LDS_BYTES, stream, p, k, k + 1);
#endif
}
```

```cpp
#include <hip/hip_runtime.h>
#include <hip/hip_cooperative_groups.h>
#include <cstdio>
#include <cstdint>
namespace cg = cooperative_groups;

#ifndef ONE_LAUNCH
#define ONE_LAUNCH 1
#endif

typedef unsigned short bf16_t;
typedef short bf16x8 __attribute__((ext_vector_type(8)));
typedef float f32x4 __attribute__((ext_vector_type(4)));
typedef float f32x2 __attribute__((ext_vector_type(2)));
typedef unsigned u32x4 __attribute__((ext_vector_type(4)));
typedef unsigned u32x2 __attribute__((ext_vector_type(2)));

constexpr int NT = 32768, NCX = 1024, DM = 1024, SEQ = 8192, CTXL = 256;
constexpr int NTHR = 512;
constexpr int NCH64 = 132;
constexpr size_t MiB = (size_t)1 << 20;
constexpr size_t OFF_CTL = 0, OFF_MOD = 1 * MiB, OFF_BINP = OFF_MOD + 128 * 1024, OFF_WIN = 2 * MiB, OFF_WPA = 14 * MiB, OFF_WPB = 16 * MiB,
                 OFF_WO = 18 * MiB, OFF_WG = 20 * MiB, OFF_WGU = 22 * MiB, OFF_WDN = 54 * MiB, OFF_HC = 70 * MiB, OFF_XRC = 72 * MiB,
                 OFF_TOT = 74 * MiB, OFF_ROUTE = 84 * MiB, OFF_LIST = 85 * MiB, OFF_WL = 87 * MiB, OFF_SLOT = 90 * MiB, SLOT = 64 * MiB,
                 WS_END = OFF_SLOT + 6 * SLOT;
constexpr int LDS_BYTES = 144 * 1024;
constexpr int NPHASE = 11;

struct Params { const float* in[37]; float* out; unsigned char* ws; int pv; int pad; };

enum { I_X = 0, I_C, I_CTX, I_CCTX, I_WADA, I_BADA, I_GMIX, I_WIN, I_BIN, I_CONVW, I_CONVB, I_LNG, I_LNB, I_WPA, I_LCW, I_LCB,
       I_WRF, I_BRF, I_WIF, I_BIF, I_LAMF, I_WRB, I_BRB, I_WIB, I_BIB, I_LAMB, I_WPB, I_WO, I_GFFN, I_WGRP, I_BGRP, I_WER, I_BER,
       I_WGATE, I_WUP, I_WDOWN, I_GFINAL };

__device__ __forceinline__ float bflo(unsigned w) { return __uint_as_float(w << 16); }
__device__ __forceinline__ float bfhi(unsigned w) { return __uint_as_float(w & 0xffff0000u); }
__device__ __forceinline__ float bf2f(bf16_t h) { return __uint_as_float(((unsigned)h) << 16); }
__device__ __forceinline__ unsigned pk2(float lo, float hi) { unsigned r; asm("v_cvt_pk_bf16_f32 %0, %1, %2" : "=v"(r) : "v"(lo), "v"(hi)); return r; }
__device__ __forceinline__ bf16_t f2bf(float f) { return (bf16_t)(pk2(f, 0.f) & 0xffffu); }
__device__ __forceinline__ float sigm(float x) { return __builtin_amdgcn_rcpf(1.0f + __expf(-x)); }
__device__ __forceinline__ float sigm2(float x2) { return __builtin_amdgcn_rcpf(1.0f + __builtin_amdgcn_exp2f(x2)); }
__device__ __forceinline__ float silu(float x) { return x * sigm(x); }
__device__ __forceinline__ float gelu_tanh(float x) { return x * sigm(1.5957691216057308f * (x + 0.044715f * x * x * x)); }
__device__ __forceinline__ float wave_sum(float v) {
#pragma unroll
    for (int o = 1; o < 64; o <<= 1) v += __shfl_xor(v, o);
    return v;
}
template <int CTRL, int RMASK> __device__ __forceinline__ float dpp_add(float v) { return v + __int_as_float(__builtin_amdgcn_update_dpp(0, __float_as_int(v), CTRL, RMASK, 0xF, false)); }
__device__ __forceinline__ float wave_sum_dpp(float v) {
    v = dpp_add<0xB1, 0xF>(v); v = dpp_add<0x4E, 0xF>(v); v = dpp_add<0x141, 0xF>(v); v = dpp_add<0x140, 0xF>(v); v = dpp_add<0x142, 0xA>(v); v = dpp_add<0x143, 0xC>(v);
    return __int_as_float(__builtin_amdgcn_readlane(__float_as_int(v), 63));
}
__device__ __forceinline__ void wave_lds_sync() { asm volatile("s_waitcnt lgkmcnt(0)" ::: "memory"); __builtin_amdgcn_wave_barrier(); }
__device__ __forceinline__ u32x2 pk4(f32x4 v) { u32x2 r; r.x = pk2(v[0], v[1]); r.y = pk2(v[2], v[3]); return r; }

__device__ __forceinline__ u32x4 pk8(f32x4 a, f32x4 b) { u32x4 r; r.x = pk2(a[0], a[1]); r.y = pk2(a[2], a[3]); r.z = pk2(b[0], b[1]); r.w = pk2(b[2], b[3]); return r; }
__device__ __forceinline__ void unpk8(u32x4 w, f32x4& a, f32x4& b) { a[0] = bflo(w.x); a[1] = bfhi(w.x); a[2] = bflo(w.y); a[3] = bfhi(w.y); b[0] = bflo(w.z); b[1] = bfhi(w.z); b[2] = bflo(w.w); b[3] = bfhi(w.w); }

template <class DRow>
__device__ __forceinline__ void tr_item(const float* __restrict__ src, int ldsrc, int k0, int n0, bf16_t* dst, int ldd, DRow drow, float* scr, int lane, float scale = 1.0f) {
    const float* sp = src + (size_t)k0 * ldsrc + n0 + lane;
    float tv[64];
#pragma unroll
    for (int kk = 0; kk < 64; ++kk) tv[kk] = sp[(size_t)kk * ldsrc];
#pragma unroll
    for (int kk = 0; kk < 64; ++kk) scr[kk * 65 + lane] = tv[kk] * scale;
    wave_lds_sync();
    const int c = lane & 7;
#pragma unroll
    for (int j = 0; j < 8; ++j) {
        const int n = (lane >> 3) + 8 * j; const float* s = scr + (8 * c) * 65 + n;
        u32x4 o; o.x = pk2(s[0], s[65]); o.y = pk2(s[130], s[195]); o.z = pk2(s[260], s[325]); o.w = pk2(s[390], s[455]);
        *(u32x4*)(dst + (size_t)drow(n0 + n) * ldd + k0 + 8 * c) = o;
    }
    wave_lds_sync();
}

__device__ __forceinline__ int win_srccol(int np) { const int p = np >> 8, r = np & 255; return p < 8 ? (r >> 7) * 1024 + 128 * p + (r & 127) : np; }

constexpr int N_WIN = 16 * 96, N_SQ = 16 * 16, N_G = 128, N_GU = 2048, N_DN = 2048;
constexpr int PREP_EARLY = N_WIN + 3 * N_SQ + N_G, PREP_ALL = PREP_EARLY + 2 * N_GU + N_DN;
__device__ __forceinline__ void prep_items(const Params& p, int first, int last, int gw, int NGW, unsigned char* lds) {
    const int lane = threadIdx.x & 63, wave = threadIdx.x >> 6;
    unsigned char* ws = p.ws;
    float* scr = (float*)lds + wave * (64 * 65);
    for (int it = first + gw; it < last; it += NGW) {
        int r = it;
        if (r < N_WIN) { const int kb = r / 96, nbk = r % 96, d0 = 64 * nbk, sc0 = win_srccol(d0);
            const int pt = d0 >> 8; const bool sgm = (pt < 8 && ((d0 >> 7) & 1)) || pt >= 16;
            tr_item(p.in[I_WIN], 6144, 64 * kb, sc0, (bf16_t*)(ws + OFF_WIN), 1024, [=](int n) { return n - sc0 + d0; }, scr, lane, sgm ? -1.4426950408889634f : 1.0f); continue; }
        r -= N_WIN;
        if (r < 3 * N_SQ) { const int which = r / N_SQ, q = r % N_SQ, kb = q / 16, nbk = q % 16;
            const float* src = which == 0 ? p.in[I_WPA] : which == 1 ? p.in[I_WPB] : p.in[I_WO];
            bf16_t* dst = (bf16_t*)(ws + (which == 0 ? OFF_WPA : which == 1 ? OFF_WPB : OFF_WO));
            tr_item(src, 1024, 64 * kb, 64 * nbk, dst, 1024, [=](int n) { return n; }, scr, lane); continue; }
        r -= 3 * N_SQ;
        if (r < N_G) { const int ty = r / 32, q = r % 32, h = q / 4, kb = (q % 4) / 2, nbk = q % 2;
            const float* src = (ty == 0 ? p.in[I_WRF] : ty == 1 ? p.in[I_WIF] : ty == 2 ? p.in[I_WRB] : p.in[I_WIB]) + (size_t)h * 128 * 128;
            tr_item(src, 128, 64 * kb, 64 * nbk, (bf16_t*)(ws + OFF_WG), 128, [=](int n) { return h * 512 + (n >> 4) * 64 + ty * 16 + (n & 15); }, scr, lane, -1.4426950408889634f); continue; }
        r -= N_G;
        if (r < 2 * N_GU) { const int bj = r / N_GU, q = r % N_GU, e = q / 128, kb = (q % 128) / 8, nbk = q % 8;
            const float* src = (bj == 0 ? p.in[I_WGATE] : p.in[I_WUP]) + (size_t)e * 1024 * 512;
            tr_item(src, 512, 64 * kb, 64 * nbk, (bf16_t*)(ws + OFF_WGU) + (size_t)e * 1024 * 1024, 1024, [=](int n) { return 256 * (n >> 7) + 128 * bj + (n & 127); }, scr, lane); continue; }
        r -= 2 * N_GU;
        { const int e = r / 128, kb = (r % 128) / 16, nbk = r % 16;
            tr_item(p.in[I_WDOWN] + (size_t)e * 512 * 1024, 1024, 64 * kb, 64 * nbk, (bf16_t*)(ws + OFF_WDN) + (size_t)e * 1024 * 512, 512, [=](int n) { return n; }, scr, lane); }
    }
}

__device__ __forceinline__ void ph0_prep(const Params& p, int bid, int nb, unsigned char* lds) {
    const int tid = threadIdx.x, lane = tid & 63, wave = tid >> 6;
    unsigned char* ws = p.ws;
    float* red = (float*)lds;
    float* MOD = (float*)(ws + OFF_MOD);
    for (int it = bid; it < 96; it += nb) {
        const int col = it * 64 + lane;
        float a[5] = {0.f, 0.f, 0.f, 0.f, 0.f};
        const float* W = p.in[I_WADA];
#pragma unroll 1
        for (int k0 = wave * 128; k0 < wave * 128 + 128; k0 += 64) {
            float wv[64];
#pragma unroll
            for (int kk = 0; kk < 64; ++kk) wv[kk] = W[(size_t)(k0 + kk) * 6144 + col];
#pragma unroll
            for (int kk = 0; kk < 64; ++kk)
#pragma unroll
                for (int r = 0; r < 5; ++r) { const float cv = r < 4 ? p.in[I_C][r * 1024 + k0 + kk] : p.in[I_CCTX][k0 + kk]; a[r] += silu(cv) * wv[kk]; }
        }
#pragma unroll
        for (int r = 0; r < 5; ++r) red[(wave * 5 + r) * 64 + lane] = a[r];
        __syncthreads();
        if (tid < 320) { const int r = tid / 64, l = tid % 64; float s = 0.f;
#pragma unroll
            for (int w = 0; w < 8; ++w) s += red[(w * 5 + r) * 64 + l];
            MOD[r * 6144 + it * 64 + l] = s + p.in[I_BADA][it * 64 + l]; }
        __syncthreads();
    }
    __syncthreads();
    if (nb > 96 + 32) { if (bid >= 96) prep_items(p, 0, PREP_EARLY, (bid - 96) * 8 + wave, (nb - 96) * 8, lds); }
    else prep_items(p, 0, PREP_EARLY, bid * 8 + wave, nb * 8, lds);
    float* BINP = (float*)(ws + OFF_BINP);
    for (int i = bid * NTHR + tid; i < 6144; i += nb * NTHR) { const int pt = i >> 8; const bool sgm = (pt < 8 && ((i >> 7) & 1)) || pt >= 16; BINP[i] = p.in[I_BIN][win_srccol(i)] * (sgm ? -1.4426950408889634f : 1.0f); }
    if (bid == 0) ((unsigned*)(ws + OFF_CTL))[tid] = 0u;
}

template <bool WT>
__device__ __forceinline__ void norm_row(const f32x4 (&v)[4], float ss, const f32x4 (&gsv)[4], const f32x4 (&shv)[4], bf16_t* dst, int lane) {
    const float rinv = rsqrtf(wave_sum_dpp(ss) * (1.0f / DM) + 1e-6f);
#pragma unroll
    for (int j = 0; j < 4; ++j) { const int c = lane * 4 + 256 * j;
        const u32x2 o = pk4(v[j] * rinv * gsv[j] + shv[j]);
        if (WT) __hip_atomic_store((unsigned long long*)(dst + c), ((unsigned long long)o.y << 32) | o.x, __ATOMIC_RELAXED, __HIP_MEMORY_SCOPE_AGENT);
        else *(u32x2*)(dst + c) = o; }
}
constexpr int CTX_GEMM_WGS = 16;
__device__ __forceinline__ bool ph1_norm(const Params& p, int bid, int nb) {
    const int lane = threadIdx.x & 63, wave = threadIdx.x >> 6;
    const float* MOD = (const float*)(p.ws + OFF_MOD);
    unsigned* ctxcnt = (unsigned*)(p.ws + OFF_CTL) + 32;
    f32x4 gm[4];
#pragma unroll
    for (int j = 0; j < 4; ++j) gm[j] = *(const f32x4*)(p.in[I_GMIX] + lane * 4 + 256 * j);
    f32x4 shv[4], gsv[4];
    const bool split = nb >= 4 * CTX_GEMM_WGS;
    for (int cr = bid * 8 + wave; cr < NCX; cr += nb * 8) {
        const float* mrow = MOD + 4 * 6144;
        f32x4 v[4]; float ss = 0.f;
#pragma unroll
        for (int j = 0; j < 4; ++j) { const int c = lane * 4 + 256 * j; v[j] = *(const f32x4*)(p.in[I_CTX] + (size_t)cr * DM + c); const f32x4 sq = v[j] * v[j]; ss += (sq[0] + sq[1]) + (sq[2] + sq[3]);
            shv[j] = *(const f32x4*)(mrow + c); gsv[j] = gm[j] * (1.0f + *(const f32x4*)(mrow + 1024 + c)); }
        norm_row<true>(v, ss, gsv, shv, (bf16_t*)(p.ws + OFF_HC) + (size_t)cr * DM, lane);
        asm volatile("s_waitcnt vmcnt(0)" ::: "memory");
        if (lane == 0) __hip_atomic_fetch_add(ctxcnt, 1u, __ATOMIC_RELAXED, __HIP_MEMORY_SCOPE_AGENT);
    }
    if (split && bid < CTX_GEMM_WGS) {
        if (threadIdx.x == 0) { unsigned sp = 0;
            while (__hip_atomic_load(ctxcnt, __ATOMIC_RELAXED, __HIP_MEMORY_SCOPE_AGENT) < (unsigned)NCX) { __builtin_amdgcn_s_sleep(2); if (++sp > (1u << 22)) break; }
            __builtin_amdgcn_fence(__ATOMIC_ACQUIRE, "agent");
            asm volatile("s_waitcnt vmcnt(0)" ::: "memory"); }
        __syncthreads();
        return true;
    }
    const int wg0 = split ? CTX_GEMM_WGS : 0;
    const int r0 = (bid - wg0) * 8 + wave, rs = (nb - wg0) * 8;
    int mprev = -1;
    f32x4 nx[4];
#pragma unroll
    for (int j = 0; j < 4; ++j) nx[j] = *(const f32x4*)(p.in[I_X] + (size_t)r0 * DM + lane * 4 + 256 * j);
#pragma unroll 1
    for (int r = r0; r < NT; r += rs) {
        const int mb = r / SEQ;
        if (mb != mprev) { mprev = mb; const float* mrow = MOD + mb * 6144;
#pragma unroll
            for (int j = 0; j < 4; ++j) { const int c = lane * 4 + 256 * j; shv[j] = *(const f32x4*)(mrow + c); gsv[j] = gm[j] * (1.0f + *(const f32x4*)(mrow + 1024 + c)); } }
        f32x4 v[4]; float ss = 0.f;
#pragma unroll
        for (int j = 0; j < 4; ++j) { v[j] = nx[j]; const f32x4 sq = v[j] * v[j]; ss += (sq[0] + sq[1]) + (sq[2] + sq[3]); }
        { const int rn = r + rs < NT ? r + rs : r;
#pragma unroll
            for (int j = 0; j < 4; ++j) nx[j] = *(const f32x4*)(p.in[I_X] + (size_t)rn * DM + lane * 4 + 256 * j); }
        norm_row<false>(v, ss, gsv, shv, (bf16_t*)(p.ws + OFF_SLOT) + (size_t)r * DM, lane);
    }
    return false;
}

struct Unit { int pm, pn, aux, aux2; };

#define LAS __attribute__((address_space(3)))
constexpr int BK = 64, HTB = 128 * BK * 2, STAGE_BYTES = 8 * HTB;
__device__ __forceinline__ int lds_byte(int r, int c) { const int st = (r >> 4) * 2 + (c >> 5), rr = r & 15, cc = c & 31, ob = rr * 64 + cc * 2; return st * 1024 + (ob ^ (((ob >> 9) & 1) << 5)); }
__device__ __forceinline__ void stage_rc(int b, int& R, int& C) { const int st = b / 1024, sb = b % 1024, swz = sb ^ (((sb >> 9) & 1) << 5); R = (st >> 1) * 16 + swz / 64; C = (st & 1) * 32 + (swz % 64) / 2; }

template <bool GATHER, class S, class E>
__device__ __forceinline__ void gemm_phase_pipe(unsigned char* ldsg, const S& sch, const E& epi) {
    LAS unsigned char* lds = (LAS unsigned char*)ldsg;
    const int tid = threadIdx.x, wid = __builtin_amdgcn_readfirstlane(tid >> 6), lane = tid & 63, wr = wid >> 2, wc = wid & 3, fr = lane & 15, fq = lane >> 4;
    const int K = sch.K, nt = K / BK;
    int Rr[2], Cc[2]; unsigned voffA[2], voffB[2];
#pragma unroll
    for (int i = 0; i < 2; ++i) { stage_rc(tid * 16 + i * 8192, Rr[i], Cc[i]); voffA[i] = (unsigned)(Rr[i] * K + Cc[i]) * 2u;
        const int rho = Rr[i] & 31, Rb = (Rr[i] & ~31) + 8 * ((rho & 15) >> 2) + 4 * (rho >> 4) + (rho & 3);
        voffB[i] = (unsigned)(Rb * K + Cc[i]) * 2u; }
    const size_t kstep = (size_t)(BK * 2);
    const size_t hstep = (size_t)128 * K * 2;
    const unsigned ldsw = (unsigned)wid * 1024u;
    const int aoff = lds_byte(wr * 64 + fr, fq * 8), boff = lds_byte(wc * 32 + fr, fq * 8);
#define PG8_SA(b, h) (((b) * 2 + (h)) * HTB)
#define PG8_SB(b, h) ((4 + (b) * 2 + (h)) * HTB)
#define PG8_STAGE_B(bufoff, gbase) do { _Pragma("unroll") for (int _i = 0; _i < 2; ++_i) \
        __builtin_amdgcn_global_load_lds((const unsigned*)((const char*)(gbase) + voffB[_i]), (LAS unsigned*)(lds + (bufoff) + ldsw + _i * 8192), 16, 0, 0); } while (0)
#define PG8_STAGE_A(bufoff, gbase, h, vo) do { _Pragma("unroll") for (int _i = 0; _i < 2; ++_i) \
        __builtin_amdgcn_global_load_lds((const unsigned*)((const char*)(gbase) + (GATHER ? (size_t)(vo)[h][_i] : (size_t)(h) * hstep + voffA[_i])), (LAS unsigned*)(lds + (bufoff) + ldsw + _i * 8192), 16, 0, 0); } while (0)
#define PG8_LDA(dst, b, h) do { _Pragma("unroll") for (int m = 0; m < 4; ++m) _Pragma("unroll") for (int k = 0; k < 2; ++k) dst[m][k] = *(const LAS bf16x8*)(lds + PG8_SA(b, h) + aoff + m * 2048 + k * 1024); } while (0)
#define PG8_LDB(dst, b, h) do { _Pragma("unroll") for (int n = 0; n < 2; ++n) _Pragma("unroll") for (int k = 0; k < 2; ++k) dst[n][k] = *(const LAS bf16x8*)(lds + PG8_SB(b, h) + boff + n * 2048 + k * 1024); } while (0)
#define PG8_MMA(ai, bj, At, Bt) do { __builtin_amdgcn_s_setprio(1); _Pragma("unroll") for (int m = 0; m < 4; ++m) _Pragma("unroll") for (int n = 0; n < 2; ++n) _Pragma("unroll") for (int k = 0; k < 2; ++k) \
        acc[ai][bj][m][n] = __builtin_amdgcn_mfma_f32_16x16x32_bf16(Bt[n][k], At[m][k], acc[ai][bj][m][n], 0, 0, 0); __builtin_amdgcn_s_setprio(0); } while (0)
#define PG8_WAIT_V(n) asm volatile("s_waitcnt vmcnt(" #n ")" ::: "memory")
#define PG8_WAIT_L(n) asm volatile("s_waitcnt lgkmcnt(" #n ")" ::: "memory")
#define PG8_BAR __builtin_amdgcn_s_barrier()
#define PG8_SCHED __builtin_amdgcn_sched_barrier(0)
    Unit cur, nxt; int ui = 0;
    if (!sch.next(0, cur)) return;
    f32x4 acc[2][2][4][2];
#pragma unroll
    for (int a = 0; a < 2; ++a)
#pragma unroll
        for (int b = 0; b < 2; ++b)
#pragma unroll
            for (int m = 0; m < 4; ++m)
#pragma unroll
                for (int n = 0; n < 2; ++n) acc[a][b][m][n] = (f32x4){0.f, 0.f, 0.f, 0.f};
    bf16x8 At[4][2], B0[2][2], B1[2][2];
    unsigned voAc[2][2], voAn[2][2];
#pragma unroll
    for (int h = 0; h < 2; ++h)
#pragma unroll
        for (int i = 0; i < 2; ++i) { voAc[h][i] = GATHER ? sch.aoff(cur, 128 * h + Rr[i]) + (unsigned)Cc[i] * 2u : 0u; voAn[h][i] = voAc[h][i]; }
    const char* cA = sch.abase(cur); const char* cB = sch.bbase(cur);
    sch.a_ready(cur);
    PG8_STAGE_B(PG8_SB(0, 0), cB); PG8_STAGE_A(PG8_SA(0, 0), cA, 0, voAc); PG8_STAGE_B(PG8_SB(0, 1), cB + hstep); PG8_STAGE_A(PG8_SA(0, 1), cA, 1, voAc);
    if (wr == 1) PG8_BAR;
    PG8_WAIT_V(4); PG8_BAR;
    PG8_STAGE_B(PG8_SB(1, 0), cB + kstep); PG8_STAGE_A(PG8_SA(1, 0), cA + kstep, 0, voAc); PG8_STAGE_B(PG8_SB(1, 1), cB + hstep + kstep);
    PG8_WAIT_V(6); PG8_BAR;
    for (;;) {
        const bool has_next = sch.next(ui + 1, nxt);
        const char* nA = has_next ? sch.abase(nxt) : cA; const char* nB = has_next ? sch.bbase(nxt) : cB;
        if (GATHER) {
#pragma unroll
            for (int h = 0; h < 2; ++h)
#pragma unroll
                for (int i = 0; i < 2; ++i) voAn[h][i] = has_next ? sch.aoff(nxt, 128 * h + Rr[i]) + (unsigned)Cc[i] * 2u : voAc[h][i];
        }
#pragma unroll 1
        for (int t = 0; t < nt; t += 2) {
            const bool last = (t == nt - 2);
            const char* a1 = cA + (size_t)(t + 1) * kstep;
            const char* a2 = last ? nA : cA + (size_t)(t + 2) * kstep; const char* b2 = last ? nB : cB + (size_t)(t + 2) * kstep;
            const char* a3 = a2 + kstep; const char* b3 = b2 + kstep;
            if (last && has_next) sch.a_ready(nxt);
            unsigned vo2[2][2];
#pragma unroll
            for (int h = 0; h < 2; ++h)
#pragma unroll
                for (int i = 0; i < 2; ++i) vo2[h][i] = last ? voAn[h][i] : voAc[h][i];
            PG8_LDB(B0, 0, 0); PG8_SCHED; PG8_LDA(At, 0, 0); PG8_STAGE_A(PG8_SA(1, 1), a1, 1, voAc);
            PG8_WAIT_L(8); PG8_BAR; PG8_WAIT_L(0); PG8_MMA(0, 0, At, B0); PG8_BAR; PG8_SCHED;
            PG8_LDB(B1, 0, 1); PG8_STAGE_B(PG8_SB(0, 0), b2);
            PG8_BAR; PG8_WAIT_L(0); PG8_MMA(0, 1, At, B1); PG8_BAR;
            PG8_LDA(At, 0, 1); PG8_STAGE_A(PG8_SA(0, 0), a2, 0, vo2);
            PG8_BAR; PG8_WAIT_L(0); PG8_MMA(1, 0, At, B0); PG8_BAR; PG8_SCHED;
            PG8_STAGE_B(PG8_SB(0, 1), b2 + hstep);
            PG8_WAIT_V(6); PG8_BAR; PG8_MMA(1, 1, At, B1); PG8_BAR;
            PG8_LDB(B0, 1, 0); PG8_SCHED; PG8_LDA(At, 1, 0); PG8_STAGE_A(PG8_SA(0, 1), a2, 1, vo2);
            PG8_WAIT_L(8); PG8_BAR; PG8_WAIT_L(0); PG8_MMA(0, 0, At, B0); PG8_BAR; PG8_SCHED;
            PG8_LDB(B1, 1, 1); PG8_STAGE_B(PG8_SB(1, 0), b3);
            PG8_BAR; PG8_WAIT_L(0); PG8_MMA(0, 1, At, B1); PG8_BAR;
            PG8_LDA(At, 1, 1); PG8_STAGE_A(PG8_SA(1, 0), a3, 0, vo2);
            PG8_BAR; PG8_WAIT_L(0); PG8_MMA(1, 0, At, B0); PG8_BAR; PG8_SCHED;
            PG8_STAGE_B(PG8_SB(1, 1), b3 + hstep);
            PG8_WAIT_V(6); PG8_BAR; PG8_MMA(1, 1, At, B1); PG8_BAR;
        }
        { int frx = fr, fqx = fq; asm volatile("" : "+v"(frx), "+v"(fqx));
            const int jx = wc * 32 + 8 * fqx, rx = wr * 64 + frx;
            const typename E::Col ecol = epi.col(cur, jx);
            constexpr int PF = E::PF;
            typename E::Pre epre[8];
#pragma unroll
            for (int g = 0; g < PF; ++g) epre[g] = epi.load(cur, (g >> 2) * 128 + (g & 3) * 16 + rx, jx);
#pragma unroll
            for (int g = 0; g < 8; ++g) { const int ai = g >> 2, m = g & 3;
                if (g + PF < 8) epre[g + PF] = epi.load(cur, ((g + PF) >> 2) * 128 + ((g + PF) & 3) * 16 + rx, jx);
                epi.apply(cur, ai * 128 + m * 16 + rx, jx, ecol, epre[g], acc[ai][0][m][0], acc[ai][0][m][1], acc[ai][1][m][0], acc[ai][1][m][1]); } }
        sch.done(cur);
        if (!has_next) break;
#pragma unroll
        for (int a = 0; a < 2; ++a)
#pragma unroll
            for (int b = 0; b < 2; ++b)
#pragma unroll
                for (int m = 0; m < 4; ++m)
#pragma unroll
                    for (int n = 0; n < 2; ++n) acc[a][b][m][n] = (f32x4){0.f, 0.f, 0.f, 0.f};
        cur = nxt; cA = nA; cB = nB; ++ui;
#pragma unroll
        for (int h = 0; h < 2; ++h)
#pragma unroll
            for (int i = 0; i < 2; ++i) voAc[h][i] = voAn[h][i];
    }
    PG8_WAIT_V(0);
    if (wr == 0) PG8_BAR;
    PG8_BAR;
#undef PG8_SA
#undef PG8_SB
#undef PG8_STAGE_A
#undef PG8_STAGE_B
#undef PG8_LDA
#undef PG8_LDB
#undef PG8_MMA
#undef PG8_WAIT_V
#undef PG8_WAIT_L
#undef PG8_BAR
#undef PG8_SCHED
}

struct NoHooks {
    __device__ __forceinline__ void a_ready(const Unit&) const {}
    __device__ __forceinline__ void done(const Unit&) const {}
};
struct SchG1 { const bf16_t *A, *Bt; int G, c, K;
    __device__ __forceinline__ void a_ready(const Unit&) const {}
    __device__ __forceinline__ void done(const Unit&) const {}
    __device__ __forceinline__ bool next(int i, Unit& u) const { const int L = i * G + c; if (L >= 128 * 24) return false; u.pm = L / 24; u.pn = L % 24; return true; }
    __device__ __forceinline__ const bf16_t* arow(const Unit& u, int r) const { return A + (size_t)(u.pm * 256 + r) * 1024; }
    __device__ __forceinline__ const bf16_t* brow(const Unit& u, int n) const { return Bt + (size_t)(u.pn * 256 + n) * 1024; }
    __device__ __forceinline__ const char* abase(const Unit& u) const { return (const char*)(A + (size_t)u.pm * 256 * 1024); }
    __device__ __forceinline__ const char* bbase(const Unit& u) const { return (const char*)(Bt + (size_t)u.pn * 256 * 1024); }
    __device__ __forceinline__ unsigned aoff(const Unit&, int) const { return 0u; } };
struct EpiG1 { bf16_t *Z, *GYG, *XR, *SGA, *SGB; const float* bias;
    static constexpr int PF = 1; struct Col { f32x4 c0, c1, c2, c3; }; struct Pre { };
    __device__ __forceinline__ Col col(const Unit& u, int j) const { const float* bp = bias + u.pn * 256 + j; return Col{*(const f32x4*)bp, *(const f32x4*)(bp + 4), *(const f32x4*)(bp + 128), *(const f32x4*)(bp + 132)}; }
    __device__ __forceinline__ Pre load(const Unit&, int, int) const { return Pre{}; }
    __device__ __forceinline__ void apply(const Unit& u, int r, int j, const Col& c, const Pre&, f32x4 a0, f32x4 a1, f32x4 b0, f32x4 b1) const {
        const size_t row = (size_t)u.pm * 256 + r;
        a0 += c.c0; a1 += c.c1; b0 += c.c2; b1 += c.c3;
        if (u.pn < 8) {
#pragma unroll
            for (int e = 0; e < 4; ++e) { a0[e] *= sigm2(b0[e]); a1[e] *= sigm2(b1[e]); }
            *(u32x4*)(Z + row * 1024 + u.pn * 128 + j) = pk8(a0, a1); }
        else { const int kind = u.pn >> 2;
            bf16_t* dst = GYG + (size_t)(kind - 2) * (SLOT / 2);
#pragma unroll
            for (int e = 0; e < 4; ++e) { if (kind == 2) { a0[e] = gelu_tanh(a0[e]); a1[e] = gelu_tanh(a1[e]); b0[e] = gelu_tanh(b0[e]); b1[e] = gelu_tanh(b1[e]); }
                else if (kind >= 4) { a0[e] = sigm2(a0[e]); a1[e] = sigm2(a1[e]); b0[e] = sigm2(b0[e]); b1[e] = sigm2(b1[e]); } }
            bf16_t* o = dst + row * 1024 + (u.pn & 3) * 256 + j;
            *(u32x4*)o = pk8(a0, a1); *(u32x4*)(o + 128) = pk8(b0, b1); }
    } };
struct SchCtx { const bf16_t *A, *Bt; int G, c, K;
    __device__ __forceinline__ void a_ready(const Unit&) const {}
    __device__ __forceinline__ void done(const Unit&) const {}
    __device__ __forceinline__ bool next(int i, Unit& u) const { const int L = i * G + c; if (L >= 16) return false; u.pm = L / 4; u.pn = L % 4; return true; }
    __device__ __forceinline__ const bf16_t* arow(const Unit& u, int r) const { return A + (size_t)(u.pm * 256 + r) * 1024; }
    __device__ __forceinline__ const bf16_t* brow(const Unit& u, int n) const { return Bt + (size_t)((12 + u.pn) * 256 + n) * 1024; }
    __device__ __forceinline__ const char* abase(const Unit& u) const { return (const char*)(A + (size_t)u.pm * 256 * 1024); }
    __device__ __forceinline__ const char* bbase(const Unit& u) const { return (const char*)(Bt + (size_t)(12 + u.pn) * 256 * 1024); }
    __device__ __forceinline__ unsigned aoff(const Unit&, int) const { return 0u; } };
struct EpiCtx { bf16_t* XRC; const float* bias;
    static constexpr int PF = 1; struct Col { f32x4 c0, c1, c2, c3; }; struct Pre { };
    __device__ __forceinline__ Col col(const Unit& u, int j) const { const float* bp = bias + (12 + u.pn) * 256 + j; return Col{*(const f32x4*)bp, *(const f32x4*)(bp + 4), *(const f32x4*)(bp + 128), *(const f32x4*)(bp + 132)}; }
    __device__ __forceinline__ Pre load(const Unit&, int, int) const { return Pre{}; }
    __device__ __forceinline__ void apply(const Unit& u, int r, int j, const Col& c, const Pre&, f32x4 a0, f32x4 a1, f32x4 b0, f32x4 b1) const {
        const size_t row = (size_t)u.pm * 256 + r;
        a0 += c.c0; a1 += c.c1; b0 += c.c2; b1 += c.c3;
        bf16_t* o = XRC + row * 1024 + u.pn * 256 + j; *(u32x4*)o = pk8(a0, a1); *(u32x4*)(o + 128) = pk8(b0, b1); } };
struct SchG2 { const bf16_t *Aa, *Ab, *Wa, *Wb; int G, c, K;
    __device__ __forceinline__ void a_ready(const Unit&) const {}
    __device__ __forceinline__ void done(const Unit&) const {}
    __device__ __forceinline__ bool next(int i, Unit& u) const { const int t = (i >> 1) * G + c; if (t >= 512) return false; u.pm = t >> 2; u.pn = t & 3; u.aux = i & 1; return true; }
    __device__ __forceinline__ const bf16_t* arow(const Unit& u, int r) const { return Aa + (size_t)u.aux * (SLOT / 2) + (size_t)(u.pm * 256 + r) * 1024; }
    __device__ __forceinline__ const bf16_t* brow(const Unit& u, int n) const { return Wa + (size_t)u.aux * (1024 * 1024) + (size_t)(u.pn * 256 + n) * 1024; }
    __device__ __forceinline__ const char* abase(const Unit& u) const { return (const char*)(Aa + (size_t)u.aux * (SLOT / 2) + (size_t)u.pm * 256 * 1024); }
    __device__ __forceinline__ const char* bbase(const Unit& u) const { return (const char*)(Wa + (size_t)u.aux * (1024 * 1024) + (size_t)u.pn * 256 * 1024); }
    __device__ __forceinline__ unsigned aoff(const Unit&, int) const { return 0u; } };
struct EpiG2 { const bf16_t *SGA, *SGB; bf16_t* M;
    static constexpr int PF = 2; struct Col { }; struct Pre { u32x4 g0, g1, t0, t1; };
    __device__ __forceinline__ Col col(const Unit&, int) const { return Col{}; }
    __device__ __forceinline__ Pre load(const Unit& u, int r, int j) const {
        const size_t o = ((size_t)u.pm * 256 + r) * 1024 + u.pn * 256 + j; const bf16_t* G = SGA + (size_t)u.aux * (SLOT / 2);
        Pre q; q.g0 = *(const u32x4*)(G + o); q.g1 = *(const u32x4*)(G + o + 128);
        if (u.aux) { q.t0 = *(const u32x4*)(M + o); q.t1 = *(const u32x4*)(M + o + 128); } else { q.t0 = (u32x4){0u, 0u, 0u, 0u}; q.t1 = q.t0; }
        return q; }
    __device__ __forceinline__ void apply(const Unit& u, int r, int j, const Col&, const Pre& q, f32x4 a0, f32x4 a1, f32x4 b0, f32x4 b1) const {
        const size_t o = ((size_t)u.pm * 256 + r) * 1024 + u.pn * 256 + j;
        f32x4 g0, g1, g2, g3, t0, t1, t2, t3; unpk8(q.g0, g0, g1); unpk8(q.g1, g2, g3); unpk8(q.t0, t0, t1); unpk8(q.t1, t2, t3);
        a0 = a0 * g0 + t0; a1 = a1 * g1 + t1; b0 = b0 * g2 + t2; b1 = b1 * g3 + t3;
        *(u32x4*)(M + o) = pk8(a0, a1); *(u32x4*)(M + o + 128) = pk8(b0, b1); } };
struct SchG3 { const bf16_t *A, *Bt; int G, c, K;
    __device__ __forceinline__ void a_ready(const Unit&) const {}
    __device__ __forceinline__ void done(const Unit&) const {}
    __device__ __forceinline__ bool next(int i, Unit& u) const { const int L = i * G + c; if (L >= 512) return false; u.pm = L >> 2; u.pn = L & 3; return true; }
    __device__ __forceinline__ const bf16_t* arow(const Unit& u, int r) const { return A + (size_t)(u.pm * 256 + r) * 1024; }
    __device__ __forceinline__ const bf16_t* brow(const Unit& u, int n) const { return Bt + (size_t)(u.pn * 256 + n) * 1024; }
    __device__ __forceinline__ const char* abase(const Unit& u) const { return (const char*)(A + (size_t)u.pm * 256 * 1024); }
    __device__ __forceinline__ const char* bbase(const Unit& u) const { return (const char*)(Bt + (size_t)u.pn * 256 * 1024); }
    __device__ __forceinline__ unsigned aoff(const Unit&, int) const { return 0u; } };
struct EpiG3 { const float *X, *MOD; bf16_t* X1B;
    static constexpr int PF = 3; struct Col { f32x4 c0, c1, c2, c3; }; struct Pre { f32x4 x0, x1, x2, x3; };
    __device__ __forceinline__ Col col(const Unit& u, int j) const { const float* gt = MOD + ((u.pm * 256) / SEQ) * 6144 + 2 * 1024 + u.pn * 256 + j; return Col{*(const f32x4*)gt, *(const f32x4*)(gt + 4), *(const f32x4*)(gt + 128), *(const f32x4*)(gt + 132)}; }
    __device__ __forceinline__ Pre load(const Unit& u, int r, int j) const { const float* xp = X + ((size_t)u.pm * 256 + r) * 1024 + u.pn * 256 + j; return Pre{*(const f32x4*)xp, *(const f32x4*)(xp + 4), *(const f32x4*)(xp + 128), *(const f32x4*)(xp + 132)}; }
    __device__ __forceinline__ void apply(const Unit& u, int r, int j, const Col& c, const Pre& q, f32x4 a0, f32x4 a1, f32x4 b0, f32x4 b1) const {
        bf16_t* op = X1B + ((size_t)u.pm * 256 + r) * 1024 + u.pn * 256 + j;
        *(u32x4*)op = pk8(q.x0 + c.c0 * a0, q.x1 + c.c1 * a1); *(u32x4*)(op + 128) = pk8(q.x2 + c.c2 * b0, q.x3 + c.c3 * b1); } };
__device__ __forceinline__ bf16_t* y_row(unsigned char* ws, size_t row) {
    return row < 65536 ? (bf16_t*)(ws + OFF_SLOT) + row * 1024 : (bf16_t*)(ws + OFF_SLOT + 4 * SLOT + 8 * MiB) + (row - 65536) * 1024;
}
struct MoeMeta { const int* m;
    __device__ __forceinline__ int cnt(int e) const { return __builtin_amdgcn_readfirstlane(m[e]); }
    __device__ __forceinline__ int tb(int e) const { return __builtin_amdgcn_readfirstlane(m[16 + e]); }
    __device__ __forceinline__ int ntiles() const { return __builtin_amdgcn_readfirstlane(m[32]); }
    __device__ __forceinline__ int find(int mt) const { int e = 0;
#pragma unroll
        for (int k = 1; k < 16; ++k) e += (__builtin_amdgcn_readfirstlane(m[16 + k]) <= mt) ? 1 : 0;
        return e; } };
__device__ __forceinline__ void moe_meta_build(const Params& p, int* meta) {
    if (threadIdx.x == 0) { const unsigned* cnt = (const unsigned*)(p.ws + OFF_CTL); int t = 0;
        for (int e = 0; e < 16; ++e) { const int c = (int)__hip_atomic_load(cnt + e, __ATOMIC_RELAXED, __HIP_MEMORY_SCOPE_AGENT); meta[e] = c; meta[16 + e] = t; t += (c + 255) >> 8; }
        meta[32] = t; }
    __syncthreads();
}
struct SchUp { const bf16_t *HM, *W; const int* LIST; MoeMeta mm; int G, c, K; const int* idx; unsigned* cntM;
    __device__ __forceinline__ bool next(int i, Unit& u) const { const int L = i * G + c; if (L >= 4 * mm.ntiles()) return false; const int mt = L >> 2; u.pn = L & 3; u.aux = mm.find(mt); u.aux2 = (mt - mm.tb(u.aux)) * 256; u.pm = mt | (i << 16); return true; }
    __device__ __forceinline__ void a_ready(const Unit&) const {}
    __device__ __forceinline__ void done(const Unit& u) const { asm volatile("s_waitcnt vmcnt(0)" ::: "memory");
        if ((threadIdx.x & 63) == 0) __hip_atomic_fetch_add(cntM + (u.pm & 0xffff), 1u, __ATOMIC_RELAXED, __HIP_MEMORY_SCOPE_AGENT); }
    __device__ __forceinline__ const char* abase(const Unit&) const { return (const char*)HM; }
    __device__ __forceinline__ const char* bbase(const Unit& u) const { return (const char*)(W + ((size_t)u.aux * 1024 + u.pn * 256) * 1024); }
    __device__ __forceinline__ unsigned aoff(const Unit& u, int r) const { return (unsigned)idx[(u.pm >> 16) * 256 + r] * 2048u; }
    __device__ __forceinline__ const bf16_t* arow(const Unit& u, int r) const { int pos = u.aux2 + r; const int c = mm.cnt(u.aux); pos = pos < c ? pos : c - 1; return HM + (size_t)LIST[u.aux * NT + pos] * 1024; }
    __device__ __forceinline__ const bf16_t* brow(const Unit& u, int n) const { return W + ((size_t)u.aux * 1024 + u.pn * 256 + n) * 1024; } };
struct EpiUp { bf16_t* ACT; const float* WL; MoeMeta mm;
    static constexpr int PF = 2; struct Col { }; struct Pre { float wt; };
    __device__ __forceinline__ Col col(const Unit&, int) const { return Col{}; }
    __device__ __forceinline__ Pre load(const Unit& u, int r, int) const { const int pos = u.aux2 + r; return Pre{pos < mm.cnt(u.aux) ? WL[u.aux * NT + pos] : 0.f}; }
    __device__ __forceinline__ void apply(const Unit& u, int r, int j, const Col&, const Pre& q, f32x4 g0, f32x4 g1, f32x4 u0, f32x4 u1) const {
        if (u.aux2 + r >= mm.cnt(u.aux)) return;
#pragma unroll
        for (int e = 0; e < 4; ++e) { g0[e] = silu(g0[e]) * u0[e] * q.wt; g1[e] = silu(g1[e]) * u1[e] * q.wt; }
        const __amdgpu_buffer_rsrc_t rsrc = __builtin_amdgcn_make_buffer_rsrc((void*)ACT, 0, 0x7fffffff, 0x00020000);
        __builtin_amdgcn_raw_buffer_store_b128(pk8(g0, g1), rsrc, (int)((((unsigned)(u.pm & 0xffff) * 256u + (unsigned)r) * 512u + (unsigned)(u.pn * 128 + j)) * 2u), 0, 16); } };
struct SchDn { const bf16_t *ACT, *W; MoeMeta mm; int G, c, K; unsigned* cntM; bool waitc;
    __device__ __forceinline__ bool next(int i, Unit& u) const {
        const int D = 4 * mm.ntiles(), umin = D / G, n5 = D - umin * G;
        int xh = (D - 2 * (G - n5)) / G; xh = xh < 0 ? 0 : xh; if (n5 == 0) xh = 0;
        int L;
        if (c < n5) { if (i >= xh) return false; L = c * xh + i; } else { L = n5 * xh + (c - n5) + (G - n5) * i; }
        if (L >= D) return false;
        const int mt = L >> 2; u.pn = L & 3; u.aux = mm.find(mt); u.aux2 = (mt - mm.tb(u.aux)) * 256; u.pm = mt; return true; }
    __device__ __forceinline__ void a_ready(const Unit& u) const {
        if (!waitc) return;
        if (threadIdx.x < 64) { unsigned sp = 0;
            while (__hip_atomic_load(cntM + u.pm, __ATOMIC_RELAXED, __HIP_MEMORY_SCOPE_AGENT) < 32u) { __builtin_amdgcn_s_sleep(2); if (++sp > (1u << 22)) break; }
            __builtin_amdgcn_fence(__ATOMIC_ACQUIRE, "agent");
            asm volatile("s_waitcnt vmcnt(0)" ::: "memory"); }
        asm volatile("" ::: "memory"); __builtin_amdgcn_s_barrier(); asm volatile("" ::: "memory"); }
    __device__ __forceinline__ void done(const Unit&) const {}
    __device__ __forceinline__ const char* abase(const Unit& u) const { return (const char*)(ACT + (size_t)u.pm * 256 * 512); }
    __device__ __forceinline__ const char* bbase(const Unit& u) const { return (const char*)(W + ((size_t)u.aux * 1024 + u.pn * 256) * 512); }
    __device__ __forceinline__ unsigned aoff(const Unit&, int) const { return 0u; } };
struct EpiDn { unsigned char* WS; MoeMeta mm;
    static constexpr int PF = 1; struct Col { }; struct Pre { };
    __device__ __forceinline__ Col col(const Unit&, int) const { return Col{}; }
    __device__ __forceinline__ Pre load(const Unit&, int, int) const { return Pre{}; }
    __device__ __forceinline__ void apply(const Unit& u, int r, int j, const Col&, const Pre&, f32x4 a0, f32x4 a1, f32x4 b0, f32x4 b1) const {
        if (u.aux2 + r >= mm.cnt(u.aux)) return;
        bf16_t* o = y_row(WS, (size_t)u.pm * 256 + r) + u.pn * 256 + j; *(u32x4*)o = pk8(a0, a1); *(u32x4*)(o + 128) = pk8(b0, b1); } };

__device__ __forceinline__ void aprep_item(const Params& p, int g, unsigned char* lds, bool have_tile, int g_next) {
    const int tid = threadIdx.x, lane = tid & 63, wave = tid >> 6;
    const bf16_t* Z = (const bf16_t*)(p.ws + OFF_SLOT + 1 * SLOT);
    bf16_t* AA = (bf16_t*)(p.ws + OFF_SLOT + 0 * SLOT) + (size_t)g * 64 * 1024;
    const unsigned* zt = (const unsigned*)lds;
    if (!have_tile) { const u32x4* src = (const u32x4*)(Z + (size_t)g * 64 * 1024); u32x4* d = (u32x4*)lds;
        u32x4 tmp[16];
#pragma unroll
        for (int i = 0; i < 16; ++i) tmp[i] = src[tid + i * NTHR];
#pragma unroll
        for (int i = 0; i < 16; ++i) d[tid + i * NTHR] = tmp[i]; }
    __syncthreads();
    {
        f32x2 w[31];
        const float* cw = p.in[I_CONVW] + 2 * tid;
#pragma unroll
        for (int k = 0; k < 31; ++k) w[k] = *(const f32x2*)(cw + k * 1024);
        const f32x2 cb = *(const f32x2*)(p.in[I_CONVB] + 2 * tid);
#pragma unroll 1
        for (int tb = 0; tb < 4; ++tb) {
            f32x2 cz[16];
#pragma unroll
            for (int o = 0; o < 16; ++o) cz[o] = cb;
#pragma unroll
            for (int r0 = 0; r0 < 48; r0 += 8) {
                unsigned vv[8];
#pragma unroll
                for (int rr = 0; rr < 8; ++rr) if (r0 + rr < 46) { const int row = 16 * tb - 15 + r0 + rr; const bool ok = (unsigned)row < 64u; const unsigned t = zt[(ok ? row : 0) * 512 + tid]; vv[rr] = ok ? t : 0u; }
#pragma unroll
                for (int rr = 0; rr < 8; ++rr) { const int r = r0 + rr;
                    if (r < 46) { const f32x2 x = (f32x2){bflo(vv[rr]), bfhi(vv[rr])};
#pragma unroll
                        for (int o = 0; o < 16; ++o) { const int k = r - o; if (k >= 0 && k < 31) cz[o] += w[k] * x; } } }
            }
#pragma unroll
            for (int o = 0; o < 16; ++o) *(unsigned*)(AA + (size_t)(16 * tb + o) * 1024 + 2 * tid) = pk2(cz[o].x, cz[o].y);
        }
    }
    asm volatile("s_waitcnt vmcnt(0)" ::: "memory");
    __syncthreads();
    u32x4 ntile[16];
    if (g_next >= 0) { const u32x4* src = (const u32x4*)(Z + (size_t)g_next * 64 * 1024);
#pragma unroll
        for (int i = 0; i < 16; ++i) ntile[i] = src[tid + i * NTHR]; }
    f32x4 lg0[2], lg1[2], lb0[2], lb1[2];
#pragma unroll
    for (int hh = 0; hh < 2; ++hh) { const int c0 = hh * 512 + lane * 8;
        lg0[hh] = *(const f32x4*)(p.in[I_LNG] + c0); lg1[hh] = *(const f32x4*)(p.in[I_LNG] + c0 + 4); lb0[hh] = *(const f32x4*)(p.in[I_LNB] + c0); lb1[hh] = *(const f32x4*)(p.in[I_LNB] + c0 + 4); }
#pragma unroll 1
    for (int half = 0; half < 2; ++half) {
        u32x4 ra[4], rb[4];
#pragma unroll
        for (int rr = 0; rr < 4; ++rr) { const bf16_t* rp = AA + (size_t)(wave * 8 + half * 4 + rr) * 1024 + lane * 8; ra[rr] = *(const u32x4*)rp; rb[rr] = *(const u32x4*)(rp + 512); }
#pragma unroll
        for (int rr = 0; rr < 4; ++rr) {
            const int row = wave * 8 + half * 4 + rr;
            f32x4 x0, x1, x2, x3; unpk8(ra[rr], x0, x1); unpk8(rb[rr], x2, x3);
            const f32x4 sv = (x0 + x1) + (x2 + x3);
            const float mean = wave_sum_dpp((sv[0] + sv[1]) + (sv[2] + sv[3])) * (1.0f / 1024.0f);
            x0 -= mean; x1 -= mean; x2 -= mean; x3 -= mean;
            const f32x4 qv = (x0 * x0 + x1 * x1) + (x2 * x2 + x3 * x3);
            const float rstd = rsqrtf(wave_sum_dpp((qv[0] + qv[1]) + (qv[2] + qv[3])) * (1.0f / 1024.0f) + 1e-6f);
            x0 = x0 * rstd * lg0[0] + lb0[0]; x1 = x1 * rstd * lg1[0] + lb1[0]; x2 = x2 * rstd * lg0[1] + lb0[1]; x3 = x3 * rstd * lg1[1] + lb1[1];
#pragma unroll
            for (int e = 0; e < 4; ++e) { x0[e] = silu(x0[e]); x1[e] = silu(x1[e]); x2[e] = silu(x2[e]); x3[e] = silu(x3[e]); }
            bf16_t* o = AA + (size_t)row * 1024 + lane * 8;
            *(u32x4*)o = pk8(x0, x1); *(u32x4*)(o + 512) = pk8(x2, x3);
        }
    }
    if (g_next >= 0) { u32x4* d = (u32x4*)lds;
#pragma unroll
        for (int i = 0; i < 16; ++i) d[tid + i * NTHR] = ntile[i]; }
    __syncthreads();
}

constexpr int XC_STRIDE = 272;
constexpr int YB_STRIDE = 132;
constexpr int B_XC_OFF = 0, B_HIN_OFF = 256 * XC_STRIDE  , B_Y_OFF = B_HIN_OFF + 4096  , B_Y_BYTES = 64 * YB_STRIDE * 4  ;
constexpr size_t OFF_TOT256 = OFF_TOT + 9 * MiB;

__device__ __forceinline__ void lru_coef(float lr2, float li2, float nsp2, float xcv, float& a, float& b) {
    const float r = __builtin_amdgcn_rcpf(1.0f + __builtin_amdgcn_exp2f(lr2));
    a = __builtin_amdgcn_exp2f(nsp2 * r);
    const float v = __builtin_fmaf(-a, a, 1.0f);
    const float d = 1.0f + __builtin_amdgcn_exp2f(li2);
    b = (v * __builtin_amdgcn_rsqf(fmaxf(v * d * d, 1e-30f))) * xcv;
}

template <bool FINAL, int DIR>
__device__ __forceinline__ void lru_dir(const unsigned char* xcs, const bf16x8 (&fbr)[4], const bf16x8 (&fbi)[4], float br, float bi, float nsp, int fr, int q, int chl,
                                        float hin_v, f32x4 (&hout)[4], float& totA, float& totB) {
    f32x4 ar[4], ai[4];
#pragma unroll
    for (int m = 0; m < 4; ++m) { ar[m] = (f32x4){br, br, br, br}; ai[m] = (f32x4){bi, bi, bi, bi}; }
#pragma unroll
    for (int kk = 0; kk < 4; ++kk) {
#pragma unroll
        for (int m = 0; m < 4; ++m) { const bf16x8 fa = *(const bf16x8*)(xcs + (16 * m + fr) * XC_STRIDE + (32 * kk + 8 * q) * 2);
            ar[m] = __builtin_amdgcn_mfma_f32_16x16x32_bf16(fa, fbr[kk], ar[m], 0, 0, 0);
            ai[m] = __builtin_amdgcn_mfma_f32_16x16x32_bf16(fa, fbi[kk], ai[m], 0, 0, 0); }
    }
#pragma unroll
    for (int m = 0; m < 4; ++m)
#pragma unroll
        for (int i = 0; i < 4; ++i) {
            const float xcv = bf2f(*(const bf16_t*)(xcs + (16 * m + 4 * q + i) * XC_STRIDE + chl * 2));
            float a, b; lru_coef(ar[m][i], ai[m][i], nsp, xcv, a, b); ar[m][i] = a; ai[m][i] = b;
        }
    float At[4], Bt[4], Ae[4], Be[4];
#pragma unroll
    for (int m = 0; m < 4; ++m) {
        float A = 1.f, B = 0.f;
#pragma unroll
        for (int ii = 0; ii < 4; ++ii) { const int i = DIR ? 3 - ii : ii; B = ar[m][i] * B + ai[m][i]; A = ar[m][i] * A; }
        if (DIR == 0) {
            float tA = __shfl_up(A, 16), tB = __shfl_up(B, 16); if (q >= 1) { B = A * tB + B; A = A * tA; }
            tA = __shfl_up(A, 32); tB = __shfl_up(B, 32); if (q >= 2) { B = A * tB + B; A = A * tA; }
            Ae[m] = __shfl_up(A, 16); Be[m] = __shfl_up(B, 16); if (q == 0) { Ae[m] = 1.f; Be[m] = 0.f; }
            At[m] = __shfl(A, 48 + fr); Bt[m] = __shfl(B, 48 + fr);
        } else {
            float tA = __shfl_down(A, 16), tB = __shfl_down(B, 16); if (q <= 2) { B = A * tB + B; A = A * tA; }
            tA = __shfl_down(A, 32); tB = __shfl_down(B, 32); if (q <= 1) { B = A * tB + B; A = A * tA; }
            Ae[m] = __shfl_down(A, 16); Be[m] = __shfl_down(B, 16); if (q == 3) { Ae[m] = 1.f; Be[m] = 0.f; }
            At[m] = __shfl(A, fr); Bt[m] = __shfl(B, fr);
        }
    }
    if (!FINAL) {
        float A = 1.f, B = 0.f;
#pragma unroll
        for (int mm = 0; mm < 4; ++mm) { const int m = DIR ? 3 - mm : mm; B = At[m] * B + Bt[m]; A = At[m] * A; }
        totA = A; totB = B;
    } else {
        float hh = hin_v;
#pragma unroll
        for (int mm = 0; mm < 4; ++mm) { const int m = DIR ? 3 - mm : mm;
            float hs = Ae[m] * hh + Be[m];
#pragma unroll
            for (int ii = 0; ii < 4; ++ii) { const int i = DIR ? 3 - ii : ii; hs = ar[m][i] * hs + ai[m][i]; hout[m][i] = hs; }
            hh = At[m] * hh + Bt[m];
        }
    }
}

template <bool FINAL>
__device__ __forceinline__ void b_phase(const Params& p, int bid, int nb, unsigned char* lds) {
    const int tid = threadIdx.x, lane = tid & 63, wave = tid >> 6, fr = lane & 15, q = lane >> 4;
    f32x2* TOT = (f32x2*)(p.ws + OFF_TOT);
    f32x2* TOT256 = (f32x2*)(p.ws + OFF_TOT256);
    const bf16_t* WG = (const bf16_t*)(p.ws + OFF_WG);
    float* hin = (float*)(lds + B_HIN_OFF);
    const int chl = 16 * wave + fr;
    const int nitems = FINAL ? 1024 : 1024 + 128;
    int hprev = -1;
    bf16x8 fb[4][4];
    float* cst = (float*)(lds + B_Y_OFF + 2 * B_Y_BYTES);
    for (int it = bid; it < nitems; it += nb) {
        const bool isctx = it >= 1024;
        const int b = isctx ? (it - 1024) >> 5 : it >> 8, c256 = isctx ? -1 : (it >> 3) & 31, h = it & 7, csub = (it >> 3) & 3;
        const int seqlen = isctx ? CTXL : SEQ, sbase = isctx ? 0 : c256 * 256;
        const bf16_t* src = isctx ? (const bf16_t*)(p.ws + OFF_XRC) + (size_t)b * CTXL * 1024 : (const bf16_t*)(p.ws + OFF_SLOT + 3 * SLOT) + (size_t)b * SEQ * 1024;
        const int kc0 = isctx ? 0 : 4 + c256 * 4, k256 = isctx ? 0 : 1 + c256;
        const int ch = h * 128 + chl;
        if (h != hprev) {
            hprev = h;
#pragma unroll
            for (int ty = 0; ty < 4; ++ty)
#pragma unroll
                for (int kk = 0; kk < 4; ++kk) fb[ty][kk] = *(const bf16x8*)(WG + (size_t)(h * 512 + wave * 64 + ty * 16 + fr) * 128 + 32 * kk + 8 * q);
            if (q == 0) { const float L2E = 1.4426950408889634f;
                          cst[0 * 128 + chl] = -L2E * p.in[I_BRF][ch]; cst[1 * 128 + chl] = -L2E * p.in[I_BIF][ch]; cst[2 * 128 + chl] = -8.0f * L2E * log1pf(__expf(-p.in[I_LAMF][ch]));
                          cst[3 * 128 + chl] = -L2E * p.in[I_BRB][ch]; cst[4 * 128 + chl] = -L2E * p.in[I_BIB][ch]; cst[5 * 128 + chl] = -8.0f * L2E * log1pf(__expf(-p.in[I_LAMB][ch])); }
            wave_lds_sync();
        }
        float runAf = 1.f, runBf = 0.f, runAb = 1.f, runBb = 0.f;
        {
            const int cgp = tid & 15, c0 = h * 128 + 8 * cgp;
            float wk[4][8], bs[8];
            { const f32x4* bp = (const f32x4*)(p.in[I_LCB] + c0); const f32x4 t0_ = bp[0], t1_ = bp[1];
                bs[0] = t0_[0]; bs[1] = t0_[1]; bs[2] = t0_[2]; bs[3] = t0_[3]; bs[4] = t1_[0]; bs[5] = t1_[1]; bs[6] = t1_[2]; bs[7] = t1_[3];
#pragma unroll
                for (int k = 0; k < 4; ++k) { const f32x4* wp = (const f32x4*)(p.in[I_LCW] + k * 1024 + c0); const f32x4 w0 = wp[0], w1 = wp[1];
                    wk[k][0] = w0[0]; wk[k][1] = w0[1]; wk[k][2] = w0[2]; wk[k][3] = w0[3]; wk[k][4] = w1[0]; wk[k][5] = w1[1]; wk[k][6] = w1[2]; wk[k][7] = w1[3]; } }
#pragma unroll 1
            for (int ps = 0; ps < (isctx ? 1 : 2); ++ps) {
                if (isctx && tid >= 256) break;
                const int tq = isctx ? csub * 64 + (tid >> 4) * 4 : ps * 128 + (tid >> 4) * 4;
                float xc[4][8];
#pragma unroll
                for (int r = 0; r < 4; ++r)
#pragma unroll
                    for (int e = 0; e < 8; ++e) xc[r][e] = bs[e];
#pragma unroll
                for (int rr = 0; rr < 7; ++rr) {
                    const int row = sbase + tq + rr - 2;
                    u32x4 a = (u32x4){0u, 0u, 0u, 0u};
                    if (row >= 0 && row < seqlen) a = *(const u32x4*)(src + (size_t)row * 1024 + c0);
                    const float x[8] = {bflo(a.x), bfhi(a.x), bflo(a.y), bfhi(a.y), bflo(a.z), bfhi(a.z), bflo(a.w), bfhi(a.w)};
#pragma unroll
                    for (int r = 0; r < 4; ++r) { const int k = rr - r;
                        if (k >= 0 && k < 4) {
#pragma unroll
                            for (int e = 0; e < 8; ++e) xc[r][e] += wk[k][e] * x[e]; } }
                }
#pragma unroll
                for (int r = 0; r < 4; ++r) {
                    u32x4 o0; o0.x = pk2(xc[r][0], xc[r][1]); o0.y = pk2(xc[r][2], xc[r][3]); o0.z = pk2(xc[r][4], xc[r][5]); o0.w = pk2(xc[r][6], xc[r][7]);
                    *(u32x4*)(lds + B_XC_OFF + (tq + r) * XC_STRIDE + cgp * 16) = o0;
                }
            }
        }
        f32x2 ct[33], cs[4];
        const int cdir = (tid >> 7) & 1, ccl = tid & 127;
        if (FINAL && tid < 256) {
            const f32x2* T2 = TOT256 + ((size_t)b * 33 * 2 + cdir) * 1024 + h * 128 + ccl;
            const f32x2* T = TOT + ((size_t)b * NCH64 * 2 + cdir) * 1024 + h * 128 + ccl;
#pragma unroll
            for (int k = 1; k < 33; ++k) { const bool use = cdir == 0 ? (k < k256) : (k > k256); ct[k] = use ? T2[(size_t)k * 2048] : (f32x2){1.f, 0.f}; }
            { f32x2 c4[4];
#pragma unroll
                for (int s_ = 0; s_ < 4; ++s_) c4[s_] = T[(size_t)s_ * 2048];
                float A = 1.f, B = 0.f;
#pragma unroll
                for (int s_ = 0; s_ < 4; ++s_) { const f32x2 t = cdir == 0 ? c4[s_] : c4[3 - s_]; B = t.x * B + t.y; A = t.x * A; }
                ct[0] = (f32x2){A, B}; }
#pragma unroll
            for (int s_ = 0; s_ < 4; ++s_) cs[s_] = T[(size_t)(kc0 + s_) * 2048];
        }
        if (FINAL && tid < 256) {
            float hc = 0.f;
            if (cdir == 0) {
#pragma unroll
                for (int k = 0; k < 33; ++k) hc = ct[k].x * hc + ct[k].y;
#pragma unroll
                for (int s_ = 0; s_ < 4; ++s_) { hin[(s_ * 2 + 0) * 128 + ccl] = hc; hc = cs[s_].x * hc + cs[s_].y; }
            } else {
                hc = ct[0].y;
#pragma unroll
                for (int k = 32; k >= 1; --k) hc = ct[k].x * hc + ct[k].y;
#pragma unroll
                for (int s_ = 3; s_ >= 0; --s_) { hin[(s_ * 2 + 1) * 128 + ccl] = hc; hc = cs[s_].x * hc + cs[s_].y; }
            }
        }
        __syncthreads();
        for (int sub = isctx ? csub : 0; sub < (isctx ? csub + 1 : 4); ++sub) {
            const int t0 = sbase + 64 * sub;
            const unsigned char* xcs = lds + B_XC_OFF + 64 * sub * XC_STRIDE;
            f32x4 hf[4], hb[4]; float tA, tB;
            lru_dir<FINAL, 0>(xcs, fb[0], fb[1], cst[0 * 128 + chl], cst[1 * 128 + chl], cst[2 * 128 + chl], fr, q, chl, FINAL ? hin[(sub * 2 + 0) * 128 + chl] : 0.f, hf, tA, tB);
            if (!FINAL) { if (q == 0) TOT[((size_t)(b * NCH64 + kc0 + sub) * 2 + 0) * 1024 + ch] = (f32x2){tA, tB};
                runBf = tA * runBf + tB; runAf = tA * runAf; }
            u32x4 gy0, gy1;
            if (FINAL) { const bf16_t* GYG = (const bf16_t*)(p.ws + OFF_SLOT + 2 * SLOT) + ((size_t)b * SEQ + t0 + lane) * 1024 + h * 128 + 16 * wave;
                gy0 = *(const u32x4*)GYG; gy1 = *(const u32x4*)(GYG + 8); }
            lru_dir<FINAL, 1>(xcs, fb[2], fb[3], cst[3 * 128 + chl], cst[4 * 128 + chl], cst[5 * 128 + chl], fr, q, chl, FINAL ? hin[(sub * 2 + 1) * 128 + chl] : 0.f, hb, tA, tB);
            if (!FINAL) { if (q == 0) TOT[((size_t)(b * NCH64 + kc0 + sub) * 2 + 1) * 1024 + ch] = (f32x2){tA, tB};
                runBb = runAb * tB + runBb; runAb = runAb * tA; }
            if (FINAL) {
                float* wy = (float*)(lds + B_Y_OFF) + wave * (64 * 20);
#pragma unroll
                for (int m = 0; m < 4; ++m)
#pragma unroll
                    for (int i = 0; i < 4; ++i) wy[(16 * m + 4 * q + i) * 20 + fr] = hf[m][i] + hb[m][i];
                wave_lds_sync();
                const f32x4* yp = (const f32x4*)(wy + lane * 20);
                const f32x4 y0 = yp[0], y1 = yp[1], y2 = yp[2], y3 = yp[3];
                u32x4 o0, o1;
                o0.x = pk2(bflo(gy0.x) * y0[0], bfhi(gy0.x) * y0[1]); o0.y = pk2(bflo(gy0.y) * y0[2], bfhi(gy0.y) * y0[3]);
                o0.z = pk2(bflo(gy0.z) * y1[0], bfhi(gy0.z) * y1[1]); o0.w = pk2(bflo(gy0.w) * y1[2], bfhi(gy0.w) * y1[3]);
                o1.x = pk2(bflo(gy1.x) * y2[0], bfhi(gy1.x) * y2[1]); o1.y = pk2(bflo(gy1.y) * y2[2], bfhi(gy1.y) * y2[3]);
                o1.z = pk2(bflo(gy1.z) * y3[0], bfhi(gy1.z) * y3[1]); o1.w = pk2(bflo(gy1.w) * y3[2], bfhi(gy1.w) * y3[3]);
                bf16_t* AB = (bf16_t*)(p.ws + OFF_SLOT + 1 * SLOT) + ((size_t)b * SEQ + t0 + lane) * 1024 + h * 128 + 16 * wave;
                *(u32x4*)AB = o0; *(u32x4*)(AB + 8) = o1;
                wave_lds_sync();
            }
        }
        __syncthreads();
        if (!FINAL && q == 0 && !isctx) {
            TOT256[((size_t)(b * 33 + k256) * 2 + 0) * 1024 + ch] = (f32x2){runAf, runBf};
            TOT256[((size_t)(b * 33 + k256) * 2 + 1) * 1024 + ch] = (f32x2){runAb, runBb};
        }
    }
}

__device__ __forceinline__ void ph8_route(const Params& p, int bid, int nb, unsigned char* lds) {
    constexpr int NU = 1;
    const int tid = threadIdx.x, lane = tid & 63, wave = tid >> 6;
    float* Wl = (float*)lds;
    int* lcnt = (int*)(lds + 81920);
    int* lbase = lcnt + 16;
    int* tinfo = lcnt + 32;
    float* twt = (float*)(tinfo + 512);
#pragma unroll 1
    for (int kk = 0; kk < 2; ++kk) { const int k = tid + kk * NTHR;
        const f32x4 wg = *(const f32x4*)(p.in[I_WGRP] + k * 4);
        Wl[0 * 1024 + k] = wg[0]; Wl[1 * 1024 + k] = wg[1]; Wl[2 * 1024 + k] = wg[2]; Wl[3 * 1024 + k] = wg[3];
#pragma unroll
        for (int o4 = 0; o4 < 4; ++o4) { const f32x4 we = *(const f32x4*)(p.in[I_WER] + k * 16 + o4 * 4);
            Wl[(4 + o4 * 4 + 0) * 1024 + k] = we[0]; Wl[(4 + o4 * 4 + 1) * 1024 + k] = we[1]; Wl[(4 + o4 * 4 + 2) * 1024 + k] = we[2]; Wl[(4 + o4 * 4 + 3) * 1024 + k] = we[3]; } }
    __syncthreads();
    const float* MOD = (const float*)(p.ws + OFF_MOD);
    const bf16_t* X1B = (const bf16_t*)(p.ws + OFF_SLOT + 5 * SLOT);
    bf16_t* HM = (bf16_t*)(p.ws + OFF_SLOT + 2 * SLOT);
    unsigned* gcnt = (unsigned*)(p.ws + OFF_CTL);
    int* LIST = (int*)(p.ws + OFF_LIST); float* WLs = (float*)(p.ws + OFF_WL); int* ROUTE = (int*)(p.ws + OFF_ROUTE);
    float* bl = (float*)(lds + 81920 + 8192);
    if (tid < 20) bl[tid] = tid < 4 ? p.in[I_BGRP][tid] : p.in[I_BER][tid - 4];
    __syncthreads();
    for (int tile = bid; tile < NT / 128; tile += nb) {
        if (tid < 16) lcnt[tid] = 0;
        __syncthreads();
        const float* mrow = MOD + ((tile * 128) / SEQ) * 6144;
        f32x4 gq[4], shq[4], scq[4];
#pragma unroll
        for (int j = 0; j < 4; ++j) { const int c = lane * 4 + 256 * j; gq[j] = *(const f32x4*)(p.in[I_GFFN] + c); shq[j] = *(const f32x4*)(mrow + 3 * 1024 + c); scq[j] = *(const f32x4*)(mrow + 4 * 1024 + c); gq[j] = gq[j] * (1.0f + scq[j]); }
        u32x2 nx[4];
#pragma unroll
        for (int j = 0; j < 4; ++j) nx[j] = *(const u32x2*)(X1B + (size_t)(tile * 128 + wave * 16) * DM + lane * 4 + 256 * j);
#pragma unroll 1
        for (int tt = 0; tt < 16; tt += NU) {
            const int tl = wave * 16 + tt, tok = tile * 128 + tl;
            f32x4 v[NU][4]; float ss[NU];
#pragma unroll
            for (int u = 0; u < NU; ++u) ss[u] = 0.f;
#pragma unroll
            for (int j = 0; j < 4; ++j) { v[0][j] = (f32x4){bflo(nx[j].x), bfhi(nx[j].x), bflo(nx[j].y), bfhi(nx[j].y)}; const f32x4 sq = v[0][j] * v[0][j]; ss[0] += (sq[0] + sq[1]) + (sq[2] + sq[3]); }
            { const int tn = tt + 1 < 16 ? tok + 1 : tok;
#pragma unroll
                for (int j = 0; j < 4; ++j) nx[j] = *(const u32x2*)(X1B + (size_t)tn * DM + lane * 4 + 256 * j); }
            float lg[NU][20];
#pragma unroll
            for (int u = 0; u < NU; ++u) { const float rinv = rsqrtf(wave_sum_dpp(ss[u]) * (1.0f / DM) + 1e-6f);
#pragma unroll
                for (int j = 0; j < 4; ++j) { v[u][j] = v[u][j] * rinv * gq[j] + shq[j]; *(u32x2*)(HM + (size_t)(tok + u) * DM + lane * 4 + 256 * j) = pk4(v[u][j]); }
}
#pragma unroll
            for (int o = 0; o < 20; ++o)
            { f32x4 wv[4];
#pragma unroll
                for (int j = 0; j < 4; ++j) wv[j] = *(const f32x4*)(Wl + o * 1024 + lane * 4 + 256 * j);
#pragma unroll
                for (int u = 0; u < NU; ++u) { f32x4 pr = v[u][0] * wv[0]; pr += v[u][1] * wv[1]; pr += v[u][2] * wv[2]; pr += v[u][3] * wv[3]; lg[u][o] = (pr[0] + pr[1]) + (pr[2] + pr[3]); }
                if ((o & 3) == 3) asm volatile("" ::: "memory"); }
#pragma unroll
            for (int u = 0; u < NU; ++u) {
#pragma unroll
                for (int o = 0; o < 20; ++o) lg[u][o] = wave_sum_dpp(lg[u][o]) + bl[o];
                int gs = 0; float gm = lg[u][0];
#pragma unroll
                for (int o = 1; o < 4; ++o) if (lg[u][o] > gm) { gm = lg[u][o]; gs = o; }
                float den = 0.f;
#pragma unroll
                for (int o = 0; o < 4; ++o) den += __expf(lg[u][o] - gm);
                const float pg = 1.0f / den;
                float el[4];
#pragma unroll
                for (int o = 0; o < 4; ++o) el[o] = gs == 0 ? lg[u][4 + o] : gs == 1 ? lg[u][8 + o] : gs == 2 ? lg[u][12 + o] : lg[u][16 + o];
                int i1 = 0; float v1 = el[0];
#pragma unroll
                for (int o = 1; o < 4; ++o) if (el[o] > v1) { v1 = el[o]; i1 = o; }
                int i2 = -1; float v2 = -3.0e38f;
#pragma unroll
                for (int o = 0; o < 4; ++o) if (o != i1 && el[o] > v2) { v2 = el[o]; i2 = o; }
                const float w1 = 1.0f / (1.0f + __expf(v2 - v1)), w2 = 1.0f - w1;
                if (lane == 0) { const int e1 = gs * 4 + i1, e2 = gs * 4 + i2;
                    const int r1 = atomicAdd(&lcnt[e1], 1), r2 = atomicAdd(&lcnt[e2], 1);
                    tinfo[(tl + u) * 4 + 0] = e1; tinfo[(tl + u) * 4 + 1] = r1; tinfo[(tl + u) * 4 + 2] = e2; tinfo[(tl + u) * 4 + 3] = r2; twt[(tl + u) * 2] = pg * w1; twt[(tl + u) * 2 + 1] = pg * w2; }
            }
        }
        __syncthreads();
        if (tid < 16) lbase[tid] = (int)__hip_atomic_fetch_add(gcnt + tid, (unsigned)lcnt[tid], __ATOMIC_RELAXED, __HIP_MEMORY_SCOPE_AGENT);
        __syncthreads();
        if (tid < 128) { const int tok = tile * 128 + tid;
            const int e1 = tinfo[tid * 4], e2 = tinfo[tid * 4 + 2], p1 = lbase[e1] + tinfo[tid * 4 + 1], p2 = lbase[e2] + tinfo[tid * 4 + 3];
            LIST[e1 * NT + p1] = tok; LIST[e2 * NT + p2] = tok; WLs[e1 * NT + p1] = twt[tid * 2]; WLs[e2 * NT + p2] = twt[tid * 2 + 1];
            ROUTE[tok * 4 + 0] = e1; ROUTE[tok * 4 + 1] = p1; ROUTE[tok * 4 + 2] = e2; ROUTE[tok * 4 + 3] = p2; }
        __syncthreads();
    }
}

__device__ __forceinline__ void ph10_final(const Params& p, int bid, int nb, const int* meta) {
    const int lane = threadIdx.x & 63, wave = threadIdx.x >> 6;
    const float* MOD = (const float*)(p.ws + OFF_MOD);
    const bf16_t* Y = (const bf16_t*)(p.ws + OFF_SLOT);
    const int* ROUTE = (const int*)(p.ws + OFF_ROUTE);
    const bf16_t* X1B = (const bf16_t*)(p.ws + OFF_SLOT + 5 * SLOT); float* OUT = p.out;
    const int r0 = bid * 8 + wave, rs = nb * 8;
    f32x4 gf[4], gtv[4]; int mprev = -1;
#pragma unroll
    for (int j = 0; j < 4; ++j) gf[j] = *(const f32x4*)(p.in[I_GFINAL] + lane * 4 + 256 * j);
    auto yrow = [&](int r, int k) -> const bf16_t* { const int e = ROUTE[r * 4 + 2 * k], pp = ROUTE[r * 4 + 2 * k + 1]; return y_row(p.ws, (size_t)meta[16 + e] * 256 + pp); };
    u32x2 nx[4], na[4], nb2[4];
    const bf16_t *ya = yrow(r0, 0), *yb = yrow(r0, 1);
#pragma unroll
    for (int j = 0; j < 4; ++j) { const int c = lane * 4 + 256 * j; nx[j] = *(const u32x2*)(X1B + (size_t)r0 * DM + c); na[j] = *(const u32x2*)(ya + c); nb2[j] = *(const u32x2*)(yb + c); }
    { const int rn = r0 + rs < NT ? r0 + rs : r0; ya = yrow(rn, 0); yb = yrow(rn, 1); }
#pragma unroll 1
    for (int r = r0; r < NT; r += rs) {
        const int mb = r / SEQ;
        if (mb != mprev) { mprev = mb;
#pragma unroll
            for (int j = 0; j < 4; ++j) gtv[j] = *(const f32x4*)(MOD + mb * 6144 + 5 * 1024 + lane * 4 + 256 * j); }
        f32x4 v[4]; float ss = 0.f;
#pragma unroll
        for (int j = 0; j < 4; ++j) {
            v[j] = (f32x4){bflo(nx[j].x), bfhi(nx[j].x), bflo(nx[j].y), bfhi(nx[j].y)};
            const f32x4 ys = (f32x4){bflo(na[j].x) + bflo(nb2[j].x), bfhi(na[j].x) + bfhi(nb2[j].x), bflo(na[j].y) + bflo(nb2[j].y), bfhi(na[j].y) + bfhi(nb2[j].y)};
            v[j] += gtv[j] * ys; const f32x4 sq = v[j] * v[j]; ss += (sq[0] + sq[1]) + (sq[2] + sq[3]); }
        { const int rn = r + rs < NT ? r + rs : r;
#pragma unroll
            for (int j = 0; j < 4; ++j) { const int c = lane * 4 + 256 * j; nx[j] = *(const u32x2*)(X1B + (size_t)rn * DM + c); na[j] = *(const u32x2*)(ya + c); nb2[j] = *(const u32x2*)(yb + c); }
            const int rn2 = r + 2 * rs < NT ? r + 2 * rs : rn; ya = yrow(rn2, 0); yb = yrow(rn2, 1); }
        const float rinv = rsqrtf(wave_sum_dpp(ss) * (1.0f / DM) + 1e-6f);
#pragma unroll
        for (int j = 0; j < 4; ++j) *(f32x4*)(OUT + (size_t)r * DM + lane * 4 + 256 * j) = v[j] * rinv * gf[j];
    }
}

#define XB_TMO      128
#define XB_XCNT(j)  (256  + 64 * (j))
#define XB_XSUB(j)  (1280 + 64 * (j))
#define XB_XGEN(j)  (2304 + 64 * (j))
#define XB_TOP      3328
#define XB_TOPGEN   3392
#define XCD_BAR_WORDS 3456
#define XB_SPIN_CAP (1u << 18)
__device__ __forceinline__ unsigned xb_ld(unsigned* p)              { return __hip_atomic_load(p, __ATOMIC_RELAXED, __HIP_MEMORY_SCOPE_AGENT); }
__device__ __forceinline__ unsigned xb_add(unsigned* p, unsigned v) { return __hip_atomic_fetch_add(p, v, __ATOMIC_RELAXED, __HIP_MEMORY_SCOPE_AGENT); }
__device__ __forceinline__ unsigned xb_xcc_id() { return (unsigned)__builtin_amdgcn_s_getreg((3 << 11) | 20) & 0xFu; }
#define XB_SPIN(cond, bar) do { unsigned _sp = 0; while (cond) { __builtin_amdgcn_s_sleep(1); \
    if ((++_sp & 255u) == 0u) { if (xb_ld(&(bar)[XB_TMO])) break; if (_sp > XB_SPIN_CAP) { atomicAdd(&(bar)[XB_TMO], 1u); break; } } } } while (0)
struct XcdBarrier { unsigned* bar; unsigned x; volatile unsigned* st; };
__device__ __forceinline__ XcdBarrier xcd_barrier_post(unsigned* bar, volatile unsigned* st) {
    XcdBarrier b; b.bar = bar; b.x = xb_xcc_id(); b.st = st;
    if (threadIdx.x == 0) (void)xb_add(&bar[XB_XCNT(b.x)], 1u);
    return b;
}
__device__ __forceinline__ void xcd_barrier_complete(unsigned* bar, unsigned x, unsigned& nloc, unsigned& nx) {
    const unsigned G = gridDim.x * gridDim.y * gridDim.z;
    unsigned sum, cnt, mine, sp = 0u;
    for (;;) {
        sum = 0u; cnt = 0u; mine = 0u;
#pragma unroll
        for (unsigned j = 0; j < 16; ++j) { const unsigned c = xb_ld(&bar[XB_XCNT(j)]); sum += c; cnt += (c > 0u) ? 1u : 0u; mine = (j == x) ? c : mine; }
        if (sum == G) break;
        __builtin_amdgcn_s_sleep(1);
        if ((++sp & 255u) == 0u) { if (xb_ld(&bar[XB_TMO])) break; if (sp > XB_SPIN_CAP) { atomicAdd(&bar[XB_TMO], 1u); break; } }
    }
    nloc = mine > 0u ? mine : 1u; nx = cnt > 0u ? cnt : 1u;
}
__device__ __forceinline__ void xcd_barrier(const XcdBarrier& b) {
    asm volatile("s_waitcnt vmcnt(0)" ::: "memory");
    __syncthreads();
    if (threadIdx.x == 0) {
        unsigned* bar = b.bar;
        __builtin_amdgcn_s_waitcnt(0);
        unsigned nloc = b.st[0], nx = b.st[1];
        if (nloc == 0u) { xcd_barrier_complete(bar, b.x, nloc, nx); b.st[0] = nloc; b.st[1] = nx; }
        const unsigned old = xb_add(&bar[XB_XSUB(b.x)], 1u);
        const unsigned gen = old / nloc;
        if (old + 1u == (gen + 1u) * nloc) {
            __builtin_amdgcn_fence(__ATOMIC_RELEASE, "agent");
            asm volatile("s_waitcnt vmcnt(0)" ::: "memory");
            const unsigned og = xb_add(&bar[XB_TOP], 1u);
            const unsigned tg = og / nx;
            if (og + 1u == (tg + 1u) * nx) xb_add(&bar[XB_TOPGEN], 1u);
            else XB_SPIN(xb_ld(&bar[XB_TOPGEN]) == tg, bar);
            __builtin_amdgcn_fence(__ATOMIC_ACQUIRE, "agent");
            xb_add(&bar[XB_XGEN(b.x)], 1u);
            asm volatile("s_waitcnt vmcnt(0)" ::: "memory");
        } else {
            XB_SPIN(xb_ld(&bar[XB_XGEN(b.x)]) == gen, bar);
            __builtin_amdgcn_fence(__ATOMIC_ACQUIRE, "agent");
            asm volatile("s_waitcnt vmcnt(0)" ::: "memory");
        }
    }
    __syncthreads();
}
constexpr size_t OFF_BAR = OFF_CTL + 4096;

__global__ void __launch_bounds__(NTHR) mega(Params p, int lo, int hi) {
    extern __shared__ __attribute__((aligned(16))) unsigned char lds[];
    cg::grid_group grid = cg::this_grid();
    const int bid = blockIdx.x, nb = gridDim.x;
    unsigned char* ws = p.ws;
    bf16_t* S0 = (bf16_t*)(ws + OFF_SLOT), *S1 = (bf16_t*)(ws + OFF_SLOT + SLOT), *S2 = (bf16_t*)(ws + OFF_SLOT + 2 * SLOT), *S3 = (bf16_t*)(ws + OFF_SLOT + 3 * SLOT),
           *S4 = (bf16_t*)(ws + OFF_SLOT + 4 * SLOT), *S5 = (bf16_t*)(ws + OFF_SLOT + 5 * SLOT);
    const float* MOD = (const float*)(ws + OFF_MOD); const float* BINP = (const float*)(ws + OFF_BINP);
    int* meta = (int*)(lds + LDS_BYTES - 256);
#ifndef PHMASK
#define PHMASK 0x7ff
#endif
#define IN(k) (((PHMASK >> (k)) & 1) && lo <= (k) && (k) < hi)
#ifndef PIPE_MASK
#define PIPE_MASK 0x364
#endif
#define GEMM_RUN(k, gather, s, e) gemm_phase_pipe<gather>(lds, s, e)
    volatile unsigned* xst = (volatile unsigned*)(lds + LDS_BYTES - 16);
    if (threadIdx.x < 2) xst[threadIdx.x] = 0u;
    __syncthreads();
    XcdBarrier xbar; xbar.bar = (unsigned*)(ws + OFF_BAR); xbar.x = 0; xbar.st = xst;
    if (hi - lo > 1) xbar = xcd_barrier_post((unsigned*)(ws + OFF_BAR), xst);
    if (p.pv == 0x7eadbeef) grid.sync();
#define SEAM(k) do { if (IN(k) && IN((k) + 1)) xcd_barrier(xbar); } while (0)
    if (IN(0)) { ph0_prep(p, bid, nb, lds); } SEAM(0);
    if (IN(1)) { if (ph1_norm(p, bid, nb)) { SchCtx s{(const bf16_t*)(ws + OFF_HC), (const bf16_t*)(ws + OFF_WIN), CTX_GEMM_WGS, bid, 1024}; EpiCtx e{(bf16_t*)(ws + OFF_XRC), BINP}; GEMM_RUN(1, false, s, e); } } SEAM(1);
    if (IN(2)) {
        if (nb < 4 * CTX_GEMM_WGS) { SchCtx s{(const bf16_t*)(ws + OFF_HC), (const bf16_t*)(ws + OFF_WIN), nb, bid, 1024}; EpiCtx e{(bf16_t*)(ws + OFF_XRC), BINP}; GEMM_RUN(2, false, s, e); }
        { SchG1 s{S0, (const bf16_t*)(ws + OFF_WIN), nb, bid, 1024}; EpiG1 e{S1, S2, S3, S4, S5, BINP}; GEMM_RUN(2, false, s, e); }
    } SEAM(2);
    if (IN(3)) {
#ifndef NO_APREP
        { bool have = false; for (int g = bid; g < 512; g += nb) { const int gn = g + nb < 512 ? g + nb : -1; aprep_item(p, g, lds, have, gn); have = gn >= 0; } }
#endif
#ifndef NO_BLOCAL
        b_phase<false>(p, bid, nb, lds);
#endif
    } SEAM(3);
    if (IN(4)) {
        if (!(bid & 1)) { prep_items(p, PREP_EARLY, PREP_ALL, bid * 8 + (int)(threadIdx.x >> 6), nb * 8, lds); __syncthreads(); }
        b_phase<true>(p, bid, nb, lds);
        if (bid & 1) { __syncthreads(); prep_items(p, PREP_EARLY, PREP_ALL, bid * 8 + (int)(threadIdx.x >> 6), nb * 8, lds); }
    } SEAM(4);
    if (IN(5)) { SchG2 s{S0, S1, (const bf16_t*)(ws + OFF_WPA), (const bf16_t*)(ws + OFF_WPB), nb, bid, 1024}; EpiG2 e{S4, S5, S3}; GEMM_RUN(5, false, s, e); } SEAM(5);
    if (IN(6)) { SchG3 s{S3, (const bf16_t*)(ws + OFF_WO), nb, bid, 1024}; EpiG3 e{p.in[I_X], MOD, S5}; GEMM_RUN(6, false, s, e); } SEAM(6);
    if (IN(7)) { ph8_route(p, bid, nb, lds); } SEAM(7);
    if (IN(8)) { __syncthreads(); moe_meta_build(p, meta); MoeMeta mm{meta};
        int* idx = (int*)(lds + STAGE_BYTES);
        SchUp s{S2, (const bf16_t*)(ws + OFF_WGU), (const int*)(ws + OFF_LIST), mm, nb, bid, 1024, idx, (unsigned*)(ws + OFF_CTL) + 64}; EpiUp e{S3, (const float*)(ws + OFF_WL), mm};
        { int iv[8]; bool ok[8];
#pragma unroll
            for (int i = 0; i < 8; ++i) { Unit u; ok[i] = s.next(i, u); iv[i] = 0;
                if (ok[i] && threadIdx.x < 256) { int pos = u.aux2 + (int)threadIdx.x; const int c = mm.cnt(u.aux); pos = pos < c ? pos : c - 1; iv[i] = s.LIST[u.aux * NT + pos]; } }
#pragma unroll
            for (int i = 0; i < 8; ++i) if (ok[i] && threadIdx.x < 256) idx[i * 256 + threadIdx.x] = iv[i]; }
        __syncthreads();
        GEMM_RUN(8, true, s, e); }
    if (IN(9)) { __syncthreads(); moe_meta_build(p, meta); MoeMeta mm{meta};
        SchDn s{S3, (const bf16_t*)(ws + OFF_WDN), mm, nb, bid, 512, (unsigned*)(ws + OFF_CTL) + 64, IN(8)}; EpiDn e{ws, mm}; GEMM_RUN(9, false, s, e); } SEAM(9);
    if (IN(10)) { __syncthreads(); moe_meta_build(p, meta); ph10_final(p, bid, nb, meta); }
#undef IN
#undef SEAM
}

extern "C" void kernel_launch(void* const* d_in, const int* in_sizes, int n_in, void* d_out, int out_size, void* d_ws, size_t ws_size, hipStream_t stream) {
    static int grid = 0;
    if (grid == 0) {
        if (n_in != 37 || out_size != NT * DM || ws_size < WS_END) { fprintf(stderr, "kernel_launch: unexpected shapes: n_in %d out %d ws %zu (need %zu)\n", n_in, out_size, ws_size, (size_t)WS_END); grid = -1; return; }
        int dev = 0, cus = 0, per_cu = 0;
        (void)hipGetDevice(&dev); (void)hipDeviceGetAttribute(&cus, hipDeviceAttributeMultiprocessorCount, dev);
        if (hipFuncSetAttribute((const void*)mega, hipFuncAttributeMaxDynamicSharedMemorySize, LDS_BYTES) != hipSuccess) { fprintf(stderr, "kernel_launch: hipFuncSetAttribute failed\n"); grid = -1; return; }
        if (hipOccupancyMaxActiveBlocksPerMultiprocessor(&per_cu, (const void*)mega, NTHR, LDS_BYTES) != hipSuccess || per_cu < 1) { fprintf(stderr, "kernel_launch: occupancy query says %d\n", per_cu); per_cu = 1; }
        (void)hipGetLastError();
        grid = cus * 1;
        fprintf(stderr, "kernel_launch: grid %d (cus %d, per_cu %d)\n", grid, cus, per_cu);
    }
    if (grid < 0) return;
    Params p{};
    for (int i = 0; i < 37; ++i) p.in[i] = (const float*)d_in[i];
    p.out = (float*)d_out; p.ws = (unsigned char*)d_ws;
#if ONE_LAUNCH
    (void)hipMemsetAsync((unsigned char*)d_ws + OFF_BAR, 0, XCD_BAR_WORDS * 4, stream);
    int lo = 0, hi = NPHASE; void* args[] = {&p, &lo, &hi};
    hipError_t e = hipLaunchCooperativeKernel((const void*)mega, dim3(grid), dim3(NTHR), args, LDS_BYTES, stream);
    if (e != hipSuccess) fprintf(stderr, "cooperative launch failed: %s (grid %d)\n", hipGetErrorString(e), grid);
#ifdef PROBE_PHASE
    hipLaunchKernelGGL(mega, dim3(grid), dim3(NTHR), LDS_BYTES, stream, p, PROBE_PHASE, PROBE_PHASE + 1);
#endif
#else
    for (int k = 0; k < NPHASE; ++k) hipLaunchKernelGGL(mega, dim3(grid), dim3(NTHR), LDS_BYTES, stream, p, k, k + 1);
#endif
}
```

```cpp
#include <hip/hip_runtime.h>
#include <hip/hip_cooperative_groups.h>
#include <cstdio>
#include <cstdint>
namespace cg = cooperative_groups;

#ifndef ONE_LAUNCH
#define ONE_LAUNCH 1
#endif

typedef unsigned short bf16_t;
typedef short bf16x8 __attribute__((ext_vector_type(8)));
typedef float f32x4 __attribute__((ext_vector_type(4)));
typedef float f32x2 __attribute__((ext_vector_type(2)));
typedef unsigned u32x4 __attribute__((ext_vector_type(4)));
typedef unsigned u32x2 __attribute__((ext_vector_type(2)));

constexpr int NT = 32768, NCX = 1024, DM = 1024, SEQ = 8192, CTXL = 256;
constexpr int NTHR = 512;
constexpr int NCH64 = 132;
constexpr size_t MiB = (size_t)1 << 20;
constexpr size_t OFF_CTL = 0, OFF_MOD = 1 * MiB, OFF_BINP = OFF_MOD + 128 * 1024, OFF_WIN = 2 * MiB, OFF_WPA = 14 * MiB, OFF_WPB = 16 * MiB,
                 OFF_WO = 18 * MiB, OFF_WG = 20 * MiB, OFF_WGU = 22 * MiB, OFF_WDN = 54 * MiB, OFF_HC = 70 * MiB, OFF_XRC = 72 * MiB,
                 OFF_TOT = 74 * MiB, OFF_ROUTE = 84 * MiB, OFF_LIST = 85 * MiB, OFF_WL = 87 * MiB, OFF_SLOT = 90 * MiB, SLOT = 64 * MiB,
                 WS_END = OFF_SLOT + 6 * SLOT;
constexpr int LDS_BYTES = 144 * 1024;
constexpr int NPHASE = 11;

struct Params { const float* in[37]; float* out; unsigned char* ws; int pv; int pad; };

enum { I_X = 0, I_C, I_CTX, I_CCTX, I_WADA, I_BADA, I_GMIX, I_WIN, I_BIN, I_CONVW, I_CONVB, I_LNG, I_LNB, I_WPA, I_LCW, I_LCB,
       I_WRF, I_BRF, I_WIF, I_BIF, I_LAMF, I_WRB, I_BRB, I_WIB, I_BIB, I_LAMB, I_WPB, I_WO, I_GFFN, I_WGRP, I_BGRP, I_WER, I_BER,
       I_WGATE, I_WUP, I_WDOWN, I_GFINAL };

__device__ __forceinline__ float bflo(unsigned w) { return __uint_as_float(w << 16); }
__device__ __forceinline__ float bfhi(unsigned w) { return __uint_as_float(w & 0xffff0000u); }
__device__ __forceinline__ float bf2f(bf16_t h) { return __uint_as_float(((unsigned)h) << 16); }
__device__ __forceinline__ unsigned pk2(float lo, float hi) { unsigned r; asm("v_cvt_pk_bf16_f32 %0, %1, %2" : "=v"(r) : "v"(lo), "v"(hi)); return r; }
__device__ __forceinline__ bf16_t f2bf(float f) { return (bf16_t)(pk2(f, 0.f) & 0xffffu); }
__device__ __forceinline__ float sigm(float x) { return __builtin_amdgcn_rcpf(1.0f + __expf(-x)); }
__device__ __forceinline__ float sigm2(float x2) { return __builtin_amdgcn_rcpf(1.0f + __builtin_amdgcn_exp2f(x2)); }
__device__ __forceinline__ float silu(float x) { return x * sigm(x); }
__device__ __forceinline__ float gelu_tanh(float x) { return x * sigm(1.5957691216057308f * (x + 0.044715f * x * x * x)); }
__device__ __forceinline__ float wave_sum(float v) {
#pragma unroll
    for (int o = 1; o < 64; o <<= 1) v += __shfl_xor(v, o);
    return v;
}
template <int CTRL, int RMASK> __device__ __forceinline__ float dpp_add(float v) { return v + __int_as_float(__builtin_amdgcn_update_dpp(0, __float_as_int(v), CTRL, RMASK, 0xF, false)); }
__device__ __forceinline__ float wave_sum_dpp(float v) {
    v = dpp_add<0xB1, 0xF>(v); v = dpp_add<0x4E, 0xF>(v); v = dpp_add<0x141, 0xF>(v); v = dpp_add<0x140, 0xF>(v); v = dpp_add<0x142, 0xA>(v); v = dpp_add<0x143, 0xC>(v);
    return __int_as_float(__builtin_amdgcn_readlane(__float_as_int(v), 63));
}
__device__ __forceinline__ void wave_lds_sync() { asm volatile("s_waitcnt lgkmcnt(0)" ::: "memory"); __builtin_amdgcn_wave_barrier(); }
__device__ __forceinline__ u32x2 pk4(f32x4 v) { u32x2 r; r.x = pk2(v[0], v[1]); r.y = pk2(v[2], v[3]); return r; }

__device__ __forceinline__ u32x4 pk8(f32x4 a, f32x4 b) { u32x4 r; r.x = pk2(a[0], a[1]); r.y = pk2(a[2], a[3]); r.z = pk2(b[0], b[1]); r.w = pk2(b[2], b[3]); return r; }
__device__ __forceinline__ void unpk8(u32x4 w, f32x4& a, f32x4& b) { a[0] = bflo(w.x); a[1] = bfhi(w.x); a[2] = bflo(w.y); a[3] = bfhi(w.y); b[0] = bflo(w.z); b[1] = bfhi(w.z); b[2] = bflo(w.w); b[3] = bfhi(w.w); }

template <class DRow>
__device__ __forceinline__ void tr_item(const float* __restrict__ src, int ldsrc, int k0, int n0, bf16_t* dst, int ldd, DRow drow, float* scr, int lane, float scale = 1.0f) {
    const float* sp = src + (size_t)k0 * ldsrc + n0 + lane;
    float tv[64];
#pragma unroll
    for (int kk = 0; kk < 64; ++kk) tv[kk] = sp[(size_t)kk * ldsrc];
#pragma unroll
    for (int kk = 0; kk < 64; ++kk) scr[kk * 65 + lane] = tv[kk] * scale;
    wave_lds_sync();
    const int c = lane & 7;
#pragma unroll
    for (int j = 0; j < 8; ++j) {
        const int n = (lane >> 3) + 8 * j; const float* s = scr + (8 * c) * 65 + n;
        u32x4 o; o.x = pk2(s[0], s[65]); o.y = pk2(s[130], s[195]); o.z = pk2(s[260], s[325]); o.w = pk2(s[390], s[455]);
        *(u32x4*)(dst + (size_t)drow(n0 + n) * ldd + k0 + 8 * c) = o;
    }
    wave_lds_sync();
}

__device__ __forceinline__ int win_srccol(int np) { const int p = np >> 8, r = np & 255; return p < 8 ? (r >> 7) * 1024 + 128 * p + (r & 127) : np; }

constexpr int N_WIN = 16 * 96, N_SQ = 16 * 16, N_G = 128, N_GU = 2048, N_DN = 2048;
constexpr int PREP_EARLY = N_WIN + 3 * N_SQ + N_G, PREP_ALL = PREP_EARLY + 2 * N_GU + N_DN;
__device__ __forceinline__ void prep_items(const Params& p, int first, int last, int gw, int NGW, unsigned char* lds) {
    const int lane = threadIdx.x & 63, wave = threadIdx.x >> 6;
    unsigned char* ws = p.ws;
    float* scr = (float*)lds + wave * (64 * 65);
    for (int it = first + gw; it < last; it += NGW) {
        int r = it;
        if (r < N_WIN) { const int kb = r / 96, nbk = r % 96, d0 = 64 * nbk, sc0 = win_srccol(d0);
            const int pt = d0 >> 8; const bool sgm = (pt < 8 && ((d0 >> 7) & 1)) || pt >= 16;
            tr_item(p.in[I_WIN], 6144, 64 * kb, sc0, (bf16_t*)(ws + OFF_WIN), 1024, [=](int n) { return n - sc0 + d0; }, scr, lane, sgm ? -1.4426950408889634f : 1.0f); continue; }
        r -= N_WIN;
        if (r < 3 * N_SQ) { const int which = r / N_SQ, q = r % N_SQ, kb = q / 16, nbk = q % 16;
            const float* src = which == 0 ? p.in[I_WPA] : which == 1 ? p.in[I_WPB] : p.in[I_WO];
            bf16_t* dst = (bf16_t*)(ws + (which == 0 ? OFF_WPA : which == 1 ? OFF_WPB : OFF_WO));
            tr_item(src, 1024, 64 * kb, 64 * nbk, dst, 1024, [=](int n) { return n; }, scr, lane); continue; }
        r -= 3 * N_SQ;
        if (r < N_G) { const int ty = r / 32, q = r % 32, h = q / 4, kb = (q % 4) / 2, nbk = q % 2;
            const float* src = (ty == 0 ? p.in[I_WRF] : ty == 1 ? p.in[I_WIF] : ty == 2 ? p.in[I_WRB] : p.in[I_WIB]) + (size_t)h * 128 * 128;
            tr_item(src, 128, 64 * kb, 64 * nbk, (bf16_t*)(ws + OFF_WG), 128, [=](int n) { return h * 512 + (n >> 4) * 64 + ty * 16 + (n & 15); }, scr, lane, -1.4426950408889634f); continue; }
        r -= N_G;
        if (r < 2 * N_GU) { const int bj = r / N_GU, q = r % N_GU, e = q / 128, kb = (q % 128) / 8, nbk = q % 8;
            const float* src = (bj == 0 ? p.in[I_WGATE] : p.in[I_WUP]) + (size_t)e * 1024 * 512;
            tr_item(src, 512, 64 * kb, 64 * nbk, (bf16_t*)(ws + OFF_WGU) + (size_t)e * 1024 * 1024, 1024, [=](int n) { return 256 * (n >> 7) + 128 * bj + (n & 127); }, scr, lane); continue; }
        r -= 2 * N_GU;
        { const int e = r / 128, kb = (r % 128) / 16, nbk = r % 16;
            tr_item(p.in[I_WDOWN] + (size_t)e * 512 * 1024, 1024, 64 * kb, 64 * nbk, (bf16_t*)(ws + OFF_WDN) + (size_t)e * 1024 * 512, 512, [=](int n) { return n; }, scr, lane); }
    }
}

__device__ __forceinline__ void ph0_prep(const Params& p, int bid, int nb, unsigned char* lds) {
    const int tid = threadIdx.x, lane = tid & 63, wave = tid >> 6;
    unsigned char* ws = p.ws;
    float* red = (float*)lds;
    float* MOD = (float*)(ws + OFF_MOD);
    for (int it = bid; it < 96; it += nb) {
        const int col = it * 64 + lane;
        float a[5] = {0.f, 0.f, 0.f, 0.f, 0.f};
        const float* W = p.in[I_WADA];
#pragma unroll 1
        for (int k0 = wave * 128; k0 < wave * 128 + 128; k0 += 64) {
            float wv[64];
#pragma unroll
            for (int kk = 0; kk < 64; ++kk) wv[kk] = W[(size_t)(k0 + kk) * 6144 + col];
#pragma unroll
            for (int kk = 0; kk < 64; ++kk)
#pragma unroll
                for (int r = 0; r < 5; ++r) { const float cv = r < 4 ? p.in[I_C][r * 1024 + k0 + kk] : p.in[I_CCTX][k0 + kk]; a[r] += silu(cv) * wv[kk]; }
        }
#pragma unroll
        for (int r = 0; r < 5; ++r) red[(wave * 5 + r) * 64 + lane] = a[r];
        __syncthreads();
        if (tid < 320) { const int r = tid / 64, l = tid % 64; float s = 0.f;
#pragma unroll
            for (int w = 0; w < 8; ++w) s += red[(w * 5 + r) * 64 + l];
            MOD[r * 6144 + it * 64 + l] = s + p.in[I_BADA][it * 64 + l]; }
        __syncthreads();
    }
    __syncthreads();
    if (nb > 96 + 32) { if (bid >= 96) prep_items(p, 0, PREP_EARLY, (bid - 96) * 8 + wave, (nb - 96) * 8, lds); }
    else prep_items(p, 0, PREP_EARLY, bid * 8 + wave, nb * 8, lds);
    float* BINP = (float*)(ws + OFF_BINP);
    for (int i = bid * NTHR + tid; i < 6144; i += nb * NTHR) { const int pt = i >> 8; const bool sgm = (pt < 8 && ((i >> 7) & 1)) || pt >= 16; BINP[i] = p.in[I_BIN][win_srccol(i)] * (sgm ? -1.4426950408889634f : 1.0f); }
    if (bid == 0) ((unsigned*)(ws + OFF_CTL))[tid] = 0u;
}

template <bool WT>
__device__ __forceinline__ void norm_row(const f32x4 (&v)[4], float ss, const f32x4 (&gsv)[4], const f32x4 (&shv)[4], bf16_t* dst, int lane) {
    const float rinv = rsqrtf(wave_sum_dpp(ss) * (1.0f / DM) + 1e-6f);
#pragma unroll
    for (int j = 0; j < 4; ++j) { const int c = lane * 4 + 256 * j;
        const u32x2 o = pk4(v[j] * rinv * gsv[j] + shv[j]);
        if (WT) __hip_atomic_store((unsigned long long*)(dst + c), ((unsigned long long)o.y << 32) | o.x, __ATOMIC_RELAXED, __HIP_MEMORY_SCOPE_AGENT);
        else *(u32x2*)(dst + c) = o; }
}
constexpr int CTX_GEMM_WGS = 16;
__device__ __forceinline__ bool ph1_norm(const Params& p, int bid, int nb) {
    const int lane = threadIdx.x & 63, wave = threadIdx.x >> 6;
    const float* MOD = (const float*)(p.ws + OFF_MOD);
    unsigned* ctxcnt = (unsigned*)(p.ws + OFF_CTL) + 32;
    f32x4 gm[4];
#pragma unroll
    for (int j = 0; j < 4; ++j) gm[j] = *(const f32x4*)(p.in[I_GMIX] + lane * 4 + 256 * j);
    f32x4 shv[4], gsv[4];
    const bool split = nb >= 4 * CTX_GEMM_WGS;
    for (int cr = bid * 8 + wave; cr < NCX; cr += nb * 8) {
        const float* mrow = MOD + 4 * 6144;
        f32x4 v[4]; float ss = 0.f;
#pragma unroll
        for (int j = 0; j < 4; ++j) { const int c = lane * 4 + 256 * j; v[j] = *(const f32x4*)(p.in[I_CTX] + (size_t)cr * DM + c); const f32x4 sq = v[j] * v[j]; ss += (sq[0] + sq[1]) + (sq[2] + sq[3]);
            shv[j] = *(const f32x4*)(mrow + c); gsv[j] = gm[j] * (1.0f + *(const f32x4*)(mrow + 1024 + c)); }
        norm_row<true>(v, ss, gsv, shv, (bf16_t*)(p.ws + OFF_HC) + (size_t)cr * DM, lane);
        asm volatile("s_waitcnt vmcnt(0)" ::: "memory");
        if (lane == 0) __hip_atomic_fetch_add(ctxcnt, 1u, __ATOMIC_RELAXED, __HIP_MEMORY_SCOPE_AGENT);
    }
    if (split && bid < CTX_GEMM_WGS) {
        if (threadIdx.x == 0) { unsigned sp = 0;
            while (__hip_atomic_load(ctxcnt, __ATOMIC_RELAXED, __HIP_MEMORY_SCOPE_AGENT) < (unsigned)NCX) { __builtin_amdgcn_s_sleep(2); if (++sp > (1u << 22)) break; }
            __builtin_amdgcn_fence(__ATOMIC_ACQUIRE, "agent");
            asm volatile("s_waitcnt vmcnt(0)" ::: "memory"); }
        __syncthreads();
        return true;
    }
    const int wg0 = split ? CTX_GEMM_WGS : 0;
    const int r0 = (bid - wg0) * 8 + wave, rs = (nb - wg0) * 8;
    int mprev = -1;
    f32x4 nx[4];
#pragma unroll
    for (int j = 0; j < 4; ++j) nx[j] = *(const f32x4*)(p.in[I_X] + (size_t)r0 * DM + lane * 4 + 256 * j);
#pragma unroll 1
    for (int r = r0; r < NT; r += rs) {
        const int mb = r / SEQ;
        if (mb != mprev) { mprev = mb; const float* mrow = MOD + mb * 6144;
#pragma unroll
            for (int j = 0; j < 4; ++j) { const int c = lane * 4 + 256 * j; shv[j] = *(const f32x4*)(mrow + c); gsv[j] = gm[j] * (1.0f + *(const f32x4*)(mrow + 1024 + c)); } }
        f32x4 v[4]; float ss = 0.f;
#pragma unroll
        for (int j = 0; j < 4; ++j) { v[j] = nx[j]; const f32x4 sq = v[j] * v[j]; ss += (sq[0] + sq[1]) + (sq[2] + sq[3]); }
        { const int rn = r + rs < NT ? r + rs : r;
#pragma unroll
            for (int j = 0; j < 4; ++j) nx[j] = *(const f32x4*)(p.in[I_X] + (size_t)rn * DM + lane * 4 + 256 * j); }
        norm_row<false>(v, ss, gsv, shv, (bf16_t*)(p.ws + OFF_SLOT) + (size_t)r * DM, lane);
    }
    return false;
}

struct Unit { int pm, pn, aux, aux2; };

#define LAS __attribute__((address_space(3)))
constexpr int BK = 64, HTB = 128 * BK * 2, STAGE_BYTES = 8 * HTB;
__device__ __forceinline__ int lds_byte(int r, int c) { const int st = (r >> 4) * 2 + (c >> 5), rr = r & 15, cc = c & 31, ob = rr * 64 + cc * 2; return st * 1024 + (ob ^ (((ob >> 9) & 1) << 5)); }
__device__ __forceinline__ void stage_rc(int b, int& R, int& C) { const int st = b / 1024, sb = b % 1024, swz = sb ^ (((sb >> 9) & 1) << 5); R = (st >> 1) * 16 + swz / 64; C = (st & 1) * 32 + (swz % 64) / 2; }

template <bool GATHER, class S, class E>
__device__ __forceinline__ void gemm_phase_pipe(unsigned char* ldsg, const S& sch, const E& epi) {
    LAS unsigned char* lds = (LAS unsigned char*)ldsg;
    const int tid = threadIdx.x, wid = __builtin_amdgcn_readfirstlane(tid >> 6), lane = tid & 63, wr = wid >> 2, wc = wid & 3, fr = lane & 15, fq = lane >> 4;
    const int K = sch.K, nt = K / BK;
    int Rr[2], Cc[2]; unsigned voffA[2], voffB[2];
#pragma unroll
    for (int i = 0; i < 2; ++i) { stage_rc(tid * 16 + i * 8192, Rr[i], Cc[i]); voffA[i] = (unsigned)(Rr[i] * K + Cc[i]) * 2u;
        const int rho = Rr[i] & 31, Rb = (Rr[i] & ~31) + 8 * ((rho & 15) >> 2) + 4 * (rho >> 4) + (rho & 3);
        voffB[i] = (unsigned)(Rb * K + Cc[i]) * 2u; }
    const size_t kstep = (size_t)(BK * 2);
    const size_t hstep = (size_t)128 * K * 2;
    const unsigned ldsw = (unsigned)wid * 1024u;
    const int aoff = lds_byte(wr * 64 + fr, fq * 8), boff = lds_byte(wc * 32 + fr, fq * 8);
#define PG8_SA(b, h) (((b) * 2 + (h)) * HTB)
#define PG8_SB(b, h) ((4 + (b) * 2 + (h)) * HTB)
#define PG8_STAGE_B(bufoff, gbase) do { _Pragma("unroll") for (int _i = 0; _i < 2; ++_i) \
        __builtin_amdgcn_global_load_lds((const unsigned*)((const char*)(gbase) + voffB[_i]), (LAS unsigned*)(lds + (bufoff) + ldsw + _i * 8192), 16, 0, 0); } while (0)
#define PG8_STAGE_A(bufoff, gbase, h, vo) do { _Pragma("unroll") for (int _i = 0; _i < 2; ++_i) \
        __builtin_amdgcn_global_load_lds((const unsigned*)((const char*)(gbase) + (GATHER ? (size_t)(vo)[h][_i] : (size_t)(h) * hstep + voffA[_i])), (LAS unsigned*)(lds + (bufoff) + ldsw + _i * 8192), 16, 0, 0); } while (0)
#define PG8_LDA(dst, b, h) do { _Pragma("unroll") for (int m = 0; m < 4; ++m) _Pragma("unroll") for (int k = 0; k < 2; ++k) dst[m][k] = *(const LAS bf16x8*)(lds + PG8_SA(b, h) + aoff + m * 2048 + k * 1024); } while (0)
#define PG8_LDB(dst, b, h) do { _Pragma("unroll") for (int n = 0; n < 2; ++n) _Pragma("unroll") for (int k = 0; k < 2; ++k) dst[n][k] = *(const LAS bf16x8*)(lds + PG8_SB(b, h) + boff + n * 2048 + k * 1024); } while (0)
#define PG8_MMA(ai, bj, At, Bt) do { __builtin_amdgcn_s_setprio(1); _Pragma("unroll") for (int m = 0; m < 4; ++m) _Pragma("unroll") for (int n = 0; n < 2; ++n) _Pragma("unroll") for (int k = 0; k < 2; ++k) \
        acc[ai][bj][m][n] = __builtin_amdgcn_mfma_f32_16x16x32_bf16(Bt[n][k], At[m][k], acc[ai][bj][m][n], 0, 0, 0); __builtin_amdgcn_s_setprio(0); } while (0)
#define PG8_WAIT_V(n) asm volatile("s_waitcnt vmcnt(" #n ")" ::: "memory")
#define PG8_WAIT_L(n) asm volatile("s_waitcnt lgkmcnt(" #n ")" ::: "memory")
#define PG8_BAR __builtin_amdgcn_s_barrier()
#define PG8_SCHED __builtin_amdgcn_sched_barrier(0)
    Unit cur, nxt; int ui = 0;
    if (!sch.next(0, cur)) return;
    f32x4 acc[2][2][4][2];
#pragma unroll
    for (int a = 0; a < 2; ++a)
#pragma unroll
        for (int b = 0; b < 2; ++b)
#pragma unroll
            for (int m = 0; m < 4; ++m)
#pragma unroll
                for (int n = 0; n < 2; ++n) acc[a][b][m][n] = (f32x4){0.f, 0.f, 0.f, 0.f};
    bf16x8 At[4][2], B0[2][2], B1[2][2];
    unsigned voAc[2][2], voAn[2][2];
#pragma unroll
    for (int h = 0; h < 2; ++h)
#pragma unroll
        for (int i = 0; i < 2; ++i) { voAc[h][i] = GATHER ? sch.aoff(cur, 128 * h + Rr[i]) + (unsigned)Cc[i] * 2u : 0u; voAn[h][i] = voAc[h][i]; }
    const char* cA = sch.abase(cur); const char* cB = sch.bbase(cur);
    sch.a_ready(cur);
    PG8_STAGE_B(PG8_SB(0, 0), cB); PG8_STAGE_A(PG8_SA(0, 0), cA, 0, voAc); PG8_STAGE_B(PG8_SB(0, 1), cB + hstep); PG8_STAGE_A(PG8_SA(0, 1), cA, 1, voAc);
    if (wr == 1) PG8_BAR;
    PG8_WAIT_V(4); PG8_BAR;
    PG8_STAGE_B(PG8_SB(1, 0), cB + kstep); PG8_STAGE_A(PG8_SA(1, 0), cA + kstep, 0, voAc); PG8_STAGE_B(PG8_SB(1, 1), cB + hstep + kstep);
    PG8_WAIT_V(6); PG8_BAR;
    for (;;) {
        const bool has_next = sch.next(ui + 1, nxt);
        const char* nA = has_next ? sch.abase(nxt) : cA; const char* nB = has_next ? sch.bbase(nxt) : cB;
        if (GATHER) {
#pragma unroll
            for (int h = 0; h < 2; ++h)
#pragma unroll
                for (int i = 0; i < 2; ++i) voAn[h][i] = has_next ? sch.aoff(nxt, 128 * h + Rr[i]) + (unsigned)Cc[i] * 2u : voAc[h][i];
        }
#pragma unroll 1
        for (int t = 0; t < nt; t += 2) {
            const bool last = (t == nt - 2);
            const char* a1 = cA + (size_t)(t + 1) * kstep;
            const char* a2 = last ? nA : cA + (size_t)(t + 2) * kstep; const char* b2 = last ? nB : cB + (size_t)(t + 2) * kstep;
            const char* a3 = a2 + kstep; const char* b3 = b2 + kstep;
            if (last && has_next) sch.a_ready(nxt);
            unsigned vo2[2][2];
#pragma unroll
            for (int h = 0; h < 2; ++h)
#pragma unroll
                for (int i = 0; i < 2; ++i) vo2[h][i] = last ? voAn[h][i] : voAc[h][i];
            PG8_LDB(B0, 0, 0); PG8_SCHED; PG8_LDA(At, 0, 0); PG8_STAGE_A(PG8_SA(1, 1), a1, 1, voAc);
            PG8_WAIT_L(8); PG8_BAR; PG8_WAIT_L(0); PG8_MMA(0, 0, At, B0); PG8_BAR; PG8_SCHED;
            PG8_LDB(B1, 0, 1); PG8_STAGE_B(PG8_SB(0, 0), b2);
            PG8_BAR; PG8_WAIT_L(0); PG8_MMA(0, 1, At, B1); PG8_BAR;
            PG8_LDA(At, 0, 1); PG8_STAGE_A(PG8_SA(0, 0), a2, 0, vo2);
            PG8_BAR; PG8_WAIT_L(0); PG8_MMA(1, 0, At, B0); PG8_BAR; PG8_SCHED;
            PG8_STAGE_B(PG8_SB(0, 1), b2 + hstep);
            PG8_WAIT_V(6); PG8_BAR; PG8_MMA(1, 1, At, B1); PG8_BAR;
            PG8_LDB(B0, 1, 0); PG8_SCHED; PG8_LDA(At, 1, 0); PG8_STAGE_A(PG8_SA(0, 1), a2, 1, vo2);
            PG8_WAIT_L(8); PG8_BAR; PG8_WAIT_L(0); PG8_MMA(0, 0, At, B0); PG8_BAR; PG8_SCHED;
            PG8_LDB(B1, 1, 1); PG8_STAGE_B(PG8_SB(1, 0), b3);
            PG8_BAR; PG8_WAIT_L(0); PG8_MMA(0, 1, At, B1); PG8_BAR;
            PG8_LDA(At, 1, 1); PG8_STAGE_A(PG8_SA(1, 0), a3, 0, vo2);
            PG8_BAR; PG8_WAIT_L(0); PG8_MMA(1, 0, At, B0); PG8_BAR; PG8_SCHED;
            PG8_STAGE_B(PG8_SB(1, 1), b3 + hstep);
            PG8_WAIT_V(6); PG8_BAR; PG8_MMA(1, 1, At, B1); PG8_BAR;
        }
        { int frx = fr, fqx = fq; asm volatile("" : "+v"(frx), "+v"(fqx));
            const int jx = wc * 32 + 8 * fqx, rx = wr * 64 + frx;
            const typename E::Col ecol = epi.col(cur, jx);
            constexpr int PF = E::PF;
            typename E::Pre epre[8];
#pragma unroll
            for (int g = 0; g < PF; ++g) epre[g] = epi.load(cur, (g >> 2) * 128 + (g & 3) * 16 + rx, jx);
#pragma unroll
            for (int g = 0; g < 8; ++g) { const int ai = g >> 2, m = g & 3;
                if (g + PF < 8) epre[g + PF] = epi.load(cur, ((g + PF) >> 2) * 128 + ((g + PF) & 3) * 16 + rx, jx);
                epi.apply(cur, ai * 128 + m * 16 + rx, jx, ecol, epre[g], acc[ai][0][m][0], acc[ai][0][m][1], acc[ai][1][m][0], acc[ai][1][m][1]); } }
        sch.done(cur);
        if (!has_next) break;
#pragma unroll
        for (int a = 0; a < 2; ++a)
#pragma unroll
            for (int b = 0; b < 2; ++b)
#pragma unroll
                for (int m = 0; m < 4; ++m)
#pragma unroll
                    for (int n = 0; n < 2; ++n) acc[a][b][m][n] = (f32x4){0.f, 0.f, 0.f, 0.f};
        cur = nxt; cA = nA; cB = nB; ++ui;
#pragma unroll
        for (int h = 0; h < 2; ++h)
#pragma unroll
            for (int i = 0; i < 2; ++i) voAc[h][i] = voAn[h][i];
    }
    PG8_WAIT_V(0);
    if (wr == 0) PG8_BAR;
    PG8_BAR;
#undef PG8_SA
#undef PG8_SB
#undef PG8_STAGE_A
#undef PG8_STAGE_B
#undef PG8_LDA
#undef PG8_LDB
#undef PG8_MMA
#undef PG8_WAIT_V
#undef PG8_WAIT_L
#undef PG8_BAR
#undef PG8_SCHED
}

struct NoHooks {
    __device__ __forceinline__ void a_ready(const Unit&) const {}
    __device__ __forceinline__ void done(const Unit&) const {}
};
struct SchG1 { const bf16_t *A, *Bt; int G, c, K;
    __device__ __forceinline__ void a_ready(const Unit&) const {}
    __device__ __forceinline__ void done(const Unit&) const {}
    __device__ __forceinline__ bool next(int i, Unit& u) const { const int L = i * G + c; if (L >= 128 * 24) return false; u.pm = L / 24; u.pn = L % 24; return true; }
    __device__ __forceinline__ const bf16_t* arow(const Unit& u, int r) const { return A + (size_t)(u.pm * 256 + r) * 1024; }
    __device__ __forceinline__ const bf16_t* brow(const Unit& u, int n) const { return Bt + (size_t)(u.pn * 256 + n) * 1024; }
    __device__ __forceinline__ const char* abase(const Unit& u) const { return (const char*)(A + (size_t)u.pm * 256 * 1024); }
    __device__ __forceinline__ const char* bbase(const Unit& u) const { return (const char*)(Bt + (size_t)u.pn * 256 * 1024); }
    __device__ __forceinline__ unsigned aoff(const Unit&, int) const { return 0u; } };
struct EpiG1 { bf16_t *Z, *GYG, *XR, *SGA, *SGB; const float* bias;
    static constexpr int PF = 1; struct Col { f32x4 c0, c1, c2, c3; }; struct Pre { };
    __device__ __forceinline__ Col col(const Unit& u, int j) const { const float* bp = bias + u.pn * 256 + j; return Col{*(const f32x4*)bp, *(const f32x4*)(bp + 4), *(const f32x4*)(bp + 128), *(const f32x4*)(bp + 132)}; }
    __device__ __forceinline__ Pre load(const Unit&, int, int) const { return Pre{}; }
    __device__ __forceinline__ void apply(const Unit& u, int r, int j, const Col& c, const Pre&, f32x4 a0, f32x4 a1, f32x4 b0, f32x4 b1) const {
        const size_t row = (size_t)u.pm * 256 + r;
        a0 += c.c0; a1 += c.c1; b0 += c.c2; b1 += c.c3;
        if (u.pn < 8) {
#pragma unroll
            for (int e = 0; e < 4; ++e) { a0[e] *= sigm2(b0[e]); a1[e] *= sigm2(b1[e]); }
            *(u32x4*)(Z + row * 1024 + u.pn * 128 + j) = pk8(a0, a1); }
        else { const int kind = u.pn >> 2;
            bf16_t* dst = GYG + (size_t)(kind - 2) * (SLOT / 2);
#pragma unroll
            for (int e = 0; e < 4; ++e) { if (kind == 2) { a0[e] = gelu_tanh(a0[e]); a1[e] = gelu_tanh(a1[e]); b0[e] = gelu_tanh(b0[e]); b1[e] = gelu_tanh(b1[e]); }
                else if (kind >= 4) { a0[e] = sigm2(a0[e]); a1[e] = sigm2(a1[e]); b0[e] = sigm2(b0[e]); b1[e] = sigm2(b1[e]); } }
            bf16_t* o = dst + row * 1024 + (u.pn & 3) * 256 + j;
            *(u32x4*)o = pk8(a0, a1); *(u32x4*)(o + 128) = pk8(b0, b1); }
    } };
struct SchCtx { const bf16_t *A, *Bt; int G, c, K;
    __device__ __forceinline__ void a_ready(const Unit&) const {}
    __device__ __forceinline__ void done(const Unit&) const {}
    __device__ __forceinline__ bool next(int i, Unit& u) const { const int L = i * G + c; if (L >= 16) return false; u.pm = L / 4; u.pn = L % 4; return true; }
    __device__ __forceinline__ const bf16_t* arow(const Unit& u, int r) const { return A + (size_t)(u.pm * 256 + r) * 1024; }
    __device__ __forceinline__ const bf16_t* brow(const Unit& u, int n) const { return Bt + (size_t)((12 + u.pn) * 256 + n) * 1024; }
    __device__ __forceinline__ const char* abase(const Unit& u) const { return (const char*)(A + (size_t)u.pm * 256 * 1024); }
    __device__ __forceinline__ const char* bbase(const Unit& u) const { return (const char*)(Bt + (size_t)(12 + u.pn) * 256 * 1024); }
    __device__ __forceinline__ unsigned aoff(const Unit&, int) const { return 0u; } };
struct EpiCtx { bf16_t* XRC; const float* bias;
    static constexpr int PF = 1; struct Col { f32x4 c0, c1, c2, c3; }; struct Pre { };
    __device__ __forceinline__ Col col(const Unit& u, int j) const { const float* bp = bias + (12 + u.pn) * 256 + j; return Col{*(const f32x4*)bp, *(const f32x4*)(bp + 4), *(const f32x4*)(bp + 128), *(const f32x4*)(bp + 132)}; }
    __device__ __forceinline__ Pre load(const Unit&, int, int) const { return Pre{}; }
    __device__ __forceinline__ void apply(const Unit& u, int r, int j, const Col& c, const Pre&, f32x4 a0, f32x4 a1, f32x4 b0, f32x4 b1) const {
        const size_t row = (size_t)u.pm * 256 + r;
        a0 += c.c0; a1 += c.c1; b0 += c.c2; b1 += c.c3;
        bf16_t* o = XRC + row * 1024 + u.pn * 256 + j; *(u32x4*)o = pk8(a0, a1); *(u32x4*)(o + 128) = pk8(b0, b1); } };
struct SchG2 { const bf16_t *Aa, *Ab, *Wa, *Wb; int G, c, K;
    __device__ __forceinline__ void a_ready(const Unit&) const {}
    __device__ __forceinline__ void done(const Unit&) const {}
    __device__ __forceinline__ bool next(int i, Unit& u) const { const int t = (i >> 1) * G + c; if (t >= 512) return false; u.pm = t >> 2; u.pn = t & 3; u.aux = i & 1; return true; }
    __device__ __forceinline__ const bf16_t* arow(const Unit& u, int r) const { return Aa + (size_t)u.aux * (SLOT / 2) + (size_t)(u.pm * 256 + r) * 1024; }
    __device__ __forceinline__ const bf16_t* brow(const Unit& u, int n) const { return Wa + (size_t)u.aux * (1024 * 1024) + (size_t)(u.pn * 256 + n) * 1024; }
    __device__ __forceinline__ const char* abase(const Unit& u) const { return (const char*)(Aa + (size_t)u.aux * (SLOT / 2) + (size_t)u.pm * 256 * 1024); }
    __device__ __forceinline__ const char* bbase(const Unit& u) const { return (const char*)(Wa + (size_t)u.aux * (1024 * 1024) + (size_t)u.pn * 256 * 1024); }
    __device__ __forceinline__ unsigned aoff(const Unit&, int) const { return 0u; } };
struct EpiG2 { const bf16_t *SGA, *SGB; bf16_t* M;
    static constexpr int PF = 2; struct Col { }; struct Pre { u32x4 g0, g1, t0, t1; };
    __device__ __forceinline__ Col col(const Unit&, int) const { return Col{}; }
    __device__ __forceinline__ Pre load(const Unit& u, int r, int j) const {
        const size_t o = ((size_t)u.pm * 256 + r) * 1024 + u.pn * 256 + j; const bf16_t* G = SGA + (size_t)u.aux * (SLOT / 2);
        Pre q; q.g0 = *(const u32x4*)(G + o); q.g1 = *(const u32x4*)(G + o + 128);
        if (u.aux) { q.t0 = *(const u32x4*)(M + o); q.t1 = *(const u32x4*)(M + o + 128); } else { q.t0 = (u32x4){0u, 0u, 0u, 0u}; q.t1 = q.t0; }
        return q; }
    __device__ __forceinline__ void apply(const Unit& u, int r, int j, const Col&, const Pre& q, f32x4 a0, f32x4 a1, f32x4 b0, f32x4 b1) const {
        const size_t o = ((size_t)u.pm * 256 + r) * 1024 + u.pn * 256 + j;
        f32x4 g0, g1, g2, g3, t0, t1, t2, t3; unpk8(q.g0, g0, g1); unpk8(q.g1, g2, g3); unpk8(q.t0, t0, t1); unpk8(q.t1, t2, t3);
        a0 = a0 * g0 + t0; a1 = a1 * g1 + t1; b0 = b0 * g2 + t2; b1 = b1 * g3 + t3;
        *(u32x4*)(M + o) = pk8(a0, a1); *(u32x4*)(M + o + 128) = pk8(b0, b1); } };
struct SchG3 { const bf16_t *A, *Bt; int G, c, K;
    __device__ __forceinline__ void a_ready(const Unit&) const {}
    __device__ __forceinline__ void done(const Unit&) const {}
    __device__ __forceinline__ bool next(int i, Unit& u) const { const int L = i * G + c; if (L >= 512) return false; u.pm = L >> 2; u.pn = L & 3; return true; }
    __device__ __forceinline__ const bf16_t* arow(const Unit& u, int r) const { return A + (size_t)(u.pm * 256 + r) * 1024; }
    __device__ __forceinline__ const bf16_t* brow(const Unit& u, int n) const { return Bt + (size_t)(u.pn * 256 + n) * 1024; }
    __device__ __forceinline__ const char* abase(const Unit& u) const { return (const char*)(A + (size_t)u.pm * 256 * 1024); }
    __device__ __forceinline__ const char* bbase(const Unit& u) const { return (const char*)(Bt + (size_t)u.pn * 256 * 1024); }
    __device__ __forceinline__ unsigned aoff(const Unit&, int) const { return 0u; } };
struct EpiG3 { const float *X, *MOD; bf16_t* X1B;
    static constexpr int PF = 3; struct Col { f32x4 c0, c1, c2, c3; }; struct Pre { f32x4 x0, x1, x2, x3; };
    __device__ __forceinline__ Col col(const Unit& u, int j) const { const float* gt = MOD + ((u.pm * 256) / SEQ) * 6144 + 2 * 1024 + u.pn * 256 + j; return Col{*(const f32x4*)gt, *(const f32x4*)(gt + 4), *(const f32x4*)(gt + 128), *(const f32x4*)(gt + 132)}; }
    __device__ __forceinline__ Pre load(const Unit& u, int r, int j) const { const float* xp = X + ((size_t)u.pm * 256 + r) * 1024 + u.pn * 256 + j; return Pre{*(const f32x4*)xp, *(const f32x4*)(xp + 4), *(const f32x4*)(xp + 128), *(const f32x4*)(xp + 132)}; }
    __device__ __forceinline__ void apply(const Unit& u, int r, int j, const Col& c, const Pre& q, f32x4 a0, f32x4 a1, f32x4 b0, f32x4 b1) const {
        bf16_t* op = X1B + ((size_t)u.pm * 256 + r) * 1024 + u.pn * 256 + j;
        *(u32x4*)op = pk8(q.x0 + c.c0 * a0, q.x1 + c.c1 * a1); *(u32x4*)(op + 128) = pk8(q.x2 + c.c2 * b0, q.x3 + c.c3 * b1); } };
__device__ __forceinline__ bf16_t* y_row(unsigned char* ws, size_t row) {
    return row < 65536 ? (bf16_t*)(ws + OFF_SLOT) + row * 1024 : (bf16_t*)(ws + OFF_SLOT + 4 * SLOT + 8 * MiB) + (row - 65536) * 1024;
}
struct MoeMeta { const int* m;
    __device__ __forceinline__ int cnt(int e) const { return __builtin_amdgcn_readfirstlane(m[e]); }
    __device__ __forceinline__ int tb(int e) const { return __builtin_amdgcn_readfirstlane(m[16 + e]); }
    __device__ __forceinline__ int ntiles() const { return __builtin_amdgcn_readfirstlane(m[32]); }
    __device__ __forceinline__ int find(int mt) const { int e = 0;
#pragma unroll
        for (int k = 1; k < 16; ++k) e += (__builtin_amdgcn_readfirstlane(m[16 + k]) <= mt) ? 1 : 0;
        return e; } };
__device__ __forceinline__ void moe_meta_build(const Params& p, int* meta) {
    if (threadIdx.x == 0) { const unsigned* cnt = (const unsigned*)(p.ws + OFF_CTL); int t = 0;
        for (int e = 0; e < 16; ++e) { const int c = (int)__hip_atomic_load(cnt + e, __ATOMIC_RELAXED, __HIP_MEMORY_SCOPE_AGENT); meta[e] = c; meta[16 + e] = t; t += (c + 255) >> 8; }
        meta[32] = t; }
    __syncthreads();
}
struct SchUp { const bf16_t *HM, *W; const int* LIST; MoeMeta mm; int G, c, K; const int* idx; unsigned* cntM;
    __device__ __forceinline__ bool next(int i, Unit& u) const { const int L = i * G + c; if (L >= 4 * mm.ntiles()) return false; const int mt = L >> 2; u.pn = L & 3; u.aux = mm.find(mt); u.aux2 = (mt - mm.tb(u.aux)) * 256; u.pm = mt | (i << 16); return true; }
    __device__ __forceinline__ void a_ready(const Unit&) const {}
    __device__ __forceinline__ void done(const Unit& u) const { asm volatile("s_waitcnt vmcnt(0)" ::: "memory");
        if ((threadIdx.x & 63) == 0) __hip_atomic_fetch_add(cntM + (u.pm & 0xffff), 1u, __ATOMIC_RELAXED, __HIP_MEMORY_SCOPE_AGENT); }
    __device__ __forceinline__ const char* abase(const Unit&) const { return (const char*)HM; }
    __device__ __forceinline__ const char* bbase(const Unit& u) const { return (const char*)(W + ((size_t)u.aux * 1024 + u.pn * 256) * 1024); }
    __device__ __forceinline__ unsigned aoff(const Unit& u, int r) const { return (unsigned)idx[(u.pm >> 16) * 256 + r] * 2048u; }
    __device__ __forceinline__ const bf16_t* arow(const Unit& u, int r) const { int pos = u.aux2 + r; const int c = mm.cnt(u.aux); pos = pos < c ? pos : c - 1; return HM + (size_t)LIST[u.aux * NT + pos] * 1024; }
    __device__ __forceinline__ const bf16_t* brow(const Unit& u, int n) const { return W + ((size_t)u.aux * 1024 + u.pn * 256 + n) * 1024; } };
struct EpiUp { bf16_t* ACT; const float* WL; MoeMeta mm;
    static constexpr int PF = 2; struct Col { }; struct Pre { float wt; };
    __device__ __forceinline__ Col col(const Unit&, int) const { return Col{}; }
    __device__ __forceinline__ Pre load(const Unit& u, int r, int) const { const int pos = u.aux2 + r; return Pre{pos < mm.cnt(u.aux) ? WL[u.aux * NT + pos] : 0.f}; }
    __device__ __forceinline__ void apply(const Unit& u, int r, int j, const Col&, const Pre& q, f32x4 g0, f32x4 g1, f32x4 u0, f32x4 u1) const {
        if (u.aux2 + r >= mm.cnt(u.aux)) return;
#pragma unroll
        for (int e = 0; e < 4; ++e) { g0[e] = silu(g0[e]) * u0[e] * q.wt; g1[e] = silu(g1[e]) * u1[e] * q.wt; }
        const __amdgpu_buffer_rsrc_t rsrc = __builtin_amdgcn_make_buffer_rsrc((void*)ACT, 0, 0x7fffffff, 0x00020000);
        __builtin_amdgcn_raw_buffer_store_b128(pk8(g0, g1), rsrc, (int)((((unsigned)(u.pm & 0xffff) * 256u + (unsigned)r) * 512u + (unsigned)(u.pn * 128 + j)) * 2u), 0, 16); } };
struct SchDn { const bf16_t *ACT, *W; MoeMeta mm; int G, c, K; unsigned* cntM; bool waitc;
    __device__ __forceinline__ bool next(int i, Unit& u) const {
        const int D = 4 * mm.ntiles(), umin = D / G, n5 = D - umin * G;
        int xh = (D - 2 * (G - n5)) / G; xh = xh < 0 ? 0 : xh; if (n5 == 0) xh = 0;
        int L;
        if (c < n5) { if (i >= xh) return false; L = c * xh + i; } else { L = n5 * xh + (c - n5) + (G - n5) * i; }
        if (L >= D) return false;
        const int mt = L >> 2; u.pn = L & 3; u.aux = mm.find(mt); u.aux2 = (mt - mm.tb(u.aux)) * 256; u.pm = mt; return true; }
    __device__ __forceinline__ void a_ready(const Unit& u) const {
        if (!waitc) return;
        if (threadIdx.x < 64) { unsigned sp = 0;
            while (__hip_atomic_load(cntM + u.pm, __ATOMIC_RELAXED, __HIP_MEMORY_SCOPE_AGENT) < 32u) { __builtin_amdgcn_s_sleep(2); if (++sp > (1u << 22)) break; }
            __builtin_amdgcn_fence(__ATOMIC_ACQUIRE, "agent");
            asm volatile("s_waitcnt vmcnt(0)" ::: "memory"); }
        asm volatile("" ::: "memory"); __builtin_amdgcn_s_barrier(); asm volatile("" ::: "memory"); }
    __device__ __forceinline__ void done(const Unit&) const {}
    __device__ __forceinline__ const char* abase(const Unit& u) const { return (const char*)(ACT + (size_t)u.pm * 256 * 512); }
    __device__ __forceinline__ const char* bbase(const Unit& u) const { return (const char*)(W + ((size_t)u.aux * 1024 + u.pn * 256) * 512); }
    __device__ __forceinline__ unsigned aoff(const Unit&, int) const { return 0u; } };
struct EpiDn { unsigned char* WS; MoeMeta mm;
    static constexpr int PF = 1; struct Col { }; struct Pre { };
    __device__ __forceinline__ Col col(const Unit&, int) const { return Col{}; }
    __device__ __forceinline__ Pre load(const Unit&, int, int) const { return Pre{}; }
    __device__ __forceinline__ void apply(const Unit& u, int r, int j, const Col&, const Pre&, f32x4 a0, f32x4 a1, f32x4 b0, f32x4 b1) const {
        if (u.aux2 + r >= mm.cnt(u.aux)) return;
        bf16_t* o = y_row(WS, (size_t)u.pm * 256 + r) + u.pn * 256 + j; *(u32x4*)o = pk8(a0, a1); *(u32x4*)(o + 128) = pk8(b0, b1); } };

__device__ __forceinline__ void aprep_item(const Params& p, int g, unsigned char* lds, bool have_tile, int g_next) {
    const int tid = threadIdx.x, lane = tid & 63, wave = tid >> 6;
    const bf16_t* Z = (const bf16_t*)(p.ws + OFF_SLOT + 1 * SLOT);
    bf16_t* AA = (bf16_t*)(p.ws + OFF_SLOT + 0 * SLOT) + (size_t)g * 64 * 1024;
    const unsigned* zt = (const unsigned*)lds;
    if (!have_tile) { const u32x4* src = (const u32x4*)(Z + (size_t)g * 64 * 1024); u32x4* d = (u32x4*)lds;
        u32x4 tmp[16];
#pragma unroll
        for (int i = 0; i < 16; ++i) tmp[i] = src[tid + i * NTHR];
#pragma unroll
        for (int i = 0; i < 16; ++i) d[tid + i * NTHR] = tmp[i]; }
    __syncthreads();
    {
        f32x2 w[31];
        const float* cw = p.in[I_CONVW] + 2 * tid;
#pragma unroll
        for (int k = 0; k < 31; ++k) w[k] = *(const f32x2*)(cw + k * 1024);
        const f32x2 cb = *(const f32x2*)(p.in[I_CONVB] + 2 * tid);
#pragma unroll 1
        for (int tb = 0; tb < 4; ++tb) {
            f32x2 cz[16];
#pragma unroll
            for (int o = 0; o < 16; ++o) cz[o] = cb;
#pragma unroll
            for (int r0 = 0; r0 < 48; r0 += 8) {
                unsigned vv[8];
#pragma unroll
                for (int rr = 0; rr < 8; ++rr) if (r0 + rr < 46) { const int row = 16 * tb - 15 + r0 + rr; const bool ok = (unsigned)row < 64u; const unsigned t = zt[(ok ? row : 0) * 512 + tid]; vv[rr] = ok ? t : 0u; }
#pragma unroll
                for (int rr = 0; rr < 8; ++rr) { const int r = r0 + rr;
                    if (r < 46) { const f32x2 x = (f32x2){bflo(vv[rr]), bfhi(vv[rr])};
#pragma unroll
                        for (int o = 0; o < 16; ++o) { const int k = r - o; if (k >= 0 && k < 31) cz[o] += w[k] * x; } } }
            }
#pragma unroll
            for (int o = 0; o < 16; ++o) *(unsigned*)(AA + (size_t)(16 * tb + o) * 1024 + 2 * tid) = pk2(cz[o].x, cz[o].y);
        }
    }
    asm volatile("s_waitcnt vmcnt(0)" ::: "memory");
    __syncthreads();
    u32x4 ntile[16];
    if (g_next >= 0) { const u32x4* src = (const u32x4*)(Z + (size_t)g_next * 64 * 1024);
#pragma unroll
        for (int i = 0; i < 16; ++i) ntile[i] = src[tid + i * NTHR]; }
    f32x4 lg0[2], lg1[2], lb0[2], lb1[2];
#pragma unroll
    for (int hh = 0; hh < 2; ++hh) { const int c0 = hh * 512 + lane * 8;
        lg0[hh] = *(const f32x4*)(p.in[I_LNG] + c0); lg1[hh] = *(const f32x4*)(p.in[I_LNG] + c0 + 4); lb0[hh] = *(const f32x4*)(p.in[I_LNB] + c0); lb1[hh] = *(const f32x4*)(p.in[I_LNB] + c0 + 4); }
#pragma unroll 1
    for (int half = 0; half < 2; ++half) {
        u32x4 ra[4], rb[4];
#pragma unroll
        for (int rr = 0; rr < 4; ++rr) { const bf16_t* rp = AA + (size_t)(wave * 8 + half * 4 + rr) * 1024 + lane * 8; ra[rr] = *(const u32x4*)rp; rb[rr] = *(const u32x4*)(rp + 512); }
#pragma unroll
        for (int rr = 0; rr < 4; ++rr) {
            const int row = wave * 8 + half * 4 + rr;
            f32x4 x0, x1, x2, x3; unpk8(ra[rr], x0, x1); unpk8(rb[rr], x2, x3);
            const f32x4 sv = (x0 + x1) + (x2 + x3);
            const float mean = wave_sum_dpp((sv[0] + sv[1]) + (sv[2] + sv[3])) * (1.0f / 1024.0f);
            x0 -= mean; x1 -= mean; x2 -= mean; x3 -= mean;
            const f32x4 qv = (x0 * x0 + x1 * x1) + (x2 * x2 + x3 * x3);
            const float rstd = rsqrtf(wave_sum_dpp((qv[0] + qv[1]) + (qv[2] + qv[3])) * (1.0f / 1024.0f) + 1e-6f);
            x0 = x0 * rstd * lg0[0] + lb0[0]; x1 = x1 * rstd * lg1[0] + lb1[0]; x2 = x2 * rstd * lg0[1] + lb0[1]; x3 = x3 * rstd * lg1[1] + lb1[1];
#pragma unroll
            for (int e = 0; e < 4; ++e) { x0[e] = silu(x0[e]); x1[e] = silu(x1[e]); x2[e] = silu(x2[e]); x3[e] = silu(x3[e]); }
            bf16_t* o = AA + (size_t)row * 1024 + lane * 8;
            *(u32x4*)o = pk8(x0, x1); *(u32x4*)(o + 512) = pk8(x2, x3);
        }
    }
    if (g_next >= 0) { u32x4* d = (u32x4*)lds;
#pragma unroll
        for (int i = 0; i < 16; ++i) d[tid + i * NTHR] = ntile[i]; }
    __syncthreads();
}

constexpr int XC_STRIDE = 272;
constexpr int YB_STRIDE = 132;
constexpr int B_XC_OFF = 0, B_HIN_OFF = 256 * XC_STRIDE  , B_Y_OFF = B_HIN_OFF + 4096  , B_Y_BYTES = 64 * YB_STRIDE * 4  ;
constexpr size_t OFF_TOT256 = OFF_TOT + 9 * MiB;

__device__ __forceinline__ void lru_coef(float lr2, float li2, float nsp2, float xcv, float& a, float& b) {
    const float r = __builtin_amdgcn_rcpf(1.0f + __builtin_amdgcn_exp2f(lr2));
    a = __builtin_amdgcn_exp2f(nsp2 * r);
    const float v = __builtin_fmaf(-a, a, 1.0f);
    const float d = 1.0f + __builtin_amdgcn_exp2f(li2);
    b = (v * __builtin_amdgcn_rsqf(fmaxf(v * d * d, 1e-30f))) * xcv;
}

template <bool FINAL, int DIR>
__device__ __forceinline__ void lru_dir(const unsigned char* xcs, const bf16x8 (&fbr)[4], const bf16x8 (&fbi)[4], float br, float bi, float nsp, int fr, int q, int chl,
                                        float hin_v, f32x4 (&hout)[4], float& totA, float& totB) {
    f32x4 ar[4], ai[4];
#pragma unroll
    for (int m = 0; m < 4; ++m) { ar[m] = (f32x4){br, br, br, br}; ai[m] = (f32x4){bi, bi, bi, bi}; }
#pragma unroll
    for (int kk = 0; kk < 4; ++kk) {
#pragma unroll
        for (int m = 0; m < 4; ++m) { const bf16x8 fa = *(const bf16x8*)(xcs + (16 * m + fr) * XC_STRIDE + (32 * kk + 8 * q) * 2);
            ar[m] = __builtin_amdgcn_mfma_f32_16x16x32_bf16(fa, fbr[kk], ar[m], 0, 0, 0);
            ai[m] = __builtin_amdgcn_mfma_f32_16x16x32_bf16(fa, fbi[kk], ai[m], 0, 0, 0); }
    }
#pragma unroll
    for (int m = 0; m < 4; ++m)
#pragma unroll
        for (int i = 0; i < 4; ++i) {
            const float xcv = bf2f(*(const bf16_t*)(xcs + (16 * m + 4 * q + i) * XC_STRIDE + chl * 2));
            float a, b; lru_coef(ar[m][i], ai[m][i], nsp, xcv, a, b); ar[m][i] = a; ai[m][i] = b;
        }
    float At[4], Bt[4], Ae[4], Be[4];
#pragma unroll
    for (int m = 0; m < 4; ++m) {
        float A = 1.f, B = 0.f;
#pragma unroll
        for (int ii = 0; ii < 4; ++ii) { const int i = DIR ? 3 - ii : ii; B = ar[m][i] * B + ai[m][i]; A = ar[m][i] * A; }
        if (DIR == 0) {
            float tA = __shfl_up(A, 16), tB = __shfl_up(B, 16); if (q >= 1) { B = A * tB + B; A = A * tA; }
            tA = __shfl_up(A, 32); tB = __shfl_up(B, 32); if (q >= 2) { B = A * tB + B; A = A * tA; }
            Ae[m] = __shfl_up(A, 16); Be[m] = __shfl_up(B, 16); if (q == 0) { Ae[m] = 1.f; Be[m] = 0.f; }
            At[m] = __shfl(A, 48 + fr); Bt[m] = __shfl(B, 48 + fr);
        } else {
            float tA = __shfl_down(A, 16), tB = __shfl_down(B, 16); if (q <= 2) { B = A * tB + B; A = A * tA; }
            tA = __shfl_down(A, 32); tB = __shfl_down(B, 32); if (q <= 1) { B = A * tB + B; A = A * tA; }
            Ae[m] = __shfl_down(A, 16); Be[m] = __shfl_down(B, 16); if (q == 3) { Ae[m] = 1.f; Be[m] = 0.f; }
            At[m] = __shfl(A, fr); Bt[m] = __shfl(B, fr);
        }
    }
    if (!FINAL) {
        float A = 1.f, B = 0.f;
#pragma unroll
        for (int mm = 0; mm < 4; ++mm) { const int m = DIR ? 3 - mm : mm; B = At[m] * B + Bt[m]; A = At[m] * A; }
        totA = A; totB = B;
    } else {
        float hh = hin_v;
#pragma unroll
        for (int mm = 0; mm < 4; ++mm) { const int m = DIR ? 3 - mm : mm;
            float hs = Ae[m] * hh + Be[m];
#pragma unroll
            for (int ii = 0; ii < 4; ++ii) { const int i = DIR ? 3 - ii : ii; hs = ar[m][i] * hs + ai[m][i]; hout[m][i] = hs; }
            hh = At[m] * hh + Bt[m];
        }
    }
}

template <bool FINAL>
__device__ __forceinline__ void b_phase(const Params& p, int bid, int nb, unsigned char* lds) {
    const int tid = threadIdx.x, lane = tid & 63, wave = tid >> 6, fr = lane & 15, q = lane >> 4;
    f32x2* TOT = (f32x2*)(p.ws + OFF_TOT);
    f32x2* TOT256 = (f32x2*)(p.ws + OFF_TOT256);
    const bf16_t* WG = (const bf16_t*)(p.ws + OFF_WG);
    float* hin = (float*)(lds + B_HIN_OFF);
    const int chl = 16 * wave + fr;
    const int nitems = FINAL ? 1024 : 1024 + 128;
    int hprev = -1;
    bf16x8 fb[4][4];
    float* cst = (float*)(lds + B_Y_OFF + 2 * B_Y_BYTES);
    for (int it = bid; it < nitems; it += nb) {
        const bool isctx = it >= 1024;
        const int b = isctx ? (it - 1024) >> 5 : it >> 8, c256 = isctx ? -1 : (it >> 3) & 31, h = it & 7, csub = (it >> 3) & 3;
        const int seqlen = isctx ? CTXL : SEQ, sbase = isctx ? 0 : c256 * 256;
        const bf16_t* src = isctx ? (const bf16_t*)(p.ws + OFF_XRC) + (size_t)b * CTXL * 1024 : (const bf16_t*)(p.ws + OFF_SLOT + 3 * SLOT) + (size_t)b * SEQ * 1024;
        const int kc0 = isctx ? 0 : 4 + c256 * 4, k256 = isctx ? 0 : 1 + c256;
        const int ch = h * 128 + chl;
        if (h != hprev) {
            hprev = h;
#pragma unroll
            for (int ty = 0; ty < 4; ++ty)
#pragma unroll
                for (int kk = 0; kk < 4; ++kk) fb[ty][kk] = *(const bf16x8*)(WG + (size_t)(h * 512 + wave * 64 + ty * 16 + fr) * 128 + 32 * kk + 8 * q);
            if (q == 0) { const float L2E = 1.4426950408889634f;
                          cst[0 * 128 + chl] = -L2E * p.in[I_BRF][ch]; cst[1 * 128 + chl] = -L2E * p.in[I_BIF][ch]; cst[2 * 128 + chl] = -8.0f * L2E * log1pf(__expf(-p.in[I_LAMF][ch]));
                          cst[3 * 128 + chl] = -L2E * p.in[I_BRB][ch]; cst[4 * 128 + chl] = -L2E * p.in[I_BIB][ch]; cst[5 * 128 + chl] = -8.0f * L2E * log1pf(__expf(-p.in[I_LAMB][ch])); }
            wave_lds_sync();
        }
        float runAf = 1.f, runBf = 0.f, runAb = 1.f, runBb = 0.f;
        {
            const int cgp = tid & 15, c0 = h * 128 + 8 * cgp;
            float wk[4][8], bs[8];
            { const f32x4* bp = (const f32x4*)(p.in[I_LCB] + c0); const f32x4 t0_ = bp[0], t1_ = bp[1];
                bs[0] = t0_[0]; bs[1] = t0_[1]; bs[2] = t0_[2]; bs[3] = t0_[3]; bs[4] = t1_[0]; bs[5] = t1_[1]; bs[6] = t1_[2]; bs[7] = t1_[3];
#pragma unroll
                for (int k = 0; k < 4; ++k) { const f32x4* wp = (const f32x4*)(p.in[I_LCW] + k * 1024 + c0); const f32x4 w0 = wp[0], w1 = wp[1];
                    wk[k][0] = w0[0]; wk[k][1] = w0[1]; wk[k][2] = w0[2]; wk[k][3] = w0[3]; wk[k][4] = w1[0]; wk[k][5] = w1[1]; wk[k][6] = w1[2]; wk[k][7] = w1[3]; } }
#pragma unroll 1
            for (int ps = 0; ps < (isctx ? 1 : 2); ++ps) {
                if (isctx && tid >= 256) break;
                const int tq = isctx ? csub * 64 + (tid >> 4) * 4 : ps * 128 + (tid >> 4) * 4;
                float xc[4][8];
#pragma unroll
                for (int r = 0; r < 4; ++r)
#pragma unroll
                    for (int e = 0; e < 8; ++e) xc[r][e] = bs[e];
#pragma unroll
                for (int rr = 0; rr < 7; ++rr) {
                    const int row = sbase + tq + rr - 2;
                    u32x4 a = (u32x4){0u, 0u, 0u, 0u};
                    if (row >= 0 && row < seqlen) a = *(const u32x4*)(src + (size_t)row * 1024 + c0);
                    const float x[8] = {bflo(a.x), bfhi(a.x), bflo(a.y), bfhi(a.y), bflo(a.z), bfhi(a.z), bflo(a.w), bfhi(a.w)};
#pragma unroll
                    for (int r = 0; r < 4; ++r) { const int k = rr - r;
                        if (k >= 0 && k < 4) {
#pragma unroll
                            for (int e = 0; e < 8; ++e) xc[r][e] += wk[k][e] * x[e]; } }
                }
#pragma unroll
                for (int r = 0; r < 4; ++r) {
                    u32x4 o0; o0.x = pk2(xc[r][0], xc[r][1]); o0.y = pk2(xc[r][2], xc[r][3]); o0.z = pk2(xc[r][4], xc[r][5]); o0.w = pk2(xc[r][6], xc[r][7]);
                    *(u32x4*)(lds + B_XC_OFF + (tq + r) * XC_STRIDE + cgp * 16) = o0;
                }
            }
        }
        f32x2 ct[33], cs[4];
        const int cdir = (tid >> 7) & 1, ccl = tid & 127;
        if (FINAL && tid < 256) {
            const f32x2* T2 = TOT256 + ((size_t)b * 33 * 2 + cdir) * 1024 + h * 128 + ccl;
            const f32x2* T = TOT + ((size_t)b * NCH64 * 2 + cdir) * 1024 + h * 128 + ccl;
#pragma unroll
            for (int k = 1; k < 33; ++k) { const bool use = cdir == 0 ? (k < k256) : (k > k256); ct[k] = use ? T2[(size_t)k * 2048] : (f32x2){1.f, 0.f}; }
            { f32x2 c4[4];
#pragma unroll
                for (int s_ = 0; s_ < 4; ++s_) c4[s_] = T[(size_t)s_ * 2048];
                float A = 1.f, B = 0.f;
#pragma unroll
                for (int s_ = 0; s_ < 4; ++s_) { const f32x2 t = cdir == 0 ? c4[s_] : c4[3 - s_]; B = t.x * B + t.y; A = t.x * A; }
                ct[0] = (f32x2){A, B}; }
#pragma unroll
            for (int s_ = 0; s_ < 4; ++s_) cs[s_] = T[(size_t)(kc0 + s_) * 2048];
        }
        if (FINAL && tid < 256) {
            float hc = 0.f;
            if (cdir == 0) {
#pragma unroll
                for (int k = 0; k < 33; ++k) hc = ct[k].x * hc + ct[k].y;
#pragma unroll
                for (int s_ = 0; s_ < 4; ++s_) { hin[(s_ * 2 + 0) * 128 + ccl] = hc; hc = cs[s_].x * hc + cs[s_].y; }
            } else {
                hc = ct[0].y;
#pragma unroll
                for (int k = 32; k >= 1; --k) hc = ct[k].x * hc + ct[k].y;
#pragma unroll
                for (int s_ = 3; s_ >= 0; --s_) { hin[(s_ * 2 + 1) * 128 + ccl] = hc; hc = cs[s_].x * hc + cs[s_].y; }
            }
        }
        __syncthreads();
        for (int sub = isctx ? csub : 0; sub < (isctx ? csub + 1 : 4); ++sub) {
            const int t0 = sbase + 64 * sub;
            const unsigned char* xcs = lds + B_XC_OFF + 64 * sub * XC_STRIDE;
            f32x4 hf[4], hb[4]; float tA, tB;
            lru_dir<FINAL, 0>(xcs, fb[0], fb[1], cst[0 * 128 + chl], cst[1 * 128 + chl], cst[2 * 128 + chl], fr, q, chl, FINAL ? hin[(sub * 2 + 0) * 128 + chl] : 0.f, hf, tA, tB);
            if (!FINAL) { if (q == 0) TOT[((size_t)(b * NCH64 + kc0 + sub) * 2 + 0) * 1024 + ch] = (f32x2){tA, tB};
                runBf = tA * runBf + tB; runAf = tA * runAf; }
            u32x4 gy0, gy1;
            if (FINAL) { const bf16_t* GYG = (const bf16_t*)(p.ws + OFF_SLOT + 2 * SLOT) + ((size_t)b * SEQ + t0 + lane) * 1024 + h * 128 + 16 * wave;
                gy0 = *(const u32x4*)GYG; gy1 = *(const u32x4*)(GYG + 8); }
            lru_dir<FINAL, 1>(xcs, fb[2], fb[3], cst[3 * 128 + chl], cst[4 * 128 + chl], cst[5 * 128 + chl], fr, q, chl, FINAL ? hin[(sub * 2 + 1) * 128 + chl] : 0.f, hb, tA, tB);
            if (!FINAL) { if (q == 0) TOT[((size_t)(b * NCH64 + kc0 + sub) * 2 + 1) * 1024 + ch] = (f32x2){tA, tB};
                runBb = runAb * tB + runBb; runAb = runAb * tA; }
            if (FINAL) {
                float* wy = (float*)(lds + B_Y_OFF) + wave * (64 * 20);
#pragma unroll
                for (int m = 0; m < 4; ++m)
#pragma unroll
                    for (int i = 0; i < 4; ++i) wy[(16 * m + 4 * q + i) * 20 + fr] = hf[m][i] + hb[m][i];
                wave_lds_sync();
                const f32x4* yp = (const f32x4*)(wy + lane * 20);
                const f32x4 y0 = yp[0], y1 = yp[1], y2 = yp[2], y3 = yp[3];
                u32x4 o0, o1;
                o0.x = pk2(bflo(gy0.x) * y0[0], bfhi(gy0.x) * y0[1]); o0.y = pk2(bflo(gy0.y) * y0[2], bfhi(gy0.y) * y0[3]);
                o0.z = pk2(bflo(gy0.z) * y1[0], bfhi(gy0.z) * y1[1]); o0.w = pk2(bflo(gy0.w) * y1[2], bfhi(gy0.w) * y1[3]);
                o1.x = pk2(bflo(gy1.x) * y2[0], bfhi(gy1.x) * y2[1]); o1.y = pk2(bflo(gy1.y) * y2[2], bfhi(gy1.y) * y2[3]);
                o1.z = pk2(bflo(gy1.z) * y3[0], bfhi(gy1.z) * y3[1]); o1.w = pk2(bflo(gy1.w) * y3[2], bfhi(gy1.w) * y3[3]);
                bf16_t* AB = (bf16_t*)(p.ws + OFF_SLOT + 1 * SLOT) + ((size_t)b * SEQ + t0 + lane) * 1024 + h * 128 + 16 * wave;
                *(u32x4*)AB = o0; *(u32x4*)(AB + 8) = o1;
                wave_lds_sync();
            }
        }
        __syncthreads();
        if (!FINAL && q == 0 && !isctx) {
            TOT256[((size_t)(b * 33 + k256) * 2 + 0) * 1024 + ch] = (f32x2){runAf, runBf};
            TOT256[((size_t)(b * 33 + k256) * 2 + 1) * 1024 + ch] = (f32x2){runAb, runBb};
        }
    }
}

__device__ __forceinline__ void ph8_route(const Params& p, int bid, int nb, unsigned char* lds) {
    constexpr int NU = 1;
    const int tid = threadIdx.x, lane = tid & 63, wave = tid >> 6;
    float* Wl = (float*)lds;
    int* lcnt = (int*)(lds + 81920);
    int* lbase = lcnt + 16;
    int* tinfo = lcnt + 32;
    float* twt = (float*)(tinfo + 512);
#pragma unroll 1
    for (int kk = 0; kk < 2; ++kk) { const int k = tid + kk * NTHR;
        const f32x4 wg = *(const f32x4*)(p.in[I_WGRP] + k * 4);
        Wl[0 * 1024 + k] = wg[0]; Wl[1 * 1024 + k] = wg[1]; Wl[2 * 1024 + k] = wg[2]; Wl[3 * 1024 + k] = wg[3];
#pragma unroll
        for (int o4 = 0; o4 < 4; ++o4) { const f32x4 we = *(const f32x4*)(p.in[I_WER] + k * 16 + o4 * 4);
            Wl[(4 + o4 * 4 + 0) * 1024 + k] = we[0]; Wl[(4 + o4 * 4 + 1) * 1024 + k] = we[1]; Wl[(4 + o4 * 4 + 2) * 1024 + k] = we[2]; Wl[(4 + o4 * 4 + 3) * 1024 + k] = we[3]; } }
    __syncthreads();
    const float* MOD = (const float*)(p.ws + OFF_MOD);
    const bf16_t* X1B = (const bf16_t*)(p.ws + OFF_SLOT + 5 * SLOT);
    bf16_t* HM = (bf16_t*)(p.ws + OFF_SLOT + 2 * SLOT);
    unsigned* gcnt = (unsigned*)(p.ws + OFF_CTL);
    int* LIST = (int*)(p.ws + OFF_LIST); float* WLs = (float*)(p.ws + OFF_WL); int* ROUTE = (int*)(p.ws + OFF_ROUTE);
    float* bl = (float*)(lds + 81920 + 8192);
    if (tid < 20) bl[tid] = tid < 4 ? p.in[I_BGRP][tid] : p.in[I_BER][tid - 4];
    __syncthreads();
    for (int tile = bid; tile < NT / 128; tile += nb) {
        if (tid < 16) lcnt[tid] = 0;
        __syncthreads();
        const float* mrow = MOD + ((tile * 128) / SEQ) * 6144;
        f32x4 gq[4], shq[4], scq[4];
#pragma unroll
        for (int j = 0; j < 4; ++j) { const int c = lane * 4 + 256 * j; gq[j] = *(const f32x4*)(p.in[I_GFFN] + c); shq[j] = *(const f32x4*)(mrow + 3 * 1024 + c); scq[j] = *(const f32x4*)(mrow + 4 * 1024 + c); gq[j] = gq[j] * (1.0f + scq[j]); }
        u32x2 nx[4];
#pragma unroll
        for (int j = 0; j < 4; ++j) nx[j] = *(const u32x2*)(X1B + (size_t)(tile * 128 + wave * 16) * DM + lane * 4 + 256 * j);
#pragma unroll 1
        for (int tt = 0; tt < 16; tt += NU) {
            const int tl = wave * 16 + tt, tok = tile * 128 + tl;
            f32x4 v[NU][4]; float ss[NU];
#pragma unroll
            for (int u = 0; u < NU; ++u) ss[u] = 0.f;
#pragma unroll
            for (int j = 0; j < 4; ++j) { v[0][j] = (f32x4){bflo(nx[j].x), bfhi(nx[j].x), bflo(nx[j].y), bfhi(nx[j].y)}; const f32x4 sq = v[0][j] * v[0][j]; ss[0] += (sq[0] + sq[1]) + (sq[2] + sq[3]); }
            { const int tn = tt + 1 < 16 ? tok + 1 : tok;
#pragma unroll
                for (int j = 0; j < 4; ++j) nx[j] = *(const u32x2*)(X1B + (size_t)tn * DM + lane * 4 + 256 * j); }
            float lg[NU][20];
#pragma unroll
            for (int u = 0; u < NU; ++u) { const float rinv = rsqrtf(wave_sum_dpp(ss[u]) * (1.0f / DM) + 1e-6f);
#pragma unroll
                for (int j = 0; j < 4; ++j) { v[u][j] = v[u][j] * rinv * gq[j] + shq[j]; *(u32x2*)(HM + (size_t)(tok + u) * DM + lane * 4 + 256 * j) = pk4(v[u][j]); }
}
#pragma unroll
            for (int o = 0; o < 20; ++o)
            { f32x4 wv[4];
#pragma unroll
                for (int j = 0; j < 4; ++j) wv[j] = *(const f32x4*)(Wl + o * 1024 + lane * 4 + 256 * j);
#pragma unroll
                for (int u = 0; u < NU; ++u) { f32x4 pr = v[u][0] * wv[0]; pr += v[u][1] * wv[1]; pr += v[u][2] * wv[2]; pr += v[u][3] * wv[3]; lg[u][o] = (pr[0] + pr[1]) + (pr[2] + pr[3]); }
                if ((o & 3) == 3) asm volatile("" ::: "memory"); }
#pragma unroll
            for (int u = 0; u < NU; ++u) {
#pragma unroll
                for (int o = 0; o < 20; ++o) lg[u][o] = wave_sum_dpp(lg[u][o]) + bl[o];
                int gs = 0; float gm = lg[u][0];
#pragma unroll
                for (int o = 1; o < 4; ++o) if (lg[u][o] > gm) { gm = lg[u][o]; gs = o; }
                float den = 0.f;
#pragma unroll
                for (int o = 0; o < 4; ++o) den += __expf(lg[u][o] - gm);
                const float pg = 1.0f / den;
                float el[4];
#pragma unroll
                for (int o = 0; o < 4; ++o) el[o] = gs == 0 ? lg[u][4 + o] : gs == 1 ? lg[u][8 + o] : gs == 2 ? lg[u][12 + o] : lg[u][16 + o];
                int i1 = 0; float v1 = el[0];
#pragma unroll
                for (int o = 1; o < 4; ++o) if (el[o] > v1) { v1 = el[o]; i1 = o; }
                int i2 = -1; float v2 = -3.0e38f;
#pragma unroll
                for (int o = 0; o < 4; ++o) if (o != i1 && el[o] > v2) { v2 = el[o]; i2 = o; }
                const float w1 = 1.0f / (1.0f + __expf(v2 - v1)), w2 = 1.0f - w1;
                if (lane == 0) { const int e1 = gs * 4 + i1, e2 = gs * 4 + i2;
                    const int r1 = atomicAdd(&lcnt[e1], 1), r2 = atomicAdd(&lcnt[e2], 1);
                    tinfo[(tl + u) * 4 + 0] = e1; tinfo[(tl + u) * 4 + 1] = r1; tinfo[(tl + u) * 4 + 2] = e2; tinfo[(tl + u) * 4 + 3] = r2; twt[(tl + u) * 2] = pg * w1; twt[(tl + u) * 2 + 1] = pg * w2; }
            }
        }
        __syncthreads();
        if (tid < 16) lbase[tid] = (int)__hip_atomic_fetch_add(gcnt + tid, (unsigned)lcnt[tid], __ATOMIC_RELAXED, __HIP_MEMORY_SCOPE_AGENT);
        __syncthreads();
        if (tid < 128) { const int tok = tile * 128 + tid;
            const int e1 = tinfo[tid * 4], e2 = tinfo[tid * 4 + 2], p1 = lbase[e1] + tinfo[tid * 4 + 1], p2 = lbase[e2] + tinfo[tid * 4 + 3];
            LIST[e1 * NT + p1] = tok; LIST[e2 * NT + p2] = tok; WLs[e1 * NT + p1] = twt[tid * 2]; WLs[e2 * NT + p2] = twt[tid * 2 + 1];
            ROUTE[tok * 4 + 0] = e1; ROUTE[tok * 4 + 1] = p1; ROUTE[tok * 4 + 2] = e2; ROUTE[tok * 4 + 3] = p2; }
        __syncthreads();
    }
}

__device__ __forceinline__ void ph10_final(const Params& p, int bid, int nb, const int* meta) {
    const int lane = threadIdx.x & 63, wave = threadIdx.x >> 6;
    const float* MOD = (const float*)(p.ws + OFF_MOD);
    const bf16_t* Y = (const bf16_t*)(p.ws + OFF_SLOT);
    const int* ROUTE = (const int*)(p.ws + OFF_ROUTE);
    const bf16_t* X1B = (const bf16_t*)(p.ws + OFF_SLOT + 5 * SLOT); float* OUT = p.out;
    const int r0 = bid * 8 + wave, rs = nb * 8;
    f32x4 gf[4], gtv[4]; int mprev = -1;
#pragma unroll
    for (int j = 0; j < 4; ++j) gf[j] = *(const f32x4*)(p.in[I_GFINAL] + lane * 4 + 256 * j);
    auto yrow = [&](int r, int k) -> const bf16_t* { const int e = ROUTE[r * 4 + 2 * k], pp = ROUTE[r * 4 + 2 * k + 1]; return y_row(p.ws, (size_t)meta[16 + e] * 256 + pp); };
    u32x2 nx[4], na[4], nb2[4];
    const bf16_t *ya = yrow(r0, 0), *yb = yrow(r0, 1);
#pragma unroll
    for (int j = 0; j < 4; ++j) { const int c = lane * 4 + 256 * j; nx[j] = *(const u32x2*)(X1B + (size_t)r0 * DM + c); na[j] = *(const u32x2*)(ya + c); nb2[j] = *(const u32x2*)(yb + c); }
    { const int rn = r0 + rs < NT ? r0 + rs : r0; ya = yrow(rn, 0); yb = yrow(rn, 1); }
#pragma unroll 1
    for (int r = r0; r < NT; r += rs) {
        const int mb = r / SEQ;
        if (mb != mprev) { mprev = mb;
#pragma unroll
            for (int j = 0; j < 4; ++j) gtv[j] = *(const f32x4*)(MOD + mb * 6144 + 5 * 1024 + lane * 4 + 256 * j); }
        f32x4 v[4]; float ss = 0.f;
#pragma unroll
        for (int j = 0; j < 4; ++j) {
            v[j] = (f32x4){bflo(nx[j].x), bfhi(nx[j].x), bflo(nx[j].y), bfhi(nx[j].y)};
            const f32x4 ys = (f32x4){bflo(na[j].x) + bflo(nb2[j].x), bfhi(na[j].x) + bfhi(nb2[j].x), bflo(na[j].y) + bflo(nb2[j].y), bfhi(na[j].y) + bfhi(nb2[j].y)};
            v[j] += gtv[j] * ys; const f32x4 sq = v[j] * v[j]; ss += (sq[0] + sq[1]) + (sq[2] + sq[3]); }
        { const int rn = r + rs < NT ? r + rs : r;
#pragma unroll
            for (int j = 0; j < 4; ++j) { const int c = lane * 4 + 256 * j; nx[j] = *(const u32x2*)(X1B + (size_t)rn * DM + c); na[j] = *(const u32x2*)(ya + c); nb2[j] = *(const u32x2*)(yb + c); }
            const int rn2 = r + 2 * rs < NT ? r + 2 * rs : rn; ya = yrow(rn2, 0); yb = yrow(rn2, 1); }
        const float rinv = rsqrtf(wave_sum_dpp(ss) * (1.0f / DM) + 1e-6f);
#pragma unroll
        for (int j = 0; j < 4; ++j) *(f32x4*)(OUT + (size_t)r * DM + lane * 4 + 256 * j) = v[j] * rinv * gf[j];
    }
}

#define XB_TMO      128
#define XB_XCNT(j)  (256  + 64 * (j))
#define XB_XSUB(j)  (1280 + 64 * (j))
#define XB_XGEN(j)  (2304 + 64 * (j))
#define XB_TOP      3328
#define XB_TOPGEN   3392
#define XCD_BAR_WORDS 3456
#define XB_SPIN_CAP (1u << 18)
__device__ __forceinline__ unsigned xb_ld(unsigned* p)              { return __hip_atomic_load(p, __ATOMIC_RELAXED, __HIP_MEMORY_SCOPE_AGENT); }
__device__ __forceinline__ unsigned xb_add(unsigned* p, unsigned v) { return __hip_atomic_fetch_add(p, v, __ATOMIC_RELAXED, __HIP_MEMORY_SCOPE_AGENT); }
__device__ __forceinline__ unsigned xb_xcc_id() { return (unsigned)__builtin_amdgcn_s_getreg((3 << 11) | 20) & 0xFu; }
#define XB_SPIN(cond, bar) do { unsigned _sp = 0; while (cond) { __builtin_amdgcn_s_sleep(1); \
    if ((++_sp & 255u) == 0u) { if (xb_ld(&(bar)[XB_TMO])) break; if (_sp > XB_SPIN_CAP) { atomicAdd(&(bar)[XB_TMO], 1u); break; } } } } while (0)
struct XcdBarrier { unsigned* bar; unsigned x; volatile unsigned* st; };
__device__ __forceinline__ XcdBarrier xcd_barrier_post(unsigned* bar, volatile unsigned* st) {
    XcdBarrier b; b.bar = bar; b.x = xb_xcc_id(); b.st = st;
    if (threadIdx.x == 0) (void)xb_add(&bar[XB_XCNT(b.x)], 1u);
    return b;
}
__device__ __forceinline__ void xcd_barrier_complete(unsigned* bar, unsigned x, unsigned& nloc, unsigned& nx) {
    const unsigned G = gridDim.x * gridDim.y * gridDim.z;
    unsigned sum, cnt, mine, sp = 0u;
    for (;;) {
        sum = 0u; cnt = 0u; mine = 0u;
#pragma unroll
        for (unsigned j = 0; j < 16; ++j) { const unsigned c = xb_ld(&bar[XB_XCNT(j)]); sum += c; cnt += (c > 0u) ? 1u : 0u; mine = (j == x) ? c : mine; }
        if (sum == G) break;
        __builtin_amdgcn_s_sleep(1);
        if ((++sp & 255u) == 0u) { if (xb_ld(&bar[XB_TMO])) break; if (sp > XB_SPIN_CAP) { atomicAdd(&bar[XB_TMO], 1u); break; } }
    }
    nloc = mine > 0u ? mine : 1u; nx = cnt > 0u ? cnt : 1u;
}
__device__ __forceinline__ void xcd_barrier(const XcdBarrier& b) {
    asm volatile("s_waitcnt vmcnt(0)" ::: "memory");
    __syncthreads();
    if (threadIdx.x == 0) {
        unsigned* bar = b.bar;
        __builtin_amdgcn_s_waitcnt(0);
        unsigned nloc = b.st[0], nx = b.st[1];
        if (nloc == 0u) { xcd_barrier_complete(bar, b.x, nloc, nx); b.st[0] = nloc; b.st[1] = nx; }
        const unsigned old = xb_add(&bar[XB_XSUB(b.x)], 1u);
        const unsigned gen = old / nloc;
        if (old + 1u == (gen + 1u) * nloc) {
            __builtin_amdgcn_fence(__ATOMIC_RELEASE, "agent");
            asm volatile("s_waitcnt vmcnt(0)" ::: "memory");
            const unsigned og = xb_add(&bar[XB_TOP], 1u);
            const unsigned tg = og / nx;
            if (og + 1u == (tg + 1u) * nx) xb_add(&bar[XB_TOPGEN], 1u);
            else XB_SPIN(xb_ld(&bar[XB_TOPGEN]) == tg, bar);
            __builtin_amdgcn_fence(__ATOMIC_ACQUIRE, "agent");
            xb_add(&bar[XB_XGEN(b.x)], 1u);
            asm volatile("s_waitcnt vmcnt(0)" ::: "memory");
        } else {
            XB_SPIN(xb_ld(&bar[XB_XGEN(b.x)]) == gen, bar);
            __builtin_amdgcn_fence(__ATOMIC_ACQUIRE, "agent");
            asm volatile("s_waitcnt vmcnt(0)" ::: "memory");
        }
    }
    __syncthreads();
}
constexpr size_t OFF_BAR = OFF_CTL + 4096;

__global__ void __launch_bounds__(NTHR) mega(Params p, int lo, int hi) {
    extern __shared__ __attribute__((aligned(16))) unsigned char lds[];
    cg::grid_group grid = cg::this_grid();
    const int bid = blockIdx.x, nb = gridDim.x;
    unsigned char* ws = p.ws;
    bf16_t* S0 = (bf16_t*)(ws + OFF_SLOT), *S1 = (bf16_t*)(ws + OFF_SLOT + SLOT), *S2 = (bf16_t*)(ws + OFF_SLOT + 2 * SLOT), *S3 = (bf16_t*)(ws + OFF_SLOT + 3 * SLOT),
           *S4 = (bf16_t*)(ws + OFF_SLOT + 4 * SLOT), *S5 = (bf16_t*)(ws + OFF_SLOT + 5 * SLOT);
    const float* MOD = (const float*)(ws + OFF_MOD); const float* BINP = (const float*)(ws + OFF_BINP);
    int* meta = (int*)(lds + LDS_BYTES - 256);
#ifndef PHMASK
#define PHMASK 0x7ff
#endif
#define IN(k) (((PHMASK >> (k)) & 1) && lo <= (k) && (k) < hi)
#ifndef PIPE_MASK
#define PIPE_MASK 0x364
#endif
#define GEMM_RUN(k, gather, s, e) gemm_phase_pipe<gather>(lds, s, e)
    volatile unsigned* xst = (volatile unsigned*)(lds + LDS_BYTES - 16);
    if (threadIdx.x < 2) xst[threadIdx.x] = 0u;
    __syncthreads();
    XcdBarrier xbar; xbar.bar = (unsigned*)(ws + OFF_BAR); xbar.x = 0; xbar.st = xst;
    if (hi - lo > 1) xbar = xcd_barrier_post((unsigned*)(ws + OFF_BAR), xst);
    if (p.pv == 0x7eadbeef) grid.sync();
#define SEAM(k) do { if (IN(k) && IN((k) + 1)) xcd_barrier(xbar); } while (0)
    if (IN(0)) { ph0_prep(p, bid, nb, lds); } SEAM(0);
    if (IN(1)) { if (ph1_norm(p, bid, nb)) { SchCtx s{(const bf16_t*)(ws + OFF_HC), (const bf16_t*)(ws + OFF_WIN), CTX_GEMM_WGS, bid, 1024}; EpiCtx e{(bf16_t*)(ws + OFF_XRC), BINP}; GEMM_RUN(1, false, s, e); } } SEAM(1);
    if (IN(2)) {
        if (nb < 4 * CTX_GEMM_WGS) { SchCtx s{(const bf16_t*)(ws + OFF_HC), (const bf16_t*)(ws + OFF_WIN), nb, bid, 1024}; EpiCtx e{(bf16_t*)(ws + OFF_XRC), BINP}; GEMM_RUN(2, false, s, e); }
        { SchG1 s{S0, (const bf16_t*)(ws + OFF_WIN), nb, bid, 1024}; EpiG1 e{S1, S2, S3, S4, S5, BINP}; GEMM_RUN(2, false, s, e); }
    } SEAM(2);
    if (IN(3)) {
        if (bid & 1) { b_phase<false>(p, bid, nb, lds); __syncthreads(); }
        { bool have = false; for (int g = bid; g < 512; g += nb) { const int gn = g + nb < 512 ? g + nb : -1; aprep_item(p, g, lds, have, gn); have = gn >= 0; } }
        if (!(bid & 1)) { __syncthreads(); b_phase<false>(p, bid, nb, lds); }
    } SEAM(3);
    if (IN(4)) {
        if (!(bid & 1)) { prep_items(p, PREP_EARLY, PREP_ALL, bid * 8 + (int)(threadIdx.x >> 6), nb * 8, lds); __syncthreads(); }
        b_phase<true>(p, bid, nb, lds);
        if (bid & 1) { __syncthreads(); prep_items(p, PREP_EARLY, PREP_ALL, bid * 8 + (int)(threadIdx.x >> 6), nb * 8, lds); }
    } SEAM(4);
    if (IN(5)) { SchG2 s{S0, S1, (const bf16_t*)(ws + OFF_WPA), (const bf16_t*)(ws + OFF_WPB), nb, bid, 1024}; EpiG2 e{S4, S5, S3}; GEMM_RUN(5, false, s, e); } SEAM(5);
    if (IN(6)) { SchG3 s{S3, (const bf16_t*)(ws + OFF_WO), nb, bid, 1024}; EpiG3 e{p.in[I_X], MOD, S5}; GEMM_RUN(6, false, s, e); } SEAM(6);
    if (IN(7)) { ph8_route(p, bid, nb, lds); } SEAM(7);
    if (IN(8)) { __syncthreads(); moe_meta_build(p, meta); MoeMeta mm{meta};
        int* idx = (int*)(lds + STAGE_BYTES);
        SchUp s{S2, (const bf16_t*)(ws + OFF_WGU), (const int*)(ws + OFF_LIST), mm, nb, bid, 1024, idx, (unsigned*)(ws + OFF_CTL) + 64}; EpiUp e{S3, (const float*)(ws + OFF_WL), mm};
        { int iv[8]; bool ok[8];
#pragma unroll
            for (int i = 0; i < 8; ++i) { Unit u; ok[i] = s.next(i, u); iv[i] = 0;
                if (ok[i] && threadIdx.x < 256) { int pos = u.aux2 + (int)threadIdx.x; const int c = mm.cnt(u.aux); pos = pos < c ? pos : c - 1; iv[i] = s.LIST[u.aux * NT + pos]; } }
#pragma unroll
            for (int i = 0; i < 8; ++i) if (ok[i] && threadIdx.x < 256) idx[i * 256 + threadIdx.x] = iv[i]; }
        __syncthreads();
        GEMM_RUN(8, true, s, e); }
    if (IN(9)) { __syncthreads(); moe_meta_build(p, meta); MoeMeta mm{meta};
        SchDn s{S3, (const bf16_t*)(ws + OFF_WDN), mm, nb, bid, 512, (unsigned*)(ws + OFF_CTL) + 64, IN(8)}; EpiDn e{ws, mm}; GEMM_RUN(9, false, s, e); } SEAM(9);
    if (IN(10)) { __syncthreads(); moe_meta_build(p, meta); ph10_final(p, bid, nb, meta); }
#undef IN
#undef SEAM
}

extern "C" void kernel_launch(void* const* d_in, const int* in_sizes, int n_in, void* d_out, int out_size, void* d_ws, size_t ws_size, hipStream_t stream) {
    static int grid = 0;
    if (grid == 0) {
        if (n_in != 37 || out_size != NT * DM || ws_size < WS_END) { fprintf(stderr, "kernel_launch: unexpected shapes: n_in %d out %d ws %zu (need %zu)\n", n_in, out_size, ws_size, (size_t)WS_END); grid = -1; return; }
        int dev = 0, cus = 0, per_cu = 0;
        (void)hipGetDevice(&dev); (void)hipDeviceGetAttribute(&cus, hipDeviceAttributeMultiprocessorCount, dev);
        if (hipFuncSetAttribute((const void*)mega, hipFuncAttributeMaxDynamicSharedMemorySize, LDS_BYTES) != hipSuccess) { fprintf(stderr, "kernel_launch: hipFuncSetAttribute failed\n"); grid = -1; return; }
        if (hipOccupancyMaxActiveBlocksPerMultiprocessor(&per_cu, (const void*)mega, NTHR, LDS_BYTES) != hipSuccess || per_cu < 1) { fprintf(stderr, "kernel_launch: occupancy query says %d\n", per_cu); per_cu = 1; }
        (void)hipGetLastError();
        grid = cus * 1;
        fprintf(stderr, "kernel_launch: grid %d (cus %d, per_cu %d)\n", grid, cus, per_cu);
    }
    if (grid < 0) return;
    Params p{};
    for (int i = 0; i < 37; ++i) p.in[i] = (const float*)d_in[i];
    p.out = (float*)d_out; p.ws = (unsigned char*)d_ws;
#if ONE_LAUNCH
    (void)hipMemsetAsync((unsigned char*)d_ws + OFF_BAR, 0, XCD_BAR_WORDS * 4, stream);
    int lo = 0, hi = NPHASE; void* args[] = {&p, &lo, &hi};
    hipError_t e = hipLaunchCooperativeKernel((const void*)mega, dim3(grid), dim3(NTHR), args, LDS_BYTES, stream);
    if (e != hipSuccess) fprintf(stderr, "cooperative launch failed: %s (grid %d)\n", hipGetErrorString(e), grid);
#ifdef PROBE_PHASE
    hipLaunchKernelGGL(mega, dim3(grid), dim3(NTHR), LDS_BYTES, stream, p, PROBE_PHASE, PROBE_PHASE + 1);
#endif
#else
    for (int k = 0; k < NPHASE; ++k) hipLaunchKernelGGL(mega, dim3(grid), dim3(NTHR), LDS_BYTES, stream, p, k, k + 1);
#endif
}
```
